# Optimizing an MI355X kernel written in HIP

```python
import math
import jax
import jax.numpy as jnp
from jax import lax
import numpy as np

D_MODEL = 1024
BATCH = 4
SEQ = 4096
DEPTH = 2

N_EVEN = (DEPTH + 1) // 2
N_ODD = DEPTH // 2

CONV_CH = D_MODEL // 2
CONV_WIDTH = 31
ATT_HEADS = 8
HEAD_DIM = 64
ATT_WIDTH = ATT_HEADS * HEAD_DIM
DILATED = ((128, 1), (512, 4), (2048, 16))
IN_COLS = 2 * CONV_CH + 3 * ATT_WIDTH
MIX_WIDTH = CONV_CH + ATT_WIDTH
SSM_GROUP = 16
SSM_GROUPS = D_MODEL // SSM_GROUP
SSM_STATE = 64
N_EXPERTS = 16
EXPERT_HIDDEN = D_MODEL
CAPACITY_FACTOR = 2
EPS = 1e-6
NEG_INF = -1e30

kernel_name = 'hybrid_conv_dilattn_s5_ecmoe'

F32 = jnp.float32


def rmsnorm(x, g):
    xf = x.astype(F32)
    y = xf * lax.rsqrt(jnp.mean(xf * xf, axis=-1, keepdims=True) + EPS)
    return (y * g.astype(F32)).astype(x.dtype)


def layernorm(x, g, b):
    mu = jnp.mean(x, axis=-1, keepdims=True)
    var = jnp.mean(jnp.square(x - mu), axis=-1, keepdims=True)
    return (x - mu) * lax.rsqrt(var + EPS) * g + b


def conformer_conv(a_val, a_gate, conv_w, conv_b, ln_g, ln_b):
    h = a_val.astype(F32) * jax.nn.sigmoid(a_gate.astype(F32))
    h = lax.conv_general_dilated(
        h, conv_w.astype(F32)[:, None, :], window_strides=(1,),
        padding=[(CONV_WIDTH // 2, CONV_WIDTH // 2)],
        dimension_numbers=('NWC', 'WIO', 'NWC'),
        feature_group_count=CONV_CH) + conv_b.astype(F32)
    h = layernorm(h, ln_g.astype(F32), ln_b.astype(F32))
    return jax.nn.silu(h)


def dilated_band_attention(q, k, v, slopes, window, dilation):
    B, H, S, Dh = q.shape
    r = window // (2 * dilation)
    L = S // dilation
    nb = -(-L // r)
    Lp = nb * r

    def to_classes(t):
        t = t.reshape(B, H, L, dilation, Dh).transpose(0, 1, 3, 2, 4)
        return jnp.pad(t, ((0, 0), (0, 0), (0, 0), (0, Lp - L), (0, 0)))

    def key_blocks(t):
        t = jnp.pad(to_classes(t), ((0, 0), (0, 0), (0, 0), (r, r), (0, 0)))
        return t.reshape(B, H, dilation, nb + 2, r, Dh)

    qb = to_classes(q).reshape(B, H, dilation, nb, r, Dh)
    kb = key_blocks(k)
    vb = key_blocks(v)

    blk = jnp.arange(nb)[:, None, None, None]
    a_q = jnp.arange(r)[None, :, None, None]
    off = jnp.arange(3)[None, None, :, None]
    a_k = jnp.arange(r)[None, None, None, :]
    qi = blk * r + a_q
    kj = (blk + off - 1) * r + a_k
    rel = kj - qi
    valid = (jnp.abs(rel) <= r) & (kj >= 0) & (kj < L)
    dist = (dilation * jnp.abs(rel)).astype(F32)
    bias = -slopes[:, None, None, None, None, None] * dist

    scale = 1.0 / math.sqrt(Dh)
    s = jnp.stack([jnp.einsum('bhcnqd,bhcnkd->bhcnqk', qb, kb[:, :, :, o:o + nb])
                   for o in range(3)], axis=-2)
    s = jnp.where(valid, s * scale + bias, NEG_INF)
    m = jnp.max(s, axis=(-2, -1), keepdims=True)
    p = jnp.exp(s - m)
    z = jnp.sum(p, axis=(-2, -1))
    o_acc = sum(jnp.einsum('bhcnqk,bhcnkd->bhcnqd', p[..., o, :], vb[:, :, :, o:o + nb])
                for o in range(3))
    out = o_acc / z[..., None]
    lse = m[..., 0, 0] + jnp.log(z)
    out = out.reshape(B, H, dilation, Lp, Dh)[:, :, :, :L]
    out = out.transpose(0, 1, 3, 2, 4).reshape(B, H, S, Dh)
    lse = lse.reshape(B, H, dilation, Lp)[:, :, :, :L].transpose(0, 1, 3, 2).reshape(B, H, S)
    return out, lse


def even_mixer(h, w_in, conv_w, conv_b, ln_g, ln_b, q_g, k_g, w_out):
    B, S, _ = h.shape
    proj = jnp.einsum('bsd,de->bse', h, w_in)
    a_val, a_gate, q, k, v = jnp.split(
        proj, [CONV_CH, 2 * CONV_CH, 2 * CONV_CH + ATT_WIDTH, 2 * CONV_CH + 2 * ATT_WIDTH], axis=-1)
    conv_out = conformer_conv(a_val, a_gate, conv_w, conv_b, ln_g, ln_b)

    def heads(t):
        return t.reshape(B, S, ATT_HEADS, HEAD_DIM).transpose(0, 2, 1, 3).astype(F32)

    qh = rmsnorm(heads(q), q_g)
    kh = rmsnorm(heads(k), k_g)
    vh = heads(v)
    slopes = 2.0 ** (-8.0 * jnp.arange(1, ATT_HEADS + 1, dtype=F32) / ATT_HEADS)
    results = [dilated_band_attention(qh, kh, vh, slopes, w, d) for (w, d) in DILATED]
    outs = jnp.stack([res[0] for res in results])
    lses = jnp.stack([res[1] for res in results])
    wts = jax.nn.softmax(lses, axis=0)
    att = jnp.sum(wts[..., None] * outs, axis=0)
    att = att.transpose(0, 2, 1, 3).reshape(B, S, ATT_WIDTH)
    mixed = jnp.concatenate([conv_out, att], axis=-1).astype(h.dtype)
    return jnp.einsum('bsc,cd->bsd', mixed, w_out)


def s5_scan(u, lam_re, lam_im, log_dt, b_re, b_im, c_re, c_im):
    lam_re = lam_re.astype(F32)
    lam_im = lam_im.astype(F32)
    dt = jnp.exp(log_dt.astype(F32))[:, None]
    mag = jnp.exp(lam_re * dt)
    ang = lam_im * dt
    lb_re = mag * jnp.cos(ang)
    lb_im = mag * jnp.sin(ang)
    den = lam_re * lam_re + lam_im * lam_im
    nr = lb_re - 1.0
    f_re = (nr * lam_re + lb_im * lam_im) / den
    f_im = (lb_im * lam_re - nr * lam_im) / den
    b_re = b_re.astype(F32)
    b_im = b_im.astype(F32)
    bb_re = f_re[..., None] * b_re - f_im[..., None] * b_im
    bb_im = f_re[..., None] * b_im + f_im[..., None] * b_re
    bu_re = jnp.einsum('bsgc,gpc->bsgp', u, bb_re)
    bu_im = jnp.einsum('bsgc,gpc->bsgp', u, bb_im)
    a_re = jnp.broadcast_to(lb_re, bu_re.shape)
    a_im = jnp.broadcast_to(lb_im, bu_im.shape)

    def combine(e1, e2):
        a1r, a1i, b1r, b1i = e1
        a2r, a2i, b2r, b2i = e2
        return (a2r * a1r - a2i * a1i,
                a2r * a1i + a2i * a1r,
                a2r * b1r - a2i * b1i + b2r,
                a2r * b1i + a2i * b1r + b2i)

    _, _, h_re, h_im = lax.associative_scan(combine, (a_re, a_im, bu_re, bu_im), axis=1)
    return (jnp.einsum('bsgp,gcp->bsgc', h_re, c_re.astype(F32))
            - jnp.einsum('bsgp,gcp->bsgc', h_im, c_im.astype(F32)))


def s5_mixer(h, lam_re, lam_im, log_dt, b_re, b_im, c_re, c_im, d_skip, w_glu):
    B, S, D = h.shape
    hf = h.astype(F32)
    u = hf.reshape(B, S, SSM_GROUPS, SSM_GROUP)
    y_f = s5_scan(u, lam_re[0], lam_im[0], log_dt[0], b_re[0], b_im[0], c_re[0], c_im[0])
    y_b = jnp.flip(s5_scan(jnp.flip(u, axis=1), lam_re[1], lam_im[1], log_dt[1],
                           b_re[1], b_im[1], c_re[1], c_im[1]), axis=1)
    y = (y_f + y_b).reshape(B, S, D) + d_skip.astype(F32) * hf
    z = jax.nn.gelu(y)
    val, gate = jnp.split(jnp.einsum('bsd,de->bse', z, w_glu.astype(F32)), 2, axis=-1)
    return (val * jax.nn.sigmoid(gate)).astype(h.dtype)


def expert_choice_ffn(h, w_router, b_router, w_gate, w_up, w_down):
    B, S, D = h.shape
    cap = CAPACITY_FACTOR * S // N_EXPERTS
    logits = jnp.einsum('bsd,de->bse', h.astype(F32), w_router.astype(F32)) + b_router.astype(F32)
    aff = jax.nn.softmax(logits, axis=-1)
    gate, idx = lax.top_k(jnp.swapaxes(aff, 1, 2), cap)
    xin = jax.vmap(lambda hb, ib: hb[ib])(h, idx)
    g = jnp.einsum('becd,edf->becf', xin, w_gate)
    u = jnp.einsum('becd,edf->becf', xin, w_up)
    out = jnp.einsum('becf,efd->becd', jax.nn.silu(g) * u, w_down)
    out = out * gate[..., None].astype(out.dtype)

    def scatter(ob, ib):
        return jnp.zeros((S, D), ob.dtype).at[ib.reshape(-1)].add(ob.reshape(-1, D))

    return jax.vmap(scatter)(out, idx).astype(h.dtype)


def setup_inputs(seed: int = 0) -> dict:
    key = jax.random.key(seed)
    ks = iter(jax.random.split(key, 40))

    def nrm(shape, scale):
        return scale * jax.random.normal(next(ks), shape, F32)

    def gain(shape):
        return 1.0 + 0.05 * jax.random.normal(next(ks), shape, F32)

    P = SSM_STATE
    G = SSM_GROUPS
    lam_im_base = math.pi * jnp.arange(P, dtype=F32)
    return {
        'x': jax.random.normal(next(ks), (BATCH, SEQ, D_MODEL), F32),
        'mix_norm_even': gain((N_EVEN, D_MODEL)),
        'w_in': nrm((N_EVEN, D_MODEL, IN_COLS), D_MODEL ** -0.5),
        'conv_w': nrm((N_EVEN, CONV_WIDTH, CONV_CH), CONV_WIDTH ** -0.5),
        'conv_b': nrm((N_EVEN, CONV_CH), 0.01),
        'conv_ln_g': gain((N_EVEN, CONV_CH)),
        'conv_ln_b': nrm((N_EVEN, CONV_CH), 0.01),
        'q_norm': gain((N_EVEN, HEAD_DIM)),
        'k_norm': gain((N_EVEN, HEAD_DIM)),
        'w_out': nrm((N_EVEN, MIX_WIDTH, D_MODEL), MIX_WIDTH ** -0.5),
        'mix_norm_odd': gain((N_ODD, D_MODEL)),
        'ssm_lam_re': -0.5 + nrm((N_ODD, 2, G, P), 0.01),
        'ssm_lam_im': lam_im_base + nrm((N_ODD, 2, G, P), 0.01),
        'ssm_log_dt': jax.random.uniform(next(ks), (N_ODD, 2, G), F32,
                                         math.log(1e-3), math.log(1e-1)),
        'ssm_b_re': nrm((N_ODD, 2, G, P, SSM_GROUP), (2 * SSM_GROUP) ** -0.5),
        'ssm_b_im': nrm((N_ODD, 2, G, P, SSM_GROUP), (2 * SSM_GROUP) ** -0.5),
        'ssm_c_re': nrm((N_ODD, 2, G, SSM_GROUP, P), P ** -0.5),
        'ssm_c_im': nrm((N_ODD, 2, G, SSM_GROUP, P), P ** -0.5),
        'ssm_d': nrm((N_ODD, D_MODEL), 0.5),
        'w_glu': nrm((N_ODD, D_MODEL, 2 * D_MODEL), D_MODEL ** -0.5),
        'ffn_norm': gain((DEPTH, D_MODEL)),
        'w_router': nrm((DEPTH, D_MODEL, N_EXPERTS), D_MODEL ** -0.5),
        'b_router': nrm((DEPTH, N_EXPERTS), 0.01),
        'w_e_gate': nrm((DEPTH, N_EXPERTS, D_MODEL, EXPERT_HIDDEN), D_MODEL ** -0.5),
        'w_e_up': nrm((DEPTH, N_EXPERTS, D_MODEL, EXPERT_HIDDEN), D_MODEL ** -0.5),
        'w_e_down': nrm((DEPTH, N_EXPERTS, EXPERT_HIDDEN, D_MODEL), EXPERT_HIDDEN ** -0.5),
    }


def reference(x, mix_norm_even, w_in, conv_w, conv_b, conv_ln_g, conv_ln_b, q_norm, k_norm,
              w_out, mix_norm_odd, ssm_lam_re, ssm_lam_im, ssm_log_dt, ssm_b_re, ssm_b_im,
              ssm_c_re, ssm_c_im, ssm_d, w_glu, ffn_norm, w_router, b_router,
              w_e_gate, w_e_up, w_e_down):
    for layer in range(DEPTH):
        i = layer // 2
        if layer % 2 == 0:
            x = x + even_mixer(rmsnorm(x, mix_norm_even[i]), w_in[i], conv_w[i], conv_b[i],
                               conv_ln_g[i], conv_ln_b[i], q_norm[i], k_norm[i], w_out[i])
        else:
            x = x + s5_mixer(rmsnorm(x, mix_norm_odd[i]), ssm_lam_re[i], ssm_lam_im[i],
                             ssm_log_dt[i], ssm_b_re[i], ssm_b_im[i], ssm_c_re[i], ssm_c_im[i],
                             ssm_d[i], w_glu[i])
        x = x + expert_choice_ffn(rmsnorm(x, ffn_norm[layer]), w_router[layer], b_router[layer],
                                  w_e_gate[layer], w_e_up[layer], w_e_down[layer])
    return x
```

```cpp
#include <hip/hip_runtime.h>
#include <cstdint>
#include <cstdio>

constexpr int NB = 4, S = 4096, D = 1024, T = NB * S;
constexpr int CONV_CH = 512, CONV_W = 31, NH = 8, HD = 64, ATTW = 512, INC = 2560;
constexpr int SG = 64, SC = 16, SP = 64;
constexpr int NE = 16, CAP = 512, EH = 1024;
constexpr float EPS = 1e-6f;

__device__ __forceinline__ float wave_sum(float v) {
#pragma unroll
    for (int o = 1; o < 64; o <<= 1) v += __shfl_xor(v, o);
    return v;
}
__device__ __forceinline__ float sigmoidf_(float x) { return 1.f / (1.f + __expf(-x)); }
__device__ __forceinline__ float siluf_(float x) { return x * sigmoidf_(x); }

__global__ void __launch_bounds__(256) k_rmsnorm(const float* __restrict__ x, const float* __restrict__ g, float* __restrict__ out, int rows) {
    const int wave = (blockIdx.x * blockDim.x + threadIdx.x) >> 6, lane = threadIdx.x & 63;
    if (wave >= rows) return;
    const float4* xr = (const float4*)(x + (size_t)wave * D);
    float4 v[4]; float s = 0.f;
#pragma unroll
    for (int j = 0; j < 4; ++j) { v[j] = xr[lane + 64 * j]; s += v[j].x * v[j].x + v[j].y * v[j].y + v[j].z * v[j].z + v[j].w * v[j].w; }
    s = wave_sum(s);
    const float r = rsqrtf(s * (1.f / D) + EPS);
    float4* o = (float4*)(out + (size_t)wave * D);
    const float4* gg = (const float4*)g;
#pragma unroll
    for (int j = 0; j < 4; ++j) { float4 w = gg[lane + 64 * j]; float4 y; y.x = v[j].x * r * w.x; y.y = v[j].y * r * w.y; y.z = v[j].z * r * w.z; y.w = v[j].w * r * w.w; o[lane + 64 * j] = y; }
}

struct GP {
    const float* A; int lda; const int* arow;
    const float* B; int ldb; long bstride; int rows_per_b, nb;
    float* C; int ldc; const float* R; const int* orow; const float* rscale; const float* AUX;
    int M, N, K;
};
template <int EPI>
__global__ void __launch_bounds__(256) k_gemm(GP p) {
    __shared__ float As[16][68];
    __shared__ float Bs[16][68];
    const int tid = threadIdx.x, tx = tid & 15, ty = tid >> 4;
    const int m0 = blockIdx.y * 64, n0 = blockIdx.x * 64;
    const float* Bm = p.B + (size_t)((m0 / p.rows_per_b) % p.nb) * p.bstride;
    float acc[4][4];
#pragma unroll
    for (int i = 0; i < 4; ++i)
#pragma unroll
        for (int j = 0; j < 4; ++j) acc[i][j] = 0.f;
    const int ar = tid >> 2, ak = (tid & 3) * 4;
    const int arow_g = p.arow ? p.arow[m0 + ar] : (m0 + ar);
    const float* Ap = p.A + (size_t)arow_g * p.lda + ak;
    const int bk = tid >> 4, bn = (tid & 15) * 4;
    const float* Bp = Bm + (size_t)bk * p.ldb + n0 + bn;
    for (int k0 = 0; k0 < p.K; k0 += 16) {
        const float4 a = *(const float4*)(Ap + k0);
        const float4 b = *(const float4*)(Bp + (size_t)k0 * p.ldb);
        As[ak + 0][ar] = a.x; As[ak + 1][ar] = a.y; As[ak + 2][ar] = a.z; As[ak + 3][ar] = a.w;
        *(float4*)&Bs[bk][bn] = b;
        __syncthreads();
#pragma unroll
        for (int kk = 0; kk < 16; ++kk) {
            const float4 av = *(const float4*)&As[kk][ty * 4];
            const float4 bv = *(const float4*)&Bs[kk][tx * 4];
            const float aa[4] = {av.x, av.y, av.z, av.w}, bb[4] = {bv.x, bv.y, bv.z, bv.w};
#pragma unroll
            for (int i = 0; i < 4; ++i)
#pragma unroll
                for (int j = 0; j < 4; ++j) acc[i][j] += aa[i] * bb[j];
        }
        __syncthreads();
    }
#pragma unroll
    for (int i = 0; i < 4; ++i) {
        const int m = m0 + ty * 4 + i;
#pragma unroll
        for (int j = 0; j < 4; ++j) {
            const int n = n0 + tx * 4 + j; const float v = acc[i][j];
            if (EPI == 0) p.C[(size_t)m * p.ldc + n] = v;
            else if (EPI == 1) p.C[(size_t)m * p.ldc + n] = p.R[(size_t)m * p.ldc + n] + v;
            else if (EPI == 2) { float* c = p.C + (size_t)m * p.ldc + n; *c = siluf_(*c) * v; }
            else if (EPI == 3) atomicAdd(p.C + (size_t)p.orow[m] * p.ldc + n, v * p.rscale[m]);
            else if (EPI == 4) { float* c = p.C + (size_t)m * p.ldc + n; *c = *c + p.AUX[(size_t)m * p.ldc + n] * sigmoidf_(v); }
        }
    }
}

__global__ void __launch_bounds__(256) k_qknorm(float* __restrict__ proj, const float* __restrict__ qg, const float* __restrict__ kg) {
    const int wave = (blockIdx.x * blockDim.x + threadIdx.x) >> 6, lane = threadIdx.x & 63;
    if (wave >= T * 16) return;
    const int t = wave >> 4, w = (wave >> 3) & 1, h = wave & 7;
    float* p = proj + (size_t)t * INC + 1024 + w * 512 + h * 64 + lane;
    const float v = *p; const float s = wave_sum(v * v);
    *p = v * rsqrtf(s * (1.f / 64.f) + EPS) * (w ? kg[lane] : qg[lane]);
}

__global__ void __launch_bounds__(256) k_conv(const float* __restrict__ proj, const float* __restrict__ cw, const float* __restrict__ cb,
                                               const float* __restrict__ lg, const float* __restrict__ lb, float* __restrict__ mixed) {
    __shared__ float red[8];
    const int tok = blockIdx.x, b = tok / S, s = tok % S, tid = threadIdx.x;
    float v[2];
#pragma unroll
    for (int i = 0; i < 2; ++i) {
        const int c = tid + 256 * i; float acc = cb[c];
        for (int j = 0; j < CONV_W; ++j) {
            const int ss = s + j - CONV_W / 2;
            if (ss >= 0 && ss < S) { const float* pr = proj + (size_t)(b * S + ss) * INC; acc += cw[j * CONV_CH + c] * (pr[c] * sigmoidf_(pr[CONV_CH + c])); }
        }
        v[i] = acc;
    }
    float sum = wave_sum(v[0] + v[1]);
    if ((tid & 63) == 0) red[tid >> 6] = sum;
    __syncthreads();
    const float mu = (red[0] + red[1] + red[2] + red[3]) * (1.f / CONV_CH);
    const float d0 = v[0] - mu, d1 = v[1] - mu;
    float sq = wave_sum(d0 * d0 + d1 * d1);
    if ((tid & 63) == 0) red[4 + (tid >> 6)] = sq;
    __syncthreads();
    const float var = (red[4] + red[5] + red[6] + red[7]) * (1.f / CONV_CH);
    const float rs = rsqrtf(var + EPS);
#pragma unroll
    for (int i = 0; i < 2; ++i) { const int c = tid + 256 * i; const float y = (v[i] - mu) * rs * lg[c] + lb[c]; mixed[(size_t)tok * D + c] = siluf_(y); }
}

__global__ void __launch_bounds__(256) k_attn(const float* __restrict__ proj, float* __restrict__ mixed) {
    const int wave = (blockIdx.x * blockDim.x + threadIdx.x) >> 6, lane = threadIdx.x & 63;
    if (wave >= T * NH) return;
    const int tok = wave >> 3, h = wave & 7, b = tok / S, s = tok % S;
    const float q = proj[(size_t)tok * INC + 1024 + h * 64 + lane];
    const float slope = exp2f(-(float)(h + 1));
    float m = -1e30f, l = 0.f, o = 0.f;
    for (int pi = 0; pi < 3; ++pi) {
        const int d = 1 << (2 * pi);
        for (int j = -64; j <= 64; ++j) {
            const int ss = s + j * d;
            if (ss < 0 || ss >= S) continue;
            const float* pr = proj + (size_t)(b * S + ss) * INC;
            const float kv = pr[1536 + h * 64 + lane];
            const float sc = wave_sum(q * kv) * 0.125f - slope * (float)(d * (j < 0 ? -j : j));
            const float mn = fmaxf(m, sc), al = __expf(m - mn), pp = __expf(sc - mn);
            l = l * al + pp; o = o * al + pp * pr[2048 + h * 64 + lane]; m = mn;
        }
    }
    mixed[(size_t)tok * D + 512 + h * 64 + lane] = o / l;
}

__global__ void __launch_bounds__(256) k_router(const float* __restrict__ xf, const float* __restrict__ wr, const float* __restrict__ br, float* __restrict__ aff) {
    const int wave = (blockIdx.x * blockDim.x + threadIdx.x) >> 6, lane = threadIdx.x & 63;
    if (wave >= T) return;
    float acc[NE];
#pragma unroll
    for (int e = 0; e < NE; ++e) acc[e] = 0.f;
    for (int k = lane; k < D; k += 64) {
        const float xv = xf[(size_t)wave * D + k];
        const float4* w4 = (const float4*)(wr + (size_t)k * NE);
#pragma unroll
        for (int q = 0; q < 4; ++q) { const float4 w = w4[q]; acc[4 * q] += xv * w.x; acc[4 * q + 1] += xv * w.y; acc[4 * q + 2] += xv * w.z; acc[4 * q + 3] += xv * w.w; }
    }
    float mx = -1e30f;
#pragma unroll
    for (int e = 0; e < NE; ++e) { acc[e] = wave_sum(acc[e]) + br[e]; mx = fmaxf(mx, acc[e]); }
    float sum = 0.f;
#pragma unroll
    for (int e = 0; e < NE; ++e) { acc[e] = expf(acc[e] - mx); sum += acc[e]; }
    const int b = wave / S, s = wave % S;
    if (lane < NE) {
        float v = 0.f;
#pragma unroll
        for (int e = 0; e < NE; ++e) if (lane == e) v = acc[e];
        aff[((size_t)b * NE + lane) * S + s] = v / sum;
    }
}

__global__ void __launch_bounds__(256) k_topk(const float* __restrict__ aff, int* __restrict__ idx, float* __restrict__ gate) {
    __shared__ float a[S];
    const int be = blockIdx.x, b = be / NE, tid = threadIdx.x;
    const float* src = aff + (size_t)be * S;
    for (int i = tid; i < S; i += 256) a[i] = src[i];
    __syncthreads();
    for (int i = tid; i < S; i += 256) {
        const float v = a[i]; int rank = 0;
        for (int j = 0; j < S; ++j) { const float w = a[j]; rank += (w > v) || (w == v && j < i); }
        if (rank < CAP) { idx[be * CAP + rank] = b * S + i; gate[be * CAP + rank] = v; }
    }
}

__global__ void __launch_bounds__(64) k_s5(const float* __restrict__ xn, const float* __restrict__ lam_re, const float* __restrict__ lam_im, const float* __restrict__ log_dt,
                                           const float* __restrict__ b_re, const float* __restrict__ b_im, const float* __restrict__ c_re, const float* __restrict__ c_im,
                                           float* __restrict__ yf, float* __restrict__ yb) {
    __shared__ float us[64][16];
    __shared__ float hs[2][64];
    const int id = blockIdx.x, dir = id & 1, g = (id >> 1) & 63, b = id >> 7, lane = threadIdx.x;
    const int pg = (dir * SG + g);
    const float lr = lam_re[pg * SP + lane], li = lam_im[pg * SP + lane], dt = expf(log_dt[pg]);
    const float mag = expf(lr * dt), ang = li * dt;
    const float lbr = mag * cosf(ang), lbi = mag * sinf(ang);
    const float den = lr * lr + li * li, nr = lbr - 1.f;
    const float fr = (nr * lr + lbi * li) / den, fi = (lbi * lr - nr * li) / den;
    float bbr[16], bbi[16];
#pragma unroll
    for (int c = 0; c < 16; ++c) { const float br_ = b_re[((size_t)pg * SP + lane) * SC + c], bi_ = b_im[((size_t)pg * SP + lane) * SC + c]; bbr[c] = fr * br_ - fi * bi_; bbi[c] = fr * bi_ + fi * br_; }
    const int oc = lane & 15, oq = lane >> 4;
    float cr[16], ci[16];
#pragma unroll
    for (int i = 0; i < 16; ++i) { cr[i] = c_re[((size_t)pg * SC + oc) * SP + oq * 16 + i]; ci[i] = c_im[((size_t)pg * SC + oc) * SP + oq * 16 + i]; }
    float hr = 0.f, hi = 0.f;
    float* yout = dir ? yb : yf;
    for (int t0 = 0; t0 < S; t0 += 64) {
        {
            const int tt = dir ? (S - 1 - (t0 + lane)) : (t0 + lane);
            const float4* src = (const float4*)(xn + (size_t)(b * S + tt) * D + g * 16);
#pragma unroll
            for (int q = 0; q < 4; ++q) *(float4*)&us[lane][4 * q] = src[q];
        }
        __syncthreads();
        for (int i = 0; i < 64; ++i) {
            float bur = 0.f, bui = 0.f;
#pragma unroll
            for (int c = 0; c < 16; ++c) { const float u = us[i][c]; bur += u * bbr[c]; bui += u * bbi[c]; }
            const float nhr = lbr * hr - lbi * hi + bur, nhi = lbr * hi + lbi * hr + bui;
            hr = nhr; hi = nhi;
            hs[0][lane] = hr; hs[1][lane] = hi;
            __syncthreads();
            float acc = 0.f;
#pragma unroll
            for (int k = 0; k < 16; ++k) acc += hs[0][oq * 16 + k] * cr[k] - hs[1][oq * 16 + k] * ci[k];
            acc += __shfl_xor(acc, 16); acc += __shfl_xor(acc, 32);
            const int tt = dir ? (S - 1 - (t0 + i)) : (t0 + i);
            if (lane < 16) yout[(size_t)(b * S + tt) * D + g * 16 + lane] = acc;
            __syncthreads();
        }
    }
}
__global__ void __launch_bounds__(256) k_s5post(const float* __restrict__ yf, const float* __restrict__ yb, const float* __restrict__ xn, const float* __restrict__ dsk, float* __restrict__ z) {
    const size_t i = (size_t)blockIdx.x * blockDim.x + threadIdx.x;
    if (i >= (size_t)T * D) return;
    const float y = yf[i] + yb[i] + dsk[i % D] * xn[i];
    z[i] = 0.5f * y * (1.f + tanhf(0.7978845608028654f * (y + 0.044715f * y * y * y)));
}

extern "C" void kernel_launch(void* const* d_in, const int* in_sizes, int n_in, void* d_out, int out_size, void* d_ws, size_t ws_size, hipStream_t stream) {
    const float* x = (const float*)d_in[0];
    const float* mix_norm_even = (const float*)d_in[1];
    const float* w_in = (const float*)d_in[2];
    const float* conv_w = (const float*)d_in[3];
    const float* conv_b = (const float*)d_in[4];
    const float* conv_ln_g = (const float*)d_in[5];
    const float* conv_ln_b = (const float*)d_in[6];
    const float* q_norm = (const float*)d_in[7];
    const float* k_norm = (const float*)d_in[8];
    const float* w_out = (const float*)d_in[9];
    const float* mix_norm_odd = (const float*)d_in[10];
    const float* lam_re = (const float*)d_in[11];
    const float* lam_im = (const float*)d_in[12];
    const float* log_dt = (const float*)d_in[13];
    const float* b_re = (const float*)d_in[14];
    const float* b_im = (const float*)d_in[15];
    const float* c_re = (const float*)d_in[16];
    const float* c_im = (const float*)d_in[17];
    const float* ssm_d = (const float*)d_in[18];
    const float* w_glu = (const float*)d_in[19];
    const float* ffn_norm = (const float*)d_in[20];
    const float* w_router = (const float*)d_in[21];
    const float* b_router = (const float*)d_in[22];
    const float* w_e_gate = (const float*)d_in[23];
    const float* w_e_up = (const float*)d_in[24];
    const float* w_e_down = (const float*)d_in[25];
    float* X = (float*)d_out;
    float* ws = (float*)d_ws;
    const size_t TD = (size_t)T * D;
    float* XN = ws;
    float* PROJ = XN + TD;
    float* MIXED = PROJ + (size_t)T * INC;
    float* AFF = MIXED + TD;
    float* GATE = AFF + (size_t)NB * NE * S;
    int* IDX = (int*)(GATE + (size_t)NB * NE * CAP);
    float* HB = (float*)(IDX + (size_t)NB * NE * CAP);
    float* YF = PROJ;
    float* YB = PROJ + TD;
    float* Z = MIXED;
    float* VAL = HB;
    if ((size_t)((char*)(HB + (size_t)NB * NE * CAP * EH) - (char*)d_ws) > ws_size) { fprintf(stderr, "ws too small\n"); return; }

    const int rows_blocks = T / 4;
    auto moe = [&](int layer) {
        k_rmsnorm<<<rows_blocks, 256, 0, stream>>>(X, ffn_norm + (size_t)layer * D, XN, T);
        k_router<<<rows_blocks, 256, 0, stream>>>(XN, w_router + (size_t)layer * D * NE, b_router + layer * NE, AFF);
        k_topk<<<NB * NE, 256, 0, stream>>>(AFF, IDX, GATE);
        const int MR = NB * NE * CAP;
        GP g{}; g.A = XN; g.lda = D; g.arow = IDX; g.B = w_e_gate + (size_t)layer * NE * D * EH; g.ldb = EH; g.bstride = (long)D * EH; g.rows_per_b = CAP; g.nb = NE;
        g.C = HB; g.ldc = EH; g.M = MR; g.N = EH; g.K = D;
        k_gemm<0><<<dim3(EH / 64, MR / 64), 256, 0, stream>>>(g);
        g.B = w_e_up + (size_t)layer * NE * D * EH;
        k_gemm<2><<<dim3(EH / 64, MR / 64), 256, 0, stream>>>(g);
        GP d{}; d.A = HB; d.lda = EH; d.arow = nullptr; d.B = w_e_down + (size_t)layer * NE * EH * D; d.ldb = D; d.bstride = (long)EH * D; d.rows_per_b = CAP; d.nb = NE;
        d.C = X; d.ldc = D; d.orow = IDX; d.rscale = GATE; d.M = MR; d.N = D; d.K = EH;
        k_gemm<3><<<dim3(D / 64, MR / 64), 256, 0, stream>>>(d);
    };

    k_rmsnorm<<<rows_blocks, 256, 0, stream>>>(x, mix_norm_even, XN, T);
    { GP g{}; g.A = XN; g.lda = D; g.B = w_in; g.ldb = INC; g.bstride = 0; g.rows_per_b = T; g.nb = 1; g.C = PROJ; g.ldc = INC; g.M = T; g.N = INC; g.K = D;
      k_gemm<0><<<dim3(INC / 64, T / 64), 256, 0, stream>>>(g); }
    k_qknorm<<<T * 16 / 4, 256, 0, stream>>>(PROJ, q_norm, k_norm);
    k_conv<<<T, 256, 0, stream>>>(PROJ, conv_w, conv_b, conv_ln_g, conv_ln_b, MIXED);
    k_attn<<<T * NH / 4, 256, 0, stream>>>(PROJ, MIXED);
    { GP g{}; g.A = MIXED; g.lda = D; g.B = w_out; g.ldb = D; g.bstride = 0; g.rows_per_b = T; g.nb = 1; g.C = X; g.ldc = D; g.R = x; g.M = T; g.N = D; g.K = D;
      k_gemm<1><<<dim3(D / 64, T / 64), 256, 0, stream>>>(g); }
    moe(0);
    k_rmsnorm<<<rows_blocks, 256, 0, stream>>>(X, mix_norm_odd, XN, T);
    k_s5<<<NB * SG * 2, 64, 0, stream>>>(XN, lam_re, lam_im, log_dt, b_re, b_im, c_re, c_im, YF, YB);
    k_s5post<<<(unsigned)((TD + 255) / 256), 256, 0, stream>>>(YF, YB, XN, ssm_d, Z);
    { GP g{}; g.A = Z; g.lda = D; g.B = w_glu; g.ldb = 2 * D; g.bstride = 0; g.rows_per_b = T; g.nb = 1; g.C = VAL; g.ldc = D; g.M = T; g.N = D; g.K = D;
      k_gemm<0><<<dim3(D / 64, T / 64), 256, 0, stream>>>(g);
      g.B = w_glu + D; g.C = X; g.AUX = VAL;
      k_gemm<4><<<dim3(D / 64, T / 64), 256, 0, stream>>>(g); }
    moe(1);
}
```

```cpp
#include <hip/hip_runtime.h>
#include <cstdint>
#include <cstdio>

namespace pg8 {
#define PG8_LAS __attribute__((address_space(3)))
typedef unsigned short bf16_t;
typedef short bf16x8 __attribute__((ext_vector_type(8)));
typedef float f32x4 __attribute__((ext_vector_type(4)));
typedef unsigned u32x4 __attribute__((ext_vector_type(4)));
constexpr int BM = 256, BK = 64, HALF = 128, HTB = HALF * BK * 2  , STAGE_BYTES = 8 * HTB, NXCD = 8, WGM = 8;

__host__ __device__ __forceinline__ int lds_byte(int r, int c) { const int st = (r >> 4) * 2 + (c >> 5), rr = r & 15, cc = c & 31, ob = rr * 64 + cc * 2; return st * 1024 + (ob ^ (((ob >> 9) & 1) << 5)); }
__host__ __device__ __forceinline__ void stage_rc(int b, int& R, int& C) { const int st = b / 1024, sb = b % 1024, swz = sb ^ (((sb >> 9) & 1) << 5); R = (st >> 1) * 16 + swz / 64; C = (st & 1) * 32 + (swz % 64) / 2; }
__host__ __device__ __forceinline__ int perm32(int rho) { const int n = rho >> 4, i = rho & 15; return 8 * (i >> 2) + 4 * n + (i & 3); }

struct Unit { int pm, pn, pb; };
struct Gemm { const bf16_t* A; const bf16_t* Bt; int K; };

struct DenseOrder {
    int nM, nN, nwg, G, c;
    __device__ void init(int M, int N, int G_, int c_) { nM = M / BM; nN = N / BM; nwg = nM * nN; G = G_; c = c_; }
    __device__ bool next(int i, Unit& u) const {
        const long L = (long)i * G + c; if (L >= nwg) return false;
        int wgid = (int)L; { const int q = nwg / NXCD, r = nwg % NXCD, xcd = wgid % NXCD, off = wgid / NXCD; wgid = (xcd < r ? xcd * (q + 1) : r * (q + 1) + (xcd - r) * q) + off; }
        const int nig = WGM * nN, gid = wgid / nig, fm = gid * WGM, gsz = (nM - fm) < WGM ? (nM - fm) : WGM;
        u.pm = fm + ((wgid % nig) % gsz); u.pn = (wgid % nig) / gsz; u.pb = u.pn; return true;
    }
    __device__ __forceinline__ void a_ready(const Unit&) const {}
    __device__ __forceinline__ void done(const Unit&) const {}
};
struct ExpertOrder {
    int nN, nun, G, c;
    __device__ void init(int nN_, int G_, int c_) { nN = nN_; nun = 128 * nN_; G = G_; c = c_; }
    __device__ bool next(int i, Unit& u) const {
        const long L = (long)i * G + c; if (L >= nun) return false;
        int V = (int)L;
        if (G == 256) V = i * 256 + (c & 7) * 32 + (c >> 3);
        const int per = 8 * nN, e = V / per, r = V % per, pml = r / nN, pn = r % nN;
        u.pm = ((pml >> 1) * 16 + e) * 2 + (pml & 1); u.pn = pn; u.pb = e * nN + pn; return true;
    }
    __device__ __forceinline__ void a_ready(const Unit&) const {}
    __device__ __forceinline__ void done(const Unit&) const {}
};

typedef float f32x2 __attribute__((ext_vector_type(2)));
typedef __bf16 bf16x2_t __attribute__((ext_vector_type(2)));
__device__ __forceinline__ unsigned pk2(float lo, float hi) { f32x2 v = {lo, hi}; bf16x2_t b = __builtin_convertvector(v, bf16x2_t); return __builtin_bit_cast(unsigned, b); }
__device__ __forceinline__ float sigm(float x) { return __builtin_amdgcn_rcpf(1.f + __builtin_amdgcn_exp2f(-1.4426950408889634f * x)); }

constexpr float QSCALE = 0.125f * 1.4426950408889634f;
struct EpiProj {
    static constexpr bool PERM = true, AFTER_DRAIN = false;
    bf16_t *GLU, *Q; const float *qg, *kg;
    __device__ __forceinline__ void operator()(const f32x4 (&acc)[2][2][4][2], const Unit& u, int wr, int wc, int fr, int fq) const {
        const int row0 = u.pm * BM + wr * 64 + fr;
        if (u.pn < 4) {
            const int col0 = 128 * u.pn + 32 * wc + 8 * fq;
#pragma unroll
            for (int ai = 0; ai < 2; ++ai)
#pragma unroll
                for (int m = 0; m < 4; ++m) {
                    const f32x4 v0 = acc[ai][0][m][0], v1 = acc[ai][0][m][1], g0 = acc[ai][1][m][0], g1 = acc[ai][1][m][1];
                    u32x4 w; w.x = pk2(v0[0] * sigm(g0[0]), v0[1] * sigm(g0[1])); w.y = pk2(v0[2] * sigm(g0[2]), v0[3] * sigm(g0[3]));
                    w.z = pk2(v1[0] * sigm(g1[0]), v1[1] * sigm(g1[1])); w.w = pk2(v1[2] * sigm(g1[2]), v1[3] * sigm(g1[3]));
                    *(u32x4*)(GLU + (size_t)(row0 + ai * HALF + m * 16) * 512 + col0) = w;
                    asm volatile("" ::: "memory");
                }
        } else {
            const int t = (u.pn - 4) >> 1;
            const int colb = 256 * ((u.pn - 4) & 1) + 64 * wc + 8 * fq;
            bf16_t* dst = Q + (size_t)t * (size_t)(8u << 20);
            const float* gp = (const float*)((uintptr_t)qg + (((uintptr_t)kg - (uintptr_t)qg) & (uintptr_t)(t == 0 ? 0 : ~(uintptr_t)0)));
#pragma unroll
            for (int ai = 0; ai < 2; ++ai)
#pragma unroll
                for (int m = 0; m < 4; ++m) {
                    float ss = 0.f;
#pragma unroll
                    for (int bj = 0; bj < 2; ++bj)
#pragma unroll
                        for (int n = 0; n < 2; ++n) { const f32x4 x = acc[ai][bj][m][n]; ss += (x[0] * x[0] + x[1] * x[1]) + (x[2] * x[2] + x[3] * x[3]); }
                    ss += __shfl_xor(ss, 16); ss += __shfl_xor(ss, 32);
                    float rs = 1.f;
                    if (t < 2) rs = rsqrtf(ss * (1.f / 64.f) + 1e-6f) * (t == 0 ? QSCALE : 1.f);
#pragma unroll
                    for (int bj = 0; bj < 2; ++bj) {
                        f32x4 g0 = {1.f, 1.f, 1.f, 1.f}, g1 = g0;
                        if (t < 2) { g0 = *(const f32x4*)(gp + 32 * bj + 8 * fq); g1 = *(const f32x4*)(gp + 32 * bj + 8 * fq + 4); }
                        const f32x4 a = acc[ai][bj][m][0] * g0 * rs, b = acc[ai][bj][m][1] * g1 * rs;
                        u32x4 w; w.x = pk2(a[0], a[1]); w.y = pk2(a[2], a[3]); w.z = pk2(b[0], b[1]); w.w = pk2(b[2], b[3]);
                        *(u32x4*)(dst + (size_t)(row0 + ai * HALF + m * 16) * 512 + colb + 32 * bj) = w;
                    }
                    asm volatile("" ::: "memory");
                }
        }
    }
};
struct EpiRes {
    static constexpr bool PERM = false, AFTER_DRAIN = false;
    const float* xin; float* X;
    __device__ __forceinline__ void operator()(const f32x4 (&acc)[2][2][4][2], const Unit& u, int wr, int wc, int fr, int fq) const {
        const int row0 = u.pm * BM + wr * 64 + fr, col0 = u.pn * BM + wc * 32 + 4 * fq;
#pragma unroll
        for (int ai = 0; ai < 2; ++ai)
#pragma unroll
            for (int m = 0; m < 4; ++m) { const size_t off = (size_t)(row0 + ai * HALF + m * 16) * 1024 + col0;
#pragma unroll
                for (int bj = 0; bj < 2; ++bj)
#pragma unroll
                    for (int n = 0; n < 2; ++n) { const f32x4 r = *(const f32x4*)(xin + off + bj * HALF + n * 16); *(f32x4*)(X + off + bj * HALF + n * 16) = r + acc[ai][bj][m][n]; } }
    }
};
struct EpiSwiGLU {
    static constexpr bool PERM = true, AFTER_DRAIN = false;
    bf16_t* H;
    __device__ __forceinline__ void operator()(const f32x4 (&acc)[2][2][4][2], const Unit& u, int wr, int wc, int fr, int fq) const {
        const int row0 = u.pm * BM + wr * 64 + fr, col0 = 128 * u.pn + 32 * wc + 8 * fq;
#pragma unroll
        for (int ai = 0; ai < 2; ++ai)
#pragma unroll
            for (int m = 0; m < 4; ++m) {
                const f32x4 g0 = acc[ai][0][m][0], g1 = acc[ai][0][m][1], u0 = acc[ai][1][m][0], u1 = acc[ai][1][m][1];
                u32x4 w; w.x = pk2(g0[0] * sigm(g0[0]) * u0[0], g0[1] * sigm(g0[1]) * u0[1]); w.y = pk2(g0[2] * sigm(g0[2]) * u0[2], g0[3] * sigm(g0[3]) * u0[3]);
                w.z = pk2(g1[0] * sigm(g1[0]) * u1[0], g1[1] * sigm(g1[1]) * u1[1]); w.w = pk2(g1[2] * sigm(g1[2]) * u1[2], g1[3] * sigm(g1[3]) * u1[3]);
                *(u32x4*)(H + (size_t)(row0 + ai * HALF + m * 16) * 1024 + col0) = w;
            }
    }
};
struct EpiDown {
    static constexpr bool PERM = true, AFTER_DRAIN = false;
    bf16_t* Y; const float* gate;
    __device__ __forceinline__ void operator()(const f32x4 (&acc)[2][2][4][2], const Unit& u, int wr, int wc, int fr, int fq) const {
        const int row0 = u.pm * BM + wr * 64 + fr, col0 = u.pn * BM + wc * 32 + 8 * fq;
#pragma unroll
        for (int ai = 0; ai < 2; ++ai)
#pragma unroll
            for (int m = 0; m < 4; ++m) { const int row = row0 + ai * HALF + m * 16; const float gs = gate[row];
#pragma unroll
                for (int bj = 0; bj < 2; ++bj) { const f32x4 a = acc[ai][bj][m][0] * gs, b = acc[ai][bj][m][1] * gs;
                    u32x4 w; w.x = pk2(a[0], a[1]); w.y = pk2(a[2], a[3]); w.z = pk2(b[0], b[1]); w.w = pk2(b[2], b[3]);
                    *(u32x4*)(Y + (size_t)row * 1024 + col0 + bj * HALF) = w; } }
    }
};
struct EpiGluRes {
    static constexpr bool PERM = false, AFTER_DRAIN = false;
    float* X;
    __device__ __forceinline__ void operator()(const f32x4 (&acc)[2][2][4][2], const Unit& u, int wr, int wc, int fr, int fq) const {
        const int row0 = u.pm * BM + wr * 64 + fr, col0 = 128 * u.pn + 32 * wc + 4 * fq;
#pragma unroll
        for (int ai = 0; ai < 2; ++ai)
#pragma unroll
            for (int m = 0; m < 4; ++m) { float* p = X + (size_t)(row0 + ai * HALF + m * 16) * 1024 + col0;
#pragma unroll
                for (int n = 0; n < 2; ++n) { const f32x4 v = acc[ai][0][m][n], g = acc[ai][1][m][n]; f32x4 r = *(const f32x4*)(p + n * 16);
                    r[0] += v[0] * sigm(g[0]); r[1] += v[1] * sigm(g[1]); r[2] += v[2] * sigm(g[2]); r[3] += v[3] * sigm(g[3]); *(f32x4*)(p + n * 16) = r; } }
    }
};

template <class Epi, class Sched, bool ALIGN_EPI = false, bool SP2 = false>
__device__ __forceinline__ void gemm_phase(PG8_LAS unsigned char* lds, const Gemm g, const Sched& S, const Epi& E) {
    const int tid = threadIdx.x, wid = __builtin_amdgcn_readfirstlane(tid >> 6), lane = tid & 63, wr = wid >> 2, wc = wid & 3, fr = lane & 15, fq = lane >> 4;
    const int K = g.K, nt = K / BK;
    unsigned voffA[2], voffB[2];
#pragma unroll
    for (int i = 0; i < 2; ++i) { int R, C; stage_rc(tid * 16 + i * 8192, R, C); const int Rb = Epi::PERM ? ((R & ~31) + perm32(R & 31)) : R;
        voffA[i] = (unsigned)(R * K + C) * 2u; voffB[i] = (unsigned)(Rb * K + C) * 2u; }
    const size_t kstep = (size_t)(BK * 2);
    const size_t hstep = (size_t)HALF * K * 2;
    const size_t tstep = 2 * hstep;
    const unsigned ldsw = (unsigned)wid * 1024u;
    const int aoff = lds_byte(wr * 64 + fr, fq * 8), boff = lds_byte(wc * 32 + fr, fq * 8);
#define PG8_SA(b, h) (((b) * 2 + (h)) * HTB)
#define PG8_SB(b, h) ((4 + (b) * 2 + (h)) * HTB)
#define PG8_STAGE(bufoff, gbase, voff) do { _Pragma("unroll") for (int _i = 0; _i < 2; ++_i) \
        __builtin_amdgcn_global_load_lds((const unsigned*)((const char*)(gbase) + (voff)[_i]), (PG8_LAS unsigned*)(lds + (bufoff) + ldsw + _i * 8192), 16, 0, 0); } while (0)
#define PG8_LDA(dst, b, h) do { _Pragma("unroll") for (int m = 0; m < 4; ++m) _Pragma("unroll") for (int k = 0; k < 2; ++k) dst[m][k] = *(const PG8_LAS bf16x8*)(lds + PG8_SA(b, h) + aoff + m * 2048 + k * 1024); } while (0)
#define PG8_LDB(dst, b, h) do { _Pragma("unroll") for (int n = 0; n < 2; ++n) _Pragma("unroll") for (int k = 0; k < 2; ++k) dst[n][k] = *(const PG8_LAS bf16x8*)(lds + PG8_SB(b, h) + boff + n * 2048 + k * 1024); } while (0)
#define PG8_MMA(ai, bj, At, Bt) do { __builtin_amdgcn_s_setprio(1); _Pragma("unroll") for (int m = 0; m < 4; ++m) _Pragma("unroll") for (int n = 0; n < 2; ++n) _Pragma("unroll") for (int k = 0; k < 2; ++k) \
        acc[ai][bj][m][n] = __builtin_amdgcn_mfma_f32_16x16x32_bf16(Bt[n][k], At[m][k], acc[ai][bj][m][n], 0, 0, 0); __builtin_amdgcn_s_setprio(0); } while (0)
#define PG8_WAIT_V(n) asm volatile("s_waitcnt vmcnt(" #n ")" ::: "memory")
#define PG8_WAIT_L(n) asm volatile("s_waitcnt lgkmcnt(" #n ")" ::: "memory")
#define PG8_BAR __builtin_amdgcn_s_barrier()
#define PG8_SCHED __builtin_amdgcn_sched_barrier(0)
    Unit cur, nxt; int ui = 0;
    if (!S.next(0, cur)) return;
    f32x4 acc[2][2][4][2];
#pragma unroll
    for (int a = 0; a < 2; ++a)
#pragma unroll
        for (int b = 0; b < 2; ++b)
#pragma unroll
            for (int m = 0; m < 4; ++m)
#pragma unroll
                for (int n = 0; n < 2; ++n) acc[a][b][m][n] = (f32x4){0.f, 0.f, 0.f, 0.f};
    bf16x8 At[4][2], B0[2][2], B1[2][2];
    const char* cA = (const char*)g.A + (size_t)cur.pm * tstep; const char* cB = (const char*)g.Bt + (size_t)cur.pb * tstep;
    S.a_ready(cur);
    if constexpr (SP2) {
        PG8_STAGE(PG8_SB(0, 0), cB, voffB); PG8_STAGE(PG8_SB(0, 1), cB + hstep, voffB); PG8_STAGE(PG8_SA(0, 0), cA, voffA); PG8_STAGE(PG8_SA(0, 1), cA + hstep, voffA);
        if (wr == 1) PG8_BAR;
        PG8_WAIT_V(2); PG8_BAR;
        PG8_STAGE(PG8_SB(1, 0), cB + kstep, voffB); PG8_STAGE(PG8_SA(1, 0), cA + kstep, voffA); PG8_STAGE(PG8_SB(1, 1), cB + hstep + kstep, voffB);
        PG8_WAIT_V(6); PG8_BAR;
    } else {
        PG8_STAGE(PG8_SB(0, 0), cB, voffB); PG8_STAGE(PG8_SA(0, 0), cA, voffA); PG8_STAGE(PG8_SB(0, 1), cB + hstep, voffB); PG8_STAGE(PG8_SA(0, 1), cA + hstep, voffA);
        if (wr == 1) PG8_BAR;
        PG8_WAIT_V(4); PG8_BAR;
        PG8_STAGE(PG8_SB(1, 0), cB + kstep, voffB); PG8_STAGE(PG8_SA(1, 0), cA + kstep, voffA); PG8_STAGE(PG8_SB(1, 1), cB + hstep + kstep, voffB);
        PG8_WAIT_V(6); PG8_BAR;
    }
    for (;;) {
        const bool has_next = S.next(ui + 1, nxt);
        const char* nA = has_next ? (const char*)g.A + (size_t)nxt.pm * tstep : cA; const char* nB = has_next ? (const char*)g.Bt + (size_t)nxt.pb * tstep : cB;
        for (int t = 0; t < nt; t += 2) {
            const bool last = (t == nt - 2);
            const char* a1 = cA + (size_t)(t + 1) * kstep;
            const char* a2 = last ? nA : cA + (size_t)(t + 2) * kstep; const char* b2 = last ? nB : cB + (size_t)(t + 2) * kstep;
            const char* a3 = a2 + kstep; const char* b3 = b2 + kstep;
            if (last && has_next) S.a_ready(nxt);
            if constexpr (SP2) {
            PG8_LDB(B0, 0, 0); PG8_LDB(B1, 0, 1); PG8_SCHED; PG8_LDA(At, 0, 0); PG8_STAGE(PG8_SA(1, 1), a1 + hstep, voffA);
            PG8_WAIT_V(8); PG8_WAIT_L(0); PG8_BAR; PG8_MMA(0, 0, At, B0); PG8_MMA(0, 1, At, B1); PG8_BAR; PG8_SCHED;
            PG8_LDA(At, 0, 1); PG8_STAGE(PG8_SB(0, 0), b2, voffB); PG8_STAGE(PG8_SB(0, 1), b2 + hstep, voffB); PG8_STAGE(PG8_SA(0, 0), a2, voffA);
            PG8_WAIT_V(8); PG8_WAIT_L(0); PG8_BAR; PG8_MMA(1, 0, At, B0); PG8_MMA(1, 1, At, B1); PG8_BAR; PG8_SCHED;
            PG8_LDB(B0, 1, 0); PG8_LDB(B1, 1, 1); PG8_SCHED; PG8_LDA(At, 1, 0); PG8_STAGE(PG8_SA(0, 1), a2 + hstep, voffA);
            PG8_WAIT_V(8); PG8_WAIT_L(0); PG8_BAR; PG8_MMA(0, 0, At, B0); PG8_MMA(0, 1, At, B1); PG8_BAR; PG8_SCHED;
            PG8_LDA(At, 1, 1); PG8_STAGE(PG8_SB(1, 0), b3, voffB); PG8_STAGE(PG8_SB(1, 1), b3 + hstep, voffB); PG8_STAGE(PG8_SA(1, 0), a3, voffA);
            PG8_WAIT_V(8); PG8_WAIT_L(0); PG8_BAR; PG8_MMA(1, 0, At, B0); PG8_MMA(1, 1, At, B1); PG8_BAR; PG8_SCHED;
            } else {
            PG8_LDB(B0, 0, 0); PG8_SCHED; PG8_LDA(At, 0, 0); PG8_STAGE(PG8_SA(1, 1), a1 + hstep, voffA);
            PG8_WAIT_L(8); PG8_BAR; PG8_WAIT_L(0); PG8_MMA(0, 0, At, B0); PG8_BAR; PG8_SCHED;
            PG8_LDB(B1, 0, 1); PG8_STAGE(PG8_SB(0, 0), b2, voffB);
            PG8_BAR; PG8_WAIT_L(0); PG8_MMA(0, 1, At, B1); PG8_BAR;
            PG8_LDA(At, 0, 1); PG8_STAGE(PG8_SA(0, 0), a2, voffA);
            PG8_BAR; PG8_WAIT_L(0); PG8_MMA(1, 0, At, B0); PG8_BAR; PG8_SCHED;
            PG8_STAGE(PG8_SB(0, 1), b2 + hstep, voffB);
            PG8_WAIT_V(6); PG8_BAR; PG8_MMA(1, 1, At, B1); PG8_BAR;
            PG8_LDB(B0, 1, 0); PG8_SCHED; PG8_LDA(At, 1, 0); PG8_STAGE(PG8_SA(0, 1), a2 + hstep, voffA);
            PG8_WAIT_L(8); PG8_BAR; PG8_WAIT_L(0); PG8_MMA(0, 0, At, B0); PG8_BAR; PG8_SCHED;
            PG8_LDB(B1, 1, 1); PG8_STAGE(PG8_SB(1, 0), b3, voffB);
            PG8_BAR; PG8_WAIT_L(0); PG8_MMA(0, 1, At, B1); PG8_BAR;
            PG8_LDA(At, 1, 1); PG8_STAGE(PG8_SA(1, 0), a3, voffA);
            PG8_BAR; PG8_WAIT_L(0); PG8_MMA(1, 0, At, B0); PG8_BAR; PG8_SCHED;
            PG8_STAGE(PG8_SB(1, 1), b3 + hstep, voffB);
            PG8_WAIT_V(6); PG8_BAR; PG8_MMA(1, 1, At, B1); PG8_BAR;
            }
        }
        if constexpr (ALIGN_EPI) { if (wr == 0) PG8_BAR; }
        if constexpr (!Epi::AFTER_DRAIN) { E(acc, cur, wr, wc, fr, fq); S.done(cur); }
        if (!has_next) break;
#pragma unroll
        for (int a = 0; a < 2; ++a)
#pragma unroll
            for (int b = 0; b < 2; ++b)
#pragma unroll
                for (int m = 0; m < 4; ++m)
#pragma unroll
                    for (int n = 0; n < 2; ++n) acc[a][b][m][n] = (f32x4){0.f, 0.f, 0.f, 0.f};
        cur = nxt; cA = nA; cB = nB; ++ui;
        if constexpr (ALIGN_EPI) { if (wr == 1) PG8_BAR; }
    }
    PG8_WAIT_V(0);
    if constexpr (!ALIGN_EPI) { if (wr == 0) PG8_BAR; }
    PG8_BAR;
    if constexpr (Epi::AFTER_DRAIN) { E.fused(acc, cur, wr, wc, fr, fq, lds, wid, lane); S.done(cur); }
#undef PG8_SA
#undef PG8_SB
#undef PG8_STAGE
#undef PG8_LDA
#undef PG8_LDB
#undef PG8_MMA
#undef PG8_WAIT_V
#undef PG8_WAIT_L
#undef PG8_BAR
#undef PG8_SCHED
}
}

constexpr int NB = 4, S = 4096, D = 1024, T = NB * S;
constexpr int CONV_CH = 512, CONV_W = 31, NH = 8, INC = 2560;
constexpr int SG = 64, SC = 16, SP = 64;
constexpr int NE = 16, CAP = 512, EH = 1024, MR = NB * NE * CAP;
constexpr float EPS = 1e-6f;
constexpr int NWAVES = 8, NTHR = NWAVES * 64;

constexpr size_t MiB = 1u << 20;
constexpr size_t WS_CTL = 0, CTL_ZERO_BYTES = 64 * 1024;
constexpr size_t WS_AFF = 1 * MiB, WS_IDX = 2 * MiB, WS_GATE = 2 * MiB + 512 * 1024, WS_SLOT = 3 * MiB;
constexpr size_t WS_WIN = 4 * MiB, WS_WOUT = 10 * MiB, WS_WGLU = 12 * MiB;
constexpr size_t WS_WEXP = 16 * MiB, WEXP_LAYER = 96 * MiB, WEXP_GU = 0, WEXP_DN = 64 * MiB;
constexpr size_t WS_XN = 208 * MiB, WS_MIXED = 240 * MiB;
constexpr size_t WS_PROJ = 272 * MiB;
constexpr size_t WS_H = 336 * MiB;
constexpr size_t WS_END = 400 * MiB;
constexpr int CW_BAR = 1024;

constexpr int SCRATCH_BYTES = 143360;
constexpr int LDSCTL_OFF = SCRATCH_BYTES;
constexpr int LDS_BYTES = 147456;

#define GAS __attribute__((address_space(1)))
#define LAS __attribute__((address_space(3)))
typedef unsigned short bf16;
typedef unsigned v4u __attribute__((ext_vector_type(4)));
typedef unsigned v2u __attribute__((ext_vector_type(2)));
typedef float f32x4 __attribute__((ext_vector_type(4)));
typedef float f32x2 __attribute__((ext_vector_type(2)));
using pg8::pk2;
using pg8::sigm;
__device__ __forceinline__ float bf2f(unsigned short h) { return __uint_as_float(((unsigned)h) << 16); }
__device__ __forceinline__ float bflo(unsigned w) { return __uint_as_float(w << 16); }
__device__ __forceinline__ float bfhi(unsigned w) { return __uint_as_float(w & 0xffff0000u); }
__device__ __forceinline__ float wave_sum(float v) {
#pragma unroll
    for (int o = 1; o < 64; o <<= 1) v += __shfl_xor(v, o);
    return v;
}

#define XB_TMO      128
#define XB_XCNT(j)  (256  + 64 * (j))
#define XB_XSUB(j)  (1280 + 64 * (j))
#define XB_XGEN(j)  (2304 + 64 * (j))
#define XB_TOP      3328
#define XB_TOPGEN   3392
#define XCD_BAR_WORDS 3456
#define XB_SPIN_CAP (1u << 18)
__device__ __forceinline__ unsigned xb_ld(unsigned* p)              { return __hip_atomic_load(p, __ATOMIC_RELAXED, __HIP_MEMORY_SCOPE_AGENT); }
__device__ __forceinline__ unsigned xb_add(unsigned* p, unsigned v) { return __hip_atomic_fetch_add(p, v, __ATOMIC_RELAXED, __HIP_MEMORY_SCOPE_AGENT); }
__device__ __forceinline__ unsigned xb_xcc_id() { return (unsigned)__builtin_amdgcn_s_getreg((3 << 11) | 20) & 0xFu; }
#define XB_SPIN(cond, bar) do { unsigned _sp = 0; while (cond) { __builtin_amdgcn_s_sleep(1); \
    if ((++_sp & 255u) == 0u) { if (xb_ld(&(bar)[XB_TMO])) break; if (_sp > XB_SPIN_CAP) { atomicAdd(&(bar)[XB_TMO], 1u); break; } } } } while (0)
struct XcdBarrier { unsigned* bar; unsigned x; volatile LAS unsigned* st; };
__device__ __forceinline__ XcdBarrier xcd_barrier_post(unsigned* bar, volatile LAS unsigned* st) {
    XcdBarrier b; b.bar = bar; b.x = xb_xcc_id(); b.st = st;
    if (threadIdx.x == 0) (void)xb_add(&bar[XB_XCNT(b.x)], 1u);
    return b;
}
__device__ __forceinline__ void xcd_barrier_complete(unsigned* bar, unsigned x, unsigned& nloc, unsigned& nx) {
    const unsigned G = gridDim.x * gridDim.y * gridDim.z;
    unsigned sum, cnt, mine, sp = 0u;
    for (;;) {
        sum = 0u; cnt = 0u; mine = 0u;
#pragma unroll
        for (unsigned j = 0; j < 16; ++j) { const unsigned c = xb_ld(&bar[XB_XCNT(j)]); sum += c; cnt += (c > 0u) ? 1u : 0u; mine = (j == x) ? c : mine; }
        if (sum == G) break;
        __builtin_amdgcn_s_sleep(1);
        if ((++sp & 255u) == 0u) { if (xb_ld(&bar[XB_TMO])) break; if (sp > XB_SPIN_CAP) { atomicAdd(&bar[XB_TMO], 1u); break; } }
    }
    nloc = mine > 0u ? mine : 1u; nx = cnt > 0u ? cnt : 1u;
}
__device__ __forceinline__ void xcd_barrier(const XcdBarrier& b) {
    asm volatile("s_waitcnt vmcnt(0)" ::: "memory");
    __syncthreads();
    if (threadIdx.x == 0) {
        unsigned* bar = b.bar;
        __builtin_amdgcn_s_waitcnt(0);
        unsigned nloc = b.st[0], nx = b.st[1];
        if (nloc == 0u) { xcd_barrier_complete(bar, b.x, nloc, nx); b.st[0] = nloc; b.st[1] = nx; }
        const unsigned old = xb_add(&bar[XB_XSUB(b.x)], 1u);
        const unsigned gen = old / nloc;
        if (old + 1u == (gen + 1u) * nloc) {
            __builtin_amdgcn_fence(__ATOMIC_RELEASE, "agent");
            asm volatile("s_waitcnt vmcnt(0)" ::: "memory");
            const unsigned og = xb_add(&bar[XB_TOP], 1u);
            const unsigned tg = og / nx;
            if (og + 1u == (tg + 1u) * nx) xb_add(&bar[XB_TOPGEN], 1u);
            else XB_SPIN(xb_ld(&bar[XB_TOPGEN]) == tg, bar);
            __builtin_amdgcn_fence(__ATOMIC_ACQUIRE, "agent");
            xb_add(&bar[XB_XGEN(b.x)], 1u);
            asm volatile("s_waitcnt vmcnt(0)" ::: "memory");
        } else {
            XB_SPIN(xb_ld(&bar[XB_XGEN(b.x)]) == gen, bar);
            __builtin_amdgcn_fence(__ATOMIC_ACQUIRE, "agent");
            asm volatile("s_waitcnt vmcnt(0)" ::: "memory");
        }
    }
    __syncthreads();
}

struct Args {
    const float* in[26]; float* out; unsigned char* ws; int ph_lo, ph_hi;
};
struct Ctx { LAS unsigned char* lds; int tid, lane, wave, vcu, G; };

__device__ __forceinline__ int rowmap(int kind, int half, int n) {
    if (kind == 0) {
        if (n < 1024) { const int hf = n >> 9, r = n & 511; return 256 * (r >> 7) + 128 * hf + (r & 127); }
        const int pn = n >> 8, w = n & 255, wc = w >> 6, bj = (w >> 5) & 1, j = w & 31; return 256 * pn + 128 * bj + 32 * wc + j;
    }
    if (kind == 2) { const int hf = n >> 10, r = n & 1023; return 256 * (r >> 7) + 128 * hf + (r & 127); }
    if (kind == 3) return 256 * (n >> 7) + 128 * half + (n & 127);
    return n;
}
__device__ __forceinline__ void conv_item(const float* __restrict__ W, int N, bf16* __restrict__ WT, int kind, int half, int kb, int nb, LAS float* scr, int lane) {
    const int k0 = 64 * kb, n0 = 64 * nb;
#pragma unroll 4
    for (int it = 0; it < 16; ++it) {
        const int kk = 4 * it + (lane >> 4), nn = 4 * (lane & 15);
        const f32x4 v = *(const f32x4*)(W + (size_t)(k0 + kk) * N + n0 + nn);
        scr[kk * 65 + nn] = v[0]; scr[kk * 65 + nn + 1] = v[1]; scr[kk * 65 + nn + 2] = v[2]; scr[kk * 65 + nn + 3] = v[3];
    }
    asm volatile("s_waitcnt lgkmcnt(0)" ::: "memory");
    const int kc = lane & 7;
#pragma unroll
    for (int jt = 0; jt < 8; ++jt) {
        const int nl = 8 * jt + (lane >> 3);
        const LAS float* s = scr + (8 * kc) * 65 + nl;
        v4u o; o.x = pk2(s[0], s[65]); o.y = pk2(s[2 * 65], s[3 * 65]); o.z = pk2(s[4 * 65], s[5 * 65]); o.w = pk2(s[6 * 65], s[7 * 65]);
        *(v4u*)(WT + (size_t)rowmap(kind, half, n0 + nl) * 1024 + k0 + 8 * kc) = o;
    }
    asm volatile("s_waitcnt lgkmcnt(0)" ::: "memory");
}
__device__ __forceinline__ void rms_row_bf16(const float* __restrict__ xrow, const float* __restrict__ g, bf16* __restrict__ orow, int lane) {
    const f32x4* xr = (const f32x4*)xrow + lane;
    f32x4 v[4]; float s = 0.f;
#pragma unroll
    for (int j = 0; j < 4; ++j) { v[j] = xr[64 * j]; s += (v[j][0] * v[j][0] + v[j][1] * v[j][1]) + (v[j][2] * v[j][2] + v[j][3] * v[j][3]); }
    const float r = rsqrtf(wave_sum(s) * (1.f / D) + EPS);
#pragma unroll
    for (int j = 0; j < 4; ++j) { const f32x4 w = ((const f32x4*)g)[lane + 64 * j]; v2u o; o.x = pk2(v[j][0] * r * w[0], v[j][1] * r * w[1]); o.y = pk2(v[j][2] * r * w[2], v[j][3] * r * w[3]); ((v2u*)orow)[lane + 64 * j] = o; }
}
__device__ __forceinline__ void p0_prologue(const Ctx& C, const Args& a) {
    LAS float* scr = (LAS float*)(C.lds + C.wave * 16640);
    const int gw = C.vcu * NWAVES + C.wave, NGW = C.G * NWAVES;
    unsigned char* ws = a.ws;
    constexpr int I_IN = 16 * 40, I_OUT = 256, I_GLU = 16 * 32, I_EXP = 2 * 16 * 3 * 256;
    constexpr int NITEMS = I_IN + I_OUT + I_GLU + I_EXP;
    for (int m = gw; m < T; m += NGW) rms_row_bf16(a.in[0] + (size_t)m * D, a.in[1], (bf16*)(ws + WS_XN) + (size_t)m * D, C.lane);
    for (int it = gw; it < NITEMS; it += NGW) {
        int r = it;
        if (r < I_IN) { conv_item(a.in[2], INC, (bf16*)(ws + WS_WIN), 0, 0, r / 40, r % 40, scr, C.lane); continue; } r -= I_IN;
        if (r < I_OUT) { conv_item(a.in[9], D, (bf16*)(ws + WS_WOUT), 1, 0, r / 16, r % 16, scr, C.lane); continue; } r -= I_OUT;
        if (r < I_GLU) { conv_item(a.in[19], 2 * D, (bf16*)(ws + WS_WGLU), 2, 0, r / 32, r % 32, scr, C.lane); continue; } r -= I_GLU;
        const int mat = r >> 8, tile = r & 255, layer = mat / 48, rem = mat % 48, e = rem / 3, which = rem % 3;
        const float* src = a.in[23 + which] + ((size_t)layer * NE + e) * (size_t)D * EH;
        bf16* dst = (bf16*)(ws + WS_WEXP + layer * WEXP_LAYER + (which == 2 ? WEXP_DN + (size_t)e * 2 * MiB : WEXP_GU + (size_t)e * 4 * MiB));
        conv_item(src, EH, dst, which == 2 ? 1 : 3, which, tile >> 4, tile & 15, scr, C.lane);
    }
}

__device__ __forceinline__ void conv_tile(const Ctx& C, const Args& a, int tile) {
    const bf16* GLU = (const bf16*)(a.ws + WS_PROJ);
    bf16* MIXED = (bf16*)(a.ws + WS_MIXED);
    const float* cw = a.in[3]; const float* cb = a.in[4]; const float* lg = a.in[5]; const float* lb = a.in[6];
    LAS float* tl = (LAS float*)C.lds;
    const int cp = C.tid & 255, th = C.tid >> 8;
    const int b = tile / (S / 32), s0 = (tile % (S / 32)) * 32;
    f32x2 w[CONV_W];
#pragma unroll
    for (int j = 0; j < CONV_W; ++j) w[j] = *(const f32x2*)(cw + j * CONV_CH + 2 * cp);
    f32x2 acc[16];
    const f32x2 bias = *(const f32x2*)(cb + 2 * cp);
#pragma unroll
    for (int k = 0; k < 16; ++k) acc[k] = bias;
    unsigned xin[46];
#pragma unroll
    for (int i = 0; i < 46; ++i) { const int ss = s0 + 16 * th - 15 + i; xin[i] = (ss >= 0 && ss < S) ? *(const unsigned*)(GLU + (size_t)(b * S + ss) * 512 + 2 * cp) : 0u; }
#pragma unroll
    for (int i = 0; i < 46; ++i) {
        const f32x2 x = {bflo(xin[i]), bfhi(xin[i])};
#pragma unroll
        for (int k = 0; k < 16; ++k) { const int j = i - k; if (j >= 0 && j < CONV_W) acc[k] += w[j] * x; }
    }
#pragma unroll
    for (int k = 0; k < 16; ++k) *(LAS f32x2*)(tl + (16 * th + k) * 512 + 2 * cp) = acc[k];
    __syncthreads();
#pragma unroll
    for (int q = 0; q < 4; ++q) {
        const int tok = 4 * C.wave + q;
        const f32x4 v0 = *(const LAS f32x4*)(tl + tok * 512 + 8 * C.lane), v1 = *(const LAS f32x4*)(tl + tok * 512 + 8 * C.lane + 4);
        const float mu = wave_sum((v0[0] + v0[1]) + (v0[2] + v0[3]) + (v1[0] + v1[1]) + (v1[2] + v1[3])) * (1.f / CONV_CH);
        const f32x4 d0 = v0 - mu, d1 = v1 - mu;
        const float var = wave_sum((d0[0] * d0[0] + d0[1] * d0[1]) + (d0[2] * d0[2] + d0[3] * d0[3]) + (d1[0] * d1[0] + d1[1] * d1[1]) + (d1[2] * d1[2] + d1[3] * d1[3])) * (1.f / CONV_CH);
        const float rs = rsqrtf(var + EPS);
        const f32x4 g0 = *(const f32x4*)(lg + 8 * C.lane), g1 = *(const f32x4*)(lg + 8 * C.lane + 4), b0 = *(const f32x4*)(lb + 8 * C.lane), b1 = *(const f32x4*)(lb + 8 * C.lane + 4);
        f32x4 y0 = d0 * rs * g0 + b0, y1 = d1 * rs * g1 + b1;
#pragma unroll
        for (int e = 0; e < 4; ++e) { y0[e] = y0[e] * sigm(y0[e]); y1[e] = y1[e] * sigm(y1[e]); }
        v4u o; o.x = pk2(y0[0], y0[1]); o.y = pk2(y0[2], y0[3]); o.z = pk2(y1[0], y1[1]); o.w = pk2(y1[2], y1[3]);
        *(v4u*)(MIXED + (size_t)(b * S + s0 + tok) * D + 8 * C.lane) = o;
    }
    __syncthreads();
}
__device__ __forceinline__ void attn_simple(const Ctx& C, const Args& a) {
    const bf16* Q = (const bf16*)(a.ws + WS_PROJ + 16 * MiB);
    const bf16* K = (const bf16*)(a.ws + WS_PROJ + 32 * MiB);
    const bf16* V = (const bf16*)(a.ws + WS_PROJ + 48 * MiB);
    bf16* MIXED = (bf16*)(a.ws + WS_MIXED);
    const int gw = C.vcu * NWAVES + C.wave, NGW = C.G * NWAVES;
    for (int u = gw; u < T * NH; u += NGW) {
        const int tok = u >> 3, h = u & 7, b = tok / S, s = tok % S;
        const float q = bf2f(Q[(size_t)tok * 512 + h * 64 + C.lane]);
        const float slope2 = exp2f(-(float)(h + 1)) * 1.4426950408889634f;
        float m = -1e30f, l = 0.f, o = 0.f;
        for (int pi = 0; pi < 3; ++pi) {
            const int d = 1 << (2 * pi);
            for (int j = -64; j <= 64; ++j) {
                const int ss = s + j * d;
                if (ss < 0 || ss >= S) continue;
                const size_t off = (size_t)(b * S + ss) * 512 + h * 64 + C.lane;
                const float kv = bf2f(K[off]), vv = bf2f(V[off]);
                const float sc = wave_sum(q * kv) - slope2 * (float)(d * (j < 0 ? -j : j));
                const float mn = fmaxf(m, sc), al = __builtin_amdgcn_exp2f(m - mn), pp = __builtin_amdgcn_exp2f(sc - mn);
                l = l * al + pp; o = o * al + pp * vv; m = mn;
            }
        }
        const float r = o / l;
        const float r2 = __shfl_xor(r, 1);
        if ((C.lane & 1) == 0) *(unsigned*)(MIXED + (size_t)tok * D + 512 + h * 64 + C.lane) = pk2(r, r2);
    }
}

__device__ __forceinline__ void p_router(const Ctx& C, const Args& a, int layer) {
    const float* X = a.out; const float* g = a.in[20] + (size_t)layer * D;
    const float* wr = a.in[21] + (size_t)layer * D * NE; const float* br = a.in[22] + layer * NE;
    bf16* XN = (bf16*)(a.ws + WS_XN); float* AFF = (float*)(a.ws + WS_AFF);
    LAS float* wl = (LAS float*)C.lds;
    for (int i = C.tid; i < D * 4; i += NTHR) { const int k = i >> 2, qd = i & 3; const f32x4 v = *(const f32x4*)(wr + (size_t)k * NE + 4 * qd);
        const int slot = ((k >> 8) * 4 + (k & 3)) * 64 + ((k >> 2) & 63); *(LAS f32x4*)(wl + slot * 20 + 4 * qd) = v; }
    __syncthreads();
    const int gw = C.vcu * NWAVES + C.wave, NGW = C.G * NWAVES;
    for (int m = gw; m < T; m += NGW) {
        const f32x4* xr = (const f32x4*)(X + (size_t)m * D) + C.lane;
        f32x4 v[4]; float s = 0.f;
#pragma unroll
        for (int j = 0; j < 4; ++j) { v[j] = xr[64 * j]; s += (v[j][0] * v[j][0] + v[j][1] * v[j][1]) + (v[j][2] * v[j][2] + v[j][3] * v[j][3]); }
        const float r = rsqrtf(wave_sum(s) * (1.f / D) + EPS);
        float acc[NE];
#pragma unroll
        for (int e = 0; e < NE; ++e) acc[e] = 0.f;
#pragma unroll
        for (int j = 0; j < 4; ++j) {
            const f32x4 w = ((const f32x4*)g)[C.lane + 64 * j];
            const f32x4 hv = v[j] * w * r;
            v2u o; o.x = pk2(hv[0], hv[1]); o.y = pk2(hv[2], hv[3]); ((v2u*)(XN + (size_t)m * D))[C.lane + 64 * j] = o;
#pragma unroll
            for (int i = 0; i < 4; ++i) {
                const LAS float* wp = wl + ((j * 4 + i) * 64 + C.lane) * 20;
#pragma unroll
                for (int qd = 0; qd < 4; ++qd) { const f32x4 ww = *(const LAS f32x4*)(wp + 4 * qd); acc[4 * qd] += hv[i] * ww[0]; acc[4 * qd + 1] += hv[i] * ww[1]; acc[4 * qd + 2] += hv[i] * ww[2]; acc[4 * qd + 3] += hv[i] * ww[3]; }
                if (i & 1) asm volatile("" ::: "memory");
            }
        }
        float mx = -1e30f;
#pragma unroll
        for (int e = 0; e < NE; ++e) { acc[e] = wave_sum(acc[e]) + br[e]; mx = fmaxf(mx, acc[e]); }
        float sum = 0.f;
#pragma unroll
        for (int e = 0; e < NE; ++e) { acc[e] = __expf(acc[e] - mx); sum += acc[e]; }
        float mine = 0.f;
#pragma unroll
        for (int e = 0; e < NE; ++e) if (C.lane == e) mine = acc[e];
        const int b = m / S, ss = m % S;
        if (C.lane < NE) AFF[((size_t)b * NE + C.lane) * S + ss] = mine / sum;
    }
    __syncthreads();
}

__device__ __forceinline__ void p_topk_gather(const Ctx& C, const Args& a) {
    const float* AFF = (const float*)(a.ws + WS_AFF);
    int* IDX = (int*)(a.ws + WS_IDX); float* GATE = (float*)(a.ws + WS_GATE); int* SLOT = (int*)(a.ws + WS_SLOT);
    const bf16* XN = (const bf16*)(a.ws + WS_XN); bf16* XG = (bf16*)(a.ws + WS_PROJ);
    LAS unsigned* red = (LAS unsigned*)C.lds;
    LAS int* lidx = (LAS int*)(C.lds + 1024);
    LAS int* misc = (LAS int*)(C.lds + 4096);
    for (int item = C.vcu; item < NB * NE * 4; item += C.G) {
        const int be = item >> 2, qt = item & 3, b = be / NE, e = be % NE;
        unsigned key[8];
        { const v4u k0 = *(const v4u*)(AFF + (size_t)be * S + 8 * C.tid), k1 = *(const v4u*)(AFF + (size_t)be * S + 8 * C.tid + 4);
          key[0] = k0.x; key[1] = k0.y; key[2] = k0.z; key[3] = k0.w; key[4] = k1.x; key[5] = k1.y; key[6] = k1.z; key[7] = k1.w; }
        unsigned cur = 0u;
        for (int bit = 30; bit >= 0; --bit) {
            const unsigned cand = cur | (1u << bit);
            unsigned c = 0;
#pragma unroll
            for (int j = 0; j < 8; ++j) c += (key[j] >= cand) ? 1u : 0u;
#pragma unroll
            for (int o = 1; o < 64; o <<= 1) c += __shfl_xor(c, o);
            const int par = bit & 1;
            if (C.lane == 0) red[par * 8 + C.wave] = c;
            __syncthreads();
            unsigned tot = 0;
#pragma unroll
            for (int w = 0; w < 8; ++w) tot += red[par * 8 + w];
            if (tot >= (unsigned)CAP) cur = cand;
        }
        unsigned cg = 0, ce = 0;
#pragma unroll
        for (int j = 0; j < 8; ++j) { cg += (key[j] > cur) ? 1u : 0u; ce += (key[j] == cur) ? 1u : 0u; }
        unsigned pk = cg | (ce << 16), inc = pk;
#pragma unroll
        for (int o = 1; o < 64; o <<= 1) { const unsigned t = __shfl_up(inc, o); if (C.lane >= o) inc += t; }
        __syncthreads();
        if (C.lane == 63) red[16 + C.wave] = inc;
        __syncthreads();
        unsigned woff = 0, total = 0;
#pragma unroll
        for (int w = 0; w < 8; ++w) { const unsigned t = red[16 + w]; if (w < C.wave) woff += t; total += t; }
        const unsigned exc = woff + inc - pk;
        const int ngt = (int)(total & 0xffffu), need = CAP - ngt;
        int gtb = (int)(exc & 0xffffu), eqb = (int)(exc >> 16);
        const bool mineq = (C.tid >> 7) == qt;
        if (C.tid == 128 * qt) misc[0] = gtb + (eqb < need ? eqb : need);
        if (C.tid == 128 * qt + 127) {
            int g2 = gtb, e2 = eqb;
#pragma unroll
            for (int j = 0; j < 8; ++j) { g2 += (key[j] > cur) ? 1 : 0; e2 += (key[j] == cur) ? 1 : 0; }
            misc[1] = g2 + (e2 < need ? e2 : need);
        }
        if (mineq) {
            int sl[8];
#pragma unroll
            for (int j = 0; j < 8; ++j) {
                const bool gt = key[j] > cur, eq = key[j] == cur;
                const bool sel = gt || (eq && eqb < need);
                const int pos = gtb + (eqb < need ? eqb : need);
                sl[j] = sel ? pos : -1;
                if (sel) { const int tok = 8 * C.tid + j; IDX[be * CAP + pos] = b * S + tok; GATE[be * CAP + pos] = __uint_as_float(key[j]); lidx[pos] = tok; }
                gtb += gt ? 1 : 0; eqb += eq ? 1 : 0;
            }
#pragma unroll
            for (int j = 0; j < 8; ++j) SLOT[((size_t)(b * S + 8 * C.tid + j)) * NE + e] = sl[j];
        }
        __syncthreads();
        const int p0 = misc[0], p1 = misc[1];
        for (int p = p0 + (C.tid >> 7); p < p1; p += 4) {
            const int tok = lidx[p];
            const v4u v = *(const v4u*)(XN + (size_t)(b * S + tok) * D + 8 * (C.tid & 127));
            *(v4u*)(XG + (size_t)(be * CAP + p) * D + 8 * (C.tid & 127)) = v;
        }
        __syncthreads();
    }
}

__device__ __forceinline__ void p_combine(const Ctx& C, const Args& a, bool with_norm) {
    float* X = a.out; const bf16* Y = (const bf16*)(a.ws + WS_PROJ); const int* SLOT = (const int*)(a.ws + WS_SLOT);
    bf16* XN = (bf16*)(a.ws + WS_XN); const float* g = a.in[10];
    const int gw = C.vcu * NWAVES + C.wave, NGW = C.G * NWAVES;
    for (int m = gw; m < T; m += NGW) {
        const int b = m / S;
        f32x4* xr = (f32x4*)(X + (size_t)m * D) + C.lane;
        f32x4 v[4];
#pragma unroll
        for (int j = 0; j < 4; ++j) v[j] = xr[64 * j];
        const int myslot = (C.lane < NE) ? SLOT[(size_t)m * NE + C.lane] : -1;
        for (int e = 0; e < NE; ++e) {
            const int sl = __shfl(myslot, e);
            if (sl >= 0) {
                const v2u* yr = (const v2u*)(Y + ((size_t)(b * NE + e) * CAP + sl) * D) + C.lane;
#pragma unroll
                for (int j = 0; j < 4; ++j) { const v2u y = yr[64 * j]; v[j][0] += bflo(y.x); v[j][1] += bfhi(y.x); v[j][2] += bflo(y.y); v[j][3] += bfhi(y.y); }
            }
        }
#pragma unroll
        for (int j = 0; j < 4; ++j) xr[64 * j] = v[j];
        if (with_norm) {
            float s = 0.f;
#pragma unroll
            for (int j = 0; j < 4; ++j) s += (v[j][0] * v[j][0] + v[j][1] * v[j][1]) + (v[j][2] * v[j][2] + v[j][3] * v[j][3]);
            const float r = rsqrtf(wave_sum(s) * (1.f / D) + EPS);
#pragma unroll
            for (int j = 0; j < 4; ++j) { const f32x4 w = ((const f32x4*)g)[C.lane + 64 * j]; v2u o; o.x = pk2(v[j][0] * r * w[0], v[j][1] * r * w[1]); o.y = pk2(v[j][2] * r * w[2], v[j][3] * r * w[3]); ((v2u*)(XN + (size_t)m * D))[C.lane + 64 * j] = o; }
        }
    }
}

__device__ __forceinline__ void p_s5_simple(const Ctx& C, const Args& a) {
    const bf16* XN = (const bf16*)(a.ws + WS_XN);
    float* YF = (float*)(a.ws + WS_PROJ); float* YB = (float*)(a.ws + WS_H);
    const float *lam_re = a.in[11], *lam_im = a.in[12], *log_dt = a.in[13], *b_re = a.in[14], *b_im = a.in[15], *c_re = a.in[16], *c_im = a.in[17];
    LAS float* us = (LAS float*)(C.lds + C.wave * 8192);
    LAS float* hs = us + 64 * 16;
    const int lane = C.lane;
    for (int job = C.wave * C.G + (int)blockIdx.x; job < NB * SG * 2; job += NWAVES * C.G) {
        const int dir = job & 1, g = (job >> 1) & 63, b = job >> 7;
        const int pg = dir * SG + g;
        const float lr = lam_re[pg * SP + lane], li = lam_im[pg * SP + lane], dt = expf(log_dt[pg]);
        const float mag = expf(lr * dt), ang = li * dt;
        const float lbr = mag * cosf(ang), lbi = mag * sinf(ang);
        const float den = lr * lr + li * li, nr = lbr - 1.f;
        const float fr = (nr * lr + lbi * li) / den, fi = (lbi * lr - nr * li) / den;
        float bbr[16], bbi[16];
#pragma unroll
        for (int c = 0; c < 16; ++c) { const float br_ = b_re[((size_t)pg * SP + lane) * SC + c], bi_ = b_im[((size_t)pg * SP + lane) * SC + c]; bbr[c] = fr * br_ - fi * bi_; bbi[c] = fr * bi_ + fi * br_; }
        const int oc = lane & 15, oq = lane >> 4;
        float cr[16], ci[16];
#pragma unroll
        for (int i = 0; i < 16; ++i) { cr[i] = c_re[((size_t)pg * SC + oc) * SP + oq * 16 + i]; ci[i] = c_im[((size_t)pg * SC + oc) * SP + oq * 16 + i]; }
        float hr = 0.f, hi = 0.f;
        float* yout = dir ? YB : YF;
        for (int t0 = 0; t0 < S; t0 += 64) {
            {
                const int tt = dir ? (S - 1 - (t0 + lane)) : (t0 + lane);
                const v4u* src = (const v4u*)(XN + (size_t)(b * S + tt) * D + g * 16);
                const v4u p0 = src[0], p1 = src[1];
                LAS float* d = us + lane * 16;
                d[0] = bflo(p0.x); d[1] = bfhi(p0.x); d[2] = bflo(p0.y); d[3] = bfhi(p0.y); d[4] = bflo(p0.z); d[5] = bfhi(p0.z); d[6] = bflo(p0.w); d[7] = bfhi(p0.w);
                d[8] = bflo(p1.x); d[9] = bfhi(p1.x); d[10] = bflo(p1.y); d[11] = bfhi(p1.y); d[12] = bflo(p1.z); d[13] = bfhi(p1.z); d[14] = bflo(p1.w); d[15] = bfhi(p1.w);
            }
            asm volatile("s_waitcnt lgkmcnt(0)" ::: "memory"); __builtin_amdgcn_wave_barrier();
            for (int i = 0; i < 64; ++i) {
                float bur = 0.f, bui = 0.f;
#pragma unroll
                for (int c = 0; c < 16; ++c) { const float u = us[i * 16 + c]; bur += u * bbr[c]; bui += u * bbi[c]; }
                const float nhr = lbr * hr - lbi * hi + bur, nhi = lbr * hi + lbi * hr + bui;
                hr = nhr; hi = nhi;
                hs[lane] = hr; hs[64 + lane] = hi;
                asm volatile("s_waitcnt lgkmcnt(0)" ::: "memory"); __builtin_amdgcn_wave_barrier();
                float acc = 0.f;
#pragma unroll
                for (int k = 0; k < 16; ++k) acc += hs[oq * 16 + k] * cr[k] - hs[64 + oq * 16 + k] * ci[k];
                acc += __shfl_xor(acc, 16); acc += __shfl_xor(acc, 32);
                const int tt = dir ? (S - 1 - (t0 + i)) : (t0 + i);
                if (lane < 16) yout[(size_t)(b * S + tt) * D + g * 16 + lane] = acc;
                asm volatile("s_waitcnt lgkmcnt(0)" ::: "memory"); __builtin_amdgcn_wave_barrier();
            }
        }
    }
}
__device__ __forceinline__ float gelu_t(float y) { const float u = 0.7978845608028654f * (y + 0.044715f * y * y * y); const float e = __builtin_amdgcn_exp2f(2.885390081777927f * u); const float th = 1.f - 2.f * __builtin_amdgcn_rcpf(e + 1.f); return 0.5f * y * (1.f + th); }
__device__ __forceinline__ void p_s5_post(const Ctx& C, const Args& a) {
    const float* X = a.out; const float* YF = (const float*)(a.ws + WS_PROJ); const float* YB = (const float*)(a.ws + WS_H);
    const float* g = a.in[10]; const float* dsk = a.in[18]; bf16* Z = (bf16*)(a.ws + WS_MIXED);
    const int gw = C.vcu * NWAVES + C.wave, NGW = C.G * NWAVES;
    for (int m = gw; m < T; m += NGW) {
        const f32x4* xr = (const f32x4*)(X + (size_t)m * D) + C.lane;
        f32x4 v[4]; float s = 0.f;
#pragma unroll
        for (int j = 0; j < 4; ++j) { v[j] = xr[64 * j]; s += (v[j][0] * v[j][0] + v[j][1] * v[j][1]) + (v[j][2] * v[j][2] + v[j][3] * v[j][3]); }
        const float r = rsqrtf(wave_sum(s) * (1.f / D) + EPS);
#pragma unroll
        for (int j = 0; j < 4; ++j) {
            const f32x4 w = ((const f32x4*)g)[C.lane + 64 * j], dd = ((const f32x4*)dsk)[C.lane + 64 * j];
            const f32x4 yf = ((const f32x4*)(YF + (size_t)m * D))[C.lane + 64 * j], yb = ((const f32x4*)(YB + (size_t)m * D))[C.lane + 64 * j];
            const f32x4 y = yf + yb + dd * (v[j] * w * r);
            v2u o; o.x = pk2(gelu_t(y[0]), gelu_t(y[1])); o.y = pk2(gelu_t(y[2]), gelu_t(y[3])); ((v2u*)(Z + (size_t)m * D))[C.lane + 64 * j] = o;
        }
    }
}

constexpr int NPHASE = 18;
__global__ void __launch_bounds__(NTHR, 2) mk_fwd(Args args) {
    extern __shared__ __attribute__((aligned(16))) unsigned char lds_raw[];
    Ctx C;
    C.lds = (LAS unsigned char*)lds_raw;
    C.tid = threadIdx.x; C.lane = C.tid & 63; C.wave = __builtin_amdgcn_readfirstlane(C.tid >> 6);
    C.G = gridDim.x; { const int bx = blockIdx.x; C.vcu = (C.G % 8 == 0) ? (bx % 8) * (C.G / 8) + bx / 8 : bx; }
    volatile LAS unsigned* MISC = (volatile LAS unsigned*)(C.lds + LDSCTL_OFF);
    for (int u = C.tid; u < (LDS_BYTES - LDSCTL_OFF) / 4; u += NTHR) ((LAS unsigned*)(C.lds + LDSCTL_OFF))[u] = 0u;
    __syncthreads();
    int lo = args.ph_lo, hi = args.ph_hi;
    unsigned char* ws = args.ws;
    asm volatile("" : "+s"(lo), "+s"(hi), "+s"(ws));
    unsigned* ctl = (unsigned*)(ws + WS_CTL);
    const bool one_launch = (lo == 0 && hi == NPHASE);
    XcdBarrier bar; bar.bar = ctl + CW_BAR; bar.x = 0; bar.st = nullptr;
    if (one_launch) bar = xcd_barrier_post(ctl + CW_BAR, MISC + 8);
    LAS unsigned char* glds = C.lds;
#ifndef MK_ONLY
#define MK_ONLY -1
#endif
#define IN(k) ((MK_ONLY < 0 || MK_ONLY == (k) || (MK_ONLY == 4 && (k) == 13) || (MK_ONLY == 5 && (k) == 14) || (MK_ONLY == 6 && (k) == 15) || (MK_ONLY == 7 && (k) == 16) || (MK_ONLY == 8 && (k) == 17)) && lo <= (k) && (k) < hi)
#define SEAM(k) do { if (IN(k) && IN((k) + 1)) xcd_barrier(bar); } while (0)

    if (IN(0)) { p0_prologue(C, args); } SEAM(0);
    if (IN(1)) {
        pg8::Gemm g{(const bf16*)(ws + WS_XN), (const bf16*)(ws + WS_WIN), D}; pg8::DenseOrder So; So.init(T, INC, C.G, (int)blockIdx.x);
        pg8::EpiProj E{(bf16*)(ws + WS_PROJ), (bf16*)(ws + WS_PROJ + 16 * MiB), args.in[7], args.in[8]};
        pg8::gemm_phase<pg8::EpiProj, pg8::DenseOrder, true, true>(glds, g, So, E);
    } SEAM(1);
    if (IN(2)) {
        for (int t = C.vcu; t < T / 32; t += C.G) conv_tile(C, args, t);
        attn_simple(C, args);
    } SEAM(2);
    if (IN(3)) {
        pg8::Gemm g{(const bf16*)(ws + WS_MIXED), (const bf16*)(ws + WS_WOUT), D}; pg8::DenseOrder So; So.init(T, D, C.G, (int)blockIdx.x);
        pg8::EpiRes E{args.in[0], args.out};
        pg8::gemm_phase<pg8::EpiRes, pg8::DenseOrder, true, true>(glds, g, So, E);
    } SEAM(3);
#define MOE_PHASES(layer, pb) do { \
        if (IN(pb)) { p_router(C, args, layer); } SEAM(pb); \
        if (IN(pb + 1)) { p_topk_gather(C, args); } SEAM(pb + 1); \
        if (IN(pb + 2)) { \
            pg8::Gemm g{(const bf16*)(ws + WS_PROJ), (const bf16*)(ws + WS_WEXP + layer * WEXP_LAYER + WEXP_GU), D}; pg8::ExpertOrder So; So.init(8, C.G, (int)blockIdx.x); \
            pg8::EpiSwiGLU E{(bf16*)(ws + WS_H)}; \
            pg8::gemm_phase<pg8::EpiSwiGLU, pg8::ExpertOrder, true, true>(glds, g, So, E); \
        } SEAM(pb + 2); \
        if (IN(pb + 3)) { \
            pg8::Gemm g{(const bf16*)(ws + WS_H), (const bf16*)(ws + WS_WEXP + layer * WEXP_LAYER + WEXP_DN), EH}; pg8::ExpertOrder So; So.init(4, C.G, (int)blockIdx.x); \
            pg8::EpiDown E{(bf16*)(ws + WS_PROJ), (const float*)(ws + WS_GATE)}; \
            pg8::gemm_phase<pg8::EpiDown, pg8::ExpertOrder, true, true>(glds, g, So, E); \
        } SEAM(pb + 3); \
        if (IN(pb + 4)) { p_combine(C, args, layer == 0); } \
    } while (0)
    MOE_PHASES(0, 4);
    SEAM(8);
    if (IN(9)) { p_s5_simple(C, args); } SEAM(9);
    if (IN(10)) {   } SEAM(10);
    if (IN(11)) { p_s5_post(C, args); } SEAM(11);
    if (IN(12)) {
        pg8::Gemm g{(const bf16*)(ws + WS_MIXED), (const bf16*)(ws + WS_WGLU), D}; pg8::DenseOrder So; So.init(T, 2 * D, C.G, (int)blockIdx.x);
        pg8::EpiGluRes E{args.out};
        pg8::gemm_phase<pg8::EpiGluRes, pg8::DenseOrder, true, true>(glds, g, So, E);
    } SEAM(12);
    MOE_PHASES(1, 13);
#undef IN
#undef SEAM
}

#ifndef MK_PER_PHASE
#define MK_PER_PHASE 0
#endif
extern "C" void kernel_launch(void* const* d_in, const int* in_sizes, int n_in, void* d_out, int out_size, void* d_ws, size_t ws_size, hipStream_t stream) {
    static int grid = 0;
    if (grid == 0) {
        if (n_in != 26 || out_size != T * D || ws_size < WS_END) { fprintf(stderr, "kernel_launch: unexpected shapes (n_in %d out %d ws %zu)\n", n_in, out_size, ws_size); grid = -1; return; }
        int dev = 0, cus = 0, per_cu = 0;
        if (hipGetDevice(&dev) != hipSuccess || hipDeviceGetAttribute(&cus, hipDeviceAttributeMultiprocessorCount, dev) != hipSuccess) { grid = -1; return; }
        if (hipFuncSetAttribute((const void*)mk_fwd, hipFuncAttributeMaxDynamicSharedMemorySize, LDS_BYTES) != hipSuccess) { fprintf(stderr, "kernel_launch: hipFuncSetAttribute failed\n"); grid = -1; return; }
        if (hipOccupancyMaxActiveBlocksPerMultiprocessor(&per_cu, (const void*)mk_fwd, NTHR, LDS_BYTES) != hipSuccess || per_cu < 1) { fprintf(stderr, "kernel_launch: occupancy query says %d blocks per CU\n", per_cu); (void)hipGetLastError(); grid = -1; return; }
        grid = cus;
    }
    if (grid < 0) return;
    (void)hipMemsetAsync((char*)d_ws + WS_CTL, 0, CTL_ZERO_BYTES, stream);
    Args a{};
    for (int i = 0; i < 26; ++i) a.in[i] = (const float*)d_in[i];
    a.out = (float*)d_out; a.ws = (unsigned char*)d_ws;
#if MK_PER_PHASE
    for (int p = 0; p < NPHASE; ++p) { a.ph_lo = p; a.ph_hi = p + 1; hipLaunchKernelGGL(mk_fwd, dim3(grid), dim3(NTHR), LDS_BYTES, stream, a); }
#else
    a.ph_lo = 0; a.ph_hi = NPHASE;
    hipLaunchKernelGGL(mk_fwd, dim3(grid), dim3(NTHR), LDS_BYTES, stream, a);
#endif
}
```

```cpp
#include <hip/hip_runtime.h>
#include <cstdint>
#include <cstdio>

namespace pg8 {
#define PG8_LAS __attribute__((address_space(3)))
typedef unsigned short bf16_t;
typedef short bf16x8 __attribute__((ext_vector_type(8)));
typedef float f32x4 __attribute__((ext_vector_type(4)));
typedef unsigned u32x4 __attribute__((ext_vector_type(4)));
constexpr int BM = 256, BK = 64, HALF = 128, HTB = HALF * BK * 2  , STAGE_BYTES = 8 * HTB, NXCD = 8, WGM = 8;

__host__ __device__ __forceinline__ int lds_byte(int r, int c) { const int st = (r >> 4) * 2 + (c >> 5), rr = r & 15, cc = c & 31, ob = rr * 64 + cc * 2; return st * 1024 + (ob ^ (((ob >> 9) & 1) << 5)); }
__host__ __device__ __forceinline__ void stage_rc(int b, int& R, int& C) { const int st = b / 1024, sb = b % 1024, swz = sb ^ (((sb >> 9) & 1) << 5); R = (st >> 1) * 16 + swz / 64; C = (st & 1) * 32 + (swz % 64) / 2; }
__host__ __device__ __forceinline__ int perm32(int rho) { const int n = rho >> 4, i = rho & 15; return 8 * (i >> 2) + 4 * n + (i & 3); }

struct Unit { int pm, pn, pb; };
struct Gemm { const bf16_t* A; const bf16_t* Bt; int K; };

struct DenseOrder {
    int nM, nN, nwg, G, c;
    __device__ void init(int M, int N, int G_, int c_) { nM = M / BM; nN = N / BM; nwg = nM * nN; G = G_; c = c_; }
    __device__ bool next(int i, Unit& u) const {
        const long L = (long)i * G + c; if (L >= nwg) return false;
        int wgid = (int)L; { const int q = nwg / NXCD, r = nwg % NXCD, xcd = wgid % NXCD, off = wgid / NXCD; wgid = (xcd < r ? xcd * (q + 1) : r * (q + 1) + (xcd - r) * q) + off; }
        const int nig = WGM * nN, gid = wgid / nig, fm = gid * WGM, gsz = (nM - fm) < WGM ? (nM - fm) : WGM;
        u.pm = fm + ((wgid % nig) % gsz); u.pn = (wgid % nig) / gsz; u.pb = u.pn; return true;
    }
    __device__ __forceinline__ void a_ready(const Unit&) const {}
    __device__ __forceinline__ void done(const Unit&) const {}
};
struct ExpertOrder {
    int nN, nun, G, c;
    __device__ void init(int nN_, int G_, int c_) { nN = nN_; nun = 128 * nN_; G = G_; c = c_; }
    __device__ bool next(int i, Unit& u) const {
        const long L = (long)i * G + c; if (L >= nun) return false;
        int V = (int)L;
        if (G == 256) V = i * 256 + (c & 7) * 32 + (c >> 3);
        const int per = 8 * nN, e = V / per, r = V % per, pml = r / nN, pn = r % nN;
        u.pm = ((pml >> 1) * 16 + e) * 2 + (pml & 1); u.pn = pn; u.pb = e * nN + pn; return true;
    }
    __device__ __forceinline__ void a_ready(const Unit&) const {}
    __device__ __forceinline__ void done(const Unit&) const {}
};

typedef float f32x2 __attribute__((ext_vector_type(2)));
typedef __bf16 bf16x2_t __attribute__((ext_vector_type(2)));
__device__ __forceinline__ unsigned pk2(float lo, float hi) { f32x2 v = {lo, hi}; bf16x2_t b = __builtin_convertvector(v, bf16x2_t); return __builtin_bit_cast(unsigned, b); }
__device__ __forceinline__ float sigm(float x) { return __builtin_amdgcn_rcpf(1.f + __builtin_amdgcn_exp2f(-1.4426950408889634f * x)); }

constexpr float QSCALE = 0.125f * 1.4426950408889634f;
struct EpiProj {
    static constexpr bool PERM = true, AFTER_DRAIN = false;
    bf16_t *GLU, *Q; const float *qg, *kg;
    __device__ __forceinline__ void operator()(const f32x4 (&acc)[2][2][4][2], const Unit& u, int wr, int wc, int fr, int fq) const {
        const int row0 = u.pm * BM + wr * 64 + fr;
        if (u.pn < 4) {
            const int col0 = 128 * u.pn + 32 * wc + 8 * fq;
#pragma unroll
            for (int ai = 0; ai < 2; ++ai)
#pragma unroll
                for (int m = 0; m < 4; ++m) {
                    const f32x4 v0 = acc[ai][0][m][0], v1 = acc[ai][0][m][1], g0 = acc[ai][1][m][0], g1 = acc[ai][1][m][1];
                    u32x4 w; w.x = pk2(v0[0] * sigm(g0[0]), v0[1] * sigm(g0[1])); w.y = pk2(v0[2] * sigm(g0[2]), v0[3] * sigm(g0[3]));
                    w.z = pk2(v1[0] * sigm(g1[0]), v1[1] * sigm(g1[1])); w.w = pk2(v1[2] * sigm(g1[2]), v1[3] * sigm(g1[3]));
                    *(u32x4*)(GLU + (size_t)(row0 + ai * HALF + m * 16) * 512 + col0) = w;
                    asm volatile("" ::: "memory");
                }
        } else {
            const int t = (u.pn - 4) >> 1;
            const int hd = 4 * ((u.pn - 4) & 1) + wc;
            bf16_t* dst = Q + (size_t)t * (size_t)(8u << 20);
            const float* gp = (const float*)((uintptr_t)qg + (((uintptr_t)kg - (uintptr_t)qg) & (uintptr_t)(t == 0 ? 0 : ~(uintptr_t)0)));
#pragma unroll
            for (int ai = 0; ai < 2; ++ai)
#pragma unroll
                for (int m = 0; m < 4; ++m) {
                    float ss = 0.f;
#pragma unroll
                    for (int bj = 0; bj < 2; ++bj)
#pragma unroll
                        for (int n = 0; n < 2; ++n) { const f32x4 x = acc[ai][bj][m][n]; ss += (x[0] * x[0] + x[1] * x[1]) + (x[2] * x[2] + x[3] * x[3]); }
                    ss += __shfl_xor(ss, 16); ss += __shfl_xor(ss, 32);
                    float rs = 1.f;
                    if (t < 2) rs = rsqrtf(ss * (1.f / 64.f) + 1e-6f) * (t == 0 ? QSCALE : 1.f);
#pragma unroll
                    for (int bj = 0; bj < 2; ++bj) {
                        f32x4 g0 = {1.f, 1.f, 1.f, 1.f}, g1 = g0;
                        if (t < 2) { g0 = *(const f32x4*)(gp + 32 * bj + 8 * fq); g1 = *(const f32x4*)(gp + 32 * bj + 8 * fq + 4); }
                        const f32x4 a = acc[ai][bj][m][0] * g0 * rs, b = acc[ai][bj][m][1] * g1 * rs;
                        u32x4 w; w.x = pk2(a[0], a[1]); w.y = pk2(a[2], a[3]); w.z = pk2(b[0], b[1]); w.w = pk2(b[2], b[3]);
                        const int row = row0 + ai * HALF + m * 16;
                        *(u32x4*)(dst + ((size_t)((row >> 12) * 8 + hd) * 4096 + (row & 4095)) * 64 + 32 * bj + 8 * fq) = w;
                    }
                    asm volatile("" ::: "memory");
                }
        }
    }
};
struct EpiRes {
    static constexpr bool PERM = false, AFTER_DRAIN = false;
    const float* xin; float* X;
    __device__ __forceinline__ void operator()(const f32x4 (&acc)[2][2][4][2], const Unit& u, int wr, int wc, int fr, int fq) const {
        const int row0 = u.pm * BM + wr * 64 + fr, col0 = u.pn * BM + wc * 32 + 4 * fq;
#pragma unroll
        for (int ai = 0; ai < 2; ++ai)
#pragma unroll
            for (int m = 0; m < 4; ++m) { const size_t off = (size_t)(row0 + ai * HALF + m * 16) * 1024 + col0;
#pragma unroll
                for (int bj = 0; bj < 2; ++bj)
#pragma unroll
                    for (int n = 0; n < 2; ++n) { const f32x4 r = *(const f32x4*)(xin + off + bj * HALF + n * 16); *(f32x4*)(X + off + bj * HALF + n * 16) = r + acc[ai][bj][m][n]; } }
    }
};
struct EpiSwiGLU {
    static constexpr bool PERM = true, AFTER_DRAIN = false;
    bf16_t* H;
    __device__ __forceinline__ void operator()(const f32x4 (&acc)[2][2][4][2], const Unit& u, int wr, int wc, int fr, int fq) const {
        const int row0 = u.pm * BM + wr * 64 + fr, col0 = 128 * u.pn + 32 * wc + 8 * fq;
#pragma unroll
        for (int ai = 0; ai < 2; ++ai)
#pragma unroll
            for (int m = 0; m < 4; ++m) {
                const f32x4 g0 = acc[ai][0][m][0], g1 = acc[ai][0][m][1], u0 = acc[ai][1][m][0], u1 = acc[ai][1][m][1];
                u32x4 w; w.x = pk2(g0[0] * sigm(g0[0]) * u0[0], g0[1] * sigm(g0[1]) * u0[1]); w.y = pk2(g0[2] * sigm(g0[2]) * u0[2], g0[3] * sigm(g0[3]) * u0[3]);
                w.z = pk2(g1[0] * sigm(g1[0]) * u1[0], g1[1] * sigm(g1[1]) * u1[1]); w.w = pk2(g1[2] * sigm(g1[2]) * u1[2], g1[3] * sigm(g1[3]) * u1[3]);
                *(u32x4*)(H + (size_t)(row0 + ai * HALF + m * 16) * 1024 + col0) = w;
            }
    }
};
struct EpiDown {
    static constexpr bool PERM = true, AFTER_DRAIN = false;
    bf16_t* Y; const float* gate;
    __device__ __forceinline__ void operator()(const f32x4 (&acc)[2][2][4][2], const Unit& u, int wr, int wc, int fr, int fq) const {
        const int row0 = u.pm * BM + wr * 64 + fr, col0 = u.pn * BM + wc * 32 + 8 * fq;
#pragma unroll
        for (int ai = 0; ai < 2; ++ai)
#pragma unroll
            for (int m = 0; m < 4; ++m) { const int row = row0 + ai * HALF + m * 16; const float gs = gate[row];
#pragma unroll
                for (int bj = 0; bj < 2; ++bj) { const f32x4 a = acc[ai][bj][m][0] * gs, b = acc[ai][bj][m][1] * gs;
                    u32x4 w; w.x = pk2(a[0], a[1]); w.y = pk2(a[2], a[3]); w.z = pk2(b[0], b[1]); w.w = pk2(b[2], b[3]);
                    *(u32x4*)(Y + (size_t)row * 1024 + col0 + bj * HALF) = w; } }
    }
};
struct EpiGluRes {
    static constexpr bool PERM = false, AFTER_DRAIN = false;
    float* X;
    __device__ __forceinline__ void operator()(const f32x4 (&acc)[2][2][4][2], const Unit& u, int wr, int wc, int fr, int fq) const {
        const int row0 = u.pm * BM + wr * 64 + fr, col0 = 128 * u.pn + 32 * wc + 4 * fq;
#pragma unroll
        for (int ai = 0; ai < 2; ++ai)
#pragma unroll
            for (int m = 0; m < 4; ++m) { float* p = X + (size_t)(row0 + ai * HALF + m * 16) * 1024 + col0;
#pragma unroll
                for (int n = 0; n < 2; ++n) { const f32x4 v = acc[ai][0][m][n], g = acc[ai][1][m][n]; f32x4 r = *(const f32x4*)(p + n * 16);
                    r[0] += v[0] * sigm(g[0]); r[1] += v[1] * sigm(g[1]); r[2] += v[2] * sigm(g[2]); r[3] += v[3] * sigm(g[3]); *(f32x4*)(p + n * 16) = r; } }
    }
};

template <class Epi, class Sched, bool ALIGN_EPI = false, bool SP2 = false>
__device__ __forceinline__ void gemm_phase(PG8_LAS unsigned char* lds, const Gemm g, const Sched& S, const Epi& E) {
    const int tid = threadIdx.x, wid = __builtin_amdgcn_readfirstlane(tid >> 6), lane = tid & 63, wr = wid >> 2, wc = wid & 3, fr = lane & 15, fq = lane >> 4;
    const int K = g.K, nt = K / BK;
    unsigned voffA[2], voffB[2];
#pragma unroll
    for (int i = 0; i < 2; ++i) { int R, C; stage_rc(tid * 16 + i * 8192, R, C); const int Rb = Epi::PERM ? ((R & ~31) + perm32(R & 31)) : R;
        voffA[i] = (unsigned)(R * K + C) * 2u; voffB[i] = (unsigned)(Rb * K + C) * 2u; }
    const size_t kstep = (size_t)(BK * 2);
    const size_t hstep = (size_t)HALF * K * 2;
    const size_t tstep = 2 * hstep;
    const unsigned ldsw = (unsigned)wid * 1024u;
    const int aoff = lds_byte(wr * 64 + fr, fq * 8), boff = lds_byte(wc * 32 + fr, fq * 8);
#define PG8_SA(b, h) (((b) * 2 + (h)) * HTB)
#define PG8_SB(b, h) ((4 + (b) * 2 + (h)) * HTB)
#define PG8_STAGE(bufoff, gbase, voff) do { _Pragma("unroll") for (int _i = 0; _i < 2; ++_i) \
        __builtin_amdgcn_global_load_lds((const unsigned*)((const char*)(gbase) + (voff)[_i]), (PG8_LAS unsigned*)(lds + (bufoff) + ldsw + _i * 8192), 16, 0, 0); } while (0)
#define PG8_LDA(dst, b, h) do { _Pragma("unroll") for (int m = 0; m < 4; ++m) _Pragma("unroll") for (int k = 0; k < 2; ++k) dst[m][k] = *(const PG8_LAS bf16x8*)(lds + PG8_SA(b, h) + aoff + m * 2048 + k * 1024); } while (0)
#define PG8_LDB(dst, b, h) do { _Pragma("unroll") for (int n = 0; n < 2; ++n) _Pragma("unroll") for (int k = 0; k < 2; ++k) dst[n][k] = *(const PG8_LAS bf16x8*)(lds + PG8_SB(b, h) + boff + n * 2048 + k * 1024); } while (0)
#define PG8_MMA(ai, bj, At, Bt) do { __builtin_amdgcn_s_setprio(1); _Pragma("unroll") for (int m = 0; m < 4; ++m) _Pragma("unroll") for (int n = 0; n < 2; ++n) _Pragma("unroll") for (int k = 0; k < 2; ++k) \
        acc[ai][bj][m][n] = __builtin_amdgcn_mfma_f32_16x16x32_bf16(Bt[n][k], At[m][k], acc[ai][bj][m][n], 0, 0, 0); __builtin_amdgcn_s_setprio(0); } while (0)
#define PG8_WAIT_V(n) asm volatile("s_waitcnt vmcnt(" #n ")" ::: "memory")
#define PG8_WAIT_L(n) asm volatile("s_waitcnt lgkmcnt(" #n ")" ::: "memory")
#define PG8_BAR __builtin_amdgcn_s_barrier()
#define PG8_SCHED __builtin_amdgcn_sched_barrier(0)
    Unit cur, nxt; int ui = 0;
    if (!S.next(0, cur)) return;
    f32x4 acc[2][2][4][2];
#pragma unroll
    for (int a = 0; a < 2; ++a)
#pragma unroll
        for (int b = 0; b < 2; ++b)
#pragma unroll
            for (int m = 0; m < 4; ++m)
#pragma unroll
                for (int n = 0; n < 2; ++n) acc[a][b][m][n] = (f32x4){0.f, 0.f, 0.f, 0.f};
    bf16x8 At[4][2], B0[2][2], B1[2][2];
    const char* cA = (const char*)g.A + (size_t)cur.pm * tstep; const char* cB = (const char*)g.Bt + (size_t)cur.pb * tstep;
    S.a_ready(cur);
    if constexpr (SP2) {
        PG8_STAGE(PG8_SB(0, 0), cB, voffB); PG8_STAGE(PG8_SB(0, 1), cB + hstep, voffB); PG8_STAGE(PG8_SA(0, 0), cA, voffA); PG8_STAGE(PG8_SA(0, 1), cA + hstep, voffA);
        if (wr == 1) PG8_BAR;
        PG8_WAIT_V(2); PG8_BAR;
        PG8_STAGE(PG8_SB(1, 0), cB + kstep, voffB); PG8_STAGE(PG8_SA(1, 0), cA + kstep, voffA); PG8_STAGE(PG8_SB(1, 1), cB + hstep + kstep, voffB);
        PG8_WAIT_V(6); PG8_BAR;
    } else {
        PG8_STAGE(PG8_SB(0, 0), cB, voffB); PG8_STAGE(PG8_SA(0, 0), cA, voffA); PG8_STAGE(PG8_SB(0, 1), cB + hstep, voffB); PG8_STAGE(PG8_SA(0, 1), cA + hstep, voffA);
        if (wr == 1) PG8_BAR;
        PG8_WAIT_V(4); PG8_BAR;
        PG8_STAGE(PG8_SB(1, 0), cB + kstep, voffB); PG8_STAGE(PG8_SA(1, 0), cA + kstep, voffA); PG8_STAGE(PG8_SB(1, 1), cB + hstep + kstep, voffB);
        PG8_WAIT_V(6); PG8_BAR;
    }
    for (;;) {
        const bool has_next = S.next(ui + 1, nxt);
        const char* nA = has_next ? (const char*)g.A + (size_t)nxt.pm * tstep : cA; const char* nB = has_next ? (const char*)g.Bt + (size_t)nxt.pb * tstep : cB;
        for (int t = 0; t < nt; t += 2) {
            const bool last = (t == nt - 2);
            const char* a1 = cA + (size_t)(t + 1) * kstep;
            const char* a2 = last ? nA : cA + (size_t)(t + 2) * kstep; const char* b2 = last ? nB : cB + (size_t)(t + 2) * kstep;
            const char* a3 = a2 + kstep; const char* b3 = b2 + kstep;
            if (last && has_next) S.a_ready(nxt);
            if constexpr (SP2) {
            PG8_LDB(B0, 0, 0); PG8_LDB(B1, 0, 1); PG8_SCHED; PG8_LDA(At, 0, 0); PG8_STAGE(PG8_SA(1, 1), a1 + hstep, voffA);
            PG8_WAIT_V(8); PG8_WAIT_L(0); PG8_BAR; PG8_MMA(0, 0, At, B0); PG8_MMA(0, 1, At, B1); PG8_BAR; PG8_SCHED;
            PG8_LDA(At, 0, 1); PG8_STAGE(PG8_SB(0, 0), b2, voffB); PG8_STAGE(PG8_SB(0, 1), b2 + hstep, voffB); PG8_STAGE(PG8_SA(0, 0), a2, voffA);
            PG8_WAIT_V(8); PG8_WAIT_L(0); PG8_BAR; PG8_MMA(1, 0, At, B0); PG8_MMA(1, 1, At, B1); PG8_BAR; PG8_SCHED;
            PG8_LDB(B0, 1, 0); PG8_LDB(B1, 1, 1); PG8_SCHED; PG8_LDA(At, 1, 0); PG8_STAGE(PG8_SA(0, 1), a2 + hstep, voffA);
            PG8_WAIT_V(8); PG8_WAIT_L(0); PG8_BAR; PG8_MMA(0, 0, At, B0); PG8_MMA(0, 1, At, B1); PG8_BAR; PG8_SCHED;
            PG8_LDA(At, 1, 1); PG8_STAGE(PG8_SB(1, 0), b3, voffB); PG8_STAGE(PG8_SB(1, 1), b3 + hstep, voffB); PG8_STAGE(PG8_SA(1, 0), a3, voffA);
            PG8_WAIT_V(8); PG8_WAIT_L(0); PG8_BAR; PG8_MMA(1, 0, At, B0); PG8_MMA(1, 1, At, B1); PG8_BAR; PG8_SCHED;
            } else {
            PG8_LDB(B0, 0, 0); PG8_SCHED; PG8_LDA(At, 0, 0); PG8_STAGE(PG8_SA(1, 1), a1 + hstep, voffA);
            PG8_WAIT_L(8); PG8_BAR; PG8_WAIT_L(0); PG8_MMA(0, 0, At, B0); PG8_BAR; PG8_SCHED;
            PG8_LDB(B1, 0, 1); PG8_STAGE(PG8_SB(0, 0), b2, voffB);
            PG8_BAR; PG8_WAIT_L(0); PG8_MMA(0, 1, At, B1); PG8_BAR;
            PG8_LDA(At, 0, 1); PG8_STAGE(PG8_SA(0, 0), a2, voffA);
            PG8_BAR; PG8_WAIT_L(0); PG8_MMA(1, 0, At, B0); PG8_BAR; PG8_SCHED;
            PG8_STAGE(PG8_SB(0, 1), b2 + hstep, voffB);
            PG8_WAIT_V(6); PG8_BAR; PG8_MMA(1, 1, At, B1); PG8_BAR;
            PG8_LDB(B0, 1, 0); PG8_SCHED; PG8_LDA(At, 1, 0); PG8_STAGE(PG8_SA(0, 1), a2 + hstep, voffA);
            PG8_WAIT_L(8); PG8_BAR; PG8_WAIT_L(0); PG8_MMA(0, 0, At, B0); PG8_BAR; PG8_SCHED;
            PG8_LDB(B1, 1, 1); PG8_STAGE(PG8_SB(1, 0), b3, voffB);
            PG8_BAR; PG8_WAIT_L(0); PG8_MMA(0, 1, At, B1); PG8_BAR;
            PG8_LDA(At, 1, 1); PG8_STAGE(PG8_SA(1, 0), a3, voffA);
            PG8_BAR; PG8_WAIT_L(0); PG8_MMA(1, 0, At, B0); PG8_BAR; PG8_SCHED;
            PG8_STAGE(PG8_SB(1, 1), b3 + hstep, voffB);
            PG8_WAIT_V(6); PG8_BAR; PG8_MMA(1, 1, At, B1); PG8_BAR;
            }
        }
        if constexpr (ALIGN_EPI) { if (wr == 0) PG8_BAR; }
        if constexpr (!Epi::AFTER_DRAIN) { E(acc, cur, wr, wc, fr, fq); S.done(cur); }
        if (!has_next) break;
#pragma unroll
        for (int a = 0; a < 2; ++a)
#pragma unroll
            for (int b = 0; b < 2; ++b)
#pragma unroll
                for (int m = 0; m < 4; ++m)
#pragma unroll
                    for (int n = 0; n < 2; ++n) acc[a][b][m][n] = (f32x4){0.f, 0.f, 0.f, 0.f};
        cur = nxt; cA = nA; cB = nB; ++ui;
        if constexpr (ALIGN_EPI) { if (wr == 1) PG8_BAR; }
    }
    PG8_WAIT_V(0);
    if constexpr (!ALIGN_EPI) { if (wr == 0) PG8_BAR; }
    PG8_BAR;
    if constexpr (Epi::AFTER_DRAIN) { E.fused(acc, cur, wr, wc, fr, fq, lds, wid, lane); S.done(cur); }
#undef PG8_SA
#undef PG8_SB
#undef PG8_STAGE
#undef PG8_LDA
#undef PG8_LDB
#undef PG8_MMA
#undef PG8_WAIT_V
#undef PG8_WAIT_L
#undef PG8_BAR
#undef PG8_SCHED
}
}

constexpr int NB = 4, S = 4096, D = 1024, T = NB * S;
constexpr int CONV_CH = 512, CONV_W = 31, NH = 8, INC = 2560;
constexpr int SG = 64, SC = 16, SP = 64;
constexpr int NE = 16, CAP = 512, EH = 1024, MR = NB * NE * CAP;
constexpr float EPS = 1e-6f;
constexpr int NWAVES = 8, NTHR = NWAVES * 64;

constexpr size_t MiB = 1u << 20;
constexpr size_t WS_CTL = 0, CTL_ZERO_BYTES = 64 * 1024;
constexpr size_t WS_AFF = 1 * MiB, WS_IDX = 2 * MiB, WS_GATE = 2 * MiB + 512 * 1024, WS_SLOT = 3 * MiB;
constexpr size_t WS_WIN = 4 * MiB, WS_WOUT = 10 * MiB, WS_WGLU = 12 * MiB;
constexpr size_t WS_WEXP = 16 * MiB, WEXP_LAYER = 96 * MiB, WEXP_GU = 0, WEXP_DN = 64 * MiB;
constexpr size_t WS_XN = 208 * MiB, WS_MIXED = 240 * MiB;
constexpr size_t WS_PROJ = 272 * MiB;
constexpr size_t WS_H = 336 * MiB;
constexpr size_t WS_END = 400 * MiB;
constexpr int CW_BAR = 1024;

constexpr int SCRATCH_BYTES = 143360;
constexpr int LDSCTL_OFF = SCRATCH_BYTES;
constexpr int LDS_BYTES = 147456;

#define GAS __attribute__((address_space(1)))
#define LAS __attribute__((address_space(3)))
typedef unsigned short bf16;
typedef unsigned v4u __attribute__((ext_vector_type(4)));
typedef unsigned v2u __attribute__((ext_vector_type(2)));
typedef float f32x4 __attribute__((ext_vector_type(4)));
typedef float f32x2 __attribute__((ext_vector_type(2)));
using pg8::pk2;
using pg8::sigm;
__device__ __forceinline__ float bf2f(unsigned short h) { return __uint_as_float(((unsigned)h) << 16); }
__device__ __forceinline__ float bflo(unsigned w) { return __uint_as_float(w << 16); }
__device__ __forceinline__ float bfhi(unsigned w) { return __uint_as_float(w & 0xffff0000u); }
__device__ __forceinline__ float wave_sum(float v) {
#pragma unroll
    for (int o = 1; o < 64; o <<= 1) v += __shfl_xor(v, o);
    return v;
}

#define XB_TMO      128
#define XB_XCNT(j)  (256  + 64 * (j))
#define XB_XSUB(j)  (1280 + 64 * (j))
#define XB_XGEN(j)  (2304 + 64 * (j))
#define XB_TOP      3328
#define XB_TOPGEN   3392
#define XCD_BAR_WORDS 3456
#define XB_SPIN_CAP (1u << 18)
__device__ __forceinline__ unsigned xb_ld(unsigned* p)              { return __hip_atomic_load(p, __ATOMIC_RELAXED, __HIP_MEMORY_SCOPE_AGENT); }
__device__ __forceinline__ unsigned xb_add(unsigned* p, unsigned v) { return __hip_atomic_fetch_add(p, v, __ATOMIC_RELAXED, __HIP_MEMORY_SCOPE_AGENT); }
__device__ __forceinline__ unsigned xb_xcc_id() { return (unsigned)__builtin_amdgcn_s_getreg((3 << 11) | 20) & 0xFu; }
#define XB_SPIN(cond, bar) do { unsigned _sp = 0; while (cond) { __builtin_amdgcn_s_sleep(1); \
    if ((++_sp & 255u) == 0u) { if (xb_ld(&(bar)[XB_TMO])) break; if (_sp > XB_SPIN_CAP) { atomicAdd(&(bar)[XB_TMO], 1u); break; } } } } while (0)
struct XcdBarrier { unsigned* bar; unsigned x; volatile LAS unsigned* st; };
__device__ __forceinline__ XcdBarrier xcd_barrier_post(unsigned* bar, volatile LAS unsigned* st) {
    XcdBarrier b; b.bar = bar; b.x = xb_xcc_id(); b.st = st;
    if (threadIdx.x == 0) (void)xb_add(&bar[XB_XCNT(b.x)], 1u);
    return b;
}
__device__ __forceinline__ void xcd_barrier_complete(unsigned* bar, unsigned x, unsigned& nloc, unsigned& nx) {
    const unsigned G = gridDim.x * gridDim.y * gridDim.z;
    unsigned sum, cnt, mine, sp = 0u;
    for (;;) {
        sum = 0u; cnt = 0u; mine = 0u;
#pragma unroll
        for (unsigned j = 0; j < 16; ++j) { const unsigned c = xb_ld(&bar[XB_XCNT(j)]); sum += c; cnt += (c > 0u) ? 1u : 0u; mine = (j == x) ? c : mine; }
        if (sum == G) break;
        __builtin_amdgcn_s_sleep(1);
        if ((++sp & 255u) == 0u) { if (xb_ld(&bar[XB_TMO])) break; if (sp > XB_SPIN_CAP) { atomicAdd(&bar[XB_TMO], 1u); break; } }
    }
    nloc = mine > 0u ? mine : 1u; nx = cnt > 0u ? cnt : 1u;
}
__device__ __forceinline__ void xcd_barrier(const XcdBarrier& b) {
    asm volatile("s_waitcnt vmcnt(0)" ::: "memory");
    __syncthreads();
    if (threadIdx.x == 0) {
        unsigned* bar = b.bar;
        __builtin_amdgcn_s_waitcnt(0);
        unsigned nloc = b.st[0], nx = b.st[1];
        if (nloc == 0u) { xcd_barrier_complete(bar, b.x, nloc, nx); b.st[0] = nloc; b.st[1] = nx; }
        const unsigned old = xb_add(&bar[XB_XSUB(b.x)], 1u);
        const unsigned gen = old / nloc;
        if (old + 1u == (gen + 1u) * nloc) {
            __builtin_amdgcn_fence(__ATOMIC_RELEASE, "agent");
            asm volatile("s_waitcnt vmcnt(0)" ::: "memory");
            const unsigned og = xb_add(&bar[XB_TOP], 1u);
            const unsigned tg = og / nx;
            if (og + 1u == (tg + 1u) * nx) xb_add(&bar[XB_TOPGEN], 1u);
            else XB_SPIN(xb_ld(&bar[XB_TOPGEN]) == tg, bar);
            __builtin_amdgcn_fence(__ATOMIC_ACQUIRE, "agent");
            xb_add(&bar[XB_XGEN(b.x)], 1u);
            asm volatile("s_waitcnt vmcnt(0)" ::: "memory");
        } else {
            XB_SPIN(xb_ld(&bar[XB_XGEN(b.x)]) == gen, bar);
            __builtin_amdgcn_fence(__ATOMIC_ACQUIRE, "agent");
            asm volatile("s_waitcnt vmcnt(0)" ::: "memory");
        }
    }
    __syncthreads();
}

struct Args {
    const float* in[26]; float* out; unsigned char* ws; int ph_lo, ph_hi;
};
struct Ctx { LAS unsigned char* lds; int tid, lane, wave, vcu, G; };

__device__ __forceinline__ int rowmap(int kind, int half, int n) {
    if (kind == 0) {
        if (n < 1024) { const int hf = n >> 9, r = n & 511; return 256 * (r >> 7) + 128 * hf + (r & 127); }
        const int pn = n >> 8, w = n & 255, wc = w >> 6, bj = (w >> 5) & 1, j = w & 31; return 256 * pn + 128 * bj + 32 * wc + j;
    }
    if (kind == 2) { const int hf = n >> 10, r = n & 1023; return 256 * (r >> 7) + 128 * hf + (r & 127); }
    if (kind == 3) return 256 * (n >> 7) + 128 * half + (n & 127);
    return n;
}
__device__ __forceinline__ void conv_item(const float* __restrict__ W, int N, bf16* __restrict__ WT, int kind, int half, int kb, int nb, LAS float* scr, int lane) {
    const int k0 = 64 * kb, n0 = 64 * nb;
#pragma unroll 4
    for (int it = 0; it < 16; ++it) {
        const int kk = 4 * it + (lane >> 4), nn = 4 * (lane & 15);
        const f32x4 v = *(const f32x4*)(W + (size_t)(k0 + kk) * N + n0 + nn);
        scr[kk * 65 + nn] = v[0]; scr[kk * 65 + nn + 1] = v[1]; scr[kk * 65 + nn + 2] = v[2]; scr[kk * 65 + nn + 3] = v[3];
    }
    asm volatile("s_waitcnt lgkmcnt(0)" ::: "memory");
    const int kc = lane & 7;
#pragma unroll
    for (int jt = 0; jt < 8; ++jt) {
        const int nl = 8 * jt + (lane >> 3);
        const LAS float* s = scr + (8 * kc) * 65 + nl;
        v4u o; o.x = pk2(s[0], s[65]); o.y = pk2(s[2 * 65], s[3 * 65]); o.z = pk2(s[4 * 65], s[5 * 65]); o.w = pk2(s[6 * 65], s[7 * 65]);
        *(v4u*)(WT + (size_t)rowmap(kind, half, n0 + nl) * 1024 + k0 + 8 * kc) = o;
    }
    asm volatile("s_waitcnt lgkmcnt(0)" ::: "memory");
}
__device__ __forceinline__ void rms_row_bf16(const float* __restrict__ xrow, const float* __restrict__ g, bf16* __restrict__ orow, int lane) {
    const f32x4* xr = (const f32x4*)xrow + lane;
    f32x4 v[4]; float s = 0.f;
#pragma unroll
    for (int j = 0; j < 4; ++j) { v[j] = xr[64 * j]; s += (v[j][0] * v[j][0] + v[j][1] * v[j][1]) + (v[j][2] * v[j][2] + v[j][3] * v[j][3]); }
    const float r = rsqrtf(wave_sum(s) * (1.f / D) + EPS);
#pragma unroll
    for (int j = 0; j < 4; ++j) { const f32x4 w = ((const f32x4*)g)[lane + 64 * j]; v2u o; o.x = pk2(v[j][0] * r * w[0], v[j][1] * r * w[1]); o.y = pk2(v[j][2] * r * w[2], v[j][3] * r * w[3]); ((v2u*)orow)[lane + 64 * j] = o; }
}
__device__ __forceinline__ void p0_prologue(const Ctx& C, const Args& a) {
    LAS float* scr = (LAS float*)(C.lds + C.wave * 16640);
    const int gw = C.vcu * NWAVES + C.wave, NGW = C.G * NWAVES;
    unsigned char* ws = a.ws;
    constexpr int I_IN = 16 * 40, I_OUT = 256, I_GLU = 16 * 32, I_EXP = 2 * 16 * 3 * 256;
    constexpr int NITEMS = I_IN + I_OUT + I_GLU + I_EXP;
    for (int m = gw; m < T; m += NGW) rms_row_bf16(a.in[0] + (size_t)m * D, a.in[1], (bf16*)(ws + WS_XN) + (size_t)m * D, C.lane);
    for (int it = gw; it < NITEMS; it += NGW) {
        int r = it;
        if (r < I_IN) { conv_item(a.in[2], INC, (bf16*)(ws + WS_WIN), 0, 0, r / 40, r % 40, scr, C.lane); continue; } r -= I_IN;
        if (r < I_OUT) { conv_item(a.in[9], D, (bf16*)(ws + WS_WOUT), 1, 0, r / 16, r % 16, scr, C.lane); continue; } r -= I_OUT;
        if (r < I_GLU) { conv_item(a.in[19], 2 * D, (bf16*)(ws + WS_WGLU), 2, 0, r / 32, r % 32, scr, C.lane); continue; } r -= I_GLU;
        const int mat = r >> 8, tile = r & 255, layer = mat / 48, rem = mat % 48, e = rem / 3, which = rem % 3;
        const float* src = a.in[23 + which] + ((size_t)layer * NE + e) * (size_t)D * EH;
        bf16* dst = (bf16*)(ws + WS_WEXP + layer * WEXP_LAYER + (which == 2 ? WEXP_DN + (size_t)e * 2 * MiB : WEXP_GU + (size_t)e * 4 * MiB));
        conv_item(src, EH, dst, which == 2 ? 1 : 3, which, tile >> 4, tile & 15, scr, C.lane);
    }
}

__device__ __forceinline__ void conv_tile(const Ctx& C, const Args& a, int tile) {
    const bf16* GLU = (const bf16*)(a.ws + WS_PROJ);
    bf16* MIXED = (bf16*)(a.ws + WS_MIXED);
    const float* cw = a.in[3]; const float* cb = a.in[4]; const float* lg = a.in[5]; const float* lb = a.in[6];
    LAS float* tl = (LAS float*)C.lds;
    const int cp = C.tid & 255, th = C.tid >> 8;
    const int b = tile / (S / 32), s0 = (tile % (S / 32)) * 32;
    f32x2 w[CONV_W];
#pragma unroll
    for (int j = 0; j < CONV_W; ++j) w[j] = *(const f32x2*)(cw + j * CONV_CH + 2 * cp);
    f32x2 acc[16];
    const f32x2 bias = *(const f32x2*)(cb + 2 * cp);
#pragma unroll
    for (int k = 0; k < 16; ++k) acc[k] = bias;
    unsigned xin[46];
#pragma unroll
    for (int i = 0; i < 46; ++i) { const int ss = s0 + 16 * th - 15 + i; xin[i] = (ss >= 0 && ss < S) ? *(const unsigned*)(GLU + (size_t)(b * S + ss) * 512 + 2 * cp) : 0u; }
#pragma unroll
    for (int i = 0; i < 46; ++i) {
        const f32x2 x = {bflo(xin[i]), bfhi(xin[i])};
#pragma unroll
        for (int k = 0; k < 16; ++k) { const int j = i - k; if (j >= 0 && j < CONV_W) acc[k] += w[j] * x; }
    }
#pragma unroll
    for (int k = 0; k < 16; ++k) *(LAS f32x2*)(tl + (16 * th + k) * 512 + 2 * cp) = acc[k];
    __syncthreads();
#pragma unroll
    for (int q = 0; q < 4; ++q) {
        const int tok = 4 * C.wave + q;
        const f32x4 v0 = *(const LAS f32x4*)(tl + tok * 512 + 8 * C.lane), v1 = *(const LAS f32x4*)(tl + tok * 512 + 8 * C.lane + 4);
        const float mu = wave_sum((v0[0] + v0[1]) + (v0[2] + v0[3]) + (v1[0] + v1[1]) + (v1[2] + v1[3])) * (1.f / CONV_CH);
        const f32x4 d0 = v0 - mu, d1 = v1 - mu;
        const float var = wave_sum((d0[0] * d0[0] + d0[1] * d0[1]) + (d0[2] * d0[2] + d0[3] * d0[3]) + (d1[0] * d1[0] + d1[1] * d1[1]) + (d1[2] * d1[2] + d1[3] * d1[3])) * (1.f / CONV_CH);
        const float rs = rsqrtf(var + EPS);
        const f32x4 g0 = *(const f32x4*)(lg + 8 * C.lane), g1 = *(const f32x4*)(lg + 8 * C.lane + 4), b0 = *(const f32x4*)(lb + 8 * C.lane), b1 = *(const f32x4*)(lb + 8 * C.lane + 4);
        f32x4 y0 = d0 * rs * g0 + b0, y1 = d1 * rs * g1 + b1;
#pragma unroll
        for (int e = 0; e < 4; ++e) { y0[e] = y0[e] * sigm(y0[e]); y1[e] = y1[e] * sigm(y1[e]); }
        v4u o; o.x = pk2(y0[0], y0[1]); o.y = pk2(y0[2], y0[3]); o.z = pk2(y1[0], y1[1]); o.w = pk2(y1[2], y1[3]);
        *(v4u*)(MIXED + (size_t)(b * S + s0 + tok) * D + 8 * C.lane) = o;
    }
    __syncthreads();
}
typedef short bf16x8 __attribute__((ext_vector_type(8)));
typedef short s16x4 __attribute__((ext_vector_type(4)));
typedef short v4i16_t __attribute__((ext_vector_type(4)));
typedef float f32x16 __attribute__((ext_vector_type(16)));
constexpr int AT_O = 0, AT_L = 65536, AT_V = 66560;
__device__ __forceinline__ s16x4 vtr(const LAS char* p) { return __builtin_bit_cast(s16x4, __builtin_amdgcn_ds_read_tr16_b64_v4i16((LAS v4i16_t*)p)); }
__device__ __forceinline__ void lds_addf(LAS float* p, float v) { (void)__hip_atomic_fetch_add(p, v, __ATOMIC_RELAXED, __HIP_MEMORY_SCOPE_WORKGROUP); }
__device__ __forceinline__ void attn_unit(const Ctx& C, const bf16* __restrict__ Qh, const bf16* __restrict__ Kh, const bf16* __restrict__ Vh,
                                          int d, int tq0, int nq, int tl0, int tls, float a2, float bound2, LAS float* Oacc, LAS float* Lacc, LAS char* vst) {
    const int lane = C.lane, r = lane & 31, hh = lane >> 5;
    const int qi = r < nq ? r : nq - 1;
    bf16x8 qf[4];
    { const bf16* qp = Qh + (size_t)(tq0 + d * qi) * 64 + 8 * hh;
#pragma unroll
      for (int ks = 0; ks < 4; ++ks) qf[ks] = *(const bf16x8*)(qp + 16 * ks); }
    f32x16 o0, o1;
#pragma unroll
    for (int v = 0; v < 16; ++v) { o0[v] = 0.f; o1[v] = 0.f; }
    float lsum = 0.f;
    const LAS char* vb = vst + ((lane >> 4) & 1) * 32 + (lane & 3) * 8 + (4 * hh + ((lane & 15) >> 2)) * 64;
#pragma unroll 1
    for (int kb = 0; kb < 5; ++kb) {
        int kp = tq0 + d * (32 * kb + r - 64); kp = kp < 0 ? 0 : (kp > S - 1 ? S - 1 : kp);
        const bf16* kptr = Kh + (size_t)kp * 64 + 8 * hh;
        bf16x8 kf[4];
#pragma unroll
        for (int ks = 0; ks < 4; ++ks) kf[ks] = *(const bf16x8*)(kptr + 16 * ks);
#pragma unroll
        for (int it = 0; it < 4; ++it) {
            const int idx = lane + 64 * it, key = idx >> 3, c = idx & 7;
            int vp = tq0 + d * (32 * kb + key - 64); vp = vp < 0 ? 0 : (vp > S - 1 ? S - 1 : vp);
            const v4u vv = *(const v4u*)(Vh + (size_t)vp * 64 + 8 * c);
            *(LAS v4u*)(vst + ((c >> 2) * 2 + (key >> 4)) * 1024 + (key & 15) * 64 + (c & 3) * 16) = vv;
        }
        f32x16 p;
#pragma unroll
        for (int v = 0; v < 16; ++v) {
            const int row = (v & 3) + 8 * (v >> 2) + 4 * hh, m = 32 * kb + row, rel = m - 64 - r, kpos = tq0 + d * (m - 64);
            const bool valid = (rel >= -64) && (rel <= 64) && (kpos >= 0) && (kpos < S) && (r < nq);
            p[v] = valid ? -(a2 * fabsf((float)rel)) - bound2 : -1e30f;
        }
#pragma unroll
        for (int ks = 0; ks < 4; ++ks) p = __builtin_amdgcn_mfma_f32_32x32x16_bf16(kf[ks], qf[ks], p, 0, 0, 0);
#pragma unroll
        for (int v = 0; v < 16; ++v) { p[v] = __builtin_amdgcn_exp2f(p[v]); lsum += p[v]; }
        v4u pw0, pw1;
        pw0.x = pk2(p[0], p[1]); pw0.y = pk2(p[2], p[3]); pw0.z = pk2(p[4], p[5]); pw0.w = pk2(p[6], p[7]);
        pw1.x = pk2(p[8], p[9]); pw1.y = pk2(p[10], p[11]); pw1.z = pk2(p[12], p[13]); pw1.w = pk2(p[14], p[15]);
        asm volatile("s_waitcnt lgkmcnt(0)" ::: "memory");
#pragma unroll
        for (int sdh = 0; sdh < 4; ++sdh) {
            const int dh = sdh >> 1, ss = sdh & 1;
            const s16x4 lo = vtr(vb + dh * 2048 + ss * 1024), hi = vtr(vb + dh * 2048 + ss * 1024 + 512);
            const bf16x8 vf = {lo[0], lo[1], lo[2], lo[3], hi[0], hi[1], hi[2], hi[3]};
            const bf16x8 pa = __builtin_bit_cast(bf16x8, ss == 0 ? pw0 : pw1);
            if (dh == 0) o0 = __builtin_amdgcn_mfma_f32_32x32x16_bf16(pa, vf, o0, 0, 0, 0);
            else o1 = __builtin_amdgcn_mfma_f32_32x32x16_bf16(pa, vf, o1, 0, 0, 0);
        }
        asm volatile("s_waitcnt lgkmcnt(0)" ::: "memory");
    }
    lsum += __shfl_xor(lsum, 32);
    if (lane < nq) lds_addf(Lacc + tl0 + tls * lane, lsum);
#pragma unroll
    for (int v = 0; v < 16; ++v) {
        const int iq = (v & 3) + 8 * (v >> 2) + 4 * hh;
        if (v < 8 || nq == 32) { LAS float* op = Oacc + (tl0 + tls * iq) * 64 + r; lds_addf(op, o0[v]); lds_addf(op + 32, o1[v]); }
    }
}
__device__ __forceinline__ void attn_phase(const Ctx& C, const Args& a) {
    const bf16* Q = (const bf16*)(a.ws + WS_PROJ + 16 * MiB);
    const bf16* K = (const bf16*)(a.ws + WS_PROJ + 32 * MiB);
    const bf16* V = (const bf16*)(a.ws + WS_PROJ + 48 * MiB);
    bf16* MIXED = (bf16*)(a.ws + WS_MIXED);
    LAS float* Oacc = (LAS float*)(C.lds + AT_O); LAS float* Lacc = (LAS float*)(C.lds + AT_L); LAS char* vst = (LAS char*)(C.lds + AT_V + C.wave * 4096);
    float mq = fabsf(a.in[7][C.lane]), mk = fabsf(a.in[8][C.lane]);
#pragma unroll
    for (int o = 1; o < 64; o <<= 1) { mq = fmaxf(mq, __shfl_xor(mq, o)); mk = fmaxf(mk, __shfl_xor(mk, o)); }
    const float bound2 = 64.f * pg8::QSCALE * mq * mk * 1.01f;
    for (int item = C.vcu; item < NB * NH * 16; item += C.G) {
        const int span = item & 15, h = (item >> 4) & 7, b = item >> 7, t0 = span * 256, w = C.wave;
        for (int i = C.tid; i < (65536 + 1024) / 16; i += NTHR) *(LAS v4u*)(C.lds + 16 * i) = (v4u){0u, 0u, 0u, 0u};
        __syncthreads();
        const size_t hb = (size_t)(b * NH + h) * S * 64;
        const bf16 *Qh = Q + hb, *Kh = K + hb, *Vh = V + hb;
        const float slope2 = exp2f(-(float)(h + 1)) * 1.4426950408889634f;
        attn_unit(C, Qh, Kh, Vh, 1, t0 + 32 * w, 32, 32 * w, 1, slope2, bound2, Oacc, Lacc, vst);
        attn_unit(C, Qh, Kh, Vh, 4, t0 + (w >> 1) + 128 * (w & 1), 32, (w >> 1) + 128 * (w & 1), 4, slope2 * 4.f, bound2, Oacc, Lacc, vst);
#pragma unroll 1
        for (int cc = 0; cc < 2; ++cc) attn_unit(C, Qh, Kh, Vh, 16, t0 + 2 * w + cc, 16, 2 * w + cc, 16, slope2 * 16.f, bound2, Oacc, Lacc, vst);
        __syncthreads();
        {
            const int q = C.tid >> 1, hf = C.tid & 1;
            const float inv = 1.f / Lacc[q];
            const LAS f32x4* op = (const LAS f32x4*)(Oacc + q * 64 + 32 * hf);
            bf16* dst = MIXED + (size_t)(b * S + t0 + q) * D + 512 + h * 64 + 32 * hf;
#pragma unroll
            for (int j = 0; j < 4; ++j) { const f32x4 x0 = op[2 * j] * inv, x1 = op[2 * j + 1] * inv; v4u o; o.x = pk2(x0[0], x0[1]); o.y = pk2(x0[2], x0[3]); o.z = pk2(x1[0], x1[1]); o.w = pk2(x1[2], x1[3]); *(v4u*)(dst + 8 * j) = o; }
        }
        __syncthreads();
    }
}

__device__ __forceinline__ void p_router(const Ctx& C, const Args& a, int layer) {
    const float* X = a.out; const float* g = a.in[20] + (size_t)layer * D;
    const float* wr = a.in[21] + (size_t)layer * D * NE; const float* br = a.in[22] + layer * NE;
    bf16* XN = (bf16*)(a.ws + WS_XN); float* AFF = (float*)(a.ws + WS_AFF);
    LAS float* wl = (LAS float*)C.lds;
    for (int i = C.tid; i < D * 4; i += NTHR) { const int k = i >> 2, qd = i & 3; const f32x4 v = *(const f32x4*)(wr + (size_t)k * NE + 4 * qd);
        const int slot = ((k >> 8) * 4 + (k & 3)) * 64 + ((k >> 2) & 63); *(LAS f32x4*)(wl + slot * 20 + 4 * qd) = v; }
    __syncthreads();
    const int gw = C.vcu * NWAVES + C.wave, NGW = C.G * NWAVES;
    for (int m = gw; m < T; m += NGW) {
        const f32x4* xr = (const f32x4*)(X + (size_t)m * D) + C.lane;
        f32x4 v[4]; float s = 0.f;
#pragma unroll
        for (int j = 0; j < 4; ++j) { v[j] = xr[64 * j]; s += (v[j][0] * v[j][0] + v[j][1] * v[j][1]) + (v[j][2] * v[j][2] + v[j][3] * v[j][3]); }
        const float r = rsqrtf(wave_sum(s) * (1.f / D) + EPS);
        float acc[NE];
#pragma unroll
        for (int e = 0; e < NE; ++e) acc[e] = 0.f;
#pragma unroll
        for (int j = 0; j < 4; ++j) {
            const f32x4 w = ((const f32x4*)g)[C.lane + 64 * j];
            const f32x4 hv = v[j] * w * r;
            v2u o; o.x = pk2(hv[0], hv[1]); o.y = pk2(hv[2], hv[3]); ((v2u*)(XN + (size_t)m * D))[C.lane + 64 * j] = o;
#pragma unroll
            for (int i = 0; i < 4; ++i) {
                const LAS float* wp = wl + ((j * 4 + i) * 64 + C.lane) * 20;
#pragma unroll
                for (int qd = 0; qd < 4; ++qd) { const f32x4 ww = *(const LAS f32x4*)(wp + 4 * qd); acc[4 * qd] += hv[i] * ww[0]; acc[4 * qd + 1] += hv[i] * ww[1]; acc[4 * qd + 2] += hv[i] * ww[2]; acc[4 * qd + 3] += hv[i] * ww[3]; }
                if (i & 1) asm volatile("" ::: "memory");
            }
        }
        float mx = -1e30f;
#pragma unroll
        for (int e = 0; e < NE; ++e) { acc[e] = wave_sum(acc[e]) + br[e]; mx = fmaxf(mx, acc[e]); }
        float sum = 0.f;
#pragma unroll
        for (int e = 0; e < NE; ++e) { acc[e] = __expf(acc[e] - mx); sum += acc[e]; }
        float mine = 0.f;
#pragma unroll
        for (int e = 0; e < NE; ++e) if (C.lane == e) mine = acc[e];
        const int b = m / S, ss = m % S;
        if (C.lane < NE) AFF[((size_t)b * NE + C.lane) * S + ss] = mine / sum;
    }
    __syncthreads();
}

__device__ __forceinline__ void p_topk_gather(const Ctx& C, const Args& a) {
    const float* AFF = (const float*)(a.ws + WS_AFF);
    int* IDX = (int*)(a.ws + WS_IDX); float* GATE = (float*)(a.ws + WS_GATE); int* SLOT = (int*)(a.ws + WS_SLOT);
    const bf16* XN = (const bf16*)(a.ws + WS_XN); bf16* XG = (bf16*)(a.ws + WS_PROJ);
    LAS unsigned* red = (LAS unsigned*)C.lds;
    LAS int* lidx = (LAS int*)(C.lds + 1024);
    LAS int* misc = (LAS int*)(C.lds + 4096);
    for (int item = C.vcu; item < NB * NE * 4; item += C.G) {
        const int be = item >> 2, qt = item & 3, b = be / NE, e = be % NE;
        unsigned key[8];
        { const v4u k0 = *(const v4u*)(AFF + (size_t)be * S + 8 * C.tid), k1 = *(const v4u*)(AFF + (size_t)be * S + 8 * C.tid + 4);
          key[0] = k0.x; key[1] = k0.y; key[2] = k0.z; key[3] = k0.w; key[4] = k1.x; key[5] = k1.y; key[6] = k1.z; key[7] = k1.w; }
        unsigned cur = 0u;
        for (int bit = 30; bit >= 0; --bit) {
            const unsigned cand = cur | (1u << bit);
            unsigned c = 0;
#pragma unroll
            for (int j = 0; j < 8; ++j) c += (key[j] >= cand) ? 1u : 0u;
#pragma unroll
            for (int o = 1; o < 64; o <<= 1) c += __shfl_xor(c, o);
            const int par = bit & 1;
            if (C.lane == 0) red[par * 8 + C.wave] = c;
            __syncthreads();
            unsigned tot = 0;
#pragma unroll
            for (int w = 0; w < 8; ++w) tot += red[par * 8 + w];
            if (tot >= (unsigned)CAP) cur = cand;
        }
        unsigned cg = 0, ce = 0;
#pragma unroll
        for (int j = 0; j < 8; ++j) { cg += (key[j] > cur) ? 1u : 0u; ce += (key[j] == cur) ? 1u : 0u; }
        unsigned pk = cg | (ce << 16), inc = pk;
#pragma unroll
        for (int o = 1; o < 64; o <<= 1) { const unsigned t = __shfl_up(inc, o); if (C.lane >= o) inc += t; }
        __syncthreads();
        if (C.lane == 63) red[16 + C.wave] = inc;
        __syncthreads();
        unsigned woff = 0, total = 0;
#pragma unroll
        for (int w = 0; w < 8; ++w) { const unsigned t = red[16 + w]; if (w < C.wave) woff += t; total += t; }
        const unsigned exc = woff + inc - pk;
        const int ngt = (int)(total & 0xffffu), need = CAP - ngt;
        int gtb = (int)(exc & 0xffffu), eqb = (int)(exc >> 16);
        const bool mineq = (C.tid >> 7) == qt;
        if (C.tid == 128 * qt) misc[0] = gtb + (eqb < need ? eqb : need);
        if (C.tid == 128 * qt + 127) {
            int g2 = gtb, e2 = eqb;
#pragma unroll
            for (int j = 0; j < 8; ++j) { g2 += (key[j] > cur) ? 1 : 0; e2 += (key[j] == cur) ? 1 : 0; }
            misc[1] = g2 + (e2 < need ? e2 : need);
        }
        if (mineq) {
            int sl[8];
#pragma unroll
            for (int j = 0; j < 8; ++j) {
                const bool gt = key[j] > cur, eq = key[j] == cur;
                const bool sel = gt || (eq && eqb < need);
                const int pos = gtb + (eqb < need ? eqb : need);
                sl[j] = sel ? pos : -1;
                if (sel) { const int tok = 8 * C.tid + j; IDX[be * CAP + pos] = b * S + tok; GATE[be * CAP + pos] = __uint_as_float(key[j]); lidx[pos] = tok; }
                gtb += gt ? 1 : 0; eqb += eq ? 1 : 0;
            }
#pragma unroll
            for (int j = 0; j < 8; ++j) SLOT[((size_t)(b * S + 8 * C.tid + j)) * NE + e] = sl[j];
        }
        __syncthreads();
        const int p0 = misc[0], p1 = misc[1];
        for (int p = p0 + (C.tid >> 7); p < p1; p += 4) {
            const int tok = lidx[p];
            const v4u v = *(const v4u*)(XN + (size_t)(b * S + tok) * D + 8 * (C.tid & 127));
            *(v4u*)(XG + (size_t)(be * CAP + p) * D + 8 * (C.tid & 127)) = v;
        }
        __syncthreads();
    }
}

__device__ __forceinline__ void p_combine(const Ctx& C, const Args& a, bool with_norm) {
    float* X = a.out; const bf16* Y = (const bf16*)(a.ws + WS_PROJ); const int* SLOT = (const int*)(a.ws + WS_SLOT);
    bf16* XN = (bf16*)(a.ws + WS_XN); const float* g = a.in[10];
    const int gw = C.vcu * NWAVES + C.wave, NGW = C.G * NWAVES;
    for (int m = gw; m < T; m += NGW) {
        const int b = m / S;
        f32x4* xr = (f32x4*)(X + (size_t)m * D) + C.lane;
        f32x4 v[4];
#pragma unroll
        for (int j = 0; j < 4; ++j) v[j] = xr[64 * j];
        const int myslot = (C.lane < NE) ? SLOT[(size_t)m * NE + C.lane] : -1;
        for (int e = 0; e < NE; ++e) {
            const int sl = __shfl(myslot, e);
            if (sl >= 0) {
                const v2u* yr = (const v2u*)(Y + ((size_t)(b * NE + e) * CAP + sl) * D) + C.lane;
#pragma unroll
                for (int j = 0; j < 4; ++j) { const v2u y = yr[64 * j]; v[j][0] += bflo(y.x); v[j][1] += bfhi(y.x); v[j][2] += bflo(y.y); v[j][3] += bfhi(y.y); }
            }
        }
#pragma unroll
        for (int j = 0; j < 4; ++j) xr[64 * j] = v[j];
        if (with_norm) {
            float s = 0.f;
#pragma unroll
            for (int j = 0; j < 4; ++j) s += (v[j][0] * v[j][0] + v[j][1] * v[j][1]) + (v[j][2] * v[j][2] + v[j][3] * v[j][3]);
            const float r = rsqrtf(wave_sum(s) * (1.f / D) + EPS);
#pragma unroll
            for (int j = 0; j < 4; ++j) { const f32x4 w = ((const f32x4*)g)[C.lane + 64 * j]; v2u o; o.x = pk2(v[j][0] * r * w[0], v[j][1] * r * w[1]); o.y = pk2(v[j][2] * r * w[2], v[j][3] * r * w[3]); ((v2u*)(XN + (size_t)m * D))[C.lane + 64 * j] = o; }
        }
    }
}

__device__ __forceinline__ void p_s5_simple(const Ctx& C, const Args& a) {
    const bf16* XN = (const bf16*)(a.ws + WS_XN);
    float* YF = (float*)(a.ws + WS_PROJ); float* YB = (float*)(a.ws + WS_H);
    const float *lam_re = a.in[11], *lam_im = a.in[12], *log_dt = a.in[13], *b_re = a.in[14], *b_im = a.in[15], *c_re = a.in[16], *c_im = a.in[17];
    LAS float* us = (LAS float*)(C.lds + C.wave * 8192);
    LAS float* hs = us + 64 * 16;
    const int lane = C.lane;
    for (int job = C.wave * C.G + (int)blockIdx.x; job < NB * SG * 2; job += NWAVES * C.G) {
        const int dir = job & 1, g = (job >> 1) & 63, b = job >> 7;
        const int pg = dir * SG + g;
        const float lr = lam_re[pg * SP + lane], li = lam_im[pg * SP + lane], dt = expf(log_dt[pg]);
        const float mag = expf(lr * dt), ang = li * dt;
        const float lbr = mag * cosf(ang), lbi = mag * sinf(ang);
        const float den = lr * lr + li * li, nr = lbr - 1.f;
        const float fr = (nr * lr + lbi * li) / den, fi = (lbi * lr - nr * li) / den;
        float bbr[16], bbi[16];
#pragma unroll
        for (int c = 0; c < 16; ++c) { const float br_ = b_re[((size_t)pg * SP + lane) * SC + c], bi_ = b_im[((size_t)pg * SP + lane) * SC + c]; bbr[c] = fr * br_ - fi * bi_; bbi[c] = fr * bi_ + fi * br_; }
        const int oc = lane & 15, oq = lane >> 4;
        float cr[16], ci[16];
#pragma unroll
        for (int i = 0; i < 16; ++i) { cr[i] = c_re[((size_t)pg * SC + oc) * SP + oq * 16 + i]; ci[i] = c_im[((size_t)pg * SC + oc) * SP + oq * 16 + i]; }
        float hr = 0.f, hi = 0.f;
        float* yout = dir ? YB : YF;
        for (int t0 = 0; t0 < S; t0 += 64) {
            {
                const int tt = dir ? (S - 1 - (t0 + lane)) : (t0 + lane);
                const v4u* src = (const v4u*)(XN + (size_t)(b * S + tt) * D + g * 16);
                const v4u p0 = src[0], p1 = src[1];
                LAS float* d = us + lane * 16;
                d[0] = bflo(p0.x); d[1] = bfhi(p0.x); d[2] = bflo(p0.y); d[3] = bfhi(p0.y); d[4] = bflo(p0.z); d[5] = bfhi(p0.z); d[6] = bflo(p0.w); d[7] = bfhi(p0.w);
                d[8] = bflo(p1.x); d[9] = bfhi(p1.x); d[10] = bflo(p1.y); d[11] = bfhi(p1.y); d[12] = bflo(p1.z); d[13] = bfhi(p1.z); d[14] = bflo(p1.w); d[15] = bfhi(p1.w);
            }
            asm volatile("s_waitcnt lgkmcnt(0)" ::: "memory"); __builtin_amdgcn_wave_barrier();
            for (int i = 0; i < 64; ++i) {
                float bur = 0.f, bui = 0.f;
#pragma unroll
                for (int c = 0; c < 16; ++c) { const float u = us[i * 16 + c]; bur += u * bbr[c]; bui += u * bbi[c]; }
                const float nhr = lbr * hr - lbi * hi + bur, nhi = lbr * hi + lbi * hr + bui;
                hr = nhr; hi = nhi;
                hs[lane] = hr; hs[64 + lane] = hi;
                asm volatile("s_waitcnt lgkmcnt(0)" ::: "memory"); __builtin_amdgcn_wave_barrier();
                float acc = 0.f;
#pragma unroll
                for (int k = 0; k < 16; ++k) acc += hs[oq * 16 + k] * cr[k] - hs[64 + oq * 16 + k] * ci[k];
                acc += __shfl_xor(acc, 16); acc += __shfl_xor(acc, 32);
                const int tt = dir ? (S - 1 - (t0 + i)) : (t0 + i);
                if (lane < 16) yout[(size_t)(b * S + tt) * D + g * 16 + lane] = acc;
                asm volatile("s_waitcnt lgkmcnt(0)" ::: "memory"); __builtin_amdgcn_wave_barrier();
            }
        }
    }
}
__device__ __forceinline__ float gelu_t(float y) { const float u = 0.7978845608028654f * (y + 0.044715f * y * y * y); const float e = __builtin_amdgcn_exp2f(2.885390081777927f * u); const float th = 1.f - 2.f * __builtin_amdgcn_rcpf(e + 1.f); return 0.5f * y * (1.f + th); }
__device__ __forceinline__ void p_s5_post(const Ctx& C, const Args& a) {
    const float* X = a.out; const float* YF = (const float*)(a.ws + WS_PROJ); const float* YB = (const float*)(a.ws + WS_H);
    const float* g = a.in[10]; const float* dsk = a.in[18]; bf16* Z = (bf16*)(a.ws + WS_MIXED);
    const int gw = C.vcu * NWAVES + C.wave, NGW = C.G * NWAVES;
    for (int m = gw; m < T; m += NGW) {
        const f32x4* xr = (const f32x4*)(X + (size_t)m * D) + C.lane;
        f32x4 v[4]; float s = 0.f;
#pragma unroll
        for (int j = 0; j < 4; ++j) { v[j] = xr[64 * j]; s += (v[j][0] * v[j][0] + v[j][1] * v[j][1]) + (v[j][2] * v[j][2] + v[j][3] * v[j][3]); }
        const float r = rsqrtf(wave_sum(s) * (1.f / D) + EPS);
#pragma unroll
        for (int j = 0; j < 4; ++j) {
            const f32x4 w = ((const f32x4*)g)[C.lane + 64 * j], dd = ((const f32x4*)dsk)[C.lane + 64 * j];
            const f32x4 yf = ((const f32x4*)(YF + (size_t)m * D))[C.lane + 64 * j], yb = ((const f32x4*)(YB + (size_t)m * D))[C.lane + 64 * j];
            const f32x4 y = yf + yb + dd * (v[j] * w * r);
            v2u o; o.x = pk2(gelu_t(y[0]), gelu_t(y[1])); o.y = pk2(gelu_t(y[2]), gelu_t(y[3])); ((v2u*)(Z + (size_t)m * D))[C.lane + 64 * j] = o;
        }
    }
}

constexpr int NPHASE = 18;
__global__ void __launch_bounds__(NTHR, 2) mk_fwd(Args args) {
    extern __shared__ __attribute__((aligned(16))) unsigned char lds_raw[];
    Ctx C;
    C.lds = (LAS unsigned char*)lds_raw;
    C.tid = threadIdx.x; C.lane = C.tid & 63; C.wave = __builtin_amdgcn_readfirstlane(C.tid >> 6);
    C.G = gridDim.x; { const int bx = blockIdx.x; C.vcu = (C.G % 8 == 0) ? (bx % 8) * (C.G / 8) + bx / 8 : bx; }
    volatile LAS unsigned* MISC = (volatile LAS unsigned*)(C.lds + LDSCTL_OFF);
    for (int u = C.tid; u < (LDS_BYTES - LDSCTL_OFF) / 4; u += NTHR) ((LAS unsigned*)(C.lds + LDSCTL_OFF))[u] = 0u;
    __syncthreads();
    int lo = args.ph_lo, hi = args.ph_hi;
    unsigned char* ws = args.ws;
    asm volatile("" : "+s"(lo), "+s"(hi), "+s"(ws));
    unsigned* ctl = (unsigned*)(ws + WS_CTL);
    const bool one_launch = (lo == 0 && hi == NPHASE);
    XcdBarrier bar; bar.bar = ctl + CW_BAR; bar.x = 0; bar.st = nullptr;
    if (one_launch) bar = xcd_barrier_post(ctl + CW_BAR, MISC + 8);
    LAS unsigned char* glds = C.lds;
#ifndef MK_ONLY
#define MK_ONLY -1
#endif
#define IN(k) ((MK_ONLY < 0 || MK_ONLY == (k) || (MK_ONLY == 4 && (k) == 13) || (MK_ONLY == 5 && (k) == 14) || (MK_ONLY == 6 && (k) == 15) || (MK_ONLY == 7 && (k) == 16) || (MK_ONLY == 8 && (k) == 17)) && lo <= (k) && (k) < hi)
#define SEAM(k) do { if (IN(k) && IN((k) + 1)) xcd_barrier(bar); } while (0)

    if (IN(0)) { p0_prologue(C, args); } SEAM(0);
    if (IN(1)) {
        pg8::Gemm g{(const bf16*)(ws + WS_XN), (const bf16*)(ws + WS_WIN), D}; pg8::DenseOrder So; So.init(T, INC, C.G, (int)blockIdx.x);
        pg8::EpiProj E{(bf16*)(ws + WS_PROJ), (bf16*)(ws + WS_PROJ + 16 * MiB), args.in[7], args.in[8]};
        pg8::gemm_phase<pg8::EpiProj, pg8::DenseOrder, true, true>(glds, g, So, E);
    } SEAM(1);
    if (IN(2)) {
        for (int t = C.vcu; t < T / 32; t += C.G) conv_tile(C, args, t);
        attn_phase(C, args);
    } SEAM(2);
    if (IN(3)) {
        pg8::Gemm g{(const bf16*)(ws + WS_MIXED), (const bf16*)(ws + WS_WOUT), D}; pg8::DenseOrder So; So.init(T, D, C.G, (int)blockIdx.x);
        pg8::EpiRes E{args.in[0], args.out};
        pg8::gemm_phase<pg8::EpiRes, pg8::DenseOrder, true, true>(glds, g, So, E);
    } SEAM(3);
#define MOE_PHASES(layer, pb) do { \
        if (IN(pb)) { p_router(C, args, layer); } SEAM(pb); \
        if (IN(pb + 1)) { p_topk_gather(C, args); } SEAM(pb + 1); \
        if (IN(pb + 2)) { \
            pg8::Gemm g{(const bf16*)(ws + WS_PROJ), (const bf16*)(ws + WS_WEXP + layer * WEXP_LAYER + WEXP_GU), D}; pg8::ExpertOrder So; So.init(8, C.G, (int)blockIdx.x); \
            pg8::EpiSwiGLU E{(bf16*)(ws + WS_H)}; \
            pg8::gemm_phase<pg8::EpiSwiGLU, pg8::ExpertOrder, true, true>(glds, g, So, E); \
        } SEAM(pb + 2); \
        if (IN(pb + 3)) { \
            pg8::Gemm g{(const bf16*)(ws + WS_H), (const bf16*)(ws + WS_WEXP + layer * WEXP_LAYER + WEXP_DN), EH}; pg8::ExpertOrder So; So.init(4, C.G, (int)blockIdx.x); \
            pg8::EpiDown E{(bf16*)(ws + WS_PROJ), (const float*)(ws + WS_GATE)}; \
            pg8::gemm_phase<pg8::EpiDown, pg8::ExpertOrder, true, true>(glds, g, So, E); \
        } SEAM(pb + 3); \
        if (IN(pb + 4)) { p_combine(C, args, layer == 0); } \
    } while (0)
    MOE_PHASES(0, 4);
    SEAM(8);
    if (IN(9)) { p_s5_simple(C, args); } SEAM(9);
    if (IN(10)) {   } SEAM(10);
    if (IN(11)) { p_s5_post(C, args); } SEAM(11);
    if (IN(12)) {
        pg8::Gemm g{(const bf16*)(ws + WS_MIXED), (const bf16*)(ws + WS_WGLU), D}; pg8::DenseOrder So; So.init(T, 2 * D, C.G, (int)blockIdx.x);
        pg8::EpiGluRes E{args.out};
        pg8::gemm_phase<pg8::EpiGluRes, pg8::DenseOrder, true, true>(glds, g, So, E);
    } SEAM(12);
    MOE_PHASES(1, 13);
#undef IN
#undef SEAM
}

#ifndef MK_PER_PHASE
#define MK_PER_PHASE 0
#endif
extern "C" void kernel_launch(void* const* d_in, const int* in_sizes, int n_in, void* d_out, int out_size, void* d_ws, size_t ws_size, hipStream_t stream) {
    static int grid = 0;
    if (grid == 0) {
        if (n_in != 26 || out_size != T * D || ws_size < WS_END) { fprintf(stderr, "kernel_launch: unexpected shapes (n_in %d out %d ws %zu)\n", n_in, out_size, ws_size); grid = -1; return; }
        int dev = 0, cus = 0, per_cu = 0;
        if (hipGetDevice(&dev) != hipSuccess || hipDeviceGetAttribute(&cus, hipDeviceAttributeMultiprocessorCount, dev) != hipSuccess) { grid = -1; return; }
        if (hipFuncSetAttribute((const void*)mk_fwd, hipFuncAttributeMaxDynamicSharedMemorySize, LDS_BYTES) != hipSuccess) { fprintf(stderr, "kernel_launch: hipFuncSetAttribute failed\n"); grid = -1; return; }
        if (hipOccupancyMaxActiveBlocksPerMultiprocessor(&per_cu, (const void*)mk_fwd, NTHR, LDS_BYTES) != hipSuccess || per_cu < 1) { fprintf(stderr, "kernel_launch: occupancy query says %d blocks per CU\n", per_cu); (void)hipGetLastError(); grid = -1; return; }
        grid = cus;
    }
    if (grid < 0) return;
    (void)hipMemsetAsync((char*)d_ws + WS_CTL, 0, CTL_ZERO_BYTES, stream);
    Args a{};
    for (int i = 0; i < 26; ++i) a.in[i] = (const float*)d_in[i];
    a.out = (float*)d_out; a.ws = (unsigned char*)d_ws;
#if MK_PER_PHASE
    for (int p = 0; p < NPHASE; ++p) { a.ph_lo = p; a.ph_hi = p + 1; hipLaunchKernelGGL(mk_fwd, dim3(grid), dim3(NTHR), LDS_BYTES, stream, a); }
#else
    a.ph_lo = 0; a.ph_hi = NPHASE;
    hipLaunchKernelGGL(mk_fwd, dim3(grid), dim3(NTHR), LDS_BYTES, stream, a);
#endif
}
```

```cpp
#include <hip/hip_runtime.h>
#include <cstdint>
#include <cstdio>

namespace pg8 {
#define PG8_LAS __attribute__((address_space(3)))
typedef unsigned short bf16_t;
typedef short bf16x8 __attribute__((ext_vector_type(8)));
typedef float f32x4 __attribute__((ext_vector_type(4)));
typedef unsigned u32x4 __attribute__((ext_vector_type(4)));
constexpr int BM = 256, BK = 64, HALF = 128, HTB = HALF * BK * 2  , STAGE_BYTES = 8 * HTB, NXCD = 8, WGM = 8;

__host__ __device__ __forceinline__ int lds_byte(int r, int c) { const int st = (r >> 4) * 2 + (c >> 5), rr = r & 15, cc = c & 31, ob = rr * 64 + cc * 2; return st * 1024 + (ob ^ (((ob >> 9) & 1) << 5)); }
__host__ __device__ __forceinline__ void stage_rc(int b, int& R, int& C) { const int st = b / 1024, sb = b % 1024, swz = sb ^ (((sb >> 9) & 1) << 5); R = (st >> 1) * 16 + swz / 64; C = (st & 1) * 32 + (swz % 64) / 2; }
__host__ __device__ __forceinline__ int perm32(int rho) { const int n = rho >> 4, i = rho & 15; return 8 * (i >> 2) + 4 * n + (i & 3); }

struct Unit { int pm, pn, pb; };
struct Gemm { const bf16_t* A; const bf16_t* Bt; int K; };

struct DenseOrder {
    int nM, nN, nwg, G, c;
    __device__ void init(int M, int N, int G_, int c_) { nM = M / BM; nN = N / BM; nwg = nM * nN; G = G_; c = c_; }
    __device__ bool next(int i, Unit& u) const {
        const long L = (long)i * G + c; if (L >= nwg) return false;
        int wgid = (int)L; { const int q = nwg / NXCD, r = nwg % NXCD, xcd = wgid % NXCD, off = wgid / NXCD; wgid = (xcd < r ? xcd * (q + 1) : r * (q + 1) + (xcd - r) * q) + off; }
        const int nig = WGM * nN, gid = wgid / nig, fm = gid * WGM, gsz = (nM - fm) < WGM ? (nM - fm) : WGM;
        u.pm = fm + ((wgid % nig) % gsz); u.pn = (wgid % nig) / gsz; u.pb = u.pn; return true;
    }
    __device__ __forceinline__ void a_ready(const Unit&) const {}
    __device__ __forceinline__ void done(const Unit&) const {}
};
struct ExpertOrder {
    int nN, nun, G, c;
    __device__ void init(int nN_, int G_, int c_) { nN = nN_; nun = 128 * nN_; G = G_; c = c_; }
    __device__ bool next(int i, Unit& u) const {
        const long L = (long)i * G + c; if (L >= nun) return false;
        int V = (int)L;
        if (G == 256) V = i * 256 + (c & 7) * 32 + (c >> 3);
        const int per = 8 * nN, e = V / per, r = V % per, pml = r / nN, pn = r % nN;
        u.pm = ((pml >> 1) * 16 + e) * 2 + (pml & 1); u.pn = pn; u.pb = e * nN + pn; return true;
    }
    __device__ __forceinline__ void a_ready(const Unit&) const {}
    __device__ __forceinline__ void done(const Unit&) const {}
};

typedef float f32x2 __attribute__((ext_vector_type(2)));
typedef __bf16 bf16x2_t __attribute__((ext_vector_type(2)));
__device__ __forceinline__ unsigned pk2(float lo, float hi) { f32x2 v = {lo, hi}; bf16x2_t b = __builtin_convertvector(v, bf16x2_t); return __builtin_bit_cast(unsigned, b); }
__device__ __forceinline__ float sigm(float x) { return __builtin_amdgcn_rcpf(1.f + __builtin_amdgcn_exp2f(-1.4426950408889634f * x)); }

constexpr float QSCALE = 0.125f * 1.4426950408889634f;
struct EpiProj {
    static constexpr bool PERM = true, AFTER_DRAIN = false;
    bf16_t *GLU, *Q; const float *qg, *kg;
    __device__ __forceinline__ void operator()(const f32x4 (&acc)[2][2][4][2], const Unit& u, int wr, int wc, int fr, int fq) const {
        const int row0 = u.pm * BM + wr * 64 + fr;
        if (u.pn < 4) {
            const int col0 = 128 * u.pn + 32 * wc + 8 * fq;
#pragma unroll
            for (int ai = 0; ai < 2; ++ai)
#pragma unroll
                for (int m = 0; m < 4; ++m) {
                    const f32x4 v0 = acc[ai][0][m][0], v1 = acc[ai][0][m][1], g0 = acc[ai][1][m][0], g1 = acc[ai][1][m][1];
                    u32x4 w; w.x = pk2(v0[0] * sigm(g0[0]), v0[1] * sigm(g0[1])); w.y = pk2(v0[2] * sigm(g0[2]), v0[3] * sigm(g0[3]));
                    w.z = pk2(v1[0] * sigm(g1[0]), v1[1] * sigm(g1[1])); w.w = pk2(v1[2] * sigm(g1[2]), v1[3] * sigm(g1[3]));
                    *(u32x4*)(GLU + (size_t)(row0 + ai * HALF + m * 16) * 512 + col0) = w;
                    asm volatile("" ::: "memory");
                }
        } else {
            const int t = (u.pn - 4) >> 1;
            const int hd = 4 * ((u.pn - 4) & 1) + wc;
            bf16_t* dst = Q + (size_t)t * (size_t)(8u << 20);
            const float* gp = (const float*)((uintptr_t)qg + (((uintptr_t)kg - (uintptr_t)qg) & (uintptr_t)(t == 0 ? 0 : ~(uintptr_t)0)));
#pragma unroll
            for (int ai = 0; ai < 2; ++ai)
#pragma unroll
                for (int m = 0; m < 4; ++m) {
                    float ss = 0.f;
#pragma unroll
                    for (int bj = 0; bj < 2; ++bj)
#pragma unroll
                        for (int n = 0; n < 2; ++n) { const f32x4 x = acc[ai][bj][m][n]; ss += (x[0] * x[0] + x[1] * x[1]) + (x[2] * x[2] + x[3] * x[3]); }
                    ss += __shfl_xor(ss, 16); ss += __shfl_xor(ss, 32);
                    float rs = 1.f;
                    if (t < 2) rs = rsqrtf(ss * (1.f / 64.f) + 1e-6f) * (t == 0 ? QSCALE : 1.f);
#pragma unroll
                    for (int bj = 0; bj < 2; ++bj) {
                        f32x4 g0 = {1.f, 1.f, 1.f, 1.f}, g1 = g0;
                        if (t < 2) { g0 = *(const f32x4*)(gp + 32 * bj + 8 * fq); g1 = *(const f32x4*)(gp + 32 * bj + 8 * fq + 4); }
                        const f32x4 a = acc[ai][bj][m][0] * g0 * rs, b = acc[ai][bj][m][1] * g1 * rs;
                        u32x4 w; w.x = pk2(a[0], a[1]); w.y = pk2(a[2], a[3]); w.z = pk2(b[0], b[1]); w.w = pk2(b[2], b[3]);
                        const int row = row0 + ai * HALF + m * 16;
                        *(u32x4*)(dst + ((size_t)((row >> 12) * 8 + hd) * 4096 + (row & 4095)) * 64 + 32 * bj + 8 * fq) = w;
                    }
                    asm volatile("" ::: "memory");
                }
        }
    }
};
struct EpiRes {
    static constexpr bool PERM = false, AFTER_DRAIN = false;
    const float* xin; float* X;
    __device__ __forceinline__ void operator()(const f32x4 (&acc)[2][2][4][2], const Unit& u, int wr, int wc, int fr, int fq) const {
        const int row0 = u.pm * BM + wr * 64 + fr, col0 = u.pn * BM + wc * 32 + 4 * fq;
#pragma unroll
        for (int ai = 0; ai < 2; ++ai)
#pragma unroll
            for (int m = 0; m < 4; ++m) { const size_t off = (size_t)(row0 + ai * HALF + m * 16) * 1024 + col0;
#pragma unroll
                for (int bj = 0; bj < 2; ++bj)
#pragma unroll
                    for (int n = 0; n < 2; ++n) { const f32x4 r = *(const f32x4*)(xin + off + bj * HALF + n * 16); *(f32x4*)(X + off + bj * HALF + n * 16) = r + acc[ai][bj][m][n]; } }
    }
};
struct EpiSwiGLU {
    static constexpr bool PERM = true, AFTER_DRAIN = false;
    bf16_t* H;
    __device__ __forceinline__ void operator()(const f32x4 (&acc)[2][2][4][2], const Unit& u, int wr, int wc, int fr, int fq) const {
        const int row0 = u.pm * BM + wr * 64 + fr, col0 = 128 * u.pn + 32 * wc + 8 * fq;
#pragma unroll
        for (int ai = 0; ai < 2; ++ai)
#pragma unroll
            for (int m = 0; m < 4; ++m) {
                const f32x4 g0 = acc[ai][0][m][0], g1 = acc[ai][0][m][1], u0 = acc[ai][1][m][0], u1 = acc[ai][1][m][1];
                u32x4 w; w.x = pk2(g0[0] * sigm(g0[0]) * u0[0], g0[1] * sigm(g0[1]) * u0[1]); w.y = pk2(g0[2] * sigm(g0[2]) * u0[2], g0[3] * sigm(g0[3]) * u0[3]);
                w.z = pk2(g1[0] * sigm(g1[0]) * u1[0], g1[1] * sigm(g1[1]) * u1[1]); w.w = pk2(g1[2] * sigm(g1[2]) * u1[2], g1[3] * sigm(g1[3]) * u1[3]);
                *(u32x4*)(H + (size_t)(row0 + ai * HALF + m * 16) * 1024 + col0) = w;
            }
    }
};
struct EpiDown {
    static constexpr bool PERM = true, AFTER_DRAIN = false;
    bf16_t* Y; const float* gate;
    __device__ __forceinline__ void operator()(const f32x4 (&acc)[2][2][4][2], const Unit& u, int wr, int wc, int fr, int fq) const {
        const int row0 = u.pm * BM + wr * 64 + fr, col0 = u.pn * BM + wc * 32 + 8 * fq;
#pragma unroll
        for (int ai = 0; ai < 2; ++ai)
#pragma unroll
            for (int m = 0; m < 4; ++m) { const int row = row0 + ai * HALF + m * 16; const float gs = gate[row];
#pragma unroll
                for (int bj = 0; bj < 2; ++bj) { const f32x4 a = acc[ai][bj][m][0] * gs, b = acc[ai][bj][m][1] * gs;
                    u32x4 w; w.x = pk2(a[0], a[1]); w.y = pk2(a[2], a[3]); w.z = pk2(b[0], b[1]); w.w = pk2(b[2], b[3]);
                    *(u32x4*)(Y + (size_t)row * 1024 + col0 + bj * HALF) = w; } }
    }
};
struct EpiGluRes {
    static constexpr bool PERM = false, AFTER_DRAIN = false;
    float* X;
    __device__ __forceinline__ void operator()(const f32x4 (&acc)[2][2][4][2], const Unit& u, int wr, int wc, int fr, int fq) const {
        const int row0 = u.pm * BM + wr * 64 + fr, col0 = 128 * u.pn + 32 * wc + 4 * fq;
#pragma unroll
        for (int ai = 0; ai < 2; ++ai)
#pragma unroll
            for (int m = 0; m < 4; ++m) { float* p = X + (size_t)(row0 + ai * HALF + m * 16) * 1024 + col0;
#pragma unroll
                for (int n = 0; n < 2; ++n) { const f32x4 v = acc[ai][0][m][n], g = acc[ai][1][m][n]; f32x4 r = *(const f32x4*)(p + n * 16);
                    r[0] += v[0] * sigm(g[0]); r[1] += v[1] * sigm(g[1]); r[2] += v[2] * sigm(g[2]); r[3] += v[3] * sigm(g[3]); *(f32x4*)(p + n * 16) = r; } }
    }
};

template <class Epi, class Sched, bool ALIGN_EPI = false, bool SP2 = false>
__device__ __forceinline__ void gemm_phase(PG8_LAS unsigned char* lds, const Gemm g, const Sched& S, const Epi& E) {
    const int tid = threadIdx.x, wid = __builtin_amdgcn_readfirstlane(tid >> 6), lane = tid & 63, wr = wid >> 2, wc = wid & 3, fr = lane & 15, fq = lane >> 4;
    const int K = g.K, nt = K / BK;
    unsigned voffA[2], voffB[2];
#pragma unroll
    for (int i = 0; i < 2; ++i) { int R, C; stage_rc(tid * 16 + i * 8192, R, C); const int Rb = Epi::PERM ? ((R & ~31) + perm32(R & 31)) : R;
        voffA[i] = (unsigned)(R * K + C) * 2u; voffB[i] = (unsigned)(Rb * K + C) * 2u; }
    const size_t kstep = (size_t)(BK * 2);
    const size_t hstep = (size_t)HALF * K * 2;
    const size_t tstep = 2 * hstep;
    const unsigned ldsw = (unsigned)wid * 1024u;
    const int aoff = lds_byte(wr * 64 + fr, fq * 8), boff = lds_byte(wc * 32 + fr, fq * 8);
#define PG8_SA(b, h) (((b) * 2 + (h)) * HTB)
#define PG8_SB(b, h) ((4 + (b) * 2 + (h)) * HTB)
#define PG8_STAGE(bufoff, gbase, voff) do { _Pragma("unroll") for (int _i = 0; _i < 2; ++_i) \
        __builtin_amdgcn_global_load_lds((const unsigned*)((const char*)(gbase) + (voff)[_i]), (PG8_LAS unsigned*)(lds + (bufoff) + ldsw + _i * 8192), 16, 0, 0); } while (0)
#define PG8_LDA(dst, b, h) do { _Pragma("unroll") for (int m = 0; m < 4; ++m) _Pragma("unroll") for (int k = 0; k < 2; ++k) dst[m][k] = *(const PG8_LAS bf16x8*)(lds + PG8_SA(b, h) + aoff + m * 2048 + k * 1024); } while (0)
#define PG8_LDB(dst, b, h) do { _Pragma("unroll") for (int n = 0; n < 2; ++n) _Pragma("unroll") for (int k = 0; k < 2; ++k) dst[n][k] = *(const PG8_LAS bf16x8*)(lds + PG8_SB(b, h) + boff + n * 2048 + k * 1024); } while (0)
#define PG8_MMA(ai, bj, At, Bt) do { __builtin_amdgcn_s_setprio(1); _Pragma("unroll") for (int m = 0; m < 4; ++m) _Pragma("unroll") for (int n = 0; n < 2; ++n) _Pragma("unroll") for (int k = 0; k < 2; ++k) \
        acc[ai][bj][m][n] = __builtin_amdgcn_mfma_f32_16x16x32_bf16(Bt[n][k], At[m][k], acc[ai][bj][m][n], 0, 0, 0); __builtin_amdgcn_s_setprio(0); } while (0)
#define PG8_WAIT_V(n) asm volatile("s_waitcnt vmcnt(" #n ")" ::: "memory")
#define PG8_WAIT_L(n) asm volatile("s_waitcnt lgkmcnt(" #n ")" ::: "memory")
#define PG8_BAR __builtin_amdgcn_s_barrier()
#define PG8_SCHED __builtin_amdgcn_sched_barrier(0)
    Unit cur, nxt; int ui = 0;
    if (!S.next(0, cur)) return;
    f32x4 acc[2][2][4][2];
#pragma unroll
    for (int a = 0; a < 2; ++a)
#pragma unroll
        for (int b = 0; b < 2; ++b)
#pragma unroll
            for (int m = 0; m < 4; ++m)
#pragma unroll
                for (int n = 0; n < 2; ++n) acc[a][b][m][n] = (f32x4){0.f, 0.f, 0.f, 0.f};
    bf16x8 At[4][2], B0[2][2], B1[2][2];
    const char* cA = (const char*)g.A + (size_t)cur.pm * tstep; const char* cB = (const char*)g.Bt + (size_t)cur.pb * tstep;
    S.a_ready(cur);
    if constexpr (SP2) {
        PG8_STAGE(PG8_SB(0, 0), cB, voffB); PG8_STAGE(PG8_SB(0, 1), cB + hstep, voffB); PG8_STAGE(PG8_SA(0, 0), cA, voffA); PG8_STAGE(PG8_SA(0, 1), cA + hstep, voffA);
        if (wr == 1) PG8_BAR;
        PG8_WAIT_V(2); PG8_BAR;
        PG8_STAGE(PG8_SB(1, 0), cB + kstep, voffB); PG8_STAGE(PG8_SA(1, 0), cA + kstep, voffA); PG8_STAGE(PG8_SB(1, 1), cB + hstep + kstep, voffB);
        PG8_WAIT_V(6); PG8_BAR;
    } else {
        PG8_STAGE(PG8_SB(0, 0), cB, voffB); PG8_STAGE(PG8_SA(0, 0), cA, voffA); PG8_STAGE(PG8_SB(0, 1), cB + hstep, voffB); PG8_STAGE(PG8_SA(0, 1), cA + hstep, voffA);
        if (wr == 1) PG8_BAR;
        PG8_WAIT_V(4); PG8_BAR;
        PG8_STAGE(PG8_SB(1, 0), cB + kstep, voffB); PG8_STAGE(PG8_SA(1, 0), cA + kstep, voffA); PG8_STAGE(PG8_SB(1, 1), cB + hstep + kstep, voffB);
        PG8_WAIT_V(6); PG8_BAR;
    }
    for (;;) {
        const bool has_next = S.next(ui + 1, nxt);
        const char* nA = has_next ? (const char*)g.A + (size_t)nxt.pm * tstep : cA; const char* nB = has_next ? (const char*)g.Bt + (size_t)nxt.pb * tstep : cB;
        for (int t = 0; t < nt; t += 2) {
            const bool last = (t == nt - 2);
            const char* a1 = cA + (size_t)(t + 1) * kstep;
            const char* a2 = last ? nA : cA + (size_t)(t + 2) * kstep; const char* b2 = last ? nB : cB + (size_t)(t + 2) * kstep;
            const char* a3 = a2 + kstep; const char* b3 = b2 + kstep;
            if (last && has_next) S.a_ready(nxt);
            if constexpr (SP2) {
            PG8_LDB(B0, 0, 0); PG8_LDB(B1, 0, 1); PG8_SCHED; PG8_LDA(At, 0, 0); PG8_STAGE(PG8_SA(1, 1), a1 + hstep, voffA);
            PG8_WAIT_V(8); PG8_WAIT_L(0); PG8_BAR; PG8_MMA(0, 0, At, B0); PG8_MMA(0, 1, At, B1); PG8_BAR; PG8_SCHED;
            PG8_LDA(At, 0, 1); PG8_STAGE(PG8_SB(0, 0), b2, voffB); PG8_STAGE(PG8_SB(0, 1), b2 + hstep, voffB); PG8_STAGE(PG8_SA(0, 0), a2, voffA);
            PG8_WAIT_V(8); PG8_WAIT_L(0); PG8_BAR; PG8_MMA(1, 0, At, B0); PG8_MMA(1, 1, At, B1); PG8_BAR; PG8_SCHED;
            PG8_LDB(B0, 1, 0); PG8_LDB(B1, 1, 1); PG8_SCHED; PG8_LDA(At, 1, 0); PG8_STAGE(PG8_SA(0, 1), a2 + hstep, voffA);
            PG8_WAIT_V(8); PG8_WAIT_L(0); PG8_BAR; PG8_MMA(0, 0, At, B0); PG8_MMA(0, 1, At, B1); PG8_BAR; PG8_SCHED;
            PG8_LDA(At, 1, 1); PG8_STAGE(PG8_SB(1, 0), b3, voffB); PG8_STAGE(PG8_SB(1, 1), b3 + hstep, voffB); PG8_STAGE(PG8_SA(1, 0), a3, voffA);
            PG8_WAIT_V(8); PG8_WAIT_L(0); PG8_BAR; PG8_MMA(1, 0, At, B0); PG8_MMA(1, 1, At, B1); PG8_BAR; PG8_SCHED;
            } else {
            PG8_LDB(B0, 0, 0); PG8_SCHED; PG8_LDA(At, 0, 0); PG8_STAGE(PG8_SA(1, 1), a1 + hstep, voffA);
            PG8_WAIT_L(8); PG8_BAR; PG8_WAIT_L(0); PG8_MMA(0, 0, At, B0); PG8_BAR; PG8_SCHED;
            PG8_LDB(B1, 0, 1); PG8_STAGE(PG8_SB(0, 0), b2, voffB);
            PG8_BAR; PG8_WAIT_L(0); PG8_MMA(0, 1, At, B1); PG8_BAR;
            PG8_LDA(At, 0, 1); PG8_STAGE(PG8_SA(0, 0), a2, voffA);
            PG8_BAR; PG8_WAIT_L(0); PG8_MMA(1, 0, At, B0); PG8_BAR; PG8_SCHED;
            PG8_STAGE(PG8_SB(0, 1), b2 + hstep, voffB);
            PG8_WAIT_V(6); PG8_BAR; PG8_MMA(1, 1, At, B1); PG8_BAR;
            PG8_LDB(B0, 1, 0); PG8_SCHED; PG8_LDA(At, 1, 0); PG8_STAGE(PG8_SA(0, 1), a2 + hstep, voffA);
            PG8_WAIT_L(8); PG8_BAR; PG8_WAIT_L(0); PG8_MMA(0, 0, At, B0); PG8_BAR; PG8_SCHED;
            PG8_LDB(B1, 1, 1); PG8_STAGE(PG8_SB(1, 0), b3, voffB);
            PG8_BAR; PG8_WAIT_L(0); PG8_MMA(0, 1, At, B1); PG8_BAR;
            PG8_LDA(At, 1, 1); PG8_STAGE(PG8_SA(1, 0), a3, voffA);
            PG8_BAR; PG8_WAIT_L(0); PG8_MMA(1, 0, At, B0); PG8_BAR; PG8_SCHED;
            PG8_STAGE(PG8_SB(1, 1), b3 + hstep, voffB);
            PG8_WAIT_V(6); PG8_BAR; PG8_MMA(1, 1, At, B1); PG8_BAR;
            }
        }
        if constexpr (ALIGN_EPI) { if (wr == 0) PG8_BAR; }
        if constexpr (!Epi::AFTER_DRAIN) { E(acc, cur, wr, wc, fr, fq); S.done(cur); }
        if (!has_next) break;
#pragma unroll
        for (int a = 0; a < 2; ++a)
#pragma unroll
            for (int b = 0; b < 2; ++b)
#pragma unroll
                for (int m = 0; m < 4; ++m)
#pragma unroll
                    for (int n = 0; n < 2; ++n) acc[a][b][m][n] = (f32x4){0.f, 0.f, 0.f, 0.f};
        cur = nxt; cA = nA; cB = nB; ++ui;
        if constexpr (ALIGN_EPI) { if (wr == 1) PG8_BAR; }
    }
    PG8_WAIT_V(0);
    if constexpr (!ALIGN_EPI) { if (wr == 0) PG8_BAR; }
    PG8_BAR;
    if constexpr (Epi::AFTER_DRAIN) { E.fused(acc, cur, wr, wc, fr, fq, lds, wid, lane); S.done(cur); }
#undef PG8_SA
#undef PG8_SB
#undef PG8_STAGE
#undef PG8_LDA
#undef PG8_LDB
#undef PG8_MMA
#undef PG8_WAIT_V
#undef PG8_WAIT_L
#undef PG8_BAR
#undef PG8_SCHED
}
}

constexpr int NB = 4, S = 4096, D = 1024, T = NB * S;
constexpr int CONV_CH = 512, CONV_W = 31, NH = 8, INC = 2560;
constexpr int SG = 64, SC = 16, SP = 64;
constexpr int NE = 16, CAP = 512, EH = 1024, MR = NB * NE * CAP;
constexpr float EPS = 1e-6f;
constexpr int NWAVES = 8, NTHR = NWAVES * 64;

constexpr size_t MiB = 1u << 20;
constexpr size_t WS_CTL = 0, CTL_ZERO_BYTES = 64 * 1024;
constexpr size_t WS_AFF = 1 * MiB, WS_IDX = 2 * MiB, WS_GATE = 2 * MiB + 512 * 1024, WS_SLOT = 3 * MiB;
constexpr size_t WS_WIN = 4 * MiB, WS_WOUT = 10 * MiB, WS_WGLU = 12 * MiB;
constexpr size_t WS_WEXP = 16 * MiB, WEXP_LAYER = 96 * MiB, WEXP_GU = 0, WEXP_DN = 64 * MiB;
constexpr size_t WS_XN = 208 * MiB, WS_MIXED = 240 * MiB;
constexpr size_t WS_PROJ = 272 * MiB;
constexpr size_t WS_H = 336 * MiB;
constexpr size_t WS_END = 404 * MiB;
constexpr int CW_BAR = 1024;

constexpr int SCRATCH_BYTES = 143360;
constexpr int LDSCTL_OFF = SCRATCH_BYTES;
constexpr int LDS_BYTES = 147456;

#define GAS __attribute__((address_space(1)))
#define LAS __attribute__((address_space(3)))
typedef unsigned short bf16;
typedef unsigned v4u __attribute__((ext_vector_type(4)));
typedef unsigned v2u __attribute__((ext_vector_type(2)));
typedef float f32x4 __attribute__((ext_vector_type(4)));
typedef float f32x2 __attribute__((ext_vector_type(2)));
using pg8::pk2;
using pg8::sigm;
__device__ __forceinline__ float bf2f(unsigned short h) { return __uint_as_float(((unsigned)h) << 16); }
__device__ __forceinline__ float bflo(unsigned w) { return __uint_as_float(w << 16); }
__device__ __forceinline__ float bfhi(unsigned w) { return __uint_as_float(w & 0xffff0000u); }
__device__ __forceinline__ float wave_sum(float v) {
#pragma unroll
    for (int o = 1; o < 64; o <<= 1) v += __shfl_xor(v, o);
    return v;
}

#define XB_TMO      128
#define XB_XCNT(j)  (256  + 64 * (j))
#define XB_XSUB(j)  (1280 + 64 * (j))
#define XB_XGEN(j)  (2304 + 64 * (j))
#define XB_TOP      3328
#define XB_TOPGEN   3392
#define XCD_BAR_WORDS 3456
#define XB_SPIN_CAP (1u << 18)
__device__ __forceinline__ unsigned xb_ld(unsigned* p)              { return __hip_atomic_load(p, __ATOMIC_RELAXED, __HIP_MEMORY_SCOPE_AGENT); }
__device__ __forceinline__ unsigned xb_add(unsigned* p, unsigned v) { return __hip_atomic_fetch_add(p, v, __ATOMIC_RELAXED, __HIP_MEMORY_SCOPE_AGENT); }
__device__ __forceinline__ unsigned xb_xcc_id() { return (unsigned)__builtin_amdgcn_s_getreg((3 << 11) | 20) & 0xFu; }
#define XB_SPIN(cond, bar) do { unsigned _sp = 0; while (cond) { __builtin_amdgcn_s_sleep(1); \
    if ((++_sp & 255u) == 0u) { if (xb_ld(&(bar)[XB_TMO])) break; if (_sp > XB_SPIN_CAP) { atomicAdd(&(bar)[XB_TMO], 1u); break; } } } } while (0)
struct XcdBarrier { unsigned* bar; unsigned x; volatile LAS unsigned* st; };
__device__ __forceinline__ XcdBarrier xcd_barrier_post(unsigned* bar, volatile LAS unsigned* st) {
    XcdBarrier b; b.bar = bar; b.x = xb_xcc_id(); b.st = st;
    if (threadIdx.x == 0) (void)xb_add(&bar[XB_XCNT(b.x)], 1u);
    return b;
}
__device__ __forceinline__ void xcd_barrier_complete(unsigned* bar, unsigned x, unsigned& nloc, unsigned& nx) {
    const unsigned G = gridDim.x * gridDim.y * gridDim.z;
    unsigned sum, cnt, mine, sp = 0u;
    for (;;) {
        sum = 0u; cnt = 0u; mine = 0u;
#pragma unroll
        for (unsigned j = 0; j < 16; ++j) { const unsigned c = xb_ld(&bar[XB_XCNT(j)]); sum += c; cnt += (c > 0u) ? 1u : 0u; mine = (j == x) ? c : mine; }
        if (sum == G) break;
        __builtin_amdgcn_s_sleep(1);
        if ((++sp & 255u) == 0u) { if (xb_ld(&bar[XB_TMO])) break; if (sp > XB_SPIN_CAP) { atomicAdd(&bar[XB_TMO], 1u); break; } }
    }
    nloc = mine > 0u ? mine : 1u; nx = cnt > 0u ? cnt : 1u;
}
__device__ __forceinline__ void xcd_barrier(const XcdBarrier& b) {
    asm volatile("s_waitcnt vmcnt(0)" ::: "memory");
    __syncthreads();
    if (threadIdx.x == 0) {
        unsigned* bar = b.bar;
        __builtin_amdgcn_s_waitcnt(0);
        unsigned nloc = b.st[0], nx = b.st[1];
        if (nloc == 0u) { xcd_barrier_complete(bar, b.x, nloc, nx); b.st[0] = nloc; b.st[1] = nx; }
        const unsigned old = xb_add(&bar[XB_XSUB(b.x)], 1u);
        const unsigned gen = old / nloc;
        if (old + 1u == (gen + 1u) * nloc) {
            __builtin_amdgcn_fence(__ATOMIC_RELEASE, "agent");
            asm volatile("s_waitcnt vmcnt(0)" ::: "memory");
            const unsigned og = xb_add(&bar[XB_TOP], 1u);
            const unsigned tg = og / nx;
            if (og + 1u == (tg + 1u) * nx) xb_add(&bar[XB_TOPGEN], 1u);
            else XB_SPIN(xb_ld(&bar[XB_TOPGEN]) == tg, bar);
            __builtin_amdgcn_fence(__ATOMIC_ACQUIRE, "agent");
            xb_add(&bar[XB_XGEN(b.x)], 1u);
            asm volatile("s_waitcnt vmcnt(0)" ::: "memory");
        } else {
            XB_SPIN(xb_ld(&bar[XB_XGEN(b.x)]) == gen, bar);
            __builtin_amdgcn_fence(__ATOMIC_ACQUIRE, "agent");
            asm volatile("s_waitcnt vmcnt(0)" ::: "memory");
        }
    }
    __syncthreads();
}

struct Args {
    const float* in[26]; float* out; unsigned char* ws; int ph_lo, ph_hi;
};
struct Ctx { LAS unsigned char* lds; int tid, lane, wave, vcu, G; };

__device__ __forceinline__ int rowmap(int kind, int half, int n) {
    if (kind == 0) {
        if (n < 1024) { const int hf = n >> 9, r = n & 511; return 256 * (r >> 7) + 128 * hf + (r & 127); }
        const int pn = n >> 8, w = n & 255, wc = w >> 6, bj = (w >> 5) & 1, j = w & 31; return 256 * pn + 128 * bj + 32 * wc + j;
    }
    if (kind == 2) { const int hf = n >> 10, r = n & 1023; return 256 * (r >> 7) + 128 * hf + (r & 127); }
    if (kind == 3) return 256 * (n >> 7) + 128 * half + (n & 127);
    return n;
}
__device__ __forceinline__ void conv_item(const float* __restrict__ W, int N, bf16* __restrict__ WT, int kind, int half, int kb, int nb, LAS float* scr, int lane) {
    const int k0 = 64 * kb, n0 = 64 * nb;
#pragma unroll 4
    for (int it = 0; it < 16; ++it) {
        const int kk = 4 * it + (lane >> 4), nn = 4 * (lane & 15);
        const f32x4 v = *(const f32x4*)(W + (size_t)(k0 + kk) * N + n0 + nn);
        scr[kk * 65 + nn] = v[0]; scr[kk * 65 + nn + 1] = v[1]; scr[kk * 65 + nn + 2] = v[2]; scr[kk * 65 + nn + 3] = v[3];
    }
    asm volatile("s_waitcnt lgkmcnt(0)" ::: "memory");
    const int kc = lane & 7;
#pragma unroll
    for (int jt = 0; jt < 8; ++jt) {
        const int nl = 8 * jt + (lane >> 3);
        const LAS float* s = scr + (8 * kc) * 65 + nl;
        v4u o; o.x = pk2(s[0], s[65]); o.y = pk2(s[2 * 65], s[3 * 65]); o.z = pk2(s[4 * 65], s[5 * 65]); o.w = pk2(s[6 * 65], s[7 * 65]);
        *(v4u*)(WT + (size_t)rowmap(kind, half, n0 + nl) * 1024 + k0 + 8 * kc) = o;
    }
    asm volatile("s_waitcnt lgkmcnt(0)" ::: "memory");
}
__device__ __forceinline__ void rms_row_bf16(const float* __restrict__ xrow, const float* __restrict__ g, bf16* __restrict__ orow, int lane) {
    const f32x4* xr = (const f32x4*)xrow + lane;
    f32x4 v[4]; float s = 0.f;
#pragma unroll
    for (int j = 0; j < 4; ++j) { v[j] = xr[64 * j]; s += (v[j][0] * v[j][0] + v[j][1] * v[j][1]) + (v[j][2] * v[j][2] + v[j][3] * v[j][3]); }
    const float r = rsqrtf(wave_sum(s) * (1.f / D) + EPS);
#pragma unroll
    for (int j = 0; j < 4; ++j) { const f32x4 w = ((const f32x4*)g)[lane + 64 * j]; v2u o; o.x = pk2(v[j][0] * r * w[0], v[j][1] * r * w[1]); o.y = pk2(v[j][2] * r * w[2], v[j][3] * r * w[3]); ((v2u*)orow)[lane + 64 * j] = o; }
}
__device__ __forceinline__ void p0_prologue(const Ctx& C, const Args& a) {
    LAS float* scr = (LAS float*)(C.lds + C.wave * 16640);
    const int gw = C.vcu * NWAVES + C.wave, NGW = C.G * NWAVES;
    unsigned char* ws = a.ws;
    constexpr int I_IN = 16 * 40, I_OUT = 256, I_GLU = 16 * 32, I_EXP = 2 * 16 * 3 * 256;
    constexpr int NITEMS = I_IN + I_OUT + I_GLU + I_EXP;
    for (int m = gw; m < T; m += NGW) rms_row_bf16(a.in[0] + (size_t)m * D, a.in[1], (bf16*)(ws + WS_XN) + (size_t)m * D, C.lane);
    for (int it = gw; it < NITEMS; it += NGW) {
        int r = it;
        if (r < I_IN) { conv_item(a.in[2], INC, (bf16*)(ws + WS_WIN), 0, 0, r / 40, r % 40, scr, C.lane); continue; } r -= I_IN;
        if (r < I_OUT) { conv_item(a.in[9], D, (bf16*)(ws + WS_WOUT), 1, 0, r / 16, r % 16, scr, C.lane); continue; } r -= I_OUT;
        if (r < I_GLU) { conv_item(a.in[19], 2 * D, (bf16*)(ws + WS_WGLU), 2, 0, r / 32, r % 32, scr, C.lane); continue; } r -= I_GLU;
        const int mat = r >> 8, tile = r & 255, layer = mat / 48, rem = mat % 48, e = rem / 3, which = rem % 3;
        const float* src = a.in[23 + which] + ((size_t)layer * NE + e) * (size_t)D * EH;
        bf16* dst = (bf16*)(ws + WS_WEXP + layer * WEXP_LAYER + (which == 2 ? WEXP_DN + (size_t)e * 2 * MiB : WEXP_GU + (size_t)e * 4 * MiB));
        conv_item(src, EH, dst, which == 2 ? 1 : 3, which, tile >> 4, tile & 15, scr, C.lane);
    }
}

__device__ __forceinline__ void conv_tile(const Ctx& C, const Args& a, int tile) {
    const bf16* GLU = (const bf16*)(a.ws + WS_PROJ);
    bf16* MIXED = (bf16*)(a.ws + WS_MIXED);
    const float* cw = a.in[3]; const float* cb = a.in[4]; const float* lg = a.in[5]; const float* lb = a.in[6];
    LAS float* tl = (LAS float*)C.lds;
    const int cp = C.tid & 255, th = C.tid >> 8;
    const int b = tile / (S / 32), s0 = (tile % (S / 32)) * 32;
    f32x2 w[CONV_W];
#pragma unroll
    for (int j = 0; j < CONV_W; ++j) w[j] = *(const f32x2*)(cw + j * CONV_CH + 2 * cp);
    f32x2 acc[16];
    const f32x2 bias = *(const f32x2*)(cb + 2 * cp);
#pragma unroll
    for (int k = 0; k < 16; ++k) acc[k] = bias;
    unsigned xin[46];
#pragma unroll
    for (int i = 0; i < 46; ++i) { const int ss = s0 + 16 * th - 15 + i; xin[i] = (ss >= 0 && ss < S) ? *(const unsigned*)(GLU + (size_t)(b * S + ss) * 512 + 2 * cp) : 0u; }
#pragma unroll
    for (int i = 0; i < 46; ++i) {
        const f32x2 x = {bflo(xin[i]), bfhi(xin[i])};
#pragma unroll
        for (int k = 0; k < 16; ++k) { const int j = i - k; if (j >= 0 && j < CONV_W) acc[k] += w[j] * x; }
    }
#pragma unroll
    for (int k = 0; k < 16; ++k) *(LAS f32x2*)(tl + (16 * th + k) * 512 + 2 * cp) = acc[k];
    __syncthreads();
#pragma unroll
    for (int q = 0; q < 4; ++q) {
        const int tok = 4 * C.wave + q;
        const f32x4 v0 = *(const LAS f32x4*)(tl + tok * 512 + 8 * C.lane), v1 = *(const LAS f32x4*)(tl + tok * 512 + 8 * C.lane + 4);
        const float mu = wave_sum((v0[0] + v0[1]) + (v0[2] + v0[3]) + (v1[0] + v1[1]) + (v1[2] + v1[3])) * (1.f / CONV_CH);
        const f32x4 d0 = v0 - mu, d1 = v1 - mu;
        const float var = wave_sum((d0[0] * d0[0] + d0[1] * d0[1]) + (d0[2] * d0[2] + d0[3] * d0[3]) + (d1[0] * d1[0] + d1[1] * d1[1]) + (d1[2] * d1[2] + d1[3] * d1[3])) * (1.f / CONV_CH);
        const float rs = rsqrtf(var + EPS);
        const f32x4 g0 = *(const f32x4*)(lg + 8 * C.lane), g1 = *(const f32x4*)(lg + 8 * C.lane + 4), b0 = *(const f32x4*)(lb + 8 * C.lane), b1 = *(const f32x4*)(lb + 8 * C.lane + 4);
        f32x4 y0 = d0 * rs * g0 + b0, y1 = d1 * rs * g1 + b1;
#pragma unroll
        for (int e = 0; e < 4; ++e) { y0[e] = y0[e] * sigm(y0[e]); y1[e] = y1[e] * sigm(y1[e]); }
        v4u o; o.x = pk2(y0[0], y0[1]); o.y = pk2(y0[2], y0[3]); o.z = pk2(y1[0], y1[1]); o.w = pk2(y1[2], y1[3]);
        *(v4u*)(MIXED + (size_t)(b * S + s0 + tok) * D + 8 * C.lane) = o;
    }
    __syncthreads();
}
typedef short bf16x8 __attribute__((ext_vector_type(8)));
typedef short s16x4 __attribute__((ext_vector_type(4)));
typedef short v4i16_t __attribute__((ext_vector_type(4)));
typedef float f32x16 __attribute__((ext_vector_type(16)));
constexpr int AT_O = 0, AT_L = 65536, AT_V = 66560;
__device__ __forceinline__ s16x4 vtr(const LAS char* p) { return __builtin_bit_cast(s16x4, __builtin_amdgcn_ds_read_tr16_b64_v4i16((LAS v4i16_t*)p)); }
__device__ __forceinline__ void lds_addf(LAS float* p, float v) { (void)__hip_atomic_fetch_add(p, v, __ATOMIC_RELAXED, __HIP_MEMORY_SCOPE_WORKGROUP); }
__device__ __forceinline__ void attn_unit(const Ctx& C, const bf16* __restrict__ Qh, const bf16* __restrict__ Kh, const bf16* __restrict__ Vh,
                                          int d, int tq0, int nq, int tl0, int tls, float a2, float bound2, LAS float* Oacc, LAS float* Lacc, LAS char* vst) {
    const int lane = C.lane, r = lane & 31, hh = lane >> 5;
    const int qi = r < nq ? r : nq - 1;
    bf16x8 qf[4];
    { const bf16* qp = Qh + (size_t)(tq0 + d * qi) * 64 + 8 * hh;
#pragma unroll
      for (int ks = 0; ks < 4; ++ks) qf[ks] = *(const bf16x8*)(qp + 16 * ks); }
    f32x16 o0, o1;
#pragma unroll
    for (int v = 0; v < 16; ++v) { o0[v] = 0.f; o1[v] = 0.f; }
    float lsum = 0.f;
    const LAS char* vb = vst + ((lane >> 4) & 1) * 32 + (lane & 3) * 8 + (4 * hh + ((lane & 15) >> 2)) * 64;
#pragma unroll 1
    for (int kb = 0; kb < 5; ++kb) {
        int kp = tq0 + d * (32 * kb + r - 64); kp = kp < 0 ? 0 : (kp > S - 1 ? S - 1 : kp);
        const bf16* kptr = Kh + (size_t)kp * 64 + 8 * hh;
        bf16x8 kf[4];
#pragma unroll
        for (int ks = 0; ks < 4; ++ks) kf[ks] = *(const bf16x8*)(kptr + 16 * ks);
#pragma unroll
        for (int it = 0; it < 4; ++it) {
            const int idx = lane + 64 * it, key = idx >> 3, c = idx & 7;
            int vp = tq0 + d * (32 * kb + key - 64); vp = vp < 0 ? 0 : (vp > S - 1 ? S - 1 : vp);
            const v4u vv = *(const v4u*)(Vh + (size_t)vp * 64 + 8 * c);
            *(LAS v4u*)(vst + ((c >> 2) * 2 + (key >> 4)) * 1024 + (key & 15) * 64 + (c & 3) * 16) = vv;
        }
        f32x16 p;
#pragma unroll
        for (int v = 0; v < 16; ++v) {
            const int row = (v & 3) + 8 * (v >> 2) + 4 * hh, m = 32 * kb + row, rel = m - 64 - r, kpos = tq0 + d * (m - 64);
            const bool valid = (rel >= -64) && (rel <= 64) && (kpos >= 0) && (kpos < S) && (r < nq);
            p[v] = valid ? -(a2 * fabsf((float)rel)) - bound2 : -1e30f;
        }
#pragma unroll
        for (int ks = 0; ks < 4; ++ks) p = __builtin_amdgcn_mfma_f32_32x32x16_bf16(kf[ks], qf[ks], p, 0, 0, 0);
#pragma unroll
        for (int v = 0; v < 16; ++v) { p[v] = __builtin_amdgcn_exp2f(p[v]); lsum += p[v]; }
        v4u pw0, pw1;
        pw0.x = pk2(p[0], p[1]); pw0.y = pk2(p[2], p[3]); pw0.z = pk2(p[4], p[5]); pw0.w = pk2(p[6], p[7]);
        pw1.x = pk2(p[8], p[9]); pw1.y = pk2(p[10], p[11]); pw1.z = pk2(p[12], p[13]); pw1.w = pk2(p[14], p[15]);
        asm volatile("s_waitcnt lgkmcnt(0)" ::: "memory");
#pragma unroll
        for (int sdh = 0; sdh < 4; ++sdh) {
            const int dh = sdh >> 1, ss = sdh & 1;
            const s16x4 lo = vtr(vb + dh * 2048 + ss * 1024), hi = vtr(vb + dh * 2048 + ss * 1024 + 512);
            const bf16x8 vf = {lo[0], lo[1], lo[2], lo[3], hi[0], hi[1], hi[2], hi[3]};
            const bf16x8 pa = __builtin_bit_cast(bf16x8, ss == 0 ? pw0 : pw1);
            if (dh == 0) o0 = __builtin_amdgcn_mfma_f32_32x32x16_bf16(pa, vf, o0, 0, 0, 0);
            else o1 = __builtin_amdgcn_mfma_f32_32x32x16_bf16(pa, vf, o1, 0, 0, 0);
        }
        asm volatile("s_waitcnt lgkmcnt(0)" ::: "memory");
    }
    lsum += __shfl_xor(lsum, 32);
    if (lane < nq) lds_addf(Lacc + tl0 + tls * lane, lsum);
#pragma unroll
    for (int v = 0; v < 16; ++v) {
        const int iq = (v & 3) + 8 * (v >> 2) + 4 * hh;
        if (v < 8 || nq == 32) { LAS float* op = Oacc + (tl0 + tls * iq) * 64 + r; lds_addf(op, o0[v]); lds_addf(op + 32, o1[v]); }
    }
}
__device__ __forceinline__ void attn_phase(const Ctx& C, const Args& a) {
    const bf16* Q = (const bf16*)(a.ws + WS_PROJ + 16 * MiB);
    const bf16* K = (const bf16*)(a.ws + WS_PROJ + 32 * MiB);
    const bf16* V = (const bf16*)(a.ws + WS_PROJ + 48 * MiB);
    bf16* MIXED = (bf16*)(a.ws + WS_MIXED);
    LAS float* Oacc = (LAS float*)(C.lds + AT_O); LAS float* Lacc = (LAS float*)(C.lds + AT_L); LAS char* vst = (LAS char*)(C.lds + AT_V + C.wave * 4096);
    float mq = fabsf(a.in[7][C.lane]), mk = fabsf(a.in[8][C.lane]);
#pragma unroll
    for (int o = 1; o < 64; o <<= 1) { mq = fmaxf(mq, __shfl_xor(mq, o)); mk = fmaxf(mk, __shfl_xor(mk, o)); }
    const float bound2 = 64.f * pg8::QSCALE * mq * mk * 1.01f;
    for (int item = C.vcu; item < NB * NH * 16; item += C.G) {
        const int span = item & 15, h = (item >> 4) & 7, b = item >> 7, t0 = span * 256, w = C.wave;
        for (int i = C.tid; i < (65536 + 1024) / 16; i += NTHR) *(LAS v4u*)(C.lds + 16 * i) = (v4u){0u, 0u, 0u, 0u};
        __syncthreads();
        const size_t hb = (size_t)(b * NH + h) * S * 64;
        const bf16 *Qh = Q + hb, *Kh = K + hb, *Vh = V + hb;
        const float slope2 = exp2f(-(float)(h + 1)) * 1.4426950408889634f;
        attn_unit(C, Qh, Kh, Vh, 1, t0 + 32 * w, 32, 32 * w, 1, slope2, bound2, Oacc, Lacc, vst);
        attn_unit(C, Qh, Kh, Vh, 4, t0 + (w >> 1) + 128 * (w & 1), 32, (w >> 1) + 128 * (w & 1), 4, slope2 * 4.f, bound2, Oacc, Lacc, vst);
#pragma unroll 1
        for (int cc = 0; cc < 2; ++cc) attn_unit(C, Qh, Kh, Vh, 16, t0 + 2 * w + cc, 16, 2 * w + cc, 16, slope2 * 16.f, bound2, Oacc, Lacc, vst);
        __syncthreads();
        {
            const int q = C.tid >> 1, hf = C.tid & 1;
            const float inv = 1.f / Lacc[q];
            const LAS f32x4* op = (const LAS f32x4*)(Oacc + q * 64 + 32 * hf);
            bf16* dst = MIXED + (size_t)(b * S + t0 + q) * D + 512 + h * 64 + 32 * hf;
#pragma unroll
            for (int j = 0; j < 4; ++j) { const f32x4 x0 = op[2 * j] * inv, x1 = op[2 * j + 1] * inv; v4u o; o.x = pk2(x0[0], x0[1]); o.y = pk2(x0[2], x0[3]); o.z = pk2(x1[0], x1[1]); o.w = pk2(x1[2], x1[3]); *(v4u*)(dst + 8 * j) = o; }
        }
        __syncthreads();
    }
}

__device__ __forceinline__ void p_router(const Ctx& C, const Args& a, int layer) {
    const float* X = a.out; const float* g = a.in[20] + (size_t)layer * D;
    const float* wr = a.in[21] + (size_t)layer * D * NE; const float* br = a.in[22] + layer * NE;
    bf16* XN = (bf16*)(a.ws + WS_XN); float* AFF = (float*)(a.ws + WS_AFF);
    LAS float* wl = (LAS float*)C.lds;
    for (int i = C.tid; i < D * 4; i += NTHR) { const int k = i >> 2, qd = i & 3; const f32x4 v = *(const f32x4*)(wr + (size_t)k * NE + 4 * qd);
        const int slot = ((k >> 8) * 4 + (k & 3)) * 64 + ((k >> 2) & 63); *(LAS f32x4*)(wl + slot * 20 + 4 * qd) = v; }
    __syncthreads();
    const int gw = C.vcu * NWAVES + C.wave, NGW = C.G * NWAVES;
    for (int m = gw; m < T; m += NGW) {
        const f32x4* xr = (const f32x4*)(X + (size_t)m * D) + C.lane;
        f32x4 v[4]; float s = 0.f;
#pragma unroll
        for (int j = 0; j < 4; ++j) { v[j] = xr[64 * j]; s += (v[j][0] * v[j][0] + v[j][1] * v[j][1]) + (v[j][2] * v[j][2] + v[j][3] * v[j][3]); }
        const float r = rsqrtf(wave_sum(s) * (1.f / D) + EPS);
        float acc[NE];
#pragma unroll
        for (int e = 0; e < NE; ++e) acc[e] = 0.f;
#pragma unroll
        for (int j = 0; j < 4; ++j) {
            const f32x4 w = ((const f32x4*)g)[C.lane + 64 * j];
            const f32x4 hv = v[j] * w * r;
            v2u o; o.x = pk2(hv[0], hv[1]); o.y = pk2(hv[2], hv[3]); ((v2u*)(XN + (size_t)m * D))[C.lane + 64 * j] = o;
#pragma unroll
            for (int i = 0; i < 4; ++i) {
                const LAS float* wp = wl + ((j * 4 + i) * 64 + C.lane) * 20;
#pragma unroll
                for (int qd = 0; qd < 4; ++qd) { const f32x4 ww = *(const LAS f32x4*)(wp + 4 * qd); acc[4 * qd] += hv[i] * ww[0]; acc[4 * qd + 1] += hv[i] * ww[1]; acc[4 * qd + 2] += hv[i] * ww[2]; acc[4 * qd + 3] += hv[i] * ww[3]; }
                if (i & 1) asm volatile("" ::: "memory");
            }
        }
        float mx = -1e30f;
#pragma unroll
        for (int e = 0; e < NE; ++e) { acc[e] = wave_sum(acc[e]) + br[e]; mx = fmaxf(mx, acc[e]); }
        float sum = 0.f;
#pragma unroll
        for (int e = 0; e < NE; ++e) { acc[e] = __expf(acc[e] - mx); sum += acc[e]; }
        float mine = 0.f;
#pragma unroll
        for (int e = 0; e < NE; ++e) if (C.lane == e) mine = acc[e];
        const int b = m / S, ss = m % S;
        if (C.lane < NE) AFF[((size_t)b * NE + C.lane) * S + ss] = mine / sum;
    }
    __syncthreads();
}

__device__ __forceinline__ void p_topk_gather(const Ctx& C, const Args& a) {
    const float* AFF = (const float*)(a.ws + WS_AFF);
    int* IDX = (int*)(a.ws + WS_IDX); float* GATE = (float*)(a.ws + WS_GATE); int* SLOT = (int*)(a.ws + WS_SLOT);
    const bf16* XN = (const bf16*)(a.ws + WS_XN); bf16* XG = (bf16*)(a.ws + WS_PROJ);
    LAS unsigned* red = (LAS unsigned*)C.lds;
    LAS int* lidx = (LAS int*)(C.lds + 1024);
    LAS int* misc = (LAS int*)(C.lds + 4096);
    for (int item = C.vcu; item < NB * NE * 4; item += C.G) {
        const int be = item >> 2, qt = item & 3, b = be / NE, e = be % NE;
        unsigned key[8];
        { const v4u k0 = *(const v4u*)(AFF + (size_t)be * S + 8 * C.tid), k1 = *(const v4u*)(AFF + (size_t)be * S + 8 * C.tid + 4);
          key[0] = k0.x; key[1] = k0.y; key[2] = k0.z; key[3] = k0.w; key[4] = k1.x; key[5] = k1.y; key[6] = k1.z; key[7] = k1.w; }
        unsigned cur = 0u;
        for (int bit = 30; bit >= 0; --bit) {
            const unsigned cand = cur | (1u << bit);
            unsigned c = 0;
#pragma unroll
            for (int j = 0; j < 8; ++j) c += (key[j] >= cand) ? 1u : 0u;
#pragma unroll
            for (int o = 1; o < 64; o <<= 1) c += __shfl_xor(c, o);
            const int par = bit & 1;
            if (C.lane == 0) red[par * 8 + C.wave] = c;
            __syncthreads();
            unsigned tot = 0;
#pragma unroll
            for (int w = 0; w < 8; ++w) tot += red[par * 8 + w];
            if (tot >= (unsigned)CAP) cur = cand;
        }
        unsigned cg = 0, ce = 0;
#pragma unroll
        for (int j = 0; j < 8; ++j) { cg += (key[j] > cur) ? 1u : 0u; ce += (key[j] == cur) ? 1u : 0u; }
        unsigned pk = cg | (ce << 16), inc = pk;
#pragma unroll
        for (int o = 1; o < 64; o <<= 1) { const unsigned t = __shfl_up(inc, o); if (C.lane >= o) inc += t; }
        __syncthreads();
        if (C.lane == 63) red[16 + C.wave] = inc;
        __syncthreads();
        unsigned woff = 0, total = 0;
#pragma unroll
        for (int w = 0; w < 8; ++w) { const unsigned t = red[16 + w]; if (w < C.wave) woff += t; total += t; }
        const unsigned exc = woff + inc - pk;
        const int ngt = (int)(total & 0xffffu), need = CAP - ngt;
        int gtb = (int)(exc & 0xffffu), eqb = (int)(exc >> 16);
        const bool mineq = (C.tid >> 7) == qt;
        if (C.tid == 128 * qt) misc[0] = gtb + (eqb < need ? eqb : need);
        if (C.tid == 128 * qt + 127) {
            int g2 = gtb, e2 = eqb;
#pragma unroll
            for (int j = 0; j < 8; ++j) { g2 += (key[j] > cur) ? 1 : 0; e2 += (key[j] == cur) ? 1 : 0; }
            misc[1] = g2 + (e2 < need ? e2 : need);
        }
        if (mineq) {
            int sl[8];
#pragma unroll
            for (int j = 0; j < 8; ++j) {
                const bool gt = key[j] > cur, eq = key[j] == cur;
                const bool sel = gt || (eq && eqb < need);
                const int pos = gtb + (eqb < need ? eqb : need);
                sl[j] = sel ? pos : -1;
                if (sel) { const int tok = 8 * C.tid + j; IDX[be * CAP + pos] = b * S + tok; GATE[be * CAP + pos] = __uint_as_float(key[j]); lidx[pos] = tok; }
                gtb += gt ? 1 : 0; eqb += eq ? 1 : 0;
            }
#pragma unroll
            for (int j = 0; j < 8; ++j) SLOT[((size_t)(b * S + 8 * C.tid + j)) * NE + e] = sl[j];
        }
        __syncthreads();
        const int p0 = misc[0], p1 = misc[1];
        for (int p = p0 + (C.tid >> 7); p < p1; p += 4) {
            const int tok = lidx[p];
            const v4u v = *(const v4u*)(XN + (size_t)(b * S + tok) * D + 8 * (C.tid & 127));
            *(v4u*)(XG + (size_t)(be * CAP + p) * D + 8 * (C.tid & 127)) = v;
        }
        __syncthreads();
    }
}

__device__ __forceinline__ void p_combine(const Ctx& C, const Args& a, bool with_norm) {
    float* X = a.out; const bf16* Y = (const bf16*)(a.ws + WS_PROJ); const int* SLOT = (const int*)(a.ws + WS_SLOT);
    bf16* XN = (bf16*)(a.ws + WS_XN); const float* g = a.in[10];
    const int gw = C.vcu * NWAVES + C.wave, NGW = C.G * NWAVES;
    for (int m = gw; m < T; m += NGW) {
        const int b = m / S;
        f32x4* xr = (f32x4*)(X + (size_t)m * D) + C.lane;
        f32x4 v[4];
#pragma unroll
        for (int j = 0; j < 4; ++j) v[j] = xr[64 * j];
        const int myslot = (C.lane < NE) ? SLOT[(size_t)m * NE + C.lane] : -1;
        for (int e = 0; e < NE; ++e) {
            const int sl = __shfl(myslot, e);
            if (sl >= 0) {
                const v2u* yr = (const v2u*)(Y + ((size_t)(b * NE + e) * CAP + sl) * D) + C.lane;
#pragma unroll
                for (int j = 0; j < 4; ++j) { const v2u y = yr[64 * j]; v[j][0] += bflo(y.x); v[j][1] += bfhi(y.x); v[j][2] += bflo(y.y); v[j][3] += bfhi(y.y); }
            }
        }
#pragma unroll
        for (int j = 0; j < 4; ++j) xr[64 * j] = v[j];
        if (with_norm) {
            float s = 0.f;
#pragma unroll
            for (int j = 0; j < 4; ++j) s += (v[j][0] * v[j][0] + v[j][1] * v[j][1]) + (v[j][2] * v[j][2] + v[j][3] * v[j][3]);
            const float r = rsqrtf(wave_sum(s) * (1.f / D) + EPS);
#pragma unroll
            for (int j = 0; j < 4; ++j) { const f32x4 w = ((const f32x4*)g)[C.lane + 64 * j]; v2u o; o.x = pk2(v[j][0] * r * w[0], v[j][1] * r * w[1]); o.y = pk2(v[j][2] * r * w[2], v[j][3] * r * w[3]); ((v2u*)(XN + (size_t)m * D))[C.lane + 64 * j] = o; }
        }
    }
}

constexpr size_t WS_CAR = 400 * MiB;
constexpr int S5_NC = 16, S5_CL = S / S5_NC;
__device__ __forceinline__ void s5_lambda(const Args& a, int pg, int p, float& lbr, float& lbi, float& fr, float& fi) {
    const float lr = a.in[11][pg * SP + p], li = a.in[12][pg * SP + p], dt = expf(a.in[13][pg]);
    const float mag = expf(lr * dt), ang = li * dt;
    lbr = mag * cosf(ang); lbi = mag * sinf(ang);
    const float den = lr * lr + li * li, nr = lbr - 1.f;
    fr = (nr * lr + lbi * li) / den; fi = (lbi * lr - nr * li) / den;
}
template <bool FINAL>
__device__ __forceinline__ void p_s5_pass(const Ctx& C, const Args& a) {
    const bf16* XN = (const bf16*)(a.ws + WS_XN); float* CAR = (float*)(a.ws + WS_CAR); bf16* Y = (bf16*)(a.ws + WS_PROJ);
    LAS char* img = (LAS char*)(C.lds + C.wave * 8192);
    const int lane = C.lane, r = lane & 31, hh = lane >> 5;
    for (int bjob = C.vcu; bjob < 512; bjob += C.G) {
        const int g = (bjob & 7) * 8 + C.wave, c = (bjob >> 3) & 15, dir = (bjob >> 7) & 1, bp = bjob >> 8;
        const int pg = dir * SG + g;
        float lbr[2], lbi[2]; bf16x8 bfr[2], bfi[2];
#pragma unroll
        for (int nt = 0; nt < 2; ++nt) {
            float fr, fi; s5_lambda(a, pg, r + 32 * nt, lbr[nt], lbi[nt], fr, fi);
            const float* br = a.in[14] + ((size_t)pg * SP + r + 32 * nt) * SC + 8 * hh; const float* bi = a.in[15] + ((size_t)pg * SP + r + 32 * nt) * SC + 8 * hh;
            const f32x4 r0 = *(const f32x4*)br, r1 = *(const f32x4*)(br + 4), i0 = *(const f32x4*)bi, i1 = *(const f32x4*)(bi + 4);
            const f32x4 xr0 = r0 * fr - i0 * fi, xr1 = r1 * fr - i1 * fi, xi0 = i0 * fr + r0 * fi, xi1 = i1 * fr + r1 * fi;
            v4u wr_, wi_; wr_.x = pk2(xr0[0], xr0[1]); wr_.y = pk2(xr0[2], xr0[3]); wr_.z = pk2(xr1[0], xr1[1]); wr_.w = pk2(xr1[2], xr1[3]);
            wi_.x = pk2(xi0[0], xi0[1]); wi_.y = pk2(xi0[2], xi0[3]); wi_.z = pk2(xi1[0], xi1[1]); wi_.w = pk2(xi1[2], xi1[3]);
            bfr[nt] = __builtin_bit_cast(bf16x8, wr_); bfi[nt] = __builtin_bit_cast(bf16x8, wi_);
        }
        bf16x8 cf[8];
        if (FINAL) {
#pragma unroll
            for (int ks = 0; ks < 8; ++ks) {
                const int k0 = 16 * ks + 8 * hh; const bool im = k0 >= 64;
                const float* src = (im ? a.in[17] : a.in[16]) + ((size_t)pg * SC + (r & 15)) * SP + (k0 & 63);
                f32x4 c0 = *(const f32x4*)src, c1 = *(const f32x4*)(src + 4);
                const float sg = (r >= 16) ? 0.f : (im ? -1.f : 1.f);
                c0 = c0 * sg; c1 = c1 * sg;
                v4u w; w.x = pk2(c0[0], c0[1]); w.y = pk2(c0[2], c0[3]); w.z = pk2(c1[0], c1[1]); w.w = pk2(c1[2], c1[3]);
                cf[ks] = __builtin_bit_cast(bf16x8, w);
            }
        }
        float hr0 = 0.f, hi0 = 0.f, hr1 = 0.f, hi1 = 0.f;
        float* cp = CAR + ((((size_t)(dir * NB + 2 * bp + hh) * SG + g) * S5_NC + c) * SP) * 2;
        if (FINAL) { hr0 = cp[2 * r]; hi0 = cp[2 * r + 1]; hr1 = cp[2 * (r + 32)]; hi1 = cp[2 * (r + 32) + 1]; }
        const int rb = 2 * bp + ((r >> 2) & 1), rv = (r & 3) + 4 * (r >> 3);
        const LAS char* ib = img + (8 * hh + ((lane & 15) >> 2)) * 64 + ((lane >> 4) & 1) * 32 + (lane & 3) * 8;
#pragma unroll 1
        for (int tile = 0; tile < S5_CL / 16; ++tile) {
            const int sidx = c * S5_CL + tile * 16;
            const int ta = dir ? (S - 1 - (sidx + rv)) : (sidx + rv);
            const bf16x8 af = *(const bf16x8*)(XN + ((size_t)rb * S + ta) * D + g * 16 + 8 * hh);
            f32x16 z;
#pragma unroll
            for (int v = 0; v < 16; ++v) z[v] = 0.f;
            f32x16 ur0 = __builtin_amdgcn_mfma_f32_32x32x16_bf16(af, bfr[0], z, 0, 0, 0), ur1 = __builtin_amdgcn_mfma_f32_32x32x16_bf16(af, bfr[1], z, 0, 0, 0);
            f32x16 ui0 = __builtin_amdgcn_mfma_f32_32x32x16_bf16(af, bfi[0], z, 0, 0, 0), ui1 = __builtin_amdgcn_mfma_f32_32x32x16_bf16(af, bfi[1], z, 0, 0, 0);
#pragma unroll
            for (int v = 0; v < 16; ++v) {
                const float a0 = lbr[0] * hr0 - lbi[0] * hi0 + ur0[v], b0 = lbr[0] * hi0 + lbi[0] * hr0 + ui0[v];
                const float a1 = lbr[1] * hr1 - lbi[1] * hi1 + ur1[v], b1 = lbr[1] * hi1 + lbi[1] * hr1 + ui1[v];
                hr0 = a0; hi0 = b0; hr1 = a1; hi1 = b1;
                ur0[v] = a0; ui0[v] = b0; ur1[v] = a1; ui1[v] = b1;
            }
            if (FINAL) {
#define S5_WR(vec, row) do { v4u w0, w1; w0.x = pk2(vec[0], vec[1]); w0.y = pk2(vec[2], vec[3]); w0.z = pk2(vec[4], vec[5]); w0.w = pk2(vec[6], vec[7]); \
                    w1.x = pk2(vec[8], vec[9]); w1.y = pk2(vec[10], vec[11]); w1.z = pk2(vec[12], vec[13]); w1.w = pk2(vec[14], vec[15]); \
                    *(LAS v4u*)(img + (row) * 64 + 32 * hh) = w0; *(LAS v4u*)(img + (row) * 64 + 32 * hh + 16) = w1; } while (0)
                S5_WR(ur0, r); S5_WR(ur1, r + 32); S5_WR(ui0, 64 + r); S5_WR(ui1, 96 + r);
#undef S5_WR
                asm volatile("s_waitcnt lgkmcnt(0)" ::: "memory");
                f32x16 y;
#pragma unroll
                for (int v = 0; v < 16; ++v) y[v] = 0.f;
#pragma unroll
                for (int ks = 0; ks < 8; ++ks) {
                    const s16x4 lo = vtr(ib + ks * 1024), hi = vtr(ib + ks * 1024 + 256);
                    const bf16x8 hf = {lo[0], lo[1], lo[2], lo[3], hi[0], hi[1], hi[2], hi[3]};
                    y = __builtin_amdgcn_mfma_f32_32x32x16_bf16(hf, cf[ks], y, 0, 0, 0);
                }
                asm volatile("s_waitcnt lgkmcnt(0)" ::: "memory");
                if (r < 16) {
                    bf16* yp = Y + (size_t)dir * T * D + g * 16 + r;
#pragma unroll
                    for (int v = 0; v < 16; ++v) {
                        const int tb = 2 * bp + (v >> 3), tv = (v & 3) + 8 * ((v >> 2) & 1) + 4 * hh;
                        const int t = dir ? (S - 1 - (sidx + tv)) : (sidx + tv);
                        yp[((size_t)tb * S + t) * D] = (bf16)(pk2(y[v], 0.f) & 0xffffu);
                    }
                }
            }
        }
        if (!FINAL) { cp[2 * r] = hr0; cp[2 * r + 1] = hi0; cp[2 * (r + 32)] = hr1; cp[2 * (r + 32) + 1] = hi1; }
    }
}
__device__ __forceinline__ void p_s5_carry(const Ctx& C, const Args& a) {
    float* CAR = (float*)(a.ws + WS_CAR);
    const int idx = (C.vcu * NWAVES + C.wave) * 64 + C.lane;
    if (idx >= 2 * NB * SG * SP) return;
    const int st = idx & 63, g = (idx >> 6) & 63, b = (idx >> 12) & 3, dir = idx >> 14;
    float pr, pi, fr, fi; s5_lambda(a, dir * SG + g, st, pr, pi, fr, fi);
#pragma unroll
    for (int i = 0; i < 8; ++i) { const float nr = pr * pr - pi * pi, ni = 2.f * pr * pi; pr = nr; pi = ni; }
    float* cp = CAR + ((((size_t)(dir * NB + b) * SG + g) * S5_NC) * SP + st) * 2;
    float cr = 0.f, ci = 0.f;
    for (int c = 0; c < S5_NC; ++c) {
        const float er = cp[c * SP * 2], ei = cp[c * SP * 2 + 1];
        cp[c * SP * 2] = cr; cp[c * SP * 2 + 1] = ci;
        const float nr = pr * cr - pi * ci + er, ni = pr * ci + pi * cr + ei; cr = nr; ci = ni;
    }
}
__device__ __forceinline__ float gelu_t(float y) { const float u = 0.7978845608028654f * (y + 0.044715f * y * y * y); const float e = __builtin_amdgcn_exp2f(2.885390081777927f * u); const float th = 1.f - 2.f * __builtin_amdgcn_rcpf(e + 1.f); return 0.5f * y * (1.f + th); }
__device__ __forceinline__ void p_s5_post(const Ctx& C, const Args& a) {
    const float* X = a.out; const bf16* YF = (const bf16*)(a.ws + WS_PROJ); const bf16* YB = YF + (size_t)T * D;
    const float* g = a.in[10]; const float* dsk = a.in[18]; bf16* Z = (bf16*)(a.ws + WS_MIXED);
    const int gw = C.vcu * NWAVES + C.wave, NGW = C.G * NWAVES;
    for (int m = gw; m < T; m += NGW) {
        const f32x4* xr = (const f32x4*)(X + (size_t)m * D) + C.lane;
        f32x4 v[4]; float s = 0.f;
#pragma unroll
        for (int j = 0; j < 4; ++j) { v[j] = xr[64 * j]; s += (v[j][0] * v[j][0] + v[j][1] * v[j][1]) + (v[j][2] * v[j][2] + v[j][3] * v[j][3]); }
        const float r = rsqrtf(wave_sum(s) * (1.f / D) + EPS);
#pragma unroll
        for (int j = 0; j < 4; ++j) {
            const f32x4 w = ((const f32x4*)g)[C.lane + 64 * j], dd = ((const f32x4*)dsk)[C.lane + 64 * j];
            const v2u pf = ((const v2u*)(YF + (size_t)m * D))[C.lane + 64 * j], pb_ = ((const v2u*)(YB + (size_t)m * D))[C.lane + 64 * j];
            const f32x4 yf = {bflo(pf.x), bfhi(pf.x), bflo(pf.y), bfhi(pf.y)}, yb = {bflo(pb_.x), bfhi(pb_.x), bflo(pb_.y), bfhi(pb_.y)};
            const f32x4 y = yf + yb + dd * (v[j] * w * r);
            v2u o; o.x = pk2(gelu_t(y[0]), gelu_t(y[1])); o.y = pk2(gelu_t(y[2]), gelu_t(y[3])); ((v2u*)(Z + (size_t)m * D))[C.lane + 64 * j] = o;
        }
    }
}

constexpr int NPHASE = 18;
__global__ void __launch_bounds__(NTHR, 2) mk_fwd(Args args) {
    extern __shared__ __attribute__((aligned(16))) unsigned char lds_raw[];
    Ctx C;
    C.lds = (LAS unsigned char*)lds_raw;
    C.tid = threadIdx.x; C.lane = C.tid & 63; C.wave = __builtin_amdgcn_readfirstlane(C.tid >> 6);
    C.G = gridDim.x; { const int bx = blockIdx.x; C.vcu = (C.G % 8 == 0) ? (bx % 8) * (C.G / 8) + bx / 8 : bx; }
    volatile LAS unsigned* MISC = (volatile LAS unsigned*)(C.lds + LDSCTL_OFF);
    for (int u = C.tid; u < (LDS_BYTES - LDSCTL_OFF) / 4; u += NTHR) ((LAS unsigned*)(C.lds + LDSCTL_OFF))[u] = 0u;
    __syncthreads();
    int lo = args.ph_lo, hi = args.ph_hi;
    unsigned char* ws = args.ws;
    asm volatile("" : "+s"(lo), "+s"(hi), "+s"(ws));
    unsigned* ctl = (unsigned*)(ws + WS_CTL);
    const bool one_launch = (lo == 0 && hi == NPHASE);
    XcdBarrier bar; bar.bar = ctl + CW_BAR; bar.x = 0; bar.st = nullptr;
    if (one_launch) bar = xcd_barrier_post(ctl + CW_BAR, MISC + 8);
    LAS unsigned char* glds = C.lds;
#ifndef MK_ONLY
#define MK_ONLY -1
#endif
#define IN(k) ((MK_ONLY < 0 || MK_ONLY == (k) || (MK_ONLY == 4 && (k) == 13) || (MK_ONLY == 5 && (k) == 14) || (MK_ONLY == 6 && (k) == 15) || (MK_ONLY == 7 && (k) == 16) || (MK_ONLY == 8 && (k) == 17)) && lo <= (k) && (k) < hi)
#define SEAM(k) do { if (IN(k) && IN((k) + 1)) xcd_barrier(bar); } while (0)

    if (IN(0)) { p0_prologue(C, args); } SEAM(0);
    if (IN(1)) {
        pg8::Gemm g{(const bf16*)(ws + WS_XN), (const bf16*)(ws + WS_WIN), D}; pg8::DenseOrder So; So.init(T, INC, C.G, (int)blockIdx.x);
        pg8::EpiProj E{(bf16*)(ws + WS_PROJ), (bf16*)(ws + WS_PROJ + 16 * MiB), args.in[7], args.in[8]};
        pg8::gemm_phase<pg8::EpiProj, pg8::DenseOrder, true, true>(glds, g, So, E);
    } SEAM(1);
    if (IN(2)) {
        for (int t = C.vcu; t < T / 32; t += C.G) conv_tile(C, args, t);
        attn_phase(C, args);
    } SEAM(2);
    if (IN(3)) {
        pg8::Gemm g{(const bf16*)(ws + WS_MIXED), (const bf16*)(ws + WS_WOUT), D}; pg8::DenseOrder So; So.init(T, D, C.G, (int)blockIdx.x);
        pg8::EpiRes E{args.in[0], args.out};
        pg8::gemm_phase<pg8::EpiRes, pg8::DenseOrder, true, true>(glds, g, So, E);
    } SEAM(3);
#define MOE_PHASES(layer, pb) do { \
        if (IN(pb)) { p_router(C, args, layer); } SEAM(pb); \
        if (IN(pb + 1)) { p_topk_gather(C, args); } SEAM(pb + 1); \
        if (IN(pb + 2)) { \
            pg8::Gemm g{(const bf16*)(ws + WS_PROJ), (const bf16*)(ws + WS_WEXP + layer * WEXP_LAYER + WEXP_GU), D}; pg8::ExpertOrder So; So.init(8, C.G, (int)blockIdx.x); \
            pg8::EpiSwiGLU E{(bf16*)(ws + WS_H)}; \
            pg8::gemm_phase<pg8::EpiSwiGLU, pg8::ExpertOrder, true, true>(glds, g, So, E); \
        } SEAM(pb + 2); \
        if (IN(pb + 3)) { \
            pg8::Gemm g{(const bf16*)(ws + WS_H), (const bf16*)(ws + WS_WEXP + layer * WEXP_LAYER + WEXP_DN), EH}; pg8::ExpertOrder So; So.init(4, C.G, (int)blockIdx.x); \
            pg8::EpiDown E{(bf16*)(ws + WS_PROJ), (const float*)(ws + WS_GATE)}; \
            pg8::gemm_phase<pg8::EpiDown, pg8::ExpertOrder, true, true>(glds, g, So, E); \
        } SEAM(pb + 3); \
        if (IN(pb + 4)) { p_combine(C, args, layer == 0); } \
    } while (0)
    MOE_PHASES(0, 4);
    SEAM(8);
    if (IN(9)) { p_s5_pass<false>(C, args); } SEAM(9);
    if (IN(10)) { p_s5_carry(C, args); } SEAM(10);
    if (IN(11)) { p_s5_pass<true>(C, args); if (one_launch) xcd_barrier(bar); p_s5_post(C, args); } SEAM(11);
    if (IN(12)) {
        pg8::Gemm g{(const bf16*)(ws + WS_MIXED), (const bf16*)(ws + WS_WGLU), D}; pg8::DenseOrder So; So.init(T, 2 * D, C.G, (int)blockIdx.x);
        pg8::EpiGluRes E{args.out};
        pg8::gemm_phase<pg8::EpiGluRes, pg8::DenseOrder, true, true>(glds, g, So, E);
    } SEAM(12);
    MOE_PHASES(1, 13);
#undef IN
#undef SEAM
}

#ifndef MK_PER_PHASE
#define MK_PER_PHASE 0
#endif
extern "C" void kernel_launch(void* const* d_in, const int* in_sizes, int n_in, void* d_out, int out_size, void* d_ws, size_t ws_size, hipStream_t stream) {
    static int grid = 0;
    if (grid == 0) {
        if (n_in != 26 || out_size != T * D || ws_size < WS_END) { fprintf(stderr, "kernel_launch: unexpected shapes (n_in %d out %d ws %zu)\n", n_in, out_size, ws_size); grid = -1; return; }
        int dev = 0, cus = 0, per_cu = 0;
        if (hipGetDevice(&dev) != hipSuccess || hipDeviceGetAttribute(&cus, hipDeviceAttributeMultiprocessorCount, dev) != hipSuccess) { grid = -1; return; }
        if (hipFuncSetAttribute((const void*)mk_fwd, hipFuncAttributeMaxDynamicSharedMemorySize, LDS_BYTES) != hipSuccess) { fprintf(stderr, "kernel_launch: hipFuncSetAttribute failed\n"); grid = -1; return; }
        if (hipOccupancyMaxActiveBlocksPerMultiprocessor(&per_cu, (const void*)mk_fwd, NTHR, LDS_BYTES) != hipSuccess || per_cu < 1) { fprintf(stderr, "kernel_launch: occupancy query says %d blocks per CU\n", per_cu); (void)hipGetLastError(); grid = -1; return; }
        grid = cus;
    }
    if (grid < 0) return;
    (void)hipMemsetAsync((char*)d_ws + WS_CTL, 0, CTL_ZERO_BYTES, stream);
    Args a{};
    for (int i = 0; i < 26; ++i) a.in[i] = (const float*)d_in[i];
    a.out = (float*)d_out; a.ws = (unsigned char*)d_ws;
#if MK_PER_PHASE
    for (int p = 0; p < NPHASE; ++p) { a.ph_lo = p; a.ph_hi = p + 1; hipLaunchKernelGGL(mk_fwd, dim3(grid), dim3(NTHR), LDS_BYTES, stream, a); }
#else
    a.ph_lo = 0; a.ph_hi = NPHASE;
    hipLaunchKernelGGL(mk_fwd, dim3(grid), dim3(NTHR), LDS_BYTES, stream, a);
#endif
}
```

```cpp
#include <hip/hip_runtime.h>
#include <cstdint>
#include <cstdio>

namespace pg8 {
#define PG8_LAS __attribute__((address_space(3)))
typedef unsigned short bf16_t;
typedef short bf16x8 __attribute__((ext_vector_type(8)));
typedef float f32x4 __attribute__((ext_vector_type(4)));
typedef unsigned u32x4 __attribute__((ext_vector_type(4)));
constexpr int BM = 256, BK = 64, HALF = 128, HTB = HALF * BK * 2  , STAGE_BYTES = 8 * HTB, NXCD = 8, WGM = 8;

__host__ __device__ __forceinline__ int lds_byte(int r, int c) { const int st = (r >> 4) * 2 + (c >> 5), rr = r & 15, cc = c & 31, ob = rr * 64 + cc * 2; return st * 1024 + (ob ^ (((ob >> 9) & 1) << 5)); }
__host__ __device__ __forceinline__ void stage_rc(int b, int& R, int& C) { const int st = b / 1024, sb = b % 1024, swz = sb ^ (((sb >> 9) & 1) << 5); R = (st >> 1) * 16 + swz / 64; C = (st & 1) * 32 + (swz % 64) / 2; }
__host__ __device__ __forceinline__ int perm32(int rho) { const int n = rho >> 4, i = rho & 15; return 8 * (i >> 2) + 4 * n + (i & 3); }

struct Unit { int pm, pn, pb; };
struct Gemm { const bf16_t* A; const bf16_t* Bt; int K; };

struct DenseOrder {
    int nM, nN, nwg, G, c;
    __device__ void init(int M, int N, int G_, int c_) { nM = M / BM; nN = N / BM; nwg = nM * nN; G = G_; c = c_; }
    __device__ bool next(int i, Unit& u) const {
        const long L = (long)i * G + c; if (L >= nwg) return false;
        int wgid = (int)L; { const int q = nwg / NXCD, r = nwg % NXCD, xcd = wgid % NXCD, off = wgid / NXCD; wgid = (xcd < r ? xcd * (q + 1) : r * (q + 1) + (xcd - r) * q) + off; }
        const int nig = WGM * nN, gid = wgid / nig, fm = gid * WGM, gsz = (nM - fm) < WGM ? (nM - fm) : WGM;
        u.pm = fm + ((wgid % nig) % gsz); u.pn = (wgid % nig) / gsz; u.pb = u.pn; return true;
    }
    __device__ __forceinline__ void a_ready(const Unit&) const {}
    __device__ __forceinline__ void done(const Unit&) const {}
};
struct ExpertOrder {
    int nN, nun, G, c;
    __device__ void init(int nN_, int G_, int c_) { nN = nN_; nun = 128 * nN_; G = G_; c = c_; }
    __device__ bool next(int i, Unit& u) const {
        const long L = (long)i * G + c; if (L >= nun) return false;
        int V = (int)L;
        if (G == 256) V = i * 256 + (c & 7) * 32 + (c >> 3);
        const int per = 8 * nN, e = V / per, r = V % per, pml = r / nN, pn = r % nN;
        u.pm = ((pml >> 1) * 16 + e) * 2 + (pml & 1); u.pn = pn; u.pb = e * nN + pn; return true;
    }
    __device__ __forceinline__ void a_ready(const Unit&) const {}
    __device__ __forceinline__ void done(const Unit&) const {}
};

typedef float f32x2 __attribute__((ext_vector_type(2)));
typedef __bf16 bf16x2_t __attribute__((ext_vector_type(2)));
__device__ __forceinline__ unsigned pk2(float lo, float hi) { f32x2 v = {lo, hi}; bf16x2_t b = __builtin_convertvector(v, bf16x2_t); return __builtin_bit_cast(unsigned, b); }
__device__ __forceinline__ float sigm(float x) { return __builtin_amdgcn_rcpf(1.f + __builtin_amdgcn_exp2f(-1.4426950408889634f * x)); }

constexpr float QSCALE = 0.125f * 1.4426950408889634f;
struct EpiProj {
    static constexpr bool PERM = true, AFTER_DRAIN = false;
    bf16_t *GLU, *Q; const float *qg, *kg;
    __device__ __forceinline__ void operator()(const f32x4 (&acc)[2][2][4][2], const Unit& u, int wr, int wc, int fr, int fq) const {
        const int row0 = u.pm * BM + wr * 64 + fr;
        if (u.pn < 4) {
            const int col0 = 128 * u.pn + 32 * wc + 8 * fq;
#pragma unroll
            for (int ai = 0; ai < 2; ++ai)
#pragma unroll
                for (int m = 0; m < 4; ++m) {
                    const f32x4 v0 = acc[ai][0][m][0], v1 = acc[ai][0][m][1], g0 = acc[ai][1][m][0], g1 = acc[ai][1][m][1];
                    u32x4 w; w.x = pk2(v0[0] * sigm(g0[0]), v0[1] * sigm(g0[1])); w.y = pk2(v0[2] * sigm(g0[2]), v0[3] * sigm(g0[3]));
                    w.z = pk2(v1[0] * sigm(g1[0]), v1[1] * sigm(g1[1])); w.w = pk2(v1[2] * sigm(g1[2]), v1[3] * sigm(g1[3]));
                    *(u32x4*)(GLU + (size_t)(row0 + ai * HALF + m * 16) * 512 + col0) = w;
                    asm volatile("" ::: "memory");
                }
        } else {
            const int t = (u.pn - 4) >> 1;
            const int hd = 4 * ((u.pn - 4) & 1) + wc;
            bf16_t* dst = Q + (size_t)t * (size_t)(8u << 20);
            const float* gp = (const float*)((uintptr_t)qg + (((uintptr_t)kg - (uintptr_t)qg) & (uintptr_t)(t == 0 ? 0 : ~(uintptr_t)0)));
#pragma unroll
            for (int ai = 0; ai < 2; ++ai)
#pragma unroll
                for (int m = 0; m < 4; ++m) {
                    float ss = 0.f;
#pragma unroll
                    for (int bj = 0; bj < 2; ++bj)
#pragma unroll
                        for (int n = 0; n < 2; ++n) { const f32x4 x = acc[ai][bj][m][n]; ss += (x[0] * x[0] + x[1] * x[1]) + (x[2] * x[2] + x[3] * x[3]); }
                    ss += __shfl_xor(ss, 16); ss += __shfl_xor(ss, 32);
                    float rs = 1.f;
                    if (t < 2) rs = rsqrtf(ss * (1.f / 64.f) + 1e-6f) * (t == 0 ? QSCALE : 1.f);
#pragma unroll
                    for (int bj = 0; bj < 2; ++bj) {
                        f32x4 g0 = {1.f, 1.f, 1.f, 1.f}, g1 = g0;
                        if (t < 2) { g0 = *(const f32x4*)(gp + 32 * bj + 8 * fq); g1 = *(const f32x4*)(gp + 32 * bj + 8 * fq + 4); }
                        const f32x4 a = acc[ai][bj][m][0] * g0 * rs, b = acc[ai][bj][m][1] * g1 * rs;
                        u32x4 w; w.x = pk2(a[0], a[1]); w.y = pk2(a[2], a[3]); w.z = pk2(b[0], b[1]); w.w = pk2(b[2], b[3]);
                        const int row = row0 + ai * HALF + m * 16;
                        *(u32x4*)(dst + ((size_t)((row >> 12) * 8 + hd) * 4096 + (row & 4095)) * 64 + 32 * bj + 8 * fq) = w;
                    }
                    asm volatile("" ::: "memory");
                }
        }
    }
};
struct EpiRes {
    static constexpr bool PERM = false, AFTER_DRAIN = false;
    const float* xin; float* X;
    __device__ __forceinline__ void operator()(const f32x4 (&acc)[2][2][4][2], const Unit& u, int wr, int wc, int fr, int fq) const {
        const int row0 = u.pm * BM + wr * 64 + fr, col0 = u.pn * BM + wc * 32 + 4 * fq;
#pragma unroll
        for (int ai = 0; ai < 2; ++ai)
#pragma unroll
            for (int m = 0; m < 4; ++m) { const size_t off = (size_t)(row0 + ai * HALF + m * 16) * 1024 + col0;
#pragma unroll
                for (int bj = 0; bj < 2; ++bj)
#pragma unroll
                    for (int n = 0; n < 2; ++n) { const f32x4 r = *(const f32x4*)(xin + off + bj * HALF + n * 16); *(f32x4*)(X + off + bj * HALF + n * 16) = r + acc[ai][bj][m][n]; } }
    }
};
struct EpiSwiGLU {
    static constexpr bool PERM = true, AFTER_DRAIN = false;
    bf16_t* H;
    __device__ __forceinline__ void operator()(const f32x4 (&acc)[2][2][4][2], const Unit& u, int wr, int wc, int fr, int fq) const {
        const int row0 = u.pm * BM + wr * 64 + fr, col0 = 128 * u.pn + 32 * wc + 8 * fq;
#pragma unroll
        for (int ai = 0; ai < 2; ++ai)
#pragma unroll
            for (int m = 0; m < 4; ++m) {
                const f32x4 g0 = acc[ai][0][m][0], g1 = acc[ai][0][m][1], u0 = acc[ai][1][m][0], u1 = acc[ai][1][m][1];
                u32x4 w; w.x = pk2(g0[0] * sigm(g0[0]) * u0[0], g0[1] * sigm(g0[1]) * u0[1]); w.y = pk2(g0[2] * sigm(g0[2]) * u0[2], g0[3] * sigm(g0[3]) * u0[3]);
                w.z = pk2(g1[0] * sigm(g1[0]) * u1[0], g1[1] * sigm(g1[1]) * u1[1]); w.w = pk2(g1[2] * sigm(g1[2]) * u1[2], g1[3] * sigm(g1[3]) * u1[3]);
                *(u32x4*)(H + (size_t)(row0 + ai * HALF + m * 16) * 1024 + col0) = w;
            }
    }
};
struct EpiDown {
    static constexpr bool PERM = true, AFTER_DRAIN = false;
    bf16_t* Y; const float* gate;
    __device__ __forceinline__ void operator()(const f32x4 (&acc)[2][2][4][2], const Unit& u, int wr, int wc, int fr, int fq) const {
        const int row0 = u.pm * BM + wr * 64 + fr, col0 = u.pn * BM + wc * 32 + 8 * fq;
#pragma unroll
        for (int ai = 0; ai < 2; ++ai)
#pragma unroll
            for (int m = 0; m < 4; ++m) { const int row = row0 + ai * HALF + m * 16; const float gs = gate[row];
#pragma unroll
                for (int bj = 0; bj < 2; ++bj) { const f32x4 a = acc[ai][bj][m][0] * gs, b = acc[ai][bj][m][1] * gs;
                    u32x4 w; w.x = pk2(a[0], a[1]); w.y = pk2(a[2], a[3]); w.z = pk2(b[0], b[1]); w.w = pk2(b[2], b[3]);
                    *(u32x4*)(Y + (size_t)row * 1024 + col0 + bj * HALF) = w; } }
    }
};
struct EpiGluRes {
    static constexpr bool PERM = false, AFTER_DRAIN = false;
    float* X;
    __device__ __forceinline__ void operator()(const f32x4 (&acc)[2][2][4][2], const Unit& u, int wr, int wc, int fr, int fq) const {
        const int row0 = u.pm * BM + wr * 64 + fr, col0 = 128 * u.pn + 32 * wc + 4 * fq;
#pragma unroll
        for (int ai = 0; ai < 2; ++ai)
#pragma unroll
            for (int m = 0; m < 4; ++m) { float* p = X + (size_t)(row0 + ai * HALF + m * 16) * 1024 + col0;
#pragma unroll
                for (int n = 0; n < 2; ++n) { const f32x4 v = acc[ai][0][m][n], g = acc[ai][1][m][n]; f32x4 r = *(const f32x4*)(p + n * 16);
                    r[0] += v[0] * sigm(g[0]); r[1] += v[1] * sigm(g[1]); r[2] += v[2] * sigm(g[2]); r[3] += v[3] * sigm(g[3]); *(f32x4*)(p + n * 16) = r; } }
    }
};

template <class Epi, class Sched, bool ALIGN_EPI = false, bool SP2 = false>
__device__ __forceinline__ void gemm_phase(PG8_LAS unsigned char* lds, const Gemm g, const Sched& S, const Epi& E) {
    const int tid = threadIdx.x, wid = __builtin_amdgcn_readfirstlane(tid >> 6), lane = tid & 63, wr = wid >> 2, wc = wid & 3, fr = lane & 15, fq = lane >> 4;
    const int K = g.K, nt = K / BK;
    unsigned voffA[2], voffB[2];
#pragma unroll
    for (int i = 0; i < 2; ++i) { int R, C; stage_rc(tid * 16 + i * 8192, R, C); const int Rb = Epi::PERM ? ((R & ~31) + perm32(R & 31)) : R;
        voffA[i] = (unsigned)(R * K + C) * 2u; voffB[i] = (unsigned)(Rb * K + C) * 2u; }
    const size_t kstep = (size_t)(BK * 2);
    const size_t hstep = (size_t)HALF * K * 2;
    const size_t tstep = 2 * hstep;
    const unsigned ldsw = (unsigned)wid * 1024u;
    const int aoff = lds_byte(wr * 64 + fr, fq * 8), boff = lds_byte(wc * 32 + fr, fq * 8);
#define PG8_SA(b, h) (((b) * 2 + (h)) * HTB)
#define PG8_SB(b, h) ((4 + (b) * 2 + (h)) * HTB)
#define PG8_STAGE(bufoff, gbase, voff) do { _Pragma("unroll") for (int _i = 0; _i < 2; ++_i) \
        __builtin_amdgcn_global_load_lds((const unsigned*)((const char*)(gbase) + (voff)[_i]), (PG8_LAS unsigned*)(lds + (bufoff) + ldsw + _i * 8192), 16, 0, 0); } while (0)
#define PG8_LDA(dst, b, h) do { _Pragma("unroll") for (int m = 0; m < 4; ++m) _Pragma("unroll") for (int k = 0; k < 2; ++k) dst[m][k] = *(const PG8_LAS bf16x8*)(lds + PG8_SA(b, h) + aoff + m * 2048 + k * 1024); } while (0)
#define PG8_LDB(dst, b, h) do { _Pragma("unroll") for (int n = 0; n < 2; ++n) _Pragma("unroll") for (int k = 0; k < 2; ++k) dst[n][k] = *(const PG8_LAS bf16x8*)(lds + PG8_SB(b, h) + boff + n * 2048 + k * 1024); } while (0)
#define PG8_MMA(ai, bj, At, Bt) do { __builtin_amdgcn_s_setprio(1); _Pragma("unroll") for (int m = 0; m < 4; ++m) _Pragma("unroll") for (int n = 0; n < 2; ++n) _Pragma("unroll") for (int k = 0; k < 2; ++k) \
        acc[ai][bj][m][n] = __builtin_amdgcn_mfma_f32_16x16x32_bf16(Bt[n][k], At[m][k], acc[ai][bj][m][n], 0, 0, 0); __builtin_amdgcn_s_setprio(0); } while (0)
#define PG8_WAIT_V(n) asm volatile("s_waitcnt vmcnt(" #n ")" ::: "memory")
#define PG8_WAIT_L(n) asm volatile("s_waitcnt lgkmcnt(" #n ")" ::: "memory")
#define PG8_BAR __builtin_amdgcn_s_barrier()
#define PG8_SCHED __builtin_amdgcn_sched_barrier(0)
    Unit cur, nxt; int ui = 0;
    if (!S.next(0, cur)) return;
    f32x4 acc[2][2][4][2];
#pragma unroll
    for (int a = 0; a < 2; ++a)
#pragma unroll
        for (int b = 0; b < 2; ++b)
#pragma unroll
            for (int m = 0; m < 4; ++m)
#pragma unroll
                for (int n = 0; n < 2; ++n) acc[a][b][m][n] = (f32x4){0.f, 0.f, 0.f, 0.f};
    bf16x8 At[4][2], B0[2][2], B1[2][2];
    const char* cA = (const char*)g.A + (size_t)cur.pm * tstep; const char* cB = (const char*)g.Bt + (size_t)cur.pb * tstep;
    S.a_ready(cur);
    if constexpr (SP2) {
        PG8_STAGE(PG8_SB(0, 0), cB, voffB); PG8_STAGE(PG8_SB(0, 1), cB + hstep, voffB); PG8_STAGE(PG8_SA(0, 0), cA, voffA); PG8_STAGE(PG8_SA(0, 1), cA + hstep, voffA);
        if (wr == 1) PG8_BAR;
        PG8_WAIT_V(2); PG8_BAR;
        PG8_STAGE(PG8_SB(1, 0), cB + kstep, voffB); PG8_STAGE(PG8_SA(1, 0), cA + kstep, voffA); PG8_STAGE(PG8_SB(1, 1), cB + hstep + kstep, voffB);
        PG8_WAIT_V(6); PG8_BAR;
    } else {
        PG8_STAGE(PG8_SB(0, 0), cB, voffB); PG8_STAGE(PG8_SA(0, 0), cA, voffA); PG8_STAGE(PG8_SB(0, 1), cB + hstep, voffB); PG8_STAGE(PG8_SA(0, 1), cA + hstep, voffA);
        if (wr == 1) PG8_BAR;
        PG8_WAIT_V(4); PG8_BAR;
        PG8_STAGE(PG8_SB(1, 0), cB + kstep, voffB); PG8_STAGE(PG8_SA(1, 0), cA + kstep, voffA); PG8_STAGE(PG8_SB(1, 1), cB + hstep + kstep, voffB);
        PG8_WAIT_V(6); PG8_BAR;
    }
    for (;;) {
        const bool has_next = S.next(ui + 1, nxt);
        const char* nA = has_next ? (const char*)g.A + (size_t)nxt.pm * tstep : cA; const char* nB = has_next ? (const char*)g.Bt + (size_t)nxt.pb * tstep : cB;
        for (int t = 0; t < nt; t += 2) {
            const bool last = (t == nt - 2);
            const char* a1 = cA + (size_t)(t + 1) * kstep;
            const char* a2 = last ? nA : cA + (size_t)(t + 2) * kstep; const char* b2 = last ? nB : cB + (size_t)(t + 2) * kstep;
            const char* a3 = a2 + kstep; const char* b3 = b2 + kstep;
            if (last && has_next) S.a_ready(nxt);
            if constexpr (SP2) {
            PG8_LDB(B0, 0, 0); PG8_LDB(B1, 0, 1); PG8_SCHED; PG8_LDA(At, 0, 0); PG8_STAGE(PG8_SA(1, 1), a1 + hstep, voffA);
            PG8_WAIT_V(8); PG8_WAIT_L(0); PG8_BAR; PG8_MMA(0, 0, At, B0); PG8_MMA(0, 1, At, B1); PG8_BAR; PG8_SCHED;
            PG8_LDA(At, 0, 1); PG8_STAGE(PG8_SB(0, 0), b2, voffB); PG8_STAGE(PG8_SB(0, 1), b2 + hstep, voffB); PG8_STAGE(PG8_SA(0, 0), a2, voffA);
            PG8_WAIT_V(8); PG8_WAIT_L(0); PG8_BAR; PG8_MMA(1, 0, At, B0); PG8_MMA(1, 1, At, B1); PG8_BAR; PG8_SCHED;
            PG8_LDB(B0, 1, 0); PG8_LDB(B1, 1, 1); PG8_SCHED; PG8_LDA(At, 1, 0); PG8_STAGE(PG8_SA(0, 1), a2 + hstep, voffA);
            PG8_WAIT_V(8); PG8_WAIT_L(0); PG8_BAR; PG8_MMA(0, 0, At, B0); PG8_MMA(0, 1, At, B1); PG8_BAR; PG8_SCHED;
            PG8_LDA(At, 1, 1); PG8_STAGE(PG8_SB(1, 0), b3, voffB); PG8_STAGE(PG8_SB(1, 1), b3 + hstep, voffB); PG8_STAGE(PG8_SA(1, 0), a3, voffA);
            PG8_WAIT_V(8); PG8_WAIT_L(0); PG8_BAR; PG8_MMA(1, 0, At, B0); PG8_MMA(1, 1, At, B1); PG8_BAR; PG8_SCHED;
            } else {
            PG8_LDB(B0, 0, 0); PG8_SCHED; PG8_LDA(At, 0, 0); PG8_STAGE(PG8_SA(1, 1), a1 + hstep, voffA);
            PG8_WAIT_L(8); PG8_BAR; PG8_WAIT_L(0); PG8_MMA(0, 0, At, B0); PG8_BAR; PG8_SCHED;
            PG8_LDB(B1, 0, 1); PG8_STAGE(PG8_SB(0, 0), b2, voffB);
            PG8_BAR; PG8_WAIT_L(0); PG8_MMA(0, 1, At, B1); PG8_BAR;
            PG8_LDA(At, 0, 1); PG8_STAGE(PG8_SA(0, 0), a2, voffA);
            PG8_BAR; PG8_WAIT_L(0); PG8_MMA(1, 0, At, B0); PG8_BAR; PG8_SCHED;
            PG8_STAGE(PG8_SB(0, 1), b2 + hstep, voffB);
            PG8_WAIT_V(6); PG8_BAR; PG8_MMA(1, 1, At, B1); PG8_BAR;
            PG8_LDB(B0, 1, 0); PG8_SCHED; PG8_LDA(At, 1, 0); PG8_STAGE(PG8_SA(0, 1), a2 + hstep, voffA);
            PG8_WAIT_L(8); PG8_BAR; PG8_WAIT_L(0); PG8_MMA(0, 0, At, B0); PG8_BAR; PG8_SCHED;
            PG8_LDB(B1, 1, 1); PG8_STAGE(PG8_SB(1, 0), b3, voffB);
            PG8_BAR; PG8_WAIT_L(0); PG8_MMA(0, 1, At, B1); PG8_BAR;
            PG8_LDA(At, 1, 1); PG8_STAGE(PG8_SA(1, 0), a3, voffA);
            PG8_BAR; PG8_WAIT_L(0); PG8_MMA(1, 0, At, B0); PG8_BAR; PG8_SCHED;
            PG8_STAGE(PG8_SB(1, 1), b3 + hstep, voffB);
            PG8_WAIT_V(6); PG8_BAR; PG8_MMA(1, 1, At, B1); PG8_BAR;
            }
        }
        if constexpr (ALIGN_EPI) { if (wr == 0) PG8_BAR; }
        if constexpr (!Epi::AFTER_DRAIN) { E(acc, cur, wr, wc, fr, fq); S.done(cur); }
        if (!has_next) break;
#pragma unroll
        for (int a = 0; a < 2; ++a)
#pragma unroll
            for (int b = 0; b < 2; ++b)
#pragma unroll
                for (int m = 0; m < 4; ++m)
#pragma unroll
                    for (int n = 0; n < 2; ++n) acc[a][b][m][n] = (f32x4){0.f, 0.f, 0.f, 0.f};
        cur = nxt; cA = nA; cB = nB; ++ui;
        if constexpr (ALIGN_EPI) { if (wr == 1) PG8_BAR; }
    }
    PG8_WAIT_V(0);
    if constexpr (!ALIGN_EPI) { if (wr == 0) PG8_BAR; }
    PG8_BAR;
    if constexpr (Epi::AFTER_DRAIN) { E.fused(acc, cur, wr, wc, fr, fq, lds, wid, lane); S.done(cur); }
#undef PG8_SA
#undef PG8_SB
#undef PG8_STAGE
#undef PG8_LDA
#undef PG8_LDB
#undef PG8_MMA
#undef PG8_WAIT_V
#undef PG8_WAIT_L
#undef PG8_BAR
#undef PG8_SCHED
}
}

constexpr int NB = 4, S = 4096, D = 1024, T = NB * S;
constexpr int CONV_CH = 512, CONV_W = 31, NH = 8, INC = 2560;
constexpr int SG = 64, SC = 16, SP = 64;
constexpr int NE = 16, CAP = 512, EH = 1024, MR = NB * NE * CAP;
constexpr float EPS = 1e-6f;
constexpr int NWAVES = 8, NTHR = NWAVES * 64;

constexpr size_t MiB = 1u << 20;
constexpr size_t WS_CTL = 0, CTL_ZERO_BYTES = 64 * 1024;
constexpr size_t WS_AFF = 1 * MiB, WS_IDX = 2 * MiB, WS_GATE = 2 * MiB + 512 * 1024, WS_SLOT = 3 * MiB;
constexpr size_t WS_WIN = 4 * MiB, WS_WOUT = 10 * MiB, WS_WGLU = 12 * MiB;
constexpr size_t WS_WEXP = 16 * MiB, WEXP_LAYER = 96 * MiB, WEXP_GU = 0, WEXP_DN = 64 * MiB;
constexpr size_t WS_XN = 208 * MiB, WS_MIXED = 240 * MiB;
constexpr size_t WS_PROJ = 272 * MiB;
constexpr size_t WS_H = 336 * MiB;
constexpr size_t WS_END = 404 * MiB;
constexpr int CW_BAR = 1024;

constexpr int SCRATCH_BYTES = 143360;
constexpr int LDSCTL_OFF = SCRATCH_BYTES;
constexpr int LDS_BYTES = 147456;

#define GAS __attribute__((address_space(1)))
#define LAS __attribute__((address_space(3)))
typedef unsigned short bf16;
typedef unsigned v4u __attribute__((ext_vector_type(4)));
typedef unsigned v2u __attribute__((ext_vector_type(2)));
typedef float f32x4 __attribute__((ext_vector_type(4)));
typedef float f32x2 __attribute__((ext_vector_type(2)));
using pg8::pk2;
using pg8::sigm;
__device__ __forceinline__ float bf2f(unsigned short h) { return __uint_as_float(((unsigned)h) << 16); }
__device__ __forceinline__ float bflo(unsigned w) { return __uint_as_float(w << 16); }
__device__ __forceinline__ float bfhi(unsigned w) { return __uint_as_float(w & 0xffff0000u); }
__device__ __forceinline__ float wave_sum(float v) {
#pragma unroll
    for (int o = 1; o < 64; o <<= 1) v += __shfl_xor(v, o);
    return v;
}

#define XB_TMO      128
#define XB_XCNT(j)  (256  + 64 * (j))
#define XB_XSUB(j)  (1280 + 64 * (j))
#define XB_XGEN(j)  (2304 + 64 * (j))
#define XB_TOP      3328
#define XB_TOPGEN   3392
#define XCD_BAR_WORDS 3456
#define XB_SPIN_CAP (1u << 18)
__device__ __forceinline__ unsigned xb_ld(unsigned* p)              { return __hip_atomic_load(p, __ATOMIC_RELAXED, __HIP_MEMORY_SCOPE_AGENT); }
__device__ __forceinline__ unsigned xb_add(unsigned* p, unsigned v) { return __hip_atomic_fetch_add(p, v, __ATOMIC_RELAXED, __HIP_MEMORY_SCOPE_AGENT); }
__device__ __forceinline__ unsigned xb_xcc_id() { return (unsigned)__builtin_amdgcn_s_getreg((3 << 11) | 20) & 0xFu; }
#define XB_SPIN(cond, bar) do { unsigned _sp = 0; while (cond) { __builtin_amdgcn_s_sleep(1); \
    if ((++_sp & 255u) == 0u) { if (xb_ld(&(bar)[XB_TMO])) break; if (_sp > XB_SPIN_CAP) { atomicAdd(&(bar)[XB_TMO], 1u); break; } } } } while (0)
struct XcdBarrier { unsigned* bar; unsigned x; volatile LAS unsigned* st; };
__device__ __forceinline__ XcdBarrier xcd_barrier_post(unsigned* bar, volatile LAS unsigned* st) {
    XcdBarrier b; b.bar = bar; b.x = xb_xcc_id(); b.st = st;
    if (threadIdx.x == 0) (void)xb_add(&bar[XB_XCNT(b.x)], 1u);
    return b;
}
__device__ __forceinline__ void xcd_barrier_complete(unsigned* bar, unsigned x, unsigned& nloc, unsigned& nx) {
    const unsigned G = gridDim.x * gridDim.y * gridDim.z;
    unsigned sum, cnt, mine, sp = 0u;
    for (;;) {
        sum = 0u; cnt = 0u; mine = 0u;
#pragma unroll
        for (unsigned j = 0; j < 16; ++j) { const unsigned c = xb_ld(&bar[XB_XCNT(j)]); sum += c; cnt += (c > 0u) ? 1u : 0u; mine = (j == x) ? c : mine; }
        if (sum == G) break;
        __builtin_amdgcn_s_sleep(1);
        if ((++sp & 255u) == 0u) { if (xb_ld(&bar[XB_TMO])) break; if (sp > XB_SPIN_CAP) { atomicAdd(&bar[XB_TMO], 1u); break; } }
    }
    nloc = mine > 0u ? mine : 1u; nx = cnt > 0u ? cnt : 1u;
}
__device__ __forceinline__ void xcd_barrier(const XcdBarrier& b) {
    asm volatile("s_waitcnt vmcnt(0)" ::: "memory");
    __syncthreads();
    if (threadIdx.x == 0) {
        unsigned* bar = b.bar;
        __builtin_amdgcn_s_waitcnt(0);
        unsigned nloc = b.st[0], nx = b.st[1];
        if (nloc == 0u) { xcd_barrier_complete(bar, b.x, nloc, nx); b.st[0] = nloc; b.st[1] = nx; }
        const unsigned old = xb_add(&bar[XB_XSUB(b.x)], 1u);
        const unsigned gen = old / nloc;
        if (old + 1u == (gen + 1u) * nloc) {
            __builtin_amdgcn_fence(__ATOMIC_RELEASE, "agent");
            asm volatile("s_waitcnt vmcnt(0)" ::: "memory");
            const unsigned og = xb_add(&bar[XB_TOP], 1u);
            const unsigned tg = og / nx;
            if (og + 1u == (tg + 1u) * nx) xb_add(&bar[XB_TOPGEN], 1u);
            else XB_SPIN(xb_ld(&bar[XB_TOPGEN]) == tg, bar);
            __builtin_amdgcn_fence(__ATOMIC_ACQUIRE, "agent");
            xb_add(&bar[XB_XGEN(b.x)], 1u);
            asm volatile("s_waitcnt vmcnt(0)" ::: "memory");
        } else {
            XB_SPIN(xb_ld(&bar[XB_XGEN(b.x)]) == gen, bar);
            __builtin_amdgcn_fence(__ATOMIC_ACQUIRE, "agent");
            asm volatile("s_waitcnt vmcnt(0)" ::: "memory");
        }
    }
    __syncthreads();
}

struct Args {
    const float* in[26]; float* out; unsigned char* ws; int ph_lo, ph_hi;
};
struct Ctx { LAS unsigned char* lds; int tid, lane, wave, vcu, G; };

__device__ __forceinline__ int rowmap(int kind, int half, int n) {
    if (kind == 0) {
        if (n < 1024) { const int hf = n >> 9, r = n & 511; return 256 * (r >> 7) + 128 * hf + (r & 127); }
        const int pn = n >> 8, w = n & 255, wc = w >> 6, bj = (w >> 5) & 1, j = w & 31; return 256 * pn + 128 * bj + 32 * wc + j;
    }
    if (kind == 2) { const int hf = n >> 10, r = n & 1023; return 256 * (r >> 7) + 128 * hf + (r & 127); }
    if (kind == 3) return 256 * (n >> 7) + 128 * half + (n & 127);
    return n;
}
__device__ __forceinline__ void conv_item(const float* __restrict__ W, int N, bf16* __restrict__ WT, int kind, int half, int kb, int nb, LAS float* scr, int lane) {
    const int k0 = 64 * kb, n0 = 64 * nb;
#pragma unroll 4
    for (int it = 0; it < 16; ++it) {
        const int kk = 4 * it + (lane >> 4), nn = 4 * (lane & 15);
        const f32x4 v = *(const f32x4*)(W + (size_t)(k0 + kk) * N + n0 + nn);
        scr[kk * 65 + nn] = v[0]; scr[kk * 65 + nn + 1] = v[1]; scr[kk * 65 + nn + 2] = v[2]; scr[kk * 65 + nn + 3] = v[3];
    }
    asm volatile("s_waitcnt lgkmcnt(0)" ::: "memory");
    const int kc = lane & 7;
#pragma unroll
    for (int jt = 0; jt < 8; ++jt) {
        const int nl = 8 * jt + (lane >> 3);
        const LAS float* s = scr + (8 * kc) * 65 + nl;
        v4u o; o.x = pk2(s[0], s[65]); o.y = pk2(s[2 * 65], s[3 * 65]); o.z = pk2(s[4 * 65], s[5 * 65]); o.w = pk2(s[6 * 65], s[7 * 65]);
        *(v4u*)(WT + (size_t)rowmap(kind, half, n0 + nl) * 1024 + k0 + 8 * kc) = o;
    }
    asm volatile("s_waitcnt lgkmcnt(0)" ::: "memory");
}
__device__ __forceinline__ void rms_row_bf16(const float* __restrict__ xrow, const float* __restrict__ g, bf16* __restrict__ orow, int lane) {
    const f32x4* xr = (const f32x4*)xrow + lane;
    f32x4 v[4]; float s = 0.f;
#pragma unroll
    for (int j = 0; j < 4; ++j) { v[j] = xr[64 * j]; s += (v[j][0] * v[j][0] + v[j][1] * v[j][1]) + (v[j][2] * v[j][2] + v[j][3] * v[j][3]); }
    const float r = rsqrtf(wave_sum(s) * (1.f / D) + EPS);
#pragma unroll
    for (int j = 0; j < 4; ++j) { const f32x4 w = ((const f32x4*)g)[lane + 64 * j]; v2u o; o.x = pk2(v[j][0] * r * w[0], v[j][1] * r * w[1]); o.y = pk2(v[j][2] * r * w[2], v[j][3] * r * w[3]); ((v2u*)orow)[lane + 64 * j] = o; }
}
__device__ __forceinline__ void p0_prologue(const Ctx& C, const Args& a) {
    LAS float* scr = (LAS float*)(C.lds + C.wave * 16640);
    const int gw = C.vcu * NWAVES + C.wave, NGW = C.G * NWAVES;
    unsigned char* ws = a.ws;
    constexpr int I_IN = 16 * 40, I_OUT = 256, I_GLU = 16 * 32, I_EXP = 2 * 16 * 3 * 256;
    constexpr int NITEMS = I_IN + I_OUT + I_GLU + I_EXP;
    for (int m = gw; m < T; m += NGW) rms_row_bf16(a.in[0] + (size_t)m * D, a.in[1], (bf16*)(ws + WS_XN) + (size_t)m * D, C.lane);
    for (int it = gw; it < NITEMS; it += NGW) {
        int r = it;
        if (r < I_IN) { conv_item(a.in[2], INC, (bf16*)(ws + WS_WIN), 0, 0, r / 40, r % 40, scr, C.lane); continue; } r -= I_IN;
        if (r < I_OUT) { conv_item(a.in[9], D, (bf16*)(ws + WS_WOUT), 1, 0, r / 16, r % 16, scr, C.lane); continue; } r -= I_OUT;
        if (r < I_GLU) { conv_item(a.in[19], 2 * D, (bf16*)(ws + WS_WGLU), 2, 0, r / 32, r % 32, scr, C.lane); continue; } r -= I_GLU;
        const int mat = r >> 8, tile = r & 255, layer = mat / 48, rem = mat % 48, e = rem / 3, which = rem % 3;
        const float* src = a.in[23 + which] + ((size_t)layer * NE + e) * (size_t)D * EH;
        bf16* dst = (bf16*)(ws + WS_WEXP + layer * WEXP_LAYER + (which == 2 ? WEXP_DN + (size_t)e * 2 * MiB : WEXP_GU + (size_t)e * 4 * MiB));
        conv_item(src, EH, dst, which == 2 ? 1 : 3, which, tile >> 4, tile & 15, scr, C.lane);
    }
}

__device__ __forceinline__ void conv_tile(const Ctx& C, const Args& a, int tile) {
    const bf16* GLU = (const bf16*)(a.ws + WS_PROJ);
    bf16* MIXED = (bf16*)(a.ws + WS_MIXED);
    const float* cw = a.in[3]; const float* cb = a.in[4]; const float* lg = a.in[5]; const float* lb = a.in[6];
    LAS float* tl = (LAS float*)C.lds;
    const int cp = C.tid & 255, th = C.tid >> 8;
    const int b = tile / (S / 32), s0 = (tile % (S / 32)) * 32;
    f32x2 w[CONV_W];
#pragma unroll
    for (int j = 0; j < CONV_W; ++j) w[j] = *(const f32x2*)(cw + j * CONV_CH + 2 * cp);
    f32x2 acc[16];
    const f32x2 bias = *(const f32x2*)(cb + 2 * cp);
#pragma unroll
    for (int k = 0; k < 16; ++k) acc[k] = bias;
    unsigned xin[46];
#pragma unroll
    for (int i = 0; i < 46; ++i) { const int ss = s0 + 16 * th - 15 + i; xin[i] = (ss >= 0 && ss < S) ? *(const unsigned*)(GLU + (size_t)(b * S + ss) * 512 + 2 * cp) : 0u; }
#pragma unroll
    for (int i = 0; i < 46; ++i) {
        const f32x2 x = {bflo(xin[i]), bfhi(xin[i])};
#pragma unroll
        for (int k = 0; k < 16; ++k) { const int j = i - k; if (j >= 0 && j < CONV_W) acc[k] += w[j] * x; }
    }
#pragma unroll
    for (int k = 0; k < 16; ++k) *(LAS f32x2*)(tl + (16 * th + k) * 512 + 2 * cp) = acc[k];
    __syncthreads();
#pragma unroll
    for (int q = 0; q < 4; ++q) {
        const int tok = 4 * C.wave + q;
        const f32x4 v0 = *(const LAS f32x4*)(tl + tok * 512 + 8 * C.lane), v1 = *(const LAS f32x4*)(tl + tok * 512 + 8 * C.lane + 4);
        const float mu = wave_sum((v0[0] + v0[1]) + (v0[2] + v0[3]) + (v1[0] + v1[1]) + (v1[2] + v1[3])) * (1.f / CONV_CH);
        const f32x4 d0 = v0 - mu, d1 = v1 - mu;
        const float var = wave_sum((d0[0] * d0[0] + d0[1] * d0[1]) + (d0[2] * d0[2] + d0[3] * d0[3]) + (d1[0] * d1[0] + d1[1] * d1[1]) + (d1[2] * d1[2] + d1[3] * d1[3])) * (1.f / CONV_CH);
        const float rs = rsqrtf(var + EPS);
        const f32x4 g0 = *(const f32x4*)(lg + 8 * C.lane), g1 = *(const f32x4*)(lg + 8 * C.lane + 4), b0 = *(const f32x4*)(lb + 8 * C.lane), b1 = *(const f32x4*)(lb + 8 * C.lane + 4);
        f32x4 y0 = d0 * rs * g0 + b0, y1 = d1 * rs * g1 + b1;
#pragma unroll
        for (int e = 0; e < 4; ++e) { y0[e] = y0[e] * sigm(y0[e]); y1[e] = y1[e] * sigm(y1[e]); }
        v4u o; o.x = pk2(y0[0], y0[1]); o.y = pk2(y0[2], y0[3]); o.z = pk2(y1[0], y1[1]); o.w = pk2(y1[2], y1[3]);
        *(v4u*)(MIXED + (size_t)(b * S + s0 + tok) * D + 8 * C.lane) = o;
    }
    __syncthreads();
}
typedef short bf16x8 __attribute__((ext_vector_type(8)));
typedef short s16x4 __attribute__((ext_vector_type(4)));
typedef short v4i16_t __attribute__((ext_vector_type(4)));
typedef float f32x16 __attribute__((ext_vector_type(16)));
constexpr int AT_O = 0, AT_L = 65536, AT_V = 66560;
__device__ __forceinline__ s16x4 vtr(const LAS char* p) { return __builtin_bit_cast(s16x4, __builtin_amdgcn_ds_read_tr16_b64_v4i16((LAS v4i16_t*)p)); }
__device__ __forceinline__ void lds_addf(LAS float* p, float v) { (void)__hip_atomic_fetch_add(p, v, __ATOMIC_RELAXED, __HIP_MEMORY_SCOPE_WORKGROUP); }
__device__ __forceinline__ int med3i(int x, int lo, int hi) { return x < lo ? lo : (x > hi ? hi : x); }
__device__ __forceinline__ void attn_unit(const Ctx& C, const bf16* __restrict__ Qh, const bf16* __restrict__ Kh, const bf16* __restrict__ Vh,
                                          int d, int tq0, int nq, int tl0, int tls, float a2, float bound2, LAS float* Oacc, LAS float* Lacc, LAS char* vst, bool first) {
    int lane_ = C.lane; asm volatile("" : "+v"(lane_));
    const int lane = lane_, r = lane & 31, hh = lane >> 5;
    const int qi = r < nq ? r : nq - 1;
    bf16x8 qf[4]; v4u ks_[2][4], vs[2][4];
    const char* Kc = (const char*)Kh; const char* Vc = (const char*)Vh;
#define AT_LOADK(kb) do { _Pragma("unroll") for (int it = 0; it < 4; ++it) { const int key = (lane >> 3) + 8 * it; \
        const unsigned ro = (unsigned)med3i(tq0 + d * (32 * (kb) + key - 64), 0, S - 1) * 128u + 16u * (lane & 7); ks_[(kb) % 2][it] = *(const v4u*)(Kc + ro); } } while (0)
#define AT_LOADV(kb) do { _Pragma("unroll") for (int it = 0; it < 4; ++it) { const int key = (lane >> 3) + 8 * it; \
        const unsigned ro = (unsigned)med3i(tq0 + d * (32 * (kb) + key - 64), 0, S - 1) * 128u + 16u * (lane & 7); vs[(kb) % 2][it] = *(const v4u*)(Vc + ro); } } while (0)
    { const char* qp = (const char*)Qh + (unsigned)(tq0 + d * qi) * 128u + 16u * hh;
#pragma unroll
      for (int ks = 0; ks < 4; ++ks) qf[ks] = *(const bf16x8*)(qp + 32 * ks); }
    AT_LOADK(0); AT_LOADV(0);
    f32x16 o0, o1;
#pragma unroll
    for (int v = 0; v < 16; ++v) { o0[v] = 0.f; o1[v] = 0.f; }
    float lsum = 0.f;
    LAS char* kst = vst, *vt = vst + 4096;
    const LAS char* vb = vt + ((lane >> 4) & 1) * 32 + (lane & 3) * 8 + (4 * hh + ((lane & 15) >> 2)) * 64;
    LAS char* vw = vt + ((lane & 7) >> 2) * 2048 + ((lane >> 3) & 15) * 64 + (lane & 3) * 16;
    LAS char* kw = kst + (lane >> 3) * 128;
    const LAS char* kr = kst + r * 128;
    const int rsw = (r >> 1) & 7;
#pragma unroll
    for (int kb = 0; kb < 5; ++kb) {
        if (kb + 1 < 5) { AT_LOADK(kb + 1); AT_LOADV(kb + 1); }
        __builtin_amdgcn_sched_barrier(0);
#pragma unroll
        for (int it = 0; it < 4; ++it) { const int key = (lane >> 3) + 8 * it;
            *(LAS v4u*)(kw + it * 1024 + (((lane & 7) ^ ((key >> 1) & 7)) << 4)) = ks_[kb % 2][it]; }
        f32x16 p;
        int relb = 32 * kb - 64 - r + 4 * hh; const int kposb = tq0 + d * (32 * kb - 64 + 4 * hh);
        asm volatile("" : "+v"(relb));
#pragma unroll
        for (int v = 0; v < 16; ++v) {
            const int rw = (v & 3) + 8 * (v >> 2), rel = relb + rw, kpos = kposb + d * rw;
            bool valid = ((unsigned)kpos < (unsigned)S) && (r < nq);
            if (kb == 0) valid = valid && (rel >= -64);
            if (kb == 4) valid = valid && (rel <= 64);
            p[v] = valid ? -(a2 * fabsf((float)rel)) - bound2 : -1e30f;
        }
        asm volatile("s_waitcnt lgkmcnt(0)" ::: "memory");
        bf16x8 kf[4];
#pragma unroll
        for (int ks = 0; ks < 4; ++ks) kf[ks] = *(const LAS bf16x8*)(kr + (((2 * ks + hh) ^ rsw) << 4));
#pragma unroll
        for (int ks = 0; ks < 4; ++ks) p = __builtin_amdgcn_mfma_f32_32x32x16_bf16(kf[ks], qf[ks], p, 0, 0, 0);
#pragma unroll
        for (int it = 0; it < 4; ++it) *(LAS v4u*)(vw + (it >> 1) * 1024 + (it & 1) * 512) = vs[kb % 2][it];
#pragma unroll
        for (int v = 0; v < 16; ++v) { p[v] = __builtin_amdgcn_exp2f(p[v]); lsum += p[v]; }
        v4u pw0, pw1;
        pw0.x = pk2(p[0], p[1]); pw0.y = pk2(p[2], p[3]); pw0.z = pk2(p[4], p[5]); pw0.w = pk2(p[6], p[7]);
        pw1.x = pk2(p[8], p[9]); pw1.y = pk2(p[10], p[11]); pw1.z = pk2(p[12], p[13]); pw1.w = pk2(p[14], p[15]);
        asm volatile("s_waitcnt lgkmcnt(0)" ::: "memory");
#pragma unroll
        for (int sdh = 0; sdh < 4; ++sdh) {
            const int dh = sdh >> 1, ss = sdh & 1;
            const s16x4 lo = vtr(vb + dh * 2048 + ss * 1024), hi = vtr(vb + dh * 2048 + ss * 1024 + 512);
            const bf16x8 vf = {lo[0], lo[1], lo[2], lo[3], hi[0], hi[1], hi[2], hi[3]};
            const bf16x8 pa = __builtin_bit_cast(bf16x8, ss == 0 ? pw0 : pw1);
            if (dh == 0) o0 = __builtin_amdgcn_mfma_f32_32x32x16_bf16(pa, vf, o0, 0, 0, 0);
            else o1 = __builtin_amdgcn_mfma_f32_32x32x16_bf16(pa, vf, o1, 0, 0, 0);
        }
        asm volatile("s_waitcnt lgkmcnt(0)" ::: "memory");
        __builtin_amdgcn_sched_barrier(0);
    }
#undef AT_LOADK
#undef AT_LOADV
    lsum += __shfl_xor(lsum, 32);
    if (lane < nq) { LAS float* lp = Lacc + tl0 + tls * lane; *lp = first ? lsum : *lp + lsum; }
#pragma unroll
    for (int v = 0; v < 16; ++v) {
        const int iq = (v & 3) + 8 * (v >> 2) + 4 * hh;
        if (v < 8 || nq == 32) { LAS float* op = Oacc + (tl0 + tls * iq) * 64 + r;
            if (first) { op[0] = o0[v]; op[32] = o1[v]; } else { const float x0 = op[0], x1 = op[32]; op[0] = x0 + o0[v]; op[32] = x1 + o1[v]; } }
    }
}
__device__ __forceinline__ void attn_phase(const Ctx& C, const Args& a) {
    const bf16* Q = (const bf16*)(a.ws + WS_PROJ + 16 * MiB);
    const bf16* K = (const bf16*)(a.ws + WS_PROJ + 32 * MiB);
    const bf16* V = (const bf16*)(a.ws + WS_PROJ + 48 * MiB);
    bf16* MIXED = (bf16*)(a.ws + WS_MIXED);
    LAS float* Oacc = (LAS float*)(C.lds + AT_O); LAS float* Lacc = (LAS float*)(C.lds + AT_L); LAS char* vst = (LAS char*)(C.lds + AT_V + C.wave * 8192);
    float mq = fabsf(a.in[7][C.lane]), mk = fabsf(a.in[8][C.lane]);
#pragma unroll
    for (int o = 1; o < 64; o <<= 1) { mq = fmaxf(mq, __shfl_xor(mq, o)); mk = fmaxf(mk, __shfl_xor(mk, o)); }
    const float bound2 = 64.f * pg8::QSCALE * mq * mk * 1.01f;
    for (int item = C.vcu; item < NB * NH * 16; item += C.G) {
        const int span = item & 15, h = (item >> 4) & 7, b = item >> 7, t0 = span * 256, w = C.wave;
        const size_t hb = (size_t)(b * NH + h) * S * 64;
        const bf16 *Qh = Q + hb, *Kh = K + hb, *Vh = V + hb;
        const float slope2 = exp2f(-(float)(h + 1)) * 1.4426950408889634f;
#pragma unroll 1
        for (int un = 0; un < 4; ++un) {
            const int d = un == 0 ? 1 : (un == 1 ? 4 : 16);
            const int tl0 = un == 0 ? 32 * w : (un == 1 ? (w >> 1) + 128 * (w & 1) : 2 * w + (un - 2));
            attn_unit(C, Qh, Kh, Vh, d, t0 + tl0, un < 2 ? 32 : 16, tl0, d, slope2 * (float)d, bound2, Oacc, Lacc, vst, un == 0);
            if (un < 2) __syncthreads();
        }
        __syncthreads();
        {
            const int q = C.tid >> 1, hf = C.tid & 1;
            const float inv = 1.f / Lacc[q];
            const LAS f32x4* op = (const LAS f32x4*)(Oacc + q * 64 + 32 * hf);
            bf16* dst = MIXED + (size_t)(b * S + t0 + q) * D + 512 + h * 64 + 32 * hf;
#pragma unroll
            for (int j = 0; j < 4; ++j) { const f32x4 x0 = op[2 * j] * inv, x1 = op[2 * j + 1] * inv; v4u o; o.x = pk2(x0[0], x0[1]); o.y = pk2(x0[2], x0[3]); o.z = pk2(x1[0], x1[1]); o.w = pk2(x1[2], x1[3]); *(v4u*)(dst + 8 * j) = o; }
        }
        __syncthreads();
    }
}

__device__ __forceinline__ void p_router(const Ctx& C, const Args& a, int layer) {
    const float* X = a.out; const float* g = a.in[20] + (size_t)layer * D;
    const float* wr = a.in[21] + (size_t)layer * D * NE; const float* br = a.in[22] + layer * NE;
    bf16* XN = (bf16*)(a.ws + WS_XN); float* AFF = (float*)(a.ws + WS_AFF);
    LAS float* wl = (LAS float*)C.lds;
    for (int i = C.tid; i < D * 4; i += NTHR) { const int k = i >> 2, qd = i & 3; const f32x4 v = *(const f32x4*)(wr + (size_t)k * NE + 4 * qd);
        const int slot = ((k >> 8) * 4 + (k & 3)) * 64 + ((k >> 2) & 63); *(LAS f32x4*)(wl + slot * 20 + 4 * qd) = v; }
    __syncthreads();
    const int gw = C.vcu * NWAVES + C.wave, NGW = C.G * NWAVES;
    for (int m = gw; m < T; m += NGW) {
        const f32x4* xr = (const f32x4*)(X + (size_t)m * D) + C.lane;
        f32x4 v[4]; float s = 0.f;
#pragma unroll
        for (int j = 0; j < 4; ++j) { v[j] = xr[64 * j]; s += (v[j][0] * v[j][0] + v[j][1] * v[j][1]) + (v[j][2] * v[j][2] + v[j][3] * v[j][3]); }
        const float r = rsqrtf(wave_sum(s) * (1.f / D) + EPS);
        float acc[NE];
#pragma unroll
        for (int e = 0; e < NE; ++e) acc[e] = 0.f;
#pragma unroll
        for (int j = 0; j < 4; ++j) {
            const f32x4 w = ((const f32x4*)g)[C.lane + 64 * j];
            const f32x4 hv = v[j] * w * r;
            v2u o; o.x = pk2(hv[0], hv[1]); o.y = pk2(hv[2], hv[3]); ((v2u*)(XN + (size_t)m * D))[C.lane + 64 * j] = o;
#pragma unroll
            for (int i = 0; i < 4; ++i) {
                const LAS float* wp = wl + ((j * 4 + i) * 64 + C.lane) * 20;
#pragma unroll
                for (int qd = 0; qd < 4; ++qd) { const f32x4 ww = *(const LAS f32x4*)(wp + 4 * qd); acc[4 * qd] += hv[i] * ww[0]; acc[4 * qd + 1] += hv[i] * ww[1]; acc[4 * qd + 2] += hv[i] * ww[2]; acc[4 * qd + 3] += hv[i] * ww[3]; }
                if (i & 1) asm volatile("" ::: "memory");
            }
        }
        float mx = -1e30f;
#pragma unroll
        for (int e = 0; e < NE; ++e) { acc[e] = wave_sum(acc[e]) + br[e]; mx = fmaxf(mx, acc[e]); }
        float sum = 0.f;
#pragma unroll
        for (int e = 0; e < NE; ++e) { acc[e] = __expf(acc[e] - mx); sum += acc[e]; }
        float mine = 0.f;
#pragma unroll
        for (int e = 0; e < NE; ++e) if (C.lane == e) mine = acc[e];
        const int b = m / S, ss = m % S;
        if (C.lane < NE) AFF[((size_t)b * NE + C.lane) * S + ss] = mine / sum;
    }
    __syncthreads();
}

__device__ __forceinline__ void p_topk_gather(const Ctx& C, const Args& a) {
    const float* AFF = (const float*)(a.ws + WS_AFF);
    int* IDX = (int*)(a.ws + WS_IDX); float* GATE = (float*)(a.ws + WS_GATE); int* SLOT = (int*)(a.ws + WS_SLOT);
    const bf16* XN = (const bf16*)(a.ws + WS_XN); bf16* XG = (bf16*)(a.ws + WS_PROJ);
    LAS unsigned* red = (LAS unsigned*)C.lds;
    LAS int* lidx = (LAS int*)(C.lds + 1024);
    LAS int* misc = (LAS int*)(C.lds + 4096);
    for (int item = C.vcu; item < NB * NE * 4; item += C.G) {
        const int be = item >> 2, qt = item & 3, b = be / NE, e = be % NE;
        unsigned key[8];
        { const v4u k0 = *(const v4u*)(AFF + (size_t)be * S + 8 * C.tid), k1 = *(const v4u*)(AFF + (size_t)be * S + 8 * C.tid + 4);
          key[0] = k0.x; key[1] = k0.y; key[2] = k0.z; key[3] = k0.w; key[4] = k1.x; key[5] = k1.y; key[6] = k1.z; key[7] = k1.w; }
        unsigned cur = 0u;
        for (int bit = 30; bit >= 0; --bit) {
            const unsigned cand = cur | (1u << bit);
            unsigned c = 0;
#pragma unroll
            for (int j = 0; j < 8; ++j) c += (key[j] >= cand) ? 1u : 0u;
#pragma unroll
            for (int o = 1; o < 64; o <<= 1) c += __shfl_xor(c, o);
            const int par = bit & 1;
            if (C.lane == 0) red[par * 8 + C.wave] = c;
            __syncthreads();
            unsigned tot = 0;
#pragma unroll
            for (int w = 0; w < 8; ++w) tot += red[par * 8 + w];
            if (tot >= (unsigned)CAP) cur = cand;
        }
        unsigned cg = 0, ce = 0;
#pragma unroll
        for (int j = 0; j < 8; ++j) { cg += (key[j] > cur) ? 1u : 0u; ce += (key[j] == cur) ? 1u : 0u; }
        unsigned pk = cg | (ce << 16), inc = pk;
#pragma unroll
        for (int o = 1; o < 64; o <<= 1) { const unsigned t = __shfl_up(inc, o); if (C.lane >= o) inc += t; }
        __syncthreads();
        if (C.lane == 63) red[16 + C.wave] = inc;
        __syncthreads();
        unsigned woff = 0, total = 0;
#pragma unroll
        for (int w = 0; w < 8; ++w) { const unsigned t = red[16 + w]; if (w < C.wave) woff += t; total += t; }
        const unsigned exc = woff + inc - pk;
        const int ngt = (int)(total & 0xffffu), need = CAP - ngt;
        int gtb = (int)(exc & 0xffffu), eqb = (int)(exc >> 16);
        const bool mineq = (C.tid >> 7) == qt;
        if (C.tid == 128 * qt) misc[0] = gtb + (eqb < need ? eqb : need);
        if (C.tid == 128 * qt + 127) {
            int g2 = gtb, e2 = eqb;
#pragma unroll
            for (int j = 0; j < 8; ++j) { g2 += (key[j] > cur) ? 1 : 0; e2 += (key[j] == cur) ? 1 : 0; }
            misc[1] = g2 + (e2 < need ? e2 : need);
        }
        if (mineq) {
            int sl[8];
#pragma unroll
            for (int j = 0; j < 8; ++j) {
                const bool gt = key[j] > cur, eq = key[j] == cur;
                const bool sel = gt || (eq && eqb < need);
                const int pos = gtb + (eqb < need ? eqb : need);
                sl[j] = sel ? pos : -1;
                if (sel) { const int tok = 8 * C.tid + j; IDX[be * CAP + pos] = b * S + tok; GATE[be * CAP + pos] = __uint_as_float(key[j]); lidx[pos] = tok; }
                gtb += gt ? 1 : 0; eqb += eq ? 1 : 0;
            }
#pragma unroll
            for (int j = 0; j < 8; ++j) SLOT[((size_t)(b * S + 8 * C.tid + j)) * NE + e] = sl[j];
        }
        __syncthreads();
        const int p0 = misc[0], p1 = misc[1];
        for (int p = p0 + (C.tid >> 7); p < p1; p += 4) {
            const int tok = lidx[p];
            const v4u v = *(const v4u*)(XN + (size_t)(b * S + tok) * D + 8 * (C.tid & 127));
            *(v4u*)(XG + (size_t)(be * CAP + p) * D + 8 * (C.tid & 127)) = v;
        }
        __syncthreads();
    }
}

__device__ __forceinline__ void p_combine(const Ctx& C, const Args& a, bool with_norm) {
    float* X = a.out; const bf16* Y = (const bf16*)(a.ws + WS_PROJ); const int* SLOT = (const int*)(a.ws + WS_SLOT);
    bf16* XN = (bf16*)(a.ws + WS_XN); const float* g = a.in[10];
    const int gw = C.vcu * NWAVES + C.wave, NGW = C.G * NWAVES;
    for (int m = gw; m < T; m += NGW) {
        const int b = m / S;
        f32x4* xr = (f32x4*)(X + (size_t)m * D) + C.lane;
        f32x4 v[4];
#pragma unroll
        for (int j = 0; j < 4; ++j) v[j] = xr[64 * j];
        const int myslot = (C.lane < NE) ? SLOT[(size_t)m * NE + C.lane] : -1;
        for (int e = 0; e < NE; ++e) {
            const int sl = __shfl(myslot, e);
            if (sl >= 0) {
                const v2u* yr = (const v2u*)(Y + ((size_t)(b * NE + e) * CAP + sl) * D) + C.lane;
#pragma unroll
                for (int j = 0; j < 4; ++j) { const v2u y = yr[64 * j]; v[j][0] += bflo(y.x); v[j][1] += bfhi(y.x); v[j][2] += bflo(y.y); v[j][3] += bfhi(y.y); }
            }
        }
#pragma unroll
        for (int j = 0; j < 4; ++j) xr[64 * j] = v[j];
        if (with_norm) {
            float s = 0.f;
#pragma unroll
            for (int j = 0; j < 4; ++j) s += (v[j][0] * v[j][0] + v[j][1] * v[j][1]) + (v[j][2] * v[j][2] + v[j][3] * v[j][3]);
            const float r = rsqrtf(wave_sum(s) * (1.f / D) + EPS);
#pragma unroll
            for (int j = 0; j < 4; ++j) { const f32x4 w = ((const f32x4*)g)[C.lane + 64 * j]; v2u o; o.x = pk2(v[j][0] * r * w[0], v[j][1] * r * w[1]); o.y = pk2(v[j][2] * r * w[2], v[j][3] * r * w[3]); ((v2u*)(XN + (size_t)m * D))[C.lane + 64 * j] = o; }
        }
    }
}

constexpr size_t WS_CAR = 400 * MiB;
constexpr int S5_NC = 16, S5_CL = S / S5_NC;
__device__ __forceinline__ void s5_lambda(const Args& a, int pg, int p, float& lbr, float& lbi, float& fr, float& fi) {
    const float lr = a.in[11][pg * SP + p], li = a.in[12][pg * SP + p], dt = expf(a.in[13][pg]);
    const float mag = expf(lr * dt), ang = li * dt;
    lbr = mag * cosf(ang); lbi = mag * sinf(ang);
    const float den = lr * lr + li * li, nr = lbr - 1.f;
    fr = (nr * lr + lbi * li) / den; fi = (lbi * lr - nr * li) / den;
}
template <bool FINAL>
__device__ __forceinline__ void p_s5_pass(const Ctx& C, const Args& a) {
    const bf16* XN = (const bf16*)(a.ws + WS_XN); float* CAR = (float*)(a.ws + WS_CAR); bf16* Y = (bf16*)(a.ws + WS_PROJ);
    LAS char* img = (LAS char*)(C.lds + C.wave * 8192);
    const int lane = C.lane, r = lane & 31, hh = lane >> 5;
    for (int bjob = C.vcu; bjob < 512; bjob += C.G) {
        const int g = (bjob & 7) * 8 + C.wave, c = (bjob >> 3) & 15, dir = (bjob >> 7) & 1, bp = bjob >> 8;
        const int pg = dir * SG + g;
        float lbr[2], lbi[2]; bf16x8 bfr[2], bfi[2];
#pragma unroll
        for (int nt = 0; nt < 2; ++nt) {
            float fr, fi; s5_lambda(a, pg, r + 32 * nt, lbr[nt], lbi[nt], fr, fi);
            const float* br = a.in[14] + ((size_t)pg * SP + r + 32 * nt) * SC + 8 * hh; const float* bi = a.in[15] + ((size_t)pg * SP + r + 32 * nt) * SC + 8 * hh;
            const f32x4 r0 = *(const f32x4*)br, r1 = *(const f32x4*)(br + 4), i0 = *(const f32x4*)bi, i1 = *(const f32x4*)(bi + 4);
            const f32x4 xr0 = r0 * fr - i0 * fi, xr1 = r1 * fr - i1 * fi, xi0 = i0 * fr + r0 * fi, xi1 = i1 * fr + r1 * fi;
            v4u wr_, wi_; wr_.x = pk2(xr0[0], xr0[1]); wr_.y = pk2(xr0[2], xr0[3]); wr_.z = pk2(xr1[0], xr1[1]); wr_.w = pk2(xr1[2], xr1[3]);
            wi_.x = pk2(xi0[0], xi0[1]); wi_.y = pk2(xi0[2], xi0[3]); wi_.z = pk2(xi1[0], xi1[1]); wi_.w = pk2(xi1[2], xi1[3]);
            bfr[nt] = __builtin_bit_cast(bf16x8, wr_); bfi[nt] = __builtin_bit_cast(bf16x8, wi_);
        }
        bf16x8 cf[8];
        if (FINAL) {
#pragma unroll
            for (int ks = 0; ks < 8; ++ks) {
                const int k0 = 16 * ks + 8 * hh; const bool im = k0 >= 64;
                const float* src = (im ? a.in[17] : a.in[16]) + ((size_t)pg * SC + (r & 15)) * SP + (k0 & 63);
                f32x4 c0 = *(const f32x4*)src, c1 = *(const f32x4*)(src + 4);
                const float sg = (r >= 16) ? 0.f : (im ? -1.f : 1.f);
                c0 = c0 * sg; c1 = c1 * sg;
                v4u w; w.x = pk2(c0[0], c0[1]); w.y = pk2(c0[2], c0[3]); w.z = pk2(c1[0], c1[1]); w.w = pk2(c1[2], c1[3]);
                cf[ks] = __builtin_bit_cast(bf16x8, w);
            }
        }
        float hr0 = 0.f, hi0 = 0.f, hr1 = 0.f, hi1 = 0.f;
        float* cp = CAR + ((((size_t)(dir * NB + 2 * bp + hh) * SG + g) * S5_NC + c) * SP) * 2;
        if (FINAL) { hr0 = cp[2 * r]; hi0 = cp[2 * r + 1]; hr1 = cp[2 * (r + 32)]; hi1 = cp[2 * (r + 32) + 1]; }
        const int rb = 2 * bp + ((r >> 2) & 1), rv = (r & 3) + 4 * (r >> 3);
        const LAS char* ib = img + (8 * hh + ((lane & 15) >> 2)) * 64 + ((lane >> 4) & 1) * 32 + (lane & 3) * 8;
#pragma unroll 1
        for (int tile = 0; tile < S5_CL / 16; ++tile) {
            const int sidx = c * S5_CL + tile * 16;
            const int ta = dir ? (S - 1 - (sidx + rv)) : (sidx + rv);
            const bf16x8 af = *(const bf16x8*)(XN + ((size_t)rb * S + ta) * D + g * 16 + 8 * hh);
            f32x16 z;
#pragma unroll
            for (int v = 0; v < 16; ++v) z[v] = 0.f;
            f32x16 ur0 = __builtin_amdgcn_mfma_f32_32x32x16_bf16(af, bfr[0], z, 0, 0, 0), ur1 = __builtin_amdgcn_mfma_f32_32x32x16_bf16(af, bfr[1], z, 0, 0, 0);
            f32x16 ui0 = __builtin_amdgcn_mfma_f32_32x32x16_bf16(af, bfi[0], z, 0, 0, 0), ui1 = __builtin_amdgcn_mfma_f32_32x32x16_bf16(af, bfi[1], z, 0, 0, 0);
#pragma unroll
            for (int v = 0; v < 16; ++v) {
                const float a0 = lbr[0] * hr0 - lbi[0] * hi0 + ur0[v], b0 = lbr[0] * hi0 + lbi[0] * hr0 + ui0[v];
                const float a1 = lbr[1] * hr1 - lbi[1] * hi1 + ur1[v], b1 = lbr[1] * hi1 + lbi[1] * hr1 + ui1[v];
                hr0 = a0; hi0 = b0; hr1 = a1; hi1 = b1;
                ur0[v] = a0; ui0[v] = b0; ur1[v] = a1; ui1[v] = b1;
            }
            if (FINAL) {
#define S5_WR(vec, row) do { v4u w0, w1; w0.x = pk2(vec[0], vec[1]); w0.y = pk2(vec[2], vec[3]); w0.z = pk2(vec[4], vec[5]); w0.w = pk2(vec[6], vec[7]); \
                    w1.x = pk2(vec[8], vec[9]); w1.y = pk2(vec[10], vec[11]); w1.z = pk2(vec[12], vec[13]); w1.w = pk2(vec[14], vec[15]); \
                    *(LAS v4u*)(img + (row) * 64 + 32 * hh) = w0; *(LAS v4u*)(img + (row) * 64 + 32 * hh + 16) = w1; } while (0)
                S5_WR(ur0, r); S5_WR(ur1, r + 32); S5_WR(ui0, 64 + r); S5_WR(ui1, 96 + r);
#undef S5_WR
                asm volatile("s_waitcnt lgkmcnt(0)" ::: "memory");
                f32x16 y;
#pragma unroll
                for (int v = 0; v < 16; ++v) y[v] = 0.f;
#pragma unroll
                for (int ks = 0; ks < 8; ++ks) {
                    const s16x4 lo = vtr(ib + ks * 1024), hi = vtr(ib + ks * 1024 + 256);
                    const bf16x8 hf = {lo[0], lo[1], lo[2], lo[3], hi[0], hi[1], hi[2], hi[3]};
                    y = __builtin_amdgcn_mfma_f32_32x32x16_bf16(hf, cf[ks], y, 0, 0, 0);
                }
                asm volatile("s_waitcnt lgkmcnt(0)" ::: "memory");
                if (r < 16) {
                    bf16* yp = Y + (size_t)dir * T * D + g * 16 + r;
#pragma unroll
                    for (int v = 0; v < 16; ++v) {
                        const int tb = 2 * bp + (v >> 3), tv = (v & 3) + 8 * ((v >> 2) & 1) + 4 * hh;
                        const int t = dir ? (S - 1 - (sidx + tv)) : (sidx + tv);
                        yp[((size_t)tb * S + t) * D] = (bf16)(pk2(y[v], 0.f) & 0xffffu);
                    }
                }
            }
        }
        if (!FINAL) { cp[2 * r] = hr0; cp[2 * r + 1] = hi0; cp[2 * (r + 32)] = hr1; cp[2 * (r + 32) + 1] = hi1; }
    }
}
__device__ __forceinline__ void p_s5_carry(const Ctx& C, const Args& a) {
    float* CAR = (float*)(a.ws + WS_CAR);
    const int idx = (C.vcu * NWAVES + C.wave) * 64 + C.lane;
    if (idx >= 2 * NB * SG * SP) return;
    const int st = idx & 63, g = (idx >> 6) & 63, b = (idx >> 12) & 3, dir = idx >> 14;
    float pr, pi, fr, fi; s5_lambda(a, dir * SG + g, st, pr, pi, fr, fi);
#pragma unroll
    for (int i = 0; i < 8; ++i) { const float nr = pr * pr - pi * pi, ni = 2.f * pr * pi; pr = nr; pi = ni; }
    float* cp = CAR + ((((size_t)(dir * NB + b) * SG + g) * S5_NC) * SP + st) * 2;
    float cr = 0.f, ci = 0.f;
    for (int c = 0; c < S5_NC; ++c) {
        const float er = cp[c * SP * 2], ei = cp[c * SP * 2 + 1];
        cp[c * SP * 2] = cr; cp[c * SP * 2 + 1] = ci;
        const float nr = pr * cr - pi * ci + er, ni = pr * ci + pi * cr + ei; cr = nr; ci = ni;
    }
}
__device__ __forceinline__ float gelu_t(float y) { const float u = 0.7978845608028654f * (y + 0.044715f * y * y * y); const float e = __builtin_amdgcn_exp2f(2.885390081777927f * u); const float th = 1.f - 2.f * __builtin_amdgcn_rcpf(e + 1.f); return 0.5f * y * (1.f + th); }
__device__ __forceinline__ void p_s5_post(const Ctx& C, const Args& a) {
    const float* X = a.out; const bf16* YF = (const bf16*)(a.ws + WS_PROJ); const bf16* YB = YF + (size_t)T * D;
    const float* g = a.in[10]; const float* dsk = a.in[18]; bf16* Z = (bf16*)(a.ws + WS_MIXED);
    const int gw = C.vcu * NWAVES + C.wave, NGW = C.G * NWAVES;
    for (int m = gw; m < T; m += NGW) {
        const f32x4* xr = (const f32x4*)(X + (size_t)m * D) + C.lane;
        f32x4 v[4]; float s = 0.f;
#pragma unroll
        for (int j = 0; j < 4; ++j) { v[j] = xr[64 * j]; s += (v[j][0] * v[j][0] + v[j][1] * v[j][1]) + (v[j][2] * v[j][2] + v[j][3] * v[j][3]); }
        const float r = rsqrtf(wave_sum(s) * (1.f / D) + EPS);
#pragma unroll
        for (int j = 0; j < 4; ++j) {
            const f32x4 w = ((const f32x4*)g)[C.lane + 64 * j], dd = ((const f32x4*)dsk)[C.lane + 64 * j];
            const v2u pf = ((const v2u*)(YF + (size_t)m * D))[C.lane + 64 * j], pb_ = ((const v2u*)(YB + (size_t)m * D))[C.lane + 64 * j];
            const f32x4 yf = {bflo(pf.x), bfhi(pf.x), bflo(pf.y), bfhi(pf.y)}, yb = {bflo(pb_.x), bfhi(pb_.x), bflo(pb_.y), bfhi(pb_.y)};
            const f32x4 y = yf + yb + dd * (v[j] * w * r);
            v2u o; o.x = pk2(gelu_t(y[0]), gelu_t(y[1])); o.y = pk2(gelu_t(y[2]), gelu_t(y[3])); ((v2u*)(Z + (size_t)m * D))[C.lane + 64 * j] = o;
        }
    }
}

constexpr int NPHASE = 18;
__global__ void __launch_bounds__(NTHR, 2) mk_fwd(Args args) {
    extern __shared__ __attribute__((aligned(16))) unsigned char lds_raw[];
    Ctx C;
    C.lds = (LAS unsigned char*)lds_raw;
    C.tid = threadIdx.x; C.lane = C.tid & 63; C.wave = __builtin_amdgcn_readfirstlane(C.tid >> 6);
    C.G = gridDim.x; { const int bx = blockIdx.x; C.vcu = (C.G % 8 == 0) ? (bx % 8) * (C.G / 8) + bx / 8 : bx; }
    volatile LAS unsigned* MISC = (volatile LAS unsigned*)(C.lds + LDSCTL_OFF);
    for (int u = C.tid; u < (LDS_BYTES - LDSCTL_OFF) / 4; u += NTHR) ((LAS unsigned*)(C.lds + LDSCTL_OFF))[u] = 0u;
    __syncthreads();
    int lo = args.ph_lo, hi = args.ph_hi;
    unsigned char* ws = args.ws;
    asm volatile("" : "+s"(lo), "+s"(hi), "+s"(ws));
    unsigned* ctl = (unsigned*)(ws + WS_CTL);
    const bool one_launch = (lo == 0 && hi == NPHASE);
    XcdBarrier bar; bar.bar = ctl + CW_BAR; bar.x = 0; bar.st = nullptr;
    if (one_launch) bar = xcd_barrier_post(ctl + CW_BAR, MISC + 8);
    LAS unsigned char* glds = C.lds;
#ifndef MK_ONLY
#define MK_ONLY -1
#endif
#define IN(k) ((MK_ONLY < 0 || MK_ONLY == (k) || (MK_ONLY == 4 && (k) == 13) || (MK_ONLY == 5 && (k) == 14) || (MK_ONLY == 6 && (k) == 15) || (MK_ONLY == 7 && (k) == 16) || (MK_ONLY == 8 && (k) == 17)) && lo <= (k) && (k) < hi)
#ifndef MK_DUP
#define MK_DUP 0
#endif
#define DUPBIT(k) ((MK_DUP >> ((k) < 13 ? (k) : (k) - 9)) & 1)
#define DUPX(k, ...) do { __VA_ARGS__ if (DUPBIT(k)) { __VA_ARGS__ } } while (0)
#define SEAM(k) do { if (IN(k) && IN((k) + 1)) xcd_barrier(bar); } while (0)

    if (IN(0)) { DUPX(0, p0_prologue(C, args);); } SEAM(0);
    if (IN(1)) {
 DUPX(1, {        pg8::Gemm g{(const bf16*)(ws + WS_XN), (const bf16*)(ws + WS_WIN), D}; pg8::DenseOrder So; So.init(T, INC, C.G, (int)blockIdx.x);
        pg8::EpiProj E{(bf16*)(ws + WS_PROJ), (bf16*)(ws + WS_PROJ + 16 * MiB), args.in[7], args.in[8]};
        pg8::gemm_phase<pg8::EpiProj, pg8::DenseOrder, true, true>(glds, g, So, E);
    }); } SEAM(1);
    if (IN(2)) {
 DUPX(2, {        for (int t = C.vcu; t < T / 32; t += C.G) conv_tile(C, args, t);
#ifdef MK_DUPCONV
        for (int t = C.vcu; t < T / 32; t += C.G) conv_tile(C, args, t);
#endif
        attn_phase(C, args);
    }); } SEAM(2);
    if (IN(3)) {
 DUPX(3, {        pg8::Gemm g{(const bf16*)(ws + WS_MIXED), (const bf16*)(ws + WS_WOUT), D}; pg8::DenseOrder So; So.init(T, D, C.G, (int)blockIdx.x);
        pg8::EpiRes E{args.in[0], args.out};
        pg8::gemm_phase<pg8::EpiRes, pg8::DenseOrder, true, true>(glds, g, So, E);
    }); } SEAM(3);
#define MOE_PHASES(layer, pb) do { \
        if (IN(pb)) { DUPX(pb, p_router(C, args, layer);); } SEAM(pb); \
        if (IN(pb + 1)) { DUPX(pb + 1, p_topk_gather(C, args);); } SEAM(pb + 1); \
        if (IN(pb + 2)) { DUPX(pb + 2, { \
            pg8::Gemm g{(const bf16*)(ws + WS_PROJ), (const bf16*)(ws + WS_WEXP + layer * WEXP_LAYER + WEXP_GU), D}; pg8::ExpertOrder So; So.init(8, C.G, (int)blockIdx.x); \
            pg8::EpiSwiGLU E{(bf16*)(ws + WS_H)}; \
            pg8::gemm_phase<pg8::EpiSwiGLU, pg8::ExpertOrder, true, true>(glds, g, So, E); \
        }); } SEAM(pb + 2); \
        if (IN(pb + 3)) { DUPX(pb + 3, { \
            pg8::Gemm g{(const bf16*)(ws + WS_H), (const bf16*)(ws + WS_WEXP + layer * WEXP_LAYER + WEXP_DN), EH}; pg8::ExpertOrder So; So.init(4, C.G, (int)blockIdx.x); \
            pg8::EpiDown E{(bf16*)(ws + WS_PROJ), (const float*)(ws + WS_GATE)}; \
            pg8::gemm_phase<pg8::EpiDown, pg8::ExpertOrder, true, true>(glds, g, So, E); \
        }); } SEAM(pb + 3); \
        if (IN(pb + 4)) { p_combine(C, args, layer == 0); } \
    } while (0)
    MOE_PHASES(0, 4);
    SEAM(8);
    if (IN(9)) { DUPX(9, p_s5_pass<false>(C, args);); } SEAM(9);
    if (IN(10)) { p_s5_carry(C, args); } SEAM(10);
    if (IN(11)) { DUPX(11, p_s5_pass<true>(C, args);); if (one_launch) xcd_barrier(bar); DUPX(11, p_s5_post(C, args);); } SEAM(11);
    if (IN(12)) {
        pg8::Gemm g{(const bf16*)(ws + WS_MIXED), (const bf16*)(ws + WS_WGLU), D}; pg8::DenseOrder So; So.init(T, 2 * D, C.G, (int)blockIdx.x);
        pg8::EpiGluRes E{args.out};
        pg8::gemm_phase<pg8::EpiGluRes, pg8::DenseOrder, true, true>(glds, g, So, E);
    } SEAM(12);
    MOE_PHASES(1, 13);
#undef IN
#undef SEAM
}

#ifndef MK_PER_PHASE
#define MK_PER_PHASE 0
#endif
extern "C" void kernel_launch(void* const* d_in, const int* in_sizes, int n_in, void* d_out, int out_size, void* d_ws, size_t ws_size, hipStream_t stream) {
    static int grid = 0;
    if (grid == 0) {
        if (n_in != 26 || out_size != T * D || ws_size < WS_END) { fprintf(stderr, "kernel_launch: unexpected shapes (n_in %d out %d ws %zu)\n", n_in, out_size, ws_size); grid = -1; return; }
        int dev = 0, cus = 0, per_cu = 0;
        if (hipGetDevice(&dev) != hipSuccess || hipDeviceGetAttribute(&cus, hipDeviceAttributeMultiprocessorCount, dev) != hipSuccess) { grid = -1; return; }
        if (hipFuncSetAttribute((const void*)mk_fwd, hipFuncAttributeMaxDynamicSharedMemorySize, LDS_BYTES) != hipSuccess) { fprintf(stderr, "kernel_launch: hipFuncSetAttribute failed\n"); grid = -1; return; }
        if (hipOccupancyMaxActiveBlocksPerMultiprocessor(&per_cu, (const void*)mk_fwd, NTHR, LDS_BYTES) != hipSuccess || per_cu < 1) { fprintf(stderr, "kernel_launch: occupancy query says %d blocks per CU\n", per_cu); (void)hipGetLastError(); grid = -1; return; }
        grid = cus;
    }
    if (grid < 0) return;
    (void)hipMemsetAsync((char*)d_ws + WS_CTL, 0, CTL_ZERO_BYTES, stream);
    Args a{};
    for (int i = 0; i < 26; ++i) a.in[i] = (const float*)d_in[i];
    a.out = (float*)d_out; a.ws = (unsigned char*)d_ws;
#if MK_PER_PHASE
    for (int p = 0; p < NPHASE; ++p) { a.ph_lo = p; a.ph_hi = p + 1; hipLaunchKernelGGL(mk_fwd, dim3(grid), dim3(NTHR), LDS_BYTES, stream, a); }
#else
    a.ph_lo = 0; a.ph_hi = NPHASE;
    hipLaunchKernelGGL(mk_fwd, dim3(grid), dim3(NTHR), LDS_BYTES, stream, a);
#endif
}
```

```cpp
#include <hip/hip_runtime.h>
#include <cstdint>
#include <cstdio>

namespace pg8 {
#define PG8_LAS __attribute__((address_space(3)))
typedef unsigned short bf16_t;
typedef short bf16x8 __attribute__((ext_vector_type(8)));
typedef float f32x4 __attribute__((ext_vector_type(4)));
typedef unsigned u32x4 __attribute__((ext_vector_type(4)));
constexpr int BM = 256, BK = 64, HALF = 128, HTB = HALF * BK * 2  , STAGE_BYTES = 8 * HTB, NXCD = 8, WGM = 8;

__host__ __device__ __forceinline__ int lds_byte(int r, int c) { const int st = (r >> 4) * 2 + (c >> 5), rr = r & 15, cc = c & 31, ob = rr * 64 + cc * 2; return st * 1024 + (ob ^ (((ob >> 9) & 1) << 5)); }
__host__ __device__ __forceinline__ void stage_rc(int b, int& R, int& C) { const int st = b / 1024, sb = b % 1024, swz = sb ^ (((sb >> 9) & 1) << 5); R = (st >> 1) * 16 + swz / 64; C = (st & 1) * 32 + (swz % 64) / 2; }
__host__ __device__ __forceinline__ int perm32(int rho) { const int n = rho >> 4, i = rho & 15; return 8 * (i >> 2) + 4 * n + (i & 3); }

struct Unit { int pm, pn, pb; };
struct Gemm { const bf16_t* A; const bf16_t* Bt; int K; const int* gidx; };

struct DenseOrder {
    int nM, nN, nwg, G, c;
    __device__ void init(int M, int N, int G_, int c_) { nM = M / BM; nN = N / BM; nwg = nM * nN; G = G_; c = c_; }
    __device__ bool next(int i, Unit& u) const {
        const long L = (long)i * G + c; if (L >= nwg) return false;
        int wgid = (int)L; { const int q = nwg / NXCD, r = nwg % NXCD, xcd = wgid % NXCD, off = wgid / NXCD; wgid = (xcd < r ? xcd * (q + 1) : r * (q + 1) + (xcd - r) * q) + off; }
        const int nig = WGM * nN, gid = wgid / nig, fm = gid * WGM, gsz = (nM - fm) < WGM ? (nM - fm) : WGM;
        u.pm = fm + ((wgid % nig) % gsz); u.pn = (wgid % nig) / gsz; u.pb = u.pn; return true;
    }
    __device__ __forceinline__ void a_ready(const Unit&) const {}
    __device__ __forceinline__ void done(const Unit&) const {}
};
struct ExpertOrder {
    int nN, nun, G, c;
    __device__ void init(int nN_, int G_, int c_) { nN = nN_; nun = 128 * nN_; G = G_; c = c_; }
    __device__ bool next(int i, Unit& u) const {
        const long L = (long)i * G + c; if (L >= nun) return false;
        int V = (int)L;
        if (G == 256) V = i * 256 + (c & 7) * 32 + (c >> 3);
        const int per = 8 * nN, e = V / per, r = V % per, pml = r / nN, pn = r % nN;
        u.pm = ((pml >> 1) * 16 + e) * 2 + (pml & 1); u.pn = pn; u.pb = e * nN + pn; return true;
    }
    __device__ __forceinline__ void a_ready(const Unit&) const {}
    __device__ __forceinline__ void done(const Unit&) const {}
};

typedef float f32x2 __attribute__((ext_vector_type(2)));
typedef __bf16 bf16x2_t __attribute__((ext_vector_type(2)));
__device__ __forceinline__ unsigned pk2(float lo, float hi) { f32x2 v = {lo, hi}; bf16x2_t b = __builtin_convertvector(v, bf16x2_t); return __builtin_bit_cast(unsigned, b); }
__device__ __forceinline__ float sigm(float x) { return __builtin_amdgcn_rcpf(1.f + __builtin_amdgcn_exp2f(-1.4426950408889634f * x)); }

constexpr float QSCALE = 0.125f * 1.4426950408889634f;
struct EpiProj {
    static constexpr bool PERM = true, AFTER_DRAIN = false;
    bf16_t *GLU, *Q; const float *qg, *kg;
    __device__ __forceinline__ void operator()(const f32x4 (&acc)[2][2][4][2], const Unit& u, int wr, int wc, int fr, int fq) const {
        const int row0 = u.pm * BM + wr * 64 + fr;
        if (u.pn < 4) {
            const int col0 = 128 * u.pn + 32 * wc + 8 * fq;
#pragma unroll
            for (int ai = 0; ai < 2; ++ai)
#pragma unroll
                for (int m = 0; m < 4; ++m) {
                    const f32x4 v0 = acc[ai][0][m][0], v1 = acc[ai][0][m][1], g0 = acc[ai][1][m][0], g1 = acc[ai][1][m][1];
                    u32x4 w; w.x = pk2(v0[0] * sigm(g0[0]), v0[1] * sigm(g0[1])); w.y = pk2(v0[2] * sigm(g0[2]), v0[3] * sigm(g0[3]));
                    w.z = pk2(v1[0] * sigm(g1[0]), v1[1] * sigm(g1[1])); w.w = pk2(v1[2] * sigm(g1[2]), v1[3] * sigm(g1[3]));
                    *(u32x4*)(GLU + (size_t)(row0 + ai * HALF + m * 16) * 512 + col0) = w;
                    asm volatile("" ::: "memory");
                }
        } else {
            const int t = (u.pn - 4) >> 1;
            const int hd = 4 * ((u.pn - 4) & 1) + wc;
            bf16_t* dst = Q + (size_t)t * (size_t)(8u << 20);
            const float* gp = (const float*)((uintptr_t)qg + (((uintptr_t)kg - (uintptr_t)qg) & (uintptr_t)(t == 0 ? 0 : ~(uintptr_t)0)));
#pragma unroll
            for (int ai = 0; ai < 2; ++ai)
#pragma unroll
                for (int m = 0; m < 4; ++m) {
                    float ss = 0.f;
#pragma unroll
                    for (int bj = 0; bj < 2; ++bj)
#pragma unroll
                        for (int n = 0; n < 2; ++n) { const f32x4 x = acc[ai][bj][m][n]; ss += (x[0] * x[0] + x[1] * x[1]) + (x[2] * x[2] + x[3] * x[3]); }
                    ss += __shfl_xor(ss, 16); ss += __shfl_xor(ss, 32);
                    float rs = 1.f;
                    if (t < 2) rs = rsqrtf(ss * (1.f / 64.f) + 1e-6f) * (t == 0 ? QSCALE : 1.f);
#pragma unroll
                    for (int bj = 0; bj < 2; ++bj) {
                        f32x4 g0 = {1.f, 1.f, 1.f, 1.f}, g1 = g0;
                        if (t < 2) { g0 = *(const f32x4*)(gp + 32 * bj + 8 * fq); g1 = *(const f32x4*)(gp + 32 * bj + 8 * fq + 4); }
                        const f32x4 a = acc[ai][bj][m][0] * g0 * rs, b = acc[ai][bj][m][1] * g1 * rs;
                        u32x4 w; w.x = pk2(a[0], a[1]); w.y = pk2(a[2], a[3]); w.z = pk2(b[0], b[1]); w.w = pk2(b[2], b[3]);
                        const int row = row0 + ai * HALF + m * 16;
                        *(u32x4*)(dst + ((size_t)((row >> 12) * 8 + hd) * 4096 + (row & 4095)) * 64 + 32 * bj + 8 * fq) = w;
                    }
                    asm volatile("" ::: "memory");
                }
        }
    }
};
struct EpiRes {
    static constexpr bool PERM = false, AFTER_DRAIN = false;
    const float* xin; float* X;
    __device__ __forceinline__ void operator()(const f32x4 (&acc)[2][2][4][2], const Unit& u, int wr, int wc, int fr, int fq) const {
        const int row0 = u.pm * BM + wr * 64 + fr, col0 = u.pn * BM + wc * 32 + 4 * fq;
#pragma unroll
        for (int ai = 0; ai < 2; ++ai)
#pragma unroll
            for (int m = 0; m < 4; ++m) { const size_t off = (size_t)(row0 + ai * HALF + m * 16) * 1024 + col0;
#pragma unroll
                for (int bj = 0; bj < 2; ++bj)
#pragma unroll
                    for (int n = 0; n < 2; ++n) { const f32x4 r = *(const f32x4*)(xin + off + bj * HALF + n * 16); *(f32x4*)(X + off + bj * HALF + n * 16) = r + acc[ai][bj][m][n]; } }
    }
};
struct EpiSwiGLU {
    static constexpr bool PERM = true, AFTER_DRAIN = false;
    bf16_t* H;
    __device__ __forceinline__ void operator()(const f32x4 (&acc)[2][2][4][2], const Unit& u, int wr, int wc, int fr, int fq) const {
        const int row0 = u.pm * BM + wr * 64 + fr, col0 = 128 * u.pn + 32 * wc + 8 * fq;
#pragma unroll
        for (int ai = 0; ai < 2; ++ai)
#pragma unroll
            for (int m = 0; m < 4; ++m) {
                const f32x4 g0 = acc[ai][0][m][0], g1 = acc[ai][0][m][1], u0 = acc[ai][1][m][0], u1 = acc[ai][1][m][1];
                u32x4 w; w.x = pk2(g0[0] * sigm(g0[0]) * u0[0], g0[1] * sigm(g0[1]) * u0[1]); w.y = pk2(g0[2] * sigm(g0[2]) * u0[2], g0[3] * sigm(g0[3]) * u0[3]);
                w.z = pk2(g1[0] * sigm(g1[0]) * u1[0], g1[1] * sigm(g1[1]) * u1[1]); w.w = pk2(g1[2] * sigm(g1[2]) * u1[2], g1[3] * sigm(g1[3]) * u1[3]);
                *(u32x4*)(H + (size_t)(row0 + ai * HALF + m * 16) * 1024 + col0) = w;
            }
    }
};
struct EpiDown {
    static constexpr bool PERM = true, AFTER_DRAIN = false;
    bf16_t* Y; const float* gate;
    __device__ __forceinline__ void operator()(const f32x4 (&acc)[2][2][4][2], const Unit& u, int wr, int wc, int fr, int fq) const {
        const int row0 = u.pm * BM + wr * 64 + fr, col0 = u.pn * BM + wc * 32 + 8 * fq;
#pragma unroll
        for (int ai = 0; ai < 2; ++ai)
#pragma unroll
            for (int m = 0; m < 4; ++m) { const int row = row0 + ai * HALF + m * 16; const float gs = gate[row];
#pragma unroll
                for (int bj = 0; bj < 2; ++bj) { const f32x4 a = acc[ai][bj][m][0] * gs, b = acc[ai][bj][m][1] * gs;
                    u32x4 w; w.x = pk2(a[0], a[1]); w.y = pk2(a[2], a[3]); w.z = pk2(b[0], b[1]); w.w = pk2(b[2], b[3]);
                    *(u32x4*)(Y + (size_t)row * 1024 + col0 + bj * HALF) = w; } }
    }
};
struct EpiGluRes {
    static constexpr bool PERM = false, AFTER_DRAIN = false;
    float* X;
    __device__ __forceinline__ void operator()(const f32x4 (&acc)[2][2][4][2], const Unit& u, int wr, int wc, int fr, int fq) const {
        const int row0 = u.pm * BM + wr * 64 + fr, col0 = 128 * u.pn + 32 * wc + 4 * fq;
#pragma unroll
        for (int ai = 0; ai < 2; ++ai)
#pragma unroll
            for (int m = 0; m < 4; ++m) { float* p = X + (size_t)(row0 + ai * HALF + m * 16) * 1024 + col0;
#pragma unroll
                for (int n = 0; n < 2; ++n) { const f32x4 v = acc[ai][0][m][n], g = acc[ai][1][m][n]; f32x4 r = *(const f32x4*)(p + n * 16);
                    r[0] += v[0] * sigm(g[0]); r[1] += v[1] * sigm(g[1]); r[2] += v[2] * sigm(g[2]); r[3] += v[3] * sigm(g[3]); *(f32x4*)(p + n * 16) = r; } }
    }
};

template <class Epi, class Sched, bool ALIGN_EPI = false, bool SP2 = false, bool GATHER = false>
__device__ __forceinline__ void gemm_phase(PG8_LAS unsigned char* lds, const Gemm g, const Sched& S, const Epi& E) {
    const int tid = threadIdx.x, wid = __builtin_amdgcn_readfirstlane(tid >> 6), lane = tid & 63, wr = wid >> 2, wc = wid & 3, fr = lane & 15, fq = lane >> 4;
    const int K = g.K, nt = K / BK;
    unsigned voffA[2], voffB[2];
#pragma unroll
    for (int i = 0; i < 2; ++i) { int R, C; stage_rc(tid * 16 + i * 8192, R, C); const int Rb = Epi::PERM ? ((R & ~31) + perm32(R & 31)) : R;
        voffA[i] = (unsigned)(R * K + C) * 2u; voffB[i] = (unsigned)(Rb * K + C) * 2u; }
    const size_t kstep = (size_t)(BK * 2);
    const size_t hstep = (size_t)HALF * K * 2;
    const size_t tstep = 2 * hstep;
    const unsigned ldsw = (unsigned)wid * 1024u;
    const int aoff = lds_byte(wr * 64 + fr, fq * 8), boff = lds_byte(wc * 32 + fr, fq * 8);
#define PG8_SA(b, h) (((b) * 2 + (h)) * HTB)
#define PG8_SB(b, h) ((4 + (b) * 2 + (h)) * HTB)
#define PG8_STAGE(bufoff, gbase, voff) do { _Pragma("unroll") for (int _i = 0; _i < 2; ++_i) \
        __builtin_amdgcn_global_load_lds((const unsigned*)((const char*)(gbase) + (voff)[_i]), (PG8_LAS unsigned*)(lds + (bufoff) + ldsw + _i * 8192), 16, 0, 0); } while (0)
#define PG8_STAGE_A(bufoff, gptr, h, nsel) do { if constexpr (GATHER) { const unsigned _o[2] = {(nsel) ? nOA[h][0] : oA[h][0], (nsel) ? nOA[h][1] : oA[h][1]}; PG8_STAGE(bufoff, gptr, _o); } \
        else { PG8_STAGE(bufoff, (gptr) + ((h) ? hstep : 0), voffA); } } while (0)
#define PG8_GOFF(dst, u) do { if constexpr (GATHER) { _Pragma("unroll") for (int _h = 0; _h < 2; ++_h) _Pragma("unroll") for (int _i = 0; _i < 2; ++_i) { \
        (dst)[_h][_i] = (unsigned)g.gidx[(u).pm * BM + _h * HALF + gR[_i]] * (unsigned)(K * 2) + gC[_i]; asm volatile("" : "+v"((dst)[_h][_i])); } } } while (0)
#define PG8_LDA(dst, b, h) do { _Pragma("unroll") for (int m = 0; m < 4; ++m) _Pragma("unroll") for (int k = 0; k < 2; ++k) dst[m][k] = *(const PG8_LAS bf16x8*)(lds + PG8_SA(b, h) + aoff + m * 2048 + k * 1024); } while (0)
#define PG8_LDB(dst, b, h) do { _Pragma("unroll") for (int n = 0; n < 2; ++n) _Pragma("unroll") for (int k = 0; k < 2; ++k) dst[n][k] = *(const PG8_LAS bf16x8*)(lds + PG8_SB(b, h) + boff + n * 2048 + k * 1024); } while (0)
#define PG8_MMA(ai, bj, At, Bt) do { __builtin_amdgcn_s_setprio(1); _Pragma("unroll") for (int m = 0; m < 4; ++m) _Pragma("unroll") for (int n = 0; n < 2; ++n) _Pragma("unroll") for (int k = 0; k < 2; ++k) \
        acc[ai][bj][m][n] = __builtin_amdgcn_mfma_f32_16x16x32_bf16(Bt[n][k], At[m][k], acc[ai][bj][m][n], 0, 0, 0); __builtin_amdgcn_s_setprio(0); } while (0)
#define PG8_WAIT_V(n) asm volatile("s_waitcnt vmcnt(" #n ")" ::: "memory")
#define PG8_WAIT_L(n) asm volatile("s_waitcnt lgkmcnt(" #n ")" ::: "memory")
#define PG8_BAR __builtin_amdgcn_s_barrier()
#define PG8_SCHED __builtin_amdgcn_sched_barrier(0)
    Unit cur, nxt; int ui = 0;
    if (!S.next(0, cur)) return;
    unsigned oA[2][2], nOA[2][2]; int gR[2]; unsigned gC[2];
    if constexpr (GATHER) { static_assert(SP2, "GATHER is wired into the SP2 loop only");
#pragma unroll
        for (int i = 0; i < 2; ++i) { int R, Cc; stage_rc(tid * 16 + i * 8192, R, Cc); gR[i] = R; gC[i] = (unsigned)Cc * 2u; } }
    PG8_GOFF(oA, cur);
    f32x4 acc[2][2][4][2];
#pragma unroll
    for (int a = 0; a < 2; ++a)
#pragma unroll
        for (int b = 0; b < 2; ++b)
#pragma unroll
            for (int m = 0; m < 4; ++m)
#pragma unroll
                for (int n = 0; n < 2; ++n) acc[a][b][m][n] = (f32x4){0.f, 0.f, 0.f, 0.f};
    bf16x8 At[4][2], B0[2][2], B1[2][2];
    const char* cA = (const char*)g.A + (GATHER ? (size_t)0 : (size_t)cur.pm * tstep); const char* cB = (const char*)g.Bt + (size_t)cur.pb * tstep;
    S.a_ready(cur);
    if constexpr (SP2) {
        PG8_STAGE(PG8_SB(0, 0), cB, voffB); PG8_STAGE(PG8_SB(0, 1), cB + hstep, voffB); PG8_STAGE_A(PG8_SA(0, 0), cA, 0, false); PG8_STAGE_A(PG8_SA(0, 1), cA, 1, false);
        if (wr == 1) PG8_BAR;
        PG8_WAIT_V(2); PG8_BAR;
        PG8_STAGE(PG8_SB(1, 0), cB + kstep, voffB); PG8_STAGE_A(PG8_SA(1, 0), cA + kstep, 0, false); PG8_STAGE(PG8_SB(1, 1), cB + hstep + kstep, voffB);
        PG8_WAIT_V(6); PG8_BAR;
    } else {
        PG8_STAGE(PG8_SB(0, 0), cB, voffB); PG8_STAGE(PG8_SA(0, 0), cA, voffA); PG8_STAGE(PG8_SB(0, 1), cB + hstep, voffB); PG8_STAGE(PG8_SA(0, 1), cA + hstep, voffA);
        if (wr == 1) PG8_BAR;
        PG8_WAIT_V(4); PG8_BAR;
        PG8_STAGE(PG8_SB(1, 0), cB + kstep, voffB); PG8_STAGE(PG8_SA(1, 0), cA + kstep, voffA); PG8_STAGE(PG8_SB(1, 1), cB + hstep + kstep, voffB);
        PG8_WAIT_V(6); PG8_BAR;
    }
    for (;;) {
        const bool has_next = S.next(ui + 1, nxt);
        const char* nA = has_next ? (const char*)g.A + (GATHER ? (size_t)0 : (size_t)nxt.pm * tstep) : cA; const char* nB = has_next ? (const char*)g.Bt + (size_t)nxt.pb * tstep : cB;
        if constexpr (GATHER) { if (has_next) { PG8_GOFF(nOA, nxt); } else {
#pragma unroll
            for (int _h = 0; _h < 2; ++_h) { nOA[_h][0] = oA[_h][0]; nOA[_h][1] = oA[_h][1]; } } }
        for (int t = 0; t < nt; t += 2) {
            const bool last = (t == nt - 2);
            const char* a1 = cA + (size_t)(t + 1) * kstep;
            const char* a2 = last ? nA : cA + (size_t)(t + 2) * kstep; const char* b2 = last ? nB : cB + (size_t)(t + 2) * kstep;
            const char* a3 = a2 + kstep; const char* b3 = b2 + kstep;
            if (last && has_next) S.a_ready(nxt);
            if constexpr (SP2) {
            PG8_LDB(B0, 0, 0); PG8_LDB(B1, 0, 1); PG8_SCHED; PG8_LDA(At, 0, 0); PG8_STAGE_A(PG8_SA(1, 1), a1, 1, false);
            PG8_WAIT_V(8); PG8_WAIT_L(0); PG8_BAR; PG8_MMA(0, 0, At, B0); PG8_MMA(0, 1, At, B1); PG8_BAR; PG8_SCHED;
            PG8_LDA(At, 0, 1); PG8_STAGE(PG8_SB(0, 0), b2, voffB); PG8_STAGE(PG8_SB(0, 1), b2 + hstep, voffB); PG8_STAGE_A(PG8_SA(0, 0), a2, 0, last);
            PG8_WAIT_V(8); PG8_WAIT_L(0); PG8_BAR; PG8_MMA(1, 0, At, B0); PG8_MMA(1, 1, At, B1); PG8_BAR; PG8_SCHED;
            PG8_LDB(B0, 1, 0); PG8_LDB(B1, 1, 1); PG8_SCHED; PG8_LDA(At, 1, 0); PG8_STAGE_A(PG8_SA(0, 1), a2, 1, last);
            PG8_WAIT_V(8); PG8_WAIT_L(0); PG8_BAR; PG8_MMA(0, 0, At, B0); PG8_MMA(0, 1, At, B1); PG8_BAR; PG8_SCHED;
            PG8_LDA(At, 1, 1); PG8_STAGE(PG8_SB(1, 0), b3, voffB); PG8_STAGE(PG8_SB(1, 1), b3 + hstep, voffB); PG8_STAGE_A(PG8_SA(1, 0), a3, 0, last);
            PG8_WAIT_V(8); PG8_WAIT_L(0); PG8_BAR; PG8_MMA(1, 0, At, B0); PG8_MMA(1, 1, At, B1); PG8_BAR; PG8_SCHED;
            } else {
            PG8_LDB(B0, 0, 0); PG8_SCHED; PG8_LDA(At, 0, 0); PG8_STAGE(PG8_SA(1, 1), a1 + hstep, voffA);
            PG8_WAIT_L(8); PG8_BAR; PG8_WAIT_L(0); PG8_MMA(0, 0, At, B0); PG8_BAR; PG8_SCHED;
            PG8_LDB(B1, 0, 1); PG8_STAGE(PG8_SB(0, 0), b2, voffB);
            PG8_BAR; PG8_WAIT_L(0); PG8_MMA(0, 1, At, B1); PG8_BAR;
            PG8_LDA(At, 0, 1); PG8_STAGE(PG8_SA(0, 0), a2, voffA);
            PG8_BAR; PG8_WAIT_L(0); PG8_MMA(1, 0, At, B0); PG8_BAR; PG8_SCHED;
            PG8_STAGE(PG8_SB(0, 1), b2 + hstep, voffB);
            PG8_WAIT_V(6); PG8_BAR; PG8_MMA(1, 1, At, B1); PG8_BAR;
            PG8_LDB(B0, 1, 0); PG8_SCHED; PG8_LDA(At, 1, 0); PG8_STAGE(PG8_SA(0, 1), a2 + hstep, voffA);
            PG8_WAIT_L(8); PG8_BAR; PG8_WAIT_L(0); PG8_MMA(0, 0, At, B0); PG8_BAR; PG8_SCHED;
            PG8_LDB(B1, 1, 1); PG8_STAGE(PG8_SB(1, 0), b3, voffB);
            PG8_BAR; PG8_WAIT_L(0); PG8_MMA(0, 1, At, B1); PG8_BAR;
            PG8_LDA(At, 1, 1); PG8_STAGE(PG8_SA(1, 0), a3, voffA);
            PG8_BAR; PG8_WAIT_L(0); PG8_MMA(1, 0, At, B0); PG8_BAR; PG8_SCHED;
            PG8_STAGE(PG8_SB(1, 1), b3 + hstep, voffB);
            PG8_WAIT_V(6); PG8_BAR; PG8_MMA(1, 1, At, B1); PG8_BAR;
            }
        }
        if constexpr (ALIGN_EPI) { if (wr == 0) PG8_BAR; }
        if constexpr (!Epi::AFTER_DRAIN) { E(acc, cur, wr, wc, fr, fq); S.done(cur); }
        if (!has_next) break;
#pragma unroll
        for (int a = 0; a < 2; ++a)
#pragma unroll
            for (int b = 0; b < 2; ++b)
#pragma unroll
                for (int m = 0; m < 4; ++m)
#pragma unroll
                    for (int n = 0; n < 2; ++n) acc[a][b][m][n] = (f32x4){0.f, 0.f, 0.f, 0.f};
        cur = nxt; cA = nA; cB = nB; ++ui;
        if constexpr (GATHER) {
#pragma unroll
            for (int _h = 0; _h < 2; ++_h) { oA[_h][0] = nOA[_h][0]; oA[_h][1] = nOA[_h][1]; } }
        if constexpr (ALIGN_EPI) { if (wr == 1) PG8_BAR; }
    }
    PG8_WAIT_V(0);
    if constexpr (!ALIGN_EPI) { if (wr == 0) PG8_BAR; }
    PG8_BAR;
    if constexpr (Epi::AFTER_DRAIN) { E.fused(acc, cur, wr, wc, fr, fq, lds, wid, lane); S.done(cur); }
#undef PG8_SA
#undef PG8_SB
#undef PG8_STAGE
#undef PG8_LDA
#undef PG8_STAGE_A
#undef PG8_GOFF
#undef PG8_LDB
#undef PG8_MMA
#undef PG8_WAIT_V
#undef PG8_WAIT_L
#undef PG8_BAR
#undef PG8_SCHED
}
}

constexpr int NB = 4, S = 4096, D = 1024, T = NB * S;
constexpr int CONV_CH = 512, CONV_W = 31, NH = 8, INC = 2560;
constexpr int SG = 64, SC = 16, SP = 64;
constexpr int NE = 16, CAP = 512, EH = 1024, MR = NB * NE * CAP;
constexpr float EPS = 1e-6f;
constexpr int NWAVES = 8, NTHR = NWAVES * 64;

constexpr size_t MiB = 1u << 20;
constexpr size_t WS_CTL = 0, CTL_ZERO_BYTES = 64 * 1024;
constexpr size_t WS_AFF = 1 * MiB, WS_IDX = 2 * MiB, WS_GATE = 2 * MiB + 512 * 1024, WS_SLOT = 3 * MiB;
constexpr size_t WS_WIN = 4 * MiB, WS_WOUT = 10 * MiB, WS_WGLU = 12 * MiB;
constexpr size_t WS_WEXP = 16 * MiB, WEXP_LAYER = 96 * MiB, WEXP_GU = 0, WEXP_DN = 64 * MiB;
constexpr size_t WS_XN = 208 * MiB, WS_MIXED = 240 * MiB;
constexpr size_t WS_PROJ = 272 * MiB;
constexpr size_t WS_H = 336 * MiB;
constexpr size_t WS_XB = 404 * MiB;
constexpr size_t WS_END = 468 * MiB;
constexpr int CW_BAR = 1024, CW_Q0 = 64;

constexpr int SCRATCH_BYTES = 143360;
constexpr int LDSCTL_OFF = SCRATCH_BYTES;
constexpr int LDS_BYTES = 147456;

#define GAS __attribute__((address_space(1)))
#define LAS __attribute__((address_space(3)))
typedef unsigned short bf16;
typedef unsigned v4u __attribute__((ext_vector_type(4)));
typedef unsigned v2u __attribute__((ext_vector_type(2)));
typedef float f32x4 __attribute__((ext_vector_type(4)));
typedef float f32x2 __attribute__((ext_vector_type(2)));
using pg8::pk2;
using pg8::sigm;
__device__ __forceinline__ float bf2f(unsigned short h) { return __uint_as_float(((unsigned)h) << 16); }
__device__ __forceinline__ float bflo(unsigned w) { return __uint_as_float(w << 16); }
__device__ __forceinline__ float bfhi(unsigned w) { return __uint_as_float(w & 0xffff0000u); }
__device__ __forceinline__ float wave_sum(float v) {
#pragma unroll
    for (int o = 1; o < 64; o <<= 1) v += __shfl_xor(v, o);
    return v;
}

#define XB_TMO      128
#define XB_XCNT(j)  (256  + 64 * (j))
#define XB_XSUB(j)  (1280 + 64 * (j))
#define XB_XGEN(j)  (2304 + 64 * (j))
#define XB_TOP      3328
#define XB_TOPGEN   3392
#define XCD_BAR_WORDS 3456
#define XB_SPIN_CAP (1u << 18)
__device__ __forceinline__ unsigned xb_ld(unsigned* p)              { return __hip_atomic_load(p, __ATOMIC_RELAXED, __HIP_MEMORY_SCOPE_AGENT); }
__device__ __forceinline__ unsigned xb_add(unsigned* p, unsigned v) { return __hip_atomic_fetch_add(p, v, __ATOMIC_RELAXED, __HIP_MEMORY_SCOPE_AGENT); }
__device__ __forceinline__ unsigned xb_xcc_id() { return (unsigned)__builtin_amdgcn_s_getreg((3 << 11) | 20) & 0xFu; }
#define XB_SPIN(cond, bar) do { unsigned _sp = 0; while (cond) { __builtin_amdgcn_s_sleep(1); \
    if ((++_sp & 255u) == 0u) { if (xb_ld(&(bar)[XB_TMO])) break; if (_sp > XB_SPIN_CAP) { atomicAdd(&(bar)[XB_TMO], 1u); break; } } } } while (0)
struct XcdBarrier { unsigned* bar; unsigned x; volatile LAS unsigned* st; };
__device__ __forceinline__ XcdBarrier xcd_barrier_post(unsigned* bar, volatile LAS unsigned* st) {
    XcdBarrier b; b.bar = bar; b.x = xb_xcc_id(); b.st = st;
    if (threadIdx.x == 0) (void)xb_add(&bar[XB_XCNT(b.x)], 1u);
    return b;
}
__device__ __forceinline__ void xcd_barrier_complete(unsigned* bar, unsigned x, unsigned& nloc, unsigned& nx) {
    const unsigned G = gridDim.x * gridDim.y * gridDim.z;
    unsigned sum, cnt, mine, sp = 0u;
    for (;;) {
        sum = 0u; cnt = 0u; mine = 0u;
#pragma unroll
        for (unsigned j = 0; j < 16; ++j) { const unsigned c = xb_ld(&bar[XB_XCNT(j)]); sum += c; cnt += (c > 0u) ? 1u : 0u; mine = (j == x) ? c : mine; }
        if (sum == G) break;
        __builtin_amdgcn_s_sleep(1);
        if ((++sp & 255u) == 0u) { if (xb_ld(&bar[XB_TMO])) break; if (sp > XB_SPIN_CAP) { atomicAdd(&bar[XB_TMO], 1u); break; } }
    }
    nloc = mine > 0u ? mine : 1u; nx = cnt > 0u ? cnt : 1u;
}
__device__ __forceinline__ void xcd_barrier(const XcdBarrier& b) {
    asm volatile("s_waitcnt vmcnt(0)" ::: "memory");
    __syncthreads();
    if (threadIdx.x == 0) {
        unsigned* bar = b.bar;
        __builtin_amdgcn_s_waitcnt(0);
        unsigned nloc = b.st[0], nx = b.st[1];
        if (nloc == 0u) { xcd_barrier_complete(bar, b.x, nloc, nx); b.st[0] = nloc; b.st[1] = nx; }
        const unsigned old = xb_add(&bar[XB_XSUB(b.x)], 1u);
        const unsigned gen = old / nloc;
        if (old + 1u == (gen + 1u) * nloc) {
            __builtin_amdgcn_fence(__ATOMIC_RELEASE, "agent");
            asm volatile("s_waitcnt vmcnt(0)" ::: "memory");
            const unsigned og = xb_add(&bar[XB_TOP], 1u);
            const unsigned tg = og / nx;
            if (og + 1u == (tg + 1u) * nx) xb_add(&bar[XB_TOPGEN], 1u);
            else XB_SPIN(xb_ld(&bar[XB_TOPGEN]) == tg, bar);
            __builtin_amdgcn_fence(__ATOMIC_ACQUIRE, "agent");
            xb_add(&bar[XB_XGEN(b.x)], 1u);
            asm volatile("s_waitcnt vmcnt(0)" ::: "memory");
        } else {
            XB_SPIN(xb_ld(&bar[XB_XGEN(b.x)]) == gen, bar);
            __builtin_amdgcn_fence(__ATOMIC_ACQUIRE, "agent");
            asm volatile("s_waitcnt vmcnt(0)" ::: "memory");
        }
    }
    __syncthreads();
}

struct Args {
    const float* in[26]; float* out; unsigned char* ws; int ph_lo, ph_hi;
};
struct Ctx { LAS unsigned char* lds; int tid, lane, wave, vcu, G; };

__device__ __forceinline__ int rowmap(int kind, int half, int n) {
    if (kind == 0) {
        if (n < 1024) { const int hf = n >> 9, r = n & 511; return 256 * (r >> 7) + 128 * hf + (r & 127); }
        const int pn = n >> 8, w = n & 255, wc = w >> 6, bj = (w >> 5) & 1, j = w & 31; return 256 * pn + 128 * bj + 32 * wc + j;
    }
    if (kind == 2) { const int hf = n >> 10, r = n & 1023; return 256 * (r >> 7) + 128 * hf + (r & 127); }
    if (kind == 3) return 256 * (n >> 7) + 128 * half + (n & 127);
    return n;
}
struct ConvDesc { const float* src; bf16* dst; int N, kind, half, k0, n0; };
__device__ __forceinline__ bool conv_desc(const Args& a, int it, ConvDesc& d) {
    constexpr int I_IN = 16 * 40, I_OUT = 256, I_GLU = 16 * 32, I_EXP = 2 * 16 * 3 * 256;
    if (it >= I_IN + I_OUT + I_GLU + I_EXP) return false;
    unsigned char* ws = a.ws; int r = it, kb, nb;
    if (r < I_IN) { d.src = a.in[2]; d.N = INC; d.dst = (bf16*)(ws + WS_WIN); d.kind = 0; d.half = 0; kb = r / 40; nb = r % 40; }
    else if ((r -= I_IN) < I_OUT) { d.src = a.in[9]; d.N = D; d.dst = (bf16*)(ws + WS_WOUT); d.kind = 1; d.half = 0; kb = r >> 4; nb = r & 15; }
    else if ((r -= I_OUT) < I_GLU) { d.src = a.in[19]; d.N = 2 * D; d.dst = (bf16*)(ws + WS_WGLU); d.kind = 2; d.half = 0; kb = r >> 5; nb = r & 31; }
    else { r -= I_GLU; const int mat = r >> 8, tile = r & 255, layer = mat / 48, rem = mat % 48, e = rem / 3, which = rem % 3;
        d.src = a.in[23 + which] + ((size_t)layer * NE + e) * (size_t)D * EH; d.N = EH;
        d.dst = (bf16*)(ws + WS_WEXP + layer * WEXP_LAYER + (which == 2 ? WEXP_DN + (size_t)e * 2 * MiB : WEXP_GU + (size_t)e * 4 * MiB));
        d.kind = which == 2 ? 1 : 3; d.half = which; kb = tile >> 4; nb = tile & 15; }
    d.k0 = 64 * kb; d.n0 = 64 * nb; return true;
}
__device__ __forceinline__ void conv_load(const ConvDesc& d, f32x4 (&v)[16], int lane) {
    const float* p = d.src + (size_t)(d.k0 + (lane >> 4)) * d.N + d.n0 + 4 * (lane & 15);
#pragma unroll
    for (int it = 0; it < 16; ++it) v[it] = *(const f32x4*)(p + (size_t)(4 * it) * d.N);
}
__device__ __forceinline__ void conv_store(const ConvDesc& d, const f32x4 (&v)[16], LAS float* scr, int lane) {
#pragma unroll
    for (int it = 0; it < 16; ++it) { const int kk = 4 * it + (lane >> 4), nn = 4 * (lane & 15);
        scr[kk * 65 + nn] = v[it][0]; scr[kk * 65 + nn + 1] = v[it][1]; scr[kk * 65 + nn + 2] = v[it][2]; scr[kk * 65 + nn + 3] = v[it][3]; }
    asm volatile("s_waitcnt lgkmcnt(0)" ::: "memory");
    const int kc = lane & 7;
#pragma unroll
    for (int jt = 0; jt < 8; ++jt) {
        const int nl = 8 * jt + (lane >> 3);
        const LAS float* s = scr + (8 * kc) * 65 + nl;
        v4u o; o.x = pk2(s[0], s[65]); o.y = pk2(s[2 * 65], s[3 * 65]); o.z = pk2(s[4 * 65], s[5 * 65]); o.w = pk2(s[6 * 65], s[7 * 65]);
        *(v4u*)(d.dst + (size_t)rowmap(d.kind, d.half, d.n0 + nl) * 1024 + d.k0 + 8 * kc) = o;
    }
    asm volatile("s_waitcnt lgkmcnt(0)" ::: "memory");
}
__device__ __forceinline__ void rms_row_bf16(const float* __restrict__ xrow, const float* __restrict__ g, bf16* __restrict__ orow, int lane) {
    const f32x4* xr = (const f32x4*)xrow + lane;
    f32x4 v[4]; float s = 0.f;
#pragma unroll
    for (int j = 0; j < 4; ++j) { v[j] = xr[64 * j]; s += (v[j][0] * v[j][0] + v[j][1] * v[j][1]) + (v[j][2] * v[j][2] + v[j][3] * v[j][3]); }
    const float r = rsqrtf(wave_sum(s) * (1.f / D) + EPS);
#pragma unroll
    for (int j = 0; j < 4; ++j) { const f32x4 w = ((const f32x4*)g)[lane + 64 * j]; v2u o; o.x = pk2(v[j][0] * r * w[0], v[j][1] * r * w[1]); o.y = pk2(v[j][2] * r * w[2], v[j][3] * r * w[3]); ((v2u*)orow)[lane + 64 * j] = o; }
}
__device__ __forceinline__ void p0_prologue(const Ctx& C, const Args& a) {
    LAS float* scr = (LAS float*)(C.lds + C.wave * 16640);
    const int gw = C.vcu * NWAVES + C.wave, NGW = C.G * NWAVES;
    unsigned char* ws = a.ws;
    for (int m = gw; m < T; m += NGW) rms_row_bf16(a.in[0] + (size_t)m * D, a.in[1], (bf16*)(ws + WS_XN) + (size_t)m * D, C.lane);
    unsigned* qhead = (unsigned*)(ws + WS_CTL) + CW_Q0;
    LAS int* qs = (LAS int*)(C.lds + 8 * 16640);
    ConvDesc dA; f32x4 vA[16];
    for (;;) {
        if (C.tid == 0) qs[0] = (int)__hip_atomic_fetch_add(qhead, 8u, __ATOMIC_RELAXED, __HIP_MEMORY_SCOPE_AGENT);
        __syncthreads();
        const int base = qs[0];
        __syncthreads();
        if (base >= 25984) break;
        if (conv_desc(a, base + C.wave, dA)) { conv_load(dA, vA, C.lane); conv_store(dA, vA, scr, C.lane); }
    }
}

__device__ __forceinline__ void conv_tile(const Ctx& C, const Args& a, int tile) {
    const bf16* GLU = (const bf16*)(a.ws + WS_PROJ);
    bf16* MIXED = (bf16*)(a.ws + WS_MIXED);
    const float* cw = a.in[3]; const float* cb = a.in[4]; const float* lg = a.in[5]; const float* lb = a.in[6];
    LAS float* tl = (LAS float*)C.lds;
    const int cp = C.tid & 255, th = C.tid >> 8;
    const int b = tile / (S / 32), s0 = (tile % (S / 32)) * 32;
    f32x2 w[CONV_W];
#pragma unroll
    for (int j = 0; j < CONV_W; ++j) w[j] = *(const f32x2*)(cw + j * CONV_CH + 2 * cp);
    f32x2 acc[16];
    const f32x2 bias = *(const f32x2*)(cb + 2 * cp);
#pragma unroll
    for (int k = 0; k < 16; ++k) acc[k] = bias;
    unsigned xin[46];
#pragma unroll
    for (int i = 0; i < 46; ++i) { const int ss = s0 + 16 * th - 15 + i; xin[i] = (ss >= 0 && ss < S) ? *(const unsigned*)(GLU + (size_t)(b * S + ss) * 512 + 2 * cp) : 0u; }
#pragma unroll
    for (int i = 0; i < 46; ++i) {
        const f32x2 x = {bflo(xin[i]), bfhi(xin[i])};
#pragma unroll
        for (int k = 0; k < 16; ++k) { const int j = i - k; if (j >= 0 && j < CONV_W) acc[k] += w[j] * x; }
    }
#pragma unroll
    for (int k = 0; k < 16; ++k) *(LAS f32x2*)(tl + (16 * th + k) * 512 + 2 * cp) = acc[k];
    __syncthreads();
#pragma unroll
    for (int q = 0; q < 4; ++q) {
        const int tok = 4 * C.wave + q;
        const f32x4 v0 = *(const LAS f32x4*)(tl + tok * 512 + 8 * C.lane), v1 = *(const LAS f32x4*)(tl + tok * 512 + 8 * C.lane + 4);
        const float mu = wave_sum((v0[0] + v0[1]) + (v0[2] + v0[3]) + (v1[0] + v1[1]) + (v1[2] + v1[3])) * (1.f / CONV_CH);
        const f32x4 d0 = v0 - mu, d1 = v1 - mu;
        const float var = wave_sum((d0[0] * d0[0] + d0[1] * d0[1]) + (d0[2] * d0[2] + d0[3] * d0[3]) + (d1[0] * d1[0] + d1[1] * d1[1]) + (d1[2] * d1[2] + d1[3] * d1[3])) * (1.f / CONV_CH);
        const float rs = rsqrtf(var + EPS);
        const f32x4 g0 = *(const f32x4*)(lg + 8 * C.lane), g1 = *(const f32x4*)(lg + 8 * C.lane + 4), b0 = *(const f32x4*)(lb + 8 * C.lane), b1 = *(const f32x4*)(lb + 8 * C.lane + 4);
        f32x4 y0 = d0 * rs * g0 + b0, y1 = d1 * rs * g1 + b1;
#pragma unroll
        for (int e = 0; e < 4; ++e) { y0[e] = y0[e] * sigm(y0[e]); y1[e] = y1[e] * sigm(y1[e]); }
        v4u o; o.x = pk2(y0[0], y0[1]); o.y = pk2(y0[2], y0[3]); o.z = pk2(y1[0], y1[1]); o.w = pk2(y1[2], y1[3]);
        *(v4u*)(MIXED + (size_t)(b * S + s0 + tok) * D + 8 * C.lane) = o;
    }
    __syncthreads();
}
typedef short bf16x8 __attribute__((ext_vector_type(8)));
typedef short s16x4 __attribute__((ext_vector_type(4)));
typedef short v4i16_t __attribute__((ext_vector_type(4)));
typedef float f32x16 __attribute__((ext_vector_type(16)));
constexpr int AT_O = 0, AT_L = 65536, AT_V = 66560;
__device__ __forceinline__ s16x4 vtr(const LAS char* p) { return __builtin_bit_cast(s16x4, __builtin_amdgcn_ds_read_tr16_b64_v4i16((LAS v4i16_t*)p)); }
__device__ __forceinline__ void lds_addf(LAS float* p, float v) { (void)__hip_atomic_fetch_add(p, v, __ATOMIC_RELAXED, __HIP_MEMORY_SCOPE_WORKGROUP); }
__device__ __forceinline__ int med3i(int x, int lo, int hi) { return x < lo ? lo : (x > hi ? hi : x); }
__device__ __forceinline__ void attn_unit(const Ctx& C, const bf16* __restrict__ Qh, const bf16* __restrict__ Kh, const bf16* __restrict__ Vh,
                                          int d, int tq0, int nq, int tl0, int tls, float a2, float bound2, LAS float* Oacc, LAS float* Lacc, LAS char* vst, bool first) {
    int lane_ = C.lane; asm volatile("" : "+v"(lane_));
    const int lane = lane_, r = lane & 31, hh = lane >> 5;
    const int qi = r < nq ? r : nq - 1;
    bf16x8 qf[4]; v4u ks_[2][4], vs[2][4];
    const char* Kc = (const char*)Kh; const char* Vc = (const char*)Vh;
#define AT_LOADK(kb) do { _Pragma("unroll") for (int it = 0; it < 4; ++it) { const int key = (lane >> 3) + 8 * it; \
        const unsigned ro = (unsigned)med3i(tq0 + d * (32 * (kb) + key - 64), 0, S - 1) * 128u + 16u * (lane & 7); ks_[(kb) % 2][it] = *(const v4u*)(Kc + ro); } } while (0)
#define AT_LOADV(kb) do { _Pragma("unroll") for (int it = 0; it < 4; ++it) { const int key = (lane >> 3) + 8 * it; \
        const unsigned ro = (unsigned)med3i(tq0 + d * (32 * (kb) + key - 64), 0, S - 1) * 128u + 16u * (lane & 7); vs[(kb) % 2][it] = *(const v4u*)(Vc + ro); } } while (0)
    { const char* qp = (const char*)Qh + (unsigned)(tq0 + d * qi) * 128u + 16u * hh;
#pragma unroll
      for (int ks = 0; ks < 4; ++ks) qf[ks] = *(const bf16x8*)(qp + 32 * ks); }
    AT_LOADK(0); AT_LOADV(0);
    f32x16 o0, o1;
#pragma unroll
    for (int v = 0; v < 16; ++v) { o0[v] = 0.f; o1[v] = 0.f; }
    float lsum = 0.f;
    LAS char* kst = vst, *vt = vst + 4096;
    const LAS char* vb = vt + ((lane >> 4) & 1) * 32 + (lane & 3) * 8 + (4 * hh + ((lane & 15) >> 2)) * 64;
    LAS char* vw = vt + ((lane & 7) >> 2) * 2048 + ((lane >> 3) & 15) * 64 + (lane & 3) * 16;
    LAS char* kw = kst + (lane >> 3) * 128;
    const LAS char* kr = kst + r * 128;
    const int rsw = (r >> 1) & 7;
#pragma unroll
    for (int kb = 0; kb < 5; ++kb) {
        if (kb + 1 < 5) { AT_LOADK(kb + 1); AT_LOADV(kb + 1); }
        __builtin_amdgcn_sched_barrier(0);
#pragma unroll
        for (int it = 0; it < 4; ++it) { const int key = (lane >> 3) + 8 * it;
            *(LAS v4u*)(kw + it * 1024 + (((lane & 7) ^ ((key >> 1) & 7)) << 4)) = ks_[kb % 2][it]; }
        f32x16 p;
        int relb = 32 * kb - 64 - r + 4 * hh; const int kposb = tq0 + d * (32 * kb - 64 + 4 * hh);
        asm volatile("" : "+v"(relb));
#pragma unroll
        for (int v = 0; v < 16; ++v) {
            const int rw = (v & 3) + 8 * (v >> 2), rel = relb + rw, kpos = kposb + d * rw;
            bool valid = ((unsigned)kpos < (unsigned)S) && (r < nq);
            if (kb == 0) valid = valid && (rel >= -64);
            if (kb == 4) valid = valid && (rel <= 64);
            p[v] = valid ? -(a2 * fabsf((float)rel)) - bound2 : -1e30f;
        }
        asm volatile("s_waitcnt lgkmcnt(0)" ::: "memory");
        bf16x8 kf[4];
#pragma unroll
        for (int ks = 0; ks < 4; ++ks) kf[ks] = *(const LAS bf16x8*)(kr + (((2 * ks + hh) ^ rsw) << 4));
#pragma unroll
        for (int ks = 0; ks < 4; ++ks) p = __builtin_amdgcn_mfma_f32_32x32x16_bf16(kf[ks], qf[ks], p, 0, 0, 0);
#pragma unroll
        for (int it = 0; it < 4; ++it) *(LAS v4u*)(vw + (it >> 1) * 1024 + (it & 1) * 512) = vs[kb % 2][it];
#pragma unroll
        for (int v = 0; v < 16; ++v) { p[v] = __builtin_amdgcn_exp2f(p[v]); lsum += p[v]; }
        v4u pw0, pw1;
        pw0.x = pk2(p[0], p[1]); pw0.y = pk2(p[2], p[3]); pw0.z = pk2(p[4], p[5]); pw0.w = pk2(p[6], p[7]);
        pw1.x = pk2(p[8], p[9]); pw1.y = pk2(p[10], p[11]); pw1.z = pk2(p[12], p[13]); pw1.w = pk2(p[14], p[15]);
        asm volatile("s_waitcnt lgkmcnt(0)" ::: "memory");
#pragma unroll
        for (int sdh = 0; sdh < 4; ++sdh) {
            const int dh = sdh >> 1, ss = sdh & 1;
            const s16x4 lo = vtr(vb + dh * 2048 + ss * 1024), hi = vtr(vb + dh * 2048 + ss * 1024 + 512);
            const bf16x8 vf = {lo[0], lo[1], lo[2], lo[3], hi[0], hi[1], hi[2], hi[3]};
            const bf16x8 pa = __builtin_bit_cast(bf16x8, ss == 0 ? pw0 : pw1);
            if (dh == 0) o0 = __builtin_amdgcn_mfma_f32_32x32x16_bf16(pa, vf, o0, 0, 0, 0);
            else o1 = __builtin_amdgcn_mfma_f32_32x32x16_bf16(pa, vf, o1, 0, 0, 0);
        }
        asm volatile("s_waitcnt lgkmcnt(0)" ::: "memory");
        __builtin_amdgcn_sched_barrier(0);
    }
#undef AT_LOADK
#undef AT_LOADV
    lsum += __shfl_xor(lsum, 32);
    if (lane < nq) { LAS float* lp = Lacc + tl0 + tls * lane; *lp = first ? lsum : *lp + lsum; }
#pragma unroll
    for (int v = 0; v < 16; ++v) {
        const int iq = (v & 3) + 8 * (v >> 2) + 4 * hh;
        if (v < 8 || nq == 32) { LAS float* op = Oacc + (tl0 + tls * iq) * 64 + r;
            if (first) { op[0] = o0[v]; op[32] = o1[v]; } else { const float x0 = op[0], x1 = op[32]; op[0] = x0 + o0[v]; op[32] = x1 + o1[v]; } }
    }
}
__device__ __forceinline__ void attn_phase(const Ctx& C, const Args& a) {
    const bf16* Q = (const bf16*)(a.ws + WS_PROJ + 16 * MiB);
    const bf16* K = (const bf16*)(a.ws + WS_PROJ + 32 * MiB);
    const bf16* V = (const bf16*)(a.ws + WS_PROJ + 48 * MiB);
    bf16* MIXED = (bf16*)(a.ws + WS_MIXED);
    LAS float* Oacc = (LAS float*)(C.lds + AT_O); LAS float* Lacc = (LAS float*)(C.lds + AT_L); LAS char* vst = (LAS char*)(C.lds + AT_V + C.wave * 8192);
    float mq = fabsf(a.in[7][C.lane]), mk = fabsf(a.in[8][C.lane]);
#pragma unroll
    for (int o = 1; o < 64; o <<= 1) { mq = fmaxf(mq, __shfl_xor(mq, o)); mk = fmaxf(mk, __shfl_xor(mk, o)); }
    const float bound2 = 64.f * pg8::QSCALE * mq * mk * 1.01f;
    for (int item = C.vcu; item < NB * NH * 16; item += C.G) {
        const int span = item & 15, h = (item >> 4) & 7, b = item >> 7, t0 = span * 256, w = C.wave;
        const size_t hb = (size_t)(b * NH + h) * S * 64;
        const bf16 *Qh = Q + hb, *Kh = K + hb, *Vh = V + hb;
        const float slope2 = exp2f(-(float)(h + 1)) * 1.4426950408889634f;
#pragma unroll 1
        for (int un = 0; un < 4; ++un) {
            const int d = un == 0 ? 1 : (un == 1 ? 4 : 16);
            const int tl0 = un == 0 ? 32 * w : (un == 1 ? (w >> 1) + 128 * (w & 1) : 2 * w + (un - 2));
            attn_unit(C, Qh, Kh, Vh, d, t0 + tl0, un < 2 ? 32 : 16, tl0, d, slope2 * (float)d, bound2, Oacc, Lacc, vst, un == 0);
            if (un < 2) __syncthreads();
        }
        __syncthreads();
        {
            const int q = C.tid >> 1, hf = C.tid & 1;
            const float inv = 1.f / Lacc[q];
            const LAS f32x4* op = (const LAS f32x4*)(Oacc + q * 64 + 32 * hf);
            bf16* dst = MIXED + (size_t)(b * S + t0 + q) * D + 512 + h * 64 + 32 * hf;
#pragma unroll
            for (int j = 0; j < 4; ++j) { const f32x4 x0 = op[2 * j] * inv, x1 = op[2 * j + 1] * inv; v4u o; o.x = pk2(x0[0], x0[1]); o.y = pk2(x0[2], x0[3]); o.z = pk2(x1[0], x1[1]); o.w = pk2(x1[2], x1[3]); *(v4u*)(dst + 8 * j) = o; }
        }
        __syncthreads();
    }
}

__device__ __forceinline__ void p_router(const Ctx& C, const Args& a, int layer) {
    const float* X = layer == 0 ? a.out : (const float*)(a.ws + WS_XB); const float* g = a.in[20] + (size_t)layer * D;
    const float* wr = a.in[21] + (size_t)layer * D * NE; const float* br = a.in[22] + layer * NE;
    bf16* XN = (bf16*)(a.ws + WS_XN); float* AFF = (float*)(a.ws + WS_AFF);
    LAS float* wl = (LAS float*)C.lds;
    for (int i = C.tid; i < D * 4; i += NTHR) { const int k = i >> 2, qd = i & 3; const f32x4 v = *(const f32x4*)(wr + (size_t)k * NE + 4 * qd);
        const int slot = ((k >> 8) * 4 + (k & 3)) * 64 + ((k >> 2) & 63); *(LAS f32x4*)(wl + slot * 20 + 4 * qd) = v; }
    __syncthreads();
    const int gw = C.vcu * NWAVES + C.wave, NGW = C.G * NWAVES;
    for (int m = gw; m < T; m += NGW) {
        const f32x4* xr = (const f32x4*)(X + (size_t)m * D) + C.lane;
        f32x4 v[4]; float s = 0.f;
#pragma unroll
        for (int j = 0; j < 4; ++j) { v[j] = xr[64 * j]; s += (v[j][0] * v[j][0] + v[j][1] * v[j][1]) + (v[j][2] * v[j][2] + v[j][3] * v[j][3]); }
        const float r = rsqrtf(wave_sum(s) * (1.f / D) + EPS);
        float acc[NE];
#pragma unroll
        for (int e = 0; e < NE; ++e) acc[e] = 0.f;
#pragma unroll
        for (int j = 0; j < 4; ++j) {
            const f32x4 w = ((const f32x4*)g)[C.lane + 64 * j];
            const f32x4 hv = v[j] * w * r;
            v2u o; o.x = pk2(hv[0], hv[1]); o.y = pk2(hv[2], hv[3]); ((v2u*)(XN + (size_t)m * D))[C.lane + 64 * j] = o;
#pragma unroll
            for (int i = 0; i < 4; ++i) {
                const LAS float* wp = wl + ((j * 4 + i) * 64 + C.lane) * 20;
#pragma unroll
                for (int qd = 0; qd < 4; ++qd) { const f32x4 ww = *(const LAS f32x4*)(wp + 4 * qd); acc[4 * qd] += hv[i] * ww[0]; acc[4 * qd + 1] += hv[i] * ww[1]; acc[4 * qd + 2] += hv[i] * ww[2]; acc[4 * qd + 3] += hv[i] * ww[3]; }
                if (i & 1) asm volatile("" ::: "memory");
            }
        }
        float mx = -1e30f;
#pragma unroll
        for (int e = 0; e < NE; ++e) { acc[e] = wave_sum(acc[e]) + br[e]; mx = fmaxf(mx, acc[e]); }
        float sum = 0.f;
#pragma unroll
        for (int e = 0; e < NE; ++e) { acc[e] = __expf(acc[e] - mx); sum += acc[e]; }
        float mine = 0.f;
#pragma unroll
        for (int e = 0; e < NE; ++e) if (C.lane == e) mine = acc[e];
        const int b = m / S, ss = m % S;
        if (C.lane < NE) AFF[((size_t)b * NE + C.lane) * S + ss] = mine / sum;
    }
    __syncthreads();
}

__device__ __forceinline__ int popc64(unsigned long long m) { return __builtin_popcountll(m); }
__device__ __forceinline__ void p_topk(const Ctx& C, const Args& a) {
    const float* AFF = (const float*)(a.ws + WS_AFF);
    int* IDX = (int*)(a.ws + WS_IDX); float* GATE = (float*)(a.ws + WS_GATE); int* SLOT = (int*)(a.ws + WS_SLOT);
    const int lane = C.lane, w = C.wave;
    for (int item = C.vcu; item < NB * NE * 4; item += C.G) {
        const int be = item >> 2, qt = item & 3, b = be / NE, e = be % NE;
        unsigned key[16][4];
#pragma unroll
        for (int j = 0; j < 16; ++j) { const v4u k = *(const v4u*)(AFF + (size_t)be * S + 256 * j + 4 * lane); key[j][0] = k.x; key[j][1] = k.y; key[j][2] = k.z; key[j][3] = k.w; }
        unsigned cur = 0u;
        LAS unsigned* curw = (LAS unsigned*)C.lds;
        if (w == 0) {
#pragma unroll 1
        for (int bit = 30; bit >= 0; --bit) {
            const unsigned cand = cur | (1u << bit);
            unsigned c4[4] = {0u, 0u, 0u, 0u};
#pragma unroll
            for (int j = 0; j < 16; ++j)
#pragma unroll
                for (int i = 0; i < 4; ++i) c4[i] += (key[j][i] >= cand) ? 1u : 0u;
            const unsigned c = (c4[0] + c4[1]) + (c4[2] + c4[3]);
            int cnt = 0;
#pragma unroll
            for (int k = 0; k < 7; ++k) cnt += popc64(__ballot((c >> k) & 1u)) << k;
            if (cnt >= CAP) cur = cand;
        }
        if (lane == 0) curw[0] = cur;
        }
        __syncthreads();
        cur = curw[0];
        __syncthreads();
        const int jj = 4 * qt + (w >> 1);
        unsigned cga = 0, pre = 0; unsigned kk[4] = {0u, 0u, 0u, 0u};
#pragma unroll
        for (int j = 0; j < 16; ++j) {
            unsigned cg = 0, ce = 0;
#pragma unroll
            for (int i = 0; i < 4; ++i) { cg += (key[j][i] > cur) ? 1u : 0u; ce += (key[j][i] == cur) ? 1u : 0u; }
            cga += cg;
            if (j < jj) pre += cg | (ce << 8);
            if (j == jj) { kk[0] = key[j][0]; kk[1] = key[j][1]; kk[2] = key[j][2]; kk[3] = key[j][3]; }
        }
        int ngt = 0, gpre = 0, epre = 0;
#pragma unroll
        for (int k = 0; k < 7; ++k) { ngt += popc64(__ballot((cga >> k) & 1u)) << k; gpre += popc64(__ballot((pre >> k) & 1u)) << k; epre += popc64(__ballot((pre >> (8 + k)) & 1u)) << k; }
        const int need = CAP - ngt;
        unsigned pk = 0;
#pragma unroll
        for (int i = 0; i < 4; ++i) pk += (kk[i] > cur ? 1u : 0u) + (kk[i] == cur ? 0x10000u : 0u);
        unsigned inc = pk;
#pragma unroll
        for (int o = 1; o < 64; o <<= 1) { const unsigned t = __shfl_up(inc, o); if (lane >= o) inc += t; }
        const unsigned exc = inc - pk;
        int gtb = gpre + (int)(exc & 0xffffu), eqb = epre + (int)(exc >> 16);
        if ((lane >> 5) == (w & 1)) {
#pragma unroll
            for (int i = 0; i < 4; ++i) {
                const bool gt = kk[i] > cur, eq = kk[i] == cur;
                const bool sel = gt || (eq && eqb < need);
                const int pos = gtb + (eqb < need ? eqb : need);
                const int tok = 256 * jj + 4 * lane + i;
                SLOT[((size_t)(b * S + tok)) * NE + e] = sel ? pos : -1;
                if (sel) { IDX[be * CAP + pos] = b * S + tok; GATE[be * CAP + pos] = __uint_as_float(kk[i]); }
                gtb += gt ? 1 : 0; eqb += eq ? 1 : 0;
            }
        }
    }
}

__device__ __forceinline__ void p_combine(const Ctx& C, const Args& a, bool with_norm) {
    const float* Xin = with_norm ? a.out : (const float*)(a.ws + WS_XB); float* Xout = with_norm ? (float*)(a.ws + WS_XB) : a.out;
    const bf16* Y = (const bf16*)(a.ws + WS_PROJ); const int* SLOT = (const int*)(a.ws + WS_SLOT);
    bf16* XN = (bf16*)(a.ws + WS_XN); const float* g = a.in[10];
    const int gw = C.vcu * NWAVES + C.wave, NGW = C.G * NWAVES;
    for (int m = gw; m < T; m += NGW) {
        const int b = m / S;
        const f32x4* xr = (const f32x4*)(Xin + (size_t)m * D) + C.lane; f32x4* xo = (f32x4*)(Xout + (size_t)m * D) + C.lane;
        f32x4 v[4];
#pragma unroll
        for (int j = 0; j < 4; ++j) v[j] = xr[64 * j];
        const int myslot = (C.lane < NE) ? SLOT[(size_t)m * NE + C.lane] : -1;
        for (int e = 0; e < NE; ++e) {
            const int sl = __shfl(myslot, e);
            if (sl >= 0) {
                const v2u* yr = (const v2u*)(Y + ((size_t)(b * NE + e) * CAP + sl) * D) + C.lane;
#pragma unroll
                for (int j = 0; j < 4; ++j) { const v2u y = yr[64 * j]; v[j][0] += bflo(y.x); v[j][1] += bfhi(y.x); v[j][2] += bflo(y.y); v[j][3] += bfhi(y.y); }
            }
        }
#pragma unroll
        for (int j = 0; j < 4; ++j) xo[64 * j] = v[j];
        if (with_norm) {
            float s = 0.f;
#pragma unroll
            for (int j = 0; j < 4; ++j) s += (v[j][0] * v[j][0] + v[j][1] * v[j][1]) + (v[j][2] * v[j][2] + v[j][3] * v[j][3]);
            const float r = rsqrtf(wave_sum(s) * (1.f / D) + EPS);
#pragma unroll
            for (int j = 0; j < 4; ++j) { const f32x4 w = ((const f32x4*)g)[C.lane + 64 * j]; v2u o; o.x = pk2(v[j][0] * r * w[0], v[j][1] * r * w[1]); o.y = pk2(v[j][2] * r * w[2], v[j][3] * r * w[3]); ((v2u*)(XN + (size_t)m * D))[C.lane + 64 * j] = o; }
        }
    }
}

constexpr size_t WS_CAR = 400 * MiB;
constexpr int S5_NC = 16, S5_CL = S / S5_NC;
__device__ __forceinline__ void s5_lambda(const Args& a, int pg, int p, float& lbr, float& lbi, float& fr, float& fi) {
    const float lr = a.in[11][pg * SP + p], li = a.in[12][pg * SP + p], dt = expf(a.in[13][pg]);
    const float mag = expf(lr * dt), ang = li * dt;
    lbr = mag * cosf(ang); lbi = mag * sinf(ang);
    const float den = lr * lr + li * li, nr = lbr - 1.f;
    fr = (nr * lr + lbi * li) / den; fi = (lbi * lr - nr * li) / den;
}
template <bool FINAL>
__device__ __forceinline__ void p_s5_pass(const Ctx& C, const Args& a) {
    const bf16* XN = (const bf16*)(a.ws + WS_XN); float* CAR = (float*)(a.ws + WS_CAR); bf16* Y = (bf16*)(a.ws + WS_PROJ);
    LAS char* img = (LAS char*)(C.lds + C.wave * 8192);
    const int lane = C.lane, r = lane & 31, hh = lane >> 5;
    for (int bjob = C.vcu; bjob < 512; bjob += C.G) {
        const int g = (bjob & 7) * 8 + C.wave, c = (bjob >> 3) & 15, dir = (bjob >> 7) & 1, bp = bjob >> 8;
        if (!FINAL && c == S5_NC - 1) continue;
        const int pg = dir * SG + g;
        float lbr[2], lbi[2]; bf16x8 bfr[2], bfi[2];
#pragma unroll
        for (int nt = 0; nt < 2; ++nt) {
            float fr, fi; s5_lambda(a, pg, r + 32 * nt, lbr[nt], lbi[nt], fr, fi);
            const float* br = a.in[14] + ((size_t)pg * SP + r + 32 * nt) * SC + 8 * hh; const float* bi = a.in[15] + ((size_t)pg * SP + r + 32 * nt) * SC + 8 * hh;
            const f32x4 r0 = *(const f32x4*)br, r1 = *(const f32x4*)(br + 4), i0 = *(const f32x4*)bi, i1 = *(const f32x4*)(bi + 4);
            const f32x4 xr0 = r0 * fr - i0 * fi, xr1 = r1 * fr - i1 * fi, xi0 = i0 * fr + r0 * fi, xi1 = i1 * fr + r1 * fi;
            v4u wr_, wi_; wr_.x = pk2(xr0[0], xr0[1]); wr_.y = pk2(xr0[2], xr0[3]); wr_.z = pk2(xr1[0], xr1[1]); wr_.w = pk2(xr1[2], xr1[3]);
            wi_.x = pk2(xi0[0], xi0[1]); wi_.y = pk2(xi0[2], xi0[3]); wi_.z = pk2(xi1[0], xi1[1]); wi_.w = pk2(xi1[2], xi1[3]);
            bfr[nt] = __builtin_bit_cast(bf16x8, wr_); bfi[nt] = __builtin_bit_cast(bf16x8, wi_);
        }
        bf16x8 cf[8];
        if (FINAL) {
#pragma unroll
            for (int ks = 0; ks < 8; ++ks) {
                const int k0 = 16 * ks + 8 * hh; const bool im = k0 >= 64;
                const float* src = (im ? a.in[17] : a.in[16]) + ((size_t)pg * SC + (r & 15)) * SP + (k0 & 63);
                f32x4 c0 = *(const f32x4*)src, c1 = *(const f32x4*)(src + 4);
                const float sg = (r >= 16) ? 0.f : (im ? -1.f : 1.f);
                c0 = c0 * sg; c1 = c1 * sg;
                v4u w; w.x = pk2(c0[0], c0[1]); w.y = pk2(c0[2], c0[3]); w.z = pk2(c1[0], c1[1]); w.w = pk2(c1[2], c1[3]);
                cf[ks] = __builtin_bit_cast(bf16x8, w);
            }
        }
        float hr0 = 0.f, hi0 = 0.f, hr1 = 0.f, hi1 = 0.f;
        float* cp0 = CAR + (((size_t)(dir * NB + 2 * bp + hh) * SG + g) * S5_NC * SP) * 2;
        if (FINAL && c > 0) {
            float p0r = lbr[0], p0i = lbi[0], p1r = lbr[1], p1i = lbi[1];
#pragma unroll
            for (int i = 0; i < 8; ++i) { const float n0r = p0r * p0r - p0i * p0i, n0i = 2.f * p0r * p0i, n1r = p1r * p1r - p1i * p1i, n1i = 2.f * p1r * p1i; p0r = n0r; p0i = n0i; p1r = n1r; p1i = n1i; }
            for (int cc = 0; cc < c; ++cc) {
                const f32x2 e0 = *(const f32x2*)(cp0 + ((size_t)cc * SP + r) * 2), e1 = *(const f32x2*)(cp0 + ((size_t)cc * SP + r + 32) * 2);
                const float a0 = p0r * hr0 - p0i * hi0 + e0[0], b0 = p0r * hi0 + p0i * hr0 + e0[1];
                const float a1 = p1r * hr1 - p1i * hi1 + e1[0], b1 = p1r * hi1 + p1i * hr1 + e1[1];
                hr0 = a0; hi0 = b0; hr1 = a1; hi1 = b1;
            }
        }
        const int rb = 2 * bp + ((r >> 2) & 1), rv = (r & 3) + 4 * (r >> 3);
        const LAS char* ib = img + (8 * hh + ((lane & 15) >> 2)) * 64 + ((lane >> 4) & 1) * 32 + (lane & 3) * 8;
        const char* xb = (const char*)(XN + (size_t)rb * S * D + g * 16 + 8 * hh);
#define S5_LOADA(tile_) (*(const bf16x8*)(xb + (size_t)(dir ? (S - 1 - (c * S5_CL + ((tile_) < 15 ? (tile_) : 15) * 16 + rv)) : (c * S5_CL + ((tile_) < 15 ? (tile_) : 15) * 16 + rv)) * (D * 2)))
        bf16x8 a0 = S5_LOADA(0), a1 = S5_LOADA(1), a2 = S5_LOADA(2), a3 = S5_LOADA(3);
        auto body = [&](bf16x8 af, const int tile) __attribute__((always_inline)) {
            asm volatile("" : "+v"(af), "+v"(hr0), "+v"(hi0), "+v"(hr1), "+v"(hi1));
            const int sidx = c * S5_CL + tile * 16;
            f32x16 z;
#pragma unroll
            for (int v = 0; v < 16; ++v) z[v] = 0.f;
            f32x16 ur0 = __builtin_amdgcn_mfma_f32_32x32x16_bf16(af, bfr[0], z, 0, 0, 0), ur1 = __builtin_amdgcn_mfma_f32_32x32x16_bf16(af, bfr[1], z, 0, 0, 0);
            f32x16 ui0 = __builtin_amdgcn_mfma_f32_32x32x16_bf16(af, bfi[0], z, 0, 0, 0), ui1 = __builtin_amdgcn_mfma_f32_32x32x16_bf16(af, bfi[1], z, 0, 0, 0);
#pragma unroll
            for (int v = 0; v < 16; ++v) {
                const float x0 = lbr[0] * hr0 - lbi[0] * hi0 + ur0[v], y0 = lbr[0] * hi0 + lbi[0] * hr0 + ui0[v];
                const float x1 = lbr[1] * hr1 - lbi[1] * hi1 + ur1[v], y1 = lbr[1] * hi1 + lbi[1] * hr1 + ui1[v];
                hr0 = x0; hi0 = y0; hr1 = x1; hi1 = y1;
                ur0[v] = x0; ui0[v] = y0; ur1[v] = x1; ui1[v] = y1;
            }
            if (FINAL) {
#define S5_WR(vec, row) do { v4u w0, w1; w0.x = pk2(vec[0], vec[1]); w0.y = pk2(vec[2], vec[3]); w0.z = pk2(vec[4], vec[5]); w0.w = pk2(vec[6], vec[7]); \
                    w1.x = pk2(vec[8], vec[9]); w1.y = pk2(vec[10], vec[11]); w1.z = pk2(vec[12], vec[13]); w1.w = pk2(vec[14], vec[15]); \
                    *(LAS v4u*)(img + (row) * 64 + 32 * hh) = w0; *(LAS v4u*)(img + (row) * 64 + 32 * hh + 16) = w1; } while (0)
                S5_WR(ur0, r); S5_WR(ur1, r + 32); S5_WR(ui0, 64 + r); S5_WR(ui1, 96 + r);
#undef S5_WR
                asm volatile("s_waitcnt lgkmcnt(0)" ::: "memory");
                f32x16 y;
#pragma unroll
                for (int v = 0; v < 16; ++v) y[v] = 0.f;
#pragma unroll
                for (int ks = 0; ks < 8; ++ks) {
                    const s16x4 lo = vtr(ib + ks * 1024), hi = vtr(ib + ks * 1024 + 256);
                    const bf16x8 hf = {lo[0], lo[1], lo[2], lo[3], hi[0], hi[1], hi[2], hi[3]};
                    y = __builtin_amdgcn_mfma_f32_32x32x16_bf16(cf[ks], hf, y, 0, 0, 0);
                }
                asm volatile("s_waitcnt lgkmcnt(0)" ::: "memory");
                const int tb = 2 * bp + (r >> 4), tv = r & 15;
                const int t = dir ? (S - 1 - (sidx + tv)) : (sidx + tv);
                bf16* yp = Y + (size_t)dir * T * D + ((size_t)tb * S + t) * D + g * 16 + 4 * hh;
                v2u w0, w1; w0.x = pk2(y[0], y[1]); w0.y = pk2(y[2], y[3]); w1.x = pk2(y[4], y[5]); w1.y = pk2(y[6], y[7]);
                *(v2u*)yp = w0; *(v2u*)(yp + 8) = w1;
            }
        };
#pragma unroll 1
        for (int tile = 0; tile < S5_CL / 16; tile += 4) {
            body(a0, tile); a0 = S5_LOADA(tile + 4);
            body(a1, tile + 1); a1 = S5_LOADA(tile + 5);
            body(a2, tile + 2); a2 = S5_LOADA(tile + 6);
            body(a3, tile + 3); a3 = S5_LOADA(tile + 7);
        }
#undef S5_LOADA
        if (!FINAL) { float* cp = cp0 + (size_t)c * SP * 2; *(f32x2*)(cp + 2 * r) = (f32x2){hr0, hi0}; *(f32x2*)(cp + 2 * (r + 32)) = (f32x2){hr1, hi1}; }
    }
}
__device__ __forceinline__ float gelu_t(float y) { const float u = 0.7978845608028654f * (y + 0.044715f * y * y * y); const float e = __builtin_amdgcn_exp2f(2.885390081777927f * u); const float th = 1.f - 2.f * __builtin_amdgcn_rcpf(e + 1.f); return 0.5f * y * (1.f + th); }
__device__ __forceinline__ void p_s5_post(const Ctx& C, const Args& a) {
    const float* X = (const float*)(a.ws + WS_XB); const bf16* YF = (const bf16*)(a.ws + WS_PROJ); const bf16* YB = YF + (size_t)T * D;
    const float* g = a.in[10]; const float* dsk = a.in[18]; bf16* Z = (bf16*)(a.ws + WS_MIXED);
    const int gw = C.vcu * NWAVES + C.wave, NGW = C.G * NWAVES;
    for (int m = gw; m < T; m += NGW) {
        const f32x4* xr = (const f32x4*)(X + (size_t)m * D) + C.lane;
        f32x4 v[4]; float s = 0.f;
#pragma unroll
        for (int j = 0; j < 4; ++j) { v[j] = xr[64 * j]; s += (v[j][0] * v[j][0] + v[j][1] * v[j][1]) + (v[j][2] * v[j][2] + v[j][3] * v[j][3]); }
        const float r = rsqrtf(wave_sum(s) * (1.f / D) + EPS);
#pragma unroll
        for (int j = 0; j < 4; ++j) {
            const f32x4 w = ((const f32x4*)g)[C.lane + 64 * j], dd = ((const f32x4*)dsk)[C.lane + 64 * j];
            const v2u pf = ((const v2u*)(YF + (size_t)m * D))[C.lane + 64 * j], pb_ = ((const v2u*)(YB + (size_t)m * D))[C.lane + 64 * j];
            const f32x4 yf = {bflo(pf.x), bfhi(pf.x), bflo(pf.y), bfhi(pf.y)}, yb = {bflo(pb_.x), bfhi(pb_.x), bflo(pb_.y), bfhi(pb_.y)};
            const f32x4 y = yf + yb + dd * (v[j] * w * r);
            v2u o; o.x = pk2(gelu_t(y[0]), gelu_t(y[1])); o.y = pk2(gelu_t(y[2]), gelu_t(y[3])); ((v2u*)(Z + (size_t)m * D))[C.lane + 64 * j] = o;
        }
    }
}

constexpr int NPHASE = 18;
__global__ void __launch_bounds__(NTHR, 2) mk_fwd(Args args) {
    extern __shared__ __attribute__((aligned(16))) unsigned char lds_raw[];
    Ctx C;
    C.lds = (LAS unsigned char*)lds_raw;
    C.tid = threadIdx.x; C.lane = C.tid & 63; C.wave = __builtin_amdgcn_readfirstlane(C.tid >> 6);
    C.G = gridDim.x; { const int bx = blockIdx.x; C.vcu = (C.G % 8 == 0) ? (bx % 8) * (C.G / 8) + bx / 8 : bx; }
    volatile LAS unsigned* MISC = (volatile LAS unsigned*)(C.lds + LDSCTL_OFF);
    for (int u = C.tid; u < (LDS_BYTES - LDSCTL_OFF) / 4; u += NTHR) ((LAS unsigned*)(C.lds + LDSCTL_OFF))[u] = 0u;
    __syncthreads();
    int lo = args.ph_lo, hi = args.ph_hi;
    unsigned char* ws = args.ws;
    asm volatile("" : "+s"(lo), "+s"(hi), "+s"(ws));
    unsigned* ctl = (unsigned*)(ws + WS_CTL);
    const bool one_launch = (lo == 0 && hi == NPHASE);
    XcdBarrier bar; bar.bar = ctl + CW_BAR; bar.x = 0; bar.st = nullptr;
    if (one_launch) bar = xcd_barrier_post(ctl + CW_BAR, MISC + 8);
    LAS unsigned char* glds = C.lds;
#ifndef MK_ONLY
#define MK_ONLY -1
#endif
#define IN(k) ((MK_ONLY < 0 || MK_ONLY == (k) || (MK_ONLY == 4 && (k) == 13) || (MK_ONLY == 5 && (k) == 14) || (MK_ONLY == 6 && (k) == 15) || (MK_ONLY == 7 && (k) == 16) || (MK_ONLY == 8 && (k) == 17)) && lo <= (k) && (k) < hi)
#ifndef MK_DUP
#define MK_DUP 0
#endif
#define DUPBIT(k) ((MK_DUP >> ((k) < 13 ? (k) : (k) - 9)) & 1)
#define DUPX(k, ...) do { __VA_ARGS__ if (DUPBIT(k)) { __VA_ARGS__ } } while (0)
#define SEAM(k) do { if (IN(k) && IN((k) + 1)) xcd_barrier(bar); } while (0)

#ifdef MK_XBAR
    if (one_launch) for (int xb_ = 0; xb_ < MK_XBAR; ++xb_) xcd_barrier(bar);
#endif
    if (IN(0)) { DUPX(0, p0_prologue(C, args);); } SEAM(0);
    if (IN(1)) {
 DUPX(1, {        pg8::Gemm g{(const bf16*)(ws + WS_XN), (const bf16*)(ws + WS_WIN), D, nullptr}; pg8::DenseOrder So; So.init(T, INC, C.G, (int)blockIdx.x);
        pg8::EpiProj E{(bf16*)(ws + WS_PROJ), (bf16*)(ws + WS_PROJ + 16 * MiB), args.in[7], args.in[8]};
        pg8::gemm_phase<pg8::EpiProj, pg8::DenseOrder, true, true>(glds, g, So, E);
    }); } SEAM(1);
    if (IN(2)) {
 DUPX(2, {        for (int t = C.vcu; t < T / 32; t += C.G) conv_tile(C, args, t);
#ifdef MK_DUPCONV
        for (int t = C.vcu; t < T / 32; t += C.G) conv_tile(C, args, t);
#endif
        attn_phase(C, args);
    }); } SEAM(2);
    if (IN(3)) {
 DUPX(3, {        pg8::Gemm g{(const bf16*)(ws + WS_MIXED), (const bf16*)(ws + WS_WOUT), D, nullptr}; pg8::DenseOrder So; So.init(T, D, C.G, (int)blockIdx.x);
        pg8::EpiRes E{args.in[0], args.out};
        pg8::gemm_phase<pg8::EpiRes, pg8::DenseOrder, true, true>(glds, g, So, E);
    }); } SEAM(3);
#define MOE_PHASES(layer, pb) do { \
        if (IN(pb)) { DUPX(pb, p_router(C, args, layer);); } SEAM(pb); \
        if (IN(pb + 1)) { DUPX(pb + 1, p_topk(C, args);); } SEAM(pb + 1); \
        if (IN(pb + 2)) { DUPX(pb + 2, { \
            pg8::Gemm g{(const bf16*)(ws + WS_XN), (const bf16*)(ws + WS_WEXP + layer * WEXP_LAYER + WEXP_GU), D, (const int*)(ws + WS_IDX)}; pg8::ExpertOrder So; So.init(8, C.G, (int)blockIdx.x); \
            pg8::EpiSwiGLU E{(bf16*)(ws + WS_H)}; \
            pg8::gemm_phase<pg8::EpiSwiGLU, pg8::ExpertOrder, true, true, true>(glds, g, So, E); \
        }); } SEAM(pb + 2); \
        if (IN(pb + 3)) { DUPX(pb + 3, { \
            pg8::Gemm g{(const bf16*)(ws + WS_H), (const bf16*)(ws + WS_WEXP + layer * WEXP_LAYER + WEXP_DN), EH, nullptr}; pg8::ExpertOrder So; So.init(4, C.G, (int)blockIdx.x); \
            pg8::EpiDown E{(bf16*)(ws + WS_PROJ), (const float*)(ws + WS_GATE)}; \
            pg8::gemm_phase<pg8::EpiDown, pg8::ExpertOrder, true, true>(glds, g, So, E); \
        }); } SEAM(pb + 3); \
        if (IN(pb + 4)) { DUPX(pb + 4, p_combine(C, args, layer == 0);); } \
    } while (0)
    MOE_PHASES(0, 4);
    SEAM(8);
    if (IN(9)) { DUPX(9, p_s5_pass<false>(C, args);); } if (IN(9) && IN(11)) xcd_barrier(bar);
    if (IN(11)) { DUPX(11, p_s5_pass<true>(C, args);); if (one_launch) xcd_barrier(bar); DUPX(11, p_s5_post(C, args);); } SEAM(11);
    if (IN(12)) {
        pg8::Gemm g{(const bf16*)(ws + WS_MIXED), (const bf16*)(ws + WS_WGLU), D, nullptr}; pg8::DenseOrder So; So.init(T, 2 * D, C.G, (int)blockIdx.x);
        pg8::EpiGluRes E{(float*)(ws + WS_XB)};
        pg8::gemm_phase<pg8::EpiGluRes, pg8::DenseOrder, true, true>(glds, g, So, E);
    } SEAM(12);
    MOE_PHASES(1, 13);
#undef IN
#undef SEAM
}

#ifndef MK_PER_PHASE
#define MK_PER_PHASE 0
#endif
extern "C" void kernel_launch(void* const* d_in, const int* in_sizes, int n_in, void* d_out, int out_size, void* d_ws, size_t ws_size, hipStream_t stream) {
    static int grid = 0;
    if (grid == 0) {
        if (n_in != 26 || out_size != T * D || ws_size < WS_END) { fprintf(stderr, "kernel_launch: unexpected shapes (n_in %d out %d ws %zu)\n", n_in, out_size, ws_size); grid = -1; return; }
        int dev = 0, cus = 0, per_cu = 0;
        if (hipGetDevice(&dev) != hipSuccess || hipDeviceGetAttribute(&cus, hipDeviceAttributeMultiprocessorCount, dev) != hipSuccess) { grid = -1; return; }
        if (hipFuncSetAttribute((const void*)mk_fwd, hipFuncAttributeMaxDynamicSharedMemorySize, LDS_BYTES) != hipSuccess) { fprintf(stderr, "kernel_launch: hipFuncSetAttribute failed\n"); grid = -1; return; }
        if (hipOccupancyMaxActiveBlocksPerMultiprocessor(&per_cu, (const void*)mk_fwd, NTHR, LDS_BYTES) != hipSuccess || per_cu < 1) { fprintf(stderr, "kernel_launch: occupancy query says %d blocks per CU\n", per_cu); (void)hipGetLastError(); grid = -1; return; }
        grid = cus;
    }
    if (grid < 0) return;
    (void)hipMemsetAsync((char*)d_ws + WS_CTL, 0, CTL_ZERO_BYTES, stream);
    Args a{};
    for (int i = 0; i < 26; ++i) a.in[i] = (const float*)d_in[i];
    a.out = (float*)d_out; a.ws = (unsigned char*)d_ws;
#if MK_PER_PHASE
    for (int p = 0; p < NPHASE; ++p) { a.ph_lo = p; a.ph_hi = p + 1; hipLaunchKernelGGL(mk_fwd, dim3(grid), dim3(NTHR), LDS_BYTES, stream, a); }
#else
    a.ph_lo = 0; a.ph_hi = NPHASE;
    hipLaunchKernelGGL(mk_fwd, dim3(grid), dim3(NTHR), LDS_BYTES, stream, a);
#endif
}
```

```cpp
#include <hip/hip_runtime.h>
#include <cstdint>
#include <cstdio>

namespace pg8 {
#define PG8_LAS __attribute__((address_space(3)))
typedef unsigned short bf16_t;
typedef short bf16x8 __attribute__((ext_vector_type(8)));
typedef float f32x4 __attribute__((ext_vector_type(4)));
typedef unsigned u32x4 __attribute__((ext_vector_type(4)));
constexpr int BM = 256, BK = 64, HALF = 128, HTB = HALF * BK * 2  , STAGE_BYTES = 8 * HTB, NXCD = 8, WGM = 8;

__host__ __device__ __forceinline__ int lds_byte(int r, int c) { const int st = (r >> 4) * 2 + (c >> 5), rr = r & 15, cc = c & 31, ob = rr * 64 + cc * 2; return st * 1024 + (ob ^ (((ob >> 9) & 1) << 5)); }
__host__ __device__ __forceinline__ void stage_rc(int b, int& R, int& C) { const int st = b / 1024, sb = b % 1024, swz = sb ^ (((sb >> 9) & 1) << 5); R = (st >> 1) * 16 + swz / 64; C = (st & 1) * 32 + (swz % 64) / 2; }
__host__ __device__ __forceinline__ int perm32(int rho) { const int n = rho >> 4, i = rho & 15; return 8 * (i >> 2) + 4 * n + (i & 3); }

struct Unit { int pm, pn, pb; };
struct Gemm { const bf16_t* A; const bf16_t* Bt; int K; const int* gidx; };

struct DenseOrder {
    int nM, nN, nwg, G, c;
    __device__ void init(int M, int N, int G_, int c_) { nM = M / BM; nN = N / BM; nwg = nM * nN; G = G_; c = c_; }
    __device__ bool next(int i, Unit& u) const {
        const long L = (long)i * G + c; if (L >= nwg) return false;
        int wgid = (int)L; { const int q = nwg / NXCD, r = nwg % NXCD, xcd = wgid % NXCD, off = wgid / NXCD; wgid = (xcd < r ? xcd * (q + 1) : r * (q + 1) + (xcd - r) * q) + off; }
        const int nig = WGM * nN, gid = wgid / nig, fm = gid * WGM, gsz = (nM - fm) < WGM ? (nM - fm) : WGM;
        u.pm = fm + ((wgid % nig) % gsz); u.pn = (wgid % nig) / gsz; u.pb = u.pn; return true;
    }
    __device__ __forceinline__ void a_ready(const Unit&) const {}
    __device__ __forceinline__ void done(const Unit&) const {}
};
struct ExpertOrder {
    int nN, nun, G, c;
    __device__ void init(int nN_, int G_, int c_) { nN = nN_; nun = 128 * nN_; G = G_; c = c_; }
    __device__ bool next(int i, Unit& u) const {
        const long L = (long)i * G + c; if (L >= nun) return false;
        int V = (int)L;
        if (G == 256) V = i * 256 + (c & 7) * 32 + (c >> 3);
        const int per = 8 * nN, e = V / per, r = V % per, pml = r / nN, pn = r % nN;
        u.pm = ((pml >> 1) * 16 + e) * 2 + (pml & 1); u.pn = pn; u.pb = e * nN + pn; return true;
    }
    __device__ __forceinline__ void a_ready(const Unit&) const {}
    __device__ __forceinline__ void done(const Unit&) const {}
};

typedef float f32x2 __attribute__((ext_vector_type(2)));
typedef __bf16 bf16x2_t __attribute__((ext_vector_type(2)));
__device__ __forceinline__ unsigned pk2(float lo, float hi) { f32x2 v = {lo, hi}; bf16x2_t b = __builtin_convertvector(v, bf16x2_t); return __builtin_bit_cast(unsigned, b); }
__device__ __forceinline__ float sigm(float x) { return __builtin_amdgcn_rcpf(1.f + __builtin_amdgcn_exp2f(-1.4426950408889634f * x)); }

constexpr float QSCALE = 0.125f * 1.4426950408889634f;
struct EpiProj {
    static constexpr bool PERM = true, AFTER_DRAIN = false;
    bf16_t *GLU, *Q; const float *qg, *kg;
    __device__ __forceinline__ void operator()(const f32x4 (&acc)[2][2][4][2], const Unit& u, int wr, int wc, int fr, int fq) const {
        const int row0 = u.pm * BM + wr * 64 + fr;
        if (u.pn < 4) {
            const int col0 = 128 * u.pn + 32 * wc + 8 * fq;
#pragma unroll
            for (int ai = 0; ai < 2; ++ai)
#pragma unroll
                for (int m = 0; m < 4; ++m) {
                    const f32x4 v0 = acc[ai][0][m][0], v1 = acc[ai][0][m][1], g0 = acc[ai][1][m][0], g1 = acc[ai][1][m][1];
                    u32x4 w; w.x = pk2(v0[0] * sigm(g0[0]), v0[1] * sigm(g0[1])); w.y = pk2(v0[2] * sigm(g0[2]), v0[3] * sigm(g0[3]));
                    w.z = pk2(v1[0] * sigm(g1[0]), v1[1] * sigm(g1[1])); w.w = pk2(v1[2] * sigm(g1[2]), v1[3] * sigm(g1[3]));
                    *(u32x4*)(GLU + (size_t)(row0 + ai * HALF + m * 16) * 512 + col0) = w;
                    asm volatile("" ::: "memory");
                }
        } else {
            const int t = (u.pn - 4) >> 1;
            const int hd = 4 * ((u.pn - 4) & 1) + wc;
            bf16_t* dst = Q + (size_t)t * (size_t)(8u << 20);
            const float* gp = (const float*)((uintptr_t)qg + (((uintptr_t)kg - (uintptr_t)qg) & (uintptr_t)(t == 0 ? 0 : ~(uintptr_t)0)));
#pragma unroll
            for (int ai = 0; ai < 2; ++ai)
#pragma unroll
                for (int m = 0; m < 4; ++m) {
                    float ss = 0.f;
#pragma unroll
                    for (int bj = 0; bj < 2; ++bj)
#pragma unroll
                        for (int n = 0; n < 2; ++n) { const f32x4 x = acc[ai][bj][m][n]; ss += (x[0] * x[0] + x[1] * x[1]) + (x[2] * x[2] + x[3] * x[3]); }
                    ss += __shfl_xor(ss, 16); ss += __shfl_xor(ss, 32);
                    float rs = 1.f;
                    if (t < 2) rs = rsqrtf(ss * (1.f / 64.f) + 1e-6f) * (t == 0 ? QSCALE : 1.f);
#pragma unroll
                    for (int bj = 0; bj < 2; ++bj) {
                        f32x4 g0 = {1.f, 1.f, 1.f, 1.f}, g1 = g0;
                        if (t < 2) { g0 = *(const f32x4*)(gp + 32 * bj + 8 * fq); g1 = *(const f32x4*)(gp + 32 * bj + 8 * fq + 4); }
                        const f32x4 a = acc[ai][bj][m][0] * g0 * rs, b = acc[ai][bj][m][1] * g1 * rs;
                        u32x4 w; w.x = pk2(a[0], a[1]); w.y = pk2(a[2], a[3]); w.z = pk2(b[0], b[1]); w.w = pk2(b[2], b[3]);
                        const int row = row0 + ai * HALF + m * 16;
                        *(u32x4*)(dst + ((size_t)((row >> 12) * 8 + hd) * 4096 + (row & 4095)) * 64 + 32 * bj + 8 * fq) = w;
                    }
                    asm volatile("" ::: "memory");
                }
        }
    }
};
struct EpiRes {
    static constexpr bool PERM = false, AFTER_DRAIN = false;
    const float* xin; float* X;
    __device__ __forceinline__ void operator()(const f32x4 (&acc)[2][2][4][2], const Unit& u, int wr, int wc, int fr, int fq) const {
        const int row0 = u.pm * BM + wr * 64 + fr, col0 = u.pn * BM + wc * 32 + 4 * fq;
#pragma unroll
        for (int ai = 0; ai < 2; ++ai)
#pragma unroll
            for (int m = 0; m < 4; ++m) { const size_t off = (size_t)(row0 + ai * HALF + m * 16) * 1024 + col0;
#pragma unroll
                for (int bj = 0; bj < 2; ++bj)
#pragma unroll
                    for (int n = 0; n < 2; ++n) { const f32x4 r = *(const f32x4*)(xin + off + bj * HALF + n * 16); *(f32x4*)(X + off + bj * HALF + n * 16) = r + acc[ai][bj][m][n]; } }
    }
};
struct EpiSwiGLU {
    static constexpr bool PERM = true, AFTER_DRAIN = false;
    bf16_t* H;
    __device__ __forceinline__ void operator()(const f32x4 (&acc)[2][2][4][2], const Unit& u, int wr, int wc, int fr, int fq) const {
        const int row0 = u.pm * BM + wr * 64 + fr, col0 = 128 * u.pn + 32 * wc + 8 * fq;
#pragma unroll
        for (int ai = 0; ai < 2; ++ai)
#pragma unroll
            for (int m = 0; m < 4; ++m) {
                const f32x4 g0 = acc[ai][0][m][0], g1 = acc[ai][0][m][1], u0 = acc[ai][1][m][0], u1 = acc[ai][1][m][1];
                u32x4 w; w.x = pk2(g0[0] * sigm(g0[0]) * u0[0], g0[1] * sigm(g0[1]) * u0[1]); w.y = pk2(g0[2] * sigm(g0[2]) * u0[2], g0[3] * sigm(g0[3]) * u0[3]);
                w.z = pk2(g1[0] * sigm(g1[0]) * u1[0], g1[1] * sigm(g1[1]) * u1[1]); w.w = pk2(g1[2] * sigm(g1[2]) * u1[2], g1[3] * sigm(g1[3]) * u1[3]);
                *(u32x4*)(H + (size_t)(row0 + ai * HALF + m * 16) * 1024 + col0) = w;
            }
    }
};
struct EpiDown {
    static constexpr bool PERM = true, AFTER_DRAIN = false;
    bf16_t* Y; const float* gate;
    __device__ __forceinline__ void operator()(const f32x4 (&acc)[2][2][4][2], const Unit& u, int wr, int wc, int fr, int fq) const {
        const int row0 = u.pm * BM + wr * 64 + fr, col0 = u.pn * BM + wc * 32 + 8 * fq;
#pragma unroll
        for (int ai = 0; ai < 2; ++ai)
#pragma unroll
            for (int m = 0; m < 4; ++m) { const int row = row0 + ai * HALF + m * 16; const float gs = gate[row];
#pragma unroll
                for (int bj = 0; bj < 2; ++bj) { const f32x4 a = acc[ai][bj][m][0] * gs, b = acc[ai][bj][m][1] * gs;
                    u32x4 w; w.x = pk2(a[0], a[1]); w.y = pk2(a[2], a[3]); w.z = pk2(b[0], b[1]); w.w = pk2(b[2], b[3]);
                    *(u32x4*)(Y + (size_t)row * 1024 + col0 + bj * HALF) = w; } }
    }
};
struct EpiGluRes {
    static constexpr bool PERM = false, AFTER_DRAIN = false;
    float* X;
    __device__ __forceinline__ void operator()(const f32x4 (&acc)[2][2][4][2], const Unit& u, int wr, int wc, int fr, int fq) const {
        const int row0 = u.pm * BM + wr * 64 + fr, col0 = 128 * u.pn + 32 * wc + 4 * fq;
#pragma unroll
        for (int ai = 0; ai < 2; ++ai)
#pragma unroll
            for (int m = 0; m < 4; ++m) { float* p = X + (size_t)(row0 + ai * HALF + m * 16) * 1024 + col0;
#pragma unroll
                for (int n = 0; n < 2; ++n) { const f32x4 v = acc[ai][0][m][n], g = acc[ai][1][m][n]; f32x4 r = *(const f32x4*)(p + n * 16);
                    r[0] += v[0] * sigm(g[0]); r[1] += v[1] * sigm(g[1]); r[2] += v[2] * sigm(g[2]); r[3] += v[3] * sigm(g[3]); *(f32x4*)(p + n * 16) = r; } }
    }
};

template <class Epi, class Sched, bool ALIGN_EPI = false, bool SP2 = false, bool GATHER = false>
__device__ __forceinline__ void gemm_phase(PG8_LAS unsigned char* lds, const Gemm g, const Sched& S, const Epi& E) {
    const int tid = threadIdx.x, wid = __builtin_amdgcn_readfirstlane(tid >> 6), lane = tid & 63, wr = wid >> 2, wc = wid & 3, fr = lane & 15, fq = lane >> 4;
    const int K = g.K, nt = K / BK;
    unsigned voffA[2], voffB[2];
#pragma unroll
    for (int i = 0; i < 2; ++i) { int R, C; stage_rc(tid * 16 + i * 8192, R, C); const int Rb = Epi::PERM ? ((R & ~31) + perm32(R & 31)) : R;
        voffA[i] = (unsigned)(R * K + C) * 2u; voffB[i] = (unsigned)(Rb * K + C) * 2u; }
    const size_t kstep = (size_t)(BK * 2);
    const size_t hstep = (size_t)HALF * K * 2;
    const size_t tstep = 2 * hstep;
    const unsigned ldsw = (unsigned)wid * 1024u;
    const int aoff = lds_byte(wr * 64 + fr, fq * 8), boff = lds_byte(wc * 32 + fr, fq * 8);
#define PG8_SA(b, h) (((b) * 2 + (h)) * HTB)
#define PG8_SB(b, h) ((4 + (b) * 2 + (h)) * HTB)
#define PG8_STAGE(bufoff, gbase, voff) do { _Pragma("unroll") for (int _i = 0; _i < 2; ++_i) \
        __builtin_amdgcn_global_load_lds((const unsigned*)((const char*)(gbase) + (voff)[_i]), (PG8_LAS unsigned*)(lds + (bufoff) + ldsw + _i * 8192), 16, 0, 0); } while (0)
#define PG8_STAGE_A(bufoff, gptr, h, nsel) do { if constexpr (GATHER) { const unsigned _o[2] = {(nsel) ? nOA[h][0] : oA[h][0], (nsel) ? nOA[h][1] : oA[h][1]}; PG8_STAGE(bufoff, gptr, _o); } \
        else { PG8_STAGE(bufoff, (gptr) + ((h) ? hstep : 0), voffA); } } while (0)
#define PG8_GOFF(dst, u) do { if constexpr (GATHER) { _Pragma("unroll") for (int _h = 0; _h < 2; ++_h) _Pragma("unroll") for (int _i = 0; _i < 2; ++_i) { \
        (dst)[_h][_i] = (unsigned)g.gidx[(u).pm * BM + _h * HALF + gR[_i]] * (unsigned)(K * 2) + gC[_i]; asm volatile("" : "+v"((dst)[_h][_i])); } } } while (0)
#define PG8_LDA(dst, b, h) do { _Pragma("unroll") for (int m = 0; m < 4; ++m) _Pragma("unroll") for (int k = 0; k < 2; ++k) dst[m][k] = *(const PG8_LAS bf16x8*)(lds + PG8_SA(b, h) + aoff + m * 2048 + k * 1024); } while (0)
#define PG8_LDB(dst, b, h) do { _Pragma("unroll") for (int n = 0; n < 2; ++n) _Pragma("unroll") for (int k = 0; k < 2; ++k) dst[n][k] = *(const PG8_LAS bf16x8*)(lds + PG8_SB(b, h) + boff + n * 2048 + k * 1024); } while (0)
#define PG8_MMA(ai, bj, At, Bt) do { __builtin_amdgcn_s_setprio(1); _Pragma("unroll") for (int m = 0; m < 4; ++m) _Pragma("unroll") for (int n = 0; n < 2; ++n) _Pragma("unroll") for (int k = 0; k < 2; ++k) \
        acc[ai][bj][m][n] = __builtin_amdgcn_mfma_f32_16x16x32_bf16(Bt[n][k], At[m][k], acc[ai][bj][m][n], 0, 0, 0); __builtin_amdgcn_s_setprio(0); } while (0)
#define PG8_WAIT_V(n) asm volatile("s_waitcnt vmcnt(" #n ")" ::: "memory")
#define PG8_WAIT_L(n) asm volatile("s_waitcnt lgkmcnt(" #n ")" ::: "memory")
#define PG8_BAR __builtin_amdgcn_s_barrier()
#define PG8_SCHED __builtin_amdgcn_sched_barrier(0)
    Unit cur, nxt; int ui = 0;
    if (!S.next(0, cur)) return;
    unsigned oA[2][2], nOA[2][2]; int gR[2]; unsigned gC[2];
    if constexpr (GATHER) { static_assert(SP2, "GATHER is wired into the SP2 loop only");
#pragma unroll
        for (int i = 0; i < 2; ++i) { int R, Cc; stage_rc(tid * 16 + i * 8192, R, Cc); gR[i] = R; gC[i] = (unsigned)Cc * 2u; } }
    PG8_GOFF(oA, cur);
    f32x4 acc[2][2][4][2];
#pragma unroll
    for (int a = 0; a < 2; ++a)
#pragma unroll
        for (int b = 0; b < 2; ++b)
#pragma unroll
            for (int m = 0; m < 4; ++m)
#pragma unroll
                for (int n = 0; n < 2; ++n) acc[a][b][m][n] = (f32x4){0.f, 0.f, 0.f, 0.f};
    bf16x8 At[4][2], B0[2][2], B1[2][2];
    const char* cA = (const char*)g.A + (GATHER ? (size_t)0 : (size_t)cur.pm * tstep); const char* cB = (const char*)g.Bt + (size_t)cur.pb * tstep;
    S.a_ready(cur);
    if constexpr (SP2) {
        PG8_STAGE(PG8_SB(0, 0), cB, voffB); PG8_STAGE(PG8_SB(0, 1), cB + hstep, voffB); PG8_STAGE_A(PG8_SA(0, 0), cA, 0, false); PG8_STAGE_A(PG8_SA(0, 1), cA, 1, false);
        if (wr == 1) PG8_BAR;
        PG8_WAIT_V(2); PG8_BAR;
        PG8_STAGE(PG8_SB(1, 0), cB + kstep, voffB); PG8_STAGE_A(PG8_SA(1, 0), cA + kstep, 0, false); PG8_STAGE(PG8_SB(1, 1), cB + hstep + kstep, voffB);
        PG8_WAIT_V(6); PG8_BAR;
    } else {
        PG8_STAGE(PG8_SB(0, 0), cB, voffB); PG8_STAGE(PG8_SA(0, 0), cA, voffA); PG8_STAGE(PG8_SB(0, 1), cB + hstep, voffB); PG8_STAGE(PG8_SA(0, 1), cA + hstep, voffA);
        if (wr == 1) PG8_BAR;
        PG8_WAIT_V(4); PG8_BAR;
        PG8_STAGE(PG8_SB(1, 0), cB + kstep, voffB); PG8_STAGE(PG8_SA(1, 0), cA + kstep, voffA); PG8_STAGE(PG8_SB(1, 1), cB + hstep + kstep, voffB);
        PG8_WAIT_V(6); PG8_BAR;
    }
    for (;;) {
        const bool has_next = S.next(ui + 1, nxt);
        const char* nA = has_next ? (const char*)g.A + (GATHER ? (size_t)0 : (size_t)nxt.pm * tstep) : cA; const char* nB = has_next ? (const char*)g.Bt + (size_t)nxt.pb * tstep : cB;
        if constexpr (GATHER) { if (has_next) { PG8_GOFF(nOA, nxt); } else {
#pragma unroll
            for (int _h = 0; _h < 2; ++_h) { nOA[_h][0] = oA[_h][0]; nOA[_h][1] = oA[_h][1]; } } }
        for (int t = 0; t < nt; t += 2) {
            const bool last = (t == nt - 2);
            const char* a1 = cA + (size_t)(t + 1) * kstep;
            const char* a2 = last ? nA : cA + (size_t)(t + 2) * kstep; const char* b2 = last ? nB : cB + (size_t)(t + 2) * kstep;
            const char* a3 = a2 + kstep; const char* b3 = b2 + kstep;
            if (last && has_next) S.a_ready(nxt);
            if constexpr (SP2) {
            PG8_LDB(B0, 0, 0); PG8_LDB(B1, 0, 1); PG8_SCHED; PG8_LDA(At, 0, 0); PG8_STAGE_A(PG8_SA(1, 1), a1, 1, false);
            PG8_WAIT_V(8); PG8_WAIT_L(0); PG8_BAR; PG8_MMA(0, 0, At, B0); PG8_MMA(0, 1, At, B1); PG8_BAR; PG8_SCHED;
            PG8_LDA(At, 0, 1); PG8_STAGE(PG8_SB(0, 0), b2, voffB); PG8_STAGE(PG8_SB(0, 1), b2 + hstep, voffB); PG8_STAGE_A(PG8_SA(0, 0), a2, 0, last);
            PG8_WAIT_V(8); PG8_WAIT_L(0); PG8_BAR; PG8_MMA(1, 0, At, B0); PG8_MMA(1, 1, At, B1); PG8_BAR; PG8_SCHED;
            PG8_LDB(B0, 1, 0); PG8_LDB(B1, 1, 1); PG8_SCHED; PG8_LDA(At, 1, 0); PG8_STAGE_A(PG8_SA(0, 1), a2, 1, last);
            PG8_WAIT_V(8); PG8_WAIT_L(0); PG8_BAR; PG8_MMA(0, 0, At, B0); PG8_MMA(0, 1, At, B1); PG8_BAR; PG8_SCHED;
            PG8_LDA(At, 1, 1); PG8_STAGE(PG8_SB(1, 0), b3, voffB); PG8_STAGE(PG8_SB(1, 1), b3 + hstep, voffB); PG8_STAGE_A(PG8_SA(1, 0), a3, 0, last);
            PG8_WAIT_V(8); PG8_WAIT_L(0); PG8_BAR; PG8_MMA(1, 0, At, B0); PG8_MMA(1, 1, At, B1); PG8_BAR; PG8_SCHED;
            } else {
            PG8_LDB(B0, 0, 0); PG8_SCHED; PG8_LDA(At, 0, 0); PG8_STAGE(PG8_SA(1, 1), a1 + hstep, voffA);
            PG8_WAIT_L(8); PG8_BAR; PG8_WAIT_L(0); PG8_MMA(0, 0, At, B0); PG8_BAR; PG8_SCHED;
            PG8_LDB(B1, 0, 1); PG8_STAGE(PG8_SB(0, 0), b2, voffB);
            PG8_BAR; PG8_WAIT_L(0); PG8_MMA(0, 1, At, B1); PG8_BAR;
            PG8_LDA(At, 0, 1); PG8_STAGE(PG8_SA(0, 0), a2, voffA);
            PG8_BAR; PG8_WAIT_L(0); PG8_MMA(1, 0, At, B0); PG8_BAR; PG8_SCHED;
            PG8_STAGE(PG8_SB(0, 1), b2 + hstep, voffB);
            PG8_WAIT_V(6); PG8_BAR; PG8_MMA(1, 1, At, B1); PG8_BAR;
            PG8_LDB(B0, 1, 0); PG8_SCHED; PG8_LDA(At, 1, 0); PG8_STAGE(PG8_SA(0, 1), a2 + hstep, voffA);
            PG8_WAIT_L(8); PG8_BAR; PG8_WAIT_L(0); PG8_MMA(0, 0, At, B0); PG8_BAR; PG8_SCHED;
            PG8_LDB(B1, 1, 1); PG8_STAGE(PG8_SB(1, 0), b3, voffB);
            PG8_BAR; PG8_WAIT_L(0); PG8_MMA(0, 1, At, B1); PG8_BAR;
            PG8_LDA(At, 1, 1); PG8_STAGE(PG8_SA(1, 0), a3, voffA);
            PG8_BAR; PG8_WAIT_L(0); PG8_MMA(1, 0, At, B0); PG8_BAR; PG8_SCHED;
            PG8_STAGE(PG8_SB(1, 1), b3 + hstep, voffB);
            PG8_WAIT_V(6); PG8_BAR; PG8_MMA(1, 1, At, B1); PG8_BAR;
            }
        }
        if constexpr (ALIGN_EPI) { if (wr == 0) PG8_BAR; }
        if constexpr (!Epi::AFTER_DRAIN) { E(acc, cur, wr, wc, fr, fq); S.done(cur); }
        if (!has_next) break;
#pragma unroll
        for (int a = 0; a < 2; ++a)
#pragma unroll
            for (int b = 0; b < 2; ++b)
#pragma unroll
                for (int m = 0; m < 4; ++m)
#pragma unroll
                    for (int n = 0; n < 2; ++n) acc[a][b][m][n] = (f32x4){0.f, 0.f, 0.f, 0.f};
        cur = nxt; cA = nA; cB = nB; ++ui;
        if constexpr (GATHER) {
#pragma unroll
            for (int _h = 0; _h < 2; ++_h) { oA[_h][0] = nOA[_h][0]; oA[_h][1] = nOA[_h][1]; } }
        if constexpr (ALIGN_EPI) { if (wr == 1) PG8_BAR; }
    }
    PG8_WAIT_V(0);
    if constexpr (!ALIGN_EPI) { if (wr == 0) PG8_BAR; }
    PG8_BAR;
    if constexpr (Epi::AFTER_DRAIN) { E.fused(acc, cur, wr, wc, fr, fq, lds, wid, lane); S.done(cur); }
#undef PG8_SA
#undef PG8_SB
#undef PG8_STAGE
#undef PG8_LDA
#undef PG8_STAGE_A
#undef PG8_GOFF
#undef PG8_LDB
#undef PG8_MMA
#undef PG8_WAIT_V
#undef PG8_WAIT_L
#undef PG8_BAR
#undef PG8_SCHED
}
}

constexpr int NB = 4, S = 4096, D = 1024, T = NB * S;
constexpr int CONV_CH = 512, CONV_W = 31, NH = 8, INC = 2560;
constexpr int SG = 64, SC = 16, SP = 64;
constexpr int NE = 16, CAP = 512, EH = 1024, MR = NB * NE * CAP;
constexpr float EPS = 1e-6f;
constexpr int NWAVES = 8, NTHR = NWAVES * 64;

constexpr size_t MiB = 1u << 20;
constexpr size_t WS_CTL = 0, CTL_ZERO_BYTES = 64 * 1024;
constexpr size_t WS_AFF = 1 * MiB, WS_IDX = 2 * MiB, WS_GATE = 2 * MiB + 512 * 1024, WS_SLOT = 3 * MiB;
constexpr size_t WS_WIN = 4 * MiB, WS_WOUT = 10 * MiB, WS_WGLU = 12 * MiB;
constexpr size_t WS_WEXP = 16 * MiB, WEXP_LAYER = 96 * MiB, WEXP_GU = 0, WEXP_DN = 64 * MiB;
constexpr size_t WS_XN = 208 * MiB, WS_MIXED = 240 * MiB;
constexpr size_t WS_PROJ = 272 * MiB;
constexpr size_t WS_H = 336 * MiB;
constexpr size_t WS_XB = 404 * MiB;
constexpr size_t WS_END = 468 * MiB;
constexpr int CW_BAR = 1024, CW_Q0 = 64;

constexpr int SCRATCH_BYTES = 143360;
constexpr int LDSCTL_OFF = SCRATCH_BYTES;
constexpr int LDS_BYTES = 147456;

#define GAS __attribute__((address_space(1)))
#define LAS __attribute__((address_space(3)))
typedef unsigned short bf16;
typedef unsigned v4u __attribute__((ext_vector_type(4)));
typedef unsigned v2u __attribute__((ext_vector_type(2)));
typedef float f32x4 __attribute__((ext_vector_type(4)));
typedef float f32x2 __attribute__((ext_vector_type(2)));
using pg8::pk2;
using pg8::sigm;
__device__ __forceinline__ float bf2f(unsigned short h) { return __uint_as_float(((unsigned)h) << 16); }
__device__ __forceinline__ float bflo(unsigned w) { return __uint_as_float(w << 16); }
__device__ __forceinline__ float bfhi(unsigned w) { return __uint_as_float(w & 0xffff0000u); }
__device__ __forceinline__ float wave_sum(float v) {
#pragma unroll
    for (int o = 1; o < 64; o <<= 1) v += __shfl_xor(v, o);
    return v;
}

#define XB_TMO      128
#define XB_XCNT(j)  (256  + 64 * (j))
#define XB_XSUB(j)  (1280 + 64 * (j))
#define XB_XGEN(j)  (2304 + 64 * (j))
#define XB_TOP      3328
#define XB_TOPGEN   3392
#define XCD_BAR_WORDS 3456
#define XB_SPIN_CAP (1u << 18)
__device__ __forceinline__ unsigned xb_ld(unsigned* p)              { return __hip_atomic_load(p, __ATOMIC_RELAXED, __HIP_MEMORY_SCOPE_AGENT); }
__device__ __forceinline__ unsigned xb_add(unsigned* p, unsigned v) { return __hip_atomic_fetch_add(p, v, __ATOMIC_RELAXED, __HIP_MEMORY_SCOPE_AGENT); }
__device__ __forceinline__ unsigned xb_xcc_id() { return (unsigned)__builtin_amdgcn_s_getreg((3 << 11) | 20) & 0xFu; }
#define XB_SPIN(cond, bar) do { unsigned _sp = 0; while (cond) { __builtin_amdgcn_s_sleep(1); \
    if ((++_sp & 255u) == 0u) { if (xb_ld(&(bar)[XB_TMO])) break; if (_sp > XB_SPIN_CAP) { atomicAdd(&(bar)[XB_TMO], 1u); break; } } } } while (0)
struct XcdBarrier { unsigned* bar; unsigned x; volatile LAS unsigned* st; };
__device__ __forceinline__ XcdBarrier xcd_barrier_post(unsigned* bar, volatile LAS unsigned* st) {
    XcdBarrier b; b.bar = bar; b.x = xb_xcc_id(); b.st = st;
    if (threadIdx.x == 0) (void)xb_add(&bar[XB_XCNT(b.x)], 1u);
    return b;
}
__device__ __forceinline__ void xcd_barrier_complete(unsigned* bar, unsigned x, unsigned& nloc, unsigned& nx) {
    const unsigned G = gridDim.x * gridDim.y * gridDim.z;
    unsigned sum, cnt, mine, sp = 0u;
    for (;;) {
        sum = 0u; cnt = 0u; mine = 0u;
#pragma unroll
        for (unsigned j = 0; j < 16; ++j) { const unsigned c = xb_ld(&bar[XB_XCNT(j)]); sum += c; cnt += (c > 0u) ? 1u : 0u; mine = (j == x) ? c : mine; }
        if (sum == G) break;
        __builtin_amdgcn_s_sleep(1);
        if ((++sp & 255u) == 0u) { if (xb_ld(&bar[XB_TMO])) break; if (sp > XB_SPIN_CAP) { atomicAdd(&bar[XB_TMO], 1u); break; } }
    }
    nloc = mine > 0u ? mine : 1u; nx = cnt > 0u ? cnt : 1u;
}
__device__ __forceinline__ void xcd_barrier(const XcdBarrier& b) {
    asm volatile("s_waitcnt vmcnt(0)" ::: "memory");
    __syncthreads();
    if (threadIdx.x == 0) {
        unsigned* bar = b.bar;
        __builtin_amdgcn_s_waitcnt(0);
        unsigned nloc = b.st[0], nx = b.st[1];
        if (nloc == 0u) { xcd_barrier_complete(bar, b.x, nloc, nx); b.st[0] = nloc; b.st[1] = nx; }
        const unsigned old = xb_add(&bar[XB_XSUB(b.x)], 1u);
        const unsigned gen = old / nloc;
        if (old + 1u == (gen + 1u) * nloc) {
            __builtin_amdgcn_fence(__ATOMIC_RELEASE, "agent");
            asm volatile("s_waitcnt vmcnt(0)" ::: "memory");
            const unsigned og = xb_add(&bar[XB_TOP], 1u);
            const unsigned tg = og / nx;
            if (og + 1u == (tg + 1u) * nx) xb_add(&bar[XB_TOPGEN], 1u);
            else XB_SPIN(xb_ld(&bar[XB_TOPGEN]) == tg, bar);
            __builtin_amdgcn_fence(__ATOMIC_ACQUIRE, "agent");
            xb_add(&bar[XB_XGEN(b.x)], 1u);
            asm volatile("s_waitcnt vmcnt(0)" ::: "memory");
        } else {
            XB_SPIN(xb_ld(&bar[XB_XGEN(b.x)]) == gen, bar);
            __builtin_amdgcn_fence(__ATOMIC_ACQUIRE, "agent");
            asm volatile("s_waitcnt vmcnt(0)" ::: "memory");
        }
    }
    __syncthreads();
}

struct Args {
    const float* in[26]; float* out; unsigned char* ws; int ph_lo, ph_hi;
};
struct Ctx { LAS unsigned char* lds; int tid, lane, wave, vcu, G; };

__device__ __forceinline__ int rowmap(int kind, int half, int n) {
    if (kind == 0) {
        if (n < 1024) { const int hf = n >> 9, r = n & 511; return 256 * (r >> 7) + 128 * hf + (r & 127); }
        const int pn = n >> 8, w = n & 255, wc = w >> 6, bj = (w >> 5) & 1, j = w & 31; return 256 * pn + 128 * bj + 32 * wc + j;
    }
    if (kind == 2) { const int hf = n >> 10, r = n & 1023; return 256 * (r >> 7) + 128 * hf + (r & 127); }
    if (kind == 3) return 256 * (n >> 7) + 128 * half + (n & 127);
    return n;
}
struct ConvDesc { const float* src; bf16* dst; int N, kind, half, k0, n0; };
__device__ __forceinline__ bool conv_desc(const Args& a, int it, ConvDesc& d) {
    constexpr int I_IN = 16 * 40, I_OUT = 256, I_GLU = 16 * 32, I_EXP = 2 * 16 * 3 * 256;
    if (it >= I_IN + I_OUT + I_GLU + I_EXP) return false;
    unsigned char* ws = a.ws; int r = it, kb, nb;
    if (r < I_IN) { d.src = a.in[2]; d.N = INC; d.dst = (bf16*)(ws + WS_WIN); d.kind = 0; d.half = 0; kb = r / 40; nb = r % 40; }
    else if ((r -= I_IN) < I_OUT) { d.src = a.in[9]; d.N = D; d.dst = (bf16*)(ws + WS_WOUT); d.kind = 1; d.half = 0; kb = r >> 4; nb = r & 15; }
    else if ((r -= I_OUT) < I_GLU) { d.src = a.in[19]; d.N = 2 * D; d.dst = (bf16*)(ws + WS_WGLU); d.kind = 2; d.half = 0; kb = r >> 5; nb = r & 31; }
    else { r -= I_GLU; const int mat = r >> 8, tile = r & 255, layer = mat / 48, rem = mat % 48, e = rem / 3, which = rem % 3;
        d.src = a.in[23 + which] + ((size_t)layer * NE + e) * (size_t)D * EH; d.N = EH;
        d.dst = (bf16*)(ws + WS_WEXP + layer * WEXP_LAYER + (which == 2 ? WEXP_DN + (size_t)e * 2 * MiB : WEXP_GU + (size_t)e * 4 * MiB));
        d.kind = which == 2 ? 1 : 3; d.half = which; kb = tile >> 4; nb = tile & 15; }
    d.k0 = 64 * kb; d.n0 = 64 * nb; return true;
}
__device__ __forceinline__ void conv_load(const ConvDesc& d, f32x4 (&v)[16], int lane) {
    const float* p = d.src + (size_t)(d.k0 + (lane >> 4)) * d.N + d.n0 + 4 * (lane & 15);
#pragma unroll
    for (int it = 0; it < 16; ++it) v[it] = *(const f32x4*)(p + (size_t)(4 * it) * d.N);
}
__device__ __forceinline__ void conv_store(const ConvDesc& d, const f32x4 (&v)[16], LAS float* scr, int lane) {
#pragma unroll
    for (int it = 0; it < 16; ++it) { const int kk = 4 * it + (lane >> 4), nn = 4 * (lane & 15);
        scr[kk * 65 + nn] = v[it][0]; scr[kk * 65 + nn + 1] = v[it][1]; scr[kk * 65 + nn + 2] = v[it][2]; scr[kk * 65 + nn + 3] = v[it][3]; }
    asm volatile("s_waitcnt lgkmcnt(0)" ::: "memory");
    const int kc = lane & 7;
#pragma unroll
    for (int jt = 0; jt < 8; ++jt) {
        const int nl = 8 * jt + (lane >> 3);
        const LAS float* s = scr + (8 * kc) * 65 + nl;
        v4u o; o.x = pk2(s[0], s[65]); o.y = pk2(s[2 * 65], s[3 * 65]); o.z = pk2(s[4 * 65], s[5 * 65]); o.w = pk2(s[6 * 65], s[7 * 65]);
        *(v4u*)(d.dst + (size_t)rowmap(d.kind, d.half, d.n0 + nl) * 1024 + d.k0 + 8 * kc) = o;
    }
    asm volatile("s_waitcnt lgkmcnt(0)" ::: "memory");
}
__device__ __forceinline__ void rms_row_bf16(const float* __restrict__ xrow, const float* __restrict__ g, bf16* __restrict__ orow, int lane) {
    const f32x4* xr = (const f32x4*)xrow + lane;
    f32x4 v[4]; float s = 0.f;
#pragma unroll
    for (int j = 0; j < 4; ++j) { v[j] = xr[64 * j]; s += (v[j][0] * v[j][0] + v[j][1] * v[j][1]) + (v[j][2] * v[j][2] + v[j][3] * v[j][3]); }
    const float r = rsqrtf(wave_sum(s) * (1.f / D) + EPS);
#pragma unroll
    for (int j = 0; j < 4; ++j) { const f32x4 w = ((const f32x4*)g)[lane + 64 * j]; v2u o; o.x = pk2(v[j][0] * r * w[0], v[j][1] * r * w[1]); o.y = pk2(v[j][2] * r * w[2], v[j][3] * r * w[3]); ((v2u*)orow)[lane + 64 * j] = o; }
}
constexpr int CONV_NITEMS = 25984, CONV_FIRST_Q = 640, CW_P1DONE = 128;
__device__ __forceinline__ void conv_drain(const Ctx& C, const Args& a, bool until_flag) {
    LAS float* scr = (LAS float*)(C.lds + C.wave * 16640);
    unsigned* ctl = (unsigned*)(a.ws + WS_CTL);
    LAS int* qs = (LAS int*)(C.lds + 8 * 16640);
    ConvDesc dA; f32x4 vA[16];
    for (;;) {
        if (C.tid == 0) {
            int v = -1;
            if (!(until_flag && __hip_atomic_load(ctl + CW_P1DONE, __ATOMIC_RELAXED, __HIP_MEMORY_SCOPE_AGENT) != 0u))
                v = CONV_FIRST_Q + (int)__hip_atomic_fetch_add(ctl + CW_Q0, 8u, __ATOMIC_RELAXED, __HIP_MEMORY_SCOPE_AGENT);
            qs[0] = v;
        }
        __syncthreads();
        const int base = qs[0];
        __syncthreads();
        if (base < 0 || base >= CONV_NITEMS) break;
        if (conv_desc(a, base + C.wave, dA)) { conv_load(dA, vA, C.lane); conv_store(dA, vA, scr, C.lane); }
    }
}
__device__ __forceinline__ void p0_prologue(const Ctx& C, const Args& a) {
    LAS float* scr = (LAS float*)(C.lds + C.wave * 16640);
    const int gw = C.vcu * NWAVES + C.wave, NGW = C.G * NWAVES;
    unsigned char* ws = a.ws;
    for (int m = gw; m < T; m += NGW) rms_row_bf16(a.in[0] + (size_t)m * D, a.in[1], (bf16*)(ws + WS_XN) + (size_t)m * D, C.lane);
    ConvDesc dA; f32x4 vA[16];
    for (int it = gw; it < CONV_FIRST_Q; it += NGW) if (conv_desc(a, it, dA)) { conv_load(dA, vA, C.lane); conv_store(dA, vA, scr, C.lane); }
}

__device__ __forceinline__ void conv_tile(const Ctx& C, const Args& a, int tile) {
    const bf16* GLU = (const bf16*)(a.ws + WS_PROJ);
    bf16* MIXED = (bf16*)(a.ws + WS_MIXED);
    const float* cw = a.in[3]; const float* cb = a.in[4]; const float* lg = a.in[5]; const float* lb = a.in[6];
    LAS float* tl = (LAS float*)C.lds;
    const int cp = C.tid & 255, th = C.tid >> 8;
    const int b = tile / (S / 32), s0 = (tile % (S / 32)) * 32;
    f32x2 w[CONV_W];
#pragma unroll
    for (int j = 0; j < CONV_W; ++j) w[j] = *(const f32x2*)(cw + j * CONV_CH + 2 * cp);
    f32x2 acc[16];
    const f32x2 bias = *(const f32x2*)(cb + 2 * cp);
#pragma unroll
    for (int k = 0; k < 16; ++k) acc[k] = bias;
    unsigned xin[46];
#pragma unroll
    for (int i = 0; i < 46; ++i) { const int ss = s0 + 16 * th - 15 + i; xin[i] = (ss >= 0 && ss < S) ? *(const unsigned*)(GLU + (size_t)(b * S + ss) * 512 + 2 * cp) : 0u; }
#pragma unroll
    for (int i = 0; i < 46; ++i) {
        const f32x2 x = {bflo(xin[i]), bfhi(xin[i])};
#pragma unroll
        for (int k = 0; k < 16; ++k) { const int j = i - k; if (j >= 0 && j < CONV_W) acc[k] += w[j] * x; }
    }
#pragma unroll
    for (int k = 0; k < 16; ++k) *(LAS f32x2*)(tl + (16 * th + k) * 512 + 2 * cp) = acc[k];
    __syncthreads();
#pragma unroll
    for (int q = 0; q < 4; ++q) {
        const int tok = 4 * C.wave + q;
        const f32x4 v0 = *(const LAS f32x4*)(tl + tok * 512 + 8 * C.lane), v1 = *(const LAS f32x4*)(tl + tok * 512 + 8 * C.lane + 4);
        const float mu = wave_sum((v0[0] + v0[1]) + (v0[2] + v0[3]) + (v1[0] + v1[1]) + (v1[2] + v1[3])) * (1.f / CONV_CH);
        const f32x4 d0 = v0 - mu, d1 = v1 - mu;
        const float var = wave_sum((d0[0] * d0[0] + d0[1] * d0[1]) + (d0[2] * d0[2] + d0[3] * d0[3]) + (d1[0] * d1[0] + d1[1] * d1[1]) + (d1[2] * d1[2] + d1[3] * d1[3])) * (1.f / CONV_CH);
        const float rs = rsqrtf(var + EPS);
        const f32x4 g0 = *(const f32x4*)(lg + 8 * C.lane), g1 = *(const f32x4*)(lg + 8 * C.lane + 4), b0 = *(const f32x4*)(lb + 8 * C.lane), b1 = *(const f32x4*)(lb + 8 * C.lane + 4);
        f32x4 y0 = d0 * rs * g0 + b0, y1 = d1 * rs * g1 + b1;
#pragma unroll
        for (int e = 0; e < 4; ++e) { y0[e] = y0[e] * sigm(y0[e]); y1[e] = y1[e] * sigm(y1[e]); }
        v4u o; o.x = pk2(y0[0], y0[1]); o.y = pk2(y0[2], y0[3]); o.z = pk2(y1[0], y1[1]); o.w = pk2(y1[2], y1[3]);
        *(v4u*)(MIXED + (size_t)(b * S + s0 + tok) * D + 8 * C.lane) = o;
    }
    __syncthreads();
}
typedef short bf16x8 __attribute__((ext_vector_type(8)));
typedef short s16x4 __attribute__((ext_vector_type(4)));
typedef short v4i16_t __attribute__((ext_vector_type(4)));
typedef float f32x16 __attribute__((ext_vector_type(16)));
constexpr int AT_O = 0, AT_L = 65536, AT_V = 66560;
__device__ __forceinline__ s16x4 vtr(const LAS char* p) { return __builtin_bit_cast(s16x4, __builtin_amdgcn_ds_read_tr16_b64_v4i16((LAS v4i16_t*)p)); }
__device__ __forceinline__ void lds_addf(LAS float* p, float v) { (void)__hip_atomic_fetch_add(p, v, __ATOMIC_RELAXED, __HIP_MEMORY_SCOPE_WORKGROUP); }
__device__ __forceinline__ int med3i(int x, int lo, int hi) { return x < lo ? lo : (x > hi ? hi : x); }
__device__ __forceinline__ void attn_unit(const Ctx& C, const bf16* __restrict__ Qh, const bf16* __restrict__ Kh, const bf16* __restrict__ Vh,
                                          int d, int tq0, int nq, int tl0, int tls, float a2, float bound2, LAS float* Oacc, LAS float* Lacc, LAS char* vst, bool first) {
    int lane_ = C.lane; asm volatile("" : "+v"(lane_));
    const int lane = lane_, r = lane & 31, hh = lane >> 5;
    const int qi = r < nq ? r : nq - 1;
    bf16x8 qf[4]; v4u ks_[2][4], vs[2][4];
    const char* Kc = (const char*)Kh; const char* Vc = (const char*)Vh;
#define AT_LOADK(kb) do { _Pragma("unroll") for (int it = 0; it < 4; ++it) { const int key = (lane >> 3) + 8 * it; \
        const unsigned ro = (unsigned)med3i(tq0 + d * (32 * (kb) + key - 64), 0, S - 1) * 128u + 16u * (lane & 7); ks_[(kb) % 2][it] = *(const v4u*)(Kc + ro); } } while (0)
#define AT_LOADV(kb) do { _Pragma("unroll") for (int it = 0; it < 4; ++it) { const int key = (lane >> 3) + 8 * it; \
        const unsigned ro = (unsigned)med3i(tq0 + d * (32 * (kb) + key - 64), 0, S - 1) * 128u + 16u * (lane & 7); vs[(kb) % 2][it] = *(const v4u*)(Vc + ro); } } while (0)
    { const char* qp = (const char*)Qh + (unsigned)(tq0 + d * qi) * 128u + 16u * hh;
#pragma unroll
      for (int ks = 0; ks < 4; ++ks) qf[ks] = *(const bf16x8*)(qp + 32 * ks); }
    AT_LOADK(0); AT_LOADV(0);
    f32x16 o0, o1;
#pragma unroll
    for (int v = 0; v < 16; ++v) { o0[v] = 0.f; o1[v] = 0.f; }
    float lsum = 0.f;
    LAS char* kst = vst, *vt = vst + 4096;
    const LAS char* vb = vt + ((lane >> 4) & 1) * 32 + (lane & 3) * 8 + (4 * hh + ((lane & 15) >> 2)) * 64;
    LAS char* vw = vt + ((lane & 7) >> 2) * 2048 + ((lane >> 3) & 15) * 64 + (lane & 3) * 16;
    LAS char* kw = kst + (lane >> 3) * 128;
    const LAS char* kr = kst + r * 128;
    const int rsw = (r >> 1) & 7;
#pragma unroll
    for (int kb = 0; kb < 5; ++kb) {
        if (kb + 1 < 5) { AT_LOADK(kb + 1); AT_LOADV(kb + 1); }
        __builtin_amdgcn_sched_barrier(0);
#pragma unroll
        for (int it = 0; it < 4; ++it) { const int key = (lane >> 3) + 8 * it;
            *(LAS v4u*)(kw + it * 1024 + (((lane & 7) ^ ((key >> 1) & 7)) << 4)) = ks_[kb % 2][it]; }
        f32x16 p;
        int relb = 32 * kb - 64 - r + 4 * hh; const int kposb = tq0 + d * (32 * kb - 64 + 4 * hh);
        asm volatile("" : "+v"(relb));
#pragma unroll
        for (int v = 0; v < 16; ++v) {
            const int rw = (v & 3) + 8 * (v >> 2), rel = relb + rw, kpos = kposb + d * rw;
            bool valid = ((unsigned)kpos < (unsigned)S) && (r < nq);
            if (kb == 0) valid = valid && (rel >= -64);
            if (kb == 4) valid = valid && (rel <= 64);
            p[v] = valid ? -(a2 * fabsf((float)rel)) - bound2 : -1e30f;
        }
        asm volatile("s_waitcnt lgkmcnt(0)" ::: "memory");
        bf16x8 kf[4];
#pragma unroll
        for (int ks = 0; ks < 4; ++ks) kf[ks] = *(const LAS bf16x8*)(kr + (((2 * ks + hh) ^ rsw) << 4));
#pragma unroll
        for (int ks = 0; ks < 4; ++ks) p = __builtin_amdgcn_mfma_f32_32x32x16_bf16(kf[ks], qf[ks], p, 0, 0, 0);
#pragma unroll
        for (int it = 0; it < 4; ++it) *(LAS v4u*)(vw + (it >> 1) * 1024 + (it & 1) * 512) = vs[kb % 2][it];
#pragma unroll
        for (int v = 0; v < 16; ++v) { p[v] = __builtin_amdgcn_exp2f(p[v]); lsum += p[v]; }
        v4u pw0, pw1;
        pw0.x = pk2(p[0], p[1]); pw0.y = pk2(p[2], p[3]); pw0.z = pk2(p[4], p[5]); pw0.w = pk2(p[6], p[7]);
        pw1.x = pk2(p[8], p[9]); pw1.y = pk2(p[10], p[11]); pw1.z = pk2(p[12], p[13]); pw1.w = pk2(p[14], p[15]);
        asm volatile("s_waitcnt lgkmcnt(0)" ::: "memory");
#pragma unroll
        for (int sdh = 0; sdh < 4; ++sdh) {
            const int dh = sdh >> 1, ss = sdh & 1;
            const s16x4 lo = vtr(vb + dh * 2048 + ss * 1024), hi = vtr(vb + dh * 2048 + ss * 1024 + 512);
            const bf16x8 vf = {lo[0], lo[1], lo[2], lo[3], hi[0], hi[1], hi[2], hi[3]};
            const bf16x8 pa = __builtin_bit_cast(bf16x8, ss == 0 ? pw0 : pw1);
            if (dh == 0) o0 = __builtin_amdgcn_mfma_f32_32x32x16_bf16(pa, vf, o0, 0, 0, 0);
            else o1 = __builtin_amdgcn_mfma_f32_32x32x16_bf16(pa, vf, o1, 0, 0, 0);
        }
        asm volatile("s_waitcnt lgkmcnt(0)" ::: "memory");
        __builtin_amdgcn_sched_barrier(0);
    }
#undef AT_LOADK
#undef AT_LOADV
    lsum += __shfl_xor(lsum, 32);
    if (lane < nq) { LAS float* lp = Lacc + tl0 + tls * lane; *lp = first ? lsum : *lp + lsum; }
#pragma unroll
    for (int v = 0; v < 16; ++v) {
        const int iq = (v & 3) + 8 * (v >> 2) + 4 * hh;
        if (v < 8 || nq == 32) { LAS float* op = Oacc + (tl0 + tls * iq) * 64 + r;
            if (first) { op[0] = o0[v]; op[32] = o1[v]; } else { const float x0 = op[0], x1 = op[32]; op[0] = x0 + o0[v]; op[32] = x1 + o1[v]; } }
    }
}
__device__ __forceinline__ void attn_phase(const Ctx& C, const Args& a) {
    const bf16* Q = (const bf16*)(a.ws + WS_PROJ + 16 * MiB);
    const bf16* K = (const bf16*)(a.ws + WS_PROJ + 32 * MiB);
    const bf16* V = (const bf16*)(a.ws + WS_PROJ + 48 * MiB);
    bf16* MIXED = (bf16*)(a.ws + WS_MIXED);
    LAS float* Oacc = (LAS float*)(C.lds + AT_O); LAS float* Lacc = (LAS float*)(C.lds + AT_L); LAS char* vst = (LAS char*)(C.lds + AT_V + C.wave * 8192);
    float mq = fabsf(a.in[7][C.lane]), mk = fabsf(a.in[8][C.lane]);
#pragma unroll
    for (int o = 1; o < 64; o <<= 1) { mq = fmaxf(mq, __shfl_xor(mq, o)); mk = fmaxf(mk, __shfl_xor(mk, o)); }
    const float bound2 = 64.f * pg8::QSCALE * mq * mk * 1.01f;
    for (int item = C.vcu; item < NB * NH * 16; item += C.G) {
        const int span = item & 15, h = (item >> 4) & 7, b = item >> 7, t0 = span * 256, w = C.wave;
        const size_t hb = (size_t)(b * NH + h) * S * 64;
        const bf16 *Qh = Q + hb, *Kh = K + hb, *Vh = V + hb;
        const float slope2 = exp2f(-(float)(h + 1)) * 1.4426950408889634f;
#pragma unroll 1
        for (int un = 0; un < 4; ++un) {
            const int d = un == 0 ? 1 : (un == 1 ? 4 : 16);
            const int tl0 = un == 0 ? 32 * w : (un == 1 ? (w >> 1) + 128 * (w & 1) : 2 * w + (un - 2));
            attn_unit(C, Qh, Kh, Vh, d, t0 + tl0, un < 2 ? 32 : 16, tl0, d, slope2 * (float)d, bound2, Oacc, Lacc, vst, un == 0);
            if (un < 2) __syncthreads();
        }
        __syncthreads();
        {
            const int q = C.tid >> 1, hf = C.tid & 1;
            const float inv = 1.f / Lacc[q];
            const LAS f32x4* op = (const LAS f32x4*)(Oacc + q * 64 + 32 * hf);
            bf16* dst = MIXED + (size_t)(b * S + t0 + q) * D + 512 + h * 64 + 32 * hf;
#pragma unroll
            for (int j = 0; j < 4; ++j) { const f32x4 x0 = op[2 * j] * inv, x1 = op[2 * j + 1] * inv; v4u o; o.x = pk2(x0[0], x0[1]); o.y = pk2(x0[2], x0[3]); o.z = pk2(x1[0], x1[1]); o.w = pk2(x1[2], x1[3]); *(v4u*)(dst + 8 * j) = o; }
        }
        __syncthreads();
    }
}

__device__ __forceinline__ void p_router(const Ctx& C, const Args& a, int layer) {
    const float* X = layer == 0 ? a.out : (const float*)(a.ws + WS_XB); const float* g = a.in[20] + (size_t)layer * D;
    const float* wr = a.in[21] + (size_t)layer * D * NE; const float* br = a.in[22] + layer * NE;
    bf16* XN = (bf16*)(a.ws + WS_XN); float* AFF = (float*)(a.ws + WS_AFF);
    LAS float* wl = (LAS float*)C.lds;
    for (int i = C.tid; i < D * 4; i += NTHR) { const int k = i >> 2, qd = i & 3; const f32x4 v = *(const f32x4*)(wr + (size_t)k * NE + 4 * qd);
        const int slot = ((k >> 8) * 4 + (k & 3)) * 64 + ((k >> 2) & 63); *(LAS f32x4*)(wl + slot * 20 + 4 * qd) = v; }
    __syncthreads();
    const int gw = C.vcu * NWAVES + C.wave, NGW = C.G * NWAVES;
    for (int m = gw; m < T; m += NGW) {
        const f32x4* xr = (const f32x4*)(X + (size_t)m * D) + C.lane;
        f32x4 v[4]; float s = 0.f;
#pragma unroll
        for (int j = 0; j < 4; ++j) { v[j] = xr[64 * j]; s += (v[j][0] * v[j][0] + v[j][1] * v[j][1]) + (v[j][2] * v[j][2] + v[j][3] * v[j][3]); }
        const float r = rsqrtf(wave_sum(s) * (1.f / D) + EPS);
        float acc[NE];
#pragma unroll
        for (int e = 0; e < NE; ++e) acc[e] = 0.f;
#pragma unroll
        for (int j = 0; j < 4; ++j) {
            const f32x4 w = ((const f32x4*)g)[C.lane + 64 * j];
            const f32x4 hv = v[j] * w * r;
            v2u o; o.x = pk2(hv[0], hv[1]); o.y = pk2(hv[2], hv[3]); ((v2u*)(XN + (size_t)m * D))[C.lane + 64 * j] = o;
#pragma unroll
            for (int i = 0; i < 4; ++i) {
                const LAS float* wp = wl + ((j * 4 + i) * 64 + C.lane) * 20;
#pragma unroll
                for (int qd = 0; qd < 4; ++qd) { const f32x4 ww = *(const LAS f32x4*)(wp + 4 * qd); acc[4 * qd] += hv[i] * ww[0]; acc[4 * qd + 1] += hv[i] * ww[1]; acc[4 * qd + 2] += hv[i] * ww[2]; acc[4 * qd + 3] += hv[i] * ww[3]; }
                if (i & 1) asm volatile("" ::: "memory");
            }
        }
        float mx = -1e30f;
#pragma unroll
        for (int e = 0; e < NE; ++e) { acc[e] = wave_sum(acc[e]) + br[e]; mx = fmaxf(mx, acc[e]); }
        float sum = 0.f;
#pragma unroll
        for (int e = 0; e < NE; ++e) { acc[e] = __expf(acc[e] - mx); sum += acc[e]; }
        float mine = 0.f;
#pragma unroll
        for (int e = 0; e < NE; ++e) if (C.lane == e) mine = acc[e];
        const int b = m / S, ss = m % S;
        if (C.lane < NE) AFF[((size_t)b * NE + C.lane) * S + ss] = mine / sum;
    }
    __syncthreads();
}

__device__ __forceinline__ int popc64(unsigned long long m) { return __builtin_popcountll(m); }
__device__ __forceinline__ void p_topk(const Ctx& C, const Args& a) {
    const float* AFF = (const float*)(a.ws + WS_AFF);
    int* IDX = (int*)(a.ws + WS_IDX); float* GATE = (float*)(a.ws + WS_GATE); int* SLOT = (int*)(a.ws + WS_SLOT);
    const int lane = C.lane, w = C.wave;
    for (int item = C.vcu; item < NB * NE * 4; item += C.G) {
        const int be = item >> 2, qt = item & 3, b = be / NE, e = be % NE;
        unsigned key[16][4];
#pragma unroll
        for (int j = 0; j < 16; ++j) { const v4u k = *(const v4u*)(AFF + (size_t)be * S + 256 * j + 4 * lane); key[j][0] = k.x; key[j][1] = k.y; key[j][2] = k.z; key[j][3] = k.w; }
        unsigned cur = 0u;
        LAS unsigned* curw = (LAS unsigned*)C.lds;
        if (w == 0) {
#pragma unroll 1
        for (int bit = 30; bit >= 0; --bit) {
            const unsigned cand = cur | (1u << bit);
            unsigned c4[4] = {0u, 0u, 0u, 0u};
#pragma unroll
            for (int j = 0; j < 16; ++j)
#pragma unroll
                for (int i = 0; i < 4; ++i) c4[i] += (key[j][i] >= cand) ? 1u : 0u;
            const unsigned c = (c4[0] + c4[1]) + (c4[2] + c4[3]);
            int cnt = 0;
#pragma unroll
            for (int k = 0; k < 7; ++k) cnt += popc64(__ballot((c >> k) & 1u)) << k;
            if (cnt >= CAP) cur = cand;
        }
        if (lane == 0) curw[0] = cur;
        }
        __syncthreads();
        cur = curw[0];
        __syncthreads();
        const int jj = 4 * qt + (w >> 1);
        unsigned cga = 0, pre = 0; unsigned kk[4] = {0u, 0u, 0u, 0u};
#pragma unroll
        for (int j = 0; j < 16; ++j) {
            unsigned cg = 0, ce = 0;
#pragma unroll
            for (int i = 0; i < 4; ++i) { cg += (key[j][i] > cur) ? 1u : 0u; ce += (key[j][i] == cur) ? 1u : 0u; }
            cga += cg;
            if (j < jj) pre += cg | (ce << 8);
            if (j == jj) { kk[0] = key[j][0]; kk[1] = key[j][1]; kk[2] = key[j][2]; kk[3] = key[j][3]; }
        }
        int ngt = 0, gpre = 0, epre = 0;
#pragma unroll
        for (int k = 0; k < 7; ++k) { ngt += popc64(__ballot((cga >> k) & 1u)) << k; gpre += popc64(__ballot((pre >> k) & 1u)) << k; epre += popc64(__ballot((pre >> (8 + k)) & 1u)) << k; }
        const int need = CAP - ngt;
        unsigned pk = 0;
#pragma unroll
        for (int i = 0; i < 4; ++i) pk += (kk[i] > cur ? 1u : 0u) + (kk[i] == cur ? 0x10000u : 0u);
        unsigned inc = pk;
#pragma unroll
        for (int o = 1; o < 64; o <<= 1) { const unsigned t = __shfl_up(inc, o); if (lane >= o) inc += t; }
        const unsigned exc = inc - pk;
        int gtb = gpre + (int)(exc & 0xffffu), eqb = epre + (int)(exc >> 16);
        if ((lane >> 5) == (w & 1)) {
#pragma unroll
            for (int i = 0; i < 4; ++i) {
                const bool gt = kk[i] > cur, eq = kk[i] == cur;
                const bool sel = gt || (eq && eqb < need);
                const int pos = gtb + (eqb < need ? eqb : need);
                const int tok = 256 * jj + 4 * lane + i;
                SLOT[((size_t)(b * S + tok)) * NE + e] = sel ? pos : -1;
                if (sel) { IDX[be * CAP + pos] = b * S + tok; GATE[be * CAP + pos] = __uint_as_float(kk[i]); }
                gtb += gt ? 1 : 0; eqb += eq ? 1 : 0;
            }
        }
    }
}

__device__ __forceinline__ void p_combine(const Ctx& C, const Args& a, bool with_norm) {
    const float* Xin = with_norm ? a.out : (const float*)(a.ws + WS_XB); float* Xout = with_norm ? (float*)(a.ws + WS_XB) : a.out;
    const bf16* Y = (const bf16*)(a.ws + WS_PROJ); const int* SLOT = (const int*)(a.ws + WS_SLOT);
    bf16* XN = (bf16*)(a.ws + WS_XN); const float* g = a.in[10];
    const int gw = C.vcu * NWAVES + C.wave, NGW = C.G * NWAVES;
    for (int m = gw; m < T; m += NGW) {
        const int b = m / S;
        const f32x4* xr = (const f32x4*)(Xin + (size_t)m * D) + C.lane; f32x4* xo = (f32x4*)(Xout + (size_t)m * D) + C.lane;
        f32x4 v[4];
#pragma unroll
        for (int j = 0; j < 4; ++j) v[j] = xr[64 * j];
        const int myslot = (C.lane < NE) ? SLOT[(size_t)m * NE + C.lane] : -1;
        for (int e = 0; e < NE; ++e) {
            const int sl = __shfl(myslot, e);
            if (sl >= 0) {
                const v2u* yr = (const v2u*)(Y + ((size_t)(b * NE + e) * CAP + sl) * D) + C.lane;
#pragma unroll
                for (int j = 0; j < 4; ++j) { const v2u y = yr[64 * j]; v[j][0] += bflo(y.x); v[j][1] += bfhi(y.x); v[j][2] += bflo(y.y); v[j][3] += bfhi(y.y); }
            }
        }
#pragma unroll
        for (int j = 0; j < 4; ++j) xo[64 * j] = v[j];
        if (with_norm) {
            float s = 0.f;
#pragma unroll
            for (int j = 0; j < 4; ++j) s += (v[j][0] * v[j][0] + v[j][1] * v[j][1]) + (v[j][2] * v[j][2] + v[j][3] * v[j][3]);
            const float r = rsqrtf(wave_sum(s) * (1.f / D) + EPS);
#pragma unroll
            for (int j = 0; j < 4; ++j) { const f32x4 w = ((const f32x4*)g)[C.lane + 64 * j]; v2u o; o.x = pk2(v[j][0] * r * w[0], v[j][1] * r * w[1]); o.y = pk2(v[j][2] * r * w[2], v[j][3] * r * w[3]); ((v2u*)(XN + (size_t)m * D))[C.lane + 64 * j] = o; }
        }
    }
}

constexpr size_t WS_CAR = 400 * MiB;
constexpr int S5_NC = 16, S5_CL = S / S5_NC;
__device__ __forceinline__ void s5_lambda(const Args& a, int pg, int p, float& lbr, float& lbi, float& fr, float& fi) {
    const float lr = a.in[11][pg * SP + p], li = a.in[12][pg * SP + p], dt = expf(a.in[13][pg]);
    const float mag = expf(lr * dt), ang = li * dt;
    lbr = mag * cosf(ang); lbi = mag * sinf(ang);
    const float den = lr * lr + li * li, nr = lbr - 1.f;
    fr = (nr * lr + lbi * li) / den; fi = (lbi * lr - nr * li) / den;
}
template <bool FINAL>
__device__ __forceinline__ void p_s5_pass(const Ctx& C, const Args& a) {
    const bf16* XN = (const bf16*)(a.ws + WS_XN); float* CAR = (float*)(a.ws + WS_CAR); bf16* Y = (bf16*)(a.ws + WS_PROJ);
    LAS char* img = (LAS char*)(C.lds + C.wave * 8192);
    const int lane = C.lane, r = lane & 31, hh = lane >> 5;
    for (int bjob = C.vcu; bjob < 512; bjob += C.G) {
        const int g = (bjob & 7) * 8 + C.wave, c = (bjob >> 3) & 15, dir = (bjob >> 7) & 1, bp = bjob >> 8;
        if (!FINAL && c == S5_NC - 1) continue;
        const int pg = dir * SG + g;
        float lbr[2], lbi[2]; bf16x8 bfr[2], bfi[2];
#pragma unroll
        for (int nt = 0; nt < 2; ++nt) {
            float fr, fi; s5_lambda(a, pg, r + 32 * nt, lbr[nt], lbi[nt], fr, fi);
            const float* br = a.in[14] + ((size_t)pg * SP + r + 32 * nt) * SC + 8 * hh; const float* bi = a.in[15] + ((size_t)pg * SP + r + 32 * nt) * SC + 8 * hh;
            const f32x4 r0 = *(const f32x4*)br, r1 = *(const f32x4*)(br + 4), i0 = *(const f32x4*)bi, i1 = *(const f32x4*)(bi + 4);
            const f32x4 xr0 = r0 * fr - i0 * fi, xr1 = r1 * fr - i1 * fi, xi0 = i0 * fr + r0 * fi, xi1 = i1 * fr + r1 * fi;
            v4u wr_, wi_; wr_.x = pk2(xr0[0], xr0[1]); wr_.y = pk2(xr0[2], xr0[3]); wr_.z = pk2(xr1[0], xr1[1]); wr_.w = pk2(xr1[2], xr1[3]);
            wi_.x = pk2(xi0[0], xi0[1]); wi_.y = pk2(xi0[2], xi0[3]); wi_.z = pk2(xi1[0], xi1[1]); wi_.w = pk2(xi1[2], xi1[3]);
            bfr[nt] = __builtin_bit_cast(bf16x8, wr_); bfi[nt] = __builtin_bit_cast(bf16x8, wi_);
        }
        bf16x8 cf[8];
        if (FINAL) {
#pragma unroll
            for (int ks = 0; ks < 8; ++ks) {
                const int k0 = 16 * ks + 8 * hh; const bool im = k0 >= 64;
                const float* src = (im ? a.in[17] : a.in[16]) + ((size_t)pg * SC + (r & 15)) * SP + (k0 & 63);
                f32x4 c0 = *(const f32x4*)src, c1 = *(const f32x4*)(src + 4);
                const float sg = (r >= 16) ? 0.f : (im ? -1.f : 1.f);
                c0 = c0 * sg; c1 = c1 * sg;
                v4u w; w.x = pk2(c0[0], c0[1]); w.y = pk2(c0[2], c0[3]); w.z = pk2(c1[0], c1[1]); w.w = pk2(c1[2], c1[3]);
                cf[ks] = __builtin_bit_cast(bf16x8, w);
            }
        }
        float hr0 = 0.f, hi0 = 0.f, hr1 = 0.f, hi1 = 0.f;
        float* cp0 = CAR + (((size_t)(dir * NB + 2 * bp + hh) * SG + g) * S5_NC * SP) * 2;
        if (FINAL && c > 0) {
            float p0r = lbr[0], p0i = lbi[0], p1r = lbr[1], p1i = lbi[1];
#pragma unroll
            for (int i = 0; i < 8; ++i) { const float n0r = p0r * p0r - p0i * p0i, n0i = 2.f * p0r * p0i, n1r = p1r * p1r - p1i * p1i, n1i = 2.f * p1r * p1i; p0r = n0r; p0i = n0i; p1r = n1r; p1i = n1i; }
            for (int cc = 0; cc < c; ++cc) {
                const f32x2 e0 = *(const f32x2*)(cp0 + ((size_t)cc * SP + r) * 2), e1 = *(const f32x2*)(cp0 + ((size_t)cc * SP + r + 32) * 2);
                const float a0 = p0r * hr0 - p0i * hi0 + e0[0], b0 = p0r * hi0 + p0i * hr0 + e0[1];
                const float a1 = p1r * hr1 - p1i * hi1 + e1[0], b1 = p1r * hi1 + p1i * hr1 + e1[1];
                hr0 = a0; hi0 = b0; hr1 = a1; hi1 = b1;
            }
        }
        const int rb = 2 * bp + ((r >> 2) & 1), rv = (r & 3) + 4 * (r >> 3);
        const LAS char* ib = img + (8 * hh + ((lane & 15) >> 2)) * 64 + ((lane >> 4) & 1) * 32 + (lane & 3) * 8;
        const char* xb = (const char*)(XN + (size_t)rb * S * D + g * 16 + 8 * hh);
#define S5_LOADA(tile_) (*(const bf16x8*)(xb + (size_t)(dir ? (S - 1 - (c * S5_CL + ((tile_) < 15 ? (tile_) : 15) * 16 + rv)) : (c * S5_CL + ((tile_) < 15 ? (tile_) : 15) * 16 + rv)) * (D * 2)))
        bf16x8 a0 = S5_LOADA(0), a1 = S5_LOADA(1), a2 = S5_LOADA(2), a3 = S5_LOADA(3);
        auto body = [&](bf16x8 af, const int tile) __attribute__((always_inline)) {
            asm volatile("" : "+v"(af), "+v"(hr0), "+v"(hi0), "+v"(hr1), "+v"(hi1));
            const int sidx = c * S5_CL + tile * 16;
            f32x16 z;
#pragma unroll
            for (int v = 0; v < 16; ++v) z[v] = 0.f;
            f32x16 ur0 = __builtin_amdgcn_mfma_f32_32x32x16_bf16(af, bfr[0], z, 0, 0, 0), ur1 = __builtin_amdgcn_mfma_f32_32x32x16_bf16(af, bfr[1], z, 0, 0, 0);
            f32x16 ui0 = __builtin_amdgcn_mfma_f32_32x32x16_bf16(af, bfi[0], z, 0, 0, 0), ui1 = __builtin_amdgcn_mfma_f32_32x32x16_bf16(af, bfi[1], z, 0, 0, 0);
#pragma unroll
            for (int v = 0; v < 16; ++v) {
                const float x0 = lbr[0] * hr0 - lbi[0] * hi0 + ur0[v], y0 = lbr[0] * hi0 + lbi[0] * hr0 + ui0[v];
                const float x1 = lbr[1] * hr1 - lbi[1] * hi1 + ur1[v], y1 = lbr[1] * hi1 + lbi[1] * hr1 + ui1[v];
                hr0 = x0; hi0 = y0; hr1 = x1; hi1 = y1;
                ur0[v] = x0; ui0[v] = y0; ur1[v] = x1; ui1[v] = y1;
            }
            if (FINAL) {
#define S5_WR(vec, row) do { v4u w0, w1; w0.x = pk2(vec[0], vec[1]); w0.y = pk2(vec[2], vec[3]); w0.z = pk2(vec[4], vec[5]); w0.w = pk2(vec[6], vec[7]); \
                    w1.x = pk2(vec[8], vec[9]); w1.y = pk2(vec[10], vec[11]); w1.z = pk2(vec[12], vec[13]); w1.w = pk2(vec[14], vec[15]); \
                    *(LAS v4u*)(img + (row) * 64 + 32 * hh) = w0; *(LAS v4u*)(img + (row) * 64 + 32 * hh + 16) = w1; } while (0)
                S5_WR(ur0, r); S5_WR(ur1, r + 32); S5_WR(ui0, 64 + r); S5_WR(ui1, 96 + r);
#undef S5_WR
                asm volatile("s_waitcnt lgkmcnt(0)" ::: "memory");
                f32x16 y;
#pragma unroll
                for (int v = 0; v < 16; ++v) y[v] = 0.f;
#pragma unroll
                for (int ks = 0; ks < 8; ++ks) {
                    const s16x4 lo = vtr(ib + ks * 1024), hi = vtr(ib + ks * 1024 + 256);
                    const bf16x8 hf = {lo[0], lo[1], lo[2], lo[3], hi[0], hi[1], hi[2], hi[3]};
                    y = __builtin_amdgcn_mfma_f32_32x32x16_bf16(cf[ks], hf, y, 0, 0, 0);
                }
                asm volatile("s_waitcnt lgkmcnt(0)" ::: "memory");
                const int tb = 2 * bp + (r >> 4), tv = r & 15;
                const int t = dir ? (S - 1 - (sidx + tv)) : (sidx + tv);
                bf16* yp = Y + (size_t)dir * T * D + ((size_t)tb * S + t) * D + g * 16 + 4 * hh;
                v2u w0, w1; w0.x = pk2(y[0], y[1]); w0.y = pk2(y[2], y[3]); w1.x = pk2(y[4], y[5]); w1.y = pk2(y[6], y[7]);
                *(v2u*)yp = w0; *(v2u*)(yp + 8) = w1;
            }
        };
#pragma unroll 1
        for (int tile = 0; tile < S5_CL / 16; tile += 4) {
            body(a0, tile); a0 = S5_LOADA(tile + 4);
            body(a1, tile + 1); a1 = S5_LOADA(tile + 5);
            body(a2, tile + 2); a2 = S5_LOADA(tile + 6);
            body(a3, tile + 3); a3 = S5_LOADA(tile + 7);
        }
#undef S5_LOADA
        if (!FINAL) { float* cp = cp0 + (size_t)c * SP * 2; *(f32x2*)(cp + 2 * r) = (f32x2){hr0, hi0}; *(f32x2*)(cp + 2 * (r + 32)) = (f32x2){hr1, hi1}; }
    }
}
__device__ __forceinline__ float gelu_t(float y) { const float u = 0.7978845608028654f * (y + 0.044715f * y * y * y); const float e = __builtin_amdgcn_exp2f(2.885390081777927f * u); const float th = 1.f - 2.f * __builtin_amdgcn_rcpf(e + 1.f); return 0.5f * y * (1.f + th); }
__device__ __forceinline__ void p_s5_post(const Ctx& C, const Args& a) {
    const float* X = (const float*)(a.ws + WS_XB); const bf16* YF = (const bf16*)(a.ws + WS_PROJ); const bf16* YB = YF + (size_t)T * D;
    const float* g = a.in[10]; const float* dsk = a.in[18]; bf16* Z = (bf16*)(a.ws + WS_MIXED);
    const int gw = C.vcu * NWAVES + C.wave, NGW = C.G * NWAVES;
    for (int m = gw; m < T; m += NGW) {
        const f32x4* xr = (const f32x4*)(X + (size_t)m * D) + C.lane;
        f32x4 v[4]; float s = 0.f;
#pragma unroll
        for (int j = 0; j < 4; ++j) { v[j] = xr[64 * j]; s += (v[j][0] * v[j][0] + v[j][1] * v[j][1]) + (v[j][2] * v[j][2] + v[j][3] * v[j][3]); }
        const float r = rsqrtf(wave_sum(s) * (1.f / D) + EPS);
#pragma unroll
        for (int j = 0; j < 4; ++j) {
            const f32x4 w = ((const f32x4*)g)[C.lane + 64 * j], dd = ((const f32x4*)dsk)[C.lane + 64 * j];
            const v2u pf = ((const v2u*)(YF + (size_t)m * D))[C.lane + 64 * j], pb_ = ((const v2u*)(YB + (size_t)m * D))[C.lane + 64 * j];
            const f32x4 yf = {bflo(pf.x), bfhi(pf.x), bflo(pf.y), bfhi(pf.y)}, yb = {bflo(pb_.x), bfhi(pb_.x), bflo(pb_.y), bfhi(pb_.y)};
            const f32x4 y = yf + yb + dd * (v[j] * w * r);
            v2u o; o.x = pk2(gelu_t(y[0]), gelu_t(y[1])); o.y = pk2(gelu_t(y[2]), gelu_t(y[3])); ((v2u*)(Z + (size_t)m * D))[C.lane + 64 * j] = o;
        }
    }
}

constexpr int NPHASE = 18;
__global__ void __launch_bounds__(NTHR, 2) mk_fwd(Args args) {
    extern __shared__ __attribute__((aligned(16))) unsigned char lds_raw[];
    Ctx C;
    C.lds = (LAS unsigned char*)lds_raw;
    C.tid = threadIdx.x; C.lane = C.tid & 63; C.wave = __builtin_amdgcn_readfirstlane(C.tid >> 6);
    C.G = gridDim.x; { const int bx = blockIdx.x; C.vcu = (C.G % 8 == 0) ? (bx % 8) * (C.G / 8) + bx / 8 : bx; }
    volatile LAS unsigned* MISC = (volatile LAS unsigned*)(C.lds + LDSCTL_OFF);
    for (int u = C.tid; u < (LDS_BYTES - LDSCTL_OFF) / 4; u += NTHR) ((LAS unsigned*)(C.lds + LDSCTL_OFF))[u] = 0u;
    __syncthreads();
    int lo = args.ph_lo, hi = args.ph_hi;
    unsigned char* ws = args.ws;
    asm volatile("" : "+s"(lo), "+s"(hi), "+s"(ws));
    unsigned* ctl = (unsigned*)(ws + WS_CTL);
    const bool one_launch = (lo == 0 && hi == NPHASE);
    XcdBarrier bar; bar.bar = ctl + CW_BAR; bar.x = 0; bar.st = nullptr;
    if (one_launch) bar = xcd_barrier_post(ctl + CW_BAR, MISC + 8);
    LAS unsigned char* glds = C.lds;
#ifndef MK_ONLY
#define MK_ONLY -1
#endif
#define IN(k) ((MK_ONLY < 0 || MK_ONLY == (k) || (MK_ONLY == 4 && (k) == 13) || (MK_ONLY == 5 && (k) == 14) || (MK_ONLY == 6 && (k) == 15) || (MK_ONLY == 7 && (k) == 16) || (MK_ONLY == 8 && (k) == 17)) && lo <= (k) && (k) < hi)
#ifndef MK_DUP
#define MK_DUP 0
#endif
#define DUPBIT(k) ((MK_DUP >> ((k) < 13 ? (k) : (k) - 9)) & 1)
#define DUPX(k, ...) do { __VA_ARGS__ if (DUPBIT(k)) { __VA_ARGS__ } } while (0)
#define SEAM(k) do { if (IN(k) && IN((k) + 1)) xcd_barrier(bar); } while (0)

#ifdef MK_XBAR
    if (one_launch) for (int xb_ = 0; xb_ < MK_XBAR; ++xb_) xcd_barrier(bar);
#endif
    if (IN(0)) { DUPX(0, p0_prologue(C, args);); } SEAM(0);
    if (IN(1)) {
        const int G1 = (C.G == 256) ? 214 : C.G;
        if ((int)blockIdx.x < G1) {
            pg8::Gemm g{(const bf16*)(ws + WS_XN), (const bf16*)(ws + WS_WIN), D, nullptr}; pg8::DenseOrder So; So.init(T, INC, G1, (int)blockIdx.x);
            pg8::EpiProj E{(bf16*)(ws + WS_PROJ), (bf16*)(ws + WS_PROJ + 16 * MiB), args.in[7], args.in[8]};
            pg8::gemm_phase<pg8::EpiProj, pg8::DenseOrder, true, true>(glds, g, So, E);
            if (C.tid == 0) __hip_atomic_fetch_add((unsigned*)(ws + WS_CTL) + CW_P1DONE, 1u, __ATOMIC_RELAXED, __HIP_MEMORY_SCOPE_AGENT);
        } else conv_drain(C, args, true);
    } SEAM(1);
    if (IN(2)) {
 DUPX(2, {        conv_drain(C, args, false);
        for (int t = C.vcu; t < T / 32; t += C.G) conv_tile(C, args, t);
#ifdef MK_DUPCONV
        for (int t = C.vcu; t < T / 32; t += C.G) conv_tile(C, args, t);
#endif
        attn_phase(C, args);
    }); } SEAM(2);
    if (IN(3)) {
 DUPX(3, {        pg8::Gemm g{(const bf16*)(ws + WS_MIXED), (const bf16*)(ws + WS_WOUT), D, nullptr}; pg8::DenseOrder So; So.init(T, D, C.G, (int)blockIdx.x);
        pg8::EpiRes E{args.in[0], args.out};
        pg8::gemm_phase<pg8::EpiRes, pg8::DenseOrder, true, true>(glds, g, So, E);
    }); } SEAM(3);
#define MOE_PHASES(layer, pb) do { \
        if (IN(pb)) { DUPX(pb, p_router(C, args, layer);); } SEAM(pb); \
        if (IN(pb + 1)) { DUPX(pb + 1, p_topk(C, args);); } SEAM(pb + 1); \
        if (IN(pb + 2)) { DUPX(pb + 2, { \
            pg8::Gemm g{(const bf16*)(ws + WS_XN), (const bf16*)(ws + WS_WEXP + layer * WEXP_LAYER + WEXP_GU), D, (const int*)(ws + WS_IDX)}; pg8::ExpertOrder So; So.init(8, C.G, (int)blockIdx.x); \
            pg8::EpiSwiGLU E{(bf16*)(ws + WS_H)}; \
            pg8::gemm_phase<pg8::EpiSwiGLU, pg8::ExpertOrder, true, true, true>(glds, g, So, E); \
        }); } SEAM(pb + 2); \
        if (IN(pb + 3)) { DUPX(pb + 3, { \
            pg8::Gemm g{(const bf16*)(ws + WS_H), (const bf16*)(ws + WS_WEXP + layer * WEXP_LAYER + WEXP_DN), EH, nullptr}; pg8::ExpertOrder So; So.init(4, C.G, (int)blockIdx.x); \
            pg8::EpiDown E{(bf16*)(ws + WS_PROJ), (const float*)(ws + WS_GATE)}; \
            pg8::gemm_phase<pg8::EpiDown, pg8::ExpertOrder, true, true>(glds, g, So, E); \
        }); } SEAM(pb + 3); \
        if (IN(pb + 4)) { DUPX(pb + 4, p_combine(C, args, layer == 0);); } \
    } while (0)
    MOE_PHASES(0, 4);
    SEAM(8);
    if (IN(9)) { DUPX(9, p_s5_pass<false>(C, args);); } if (IN(9) && IN(11)) xcd_barrier(bar);
    if (IN(11)) { DUPX(11, p_s5_pass<true>(C, args);); if (one_launch) xcd_barrier(bar); DUPX(11, p_s5_post(C, args);); } SEAM(11);
    if (IN(12)) {
        pg8::Gemm g{(const bf16*)(ws + WS_MIXED), (const bf16*)(ws + WS_WGLU), D, nullptr}; pg8::DenseOrder So; So.init(T, 2 * D, C.G, (int)blockIdx.x);
        pg8::EpiGluRes E{(float*)(ws + WS_XB)};
        pg8::gemm_phase<pg8::EpiGluRes, pg8::DenseOrder, true, true>(glds, g, So, E);
    } SEAM(12);
    MOE_PHASES(1, 13);
#undef IN
#undef SEAM
}

#ifndef MK_PER_PHASE
#define MK_PER_PHASE 0
#endif
extern "C" void kernel_launch(void* const* d_in, const int* in_sizes, int n_in, void* d_out, int out_size, void* d_ws, size_t ws_size, hipStream_t stream) {
    static int grid = 0;
    if (grid == 0) {
        if (n_in != 26 || out_size != T * D || ws_size < WS_END) { fprintf(stderr, "kernel_launch: unexpected shapes (n_in %d out %d ws %zu)\n", n_in, out_size, ws_size); grid = -1; return; }
        int dev = 0, cus = 0, per_cu = 0;
        if (hipGetDevice(&dev) != hipSuccess || hipDeviceGetAttribute(&cus, hipDeviceAttributeMultiprocessorCount, dev) != hipSuccess) { grid = -1; return; }
        if (hipFuncSetAttribute((const void*)mk_fwd, hipFuncAttributeMaxDynamicSharedMemorySize, LDS_BYTES) != hipSuccess) { fprintf(stderr, "kernel_launch: hipFuncSetAttribute failed\n"); grid = -1; return; }
        if (hipOccupancyMaxActiveBlocksPerMultiprocessor(&per_cu, (const void*)mk_fwd, NTHR, LDS_BYTES) != hipSuccess || per_cu < 1) { fprintf(stderr, "kernel_launch: occupancy query says %d blocks per CU\n", per_cu); (void)hipGetLastError(); grid = -1; return; }
        grid = cus;
    }
    if (grid < 0) return;
    (void)hipMemsetAsync((char*)d_ws + WS_CTL, 0, CTL_ZERO_BYTES, stream);
    Args a{};
    for (int i = 0; i < 26; ++i) a.in[i] = (const float*)d_in[i];
    a.out = (float*)d_out; a.ws = (unsigned char*)d_ws;
#if MK_PER_PHASE
    for (int p = 0; p < NPHASE; ++p) { a.ph_lo = p; a.ph_hi = p + 1; hipLaunchKernelGGL(mk_fwd, dim3(grid), dim3(NTHR), LDS_BYTES, stream, a); }
#else
    a.ph_lo = 0; a.ph_hi = NPHASE;
    hipLaunchKernelGGL(mk_fwd, dim3(grid), dim3(NTHR), LDS_BYTES, stream, a);
#endif
}
```

```cpp
#include <hip/hip_runtime.h>
#include <cstdint>
#include <cstdio>

namespace pg8 {
#define PG8_LAS __attribute__((address_space(3)))
typedef unsigned short bf16_t;
typedef short bf16x8 __attribute__((ext_vector_type(8)));
typedef float f32x4 __attribute__((ext_vector_type(4)));
typedef unsigned u32x4 __attribute__((ext_vector_type(4)));
constexpr int BM = 256, BK = 64, HALF = 128, HTB = HALF * BK * 2  , STAGE_BYTES = 8 * HTB, NXCD = 8, WGM = 8;

__host__ __device__ __forceinline__ int lds_byte(int r, int c) { const int st = (r >> 4) * 2 + (c >> 5), rr = r & 15, cc = c & 31, ob = rr * 64 + cc * 2; return st * 1024 + (ob ^ (((ob >> 9) & 1) << 5)); }
__host__ __device__ __forceinline__ void stage_rc(int b, int& R, int& C) { const int st = b / 1024, sb = b % 1024, swz = sb ^ (((sb >> 9) & 1) << 5); R = (st >> 1) * 16 + swz / 64; C = (st & 1) * 32 + (swz % 64) / 2; }
__host__ __device__ __forceinline__ int perm32(int rho) { const int n = rho >> 4, i = rho & 15; return 8 * (i >> 2) + 4 * n + (i & 3); }

struct Unit { int pm, pn, pb; };
struct Gemm { const bf16_t* A; const bf16_t* Bt; int K; const int* gidx; int lda, ldb; };

struct DenseOrder {
    int nM, nN, nwg, G, c;
    __device__ void init(int M, int N, int G_, int c_) { nM = M / BM; nN = N / BM; nwg = nM * nN; G = G_; c = c_; }
    __device__ bool next(int i, Unit& u) const {
        const long L = (long)i * G + c; if (L >= nwg) return false;
        int wgid = (int)L; { const int q = nwg / NXCD, r = nwg % NXCD, xcd = wgid % NXCD, off = wgid / NXCD; wgid = (xcd < r ? xcd * (q + 1) : r * (q + 1) + (xcd - r) * q) + off; }
        const int nig = WGM * nN, gid = wgid / nig, fm = gid * WGM, gsz = (nM - fm) < WGM ? (nM - fm) : WGM;
        u.pm = fm + ((wgid % nig) % gsz); u.pn = (wgid % nig) / gsz; u.pb = u.pn; return true;
    }
    __device__ __forceinline__ void a_ready(const Unit&) const {}
    __device__ __forceinline__ void done(const Unit&) const {}
};
struct ExpertOrder {
    int nN, nun, G, c;
    __device__ void init(int nN_, int G_, int c_) { nN = nN_; nun = 128 * nN_; G = G_; c = c_; }
    __device__ bool next(int i, Unit& u) const {
        const long L = (long)i * G + c; if (L >= nun) return false;
        int V = (int)L;
        if (G == 256) V = i * 256 + (c & 7) * 32 + (c >> 3);
        const int per = 8 * nN, e = V / per, r = V % per, pml = r / nN, pn = r % nN;
        u.pm = ((pml >> 1) * 16 + e) * 2 + (pml & 1); u.pn = pn; u.pb = e * nN + pn; return true;
    }
    __device__ __forceinline__ void a_ready(const Unit&) const {}
    __device__ __forceinline__ void done(const Unit&) const {}
};

typedef float f32x2 __attribute__((ext_vector_type(2)));
typedef __bf16 bf16x2_t __attribute__((ext_vector_type(2)));
__device__ __forceinline__ unsigned pk2(float lo, float hi) { f32x2 v = {lo, hi}; bf16x2_t b = __builtin_convertvector(v, bf16x2_t); return __builtin_bit_cast(unsigned, b); }
__device__ __forceinline__ float sigm(float x) { return __builtin_amdgcn_rcpf(1.f + __builtin_amdgcn_exp2f(-1.4426950408889634f * x)); }

constexpr float QSCALE = 0.125f * 1.4426950408889634f;
struct EpiProj {
    static constexpr bool PERM = true, AFTER_DRAIN = false;
    bf16_t *GLU, *Q; const float *qg, *kg;
    __device__ __forceinline__ void operator()(const f32x4 (&acc)[2][2][4][2], const Unit& u, int wr, int wc, int fr, int fq) const {
        const int row0 = u.pm * BM + wr * 64 + fr;
        if (u.pn < 4) {
            const int col0 = 128 * u.pn + 32 * wc + 8 * fq;
#pragma unroll
            for (int ai = 0; ai < 2; ++ai)
#pragma unroll
                for (int m = 0; m < 4; ++m) {
                    const f32x4 v0 = acc[ai][0][m][0], v1 = acc[ai][0][m][1], g0 = acc[ai][1][m][0], g1 = acc[ai][1][m][1];
                    u32x4 w; w.x = pk2(v0[0] * sigm(g0[0]), v0[1] * sigm(g0[1])); w.y = pk2(v0[2] * sigm(g0[2]), v0[3] * sigm(g0[3]));
                    w.z = pk2(v1[0] * sigm(g1[0]), v1[1] * sigm(g1[1])); w.w = pk2(v1[2] * sigm(g1[2]), v1[3] * sigm(g1[3]));
                    *(u32x4*)(GLU + (size_t)(row0 + ai * HALF + m * 16) * 512 + col0) = w;
                    asm volatile("" ::: "memory");
                }
        } else {
            const int t = (u.pn - 4) >> 1;
            const int hd = 4 * ((u.pn - 4) & 1) + wc;
            bf16_t* dst = Q + (size_t)t * (size_t)(8u << 20);
            const float* gp = (const float*)((uintptr_t)qg + (((uintptr_t)kg - (uintptr_t)qg) & (uintptr_t)(t == 0 ? 0 : ~(uintptr_t)0)));
#pragma unroll
            for (int ai = 0; ai < 2; ++ai)
#pragma unroll
                for (int m = 0; m < 4; ++m) {
                    float ss = 0.f;
#pragma unroll
                    for (int bj = 0; bj < 2; ++bj)
#pragma unroll
                        for (int n = 0; n < 2; ++n) { const f32x4 x = acc[ai][bj][m][n]; ss += (x[0] * x[0] + x[1] * x[1]) + (x[2] * x[2] + x[3] * x[3]); }
                    ss += __shfl_xor(ss, 16); ss += __shfl_xor(ss, 32);
                    float rs = 1.f;
                    if (t < 2) rs = rsqrtf(ss * (1.f / 64.f) + 1e-6f) * (t == 0 ? QSCALE : 1.f);
#pragma unroll
                    for (int bj = 0; bj < 2; ++bj) {
                        f32x4 g0 = {1.f, 1.f, 1.f, 1.f}, g1 = g0;
                        if (t < 2) { g0 = *(const f32x4*)(gp + 32 * bj + 8 * fq); g1 = *(const f32x4*)(gp + 32 * bj + 8 * fq + 4); }
                        const f32x4 a = acc[ai][bj][m][0] * g0 * rs, b = acc[ai][bj][m][1] * g1 * rs;
                        u32x4 w; w.x = pk2(a[0], a[1]); w.y = pk2(a[2], a[3]); w.z = pk2(b[0], b[1]); w.w = pk2(b[2], b[3]);
                        const int row = row0 + ai * HALF + m * 16;
                        *(u32x4*)(dst + ((size_t)((row >> 12) * 8 + hd) * 4096 + (row & 4095)) * 64 + 32 * bj + 8 * fq) = w;
                    }
                    asm volatile("" ::: "memory");
                }
        }
    }
};
struct EpiRes {
    static constexpr bool PERM = false, AFTER_DRAIN = false;
    const float* xin; float* X;
    __device__ __forceinline__ void operator()(const f32x4 (&acc)[2][2][4][2], const Unit& u, int wr, int wc, int fr, int fq) const {
        const int row0 = u.pm * BM + wr * 64 + fr, col0 = u.pn * BM + wc * 32 + 4 * fq;
#pragma unroll
        for (int ai = 0; ai < 2; ++ai)
#pragma unroll
            for (int m = 0; m < 4; ++m) { const size_t off = (size_t)(row0 + ai * HALF + m * 16) * 1024 + col0;
#pragma unroll
                for (int bj = 0; bj < 2; ++bj)
#pragma unroll
                    for (int n = 0; n < 2; ++n) { const f32x4 r = *(const f32x4*)(xin + off + bj * HALF + n * 16); *(f32x4*)(X + off + bj * HALF + n * 16) = r + acc[ai][bj][m][n]; } }
    }
};
struct EpiSwiGLU {
    static constexpr bool PERM = true, AFTER_DRAIN = false;
    bf16_t* H;
    __device__ __forceinline__ void operator()(const f32x4 (&acc)[2][2][4][2], const Unit& u, int wr, int wc, int fr, int fq) const {
        const int row0 = u.pm * BM + wr * 64 + fr, col0 = 128 * u.pn + 32 * wc + 8 * fq;
#pragma unroll
        for (int ai = 0; ai < 2; ++ai)
#pragma unroll
            for (int m = 0; m < 4; ++m) {
                const f32x4 g0 = acc[ai][0][m][0], g1 = acc[ai][0][m][1], u0 = acc[ai][1][m][0], u1 = acc[ai][1][m][1];
                u32x4 w; w.x = pk2(g0[0] * sigm(g0[0]) * u0[0], g0[1] * sigm(g0[1]) * u0[1]); w.y = pk2(g0[2] * sigm(g0[2]) * u0[2], g0[3] * sigm(g0[3]) * u0[3]);
                w.z = pk2(g1[0] * sigm(g1[0]) * u1[0], g1[1] * sigm(g1[1]) * u1[1]); w.w = pk2(g1[2] * sigm(g1[2]) * u1[2], g1[3] * sigm(g1[3]) * u1[3]);
                *(u32x4*)(H + (size_t)(row0 + ai * HALF + m * 16) * 1024 + col0) = w;
            }
    }
};
struct EpiDown {
    static constexpr bool PERM = true, AFTER_DRAIN = false;
    bf16_t* Y; const float* gate;
    __device__ __forceinline__ void operator()(const f32x4 (&acc)[2][2][4][2], const Unit& u, int wr, int wc, int fr, int fq) const {
        const int row0 = u.pm * BM + wr * 64 + fr, col0 = u.pn * BM + wc * 32 + 8 * fq;
#pragma unroll
        for (int ai = 0; ai < 2; ++ai)
#pragma unroll
            for (int m = 0; m < 4; ++m) { const int row = row0 + ai * HALF + m * 16; const float gs = gate[row];
#pragma unroll
                for (int bj = 0; bj < 2; ++bj) { const f32x4 a = acc[ai][bj][m][0] * gs, b = acc[ai][bj][m][1] * gs;
                    u32x4 w; w.x = pk2(a[0], a[1]); w.y = pk2(a[2], a[3]); w.z = pk2(b[0], b[1]); w.w = pk2(b[2], b[3]);
                    *(u32x4*)(Y + (size_t)row * 1024 + col0 + bj * HALF) = w; } }
    }
};
struct EpiGluRes {
    static constexpr bool PERM = false, AFTER_DRAIN = false;
    float* X;
    __device__ __forceinline__ void operator()(const f32x4 (&acc)[2][2][4][2], const Unit& u, int wr, int wc, int fr, int fq) const {
        const int row0 = u.pm * BM + wr * 64 + fr, col0 = 128 * u.pn + 32 * wc + 4 * fq;
#pragma unroll
        for (int ai = 0; ai < 2; ++ai)
#pragma unroll
            for (int m = 0; m < 4; ++m) { float* p = X + (size_t)(row0 + ai * HALF + m * 16) * 1024 + col0;
#pragma unroll
                for (int n = 0; n < 2; ++n) { const f32x4 v = acc[ai][0][m][n], g = acc[ai][1][m][n]; f32x4 r = *(const f32x4*)(p + n * 16);
                    r[0] += v[0] * sigm(g[0]); r[1] += v[1] * sigm(g[1]); r[2] += v[2] * sigm(g[2]); r[3] += v[3] * sigm(g[3]); *(f32x4*)(p + n * 16) = r; } }
    }
};

template <class Epi, class Sched, bool ALIGN_EPI = false, bool SP2 = false, bool GATHER = false>
__device__ __forceinline__ void gemm_phase(PG8_LAS unsigned char* lds, const Gemm g, const Sched& S, const Epi& E) {
    const int tid = threadIdx.x, wid = __builtin_amdgcn_readfirstlane(tid >> 6), lane = tid & 63, wr = wid >> 2, wc = wid & 3, fr = lane & 15, fq = lane >> 4;
    const int K = g.K, nt = K / BK;
    unsigned voffA[2], voffB[2];
#pragma unroll
    for (int i = 0; i < 2; ++i) { int R, C; stage_rc(tid * 16 + i * 8192, R, C); const int Rb = Epi::PERM ? ((R & ~31) + perm32(R & 31)) : R;
        voffA[i] = (unsigned)(R * g.lda + C) * 2u; voffB[i] = (unsigned)(Rb * g.ldb + C) * 2u; }
    const size_t kstep = (size_t)(BK * 2);
    const size_t hstepA = (size_t)HALF * g.lda * 2, hstepB = (size_t)HALF * g.ldb * 2;
    const size_t tstepA = 2 * hstepA, tstepB = 2 * hstepB;
    const unsigned ldsw = (unsigned)wid * 1024u;
    const int aoff = lds_byte(wr * 64 + fr, fq * 8), boff = lds_byte(wc * 32 + fr, fq * 8);
#define PG8_SA(b, h) (((b) * 2 + (h)) * HTB)
#define PG8_SB(b, h) ((4 + (b) * 2 + (h)) * HTB)
#define PG8_STAGE(bufoff, gbase, voff) do { _Pragma("unroll") for (int _i = 0; _i < 2; ++_i) \
        __builtin_amdgcn_global_load_lds((const unsigned*)((const char*)(gbase) + (voff)[_i]), (PG8_LAS unsigned*)(lds + (bufoff) + ldsw + _i * 8192), 16, 0, 0); } while (0)
#define PG8_STAGE_A(bufoff, gptr, h, nsel) do { if constexpr (GATHER) { const unsigned _o[2] = {(nsel) ? nOA[h][0] : oA[h][0], (nsel) ? nOA[h][1] : oA[h][1]}; PG8_STAGE(bufoff, gptr, _o); } \
        else { PG8_STAGE(bufoff, (gptr) + ((h) ? hstepA : 0), voffA); } } while (0)
#define PG8_GOFF(dst, u) do { if constexpr (GATHER) { _Pragma("unroll") for (int _h = 0; _h < 2; ++_h) _Pragma("unroll") for (int _i = 0; _i < 2; ++_i) { \
        (dst)[_h][_i] = (unsigned)g.gidx[(u).pm * BM + _h * HALF + gR[_i]] * (unsigned)(g.lda * 2) + gC[_i]; asm volatile("" : "+v"((dst)[_h][_i])); } } } while (0)
#define PG8_LDA(dst, b, h) do { _Pragma("unroll") for (int m = 0; m < 4; ++m) _Pragma("unroll") for (int k = 0; k < 2; ++k) dst[m][k] = *(const PG8_LAS bf16x8*)(lds + PG8_SA(b, h) + aoff + m * 2048 + k * 1024); } while (0)
#define PG8_LDB(dst, b, h) do { _Pragma("unroll") for (int n = 0; n < 2; ++n) _Pragma("unroll") for (int k = 0; k < 2; ++k) dst[n][k] = *(const PG8_LAS bf16x8*)(lds + PG8_SB(b, h) + boff + n * 2048 + k * 1024); } while (0)
#define PG8_MMA(ai, bj, At, Bt) do { __builtin_amdgcn_s_setprio(1); _Pragma("unroll") for (int m = 0; m < 4; ++m) _Pragma("unroll") for (int n = 0; n < 2; ++n) _Pragma("unroll") for (int k = 0; k < 2; ++k) \
        acc[ai][bj][m][n] = __builtin_amdgcn_mfma_f32_16x16x32_bf16(Bt[n][k], At[m][k], acc[ai][bj][m][n], 0, 0, 0); __builtin_amdgcn_s_setprio(0); } while (0)
#define PG8_WAIT_V(n) asm volatile("s_waitcnt vmcnt(" #n ")" ::: "memory")
#define PG8_WAIT_L(n) asm volatile("s_waitcnt lgkmcnt(" #n ")" ::: "memory")
#define PG8_BAR __builtin_amdgcn_s_barrier()
#define PG8_SCHED __builtin_amdgcn_sched_barrier(0)
    Unit cur, nxt; int ui = 0;
    if (!S.next(0, cur)) return;
    unsigned oA[2][2], nOA[2][2]; int gR[2]; unsigned gC[2];
    if constexpr (GATHER) { static_assert(SP2, "GATHER is wired into the SP2 loop only");
#pragma unroll
        for (int i = 0; i < 2; ++i) { int R, Cc; stage_rc(tid * 16 + i * 8192, R, Cc); gR[i] = R; gC[i] = (unsigned)Cc * 2u; } }
    PG8_GOFF(oA, cur);
    f32x4 acc[2][2][4][2];
#pragma unroll
    for (int a = 0; a < 2; ++a)
#pragma unroll
        for (int b = 0; b < 2; ++b)
#pragma unroll
            for (int m = 0; m < 4; ++m)
#pragma unroll
                for (int n = 0; n < 2; ++n) acc[a][b][m][n] = (f32x4){0.f, 0.f, 0.f, 0.f};
    bf16x8 At[4][2], B0[2][2], B1[2][2];
    const char* cA = (const char*)g.A + (GATHER ? (size_t)0 : (size_t)cur.pm * tstepA); const char* cB = (const char*)g.Bt + (size_t)cur.pb * tstepB;
    S.a_ready(cur);
    if constexpr (SP2) {
        PG8_STAGE(PG8_SB(0, 0), cB, voffB); PG8_STAGE(PG8_SB(0, 1), cB + hstepB, voffB); PG8_STAGE_A(PG8_SA(0, 0), cA, 0, false); PG8_STAGE_A(PG8_SA(0, 1), cA, 1, false);
        if (wr == 1) PG8_BAR;
        PG8_WAIT_V(2); PG8_BAR;
        PG8_STAGE(PG8_SB(1, 0), cB + kstep, voffB); PG8_STAGE_A(PG8_SA(1, 0), cA + kstep, 0, false); PG8_STAGE(PG8_SB(1, 1), cB + hstepB + kstep, voffB);
        PG8_WAIT_V(6); PG8_BAR;
    } else {
        PG8_STAGE(PG8_SB(0, 0), cB, voffB); PG8_STAGE(PG8_SA(0, 0), cA, voffA); PG8_STAGE(PG8_SB(0, 1), cB + hstepB, voffB); PG8_STAGE(PG8_SA(0, 1), cA + hstepA, voffA);
        if (wr == 1) PG8_BAR;
        PG8_WAIT_V(4); PG8_BAR;
        PG8_STAGE(PG8_SB(1, 0), cB + kstep, voffB); PG8_STAGE(PG8_SA(1, 0), cA + kstep, voffA); PG8_STAGE(PG8_SB(1, 1), cB + hstepB + kstep, voffB);
        PG8_WAIT_V(6); PG8_BAR;
    }
    for (;;) {
        const bool has_next = S.next(ui + 1, nxt);
        const char* nA = has_next ? (const char*)g.A + (GATHER ? (size_t)0 : (size_t)nxt.pm * tstepA) : cA; const char* nB = has_next ? (const char*)g.Bt + (size_t)nxt.pb * tstepB : cB;
        if constexpr (GATHER) { if (has_next) { PG8_GOFF(nOA, nxt); } else {
#pragma unroll
            for (int _h = 0; _h < 2; ++_h) { nOA[_h][0] = oA[_h][0]; nOA[_h][1] = oA[_h][1]; } } }
        for (int t = 0; t < nt; t += 2) {
            const bool last = (t == nt - 2);
            const char* a1 = cA + (size_t)(t + 1) * kstep;
            const char* a2 = last ? nA : cA + (size_t)(t + 2) * kstep; const char* b2 = last ? nB : cB + (size_t)(t + 2) * kstep;
            const char* a3 = a2 + kstep; const char* b3 = b2 + kstep;
            if (last && has_next) S.a_ready(nxt);
            if constexpr (SP2) {
            PG8_LDB(B0, 0, 0); PG8_LDB(B1, 0, 1); PG8_SCHED; PG8_LDA(At, 0, 0); PG8_STAGE_A(PG8_SA(1, 1), a1, 1, false);
            PG8_WAIT_V(8); PG8_WAIT_L(0); PG8_BAR; PG8_MMA(0, 0, At, B0); PG8_MMA(0, 1, At, B1); PG8_BAR; PG8_SCHED;
            PG8_LDA(At, 0, 1); PG8_STAGE(PG8_SB(0, 0), b2, voffB); PG8_STAGE(PG8_SB(0, 1), b2 + hstepB, voffB); PG8_STAGE_A(PG8_SA(0, 0), a2, 0, last);
            PG8_WAIT_V(8); PG8_WAIT_L(0); PG8_BAR; PG8_MMA(1, 0, At, B0); PG8_MMA(1, 1, At, B1); PG8_BAR; PG8_SCHED;
            PG8_LDB(B0, 1, 0); PG8_LDB(B1, 1, 1); PG8_SCHED; PG8_LDA(At, 1, 0); PG8_STAGE_A(PG8_SA(0, 1), a2, 1, last);
            PG8_WAIT_V(8); PG8_WAIT_L(0); PG8_BAR; PG8_MMA(0, 0, At, B0); PG8_MMA(0, 1, At, B1); PG8_BAR; PG8_SCHED;
            PG8_LDA(At, 1, 1); PG8_STAGE(PG8_SB(1, 0), b3, voffB); PG8_STAGE(PG8_SB(1, 1), b3 + hstepB, voffB); PG8_STAGE_A(PG8_SA(1, 0), a3, 0, last);
            PG8_WAIT_V(8); PG8_WAIT_L(0); PG8_BAR; PG8_MMA(1, 0, At, B0); PG8_MMA(1, 1, At, B1); PG8_BAR; PG8_SCHED;
            } else {
            PG8_LDB(B0, 0, 0); PG8_SCHED; PG8_LDA(At, 0, 0); PG8_STAGE(PG8_SA(1, 1), a1 + hstepA, voffA);
            PG8_WAIT_L(8); PG8_BAR; PG8_WAIT_L(0); PG8_MMA(0, 0, At, B0); PG8_BAR; PG8_SCHED;
            PG8_LDB(B1, 0, 1); PG8_STAGE(PG8_SB(0, 0), b2, voffB);
            PG8_BAR; PG8_WAIT_L(0); PG8_MMA(0, 1, At, B1); PG8_BAR;
            PG8_LDA(At, 0, 1); PG8_STAGE(PG8_SA(0, 0), a2, voffA);
            PG8_BAR; PG8_WAIT_L(0); PG8_MMA(1, 0, At, B0); PG8_BAR; PG8_SCHED;
            PG8_STAGE(PG8_SB(0, 1), b2 + hstepB, voffB);
            PG8_WAIT_V(6); PG8_BAR; PG8_MMA(1, 1, At, B1); PG8_BAR;
            PG8_LDB(B0, 1, 0); PG8_SCHED; PG8_LDA(At, 1, 0); PG8_STAGE(PG8_SA(0, 1), a2 + hstepA, voffA);
            PG8_WAIT_L(8); PG8_BAR; PG8_WAIT_L(0); PG8_MMA(0, 0, At, B0); PG8_BAR; PG8_SCHED;
            PG8_LDB(B1, 1, 1); PG8_STAGE(PG8_SB(1, 0), b3, voffB);
            PG8_BAR; PG8_WAIT_L(0); PG8_MMA(0, 1, At, B1); PG8_BAR;
            PG8_LDA(At, 1, 1); PG8_STAGE(PG8_SA(1, 0), a3, voffA);
            PG8_BAR; PG8_WAIT_L(0); PG8_MMA(1, 0, At, B0); PG8_BAR; PG8_SCHED;
            PG8_STAGE(PG8_SB(1, 1), b3 + hstepB, voffB);
            PG8_WAIT_V(6); PG8_BAR; PG8_MMA(1, 1, At, B1); PG8_BAR;
            }
        }
        if constexpr (ALIGN_EPI) { if (wr == 0) PG8_BAR; }
        if constexpr (!Epi::AFTER_DRAIN) { E(acc, cur, wr, wc, fr, fq); S.done(cur); }
        if (!has_next) break;
#pragma unroll
        for (int a = 0; a < 2; ++a)
#pragma unroll
            for (int b = 0; b < 2; ++b)
#pragma unroll
                for (int m = 0; m < 4; ++m)
#pragma unroll
                    for (int n = 0; n < 2; ++n) acc[a][b][m][n] = (f32x4){0.f, 0.f, 0.f, 0.f};
        cur = nxt; cA = nA; cB = nB; ++ui;
        if constexpr (GATHER) {
#pragma unroll
            for (int _h = 0; _h < 2; ++_h) { oA[_h][0] = nOA[_h][0]; oA[_h][1] = nOA[_h][1]; } }
        if constexpr (ALIGN_EPI) { if (wr == 1) PG8_BAR; }
    }
    PG8_WAIT_V(0);
    if constexpr (!ALIGN_EPI) { if (wr == 0) PG8_BAR; }
    PG8_BAR;
    if constexpr (Epi::AFTER_DRAIN) { E.fused(acc, cur, wr, wc, fr, fq, lds, wid, lane); S.done(cur); }
#undef PG8_SA
#undef PG8_SB
#undef PG8_STAGE
#undef PG8_LDA
#undef PG8_STAGE_A
#undef PG8_GOFF
#undef PG8_LDB
#undef PG8_MMA
#undef PG8_WAIT_V
#undef PG8_WAIT_L
#undef PG8_BAR
#undef PG8_SCHED
}
}

constexpr int NB = 4, S = 4096, D = 1024, T = NB * S;
constexpr int CONV_CH = 512, CONV_W = 31, NH = 8, INC = 2560;
constexpr int SG = 64, SC = 16, SP = 64;
constexpr int NE = 16, CAP = 512, EH = 1024, MR = NB * NE * CAP;
constexpr float EPS = 1e-6f;
constexpr int NWAVES = 8, NTHR = NWAVES * 64;

constexpr size_t MiB = 1u << 20;
constexpr size_t WS_CTL = 0, CTL_ZERO_BYTES = 64 * 1024;
constexpr size_t WS_AFF = 1 * MiB, WS_IDX = 2 * MiB, WS_GATE = 2 * MiB + 512 * 1024, WS_SLOT = 3 * MiB;
constexpr size_t WS_WIN = 4 * MiB, WS_WOUT = 10 * MiB, WS_WGLU = 12 * MiB;
constexpr size_t WS_WEXP = 16 * MiB, WEXP_LAYER = 96 * MiB, WEXP_GU = 0, WEXP_DN = 64 * MiB;
constexpr size_t WS_XN = 208 * MiB, WS_MIXED = 240 * MiB;
constexpr size_t WS_PROJ = 272 * MiB;
constexpr size_t WS_H = 336 * MiB;
constexpr size_t WS_XB = 404 * MiB;
constexpr size_t WS_END = 492 * MiB;
constexpr int CW_BAR = 1024, CW_Q0 = 64;

constexpr int SCRATCH_BYTES = 143360;
constexpr int LDSCTL_OFF = SCRATCH_BYTES;
constexpr int LDS_BYTES = 147456;

#define GAS __attribute__((address_space(1)))
#define LAS __attribute__((address_space(3)))
typedef unsigned short bf16;
typedef unsigned v4u __attribute__((ext_vector_type(4)));
typedef unsigned v2u __attribute__((ext_vector_type(2)));
typedef float f32x4 __attribute__((ext_vector_type(4)));
typedef float f32x2 __attribute__((ext_vector_type(2)));
using pg8::pk2;
using pg8::sigm;
__device__ __forceinline__ float bf2f(unsigned short h) { return __uint_as_float(((unsigned)h) << 16); }
__device__ __forceinline__ float bflo(unsigned w) { return __uint_as_float(w << 16); }
__device__ __forceinline__ float bfhi(unsigned w) { return __uint_as_float(w & 0xffff0000u); }
__device__ __forceinline__ float wave_sum(float v) {
#pragma unroll
    for (int o = 1; o < 64; o <<= 1) v += __shfl_xor(v, o);
    return v;
}

#define XB_TMO      128
#define XB_XCNT(j)  (256  + 64 * (j))
#define XB_XSUB(j)  (1280 + 64 * (j))
#define XB_XGEN(j)  (2304 + 64 * (j))
#define XB_TOP      3328
#define XB_TOPGEN   3392
#define XCD_BAR_WORDS 3456
#define XB_SPIN_CAP (1u << 18)
__device__ __forceinline__ unsigned xb_ld(unsigned* p)              { return __hip_atomic_load(p, __ATOMIC_RELAXED, __HIP_MEMORY_SCOPE_AGENT); }
__device__ __forceinline__ unsigned xb_add(unsigned* p, unsigned v) { return __hip_atomic_fetch_add(p, v, __ATOMIC_RELAXED, __HIP_MEMORY_SCOPE_AGENT); }
__device__ __forceinline__ unsigned xb_xcc_id() { return (unsigned)__builtin_amdgcn_s_getreg((3 << 11) | 20) & 0xFu; }
#define XB_SPIN(cond, bar) do { unsigned _sp = 0; while (cond) { __builtin_amdgcn_s_sleep(1); \
    if ((++_sp & 255u) == 0u) { if (xb_ld(&(bar)[XB_TMO])) break; if (_sp > XB_SPIN_CAP) { atomicAdd(&(bar)[XB_TMO], 1u); break; } } } } while (0)
struct XcdBarrier { unsigned* bar; unsigned x; volatile LAS unsigned* st; };
__device__ __forceinline__ XcdBarrier xcd_barrier_post(unsigned* bar, volatile LAS unsigned* st) {
    XcdBarrier b; b.bar = bar; b.x = xb_xcc_id(); b.st = st;
    if (threadIdx.x == 0) (void)xb_add(&bar[XB_XCNT(b.x)], 1u);
    return b;
}
__device__ __forceinline__ void xcd_barrier_complete(unsigned* bar, unsigned x, unsigned& nloc, unsigned& nx) {
    const unsigned G = gridDim.x * gridDim.y * gridDim.z;
    unsigned sum, cnt, mine, sp = 0u;
    for (;;) {
        sum = 0u; cnt = 0u; mine = 0u;
#pragma unroll
        for (unsigned j = 0; j < 16; ++j) { const unsigned c = xb_ld(&bar[XB_XCNT(j)]); sum += c; cnt += (c > 0u) ? 1u : 0u; mine = (j == x) ? c : mine; }
        if (sum == G) break;
        __builtin_amdgcn_s_sleep(1);
        if ((++sp & 255u) == 0u) { if (xb_ld(&bar[XB_TMO])) break; if (sp > XB_SPIN_CAP) { atomicAdd(&bar[XB_TMO], 1u); break; } }
    }
    nloc = mine > 0u ? mine : 1u; nx = cnt > 0u ? cnt : 1u;
}
__device__ __forceinline__ void xcd_barrier(const XcdBarrier& b) {
    asm volatile("s_waitcnt vmcnt(0)" ::: "memory");
    __syncthreads();
    if (threadIdx.x == 0) {
        unsigned* bar = b.bar;
        __builtin_amdgcn_s_waitcnt(0);
        unsigned nloc = b.st[0], nx = b.st[1];
        if (nloc == 0u) { xcd_barrier_complete(bar, b.x, nloc, nx); b.st[0] = nloc; b.st[1] = nx; }
        const unsigned old = xb_add(&bar[XB_XSUB(b.x)], 1u);
        const unsigned gen = old / nloc;
        if (old + 1u == (gen + 1u) * nloc) {
            __builtin_amdgcn_fence(__ATOMIC_RELEASE, "agent");
            asm volatile("s_waitcnt vmcnt(0)" ::: "memory");
            const unsigned og = xb_add(&bar[XB_TOP], 1u);
            const unsigned tg = og / nx;
            if (og + 1u == (tg + 1u) * nx) xb_add(&bar[XB_TOPGEN], 1u);
            else XB_SPIN(xb_ld(&bar[XB_TOPGEN]) == tg, bar);
            __builtin_amdgcn_fence(__ATOMIC_ACQUIRE, "agent");
            xb_add(&bar[XB_XGEN(b.x)], 1u);
            asm volatile("s_waitcnt vmcnt(0)" ::: "memory");
        } else {
            XB_SPIN(xb_ld(&bar[XB_XGEN(b.x)]) == gen, bar);
            __builtin_amdgcn_fence(__ATOMIC_ACQUIRE, "agent");
            asm volatile("s_waitcnt vmcnt(0)" ::: "memory");
        }
    }
    __syncthreads();
}

struct Args {
    const float* in[26]; float* out; unsigned char* ws; int ph_lo, ph_hi;
};
struct Ctx { LAS unsigned char* lds; int tid, lane, wave, vcu, G; };

__device__ __forceinline__ int rowmap(int kind, int half, int n) {
    if (kind == 0) {
        if (n < 1024) { const int hf = n >> 9, r = n & 511; return 256 * (r >> 7) + 128 * hf + (r & 127); }
        const int pn = n >> 8, w = n & 255, wc = w >> 6, bj = (w >> 5) & 1, j = w & 31; return 256 * pn + 128 * bj + 32 * wc + j;
    }
    if (kind == 2) { const int hf = n >> 10, r = n & 1023; return 256 * (r >> 7) + 128 * hf + (r & 127); }
    if (kind == 3) return 256 * (n >> 7) + 128 * half + (n & 127);
    return n;
}
struct ConvDesc { const float* src; bf16* dst; int N, kind, half, k0, n0; };
__device__ __forceinline__ bool conv_desc(const Args& a, int it, ConvDesc& d) {
    constexpr int I_IN = 16 * 40, I_OUT = 256, I_GLU = 16 * 32, I_EXP = 2 * 16 * 3 * 256;
    if (it >= I_IN + I_OUT + I_GLU + I_EXP) return false;
    unsigned char* ws = a.ws; int r = it, kb, nb;
    if (r < I_IN) { d.src = a.in[2]; d.N = INC; d.dst = (bf16*)(ws + WS_WIN); d.kind = 0; d.half = 0; kb = r / 40; nb = r % 40; }
    else if ((r -= I_IN) < I_OUT) { d.src = a.in[9]; d.N = D; d.dst = (bf16*)(ws + WS_WOUT); d.kind = 1; d.half = 0; kb = r >> 4; nb = r & 15; }
    else if ((r -= I_OUT) < I_GLU) { d.src = a.in[19]; d.N = 2 * D; d.dst = (bf16*)(ws + WS_WGLU); d.kind = 2; d.half = 0; kb = r >> 5; nb = r & 31; }
    else { r -= I_GLU; const int mat = r >> 8, tile = r & 255, layer = mat / 48, rem = mat % 48, e = rem / 3, which = rem % 3;
        d.src = a.in[23 + which] + ((size_t)layer * NE + e) * (size_t)D * EH; d.N = EH;
        d.dst = (bf16*)(ws + WS_WEXP + layer * WEXP_LAYER + (which == 2 ? WEXP_DN + (size_t)e * 2 * MiB : WEXP_GU + (size_t)e * 4 * MiB));
        d.kind = which == 2 ? 1 : 3; d.half = which; kb = tile >> 4; nb = tile & 15; }
    d.k0 = 64 * kb; d.n0 = 64 * nb; return true;
}
__device__ __forceinline__ void conv_load(const ConvDesc& d, f32x4 (&v)[16], int lane) {
    const float* p = d.src + (size_t)(d.k0 + (lane >> 4)) * d.N + d.n0 + 4 * (lane & 15);
#pragma unroll
    for (int it = 0; it < 16; ++it) v[it] = *(const f32x4*)(p + (size_t)(4 * it) * d.N);
}
__device__ __forceinline__ void conv_store(const ConvDesc& d, const f32x4 (&v)[16], LAS float* scr, int lane) {
#pragma unroll
    for (int it = 0; it < 16; ++it) { const int kk = 4 * it + (lane >> 4), nn = 4 * (lane & 15);
        scr[kk * 65 + nn] = v[it][0]; scr[kk * 65 + nn + 1] = v[it][1]; scr[kk * 65 + nn + 2] = v[it][2]; scr[kk * 65 + nn + 3] = v[it][3]; }
    asm volatile("s_waitcnt lgkmcnt(0)" ::: "memory");
    const int kc = lane & 7;
#pragma unroll
    for (int jt = 0; jt < 8; ++jt) {
        const int nl = 8 * jt + (lane >> 3);
        const LAS float* s = scr + (8 * kc) * 65 + nl;
        v4u o; o.x = pk2(s[0], s[65]); o.y = pk2(s[2 * 65], s[3 * 65]); o.z = pk2(s[4 * 65], s[5 * 65]); o.w = pk2(s[6 * 65], s[7 * 65]);
        *(v4u*)(d.dst + (size_t)rowmap(d.kind, d.half, d.n0 + nl) * 1024 + d.k0 + 8 * kc) = o;
    }
    asm volatile("s_waitcnt lgkmcnt(0)" ::: "memory");
}
__device__ __forceinline__ void rms_row_bf16(const float* __restrict__ xrow, const float* __restrict__ g, bf16* __restrict__ orow, int lane) {
    const f32x4* xr = (const f32x4*)xrow + lane;
    f32x4 v[4]; float s = 0.f;
#pragma unroll
    for (int j = 0; j < 4; ++j) { v[j] = xr[64 * j]; s += (v[j][0] * v[j][0] + v[j][1] * v[j][1]) + (v[j][2] * v[j][2] + v[j][3] * v[j][3]); }
    const float r = rsqrtf(wave_sum(s) * (1.f / D) + EPS);
#pragma unroll
    for (int j = 0; j < 4; ++j) { const f32x4 w = ((const f32x4*)g)[lane + 64 * j]; v2u o; o.x = pk2(v[j][0] * r * w[0], v[j][1] * r * w[1]); o.y = pk2(v[j][2] * r * w[2], v[j][3] * r * w[3]); ((v2u*)orow)[lane + 64 * j] = o; }
}
constexpr int CONV_NITEMS = 25984, CONV_FIRST_Q = 640, CW_P1DONE = 128;
__device__ __forceinline__ void conv_drain(const Ctx& C, const Args& a, bool until_flag) {
    LAS float* scr = (LAS float*)(C.lds + C.wave * 16640);
    unsigned* ctl = (unsigned*)(a.ws + WS_CTL);
    LAS int* qs = (LAS int*)(C.lds + 8 * 16640);
    ConvDesc dA; f32x4 vA[16];
    for (;;) {
        if (C.tid == 0) {
            int v = -1;
            if (!(until_flag && __hip_atomic_load(ctl + CW_P1DONE, __ATOMIC_RELAXED, __HIP_MEMORY_SCOPE_AGENT) != 0u))
                v = CONV_FIRST_Q + (int)__hip_atomic_fetch_add(ctl + CW_Q0, 8u, __ATOMIC_RELAXED, __HIP_MEMORY_SCOPE_AGENT);
            qs[0] = v;
        }
        __syncthreads();
        const int base = qs[0];
        __syncthreads();
        if (base < 0 || base >= CONV_NITEMS) break;
        if (conv_desc(a, base + C.wave, dA)) { conv_load(dA, vA, C.lane); conv_store(dA, vA, scr, C.lane); }
    }
}
__device__ __forceinline__ void p0_prologue(const Ctx& C, const Args& a) {
    LAS float* scr = (LAS float*)(C.lds + C.wave * 16640);
    const int gw = C.vcu * NWAVES + C.wave, NGW = C.G * NWAVES;
    unsigned char* ws = a.ws;
    for (int m = gw; m < T; m += NGW) rms_row_bf16(a.in[0] + (size_t)m * D, a.in[1], (bf16*)(ws + WS_XN) + (size_t)m * D, C.lane);
    ConvDesc dA; f32x4 vA[16];
    for (int it = gw; it < CONV_FIRST_Q; it += NGW) if (conv_desc(a, it, dA)) { conv_load(dA, vA, C.lane); conv_store(dA, vA, scr, C.lane); }
}

__device__ __forceinline__ void conv_tile(const Ctx& C, const Args& a, int tile) {
    const bf16* GLU = (const bf16*)(a.ws + WS_PROJ);
    bf16* MIXED = (bf16*)(a.ws + WS_MIXED);
    const float* cw = a.in[3]; const float* cb = a.in[4]; const float* lg = a.in[5]; const float* lb = a.in[6];
    LAS float* tl = (LAS float*)C.lds;
    const int cp = C.tid & 255, th = C.tid >> 8;
    const int b = tile / (S / 32), s0 = (tile % (S / 32)) * 32;
    f32x2 w[CONV_W];
#pragma unroll
    for (int j = 0; j < CONV_W; ++j) w[j] = *(const f32x2*)(cw + j * CONV_CH + 2 * cp);
    f32x2 acc[16];
    const f32x2 bias = *(const f32x2*)(cb + 2 * cp);
#pragma unroll
    for (int k = 0; k < 16; ++k) acc[k] = bias;
    unsigned xin[46];
#pragma unroll
    for (int i = 0; i < 46; ++i) { const int ss = s0 + 16 * th - 15 + i; xin[i] = (ss >= 0 && ss < S) ? *(const unsigned*)(GLU + (size_t)(b * S + ss) * 512 + 2 * cp) : 0u; }
#pragma unroll
    for (int i = 0; i < 46; ++i) {
        const f32x2 x = {bflo(xin[i]), bfhi(xin[i])};
#pragma unroll
        for (int k = 0; k < 16; ++k) { const int j = i - k; if (j >= 0 && j < CONV_W) acc[k] += w[j] * x; }
    }
#pragma unroll
    for (int k = 0; k < 16; ++k) *(LAS f32x2*)(tl + (16 * th + k) * 512 + 2 * cp) = acc[k];
    __syncthreads();
#pragma unroll
    for (int q = 0; q < 4; ++q) {
        const int tok = 4 * C.wave + q;
        const f32x4 v0 = *(const LAS f32x4*)(tl + tok * 512 + 8 * C.lane), v1 = *(const LAS f32x4*)(tl + tok * 512 + 8 * C.lane + 4);
        const float mu = wave_sum((v0[0] + v0[1]) + (v0[2] + v0[3]) + (v1[0] + v1[1]) + (v1[2] + v1[3])) * (1.f / CONV_CH);
        const f32x4 d0 = v0 - mu, d1 = v1 - mu;
        const float var = wave_sum((d0[0] * d0[0] + d0[1] * d0[1]) + (d0[2] * d0[2] + d0[3] * d0[3]) + (d1[0] * d1[0] + d1[1] * d1[1]) + (d1[2] * d1[2] + d1[3] * d1[3])) * (1.f / CONV_CH);
        const float rs = rsqrtf(var + EPS);
        const f32x4 g0 = *(const f32x4*)(lg + 8 * C.lane), g1 = *(const f32x4*)(lg + 8 * C.lane + 4), b0 = *(const f32x4*)(lb + 8 * C.lane), b1 = *(const f32x4*)(lb + 8 * C.lane + 4);
        f32x4 y0 = d0 * rs * g0 + b0, y1 = d1 * rs * g1 + b1;
#pragma unroll
        for (int e = 0; e < 4; ++e) { y0[e] = y0[e] * sigm(y0[e]); y1[e] = y1[e] * sigm(y1[e]); }
        v4u o; o.x = pk2(y0[0], y0[1]); o.y = pk2(y0[2], y0[3]); o.z = pk2(y1[0], y1[1]); o.w = pk2(y1[2], y1[3]);
        *(v4u*)(MIXED + (size_t)(b * S + s0 + tok) * D + 8 * C.lane) = o;
    }
    __syncthreads();
}
typedef short bf16x8 __attribute__((ext_vector_type(8)));
typedef short s16x4 __attribute__((ext_vector_type(4)));
typedef short v4i16_t __attribute__((ext_vector_type(4)));
typedef float f32x16 __attribute__((ext_vector_type(16)));
constexpr int AT_O = 0, AT_L = 65536, AT_V = 66560;
__device__ __forceinline__ s16x4 vtr(const LAS char* p) { return __builtin_bit_cast(s16x4, __builtin_amdgcn_ds_read_tr16_b64_v4i16((LAS v4i16_t*)p)); }
__device__ __forceinline__ void lds_addf(LAS float* p, float v) { (void)__hip_atomic_fetch_add(p, v, __ATOMIC_RELAXED, __HIP_MEMORY_SCOPE_WORKGROUP); }
__device__ __forceinline__ int med3i(int x, int lo, int hi) { return x < lo ? lo : (x > hi ? hi : x); }
__device__ __forceinline__ void attn_unit(const Ctx& C, const bf16* __restrict__ Qh, const bf16* __restrict__ Kh, const bf16* __restrict__ Vh,
                                          int d, int tq0, int nq, int tl0, int tls, float a2, float bound2, LAS float* Oacc, LAS float* Lacc, LAS char* vst, bool first) {
    int lane_ = C.lane; asm volatile("" : "+v"(lane_));
    const int lane = lane_, r = lane & 31, hh = lane >> 5;
    const int qi = r < nq ? r : nq - 1;
    bf16x8 qf[4]; v4u ks_[2][4], vs[2][4];
    const char* Kc = (const char*)Kh; const char* Vc = (const char*)Vh;
#define AT_LOADK(kb) do { _Pragma("unroll") for (int it = 0; it < 4; ++it) { const int key = (lane >> 3) + 8 * it; \
        const unsigned ro = (unsigned)med3i(tq0 + d * (32 * (kb) + key - 64), 0, S - 1) * 128u + 16u * (lane & 7); ks_[(kb) % 2][it] = *(const v4u*)(Kc + ro); } } while (0)
#define AT_LOADV(kb) do { _Pragma("unroll") for (int it = 0; it < 4; ++it) { const int key = (lane >> 3) + 8 * it; \
        const unsigned ro = (unsigned)med3i(tq0 + d * (32 * (kb) + key - 64), 0, S - 1) * 128u + 16u * (lane & 7); vs[(kb) % 2][it] = *(const v4u*)(Vc + ro); } } while (0)
    { const char* qp = (const char*)Qh + (unsigned)(tq0 + d * qi) * 128u + 16u * hh;
#pragma unroll
      for (int ks = 0; ks < 4; ++ks) qf[ks] = *(const bf16x8*)(qp + 32 * ks); }
    AT_LOADK(0); AT_LOADV(0);
    f32x16 o0, o1;
#pragma unroll
    for (int v = 0; v < 16; ++v) { o0[v] = 0.f; o1[v] = 0.f; }
    float lsum = 0.f;
    LAS char* kst = vst, *vt = vst + 4096;
    const LAS char* vb = vt + ((lane >> 4) & 1) * 32 + (lane & 3) * 8 + (4 * hh + ((lane & 15) >> 2)) * 64;
    LAS char* vw = vt + ((lane & 7) >> 2) * 2048 + ((lane >> 3) & 15) * 64 + (lane & 3) * 16;
    LAS char* kw = kst + (lane >> 3) * 128;
    const LAS char* kr = kst + r * 128;
    const int rsw = (r >> 1) & 7;
#pragma unroll
    for (int kb = 0; kb < 5; ++kb) {
        if (kb + 1 < 5) { AT_LOADK(kb + 1); AT_LOADV(kb + 1); }
        __builtin_amdgcn_sched_barrier(0);
#pragma unroll
        for (int it = 0; it < 4; ++it) { const int key = (lane >> 3) + 8 * it;
            *(LAS v4u*)(kw + it * 1024 + (((lane & 7) ^ ((key >> 1) & 7)) << 4)) = ks_[kb % 2][it]; }
        f32x16 p;
        int relb = 32 * kb - 64 - r + 4 * hh; const int kposb = tq0 + d * (32 * kb - 64 + 4 * hh);
        asm volatile("" : "+v"(relb));
#pragma unroll
        for (int v = 0; v < 16; ++v) {
            const int rw = (v & 3) + 8 * (v >> 2), rel = relb + rw, kpos = kposb + d * rw;
            bool valid = ((unsigned)kpos < (unsigned)S) && (r < nq);
            if (kb == 0) valid = valid && (rel >= -64);
            if (kb == 4) valid = valid && (rel <= 64);
            p[v] = valid ? -(a2 * fabsf((float)rel)) - bound2 : -1e30f;
        }
        asm volatile("s_waitcnt lgkmcnt(0)" ::: "memory");
        bf16x8 kf[4];
#pragma unroll
        for (int ks = 0; ks < 4; ++ks) kf[ks] = *(const LAS bf16x8*)(kr + (((2 * ks + hh) ^ rsw) << 4));
#pragma unroll
        for (int ks = 0; ks < 4; ++ks) p = __builtin_amdgcn_mfma_f32_32x32x16_bf16(kf[ks], qf[ks], p, 0, 0, 0);
#pragma unroll
        for (int it = 0; it < 4; ++it) *(LAS v4u*)(vw + (it >> 1) * 1024 + (it & 1) * 512) = vs[kb % 2][it];
#pragma unroll
        for (int v = 0; v < 16; ++v) { p[v] = __builtin_amdgcn_exp2f(p[v]); lsum += p[v]; }
        v4u pw0, pw1;
        pw0.x = pk2(p[0], p[1]); pw0.y = pk2(p[2], p[3]); pw0.z = pk2(p[4], p[5]); pw0.w = pk2(p[6], p[7]);
        pw1.x = pk2(p[8], p[9]); pw1.y = pk2(p[10], p[11]); pw1.z = pk2(p[12], p[13]); pw1.w = pk2(p[14], p[15]);
        asm volatile("s_waitcnt lgkmcnt(0)" ::: "memory");
#pragma unroll
        for (int sdh = 0; sdh < 4; ++sdh) {
            const int dh = sdh >> 1, ss = sdh & 1;
            const s16x4 lo = vtr(vb + dh * 2048 + ss * 1024), hi = vtr(vb + dh * 2048 + ss * 1024 + 512);
            const bf16x8 vf = {lo[0], lo[1], lo[2], lo[3], hi[0], hi[1], hi[2], hi[3]};
            const bf16x8 pa = __builtin_bit_cast(bf16x8, ss == 0 ? pw0 : pw1);
            if (dh == 0) o0 = __builtin_amdgcn_mfma_f32_32x32x16_bf16(pa, vf, o0, 0, 0, 0);
            else o1 = __builtin_amdgcn_mfma_f32_32x32x16_bf16(pa, vf, o1, 0, 0, 0);
        }
        asm volatile("s_waitcnt lgkmcnt(0)" ::: "memory");
        __builtin_amdgcn_sched_barrier(0);
    }
#undef AT_LOADK
#undef AT_LOADV
    lsum += __shfl_xor(lsum, 32);
    if (lane < nq) { LAS float* lp = Lacc + tl0 + tls * lane; *lp = first ? lsum : *lp + lsum; }
#pragma unroll
    for (int v = 0; v < 16; ++v) {
        const int iq = (v & 3) + 8 * (v >> 2) + 4 * hh;
        if (v < 8 || nq == 32) { LAS float* op = Oacc + (tl0 + tls * iq) * 64 + r;
            if (first) { op[0] = o0[v]; op[32] = o1[v]; } else { const float x0 = op[0], x1 = op[32]; op[0] = x0 + o0[v]; op[32] = x1 + o1[v]; } }
    }
}
__device__ __forceinline__ void attn_phase(const Ctx& C, const Args& a) {
    const bf16* Q = (const bf16*)(a.ws + WS_PROJ + 16 * MiB);
    const bf16* K = (const bf16*)(a.ws + WS_PROJ + 32 * MiB);
    const bf16* V = (const bf16*)(a.ws + WS_PROJ + 48 * MiB);
    bf16* MIXED = (bf16*)(a.ws + WS_MIXED);
    LAS float* Oacc = (LAS float*)(C.lds + AT_O); LAS float* Lacc = (LAS float*)(C.lds + AT_L); LAS char* vst = (LAS char*)(C.lds + AT_V + C.wave * 8192);
    float mq = fabsf(a.in[7][C.lane]), mk = fabsf(a.in[8][C.lane]);
#pragma unroll
    for (int o = 1; o < 64; o <<= 1) { mq = fmaxf(mq, __shfl_xor(mq, o)); mk = fmaxf(mk, __shfl_xor(mk, o)); }
    const float bound2 = 64.f * pg8::QSCALE * mq * mk * 1.01f;
    for (int item = C.vcu; item < NB * NH * 16; item += C.G) {
        const int span = item & 15, h = (item >> 4) & 7, b = item >> 7, t0 = span * 256, w = C.wave;
        const size_t hb = (size_t)(b * NH + h) * S * 64;
        const bf16 *Qh = Q + hb, *Kh = K + hb, *Vh = V + hb;
        const float slope2 = exp2f(-(float)(h + 1)) * 1.4426950408889634f;
#pragma unroll 1
        for (int un = 0; un < 4; ++un) {
            const int d = un == 0 ? 1 : (un == 1 ? 4 : 16);
            const int tl0 = un == 0 ? 32 * w : (un == 1 ? (w >> 1) + 128 * (w & 1) : 2 * w + (un - 2));
            attn_unit(C, Qh, Kh, Vh, d, t0 + tl0, un < 2 ? 32 : 16, tl0, d, slope2 * (float)d, bound2, Oacc, Lacc, vst, un == 0);
            if (un < 2) __syncthreads();
        }
        __syncthreads();
        {
            const int q = C.tid >> 1, hf = C.tid & 1;
            const float inv = 1.f / Lacc[q];
            const LAS f32x4* op = (const LAS f32x4*)(Oacc + q * 64 + 32 * hf);
            bf16* dst = MIXED + (size_t)(b * S + t0 + q) * D + 512 + h * 64 + 32 * hf;
#pragma unroll
            for (int j = 0; j < 4; ++j) { const f32x4 x0 = op[2 * j] * inv, x1 = op[2 * j + 1] * inv; v4u o; o.x = pk2(x0[0], x0[1]); o.y = pk2(x0[2], x0[3]); o.z = pk2(x1[0], x1[1]); o.w = pk2(x1[2], x1[3]); *(v4u*)(dst + 8 * j) = o; }
        }
        __syncthreads();
    }
}

__device__ __forceinline__ void p_router(const Ctx& C, const Args& a, int layer) {
    const float* X = layer == 0 ? a.out : (const float*)(a.ws + WS_XB); const float* g = a.in[20] + (size_t)layer * D;
    const float* wr = a.in[21] + (size_t)layer * D * NE; const float* br = a.in[22] + layer * NE;
    bf16* XN = (bf16*)(a.ws + WS_XN); float* AFF = (float*)(a.ws + WS_AFF);
    LAS float* wl = (LAS float*)C.lds;
    for (int i = C.tid; i < D * 4; i += NTHR) { const int k = i >> 2, qd = i & 3; const f32x4 v = *(const f32x4*)(wr + (size_t)k * NE + 4 * qd);
        const int slot = ((k >> 8) * 4 + (k & 3)) * 64 + ((k >> 2) & 63); *(LAS f32x4*)(wl + slot * 20 + 4 * qd) = v; }
    __syncthreads();
    const int gw = C.vcu * NWAVES + C.wave, NGW = C.G * NWAVES;
    for (int m = gw; m < T; m += NGW) {
        const f32x4* xr = (const f32x4*)(X + (size_t)m * D) + C.lane;
        f32x4 v[4]; float s = 0.f;
#pragma unroll
        for (int j = 0; j < 4; ++j) { v[j] = xr[64 * j]; s += (v[j][0] * v[j][0] + v[j][1] * v[j][1]) + (v[j][2] * v[j][2] + v[j][3] * v[j][3]); }
        const float r = rsqrtf(wave_sum(s) * (1.f / D) + EPS);
        float acc[NE];
#pragma unroll
        for (int e = 0; e < NE; ++e) acc[e] = 0.f;
#pragma unroll
        for (int j = 0; j < 4; ++j) {
            const f32x4 w = ((const f32x4*)g)[C.lane + 64 * j];
            const f32x4 hv = v[j] * w * r;
            v2u o; o.x = pk2(hv[0], hv[1]); o.y = pk2(hv[2], hv[3]); ((v2u*)(XN + (size_t)m * D))[C.lane + 64 * j] = o;
#pragma unroll
            for (int i = 0; i < 4; ++i) {
                const LAS float* wp = wl + ((j * 4 + i) * 64 + C.lane) * 20;
#pragma unroll
                for (int qd = 0; qd < 4; ++qd) { const f32x4 ww = *(const LAS f32x4*)(wp + 4 * qd); acc[4 * qd] += hv[i] * ww[0]; acc[4 * qd + 1] += hv[i] * ww[1]; acc[4 * qd + 2] += hv[i] * ww[2]; acc[4 * qd + 3] += hv[i] * ww[3]; }
                if (i & 1) asm volatile("" ::: "memory");
            }
        }
        float mx = -1e30f;
#pragma unroll
        for (int e = 0; e < NE; ++e) { acc[e] = wave_sum(acc[e]) + br[e]; mx = fmaxf(mx, acc[e]); }
        float sum = 0.f;
#pragma unroll
        for (int e = 0; e < NE; ++e) { acc[e] = __expf(acc[e] - mx); sum += acc[e]; }
        float mine = 0.f;
#pragma unroll
        for (int e = 0; e < NE; ++e) if (C.lane == e) mine = acc[e];
        const int b = m / S, ss = m % S;
        if (C.lane < NE) AFF[((size_t)b * NE + C.lane) * S + ss] = mine / sum;
    }
    __syncthreads();
}

__device__ __forceinline__ int popc64(unsigned long long m) { return __builtin_popcountll(m); }
__device__ __forceinline__ void p_topk(const Ctx& C, const Args& a) {
    const float* AFF = (const float*)(a.ws + WS_AFF);
    int* IDX = (int*)(a.ws + WS_IDX); float* GATE = (float*)(a.ws + WS_GATE); int* SLOT = (int*)(a.ws + WS_SLOT);
    const int lane = C.lane, w = C.wave;
    for (int item = C.vcu; item < NB * NE * 4; item += C.G) {
        const int be = item >> 2, qt = item & 3, b = be / NE, e = be % NE;
        unsigned key[16][4];
#pragma unroll
        for (int j = 0; j < 16; ++j) { const v4u k = *(const v4u*)(AFF + (size_t)be * S + 256 * j + 4 * lane); key[j][0] = k.x; key[j][1] = k.y; key[j][2] = k.z; key[j][3] = k.w; }
        unsigned cur = 0u;
        LAS unsigned* curw = (LAS unsigned*)C.lds;
        if (w == 0) {
#pragma unroll 1
        for (int bit = 30; bit >= 0; --bit) {
            const unsigned cand = cur | (1u << bit);
            unsigned c4[4] = {0u, 0u, 0u, 0u};
#pragma unroll
            for (int j = 0; j < 16; ++j)
#pragma unroll
                for (int i = 0; i < 4; ++i) c4[i] += (key[j][i] >= cand) ? 1u : 0u;
            const unsigned c = (c4[0] + c4[1]) + (c4[2] + c4[3]);
            int cnt = 0;
#pragma unroll
            for (int k = 0; k < 7; ++k) cnt += popc64(__ballot((c >> k) & 1u)) << k;
            if (cnt >= CAP) cur = cand;
        }
        if (lane == 0) curw[0] = cur;
        }
        __syncthreads();
        cur = curw[0];
        __syncthreads();
        const int jj = 4 * qt + (w >> 1);
        unsigned cga = 0, pre = 0; unsigned kk[4] = {0u, 0u, 0u, 0u};
#pragma unroll
        for (int j = 0; j < 16; ++j) {
            unsigned cg = 0, ce = 0;
#pragma unroll
            for (int i = 0; i < 4; ++i) { cg += (key[j][i] > cur) ? 1u : 0u; ce += (key[j][i] == cur) ? 1u : 0u; }
            cga += cg;
            if (j < jj) pre += cg | (ce << 8);
            if (j == jj) { kk[0] = key[j][0]; kk[1] = key[j][1]; kk[2] = key[j][2]; kk[3] = key[j][3]; }
        }
        int ngt = 0, gpre = 0, epre = 0;
#pragma unroll
        for (int k = 0; k < 7; ++k) { ngt += popc64(__ballot((cga >> k) & 1u)) << k; gpre += popc64(__ballot((pre >> k) & 1u)) << k; epre += popc64(__ballot((pre >> (8 + k)) & 1u)) << k; }
        const int need = CAP - ngt;
        unsigned pk = 0;
#pragma unroll
        for (int i = 0; i < 4; ++i) pk += (kk[i] > cur ? 1u : 0u) + (kk[i] == cur ? 0x10000u : 0u);
        unsigned inc = pk;
#pragma unroll
        for (int o = 1; o < 64; o <<= 1) { const unsigned t = __shfl_up(inc, o); if (lane >= o) inc += t; }
        const unsigned exc = inc - pk;
        int gtb = gpre + (int)(exc & 0xffffu), eqb = epre + (int)(exc >> 16);
        if ((lane >> 5) == (w & 1)) {
#pragma unroll
            for (int i = 0; i < 4; ++i) {
                const bool gt = kk[i] > cur, eq = kk[i] == cur;
                const bool sel = gt || (eq && eqb < need);
                const int pos = gtb + (eqb < need ? eqb : need);
                const int tok = 256 * jj + 4 * lane + i;
                SLOT[((size_t)(b * S + tok)) * NE + e] = sel ? pos : -1;
                if (sel) { IDX[be * CAP + pos] = b * S + tok; GATE[be * CAP + pos] = __uint_as_float(kk[i]); }
                gtb += gt ? 1 : 0; eqb += eq ? 1 : 0;
            }
        }
    }
}

__device__ __forceinline__ void p_combine(const Ctx& C, const Args& a, bool with_norm) {
    const float* Xin = with_norm ? a.out : (const float*)(a.ws + WS_XB); float* Xout = with_norm ? (float*)(a.ws + WS_XB) : a.out;
    const bf16* Y = (const bf16*)(a.ws + WS_PROJ); const int* SLOT = (const int*)(a.ws + WS_SLOT);
    bf16* UC = (bf16*)(a.ws + WS_H); const float* g = a.in[10];
    const int gw = C.vcu * NWAVES + C.wave, NGW = C.G * NWAVES;
    for (int m = gw; m < T; m += NGW) {
        const int b = m / S;
        const f32x4* xr = (const f32x4*)(Xin + (size_t)m * D) + 4 * C.lane; f32x4* xo = (f32x4*)(Xout + (size_t)m * D) + 4 * C.lane;
        f32x4 v[4];
#pragma unroll
        for (int j = 0; j < 4; ++j) v[j] = xr[j];
        const int myslot = (C.lane < NE) ? SLOT[(size_t)m * NE + C.lane] : -1;
        for (int e = 0; e < NE; ++e) {
            const int sl = __shfl(myslot, e);
            if (sl >= 0) {
                const v2u* yr = (const v2u*)(Y + ((size_t)(b * NE + e) * CAP + sl) * D) + 4 * C.lane;
#pragma unroll
                for (int j = 0; j < 4; ++j) { const v2u y = yr[j]; v[j][0] += bflo(y.x); v[j][1] += bfhi(y.x); v[j][2] += bflo(y.y); v[j][3] += bfhi(y.y); }
            }
        }
#pragma unroll
        for (int j = 0; j < 4; ++j) xo[j] = v[j];
        if (with_norm) {
            float s = 0.f;
#pragma unroll
            for (int j = 0; j < 4; ++j) s += (v[j][0] * v[j][0] + v[j][1] * v[j][1]) + (v[j][2] * v[j][2] + v[j][3] * v[j][3]);
            const float r = rsqrtf(wave_sum(s) * (1.f / D) + EPS);
            unsigned w[8];
#pragma unroll
            for (int j = 0; j < 4; ++j) { const f32x4 gg = ((const f32x4*)g)[4 * C.lane + j]; w[2 * j] = pk2(v[j][0] * r * gg[0], v[j][1] * r * gg[1]); w[2 * j + 1] = pk2(v[j][2] * r * gg[2], v[j][3] * r * gg[3]); }
            bf16* up = UC + ((size_t)(C.lane * 1024 + (m >> 4)) * 512 + (m & 15) * 16);
            *(v4u*)up = (v4u){w[0], w[1], w[2], w[3]}; *(v4u*)(up + 8) = (v4u){w[4], w[5], w[6], w[7]};
        }
    }
}

constexpr size_t WS_UC = WS_H;
constexpr size_t WS_E = WS_PROJ;
constexpr size_t WS_TM = 468 * MiB;
constexpr size_t WS_W16 = 484 * MiB;
__device__ __forceinline__ void s5_lambda(const Args& a, int pg, int p, float& lbr, float& lbi, float& fr, float& fi) {
    const float lr = a.in[11][pg * SP + p], li = a.in[12][pg * SP + p], dt = expf(a.in[13][pg]);
    const float mag = expf(lr * dt), ang = li * dt;
    lbr = mag * cosf(ang); lbi = mag * sinf(ang);
    const float den = lr * lr + li * li, nr = lbr - 1.f;
    fr = (nr * lr + lbi * li) / den; fi = (lbi * lr - nr * li) / den;
}
__device__ __forceinline__ void p_s5_pre(const Ctx& C, const Args& a, int g) {
    LAS float* lam = (LAS float*)C.lds; LAS float* bb = lam + 2 * 64 * 17 * 2; LAS float* cc = bb + 2 * 64 * 16 * 2; LAS float* Kt = cc + 2 * 16 * 64 * 2;
    bf16* TM = (bf16*)(a.ws + WS_TM) + (size_t)g * 256 * 512; bf16* W16 = (bf16*)(a.ws + WS_W16) + (size_t)g * 256 * 256;
    const int tid = C.tid;
    if (tid < 128) {
        const int dir = tid >> 6, p = tid & 63, pg = dir * SG + g;
        float lbr, lbi, fr, fi; s5_lambda(a, pg, p, lbr, lbi, fr, fi);
        float pr = 1.f, pi = 0.f;
        for (int k = 0; k <= 16; ++k) { lam[((dir * 64 + p) * 17 + k) * 2] = pr; lam[((dir * 64 + p) * 17 + k) * 2 + 1] = pi; const float nr = pr * lbr - pi * lbi, ni = pr * lbi + pi * lbr; pr = nr; pi = ni; }
        for (int c = 0; c < 16; ++c) { const float br = a.in[14][((size_t)pg * SP + p) * SC + c], bi = a.in[15][((size_t)pg * SP + p) * SC + c];
            bb[((dir * 64 + p) * 16 + c) * 2] = fr * br - fi * bi; bb[((dir * 64 + p) * 16 + c) * 2 + 1] = fr * bi + fi * br; }
    }
    for (int i = tid; i < 2048; i += NTHR) { const int dir = i >> 10, r = i & 1023;
        cc[i * 2] = a.in[16][(size_t)(dir * SG + g) * 1024 + r]; cc[i * 2 + 1] = a.in[17][(size_t)(dir * SG + g) * 1024 + r]; }
    __syncthreads();
    for (int id = tid; id < 8192; id += NTHR) {
        const int dir = id >> 12, k = (id >> 8) & 15, cp = (id >> 4) & 15, c = id & 15; float acc = 0.f;
        for (int p = 0; p < 64; ++p) {
            const float cr = cc[((dir * 16 + cp) * 64 + p) * 2], ci = cc[((dir * 16 + cp) * 64 + p) * 2 + 1];
            const float lr = lam[((dir * 64 + p) * 17 + k) * 2], li = lam[((dir * 64 + p) * 17 + k) * 2 + 1];
            const float xr = cr * lr - ci * li, xi = cr * li + ci * lr;
            acc += xr * bb[((dir * 64 + p) * 16 + c) * 2] - xi * bb[((dir * 64 + p) * 16 + c) * 2 + 1];
        }
        Kt[id] = acc;
    }
    __syncthreads();
    const float* dsk = a.in[18] + g * 16;
    for (int e8 = tid; e8 < 256 * 64; e8 += NTHR) {
        const int n = e8 >> 6, ch = e8 & 63, t = n >> 4, cp = n & 15; float v[8];
        if (ch < 32) {
            const int s_ = ch >> 1, c0 = (ch & 1) * 8;
#pragma unroll
            for (int i = 0; i < 8; ++i) { const int c = c0 + i; float x = 0.f;
                if (s_ <= t) x += Kt[((0 * 16 + (t - s_)) * 16 + cp) * 16 + c];
                if (s_ >= t) x += Kt[((1 * 16 + (s_ - t)) * 16 + cp) * 16 + c];
                if (s_ == t && c == cp) x += dsk[cp];
                v[i] = x; }
        } else {
            const int dir = (ch - 32) >> 4, p0 = ((ch - 32) & 15) * 4, e = dir ? 16 - t : t + 1;
#pragma unroll
            for (int i = 0; i < 4; ++i) { const int p = p0 + i;
                const float cr = cc[((dir * 16 + cp) * 64 + p) * 2], ci = cc[((dir * 16 + cp) * 64 + p) * 2 + 1];
                const float lr = lam[((dir * 64 + p) * 17 + e) * 2], li = lam[((dir * 64 + p) * 17 + e) * 2 + 1];
                v[2 * i] = cr * lr - ci * li; v[2 * i + 1] = -(cr * li + ci * lr); }
        }
        v4u o; o.x = pk2(v[0], v[1]); o.y = pk2(v[2], v[3]); o.z = pk2(v[4], v[5]); o.w = pk2(v[6], v[7]);
        *(v4u*)(TM + (size_t)n * 512 + 8 * ch) = o;
    }
    for (int e8 = tid; e8 < 256 * 32; e8 += NTHR) {
        const int n = e8 >> 5, ch = e8 & 31, dir = n >> 7, p = (n & 127) >> 1, part = n & 1, s_ = ch >> 1, c0 = (ch & 1) * 8, e = dir ? s_ : 15 - s_;
        const float lr = lam[((dir * 64 + p) * 17 + e) * 2], li = lam[((dir * 64 + p) * 17 + e) * 2 + 1]; float v[8];
#pragma unroll
        for (int i = 0; i < 8; ++i) { const float br = bb[((dir * 64 + p) * 16 + c0 + i) * 2], bi = bb[((dir * 64 + p) * 16 + c0 + i) * 2 + 1];
            v[i] = part ? (lr * bi + li * br) : (lr * br - li * bi); }
        v4u o; o.x = pk2(v[0], v[1]); o.y = pk2(v[2], v[3]); o.z = pk2(v[4], v[5]); o.w = pk2(v[6], v[7]);
        *(v4u*)(W16 + (size_t)n * 256 + 8 * ch) = o;
    }
    __syncthreads();
}
struct S5Order {
    int G, c;
    __device__ void init(int G_, int c_) { G = G_; c = c_; }
    __device__ bool next(int i, pg8::Unit& u) const {
        const long L = (long)i * G + c; if (L >= 256) return false;
        int V = (int)L; if (G == 256) V = (c & 7) * 32 + (c >> 3);
        u.pm = V; u.pn = 0; u.pb = V >> 2; return true;
    }
    __device__ __forceinline__ void a_ready(const pg8::Unit&) const {}
    __device__ __forceinline__ void done(const pg8::Unit&) const {}
};
struct EpiS5Scan {
    static constexpr bool PERM = true, AFTER_DRAIN = true;
    bf16* UC; const float *lam_re, *lam_im, *log_dt;
    static constexpr int PITCH = 528;
    __device__ __forceinline__ void fused(const pg8::f32x4 (&acc)[2][2][4][2], const pg8::Unit& u, int wr, int wc, int fr, int fq, LAS unsigned char* lds, int wid, int lane) const {
        const int tid = wid * 64 + lane;
#pragma unroll
        for (int ai = 0; ai < 2; ++ai)
#pragma unroll
            for (int m = 0; m < 4; ++m)
#pragma unroll
                for (int bj = 0; bj < 2; ++bj) { const pg8::f32x4 x = acc[ai][bj][m][0], y = acc[ai][bj][m][1];
                    v4u w; w.x = pk2(x[0], x[1]); w.y = pk2(x[2], x[3]); w.z = pk2(y[0], y[1]); w.w = pk2(y[2], y[3]);
                    *(LAS v4u*)(lds + (ai * 128 + wr * 64 + m * 16 + fr) * PITCH + (bj * 128 + wc * 32 + 8 * fq) * 2) = w; }
        __syncthreads();
        const int g = u.pm >> 2;
        if (tid < 128) {
            const int dir = tid >> 6, p = tid & 63, pg = dir * SG + g;
            const float lr = lam_re[pg * SP + p], li = lam_im[pg * SP + p], dt = expf(log_dt[pg]);
            const float mag = expf(lr * dt), ang = li * dt;
            float pr = mag * cosf(ang), pi = mag * sinf(ang);
#pragma unroll
            for (int i = 0; i < 4; ++i) { const float nr = pr * pr - pi * pi, ni = 2.f * pr * pi; pr = nr; pi = ni; }
            LAS unsigned char* col = lds + (dir * 128 + 2 * p) * 2;
            float hr = 0.f, hi = 0.f;
#pragma unroll 8
            for (int j = 0; j < 256; ++j) {
                LAS unsigned* cell = (LAS unsigned*)(col + (dir ? 255 - j : j) * PITCH);
                const unsigned e = *cell; *cell = pk2(hr, hi);
                const float er = bflo(e), ei = bfhi(e); const float nr = pr * hr - pi * hi + er, ni = pr * hi + pi * hr + ei; hr = nr; hi = ni;
            }
        }
        __syncthreads();
        bf16* dst = UC + (size_t)u.pm * 256 * 512 + 256;
#pragma unroll
        for (int i = 0; i < 16; ++i) { const int idx = tid + 512 * i, row = idx >> 5, ch = idx & 31;
            *(v4u*)(dst + (size_t)row * 512 + 8 * ch) = *(const LAS v4u*)(lds + row * PITCH + 16 * ch); }
        __syncthreads();
    }
};
__device__ __forceinline__ float gelu_t(float y) { const float u = 0.7978845608028654f * (y + 0.044715f * y * y * y); const float e = __builtin_amdgcn_exp2f(2.885390081777927f * u); const float th = 1.f - 2.f * __builtin_amdgcn_rcpf(e + 1.f); return 0.5f * y * (1.f + th); }
struct EpiS5Z {
    static constexpr bool PERM = true, AFTER_DRAIN = false;
    bf16* Z;
    __device__ __forceinline__ void operator()(const pg8::f32x4 (&acc)[2][2][4][2], const pg8::Unit& u, int wr, int wc, int fr, int fq) const {
        const int row0 = u.pm * 256 + wr * 64 + fr;
#pragma unroll
        for (int ai = 0; ai < 2; ++ai)
#pragma unroll
            for (int m = 0; m < 4; ++m) { const int row = row0 + ai * 128 + m * 16, g = row >> 10, J = row & 1023;
#pragma unroll
                for (int bj = 0; bj < 2; ++bj) { const int t = 8 * bj + 2 * wc + (fq >> 1), c0 = 8 * (fq & 1);
                    const pg8::f32x4 x = acc[ai][bj][m][0], y = acc[ai][bj][m][1];
                    v4u w; w.x = pk2(gelu_t(x[0]), gelu_t(x[1])); w.y = pk2(gelu_t(x[2]), gelu_t(x[3])); w.z = pk2(gelu_t(y[0]), gelu_t(y[1])); w.w = pk2(gelu_t(y[2]), gelu_t(y[3]));
                    *(v4u*)(Z + (size_t)(16 * J + t) * D + g * 16 + c0) = w; } }
    }
};
constexpr int NPHASE = 18;
__global__ void __launch_bounds__(NTHR, 2) mk_fwd(Args args) {
    extern __shared__ __attribute__((aligned(16))) unsigned char lds_raw[];
    Ctx C;
    C.lds = (LAS unsigned char*)lds_raw;
    C.tid = threadIdx.x; C.lane = C.tid & 63; C.wave = __builtin_amdgcn_readfirstlane(C.tid >> 6);
    C.G = gridDim.x; { const int bx = blockIdx.x; C.vcu = (C.G % 8 == 0) ? (bx % 8) * (C.G / 8) + bx / 8 : bx; }
    volatile LAS unsigned* MISC = (volatile LAS unsigned*)(C.lds + LDSCTL_OFF);
    for (int u = C.tid; u < (LDS_BYTES - LDSCTL_OFF) / 4; u += NTHR) ((LAS unsigned*)(C.lds + LDSCTL_OFF))[u] = 0u;
    __syncthreads();
    int lo = args.ph_lo, hi = args.ph_hi;
    unsigned char* ws = args.ws;
    asm volatile("" : "+s"(lo), "+s"(hi), "+s"(ws));
    unsigned* ctl = (unsigned*)(ws + WS_CTL);
    const bool one_launch = (lo == 0 && hi == NPHASE);
    XcdBarrier bar; bar.bar = ctl + CW_BAR; bar.x = 0; bar.st = nullptr;
    if (one_launch) bar = xcd_barrier_post(ctl + CW_BAR, MISC + 8);
    LAS unsigned char* glds = C.lds;
#ifndef MK_ONLY
#define MK_ONLY -1
#endif
#define IN(k) ((MK_ONLY < 0 || MK_ONLY == (k) || (MK_ONLY == 4 && (k) == 13) || (MK_ONLY == 5 && (k) == 14) || (MK_ONLY == 6 && (k) == 15) || (MK_ONLY == 7 && (k) == 16) || (MK_ONLY == 8 && (k) == 17)) && lo <= (k) && (k) < hi)
#ifndef MK_S5DUP
#define MK_S5DUP 0
#endif
#ifndef MK_DUP
#define MK_DUP 0
#endif
#define DUPBIT(k) ((MK_DUP >> ((k) < 13 ? (k) : (k) - 9)) & 1)
#define DUPX(k, ...) do { __VA_ARGS__ if (DUPBIT(k)) { __VA_ARGS__ } } while (0)
#define SEAM(k) do { if (IN(k) && IN((k) + 1)) xcd_barrier(bar); } while (0)

#ifdef MK_XBAR
    if (one_launch) for (int xb_ = 0; xb_ < MK_XBAR; ++xb_) xcd_barrier(bar);
#endif
    if (IN(0)) { DUPX(0, p0_prologue(C, args);); } SEAM(0);
    if (IN(1)) {
        const int G1 = (C.G == 256) ? 214 : C.G;
        if ((int)blockIdx.x < G1) {
            pg8::Gemm g{(const bf16*)(ws + WS_XN), (const bf16*)(ws + WS_WIN), D, nullptr, D, D}; pg8::DenseOrder So; So.init(T, INC, G1, (int)blockIdx.x);
            pg8::EpiProj E{(bf16*)(ws + WS_PROJ), (bf16*)(ws + WS_PROJ + 16 * MiB), args.in[7], args.in[8]};
            pg8::gemm_phase<pg8::EpiProj, pg8::DenseOrder, true, true>(glds, g, So, E);
            if (C.tid == 0) __hip_atomic_fetch_add((unsigned*)(ws + WS_CTL) + CW_P1DONE, 1u, __ATOMIC_RELAXED, __HIP_MEMORY_SCOPE_AGENT);
        } else conv_drain(C, args, true);
    } SEAM(1);
    if (IN(2)) {
 DUPX(2, {        for (int gq = C.vcu; gq < SG; gq += C.G) p_s5_pre(C, args, gq);
        conv_drain(C, args, false);
        for (int t = C.vcu; t < T / 32; t += C.G) conv_tile(C, args, t);
#ifdef MK_DUPCONV
        for (int t = C.vcu; t < T / 32; t += C.G) conv_tile(C, args, t);
#endif
        attn_phase(C, args);
    }); } SEAM(2);
    if (IN(3)) {
 DUPX(3, {        pg8::Gemm g{(const bf16*)(ws + WS_MIXED), (const bf16*)(ws + WS_WOUT), D, nullptr, D, D}; pg8::DenseOrder So; So.init(T, D, C.G, (int)blockIdx.x);
        pg8::EpiRes E{args.in[0], args.out};
        pg8::gemm_phase<pg8::EpiRes, pg8::DenseOrder, true, true>(glds, g, So, E);
    }); } SEAM(3);
#define MOE_PHASES(layer, pb) do { \
        if (IN(pb)) { DUPX(pb, p_router(C, args, layer);); } SEAM(pb); \
        if (IN(pb + 1)) { DUPX(pb + 1, p_topk(C, args);); } SEAM(pb + 1); \
        if (IN(pb + 2)) { DUPX(pb + 2, { \
            pg8::Gemm g{(const bf16*)(ws + WS_XN), (const bf16*)(ws + WS_WEXP + layer * WEXP_LAYER + WEXP_GU), D, (const int*)(ws + WS_IDX), D, D}; pg8::ExpertOrder So; So.init(8, C.G, (int)blockIdx.x); \
            pg8::EpiSwiGLU E{(bf16*)(ws + WS_H)}; \
            pg8::gemm_phase<pg8::EpiSwiGLU, pg8::ExpertOrder, true, true, true>(glds, g, So, E); \
        }); } SEAM(pb + 2); \
        if (IN(pb + 3)) { DUPX(pb + 3, { \
            pg8::Gemm g{(const bf16*)(ws + WS_H), (const bf16*)(ws + WS_WEXP + layer * WEXP_LAYER + WEXP_DN), EH, nullptr, EH, EH}; pg8::ExpertOrder So; So.init(4, C.G, (int)blockIdx.x); \
            pg8::EpiDown E{(bf16*)(ws + WS_PROJ), (const float*)(ws + WS_GATE)}; \
            pg8::gemm_phase<pg8::EpiDown, pg8::ExpertOrder, true, true>(glds, g, So, E); \
        }); } SEAM(pb + 3); \
        if (IN(pb + 4)) { DUPX(pb + 4, p_combine(C, args, layer == 0);); } \
    } while (0)
    MOE_PHASES(0, 4);
    SEAM(8);
    if (IN(9)) {
        int k9 = 256; asm volatile("" : "+s"(k9));
        pg8::Gemm g{(const bf16*)(ws + WS_UC), (const bf16*)(ws + WS_W16), k9, nullptr, 512, 256}; S5Order So; So.init(C.G, (int)blockIdx.x);
        EpiS5Scan E{(bf16*)(ws + WS_UC), args.in[11], args.in[12], args.in[13]};
        pg8::gemm_phase<EpiS5Scan, S5Order, false, true>(glds, g, So, E);
    }
    asm volatile("s_waitcnt vmcnt(0)" ::: "memory"); __syncthreads();
    if (IN(11)) {
        int k11 = 512; asm volatile("" : "+s"(k11));
        pg8::Gemm g{(const bf16*)(ws + WS_UC), (const bf16*)(ws + WS_TM), k11, nullptr, 512, 512}; S5Order So; So.init(C.G, (int)blockIdx.x);
        EpiS5Z E{(bf16*)(ws + WS_MIXED)};
        pg8::gemm_phase<EpiS5Z, S5Order, true, true>(glds, g, So, E);
#if MK_S5DUP == 11
        pg8::gemm_phase<EpiS5Z, S5Order, true, true>(glds, g, So, E);
#endif
    } SEAM(11);
    if (IN(12)) {
        pg8::Gemm g{(const bf16*)(ws + WS_MIXED), (const bf16*)(ws + WS_WGLU), D, nullptr, D, D}; pg8::DenseOrder So; So.init(T, 2 * D, C.G, (int)blockIdx.x);
        pg8::EpiGluRes E{(float*)(ws + WS_XB)};
        pg8::gemm_phase<pg8::EpiGluRes, pg8::DenseOrder, true, true>(glds, g, So, E);
    } SEAM(12);
    MOE_PHASES(1, 13);
#undef IN
#undef SEAM
}

#ifndef MK_PER_PHASE
#define MK_PER_PHASE 0
#endif
extern "C" void kernel_launch(void* const* d_in, const int* in_sizes, int n_in, void* d_out, int out_size, void* d_ws, size_t ws_size, hipStream_t stream) {
    static int grid = 0;
    if (grid == 0) {
        if (n_in != 26 || out_size != T * D || ws_size < WS_END) { fprintf(stderr, "kernel_launch: unexpected shapes (n_in %d out %d ws %zu)\n", n_in, out_size, ws_size); grid = -1; return; }
        int dev = 0, cus = 0, per_cu = 0;
        if (hipGetDevice(&dev) != hipSuccess || hipDeviceGetAttribute(&cus, hipDeviceAttributeMultiprocessorCount, dev) != hipSuccess) { grid = -1; return; }
        if (hipFuncSetAttribute((const void*)mk_fwd, hipFuncAttributeMaxDynamicSharedMemorySize, LDS_BYTES) != hipSuccess) { fprintf(stderr, "kernel_launch: hipFuncSetAttribute failed\n"); grid = -1; return; }
        if (hipOccupancyMaxActiveBlocksPerMultiprocessor(&per_cu, (const void*)mk_fwd, NTHR, LDS_BYTES) != hipSuccess || per_cu < 1) { fprintf(stderr, "kernel_launch: occupancy query says %d blocks per CU\n", per_cu); (void)hipGetLastError(); grid = -1; return; }
        grid = cus;
    }
    if (grid < 0) return;
    (void)hipMemsetAsync((char*)d_ws + WS_CTL, 0, CTL_ZERO_BYTES, stream);
    Args a{};
    for (int i = 0; i < 26; ++i) a.in[i] = (const float*)d_in[i];
    a.out = (float*)d_out; a.ws = (unsigned char*)d_ws;
#if MK_PER_PHASE
    for (int p = 0; p < NPHASE; ++p) { a.ph_lo = p; a.ph_hi = p + 1; hipLaunchKernelGGL(mk_fwd, dim3(grid), dim3(NTHR), LDS_BYTES, stream, a); }
#else
    a.ph_lo = 0; a.ph_hi = NPHASE;
    hipLaunchKernelGGL(mk_fwd, dim3(grid), dim3(NTHR), LDS_BYTES, stream, a);
#endif
}
```

```cpp
#include <hip/hip_runtime.h>
#include <cstdint>
#include <cstdio>

namespace pg8 {
#define PG8_LAS __attribute__((address_space(3)))
typedef unsigned short bf16_t;
typedef short bf16x8 __attribute__((ext_vector_type(8)));
typedef float f32x4 __attribute__((ext_vector_type(4)));
typedef unsigned u32x4 __attribute__((ext_vector_type(4)));
constexpr int BM = 256, BK = 64, HALF = 128, HTB = HALF * BK * 2  , STAGE_BYTES = 8 * HTB, NXCD = 8, WGM = 8;

__host__ __device__ __forceinline__ int lds_byte(int r, int c) { const int st = (r >> 4) * 2 + (c >> 5), rr = r & 15, cc = c & 31, ob = rr * 64 + cc * 2; return st * 1024 + (ob ^ (((ob >> 9) & 1) << 5)); }
__host__ __device__ __forceinline__ void stage_rc(int b, int& R, int& C) { const int st = b / 1024, sb = b % 1024, swz = sb ^ (((sb >> 9) & 1) << 5); R = (st >> 1) * 16 + swz / 64; C = (st & 1) * 32 + (swz % 64) / 2; }
__host__ __device__ __forceinline__ int perm32(int rho) { const int n = rho >> 4, i = rho & 15; return 8 * (i >> 2) + 4 * n + (i & 3); }

struct Unit { int pm, pn, pb; };
struct Gemm { const bf16_t* A; const bf16_t* Bt; int K; const int* gidx; int lda, ldb; };

struct DenseOrder {
    int nM, nN, nwg, G, c;
    __device__ void init(int M, int N, int G_, int c_) { nM = M / BM; nN = N / BM; nwg = nM * nN; G = G_; c = c_; }
    __device__ bool next(int i, Unit& u) const {
        const long L = (long)i * G + c; if (L >= nwg) return false;
        int wgid = (int)L; { const int q = nwg / NXCD, r = nwg % NXCD, xcd = wgid % NXCD, off = wgid / NXCD; wgid = (xcd < r ? xcd * (q + 1) : r * (q + 1) + (xcd - r) * q) + off; }
        const int nig = WGM * nN, gid = wgid / nig, fm = gid * WGM, gsz = (nM - fm) < WGM ? (nM - fm) : WGM;
        u.pm = fm + ((wgid % nig) % gsz); u.pn = (wgid % nig) / gsz; u.pb = u.pn; return true;
    }
    __device__ __forceinline__ void a_ready(const Unit&) const {}
    __device__ __forceinline__ void done(const Unit&) const {}
};
struct ExpertOrder {
    int nN, nun, G, c;
    __device__ void init(int nN_, int G_, int c_) { nN = nN_; nun = 128 * nN_; G = G_; c = c_; }
    __device__ bool next(int i, Unit& u) const {
        const long L = (long)i * G + c; if (L >= nun) return false;
        int V = (int)L;
        if (G == 256) {
            const int x = c & 7, j = c >> 3, upx = 32, rpe = (8 * nN) / upx;
            const int e_ = 8 * (i / rpe) + x, r_ = (i % rpe) * upx + j;
            V = e_ * 8 * nN + r_;
        }
        const int per = 8 * nN, e = V / per, r = V % per, pml = r / nN, pn = r % nN;
        u.pm = ((pml >> 1) * 16 + e) * 2 + (pml & 1); u.pn = pn; u.pb = e * nN + pn; return true;
    }
    __device__ __forceinline__ void a_ready(const Unit&) const {}
    __device__ __forceinline__ void done(const Unit&) const {}
};

typedef float f32x2 __attribute__((ext_vector_type(2)));
typedef __bf16 bf16x2_t __attribute__((ext_vector_type(2)));
__device__ __forceinline__ unsigned pk2(float lo, float hi) { f32x2 v = {lo, hi}; bf16x2_t b = __builtin_convertvector(v, bf16x2_t); return __builtin_bit_cast(unsigned, b); }
__device__ __forceinline__ float sigm(float x) { return __builtin_amdgcn_rcpf(1.f + __builtin_amdgcn_exp2f(-1.4426950408889634f * x)); }

constexpr float QSCALE = 0.125f * 1.4426950408889634f;
struct EpiProj {
    static constexpr bool PERM = true, AFTER_DRAIN = false;
    bf16_t *GLU, *Q; const float *qg, *kg;
    __device__ __forceinline__ void operator()(const f32x4 (&acc)[2][2][4][2], const Unit& u, int wr, int wc, int fr, int fq) const {
        const int row0 = u.pm * BM + wr * 64 + fr;
        if (u.pn < 4) {
            const int col0 = 128 * u.pn + 32 * wc + 8 * fq;
#pragma unroll
            for (int ai = 0; ai < 2; ++ai)
#pragma unroll
                for (int m = 0; m < 4; ++m) {
                    const f32x4 v0 = acc[ai][0][m][0], v1 = acc[ai][0][m][1], g0 = acc[ai][1][m][0], g1 = acc[ai][1][m][1];
                    u32x4 w; w.x = pk2(v0[0] * sigm(g0[0]), v0[1] * sigm(g0[1])); w.y = pk2(v0[2] * sigm(g0[2]), v0[3] * sigm(g0[3]));
                    w.z = pk2(v1[0] * sigm(g1[0]), v1[1] * sigm(g1[1])); w.w = pk2(v1[2] * sigm(g1[2]), v1[3] * sigm(g1[3]));
                    *(u32x4*)(GLU + (size_t)(row0 + ai * HALF + m * 16) * 512 + col0) = w;
                    asm volatile("" ::: "memory");
                }
        } else {
            const int t = (u.pn - 4) >> 1;
            const int hd = 4 * ((u.pn - 4) & 1) + wc;
            bf16_t* dst = Q + (size_t)t * (size_t)(8u << 20);
            const float* gp = (const float*)((uintptr_t)qg + (((uintptr_t)kg - (uintptr_t)qg) & (uintptr_t)(t == 0 ? 0 : ~(uintptr_t)0)));
#pragma unroll
            for (int ai = 0; ai < 2; ++ai)
#pragma unroll
                for (int m = 0; m < 4; ++m) {
                    float ss = 0.f;
#pragma unroll
                    for (int bj = 0; bj < 2; ++bj)
#pragma unroll
                        for (int n = 0; n < 2; ++n) { const f32x4 x = acc[ai][bj][m][n]; ss += (x[0] * x[0] + x[1] * x[1]) + (x[2] * x[2] + x[3] * x[3]); }
                    ss += __shfl_xor(ss, 16); ss += __shfl_xor(ss, 32);
                    float rs = 1.f;
                    if (t < 2) rs = rsqrtf(ss * (1.f / 64.f) + 1e-6f) * (t == 0 ? QSCALE : 1.f);
#pragma unroll
                    for (int bj = 0; bj < 2; ++bj) {
                        f32x4 g0 = {1.f, 1.f, 1.f, 1.f}, g1 = g0;
                        if (t < 2) { g0 = *(const f32x4*)(gp + 32 * bj + 8 * fq); g1 = *(const f32x4*)(gp + 32 * bj + 8 * fq + 4); }
                        const f32x4 a = acc[ai][bj][m][0] * g0 * rs, b = acc[ai][bj][m][1] * g1 * rs;
                        u32x4 w; w.x = pk2(a[0], a[1]); w.y = pk2(a[2], a[3]); w.z = pk2(b[0], b[1]); w.w = pk2(b[2], b[3]);
                        const int row = row0 + ai * HALF + m * 16;
                        *(u32x4*)(dst + ((size_t)((row >> 12) * 8 + hd) * 4096 + (row & 4095)) * 64 + 32 * bj + 8 * fq) = w;
                    }
                    asm volatile("" ::: "memory");
                }
        }
    }
};
struct EpiRes {
    static constexpr bool PERM = false, AFTER_DRAIN = false;
    const float* xin; float* X;
    __device__ __forceinline__ void operator()(const f32x4 (&acc)[2][2][4][2], const Unit& u, int wr, int wc, int fr, int fq) const {
        const int row0 = u.pm * BM + wr * 64 + fr, col0 = u.pn * BM + wc * 32 + 4 * fq;
#pragma unroll
        for (int ai = 0; ai < 2; ++ai)
#pragma unroll
            for (int m = 0; m < 4; ++m) { const size_t off = (size_t)(row0 + ai * HALF + m * 16) * 1024 + col0;
#pragma unroll
                for (int bj = 0; bj < 2; ++bj)
#pragma unroll
                    for (int n = 0; n < 2; ++n) { const f32x4 r = *(const f32x4*)(xin + off + bj * HALF + n * 16); *(f32x4*)(X + off + bj * HALF + n * 16) = r + acc[ai][bj][m][n]; } }
    }
};
struct EpiSwiGLU {
    static constexpr bool PERM = true, AFTER_DRAIN = false;
    bf16_t* H;
    __device__ __forceinline__ void operator()(const f32x4 (&acc)[2][2][4][2], const Unit& u, int wr, int wc, int fr, int fq) const {
        const int row0 = u.pm * BM + wr * 64 + fr, col0 = 128 * u.pn + 32 * wc + 8 * fq;
#pragma unroll
        for (int ai = 0; ai < 2; ++ai)
#pragma unroll
            for (int m = 0; m < 4; ++m) {
                const f32x4 g0 = acc[ai][0][m][0], g1 = acc[ai][0][m][1], u0 = acc[ai][1][m][0], u1 = acc[ai][1][m][1];
                u32x4 w; w.x = pk2(g0[0] * sigm(g0[0]) * u0[0], g0[1] * sigm(g0[1]) * u0[1]); w.y = pk2(g0[2] * sigm(g0[2]) * u0[2], g0[3] * sigm(g0[3]) * u0[3]);
                w.z = pk2(g1[0] * sigm(g1[0]) * u1[0], g1[1] * sigm(g1[1]) * u1[1]); w.w = pk2(g1[2] * sigm(g1[2]) * u1[2], g1[3] * sigm(g1[3]) * u1[3]);
                *(u32x4*)(H + (size_t)(row0 + ai * HALF + m * 16) * 1024 + col0) = w;
            }
    }
};
struct EpiDown {
    static constexpr bool PERM = true, AFTER_DRAIN = false;
    bf16_t* Y; const float* gate;
    __device__ __forceinline__ void operator()(const f32x4 (&acc)[2][2][4][2], const Unit& u, int wr, int wc, int fr, int fq) const {
        const int row0 = u.pm * BM + wr * 64 + fr, col0 = u.pn * BM + wc * 32 + 8 * fq;
#pragma unroll
        for (int ai = 0; ai < 2; ++ai)
#pragma unroll
            for (int m = 0; m < 4; ++m) { const int row = row0 + ai * HALF + m * 16; const float gs = gate[row];
#pragma unroll
                for (int bj = 0; bj < 2; ++bj) { const f32x4 a = acc[ai][bj][m][0] * gs, b = acc[ai][bj][m][1] * gs;
                    u32x4 w; w.x = pk2(a[0], a[1]); w.y = pk2(a[2], a[3]); w.z = pk2(b[0], b[1]); w.w = pk2(b[2], b[3]);
                    *(u32x4*)(Y + (size_t)row * 1024 + col0 + bj * HALF) = w; } }
    }
};
struct EpiGluRes {
    static constexpr bool PERM = false, AFTER_DRAIN = false;
    float* X;
    __device__ __forceinline__ void operator()(const f32x4 (&acc)[2][2][4][2], const Unit& u, int wr, int wc, int fr, int fq) const {
        const int row0 = u.pm * BM + wr * 64 + fr, col0 = 128 * u.pn + 32 * wc + 4 * fq;
#pragma unroll
        for (int ai = 0; ai < 2; ++ai)
#pragma unroll
            for (int m = 0; m < 4; ++m) { float* p = X + (size_t)(row0 + ai * HALF + m * 16) * 1024 + col0;
#pragma unroll
                for (int n = 0; n < 2; ++n) { const f32x4 v = acc[ai][0][m][n], g = acc[ai][1][m][n]; f32x4 r = *(const f32x4*)(p + n * 16);
                    r[0] += v[0] * sigm(g[0]); r[1] += v[1] * sigm(g[1]); r[2] += v[2] * sigm(g[2]); r[3] += v[3] * sigm(g[3]); *(f32x4*)(p + n * 16) = r; } }
    }
};

template <class Epi, class Sched, bool ALIGN_EPI = false, bool SP2 = false, bool GATHER = false>
__device__ __forceinline__ void gemm_phase(PG8_LAS unsigned char* lds, const Gemm g, const Sched& S, const Epi& E) {
    const int tid = threadIdx.x, wid = __builtin_amdgcn_readfirstlane(tid >> 6), lane = tid & 63, wr = wid >> 2, wc = wid & 3, fr = lane & 15, fq = lane >> 4;
    const int K = g.K, nt = K / BK;
    unsigned voffA[2], voffB[2];
#pragma unroll
    for (int i = 0; i < 2; ++i) { int R, C; stage_rc(tid * 16 + i * 8192, R, C); const int Rb = Epi::PERM ? ((R & ~31) + perm32(R & 31)) : R;
        voffA[i] = (unsigned)(R * g.lda + C) * 2u; voffB[i] = (unsigned)(Rb * g.ldb + C) * 2u; }
    const size_t kstep = (size_t)(BK * 2);
    const size_t hstepA = (size_t)HALF * g.lda * 2, hstepB = (size_t)HALF * g.ldb * 2;
    const size_t tstepA = 2 * hstepA, tstepB = 2 * hstepB;
    const unsigned ldsw = (unsigned)wid * 1024u;
    const int aoff = lds_byte(wr * 64 + fr, fq * 8), boff = lds_byte(wc * 32 + fr, fq * 8);
#define PG8_SA(b, h) (((b) * 2 + (h)) * HTB)
#define PG8_SB(b, h) ((4 + (b) * 2 + (h)) * HTB)
#define PG8_STAGE(bufoff, gbase, voff) do { _Pragma("unroll") for (int _i = 0; _i < 2; ++_i) \
        __builtin_amdgcn_global_load_lds((const unsigned*)((const char*)(gbase) + (voff)[_i]), (PG8_LAS unsigned*)(lds + (bufoff) + ldsw + _i * 8192), 16, 0, 0); } while (0)
#define PG8_STAGE_A(bufoff, gptr, h, nsel) do { if constexpr (GATHER) { const unsigned _o[2] = {(nsel) ? nOA[h][0] : oA[h][0], (nsel) ? nOA[h][1] : oA[h][1]}; PG8_STAGE(bufoff, gptr, _o); } \
        else { PG8_STAGE(bufoff, (gptr) + ((h) ? hstepA : 0), voffA); } } while (0)
#define PG8_GOFF(dst, u) do { if constexpr (GATHER) { _Pragma("unroll") for (int _h = 0; _h < 2; ++_h) _Pragma("unroll") for (int _i = 0; _i < 2; ++_i) { \
        (dst)[_h][_i] = (unsigned)g.gidx[(u).pm * BM + _h * HALF + gR[_i]] * (unsigned)(g.lda * 2) + gC[_i]; asm volatile("" : "+v"((dst)[_h][_i])); } } } while (0)
#define PG8_LDA(dst, b, h) do { _Pragma("unroll") for (int m = 0; m < 4; ++m) _Pragma("unroll") for (int k = 0; k < 2; ++k) dst[m][k] = *(const PG8_LAS bf16x8*)(lds + PG8_SA(b, h) + aoff + m * 2048 + k * 1024); } while (0)
#define PG8_LDB(dst, b, h) do { _Pragma("unroll") for (int n = 0; n < 2; ++n) _Pragma("unroll") for (int k = 0; k < 2; ++k) dst[n][k] = *(const PG8_LAS bf16x8*)(lds + PG8_SB(b, h) + boff + n * 2048 + k * 1024); } while (0)
#define PG8_MMA(ai, bj, At, Bt) do { __builtin_amdgcn_s_setprio(1); _Pragma("unroll") for (int m = 0; m < 4; ++m) _Pragma("unroll") for (int n = 0; n < 2; ++n) _Pragma("unroll") for (int k = 0; k < 2; ++k) \
        acc[ai][bj][m][n] = __builtin_amdgcn_mfma_f32_16x16x32_bf16(Bt[n][k], At[m][k], acc[ai][bj][m][n], 0, 0, 0); __builtin_amdgcn_s_setprio(0); } while (0)
#define PG8_WAIT_V(n) asm volatile("s_waitcnt vmcnt(" #n ")" ::: "memory")
#define PG8_WAIT_L(n) asm volatile("s_waitcnt lgkmcnt(" #n ")" ::: "memory")
#define PG8_BAR __builtin_amdgcn_s_barrier()
#define PG8_SCHED __builtin_amdgcn_sched_barrier(0)
    Unit cur, nxt; int ui = 0;
    if (!S.next(0, cur)) return;
    unsigned oA[2][2], nOA[2][2]; int gR[2]; unsigned gC[2];
    if constexpr (GATHER) { static_assert(SP2, "GATHER is wired into the SP2 loop only");
#pragma unroll
        for (int i = 0; i < 2; ++i) { int R, Cc; stage_rc(tid * 16 + i * 8192, R, Cc); gR[i] = R; gC[i] = (unsigned)Cc * 2u; } }
    PG8_GOFF(oA, cur);
    f32x4 acc[2][2][4][2];
#pragma unroll
    for (int a = 0; a < 2; ++a)
#pragma unroll
        for (int b = 0; b < 2; ++b)
#pragma unroll
            for (int m = 0; m < 4; ++m)
#pragma unroll
                for (int n = 0; n < 2; ++n) acc[a][b][m][n] = (f32x4){0.f, 0.f, 0.f, 0.f};
    bf16x8 At[4][2], B0[2][2], B1[2][2];
    const char* cA = (const char*)g.A + (GATHER ? (size_t)0 : (size_t)cur.pm * tstepA); const char* cB = (const char*)g.Bt + (size_t)cur.pb * tstepB;
    S.a_ready(cur);
    if constexpr (SP2) {
        PG8_STAGE(PG8_SB(0, 0), cB, voffB); PG8_STAGE(PG8_SB(0, 1), cB + hstepB, voffB); PG8_STAGE_A(PG8_SA(0, 0), cA, 0, false); PG8_STAGE_A(PG8_SA(0, 1), cA, 1, false);
        if (wr == 1) PG8_BAR;
        PG8_WAIT_V(2); PG8_BAR;
        PG8_STAGE(PG8_SB(1, 0), cB + kstep, voffB); PG8_STAGE_A(PG8_SA(1, 0), cA + kstep, 0, false); PG8_STAGE(PG8_SB(1, 1), cB + hstepB + kstep, voffB);
        PG8_WAIT_V(6); PG8_BAR;
    } else {
        PG8_STAGE(PG8_SB(0, 0), cB, voffB); PG8_STAGE(PG8_SA(0, 0), cA, voffA); PG8_STAGE(PG8_SB(0, 1), cB + hstepB, voffB); PG8_STAGE(PG8_SA(0, 1), cA + hstepA, voffA);
        if (wr == 1) PG8_BAR;
        PG8_WAIT_V(4); PG8_BAR;
        PG8_STAGE(PG8_SB(1, 0), cB + kstep, voffB); PG8_STAGE(PG8_SA(1, 0), cA + kstep, voffA); PG8_STAGE(PG8_SB(1, 1), cB + hstepB + kstep, voffB);
        PG8_WAIT_V(6); PG8_BAR;
    }
    for (;;) {
        const bool has_next = S.next(ui + 1, nxt);
        const char* nA = has_next ? (const char*)g.A + (GATHER ? (size_t)0 : (size_t)nxt.pm * tstepA) : cA; const char* nB = has_next ? (const char*)g.Bt + (size_t)nxt.pb * tstepB : cB;
        if constexpr (GATHER) { if (has_next) { PG8_GOFF(nOA, nxt); } else {
#pragma unroll
            for (int _h = 0; _h < 2; ++_h) { nOA[_h][0] = oA[_h][0]; nOA[_h][1] = oA[_h][1]; } } }
        for (int t = 0; t < nt; t += 2) {
            const bool last = (t == nt - 2);
            const char* a1 = cA + (size_t)(t + 1) * kstep;
            const char* a2 = last ? nA : cA + (size_t)(t + 2) * kstep; const char* b2 = last ? nB : cB + (size_t)(t + 2) * kstep;
            const char* a3 = a2 + kstep; const char* b3 = b2 + kstep;
            if (last && has_next) S.a_ready(nxt);
            if constexpr (SP2) {
            PG8_LDB(B0, 0, 0); PG8_LDB(B1, 0, 1); PG8_SCHED; PG8_LDA(At, 0, 0); PG8_STAGE_A(PG8_SA(1, 1), a1, 1, false);
            PG8_WAIT_V(8); PG8_WAIT_L(0); PG8_BAR; PG8_MMA(0, 0, At, B0); PG8_MMA(0, 1, At, B1); PG8_BAR; PG8_SCHED;
            PG8_LDA(At, 0, 1); PG8_STAGE(PG8_SB(0, 0), b2, voffB); PG8_STAGE(PG8_SB(0, 1), b2 + hstepB, voffB); PG8_STAGE_A(PG8_SA(0, 0), a2, 0, last);
            PG8_WAIT_V(8); PG8_WAIT_L(0); PG8_BAR; PG8_MMA(1, 0, At, B0); PG8_MMA(1, 1, At, B1); PG8_BAR; PG8_SCHED;
            PG8_LDB(B0, 1, 0); PG8_LDB(B1, 1, 1); PG8_SCHED; PG8_LDA(At, 1, 0); PG8_STAGE_A(PG8_SA(0, 1), a2, 1, last);
            PG8_WAIT_V(8); PG8_WAIT_L(0); PG8_BAR; PG8_MMA(0, 0, At, B0); PG8_MMA(0, 1, At, B1); PG8_BAR; PG8_SCHED;
            PG8_LDA(At, 1, 1); PG8_STAGE(PG8_SB(1, 0), b3, voffB); PG8_STAGE(PG8_SB(1, 1), b3 + hstepB, voffB); PG8_STAGE_A(PG8_SA(1, 0), a3, 0, last);
            PG8_WAIT_V(8); PG8_WAIT_L(0); PG8_BAR; PG8_MMA(1, 0, At, B0); PG8_MMA(1, 1, At, B1); PG8_BAR; PG8_SCHED;
            } else {
            PG8_LDB(B0, 0, 0); PG8_SCHED; PG8_LDA(At, 0, 0); PG8_STAGE(PG8_SA(1, 1), a1 + hstepA, voffA);
            PG8_WAIT_L(8); PG8_BAR; PG8_WAIT_L(0); PG8_MMA(0, 0, At, B0); PG8_BAR; PG8_SCHED;
            PG8_LDB(B1, 0, 1); PG8_STAGE(PG8_SB(0, 0), b2, voffB);
            PG8_BAR; PG8_WAIT_L(0); PG8_MMA(0, 1, At, B1); PG8_BAR;
            PG8_LDA(At, 0, 1); PG8_STAGE(PG8_SA(0, 0), a2, voffA);
            PG8_BAR; PG8_WAIT_L(0); PG8_MMA(1, 0, At, B0); PG8_BAR; PG8_SCHED;
            PG8_STAGE(PG8_SB(0, 1), b2 + hstepB, voffB);
            PG8_WAIT_V(6); PG8_BAR; PG8_MMA(1, 1, At, B1); PG8_BAR;
            PG8_LDB(B0, 1, 0); PG8_SCHED; PG8_LDA(At, 1, 0); PG8_STAGE(PG8_SA(0, 1), a2 + hstepA, voffA);
            PG8_WAIT_L(8); PG8_BAR; PG8_WAIT_L(0); PG8_MMA(0, 0, At, B0); PG8_BAR; PG8_SCHED;
            PG8_LDB(B1, 1, 1); PG8_STAGE(PG8_SB(1, 0), b3, voffB);
            PG8_BAR; PG8_WAIT_L(0); PG8_MMA(0, 1, At, B1); PG8_BAR;
            PG8_LDA(At, 1, 1); PG8_STAGE(PG8_SA(1, 0), a3, voffA);
            PG8_BAR; PG8_WAIT_L(0); PG8_MMA(1, 0, At, B0); PG8_BAR; PG8_SCHED;
            PG8_STAGE(PG8_SB(1, 1), b3 + hstepB, voffB);
            PG8_WAIT_V(6); PG8_BAR; PG8_MMA(1, 1, At, B1); PG8_BAR;
            }
        }
        if constexpr (ALIGN_EPI) { if (wr == 0) PG8_BAR; }
        if constexpr (!Epi::AFTER_DRAIN) { E(acc, cur, wr, wc, fr, fq); S.done(cur); }
        if (!has_next) break;
#pragma unroll
        for (int a = 0; a < 2; ++a)
#pragma unroll
            for (int b = 0; b < 2; ++b)
#pragma unroll
                for (int m = 0; m < 4; ++m)
#pragma unroll
                    for (int n = 0; n < 2; ++n) acc[a][b][m][n] = (f32x4){0.f, 0.f, 0.f, 0.f};
        cur = nxt; cA = nA; cB = nB; ++ui;
        if constexpr (GATHER) {
#pragma unroll
            for (int _h = 0; _h < 2; ++_h) { oA[_h][0] = nOA[_h][0]; oA[_h][1] = nOA[_h][1]; } }
        if constexpr (ALIGN_EPI) { if (wr == 1) PG8_BAR; }
    }
    PG8_WAIT_V(0);
    if constexpr (!ALIGN_EPI) { if (wr == 0) PG8_BAR; }
    PG8_BAR;
    if constexpr (Epi::AFTER_DRAIN) { E.fused(acc, cur, wr, wc, fr, fq, lds, wid, lane); S.done(cur); }
#undef PG8_SA
#undef PG8_SB
#undef PG8_STAGE
#undef PG8_LDA
#undef PG8_STAGE_A
#undef PG8_GOFF
#undef PG8_LDB
#undef PG8_MMA
#undef PG8_WAIT_V
#undef PG8_WAIT_L
#undef PG8_BAR
#undef PG8_SCHED
}
}

constexpr int NB = 4, S = 4096, D = 1024, T = NB * S;
constexpr int CONV_CH = 512, CONV_W = 31, NH = 8, INC = 2560;
constexpr int SG = 64, SC = 16, SP = 64;
constexpr int NE = 16, CAP = 512, EH = 1024, MR = NB * NE * CAP;
constexpr float EPS = 1e-6f;
constexpr int NWAVES = 8, NTHR = NWAVES * 64;

constexpr size_t MiB = 1u << 20;
constexpr size_t WS_CTL = 0, CTL_ZERO_BYTES = 64 * 1024;
constexpr size_t WS_AFF = 1 * MiB, WS_IDX = 2 * MiB, WS_GATE = 2 * MiB + 512 * 1024, WS_SLOT = 3 * MiB;
constexpr size_t WS_WIN = 4 * MiB, WS_WOUT = 10 * MiB, WS_WGLU = 12 * MiB;
constexpr size_t WS_WEXP = 16 * MiB, WEXP_LAYER = 96 * MiB, WEXP_GU = 0, WEXP_DN = 64 * MiB;
constexpr size_t WS_XN = 208 * MiB, WS_MIXED = 240 * MiB;
constexpr size_t WS_PROJ = 272 * MiB;
constexpr size_t WS_H = 336 * MiB;
constexpr size_t WS_XB = 404 * MiB;
constexpr size_t WS_END = 492 * MiB;
constexpr int CW_BAR = 1024, CW_Q0 = 64;

constexpr int SCRATCH_BYTES = 143360;
constexpr int LDSCTL_OFF = SCRATCH_BYTES;
constexpr int LDS_BYTES = 147456;

#define GAS __attribute__((address_space(1)))
#define LAS __attribute__((address_space(3)))
typedef unsigned short bf16;
typedef unsigned v4u __attribute__((ext_vector_type(4)));
typedef unsigned v2u __attribute__((ext_vector_type(2)));
typedef float f32x4 __attribute__((ext_vector_type(4)));
typedef float f32x2 __attribute__((ext_vector_type(2)));
using pg8::pk2;
using pg8::sigm;
__device__ __forceinline__ float bf2f(unsigned short h) { return __uint_as_float(((unsigned)h) << 16); }
__device__ __forceinline__ float bflo(unsigned w) { return __uint_as_float(w << 16); }
__device__ __forceinline__ float bfhi(unsigned w) { return __uint_as_float(w & 0xffff0000u); }
__device__ __forceinline__ float wave_sum(float v) {
#pragma unroll
    for (int o = 1; o < 64; o <<= 1) v += __shfl_xor(v, o);
    return v;
}

#define XB_TMO      128
#define XB_XCNT(j)  (256  + 64 * (j))
#define XB_XSUB(j)  (1280 + 64 * (j))
#define XB_XGEN(j)  (2304 + 64 * (j))
#define XB_TOP      3328
#define XB_TOPGEN   3392
#define XCD_BAR_WORDS 3456
#define XB_SPIN_CAP (1u << 18)
__device__ __forceinline__ unsigned xb_ld(unsigned* p)              { return __hip_atomic_load(p, __ATOMIC_RELAXED, __HIP_MEMORY_SCOPE_AGENT); }
__device__ __forceinline__ unsigned xb_add(unsigned* p, unsigned v) { return __hip_atomic_fetch_add(p, v, __ATOMIC_RELAXED, __HIP_MEMORY_SCOPE_AGENT); }
__device__ __forceinline__ unsigned xb_xcc_id() { return (unsigned)__builtin_amdgcn_s_getreg((3 << 11) | 20) & 0xFu; }
#define XB_SPIN(cond, bar) do { unsigned _sp = 0; while (cond) { __builtin_amdgcn_s_sleep(1); \
    if ((++_sp & 255u) == 0u) { if (xb_ld(&(bar)[XB_TMO])) break; if (_sp > XB_SPIN_CAP) { atomicAdd(&(bar)[XB_TMO], 1u); break; } } } } while (0)
struct XcdBarrier { unsigned* bar; unsigned x; volatile LAS unsigned* st; };
__device__ __forceinline__ XcdBarrier xcd_barrier_post(unsigned* bar, volatile LAS unsigned* st) {
    XcdBarrier b; b.bar = bar; b.x = xb_xcc_id(); b.st = st;
    if (threadIdx.x == 0) (void)xb_add(&bar[XB_XCNT(b.x)], 1u);
    return b;
}
__device__ __forceinline__ void xcd_barrier_complete(unsigned* bar, unsigned x, unsigned& nloc, unsigned& nx) {
    const unsigned G = gridDim.x * gridDim.y * gridDim.z;
    unsigned sum, cnt, mine, sp = 0u;
    for (;;) {
        sum = 0u; cnt = 0u; mine = 0u;
#pragma unroll
        for (unsigned j = 0; j < 16; ++j) { const unsigned c = xb_ld(&bar[XB_XCNT(j)]); sum += c; cnt += (c > 0u) ? 1u : 0u; mine = (j == x) ? c : mine; }
        if (sum == G) break;
        __builtin_amdgcn_s_sleep(1);
        if ((++sp & 255u) == 0u) { if (xb_ld(&bar[XB_TMO])) break; if (sp > XB_SPIN_CAP) { atomicAdd(&bar[XB_TMO], 1u); break; } }
    }
    nloc = mine > 0u ? mine : 1u; nx = cnt > 0u ? cnt : 1u;
}
__device__ __forceinline__ void xcd_barrier(const XcdBarrier& b) {
    asm volatile("s_waitcnt vmcnt(0)" ::: "memory");
    __syncthreads();
    if (threadIdx.x == 0) {
        unsigned* bar = b.bar;
        __builtin_amdgcn_s_waitcnt(0);
        unsigned nloc = b.st[0], nx = b.st[1];
        if (nloc == 0u) { xcd_barrier_complete(bar, b.x, nloc, nx); b.st[0] = nloc; b.st[1] = nx; }
        const unsigned old = xb_add(&bar[XB_XSUB(b.x)], 1u);
        const unsigned gen = old / nloc;
        if (old + 1u == (gen + 1u) * nloc) {
            __builtin_amdgcn_fence(__ATOMIC_RELEASE, "agent");
            asm volatile("s_waitcnt vmcnt(0)" ::: "memory");
            const unsigned og = xb_add(&bar[XB_TOP], 1u);
            const unsigned tg = og / nx;
            if (og + 1u == (tg + 1u) * nx) xb_add(&bar[XB_TOPGEN], 1u);
            else XB_SPIN(xb_ld(&bar[XB_TOPGEN]) == tg, bar);
            __builtin_amdgcn_fence(__ATOMIC_ACQUIRE, "agent");
            xb_add(&bar[XB_XGEN(b.x)], 1u);
            asm volatile("s_waitcnt vmcnt(0)" ::: "memory");
        } else {
            XB_SPIN(xb_ld(&bar[XB_XGEN(b.x)]) == gen, bar);
            __builtin_amdgcn_fence(__ATOMIC_ACQUIRE, "agent");
            asm volatile("s_waitcnt vmcnt(0)" ::: "memory");
        }
    }
    __syncthreads();
}

struct Args {
    const float* in[26]; float* out; unsigned char* ws; int ph_lo, ph_hi;
};
struct Ctx { LAS unsigned char* lds; int tid, lane, wave, vcu, G; };

__device__ __forceinline__ int rowmap(int kind, int half, int n) {
    if (kind == 0) {
        if (n < 1024) { const int hf = n >> 9, r = n & 511; return 256 * (r >> 7) + 128 * hf + (r & 127); }
        const int pn = n >> 8, w = n & 255, wc = w >> 6, bj = (w >> 5) & 1, j = w & 31; return 256 * pn + 128 * bj + 32 * wc + j;
    }
    if (kind == 2) { const int hf = n >> 10, r = n & 1023; return 256 * (r >> 7) + 128 * hf + (r & 127); }
    if (kind == 3) return 256 * (n >> 7) + 128 * half + (n & 127);
    return n;
}
struct ConvDesc { const float* src; bf16* dst; int N, kind, half, k0, n0; };
__device__ __forceinline__ bool conv_desc(const Args& a, int it, ConvDesc& d) {
    constexpr int I_IN = 16 * 40, I_OUT = 256, I_GLU = 16 * 32, I_EXP = 2 * 16 * 3 * 256;
    if (it >= I_IN + I_OUT + I_GLU + I_EXP) return false;
    unsigned char* ws = a.ws; int r = it, kb, nb;
    if (r < I_IN) { d.src = a.in[2]; d.N = INC; d.dst = (bf16*)(ws + WS_WIN); d.kind = 0; d.half = 0; kb = r / 40; nb = r % 40; }
    else if ((r -= I_IN) < I_OUT) { d.src = a.in[9]; d.N = D; d.dst = (bf16*)(ws + WS_WOUT); d.kind = 1; d.half = 0; kb = r >> 4; nb = r & 15; }
    else if ((r -= I_OUT) < I_GLU) { d.src = a.in[19]; d.N = 2 * D; d.dst = (bf16*)(ws + WS_WGLU); d.kind = 2; d.half = 0; kb = r >> 5; nb = r & 31; }
    else { r -= I_GLU; const int mat = r >> 8, tile = r & 255, layer = mat / 48, rem = mat % 48, e = rem / 3, which = rem % 3;
        d.src = a.in[23 + which] + ((size_t)layer * NE + e) * (size_t)D * EH; d.N = EH;
        d.dst = (bf16*)(ws + WS_WEXP + layer * WEXP_LAYER + (which == 2 ? WEXP_DN + (size_t)e * 2 * MiB : WEXP_GU + (size_t)e * 4 * MiB));
        d.kind = which == 2 ? 1 : 3; d.half = which; kb = tile >> 4; nb = tile & 15; }
    d.k0 = 64 * kb; d.n0 = 64 * nb; return true;
}
__device__ __forceinline__ void conv_load(const ConvDesc& d, f32x4 (&v)[16], int lane) {
    const float* p = d.src + (size_t)(d.k0 + (lane >> 4)) * d.N + d.n0 + 4 * (lane & 15);
#pragma unroll
    for (int it = 0; it < 16; ++it) v[it] = *(const f32x4*)(p + (size_t)(4 * it) * d.N);
}
__device__ __forceinline__ void conv_store(const ConvDesc& d, const f32x4 (&v)[16], LAS float* scr, int lane) {
#pragma unroll
    for (int it = 0; it < 16; ++it) { const int kk = 4 * it + (lane >> 4), nn = 4 * (lane & 15);
        scr[kk * 65 + nn] = v[it][0]; scr[kk * 65 + nn + 1] = v[it][1]; scr[kk * 65 + nn + 2] = v[it][2]; scr[kk * 65 + nn + 3] = v[it][3]; }
    asm volatile("s_waitcnt lgkmcnt(0)" ::: "memory");
    const int kc = lane & 7;
#pragma unroll
    for (int jt = 0; jt < 8; ++jt) {
        const int nl = 8 * jt + (lane >> 3);
        const LAS float* s = scr + (8 * kc) * 65 + nl;
        v4u o; o.x = pk2(s[0], s[65]); o.y = pk2(s[2 * 65], s[3 * 65]); o.z = pk2(s[4 * 65], s[5 * 65]); o.w = pk2(s[6 * 65], s[7 * 65]);
        *(v4u*)(d.dst + (size_t)rowmap(d.kind, d.half, d.n0 + nl) * 1024 + d.k0 + 8 * kc) = o;
    }
    asm volatile("s_waitcnt lgkmcnt(0)" ::: "memory");
}
__device__ __forceinline__ void rms_row_bf16(const float* __restrict__ xrow, const float* __restrict__ g, bf16* __restrict__ orow, int lane) {
    const f32x4* xr = (const f32x4*)xrow + lane;
    f32x4 v[4]; float s = 0.f;
#pragma unroll
    for (int j = 0; j < 4; ++j) { v[j] = xr[64 * j]; s += (v[j][0] * v[j][0] + v[j][1] * v[j][1]) + (v[j][2] * v[j][2] + v[j][3] * v[j][3]); }
    const float r = rsqrtf(wave_sum(s) * (1.f / D) + EPS);
#pragma unroll
    for (int j = 0; j < 4; ++j) { const f32x4 w = ((const f32x4*)g)[lane + 64 * j]; v2u o; o.x = pk2(v[j][0] * r * w[0], v[j][1] * r * w[1]); o.y = pk2(v[j][2] * r * w[2], v[j][3] * r * w[3]); ((v2u*)orow)[lane + 64 * j] = o; }
}
constexpr int CONV_NITEMS = 25984, CONV_FIRST_Q = 640, CW_P1DONE = 128;
__device__ __forceinline__ void conv_drain(const Ctx& C, const Args& a, bool until_flag) {
    LAS float* scr = (LAS float*)(C.lds + C.wave * 16640);
    unsigned* ctl = (unsigned*)(a.ws + WS_CTL);
    LAS int* qs = (LAS int*)(C.lds + 8 * 16640);
    ConvDesc dA; f32x4 vA[16];
    for (;;) {
        if (C.tid == 0) {
            int v = -1;
            if (!(until_flag && __hip_atomic_load(ctl + CW_P1DONE, __ATOMIC_RELAXED, __HIP_MEMORY_SCOPE_AGENT) != 0u))
                v = CONV_FIRST_Q + (int)__hip_atomic_fetch_add(ctl + CW_Q0, 8u, __ATOMIC_RELAXED, __HIP_MEMORY_SCOPE_AGENT);
            qs[0] = v;
        }
        __syncthreads();
        const int base = qs[0];
        __syncthreads();
        if (base < 0 || base >= CONV_NITEMS) break;
        if (conv_desc(a, base + C.wave, dA)) { conv_load(dA, vA, C.lane); conv_store(dA, vA, scr, C.lane); }
    }
}
__device__ __forceinline__ void p0_prologue(const Ctx& C, const Args& a) {
    LAS float* scr = (LAS float*)(C.lds + C.wave * 16640);
    const int gw = C.vcu * NWAVES + C.wave, NGW = C.G * NWAVES;
    unsigned char* ws = a.ws;
    {
        const float* x = a.in[0]; const float* gg = a.in[1]; bf16* XN = (bf16*)(ws + WS_XN); const int lane = C.lane;
        auto LOADR = [&](f32x4 (&v)[4], int m) __attribute__((always_inline)) { const f32x4* xr = (const f32x4*)(x + (size_t)m * D) + lane;
#pragma unroll
            for (int j = 0; j < 4; ++j) v[j] = xr[64 * j]; };
        auto PROC = [&](const f32x4 (&v)[4], int m) __attribute__((always_inline)) { float s = 0.f;
#pragma unroll
            for (int j = 0; j < 4; ++j) s += (v[j][0] * v[j][0] + v[j][1] * v[j][1]) + (v[j][2] * v[j][2] + v[j][3] * v[j][3]);
            const float r = rsqrtf(wave_sum(s) * (1.f / D) + EPS);
#pragma unroll
            for (int j = 0; j < 4; ++j) { const f32x4 w = ((const f32x4*)gg)[lane + 64 * j]; v2u o; o.x = pk2(v[j][0] * r * w[0], v[j][1] * r * w[1]); o.y = pk2(v[j][2] * r * w[2], v[j][3] * r * w[3]); ((v2u*)(XN + (size_t)m * D))[lane + 64 * j] = o; } };
        f32x4 va[4], vb[4]; int m = gw;
        if (m < T) LOADR(va, m);
        for (; m < T; m += 2 * NGW) { if (m + NGW < T) LOADR(vb, m + NGW); PROC(va, m); if (m + 2 * NGW < T) LOADR(va, m + 2 * NGW); if (m + NGW < T) PROC(vb, m + NGW); }
    }
    ConvDesc dA; f32x4 vA[16];
    for (int it = gw; it < CONV_FIRST_Q; it += NGW) if (conv_desc(a, it, dA)) { conv_load(dA, vA, C.lane); conv_store(dA, vA, scr, C.lane); }
}

__device__ __forceinline__ void conv_tile(const Ctx& C, const Args& a, int tile) {
    const bf16* GLU = (const bf16*)(a.ws + WS_PROJ);
    bf16* MIXED = (bf16*)(a.ws + WS_MIXED);
    const float* cw = a.in[3]; const float* cb = a.in[4]; const float* lg = a.in[5]; const float* lb = a.in[6];
    LAS float* tl = (LAS float*)C.lds;
    const int cp = C.tid & 255, th = C.tid >> 8;
    const int b = tile / (S / 32), s0 = (tile % (S / 32)) * 32;
    f32x2 w[CONV_W];
#pragma unroll
    for (int j = 0; j < CONV_W; ++j) w[j] = *(const f32x2*)(cw + j * CONV_CH + 2 * cp);
    f32x2 acc[16];
    const f32x2 bias = *(const f32x2*)(cb + 2 * cp);
#pragma unroll
    for (int k = 0; k < 16; ++k) acc[k] = bias;
    unsigned xin[46];
#pragma unroll
    for (int i = 0; i < 46; ++i) { const int ss = s0 + 16 * th - 15 + i; xin[i] = (ss >= 0 && ss < S) ? *(const unsigned*)(GLU + (size_t)(b * S + ss) * 512 + 2 * cp) : 0u; }
#pragma unroll
    for (int i = 0; i < 46; ++i) {
        const f32x2 x = {bflo(xin[i]), bfhi(xin[i])};
#pragma unroll
        for (int k = 0; k < 16; ++k) { const int j = i - k; if (j >= 0 && j < CONV_W) acc[k] += w[j] * x; }
    }
#pragma unroll
    for (int k = 0; k < 16; ++k) *(LAS f32x2*)(tl + (16 * th + k) * 512 + 2 * cp) = acc[k];
    __syncthreads();
#pragma unroll
    for (int q = 0; q < 4; ++q) {
        const int tok = 4 * C.wave + q;
        const f32x4 v0 = *(const LAS f32x4*)(tl + tok * 512 + 8 * C.lane), v1 = *(const LAS f32x4*)(tl + tok * 512 + 8 * C.lane + 4);
        const float mu = wave_sum((v0[0] + v0[1]) + (v0[2] + v0[3]) + (v1[0] + v1[1]) + (v1[2] + v1[3])) * (1.f / CONV_CH);
        const f32x4 d0 = v0 - mu, d1 = v1 - mu;
        const float var = wave_sum((d0[0] * d0[0] + d0[1] * d0[1]) + (d0[2] * d0[2] + d0[3] * d0[3]) + (d1[0] * d1[0] + d1[1] * d1[1]) + (d1[2] * d1[2] + d1[3] * d1[3])) * (1.f / CONV_CH);
        const float rs = rsqrtf(var + EPS);
        const f32x4 g0 = *(const f32x4*)(lg + 8 * C.lane), g1 = *(const f32x4*)(lg + 8 * C.lane + 4), b0 = *(const f32x4*)(lb + 8 * C.lane), b1 = *(const f32x4*)(lb + 8 * C.lane + 4);
        f32x4 y0 = d0 * rs * g0 + b0, y1 = d1 * rs * g1 + b1;
#pragma unroll
        for (int e = 0; e < 4; ++e) { y0[e] = y0[e] * sigm(y0[e]); y1[e] = y1[e] * sigm(y1[e]); }
        v4u o; o.x = pk2(y0[0], y0[1]); o.y = pk2(y0[2], y0[3]); o.z = pk2(y1[0], y1[1]); o.w = pk2(y1[2], y1[3]);
        *(v4u*)(MIXED + (size_t)(b * S + s0 + tok) * D + 8 * C.lane) = o;
    }
    __syncthreads();
}
typedef short bf16x8 __attribute__((ext_vector_type(8)));
typedef short s16x4 __attribute__((ext_vector_type(4)));
typedef short v4i16_t __attribute__((ext_vector_type(4)));
typedef float f32x16 __attribute__((ext_vector_type(16)));
constexpr int AT_O = 0, AT_L = 65536, AT_V = 66560;
__device__ __forceinline__ s16x4 vtr(const LAS char* p) { return __builtin_bit_cast(s16x4, __builtin_amdgcn_ds_read_tr16_b64_v4i16((LAS v4i16_t*)p)); }
__device__ __forceinline__ void lds_addf(LAS float* p, float v) { (void)__hip_atomic_fetch_add(p, v, __ATOMIC_RELAXED, __HIP_MEMORY_SCOPE_WORKGROUP); }
__device__ __forceinline__ int med3i(int x, int lo, int hi) { return x < lo ? lo : (x > hi ? hi : x); }
__device__ __forceinline__ void attn_unit(const Ctx& C, const bf16* __restrict__ Qh, const bf16* __restrict__ Kh, const bf16* __restrict__ Vh,
                                          int d, int tq0, int nq, int tl0, int tls, float a2, float bound2, LAS float* Oacc, LAS float* Lacc, LAS char* vst, bool first) {
    int lane_ = C.lane; asm volatile("" : "+v"(lane_));
    const int lane = lane_, r = lane & 31, hh = lane >> 5;
    const int qi = r < nq ? r : nq - 1;
    bf16x8 qf[4]; v4u ks_[2][4], vs[2][4];
    const char* Kc = (const char*)Kh; const char* Vc = (const char*)Vh;
#define AT_LOADK(kb) do { _Pragma("unroll") for (int it = 0; it < 4; ++it) { const int key = (lane >> 3) + 8 * it; \
        const unsigned ro = (unsigned)med3i(tq0 + d * (32 * (kb) + key - 64), 0, S - 1) * 128u + 16u * (lane & 7); ks_[(kb) % 2][it] = *(const v4u*)(Kc + ro); } } while (0)
#define AT_LOADV(kb) do { _Pragma("unroll") for (int it = 0; it < 4; ++it) { const int key = (lane >> 3) + 8 * it; \
        const unsigned ro = (unsigned)med3i(tq0 + d * (32 * (kb) + key - 64), 0, S - 1) * 128u + 16u * (lane & 7); vs[(kb) % 2][it] = *(const v4u*)(Vc + ro); } } while (0)
    { const char* qp = (const char*)Qh + (unsigned)(tq0 + d * qi) * 128u + 16u * hh;
#pragma unroll
      for (int ks = 0; ks < 4; ++ks) qf[ks] = *(const bf16x8*)(qp + 32 * ks); }
    AT_LOADK(0); AT_LOADV(0);
    f32x16 o0, o1;
#pragma unroll
    for (int v = 0; v < 16; ++v) { o0[v] = 0.f; o1[v] = 0.f; }
    float lsum = 0.f;
    LAS char* kst = vst, *vt = vst + 4096;
    const LAS char* vb = vt + ((lane >> 4) & 1) * 32 + (lane & 3) * 8 + (4 * hh + ((lane & 15) >> 2)) * 64;
    LAS char* vw = vt + ((lane & 7) >> 2) * 2048 + ((lane >> 3) & 15) * 64 + (lane & 3) * 16;
    LAS char* kw = kst + (lane >> 3) * 128;
    const LAS char* kr = kst + r * 128;
    const int rsw = (r >> 1) & 7;
#pragma unroll
    for (int kb = 0; kb < 5; ++kb) {
        if (kb + 1 < 5) { AT_LOADK(kb + 1); AT_LOADV(kb + 1); }
        __builtin_amdgcn_sched_barrier(0);
#pragma unroll
        for (int it = 0; it < 4; ++it) { const int key = (lane >> 3) + 8 * it;
            *(LAS v4u*)(kw + it * 1024 + (((lane & 7) ^ ((key >> 1) & 7)) << 4)) = ks_[kb % 2][it]; }
        f32x16 p;
        int relb = 32 * kb - 64 - r + 4 * hh; const int kposb = tq0 + d * (32 * kb - 64 + 4 * hh);
        asm volatile("" : "+v"(relb));
#pragma unroll
        for (int v = 0; v < 16; ++v) {
            const int rw = (v & 3) + 8 * (v >> 2), rel = relb + rw, kpos = kposb + d * rw;
            bool valid = ((unsigned)kpos < (unsigned)S) && (r < nq);
            if (kb == 0) valid = valid && (rel >= -64);
            if (kb == 4) valid = valid && (rel <= 64);
            p[v] = valid ? -(a2 * fabsf((float)rel)) - bound2 : -1e30f;
        }
        asm volatile("s_waitcnt lgkmcnt(0)" ::: "memory");
        bf16x8 kf[4];
#pragma unroll
        for (int ks = 0; ks < 4; ++ks) kf[ks] = *(const LAS bf16x8*)(kr + (((2 * ks + hh) ^ rsw) << 4));
#pragma unroll
        for (int ks = 0; ks < 4; ++ks) p = __builtin_amdgcn_mfma_f32_32x32x16_bf16(kf[ks], qf[ks], p, 0, 0, 0);
#pragma unroll
        for (int it = 0; it < 4; ++it) *(LAS v4u*)(vw + (it >> 1) * 1024 + (it & 1) * 512) = vs[kb % 2][it];
#pragma unroll
        for (int v = 0; v < 16; ++v) { p[v] = __builtin_amdgcn_exp2f(p[v]); lsum += p[v]; }
        v4u pw0, pw1;
        pw0.x = pk2(p[0], p[1]); pw0.y = pk2(p[2], p[3]); pw0.z = pk2(p[4], p[5]); pw0.w = pk2(p[6], p[7]);
        pw1.x = pk2(p[8], p[9]); pw1.y = pk2(p[10], p[11]); pw1.z = pk2(p[12], p[13]); pw1.w = pk2(p[14], p[15]);
        asm volatile("s_waitcnt lgkmcnt(0)" ::: "memory");
#pragma unroll
        for (int sdh = 0; sdh < 4; ++sdh) {
            const int dh = sdh >> 1, ss = sdh & 1;
            const s16x4 lo = vtr(vb + dh * 2048 + ss * 1024), hi = vtr(vb + dh * 2048 + ss * 1024 + 512);
            const bf16x8 vf = {lo[0], lo[1], lo[2], lo[3], hi[0], hi[1], hi[2], hi[3]};
            const bf16x8 pa = __builtin_bit_cast(bf16x8, ss == 0 ? pw0 : pw1);
            if (dh == 0) o0 = __builtin_amdgcn_mfma_f32_32x32x16_bf16(pa, vf, o0, 0, 0, 0);
            else o1 = __builtin_amdgcn_mfma_f32_32x32x16_bf16(pa, vf, o1, 0, 0, 0);
        }
        asm volatile("s_waitcnt lgkmcnt(0)" ::: "memory");
        __builtin_amdgcn_sched_barrier(0);
    }
#undef AT_LOADK
#undef AT_LOADV
    lsum += __shfl_xor(lsum, 32);
    if (lane < nq) { LAS float* lp = Lacc + tl0 + tls * lane; *lp = first ? lsum : *lp + lsum; }
#pragma unroll
    for (int v = 0; v < 16; ++v) {
        const int iq = (v & 3) + 8 * (v >> 2) + 4 * hh;
        if (v < 8 || nq == 32) { LAS float* op = Oacc + (tl0 + tls * iq) * 64 + r;
            if (first) { op[0] = o0[v]; op[32] = o1[v]; } else { const float x0 = op[0], x1 = op[32]; op[0] = x0 + o0[v]; op[32] = x1 + o1[v]; } }
    }
}
__device__ __forceinline__ void attn_phase(const Ctx& C, const Args& a) {
    const bf16* Q = (const bf16*)(a.ws + WS_PROJ + 16 * MiB);
    const bf16* K = (const bf16*)(a.ws + WS_PROJ + 32 * MiB);
    const bf16* V = (const bf16*)(a.ws + WS_PROJ + 48 * MiB);
    bf16* MIXED = (bf16*)(a.ws + WS_MIXED);
    LAS float* Oacc = (LAS float*)(C.lds + AT_O); LAS float* Lacc = (LAS float*)(C.lds + AT_L); LAS char* vst = (LAS char*)(C.lds + AT_V + C.wave * 8192);
    float mq = fabsf(a.in[7][C.lane]), mk = fabsf(a.in[8][C.lane]);
#pragma unroll
    for (int o = 1; o < 64; o <<= 1) { mq = fmaxf(mq, __shfl_xor(mq, o)); mk = fmaxf(mk, __shfl_xor(mk, o)); }
    const float bound2 = 64.f * pg8::QSCALE * mq * mk * 1.01f;
    for (int item = C.vcu; item < NB * NH * 16; item += C.G) {
        const int span = item & 15, h = (item >> 4) & 7, b = item >> 7, t0 = span * 256, w = C.wave;
        const size_t hb = (size_t)(b * NH + h) * S * 64;
        const bf16 *Qh = Q + hb, *Kh = K + hb, *Vh = V + hb;
        const float slope2 = exp2f(-(float)(h + 1)) * 1.4426950408889634f;
#pragma unroll 1
        for (int un = 0; un < 4; ++un) {
            const int d = un == 0 ? 1 : (un == 1 ? 4 : 16);
            const int tl0 = un == 0 ? 32 * w : (un == 1 ? (w >> 1) + 128 * (w & 1) : 2 * w + (un - 2));
            attn_unit(C, Qh, Kh, Vh, d, t0 + tl0, un < 2 ? 32 : 16, tl0, d, slope2 * (float)d, bound2, Oacc, Lacc, vst, un == 0);
            if (un < 2) __syncthreads();
        }
        __syncthreads();
        {
            const int q = C.tid >> 1, hf = C.tid & 1;
            const float inv = 1.f / Lacc[q];
            const LAS f32x4* op = (const LAS f32x4*)(Oacc + q * 64 + 32 * hf);
            bf16* dst = MIXED + (size_t)(b * S + t0 + q) * D + 512 + h * 64 + 32 * hf;
#pragma unroll
            for (int j = 0; j < 4; ++j) { const f32x4 x0 = op[2 * j] * inv, x1 = op[2 * j + 1] * inv; v4u o; o.x = pk2(x0[0], x0[1]); o.y = pk2(x0[2], x0[3]); o.z = pk2(x1[0], x1[1]); o.w = pk2(x1[2], x1[3]); *(v4u*)(dst + 8 * j) = o; }
        }
        __syncthreads();
    }
}

__device__ __forceinline__ void p_router(const Ctx& C, const Args& a, int layer) {
    const float* X = layer == 0 ? a.out : (const float*)(a.ws + WS_XB); const float* g = a.in[20] + (size_t)layer * D;
    const float* wr = a.in[21] + (size_t)layer * D * NE; const float* br = a.in[22] + layer * NE;
    bf16* XN = (bf16*)(a.ws + WS_XN); float* AFF = (float*)(a.ws + WS_AFF);
    LAS float* wl = (LAS float*)C.lds;
    for (int i = C.tid; i < D * 4; i += NTHR) { const int k = i >> 2, qd = i & 3; const f32x4 v = *(const f32x4*)(wr + (size_t)k * NE + 4 * qd);
        const int slot = ((k >> 8) * 4 + (k & 3)) * 64 + ((k >> 2) & 63); *(LAS f32x4*)(wl + slot * 20 + 4 * qd) = v; }
    __syncthreads();
    const int gw = C.vcu * NWAVES + C.wave, NGW = C.G * NWAVES, lane = C.lane;
    auto LOADR = [&](f32x4 (&v)[4], int m) __attribute__((always_inline)) { const f32x4* xr = (const f32x4*)(X + (size_t)m * D) + lane;
#pragma unroll
        for (int j = 0; j < 4; ++j) v[j] = xr[64 * j]; };
    auto PROC = [&](const f32x4 (&v)[4], int m) __attribute__((always_inline)) {
        float s = 0.f;
#pragma unroll
        for (int j = 0; j < 4; ++j) s += (v[j][0] * v[j][0] + v[j][1] * v[j][1]) + (v[j][2] * v[j][2] + v[j][3] * v[j][3]);
        const float r = rsqrtf(wave_sum(s) * (1.f / D) + EPS);
        float acc[NE];
#pragma unroll
        for (int e = 0; e < NE; ++e) acc[e] = 0.f;
#pragma unroll
        for (int j = 0; j < 4; ++j) {
            const f32x4 w = ((const f32x4*)g)[lane + 64 * j];
            const f32x4 hv = v[j] * w * r;
            v2u o; o.x = pk2(hv[0], hv[1]); o.y = pk2(hv[2], hv[3]); ((v2u*)(XN + (size_t)m * D))[lane + 64 * j] = o;
#pragma unroll
            for (int i = 0; i < 4; ++i) {
                const LAS float* wp = wl + ((j * 4 + i) * 64 + lane) * 20;
#pragma unroll
                for (int qd = 0; qd < 4; ++qd) { const f32x4 ww = *(const LAS f32x4*)(wp + 4 * qd); acc[4 * qd] += hv[i] * ww[0]; acc[4 * qd + 1] += hv[i] * ww[1]; acc[4 * qd + 2] += hv[i] * ww[2]; acc[4 * qd + 3] += hv[i] * ww[3]; }
                if (i & 1) asm volatile("" ::: "memory");
            }
        }
#pragma unroll
        for (int i = 0; i < 8; ++i) { const bool up = lane & 32; const float keep = up ? acc[i + 8] : acc[i], give = up ? acc[i] : acc[i + 8]; acc[i] = keep + __shfl_xor(give, 32); }
#pragma unroll
        for (int i = 0; i < 4; ++i) { const bool up = lane & 16; const float keep = up ? acc[i + 4] : acc[i], give = up ? acc[i] : acc[i + 4]; acc[i] = keep + __shfl_xor(give, 16); }
#pragma unroll
        for (int i = 0; i < 2; ++i) { const bool up = lane & 8; const float keep = up ? acc[i + 2] : acc[i], give = up ? acc[i] : acc[i + 2]; acc[i] = keep + __shfl_xor(give, 8); }
        { const bool up = lane & 4; const float keep = up ? acc[1] : acc[0], give = up ? acc[0] : acc[1]; acc[0] = keep + __shfl_xor(give, 4); }
        float lg = acc[0]; lg += __shfl_xor(lg, 2); lg += __shfl_xor(lg, 1);
        const int e = ((lane >> 5) & 1) * 8 + ((lane >> 4) & 1) * 4 + ((lane >> 3) & 1) * 2 + ((lane >> 2) & 1);
        lg += br[e];
        float mx = lg;
#pragma unroll
        for (int o = 4; o < 64; o <<= 1) mx = fmaxf(mx, __shfl_xor(mx, o));
        const float ex = __expf(lg - mx); float sum = ex;
#pragma unroll
        for (int o = 4; o < 64; o <<= 1) sum += __shfl_xor(sum, o);
        const int b = m / S, ss = m % S;
        if ((lane & 3) == 0) AFF[((size_t)b * NE + e) * S + ss] = ex / sum;
    };
    f32x4 va[4], vb[4];
    int m = gw;
    if (m < T) LOADR(va, m);
    for (; m < T; m += 2 * NGW) {
        if (m + NGW < T) LOADR(vb, m + NGW);
        PROC(va, m);
        if (m + 2 * NGW < T) LOADR(va, m + 2 * NGW);
        if (m + NGW < T) PROC(vb, m + NGW);
    }
    __syncthreads();
}

__device__ __forceinline__ int popc64(unsigned long long m) { return __builtin_popcountll(m); }
__device__ __forceinline__ void p_topk(const Ctx& C, const Args& a) {
    const float* AFF = (const float*)(a.ws + WS_AFF);
    int* IDX = (int*)(a.ws + WS_IDX); float* GATE = (float*)(a.ws + WS_GATE); int* SLOT = (int*)(a.ws + WS_SLOT);
    const int lane = C.lane, w = C.wave;
    for (int item = C.vcu; item < NB * NE * 4; item += C.G) {
        const int be = item >> 2, qt = item & 3, b = be / NE, e = be % NE;
        unsigned key[16][4];
#pragma unroll
        for (int j = 0; j < 16; ++j) { const v4u k = *(const v4u*)(AFF + (size_t)be * S + 256 * j + 4 * lane); key[j][0] = k.x; key[j][1] = k.y; key[j][2] = k.z; key[j][3] = k.w; }
        unsigned cur = 0u;
        LAS unsigned* curw = (LAS unsigned*)C.lds;
        if (w == 0) {
#pragma unroll 1
        for (int bit = 30; bit >= 0; --bit) {
            const unsigned cand = cur | (1u << bit);
            unsigned c4[4] = {0u, 0u, 0u, 0u};
#pragma unroll
            for (int j = 0; j < 16; ++j)
#pragma unroll
                for (int i = 0; i < 4; ++i) c4[i] += (key[j][i] >= cand) ? 1u : 0u;
            const unsigned c = (c4[0] + c4[1]) + (c4[2] + c4[3]);
            int cnt = 0;
#pragma unroll
            for (int k = 0; k < 7; ++k) cnt += popc64(__ballot((c >> k) & 1u)) << k;
            if (cnt >= CAP) cur = cand;
        }
        if (lane == 0) curw[0] = cur;
        }
        __syncthreads();
        cur = curw[0];
        __syncthreads();
        const int jj = 4 * qt + (w >> 1);
        unsigned cga = 0, pre = 0; unsigned kk[4] = {0u, 0u, 0u, 0u};
#pragma unroll
        for (int j = 0; j < 16; ++j) {
            unsigned cg = 0, ce = 0;
#pragma unroll
            for (int i = 0; i < 4; ++i) { cg += (key[j][i] > cur) ? 1u : 0u; ce += (key[j][i] == cur) ? 1u : 0u; }
            cga += cg;
            if (j < jj) pre += cg | (ce << 8);
            if (j == jj) { kk[0] = key[j][0]; kk[1] = key[j][1]; kk[2] = key[j][2]; kk[3] = key[j][3]; }
        }
        int ngt = 0, gpre = 0, epre = 0;
#pragma unroll
        for (int k = 0; k < 7; ++k) { ngt += popc64(__ballot((cga >> k) & 1u)) << k; gpre += popc64(__ballot((pre >> k) & 1u)) << k; epre += popc64(__ballot((pre >> (8 + k)) & 1u)) << k; }
        const int need = CAP - ngt;
        unsigned pk = 0;
#pragma unroll
        for (int i = 0; i < 4; ++i) pk += (kk[i] > cur ? 1u : 0u) + (kk[i] == cur ? 0x10000u : 0u);
        unsigned inc = pk;
#pragma unroll
        for (int o = 1; o < 64; o <<= 1) { const unsigned t = __shfl_up(inc, o); if (lane >= o) inc += t; }
        const unsigned exc = inc - pk;
        int gtb = gpre + (int)(exc & 0xffffu), eqb = epre + (int)(exc >> 16);
        if ((lane >> 5) == (w & 1)) {
#pragma unroll
            for (int i = 0; i < 4; ++i) {
                const bool gt = kk[i] > cur, eq = kk[i] == cur;
                const bool sel = gt || (eq && eqb < need);
                const int pos = gtb + (eqb < need ? eqb : need);
                const int tok = 256 * jj + 4 * lane + i;
                SLOT[((size_t)(b * S + tok)) * NE + e] = sel ? pos : -1;
                if (sel) { IDX[be * CAP + pos] = b * S + tok; GATE[be * CAP + pos] = __uint_as_float(kk[i]); }
                gtb += gt ? 1 : 0; eqb += eq ? 1 : 0;
            }
        }
    }
}

__device__ __forceinline__ void p_combine(const Ctx& C, const Args& a, bool with_norm) {
    const float* Xin = with_norm ? a.out : (const float*)(a.ws + WS_XB); float* Xout = with_norm ? (float*)(a.ws + WS_XB) : a.out;
    const bf16* Y = (const bf16*)(a.ws + WS_PROJ); const int* SLOT = (const int*)(a.ws + WS_SLOT);
    bf16* UC = (bf16*)(a.ws + WS_H); const float* g = a.in[10];
    const int gw = C.vcu * NWAVES + C.wave, NGW = C.G * NWAVES, lane = C.lane;
    auto LOADR = [&](f32x4 (&v)[4], int& slot, int m) __attribute__((always_inline)) { const f32x4* xr = (const f32x4*)(Xin + (size_t)m * D) + 4 * lane;
#pragma unroll
        for (int j = 0; j < 4; ++j) v[j] = xr[j];
        slot = (lane < NE) ? SLOT[(size_t)m * NE + lane] : -1; };
    auto PROC = [&](f32x4 (&v)[4], int myslot, int m) __attribute__((always_inline)) {
        const int b = m / S;
        unsigned long long mask = __ballot(myslot >= 0);
        while (mask) {
            v2u y[4][4]; int ee[4];
#pragma unroll
            for (int q = 0; q < 4; ++q) { ee[q] = mask ? (int)__builtin_ctzll(mask) : -1; if (mask) mask &= mask - 1; }
#pragma unroll
            for (int q = 0; q < 4; ++q) if (ee[q] >= 0) { const int sl = __shfl(myslot, ee[q]);
                const v2u* yr = (const v2u*)(Y + ((size_t)(b * NE + ee[q]) * CAP + sl) * D) + 4 * lane;
#pragma unroll
                for (int j = 0; j < 4; ++j) y[q][j] = yr[j]; }
#pragma unroll
            for (int q = 0; q < 4; ++q) if (ee[q] >= 0) {
#pragma unroll
                for (int j = 0; j < 4; ++j) { v[j][0] += bflo(y[q][j].x); v[j][1] += bfhi(y[q][j].x); v[j][2] += bflo(y[q][j].y); v[j][3] += bfhi(y[q][j].y); } }
        }
        f32x4* xo = (f32x4*)(Xout + (size_t)m * D) + 4 * lane;
#pragma unroll
        for (int j = 0; j < 4; ++j) xo[j] = v[j];
        if (with_norm) {
            float s = 0.f;
#pragma unroll
            for (int j = 0; j < 4; ++j) s += (v[j][0] * v[j][0] + v[j][1] * v[j][1]) + (v[j][2] * v[j][2] + v[j][3] * v[j][3]);
            const float r = rsqrtf(wave_sum(s) * (1.f / D) + EPS);
            unsigned w[8];
#pragma unroll
            for (int j = 0; j < 4; ++j) { const f32x4 gg = ((const f32x4*)g)[4 * lane + j]; w[2 * j] = pk2(v[j][0] * r * gg[0], v[j][1] * r * gg[1]); w[2 * j + 1] = pk2(v[j][2] * r * gg[2], v[j][3] * r * gg[3]); }
            bf16* up = UC + ((size_t)(lane * 1024 + (m >> 4)) * 512 + (m & 15) * 16);
            *(v4u*)up = (v4u){w[0], w[1], w[2], w[3]}; *(v4u*)(up + 8) = (v4u){w[4], w[5], w[6], w[7]};
        }
    };
    f32x4 va[4], vb[4]; int sa = -1, sb = -1;
    int m = gw;
    if (m < T) LOADR(va, sa, m);
    for (; m < T; m += 2 * NGW) {
        if (m + NGW < T) LOADR(vb, sb, m + NGW);
        PROC(va, sa, m);
        if (m + 2 * NGW < T) LOADR(va, sa, m + 2 * NGW);
        if (m + NGW < T) PROC(vb, sb, m + NGW);
    }
}

constexpr size_t WS_UC = WS_H;
constexpr size_t WS_E = WS_PROJ;
constexpr size_t WS_TM = 468 * MiB;
constexpr size_t WS_W16 = 484 * MiB;
__device__ __forceinline__ void s5_lambda(const Args& a, int pg, int p, float& lbr, float& lbi, float& fr, float& fi) {
    const float lr = a.in[11][pg * SP + p], li = a.in[12][pg * SP + p], dt = expf(a.in[13][pg]);
    const float mag = expf(lr * dt), ang = li * dt;
    lbr = mag * cosf(ang); lbi = mag * sinf(ang);
    const float den = lr * lr + li * li, nr = lbr - 1.f;
    fr = (nr * lr + lbi * li) / den; fi = (lbi * lr - nr * li) / den;
}
__device__ __forceinline__ void p_s5_pre(const Ctx& C, const Args& a, int g) {
    LAS float* lam = (LAS float*)C.lds; LAS float* bb = lam + 2 * 64 * 17 * 2; LAS float* cc = bb + 2 * 64 * 16 * 2; LAS float* Kt = cc + 2 * 16 * 64 * 2;
    bf16* TM = (bf16*)(a.ws + WS_TM) + (size_t)g * 256 * 512; bf16* W16 = (bf16*)(a.ws + WS_W16) + (size_t)g * 256 * 256;
    const int tid = C.tid;
    if (tid < 128) {
        const int dir = tid >> 6, p = tid & 63, pg = dir * SG + g;
        float lbr, lbi, fr, fi; s5_lambda(a, pg, p, lbr, lbi, fr, fi);
        float pr = 1.f, pi = 0.f;
        for (int k = 0; k <= 16; ++k) { lam[((dir * 64 + p) * 17 + k) * 2] = pr; lam[((dir * 64 + p) * 17 + k) * 2 + 1] = pi; const float nr = pr * lbr - pi * lbi, ni = pr * lbi + pi * lbr; pr = nr; pi = ni; }
        for (int c = 0; c < 16; ++c) { const float br = a.in[14][((size_t)pg * SP + p) * SC + c], bi = a.in[15][((size_t)pg * SP + p) * SC + c];
            bb[((dir * 64 + p) * 16 + c) * 2] = fr * br - fi * bi; bb[((dir * 64 + p) * 16 + c) * 2 + 1] = fr * bi + fi * br; }
    }
    for (int i = tid; i < 2048; i += NTHR) { const int dir = i >> 10, r = i & 1023;
        cc[i * 2] = a.in[16][(size_t)(dir * SG + g) * 1024 + r]; cc[i * 2 + 1] = a.in[17][(size_t)(dir * SG + g) * 1024 + r]; }
    __syncthreads();
    for (int id = tid; id < 8192; id += NTHR) {
        const int dir = id >> 12, k = (id >> 8) & 15, cp = (id >> 4) & 15, c = id & 15; float acc = 0.f;
        for (int p = 0; p < 64; ++p) {
            const float cr = cc[((dir * 16 + cp) * 64 + p) * 2], ci = cc[((dir * 16 + cp) * 64 + p) * 2 + 1];
            const float lr = lam[((dir * 64 + p) * 17 + k) * 2], li = lam[((dir * 64 + p) * 17 + k) * 2 + 1];
            const float xr = cr * lr - ci * li, xi = cr * li + ci * lr;
            acc += xr * bb[((dir * 64 + p) * 16 + c) * 2] - xi * bb[((dir * 64 + p) * 16 + c) * 2 + 1];
        }
        Kt[id] = acc;
    }
    __syncthreads();
    const float* dsk = a.in[18] + g * 16;
    for (int e8 = tid; e8 < 256 * 64; e8 += NTHR) {
        const int n = e8 >> 6, ch = e8 & 63, t = n >> 4, cp = n & 15; float v[8];
        if (ch < 32) {
            const int s_ = ch >> 1, c0 = (ch & 1) * 8;
#pragma unroll
            for (int i = 0; i < 8; ++i) { const int c = c0 + i; float x = 0.f;
                if (s_ <= t) x += Kt[((0 * 16 + (t - s_)) * 16 + cp) * 16 + c];
                if (s_ >= t) x += Kt[((1 * 16 + (s_ - t)) * 16 + cp) * 16 + c];
                if (s_ == t && c == cp) x += dsk[cp];
                v[i] = x; }
        } else {
            const int dir = (ch - 32) >> 4, p0 = ((ch - 32) & 15) * 4, e = dir ? 16 - t : t + 1;
#pragma unroll
            for (int i = 0; i < 4; ++i) { const int p = p0 + i;
                const float cr = cc[((dir * 16 + cp) * 64 + p) * 2], ci = cc[((dir * 16 + cp) * 64 + p) * 2 + 1];
                const float lr = lam[((dir * 64 + p) * 17 + e) * 2], li = lam[((dir * 64 + p) * 17 + e) * 2 + 1];
                v[2 * i] = cr * lr - ci * li; v[2 * i + 1] = -(cr * li + ci * lr); }
        }
        v4u o; o.x = pk2(v[0], v[1]); o.y = pk2(v[2], v[3]); o.z = pk2(v[4], v[5]); o.w = pk2(v[6], v[7]);
        *(v4u*)(TM + (size_t)n * 512 + 8 * ch) = o;
    }
    for (int e8 = tid; e8 < 256 * 32; e8 += NTHR) {
        const int n = e8 >> 5, ch = e8 & 31, dir = n >> 7, p = (n & 127) >> 1, part = n & 1, s_ = ch >> 1, c0 = (ch & 1) * 8, e = dir ? s_ : 15 - s_;
        const float lr = lam[((dir * 64 + p) * 17 + e) * 2], li = lam[((dir * 64 + p) * 17 + e) * 2 + 1]; float v[8];
#pragma unroll
        for (int i = 0; i < 8; ++i) { const float br = bb[((dir * 64 + p) * 16 + c0 + i) * 2], bi = bb[((dir * 64 + p) * 16 + c0 + i) * 2 + 1];
            v[i] = part ? (lr * bi + li * br) : (lr * br - li * bi); }
        v4u o; o.x = pk2(v[0], v[1]); o.y = pk2(v[2], v[3]); o.z = pk2(v[4], v[5]); o.w = pk2(v[6], v[7]);
        *(v4u*)(W16 + (size_t)n * 256 + 8 * ch) = o;
    }
    __syncthreads();
}
struct S5Order {
    int G, c;
    __device__ void init(int G_, int c_) { G = G_; c = c_; }
    __device__ bool next(int i, pg8::Unit& u) const {
        const long L = (long)i * G + c; if (L >= 256) return false;
        int V = (int)L; if (G == 256) V = (c & 7) * 32 + (c >> 3);
        u.pm = V; u.pn = 0; u.pb = V >> 2; return true;
    }
    __device__ __forceinline__ void a_ready(const pg8::Unit&) const {}
    __device__ __forceinline__ void done(const pg8::Unit&) const {}
};
struct EpiS5Scan {
    static constexpr bool PERM = true, AFTER_DRAIN = true;
    bf16* UC; const float *lam_re, *lam_im, *log_dt;
    static constexpr int PITCH = 528;
    __device__ __forceinline__ void fused(const pg8::f32x4 (&acc)[2][2][4][2], const pg8::Unit& u, int wr, int wc, int fr, int fq, LAS unsigned char* lds, int wid, int lane) const {
        const int tid = wid * 64 + lane;
#pragma unroll
        for (int ai = 0; ai < 2; ++ai)
#pragma unroll
            for (int m = 0; m < 4; ++m)
#pragma unroll
                for (int bj = 0; bj < 2; ++bj) { const pg8::f32x4 x = acc[ai][bj][m][0], y = acc[ai][bj][m][1];
                    v4u w; w.x = pk2(x[0], x[1]); w.y = pk2(x[2], x[3]); w.z = pk2(y[0], y[1]); w.w = pk2(y[2], y[3]);
                    *(LAS v4u*)(lds + (ai * 128 + wr * 64 + m * 16 + fr) * PITCH + (bj * 128 + wc * 32 + 8 * fq) * 2) = w; }
        __syncthreads();
        const int g = u.pm >> 2;
        if (tid < 128) {
            const int dir = tid >> 6, p = tid & 63, pg = dir * SG + g;
            const float lr = lam_re[pg * SP + p], li = lam_im[pg * SP + p], dt = expf(log_dt[pg]);
            const float mag = expf(lr * dt), ang = li * dt;
            float pr = mag * cosf(ang), pi = mag * sinf(ang);
#pragma unroll
            for (int i = 0; i < 4; ++i) { const float nr = pr * pr - pi * pi, ni = 2.f * pr * pi; pr = nr; pi = ni; }
            LAS unsigned char* col = lds + (dir * 128 + 2 * p) * 2;
            float hr = 0.f, hi = 0.f;
#pragma unroll 8
            for (int j = 0; j < 256; ++j) {
                LAS unsigned* cell = (LAS unsigned*)(col + (dir ? 255 - j : j) * PITCH);
                const unsigned e = *cell; *cell = pk2(hr, hi);
                const float er = bflo(e), ei = bfhi(e); const float nr = pr * hr - pi * hi + er, ni = pr * hi + pi * hr + ei; hr = nr; hi = ni;
            }
        }
        __syncthreads();
        bf16* dst = UC + (size_t)u.pm * 256 * 512 + 256;
#pragma unroll
        for (int i = 0; i < 16; ++i) { const int idx = tid + 512 * i, row = idx >> 5, ch = idx & 31;
            *(v4u*)(dst + (size_t)row * 512 + 8 * ch) = *(const LAS v4u*)(lds + row * PITCH + 16 * ch); }
        __syncthreads();
    }
};
__device__ __forceinline__ float gelu_t(float y) { const float u = 0.7978845608028654f * (y + 0.044715f * y * y * y); const float e = __builtin_amdgcn_exp2f(2.885390081777927f * u); const float th = 1.f - 2.f * __builtin_amdgcn_rcpf(e + 1.f); return 0.5f * y * (1.f + th); }
struct EpiS5Z {
    static constexpr bool PERM = true, AFTER_DRAIN = false;
    bf16* Z;
    __device__ __forceinline__ void operator()(const pg8::f32x4 (&acc)[2][2][4][2], const pg8::Unit& u, int wr, int wc, int fr, int fq) const {
        const int row0 = u.pm * 256 + wr * 64 + fr;
#pragma unroll
        for (int ai = 0; ai < 2; ++ai)
#pragma unroll
            for (int m = 0; m < 4; ++m) { const int row = row0 + ai * 128 + m * 16, g = row >> 10, J = row & 1023;
#pragma unroll
                for (int bj = 0; bj < 2; ++bj) { const int t = 8 * bj + 2 * wc + (fq >> 1), c0 = 8 * (fq & 1);
                    const pg8::f32x4 x = acc[ai][bj][m][0], y = acc[ai][bj][m][1];
                    v4u w; w.x = pk2(gelu_t(x[0]), gelu_t(x[1])); w.y = pk2(gelu_t(x[2]), gelu_t(x[3])); w.z = pk2(gelu_t(y[0]), gelu_t(y[1])); w.w = pk2(gelu_t(y[2]), gelu_t(y[3]));
                    *(v4u*)(Z + (size_t)(16 * J + t) * D + g * 16 + c0) = w; } }
    }
};
constexpr int NPHASE = 18;
__global__ void __launch_bounds__(NTHR, 2) mk_fwd(Args args) {
    extern __shared__ __attribute__((aligned(16))) unsigned char lds_raw[];
    Ctx C;
    C.lds = (LAS unsigned char*)lds_raw;
    C.tid = threadIdx.x; C.lane = C.tid & 63; C.wave = __builtin_amdgcn_readfirstlane(C.tid >> 6);
    C.G = gridDim.x; { const int bx = blockIdx.x; C.vcu = (C.G % 8 == 0) ? (bx % 8) * (C.G / 8) + bx / 8 : bx; }
    volatile LAS unsigned* MISC = (volatile LAS unsigned*)(C.lds + LDSCTL_OFF);
    for (int u = C.tid; u < (LDS_BYTES - LDSCTL_OFF) / 4; u += NTHR) ((LAS unsigned*)(C.lds + LDSCTL_OFF))[u] = 0u;
    __syncthreads();
    int lo = args.ph_lo, hi = args.ph_hi;
    unsigned char* ws = args.ws;
    asm volatile("" : "+s"(lo), "+s"(hi), "+s"(ws));
    unsigned* ctl = (unsigned*)(ws + WS_CTL);
    const bool one_launch = (lo == 0 && hi == NPHASE);
    XcdBarrier bar; bar.bar = ctl + CW_BAR; bar.x = 0; bar.st = nullptr;
    if (one_launch) bar = xcd_barrier_post(ctl + CW_BAR, MISC + 8);
    LAS unsigned char* glds = C.lds;
#ifndef MK_ONLY
#define MK_ONLY -1
#endif
#define IN(k) ((MK_ONLY < 0 || MK_ONLY == (k) || (MK_ONLY == 4 && (k) == 13) || (MK_ONLY == 5 && (k) == 14) || (MK_ONLY == 6 && (k) == 15) || (MK_ONLY == 7 && (k) == 16) || (MK_ONLY == 8 && (k) == 17)) && lo <= (k) && (k) < hi)
#ifndef MK_S5DUP
#define MK_S5DUP 0
#endif
#ifndef MK_DUP
#define MK_DUP 0
#endif
#define DUPBIT(k) ((MK_DUP >> ((k) < 13 ? (k) : (k) - 9)) & 1)
#define DUPX(k, ...) do { __VA_ARGS__ if (DUPBIT(k)) { __VA_ARGS__ } } while (0)
#define SEAM(k) do { if (IN(k) && IN((k) + 1)) xcd_barrier(bar); } while (0)

#ifdef MK_XBAR
    if (one_launch) for (int xb_ = 0; xb_ < MK_XBAR; ++xb_) xcd_barrier(bar);
#endif
    if (IN(0)) { DUPX(0, p0_prologue(C, args);); } SEAM(0);
    if (IN(1)) {
        const int G1 = (C.G == 256) ? 214 : C.G;
        if ((int)blockIdx.x < G1) {
            pg8::Gemm g{(const bf16*)(ws + WS_XN), (const bf16*)(ws + WS_WIN), D, nullptr, D, D}; pg8::DenseOrder So; So.init(T, INC, G1, (int)blockIdx.x);
            pg8::EpiProj E{(bf16*)(ws + WS_PROJ), (bf16*)(ws + WS_PROJ + 16 * MiB), args.in[7], args.in[8]};
            pg8::gemm_phase<pg8::EpiProj, pg8::DenseOrder, true, true>(glds, g, So, E);
            if (C.tid == 0) __hip_atomic_fetch_add((unsigned*)(ws + WS_CTL) + CW_P1DONE, 1u, __ATOMIC_RELAXED, __HIP_MEMORY_SCOPE_AGENT);
        } else conv_drain(C, args, true);
    } SEAM(1);
    if (IN(2)) {
 DUPX(2, {        for (int gq = C.vcu; gq < SG; gq += C.G) p_s5_pre(C, args, gq);
        conv_drain(C, args, false);
        for (int t = C.vcu; t < T / 32; t += C.G) conv_tile(C, args, t);
#ifdef MK_DUPCONV
        for (int t = C.vcu; t < T / 32; t += C.G) conv_tile(C, args, t);
#endif
        attn_phase(C, args);
    }); } SEAM(2);
    if (IN(3)) {
 DUPX(3, {        pg8::Gemm g{(const bf16*)(ws + WS_MIXED), (const bf16*)(ws + WS_WOUT), D, nullptr, D, D}; pg8::DenseOrder So; So.init(T, D, C.G, (int)blockIdx.x);
        pg8::EpiRes E{args.in[0], args.out};
        pg8::gemm_phase<pg8::EpiRes, pg8::DenseOrder, true, true>(glds, g, So, E);
    }); } SEAM(3);
#define MOE_PHASES(layer, pb) do { \
        if (IN(pb)) { DUPX(pb, p_router(C, args, layer);); } SEAM(pb); \
        if (IN(pb + 1)) { DUPX(pb + 1, p_topk(C, args);); } SEAM(pb + 1); \
        if (IN(pb + 2)) { DUPX(pb + 2, { \
            pg8::Gemm g{(const bf16*)(ws + WS_XN), (const bf16*)(ws + WS_WEXP + layer * WEXP_LAYER + WEXP_GU), D, (const int*)(ws + WS_IDX), D, D}; pg8::ExpertOrder So; So.init(8, C.G, (int)blockIdx.x); \
            pg8::EpiSwiGLU E{(bf16*)(ws + WS_H)}; \
            pg8::gemm_phase<pg8::EpiSwiGLU, pg8::ExpertOrder, true, true, true>(glds, g, So, E); \
        }); } SEAM(pb + 2); \
        if (IN(pb + 3)) { DUPX(pb + 3, { \
            pg8::Gemm g{(const bf16*)(ws + WS_H), (const bf16*)(ws + WS_WEXP + layer * WEXP_LAYER + WEXP_DN), EH, nullptr, EH, EH}; pg8::ExpertOrder So; So.init(4, C.G, (int)blockIdx.x); \
            pg8::EpiDown E{(bf16*)(ws + WS_PROJ), (const float*)(ws + WS_GATE)}; \
            pg8::gemm_phase<pg8::EpiDown, pg8::ExpertOrder, true, true>(glds, g, So, E); \
        }); } SEAM(pb + 3); \
        if (IN(pb + 4)) { DUPX(pb + 4, p_combine(C, args, layer == 0);); } \
    } while (0)
    MOE_PHASES(0, 4);
    SEAM(8);
    if (IN(9)) {
        int k9 = 256; asm volatile("" : "+s"(k9));
        pg8::Gemm g{(const bf16*)(ws + WS_UC), (const bf16*)(ws + WS_W16), k9, nullptr, 512, 256}; S5Order So; So.init(C.G, (int)blockIdx.x);
        EpiS5Scan E{(bf16*)(ws + WS_UC), args.in[11], args.in[12], args.in[13]};
        pg8::gemm_phase<EpiS5Scan, S5Order, false, true>(glds, g, So, E);
    }
    asm volatile("s_waitcnt vmcnt(0)" ::: "memory"); __syncthreads();
    if (IN(11)) {
        int k11 = 512; asm volatile("" : "+s"(k11));
        pg8::Gemm g{(const bf16*)(ws + WS_UC), (const bf16*)(ws + WS_TM), k11, nullptr, 512, 512}; S5Order So; So.init(C.G, (int)blockIdx.x);
        EpiS5Z E{(bf16*)(ws + WS_MIXED)};
        pg8::gemm_phase<EpiS5Z, S5Order, true, true>(glds, g, So, E);
#if MK_S5DUP == 11
        pg8::gemm_phase<EpiS5Z, S5Order, true, true>(glds, g, So, E);
#endif
    } SEAM(11);
    if (IN(12)) {
        pg8::Gemm g{(const bf16*)(ws + WS_MIXED), (const bf16*)(ws + WS_WGLU), D, nullptr, D, D}; pg8::DenseOrder So; So.init(T, 2 * D, C.G, (int)blockIdx.x);
        pg8::EpiGluRes E{(float*)(ws + WS_XB)};
        pg8::gemm_phase<pg8::EpiGluRes, pg8::DenseOrder, true, true>(glds, g, So, E);
    } SEAM(12);
    MOE_PHASES(1, 13);
#undef IN
#undef SEAM
}

#ifndef MK_PER_PHASE
#define MK_PER_PHASE 0
#endif
extern "C" void kernel_launch(void* const* d_in, const int* in_sizes, int n_in, void* d_out, int out_size, void* d_ws, size_t ws_size, hipStream_t stream) {
    static int grid = 0;
    if (grid == 0) {
        if (n_in != 26 || out_size != T * D || ws_size < WS_END) { fprintf(stderr, "kernel_launch: unexpected shapes (n_in %d out %d ws %zu)\n", n_in, out_size, ws_size); grid = -1; return; }
        int dev = 0, cus = 0, per_cu = 0;
        if (hipGetDevice(&dev) != hipSuccess || hipDeviceGetAttribute(&cus, hipDeviceAttributeMultiprocessorCount, dev) != hipSuccess) { grid = -1; return; }
        if (hipFuncSetAttribute((const void*)mk_fwd, hipFuncAttributeMaxDynamicSharedMemorySize, LDS_BYTES) != hipSuccess) { fprintf(stderr, "kernel_launch: hipFuncSetAttribute failed\n"); grid = -1; return; }
        if (hipOccupancyMaxActiveBlocksPerMultiprocessor(&per_cu, (const void*)mk_fwd, NTHR, LDS_BYTES) != hipSuccess || per_cu < 1) { fprintf(stderr, "kernel_launch: occupancy query says %d blocks per CU\n", per_cu); (void)hipGetLastError(); grid = -1; return; }
        grid = cus;
    }
    if (grid < 0) return;
    (void)hipMemsetAsync((char*)d_ws + WS_CTL, 0, CTL_ZERO_BYTES, stream);
    Args a{};
    for (int i = 0; i < 26; ++i) a.in[i] = (const float*)d_in[i];
    a.out = (float*)d_out; a.ws = (unsigned char*)d_ws;
#if MK_PER_PHASE
    for (int p = 0; p < NPHASE; ++p) { a.ph_lo = p; a.ph_hi = p + 1; hipLaunchKernelGGL(mk_fwd, dim3(grid), dim3(NTHR), LDS_BYTES, stream, a); }
#else
    a.ph_lo = 0; a.ph_hi = NPHASE;
    hipLaunchKernelGGL(mk_fwd, dim3(grid), dim3(NTHR), LDS_BYTES, stream, a);
#endif
}
```

```cpp
#include <hip/hip_runtime.h>
#include <cstdint>
#include <cstdio>

namespace pg8 {
#define PG8_LAS __attribute__((address_space(3)))
typedef unsigned short bf16_t;
typedef short bf16x8 __attribute__((ext_vector_type(8)));
typedef float f32x4 __attribute__((ext_vector_type(4)));
typedef unsigned u32x4 __attribute__((ext_vector_type(4)));
constexpr int BM = 256, BK = 64, HALF = 128, HTB = HALF * BK * 2  , STAGE_BYTES = 8 * HTB, NXCD = 8, WGM = 8;

__host__ __device__ __forceinline__ int lds_byte(int r, int c) { const int st = (r >> 4) * 2 + (c >> 5), rr = r & 15, cc = c & 31, ob = rr * 64 + cc * 2; return st * 1024 + (ob ^ (((ob >> 9) & 1) << 5)); }
__host__ __device__ __forceinline__ void stage_rc(int b, int& R, int& C) { const int st = b / 1024, sb = b % 1024, swz = sb ^ (((sb >> 9) & 1) << 5); R = (st >> 1) * 16 + swz / 64; C = (st & 1) * 32 + (swz % 64) / 2; }
__host__ __device__ __forceinline__ int perm32(int rho) { const int n = rho >> 4, i = rho & 15; return 8 * (i >> 2) + 4 * n + (i & 3); }

struct Unit { int pm, pn, pb; };
struct Gemm { const bf16_t* A; const bf16_t* Bt; int K; const int* gidx; int lda, ldb; };

struct DenseOrder {
    int nM, nN, nwg, G, c;
    __device__ void init(int M, int N, int G_, int c_) { nM = M / BM; nN = N / BM; nwg = nM * nN; G = G_; c = c_; }
    __device__ bool next(int i, Unit& u) const {
        const long L = (long)i * G + c; if (L >= nwg) return false;
        int wgid = (int)L; { const int q = nwg / NXCD, r = nwg % NXCD, xcd = wgid % NXCD, off = wgid / NXCD; wgid = (xcd < r ? xcd * (q + 1) : r * (q + 1) + (xcd - r) * q) + off; }
        const int nig = WGM * nN, gid = wgid / nig, fm = gid * WGM, gsz = (nM - fm) < WGM ? (nM - fm) : WGM;
        u.pm = fm + ((wgid % nig) % gsz); u.pn = (wgid % nig) / gsz; u.pb = u.pn; return true;
    }
    __device__ __forceinline__ void a_ready(const Unit&) const {}
    __device__ __forceinline__ void done(const Unit&) const {}
};
struct ExpertOrder {
    int nN, nun, G, c;
    __device__ void init(int nN_, int G_, int c_) { nN = nN_; nun = 128 * nN_; G = G_; c = c_; }
    __device__ bool next(int i, Unit& u) const {
        const long L = (long)i * G + c; if (L >= nun) return false;
        int V = (int)L;
        if (G == 256) {
            const int x = c & 7, j = c >> 3, upx = 32, rpe = (8 * nN) / upx;
            const int e_ = 8 * (i / rpe) + x, r_ = (i % rpe) * upx + j;
            V = e_ * 8 * nN + r_;
        }
        const int per = 8 * nN, e = V / per, r = V % per, pml = r / nN, pn = r % nN;
        u.pm = ((pml >> 1) * 16 + e) * 2 + (pml & 1); u.pn = pn; u.pb = e * nN + pn; return true;
    }
    __device__ __forceinline__ void a_ready(const Unit&) const {}
    __device__ __forceinline__ void done(const Unit&) const {}
};

typedef float f32x2 __attribute__((ext_vector_type(2)));
typedef __bf16 bf16x2_t __attribute__((ext_vector_type(2)));
__device__ __forceinline__ unsigned pk2(float lo, float hi) { f32x2 v = {lo, hi}; bf16x2_t b = __builtin_convertvector(v, bf16x2_t); return __builtin_bit_cast(unsigned, b); }
__device__ __forceinline__ float sigm(float x) { return __builtin_amdgcn_rcpf(1.f + __builtin_amdgcn_exp2f(-1.4426950408889634f * x)); }

constexpr float QSCALE = 0.125f * 1.4426950408889634f;
struct EpiProj {
    static constexpr bool PERM = true, AFTER_DRAIN = false;
    bf16_t *GLU, *Q; const float *qg, *kg;
    __device__ __forceinline__ void operator()(const f32x4 (&acc)[2][2][4][2], const Unit& u, int wr, int wc, int fr, int fq) const {
        const int row0 = u.pm * BM + wr * 64 + fr;
        if (u.pn < 4) {
            const int col0 = 128 * u.pn + 32 * wc + 8 * fq;
#pragma unroll
            for (int ai = 0; ai < 2; ++ai)
#pragma unroll
                for (int m = 0; m < 4; ++m) {
                    const f32x4 v0 = acc[ai][0][m][0], v1 = acc[ai][0][m][1], g0 = acc[ai][1][m][0], g1 = acc[ai][1][m][1];
                    u32x4 w; w.x = pk2(v0[0] * sigm(g0[0]), v0[1] * sigm(g0[1])); w.y = pk2(v0[2] * sigm(g0[2]), v0[3] * sigm(g0[3]));
                    w.z = pk2(v1[0] * sigm(g1[0]), v1[1] * sigm(g1[1])); w.w = pk2(v1[2] * sigm(g1[2]), v1[3] * sigm(g1[3]));
                    *(u32x4*)(GLU + (size_t)(row0 + ai * HALF + m * 16) * 512 + col0) = w;
                    asm volatile("" ::: "memory");
                }
        } else {
            const int t = (u.pn - 4) >> 1;
            const int hd = 4 * ((u.pn - 4) & 1) + wc;
            bf16_t* dst = Q + (size_t)t * (size_t)(8u << 20);
            const float* gp = (const float*)((uintptr_t)qg + (((uintptr_t)kg - (uintptr_t)qg) & (uintptr_t)(t == 0 ? 0 : ~(uintptr_t)0)));
#pragma unroll
            for (int ai = 0; ai < 2; ++ai)
#pragma unroll
                for (int m = 0; m < 4; ++m) {
                    float ss = 0.f;
#pragma unroll
                    for (int bj = 0; bj < 2; ++bj)
#pragma unroll
                        for (int n = 0; n < 2; ++n) { const f32x4 x = acc[ai][bj][m][n]; ss += (x[0] * x[0] + x[1] * x[1]) + (x[2] * x[2] + x[3] * x[3]); }
                    ss += __shfl_xor(ss, 16); ss += __shfl_xor(ss, 32);
                    float rs = 1.f;
                    if (t < 2) rs = rsqrtf(ss * (1.f / 64.f) + 1e-6f) * (t == 0 ? QSCALE : 1.f);
#pragma unroll
                    for (int bj = 0; bj < 2; ++bj) {
                        f32x4 g0 = {1.f, 1.f, 1.f, 1.f}, g1 = g0;
                        if (t < 2) { g0 = *(const f32x4*)(gp + 32 * bj + 8 * fq); g1 = *(const f32x4*)(gp + 32 * bj + 8 * fq + 4); }
                        const f32x4 a = acc[ai][bj][m][0] * g0 * rs, b = acc[ai][bj][m][1] * g1 * rs;
                        u32x4 w; w.x = pk2(a[0], a[1]); w.y = pk2(a[2], a[3]); w.z = pk2(b[0], b[1]); w.w = pk2(b[2], b[3]);
                        const int row = row0 + ai * HALF + m * 16;
                        *(u32x4*)(dst + ((size_t)((row >> 12) * 8 + hd) * 4096 + (row & 4095)) * 64 + 32 * bj + 8 * fq) = w;
                    }
                    asm volatile("" ::: "memory");
                }
        }
    }
};
struct EpiRes {
    static constexpr bool PERM = true, AFTER_DRAIN = false;
    const float* xin; bf16_t* X;
    __device__ __forceinline__ void operator()(const f32x4 (&acc)[2][2][4][2], const Unit& u, int wr, int wc, int fr, int fq) const {
        const int row0 = u.pm * BM + wr * 64 + fr, col0 = u.pn * BM + wc * 32 + 8 * fq;
#pragma unroll
        for (int ai = 0; ai < 2; ++ai)
#pragma unroll
            for (int m = 0; m < 4; ++m) { const size_t off = (size_t)(row0 + ai * HALF + m * 16) * 1024 + col0;
#pragma unroll
                for (int bj = 0; bj < 2; ++bj) { const f32x4 a = *(const f32x4*)(xin + off + bj * HALF) + acc[ai][bj][m][0], b = *(const f32x4*)(xin + off + bj * HALF + 4) + acc[ai][bj][m][1];
                    u32x4 w; w.x = pk2(a[0], a[1]); w.y = pk2(a[2], a[3]); w.z = pk2(b[0], b[1]); w.w = pk2(b[2], b[3]);
                    *(u32x4*)(X + off + bj * HALF) = w; } }
    }
};
struct EpiSwiGLU {
    static constexpr bool PERM = true, AFTER_DRAIN = false;
    bf16_t* H;
    __device__ __forceinline__ void operator()(const f32x4 (&acc)[2][2][4][2], const Unit& u, int wr, int wc, int fr, int fq) const {
        const int row0 = u.pm * BM + wr * 64 + fr, col0 = 128 * u.pn + 32 * wc + 8 * fq;
#pragma unroll
        for (int ai = 0; ai < 2; ++ai)
#pragma unroll
            for (int m = 0; m < 4; ++m) {
                const f32x4 g0 = acc[ai][0][m][0], g1 = acc[ai][0][m][1], u0 = acc[ai][1][m][0], u1 = acc[ai][1][m][1];
                u32x4 w; w.x = pk2(g0[0] * sigm(g0[0]) * u0[0], g0[1] * sigm(g0[1]) * u0[1]); w.y = pk2(g0[2] * sigm(g0[2]) * u0[2], g0[3] * sigm(g0[3]) * u0[3]);
                w.z = pk2(g1[0] * sigm(g1[0]) * u1[0], g1[1] * sigm(g1[1]) * u1[1]); w.w = pk2(g1[2] * sigm(g1[2]) * u1[2], g1[3] * sigm(g1[3]) * u1[3]);
                *(u32x4*)(H + (size_t)(row0 + ai * HALF + m * 16) * 1024 + col0) = w;
            }
    }
};
struct EpiDown {
    static constexpr bool PERM = true, AFTER_DRAIN = false;
    bf16_t* Y; const float* gate;
    __device__ __forceinline__ void operator()(const f32x4 (&acc)[2][2][4][2], const Unit& u, int wr, int wc, int fr, int fq) const {
        const int row0 = u.pm * BM + wr * 64 + fr, col0 = u.pn * BM + wc * 32 + 8 * fq;
#pragma unroll
        for (int ai = 0; ai < 2; ++ai)
#pragma unroll
            for (int m = 0; m < 4; ++m) { const int row = row0 + ai * HALF + m * 16; const float gs = gate[row];
#pragma unroll
                for (int bj = 0; bj < 2; ++bj) { const f32x4 a = acc[ai][bj][m][0] * gs, b = acc[ai][bj][m][1] * gs;
                    u32x4 w; w.x = pk2(a[0], a[1]); w.y = pk2(a[2], a[3]); w.z = pk2(b[0], b[1]); w.w = pk2(b[2], b[3]);
                    *(u32x4*)(Y + (size_t)row * 1024 + col0 + bj * HALF) = w; } }
    }
};
struct EpiGluRes {
    static constexpr bool PERM = true, AFTER_DRAIN = false;
    bf16_t* X;
    __device__ __forceinline__ void operator()(const f32x4 (&acc)[2][2][4][2], const Unit& u, int wr, int wc, int fr, int fq) const {
        const int row0 = u.pm * BM + wr * 64 + fr, col0 = 128 * u.pn + 32 * wc + 8 * fq;
#pragma unroll
        for (int ai = 0; ai < 2; ++ai)
#pragma unroll
            for (int m = 0; m < 4; ++m) { bf16_t* p = X + (size_t)(row0 + ai * HALF + m * 16) * 1024 + col0;
                const u32x4 o = *(const u32x4*)p; const f32x4 v0 = acc[ai][0][m][0], v1 = acc[ai][0][m][1], g0 = acc[ai][1][m][0], g1 = acc[ai][1][m][1];
                u32x4 w;
                w.x = pk2(__uint_as_float(o.x << 16) + v0[0] * sigm(g0[0]), __uint_as_float(o.x & 0xffff0000u) + v0[1] * sigm(g0[1]));
                w.y = pk2(__uint_as_float(o.y << 16) + v0[2] * sigm(g0[2]), __uint_as_float(o.y & 0xffff0000u) + v0[3] * sigm(g0[3]));
                w.z = pk2(__uint_as_float(o.z << 16) + v1[0] * sigm(g1[0]), __uint_as_float(o.z & 0xffff0000u) + v1[1] * sigm(g1[1]));
                w.w = pk2(__uint_as_float(o.w << 16) + v1[2] * sigm(g1[2]), __uint_as_float(o.w & 0xffff0000u) + v1[3] * sigm(g1[3]));
                *(u32x4*)p = w; }
    }
};

template <class Epi, class Sched, bool ALIGN_EPI = false, bool SP2 = false, bool GATHER = false>
__device__ __forceinline__ void gemm_phase(PG8_LAS unsigned char* lds, const Gemm g, const Sched& S, const Epi& E) {
    const int tid = threadIdx.x, wid = __builtin_amdgcn_readfirstlane(tid >> 6), lane = tid & 63, wr = wid >> 2, wc = wid & 3, fr = lane & 15, fq = lane >> 4;
    const int K = g.K, nt = K / BK;
    unsigned voffA[2], voffB[2];
#pragma unroll
    for (int i = 0; i < 2; ++i) { int R, C; stage_rc(tid * 16 + i * 8192, R, C); const int Rb = Epi::PERM ? ((R & ~31) + perm32(R & 31)) : R;
        voffA[i] = (unsigned)(R * g.lda + C) * 2u; voffB[i] = (unsigned)(Rb * g.ldb + C) * 2u; }
    const size_t kstep = (size_t)(BK * 2);
    const size_t hstepA = (size_t)HALF * g.lda * 2, hstepB = (size_t)HALF * g.ldb * 2;
    const size_t tstepA = 2 * hstepA, tstepB = 2 * hstepB;
    const unsigned ldsw = (unsigned)wid * 1024u;
    const int aoff = lds_byte(wr * 64 + fr, fq * 8), boff = lds_byte(wc * 32 + fr, fq * 8);
#define PG8_SA(b, h) (((b) * 2 + (h)) * HTB)
#define PG8_SB(b, h) ((4 + (b) * 2 + (h)) * HTB)
#define PG8_STAGE(bufoff, gbase, voff) do { _Pragma("unroll") for (int _i = 0; _i < 2; ++_i) \
        __builtin_amdgcn_global_load_lds((const unsigned*)((const char*)(gbase) + (voff)[_i]), (PG8_LAS unsigned*)(lds + (bufoff) + ldsw + _i * 8192), 16, 0, 0); } while (0)
#define PG8_STAGE_A(bufoff, gptr, h, nsel) do { if constexpr (GATHER) { const unsigned _o[2] = {(nsel) ? nOA[h][0] : oA[h][0], (nsel) ? nOA[h][1] : oA[h][1]}; PG8_STAGE(bufoff, gptr, _o); } \
        else { PG8_STAGE(bufoff, (gptr) + ((h) ? hstepA : 0), voffA); } } while (0)
#define PG8_GOFF(dst, u) do { if constexpr (GATHER) { _Pragma("unroll") for (int _h = 0; _h < 2; ++_h) _Pragma("unroll") for (int _i = 0; _i < 2; ++_i) { \
        (dst)[_h][_i] = (unsigned)g.gidx[(u).pm * BM + _h * HALF + gR[_i]] * (unsigned)(g.lda * 2) + gC[_i]; asm volatile("" : "+v"((dst)[_h][_i])); } } } while (0)
#define PG8_LDA(dst, b, h) do { _Pragma("unroll") for (int m = 0; m < 4; ++m) _Pragma("unroll") for (int k = 0; k < 2; ++k) dst[m][k] = *(const PG8_LAS bf16x8*)(lds + PG8_SA(b, h) + aoff + m * 2048 + k * 1024); } while (0)
#define PG8_LDB(dst, b, h) do { _Pragma("unroll") for (int n = 0; n < 2; ++n) _Pragma("unroll") for (int k = 0; k < 2; ++k) dst[n][k] = *(const PG8_LAS bf16x8*)(lds + PG8_SB(b, h) + boff + n * 2048 + k * 1024); } while (0)
#define PG8_MMA(ai, bj, At, Bt) do { __builtin_amdgcn_s_setprio(1); _Pragma("unroll") for (int m = 0; m < 4; ++m) _Pragma("unroll") for (int n = 0; n < 2; ++n) _Pragma("unroll") for (int k = 0; k < 2; ++k) \
        acc[ai][bj][m][n] = __builtin_amdgcn_mfma_f32_16x16x32_bf16(Bt[n][k], At[m][k], acc[ai][bj][m][n], 0, 0, 0); __builtin_amdgcn_s_setprio(0); } while (0)
#define PG8_WAIT_V(n) asm volatile("s_waitcnt vmcnt(" #n ")" ::: "memory")
#define PG8_WAIT_L(n) asm volatile("s_waitcnt lgkmcnt(" #n ")" ::: "memory")
#define PG8_BAR __builtin_amdgcn_s_barrier()
#define PG8_SCHED __builtin_amdgcn_sched_barrier(0)
    Unit cur, nxt; int ui = 0;
    if (!S.next(0, cur)) return;
    unsigned oA[2][2], nOA[2][2]; int gR[2]; unsigned gC[2];
    if constexpr (GATHER) { static_assert(SP2, "GATHER is wired into the SP2 loop only");
#pragma unroll
        for (int i = 0; i < 2; ++i) { int R, Cc; stage_rc(tid * 16 + i * 8192, R, Cc); gR[i] = R; gC[i] = (unsigned)Cc * 2u; } }
    PG8_GOFF(oA, cur);
    f32x4 acc[2][2][4][2];
#pragma unroll
    for (int a = 0; a < 2; ++a)
#pragma unroll
        for (int b = 0; b < 2; ++b)
#pragma unroll
            for (int m = 0; m < 4; ++m)
#pragma unroll
                for (int n = 0; n < 2; ++n) acc[a][b][m][n] = (f32x4){0.f, 0.f, 0.f, 0.f};
    bf16x8 At[4][2], B0[2][2], B1[2][2];
    const char* cA = (const char*)g.A + (GATHER ? (size_t)0 : (size_t)cur.pm * tstepA); const char* cB = (const char*)g.Bt + (size_t)cur.pb * tstepB;
    S.a_ready(cur);
    if constexpr (SP2) {
        PG8_STAGE(PG8_SB(0, 0), cB, voffB); PG8_STAGE(PG8_SB(0, 1), cB + hstepB, voffB); PG8_STAGE_A(PG8_SA(0, 0), cA, 0, false); PG8_STAGE_A(PG8_SA(0, 1), cA, 1, false);
        if (wr == 1) PG8_BAR;
        PG8_WAIT_V(2); PG8_BAR;
        PG8_STAGE(PG8_SB(1, 0), cB + kstep, voffB); PG8_STAGE_A(PG8_SA(1, 0), cA + kstep, 0, false); PG8_STAGE(PG8_SB(1, 1), cB + hstepB + kstep, voffB);
        PG8_WAIT_V(6); PG8_BAR;
    } else {
        PG8_STAGE(PG8_SB(0, 0), cB, voffB); PG8_STAGE(PG8_SA(0, 0), cA, voffA); PG8_STAGE(PG8_SB(0, 1), cB + hstepB, voffB); PG8_STAGE(PG8_SA(0, 1), cA + hstepA, voffA);
        if (wr == 1) PG8_BAR;
        PG8_WAIT_V(4); PG8_BAR;
        PG8_STAGE(PG8_SB(1, 0), cB + kstep, voffB); PG8_STAGE(PG8_SA(1, 0), cA + kstep, voffA); PG8_STAGE(PG8_SB(1, 1), cB + hstepB + kstep, voffB);
        PG8_WAIT_V(6); PG8_BAR;
    }
    for (;;) {
        const bool has_next = S.next(ui + 1, nxt);
        const char* nA = has_next ? (const char*)g.A + (GATHER ? (size_t)0 : (size_t)nxt.pm * tstepA) : cA; const char* nB = has_next ? (const char*)g.Bt + (size_t)nxt.pb * tstepB : cB;
        if constexpr (GATHER) { if (has_next) { PG8_GOFF(nOA, nxt); } else {
#pragma unroll
            for (int _h = 0; _h < 2; ++_h) { nOA[_h][0] = oA[_h][0]; nOA[_h][1] = oA[_h][1]; } } }
        for (int t = 0; t < nt; t += 2) {
            const bool last = (t == nt - 2);
            const char* a1 = cA + (size_t)(t + 1) * kstep;
            const char* a2 = last ? nA : cA + (size_t)(t + 2) * kstep; const char* b2 = last ? nB : cB + (size_t)(t + 2) * kstep;
            const char* a3 = a2 + kstep; const char* b3 = b2 + kstep;
            if (last && has_next) S.a_ready(nxt);
            if constexpr (SP2) {
            PG8_LDB(B0, 0, 0); PG8_LDB(B1, 0, 1); PG8_SCHED; PG8_LDA(At, 0, 0); PG8_STAGE_A(PG8_SA(1, 1), a1, 1, false);
            PG8_WAIT_V(8); PG8_WAIT_L(0); PG8_BAR; PG8_MMA(0, 0, At, B0); PG8_MMA(0, 1, At, B1); PG8_BAR; PG8_SCHED;
            PG8_LDA(At, 0, 1); PG8_STAGE(PG8_SB(0, 0), b2, voffB); PG8_STAGE(PG8_SB(0, 1), b2 + hstepB, voffB); PG8_STAGE_A(PG8_SA(0, 0), a2, 0, last);
            PG8_WAIT_V(8); PG8_WAIT_L(0); PG8_BAR; PG8_MMA(1, 0, At, B0); PG8_MMA(1, 1, At, B1); PG8_BAR; PG8_SCHED;
            PG8_LDB(B0, 1, 0); PG8_LDB(B1, 1, 1); PG8_SCHED; PG8_LDA(At, 1, 0); PG8_STAGE_A(PG8_SA(0, 1), a2, 1, last);
            PG8_WAIT_V(8); PG8_WAIT_L(0); PG8_BAR; PG8_MMA(0, 0, At, B0); PG8_MMA(0, 1, At, B1); PG8_BAR; PG8_SCHED;
            PG8_LDA(At, 1, 1); PG8_STAGE(PG8_SB(1, 0), b3, voffB); PG8_STAGE(PG8_SB(1, 1), b3 + hstepB, voffB); PG8_STAGE_A(PG8_SA(1, 0), a3, 0, last);
            PG8_WAIT_V(8); PG8_WAIT_L(0); PG8_BAR; PG8_MMA(1, 0, At, B0); PG8_MMA(1, 1, At, B1); PG8_BAR; PG8_SCHED;
            } else {
            PG8_LDB(B0, 0, 0); PG8_SCHED; PG8_LDA(At, 0, 0); PG8_STAGE(PG8_SA(1, 1), a1 + hstepA, voffA);
            PG8_WAIT_L(8); PG8_BAR; PG8_WAIT_L(0); PG8_MMA(0, 0, At, B0); PG8_BAR; PG8_SCHED;
            PG8_LDB(B1, 0, 1); PG8_STAGE(PG8_SB(0, 0), b2, voffB);
            PG8_BAR; PG8_WAIT_L(0); PG8_MMA(0, 1, At, B1); PG8_BAR;
            PG8_LDA(At, 0, 1); PG8_STAGE(PG8_SA(0, 0), a2, voffA);
            PG8_BAR; PG8_WAIT_L(0); PG8_MMA(1, 0, At, B0); PG8_BAR; PG8_SCHED;
            PG8_STAGE(PG8_SB(0, 1), b2 + hstepB, voffB);
            PG8_WAIT_V(6); PG8_BAR; PG8_MMA(1, 1, At, B1); PG8_BAR;
            PG8_LDB(B0, 1, 0); PG8_SCHED; PG8_LDA(At, 1, 0); PG8_STAGE(PG8_SA(0, 1), a2 + hstepA, voffA);
            PG8_WAIT_L(8); PG8_BAR; PG8_WAIT_L(0); PG8_MMA(0, 0, At, B0); PG8_BAR; PG8_SCHED;
            PG8_LDB(B1, 1, 1); PG8_STAGE(PG8_SB(1, 0), b3, voffB);
            PG8_BAR; PG8_WAIT_L(0); PG8_MMA(0, 1, At, B1); PG8_BAR;
            PG8_LDA(At, 1, 1); PG8_STAGE(PG8_SA(1, 0), a3, voffA);
            PG8_BAR; PG8_WAIT_L(0); PG8_MMA(1, 0, At, B0); PG8_BAR; PG8_SCHED;
            PG8_STAGE(PG8_SB(1, 1), b3 + hstepB, voffB);
            PG8_WAIT_V(6); PG8_BAR; PG8_MMA(1, 1, At, B1); PG8_BAR;
            }
        }
        if constexpr (ALIGN_EPI) { if (wr == 0) PG8_BAR; }
        if constexpr (!Epi::AFTER_DRAIN) { E(acc, cur, wr, wc, fr, fq); S.done(cur); }
        if (!has_next) break;
#pragma unroll
        for (int a = 0; a < 2; ++a)
#pragma unroll
            for (int b = 0; b < 2; ++b)
#pragma unroll
                for (int m = 0; m < 4; ++m)
#pragma unroll
                    for (int n = 0; n < 2; ++n) acc[a][b][m][n] = (f32x4){0.f, 0.f, 0.f, 0.f};
        cur = nxt; cA = nA; cB = nB; ++ui;
        if constexpr (GATHER) {
#pragma unroll
            for (int _h = 0; _h < 2; ++_h) { oA[_h][0] = nOA[_h][0]; oA[_h][1] = nOA[_h][1]; } }
        if constexpr (ALIGN_EPI) { if (wr == 1) PG8_BAR; }
    }
    PG8_WAIT_V(0);
    if constexpr (!ALIGN_EPI) { if (wr == 0) PG8_BAR; }
    PG8_BAR;
    if constexpr (Epi::AFTER_DRAIN) { E.fused(acc, cur, wr, wc, fr, fq, lds, wid, lane); S.done(cur); }
#undef PG8_SA
#undef PG8_SB
#undef PG8_STAGE
#undef PG8_LDA
#undef PG8_STAGE_A
#undef PG8_GOFF
#undef PG8_LDB
#undef PG8_MMA
#undef PG8_WAIT_V
#undef PG8_WAIT_L
#undef PG8_BAR
#undef PG8_SCHED
}
}

constexpr int NB = 4, S = 4096, D = 1024, T = NB * S;
constexpr int CONV_CH = 512, CONV_W = 31, NH = 8, INC = 2560;
constexpr int SG = 64, SC = 16, SP = 64;
constexpr int NE = 16, CAP = 512, EH = 1024, MR = NB * NE * CAP;
constexpr float EPS = 1e-6f;
constexpr int NWAVES = 8, NTHR = NWAVES * 64;

constexpr size_t MiB = 1u << 20;
constexpr size_t WS_CTL = 0, CTL_ZERO_BYTES = 64 * 1024;
constexpr size_t WS_AFF = 1 * MiB, WS_IDX = 2 * MiB, WS_GATE = 2 * MiB + 512 * 1024, WS_SLOT = 3 * MiB;
constexpr size_t WS_WIN = 4 * MiB, WS_WOUT = 10 * MiB, WS_WGLU = 12 * MiB;
constexpr size_t WS_WEXP = 16 * MiB, WEXP_LAYER = 96 * MiB, WEXP_GU = 0, WEXP_DN = 64 * MiB;
constexpr size_t WS_XN = 208 * MiB, WS_MIXED = 240 * MiB;
constexpr size_t WS_PROJ = 272 * MiB;
constexpr size_t WS_H = 336 * MiB;
constexpr size_t WS_XA = 404 * MiB, WS_XB = 436 * MiB;
constexpr size_t WS_END = 492 * MiB;
constexpr int CW_BAR = 1024, CW_Q0 = 64;

constexpr int SCRATCH_BYTES = 143360;
constexpr int LDSCTL_OFF = SCRATCH_BYTES;
constexpr int LDS_BYTES = 147456;

#define GAS __attribute__((address_space(1)))
#define LAS __attribute__((address_space(3)))
typedef unsigned short bf16;
typedef unsigned v4u __attribute__((ext_vector_type(4)));
typedef unsigned v2u __attribute__((ext_vector_type(2)));
typedef float f32x4 __attribute__((ext_vector_type(4)));
typedef float f32x2 __attribute__((ext_vector_type(2)));
using pg8::pk2;
using pg8::sigm;
__device__ __forceinline__ float bf2f(unsigned short h) { return __uint_as_float(((unsigned)h) << 16); }
__device__ __forceinline__ float bflo(unsigned w) { return __uint_as_float(w << 16); }
__device__ __forceinline__ float bfhi(unsigned w) { return __uint_as_float(w & 0xffff0000u); }
__device__ __forceinline__ float wave_sum(float v) {
#pragma unroll
    for (int o = 1; o < 64; o <<= 1) v += __shfl_xor(v, o);
    return v;
}

#define XB_TMO      128
#define XB_XCNT(j)  (256  + 64 * (j))
#define XB_XSUB(j)  (1280 + 64 * (j))
#define XB_XGEN(j)  (2304 + 64 * (j))
#define XB_TOP      3328
#define XB_TOPGEN   3392
#define XCD_BAR_WORDS 3456
#define XB_SPIN_CAP (1u << 18)
__device__ __forceinline__ unsigned xb_ld(unsigned* p)              { return __hip_atomic_load(p, __ATOMIC_RELAXED, __HIP_MEMORY_SCOPE_AGENT); }
__device__ __forceinline__ unsigned xb_add(unsigned* p, unsigned v) { return __hip_atomic_fetch_add(p, v, __ATOMIC_RELAXED, __HIP_MEMORY_SCOPE_AGENT); }
__device__ __forceinline__ unsigned xb_xcc_id() { return (unsigned)__builtin_amdgcn_s_getreg((3 << 11) | 20) & 0xFu; }
#define XB_SPIN(cond, bar) do { unsigned _sp = 0; while (cond) { __builtin_amdgcn_s_sleep(1); \
    if ((++_sp & 255u) == 0u) { if (xb_ld(&(bar)[XB_TMO])) break; if (_sp > XB_SPIN_CAP) { atomicAdd(&(bar)[XB_TMO], 1u); break; } } } } while (0)
struct XcdBarrier { unsigned* bar; unsigned x; volatile LAS unsigned* st; };
__device__ __forceinline__ XcdBarrier xcd_barrier_post(unsigned* bar, volatile LAS unsigned* st) {
    XcdBarrier b; b.bar = bar; b.x = xb_xcc_id(); b.st = st;
    if (threadIdx.x == 0) (void)xb_add(&bar[XB_XCNT(b.x)], 1u);
    return b;
}
__device__ __forceinline__ void xcd_barrier_complete(unsigned* bar, unsigned x, unsigned& nloc, unsigned& nx) {
    const unsigned G = gridDim.x * gridDim.y * gridDim.z;
    unsigned sum, cnt, mine, sp = 0u;
    for (;;) {
        sum = 0u; cnt = 0u; mine = 0u;
#pragma unroll
        for (unsigned j = 0; j < 16; ++j) { const unsigned c = xb_ld(&bar[XB_XCNT(j)]); sum += c; cnt += (c > 0u) ? 1u : 0u; mine = (j == x) ? c : mine; }
        if (sum == G) break;
        __builtin_amdgcn_s_sleep(1);
        if ((++sp & 255u) == 0u) { if (xb_ld(&bar[XB_TMO])) break; if (sp > XB_SPIN_CAP) { atomicAdd(&bar[XB_TMO], 1u); break; } }
    }
    nloc = mine > 0u ? mine : 1u; nx = cnt > 0u ? cnt : 1u;
}
__device__ __forceinline__ void xcd_barrier(const XcdBarrier& b) {
    asm volatile("s_waitcnt vmcnt(0)" ::: "memory");
    __syncthreads();
    if (threadIdx.x == 0) {
        unsigned* bar = b.bar;
        __builtin_amdgcn_s_waitcnt(0);
        unsigned nloc = b.st[0], nx = b.st[1];
        if (nloc == 0u) { xcd_barrier_complete(bar, b.x, nloc, nx); b.st[0] = nloc; b.st[1] = nx; }
        const unsigned old = xb_add(&bar[XB_XSUB(b.x)], 1u);
        const unsigned gen = old / nloc;
        if (old + 1u == (gen + 1u) * nloc) {
            __builtin_amdgcn_fence(__ATOMIC_RELEASE, "agent");
            asm volatile("s_waitcnt vmcnt(0)" ::: "memory");
            const unsigned og = xb_add(&bar[XB_TOP], 1u);
            const unsigned tg = og / nx;
            if (og + 1u == (tg + 1u) * nx) xb_add(&bar[XB_TOPGEN], 1u);
            else XB_SPIN(xb_ld(&bar[XB_TOPGEN]) == tg, bar);
            __builtin_amdgcn_fence(__ATOMIC_ACQUIRE, "agent");
            xb_add(&bar[XB_XGEN(b.x)], 1u);
            asm volatile("s_waitcnt vmcnt(0)" ::: "memory");
        } else {
            XB_SPIN(xb_ld(&bar[XB_XGEN(b.x)]) == gen, bar);
            __builtin_amdgcn_fence(__ATOMIC_ACQUIRE, "agent");
            asm volatile("s_waitcnt vmcnt(0)" ::: "memory");
        }
    }
    __syncthreads();
}

struct Args {
    const float* in[26]; float* out; unsigned char* ws; int ph_lo, ph_hi;
};
struct Ctx { LAS unsigned char* lds; int tid, lane, wave, vcu, G; };

__device__ __forceinline__ int rowmap(int kind, int half, int n) {
    if (kind == 0) {
        if (n < 1024) { const int hf = n >> 9, r = n & 511; return 256 * (r >> 7) + 128 * hf + (r & 127); }
        const int pn = n >> 8, w = n & 255, wc = w >> 6, bj = (w >> 5) & 1, j = w & 31; return 256 * pn + 128 * bj + 32 * wc + j;
    }
    if (kind == 2) { const int hf = n >> 10, r = n & 1023; return 256 * (r >> 7) + 128 * hf + (r & 127); }
    if (kind == 3) return 256 * (n >> 7) + 128 * half + (n & 127);
    return n;
}
struct ConvDesc { const float* src; bf16* dst; int N, kind, half, k0, n0; };
__device__ __forceinline__ bool conv_desc(const Args& a, int it, ConvDesc& d) {
    constexpr int I_IN = 16 * 40, I_OUT = 256, I_GLU = 16 * 32, I_EXP = 2 * 16 * 3 * 256;
    if (it >= I_IN + I_OUT + I_GLU + I_EXP) return false;
    unsigned char* ws = a.ws; int r = it, kb, nb;
    if (r < I_IN) { d.src = a.in[2]; d.N = INC; d.dst = (bf16*)(ws + WS_WIN); d.kind = 0; d.half = 0; kb = r / 40; nb = r % 40; }
    else if ((r -= I_IN) < I_OUT) { d.src = a.in[9]; d.N = D; d.dst = (bf16*)(ws + WS_WOUT); d.kind = 1; d.half = 0; kb = r >> 4; nb = r & 15; }
    else if ((r -= I_OUT) < I_GLU) { d.src = a.in[19]; d.N = 2 * D; d.dst = (bf16*)(ws + WS_WGLU); d.kind = 2; d.half = 0; kb = r >> 5; nb = r & 31; }
    else { r -= I_GLU; const int mat = r >> 8, tile = r & 255, layer = mat / 48, rem = mat % 48, e = rem / 3, which = rem % 3;
        d.src = a.in[23 + which] + ((size_t)layer * NE + e) * (size_t)D * EH; d.N = EH;
        d.dst = (bf16*)(ws + WS_WEXP + layer * WEXP_LAYER + (which == 2 ? WEXP_DN + (size_t)e * 2 * MiB : WEXP_GU + (size_t)e * 4 * MiB));
        d.kind = which == 2 ? 1 : 3; d.half = which; kb = tile >> 4; nb = tile & 15; }
    d.k0 = 64 * kb; d.n0 = 64 * nb; return true;
}
__device__ __forceinline__ void conv_load(const ConvDesc& d, f32x4 (&v)[16], int lane) {
    const float* p = d.src + (size_t)(d.k0 + (lane >> 4)) * d.N + d.n0 + 4 * (lane & 15);
#pragma unroll
    for (int it = 0; it < 16; ++it) v[it] = *(const f32x4*)(p + (size_t)(4 * it) * d.N);
}
__device__ __forceinline__ void conv_store(const ConvDesc& d, const f32x4 (&v)[16], LAS float* scr, int lane) {
#pragma unroll
    for (int it = 0; it < 16; ++it) { const int kk = 4 * it + (lane >> 4), nn = 4 * (lane & 15);
        scr[kk * 65 + nn] = v[it][0]; scr[kk * 65 + nn + 1] = v[it][1]; scr[kk * 65 + nn + 2] = v[it][2]; scr[kk * 65 + nn + 3] = v[it][3]; }
    asm volatile("s_waitcnt lgkmcnt(0)" ::: "memory");
    const int kc = lane & 7;
#pragma unroll
    for (int jt = 0; jt < 8; ++jt) {
        const int nl = 8 * jt + (lane >> 3);
        const LAS float* s = scr + (8 * kc) * 65 + nl;
        v4u o; o.x = pk2(s[0], s[65]); o.y = pk2(s[2 * 65], s[3 * 65]); o.z = pk2(s[4 * 65], s[5 * 65]); o.w = pk2(s[6 * 65], s[7 * 65]);
        *(v4u*)(d.dst + (size_t)rowmap(d.kind, d.half, d.n0 + nl) * 1024 + d.k0 + 8 * kc) = o;
    }
    asm volatile("s_waitcnt lgkmcnt(0)" ::: "memory");
}
__device__ __forceinline__ void rms_row_bf16(const float* __restrict__ xrow, const float* __restrict__ g, bf16* __restrict__ orow, int lane) {
    const f32x4* xr = (const f32x4*)xrow + lane;
    f32x4 v[4]; float s = 0.f;
#pragma unroll
    for (int j = 0; j < 4; ++j) { v[j] = xr[64 * j]; s += (v[j][0] * v[j][0] + v[j][1] * v[j][1]) + (v[j][2] * v[j][2] + v[j][3] * v[j][3]); }
    const float r = rsqrtf(wave_sum(s) * (1.f / D) + EPS);
#pragma unroll
    for (int j = 0; j < 4; ++j) { const f32x4 w = ((const f32x4*)g)[lane + 64 * j]; v2u o; o.x = pk2(v[j][0] * r * w[0], v[j][1] * r * w[1]); o.y = pk2(v[j][2] * r * w[2], v[j][3] * r * w[3]); ((v2u*)orow)[lane + 64 * j] = o; }
}
constexpr int CONV_NITEMS = 25984, CONV_FIRST_Q = 640, CW_P1DONE = 128;
__device__ __forceinline__ void conv_drain(const Ctx& C, const Args& a, bool until_flag) {
    LAS float* scr = (LAS float*)(C.lds + C.wave * 16640);
    unsigned* ctl = (unsigned*)(a.ws + WS_CTL);
    LAS int* qs = (LAS int*)(C.lds + 8 * 16640);
    ConvDesc dA; f32x4 vA[16];
    for (;;) {
        if (C.tid == 0) {
            int v = -1;
            if (!(until_flag && __hip_atomic_load(ctl + CW_P1DONE, __ATOMIC_RELAXED, __HIP_MEMORY_SCOPE_AGENT) != 0u))
                v = CONV_FIRST_Q + (int)__hip_atomic_fetch_add(ctl + CW_Q0, 8u, __ATOMIC_RELAXED, __HIP_MEMORY_SCOPE_AGENT);
            qs[0] = v;
        }
        __syncthreads();
        const int base = qs[0];
        __syncthreads();
        if (base < 0 || base >= CONV_NITEMS) break;
        if (conv_desc(a, base + C.wave, dA)) { conv_load(dA, vA, C.lane); conv_store(dA, vA, scr, C.lane); }
    }
}
__device__ __forceinline__ void p0_prologue(const Ctx& C, const Args& a) {
    LAS float* scr = (LAS float*)(C.lds + C.wave * 16640);
    const int gw = C.vcu * NWAVES + C.wave, NGW = C.G * NWAVES;
    unsigned char* ws = a.ws;
    {
        const float* x = a.in[0]; const float* gg = a.in[1]; bf16* XN = (bf16*)(ws + WS_XN); const int lane = C.lane;
        auto LOADR = [&](f32x4 (&v)[4], int m) __attribute__((always_inline)) { const f32x4* xr = (const f32x4*)(x + (size_t)m * D) + lane;
#pragma unroll
            for (int j = 0; j < 4; ++j) v[j] = xr[64 * j]; };
        auto PROC = [&](const f32x4 (&v)[4], int m) __attribute__((always_inline)) { float s = 0.f;
#pragma unroll
            for (int j = 0; j < 4; ++j) s += (v[j][0] * v[j][0] + v[j][1] * v[j][1]) + (v[j][2] * v[j][2] + v[j][3] * v[j][3]);
            const float r = rsqrtf(wave_sum(s) * (1.f / D) + EPS);
#pragma unroll
            for (int j = 0; j < 4; ++j) { const f32x4 w = ((const f32x4*)gg)[lane + 64 * j]; v2u o; o.x = pk2(v[j][0] * r * w[0], v[j][1] * r * w[1]); o.y = pk2(v[j][2] * r * w[2], v[j][3] * r * w[3]); ((v2u*)(XN + (size_t)m * D))[lane + 64 * j] = o; } };
        f32x4 va[4], vb[4]; int m = gw;
        if (m < T) LOADR(va, m);
        for (; m < T; m += 2 * NGW) { if (m + NGW < T) LOADR(vb, m + NGW); PROC(va, m); if (m + 2 * NGW < T) LOADR(va, m + 2 * NGW); if (m + NGW < T) PROC(vb, m + NGW); }
    }
    ConvDesc dA; f32x4 vA[16];
    for (int it = gw; it < CONV_FIRST_Q; it += NGW) if (conv_desc(a, it, dA)) { conv_load(dA, vA, C.lane); conv_store(dA, vA, scr, C.lane); }
}

__device__ __forceinline__ void conv_phase(const Ctx& C, const Args& a) {
    const bf16* GLU = (const bf16*)(a.ws + WS_PROJ);
    bf16* MIXED = (bf16*)(a.ws + WS_MIXED);
    const float* cw = a.in[3]; const float* cb = a.in[4]; const float* lg = a.in[5]; const float* lb = a.in[6];
    LAS float* tl = (LAS float*)C.lds;
    const int cp = C.tid & 255, th = C.tid >> 8, lane = C.lane, wave = C.wave;
    f32x2 w[CONV_W];
#pragma unroll
    for (int j = 0; j < CONV_W; ++j) w[j] = *(const f32x2*)(cw + j * CONV_CH + 2 * cp);
    const f32x2 bias = *(const f32x2*)(cb + 2 * cp);
    auto LOADT = [&](unsigned (&xin)[46], int tile) __attribute__((always_inline)) {
        const int b = tile / (S / 32), s0 = (tile % (S / 32)) * 32;
#pragma unroll
        for (int i = 0; i < 46; ++i) { const int ss = s0 + 16 * th - 15 + i; xin[i] = (ss >= 0 && ss < S) ? *(const unsigned*)(GLU + (size_t)(b * S + ss) * 512 + 2 * cp) : 0u; } };
    auto PROC = [&](const unsigned (&xin)[46], unsigned (&xn)[46], int tile, int nt) __attribute__((always_inline)) {
        const int b = tile / (S / 32), s0 = (tile % (S / 32)) * 32;
        f32x2 acc[16];
#pragma unroll
        for (int k = 0; k < 16; ++k) acc[k] = bias;
#pragma unroll
        for (int i = 0; i < 46; ++i) {
            unsigned xi = xin[i]; asm volatile("" : "+v"(xi));
            const f32x2 x = {bflo(xi), bfhi(xi)};
#pragma unroll
            for (int k = 0; k < 16; ++k) { const int j = i - k; if (j >= 0 && j < CONV_W) acc[k] += w[j] * x; }
        }
        if (nt < T / 32) LOADT(xn, nt);
#pragma unroll
        for (int k = 0; k < 16; ++k) *(LAS f32x2*)(tl + (16 * th + k) * 512 + 2 * cp) = acc[k];
        __syncthreads();
#pragma unroll
        for (int q = 0; q < 4; ++q) {
            const int tok = 4 * wave + q;
            const f32x4 v0 = *(const LAS f32x4*)(tl + tok * 512 + 8 * lane), v1 = *(const LAS f32x4*)(tl + tok * 512 + 8 * lane + 4);
            const float mu = wave_sum((v0[0] + v0[1]) + (v0[2] + v0[3]) + (v1[0] + v1[1]) + (v1[2] + v1[3])) * (1.f / CONV_CH);
            const f32x4 d0 = v0 - mu, d1 = v1 - mu;
            const float var = wave_sum((d0[0] * d0[0] + d0[1] * d0[1]) + (d0[2] * d0[2] + d0[3] * d0[3]) + (d1[0] * d1[0] + d1[1] * d1[1]) + (d1[2] * d1[2] + d1[3] * d1[3])) * (1.f / CONV_CH);
            const float rs = rsqrtf(var + EPS);
            const f32x4 g0 = *(const f32x4*)(lg + 8 * lane), g1 = *(const f32x4*)(lg + 8 * lane + 4), b0 = *(const f32x4*)(lb + 8 * lane), b1 = *(const f32x4*)(lb + 8 * lane + 4);
            f32x4 y0 = d0 * rs * g0 + b0, y1 = d1 * rs * g1 + b1;
#pragma unroll
            for (int e = 0; e < 4; ++e) { y0[e] = y0[e] * sigm(y0[e]); y1[e] = y1[e] * sigm(y1[e]); }
            v4u o; o.x = pk2(y0[0], y0[1]); o.y = pk2(y0[2], y0[3]); o.z = pk2(y1[0], y1[1]); o.w = pk2(y1[2], y1[3]);
            *(v4u*)(MIXED + (size_t)(b * S + s0 + tok) * D + 8 * lane) = o;
        }
        __syncthreads();
    };
    unsigned xa[46];
    int t = C.vcu;
    if (t < T / 32) LOADT(xa, t);
#pragma unroll 1
    for (; t < T / 32; t += C.G) PROC(xa, xa, t, t + C.G);
}
typedef short bf16x8 __attribute__((ext_vector_type(8)));
typedef short s16x4 __attribute__((ext_vector_type(4)));
typedef short v4i16_t __attribute__((ext_vector_type(4)));
typedef float f32x16 __attribute__((ext_vector_type(16)));
constexpr int AT_O = 0, AT_L = 65536, AT_V = 66560;
__device__ __forceinline__ s16x4 vtr(const LAS char* p) { return __builtin_bit_cast(s16x4, __builtin_amdgcn_ds_read_tr16_b64_v4i16((LAS v4i16_t*)p)); }
__device__ __forceinline__ void lds_addf(LAS float* p, float v) { (void)__hip_atomic_fetch_add(p, v, __ATOMIC_RELAXED, __HIP_MEMORY_SCOPE_WORKGROUP); }
__device__ __forceinline__ int med3i(int x, int lo, int hi) { return x < lo ? lo : (x > hi ? hi : x); }
__device__ __forceinline__ void attn_unit(const Ctx& C, const bf16* __restrict__ Qh, const bf16* __restrict__ Kh, const bf16* __restrict__ Vh,
                                          int d, int tq0, int nq, int tl0, int tls, float a2, float bound2, LAS float* Oacc, LAS float* Lacc, LAS char* vst, bool first) {
    int lane_ = C.lane; asm volatile("" : "+v"(lane_));
    const int lane = lane_, r = lane & 31, hh = lane >> 5;
    const int qi = r < nq ? r : nq - 1;
    bf16x8 qf[4]; v4u ks_[2][4], vs[2][4];
    const char* Kc = (const char*)Kh; const char* Vc = (const char*)Vh;
#define AT_LOADK(kb) do { _Pragma("unroll") for (int it = 0; it < 4; ++it) { const int key = (lane >> 3) + 8 * it; \
        const unsigned ro = (unsigned)med3i(tq0 + d * (32 * (kb) + key - 64), 0, S - 1) * 128u + 16u * (lane & 7); ks_[(kb) % 2][it] = *(const v4u*)(Kc + ro); } } while (0)
#define AT_LOADV(kb) do { _Pragma("unroll") for (int it = 0; it < 4; ++it) { const int key = (lane >> 3) + 8 * it; \
        const unsigned ro = (unsigned)med3i(tq0 + d * (32 * (kb) + key - 64), 0, S - 1) * 128u + 16u * (lane & 7); vs[(kb) % 2][it] = *(const v4u*)(Vc + ro); } } while (0)
    { const char* qp = (const char*)Qh + (unsigned)(tq0 + d * qi) * 128u + 16u * hh;
#pragma unroll
      for (int ks = 0; ks < 4; ++ks) qf[ks] = *(const bf16x8*)(qp + 32 * ks); }
    AT_LOADK(0); AT_LOADV(0);
    f32x16 o0, o1;
#pragma unroll
    for (int v = 0; v < 16; ++v) { o0[v] = 0.f; o1[v] = 0.f; }
    float lsum = 0.f;
    LAS char* kst = vst, *vt = vst + 4096;
    const LAS char* vb = vt + ((lane >> 4) & 1) * 32 + (lane & 3) * 8 + (4 * hh + ((lane & 15) >> 2)) * 64;
    LAS char* vw = vt + ((lane & 7) >> 2) * 2048 + ((lane >> 3) & 15) * 64 + (lane & 3) * 16;
    LAS char* kw = kst + (lane >> 3) * 128;
    const LAS char* kr = kst + r * 128;
    const int rsw = (r >> 1) & 7;
#pragma unroll
    for (int kb = 0; kb < 5; ++kb) {
        if (kb + 1 < 5) { AT_LOADK(kb + 1); AT_LOADV(kb + 1); }
#pragma unroll
        for (int it = 0; it < 4; ++it) { const int key = (lane >> 3) + 8 * it;
            *(LAS v4u*)(kw + it * 1024 + (((lane & 7) ^ ((key >> 1) & 7)) << 4)) = ks_[kb % 2][it]; }
        f32x16 p;
        int relb = 32 * kb - 64 - r + 4 * hh; const int kposb = tq0 + d * (32 * kb - 64 + 4 * hh);
        asm volatile("" : "+v"(relb));
#pragma unroll
        for (int v = 0; v < 16; ++v) {
            const int rw = (v & 3) + 8 * (v >> 2), rel = relb + rw, kpos = kposb + d * rw;
            bool valid = ((unsigned)kpos < (unsigned)S) && (r < nq);
            if (kb == 0) valid = valid && (rel >= -64);
            if (kb == 4) valid = valid && (rel <= 64);
            p[v] = valid ? -(a2 * fabsf((float)rel)) - bound2 : -1e30f;
        }
        asm volatile("s_waitcnt lgkmcnt(0)" ::: "memory");
        bf16x8 kf[4];
#pragma unroll
        for (int ks = 0; ks < 4; ++ks) kf[ks] = *(const LAS bf16x8*)(kr + (((2 * ks + hh) ^ rsw) << 4));
#pragma unroll
        for (int ks = 0; ks < 4; ++ks) p = __builtin_amdgcn_mfma_f32_32x32x16_bf16(kf[ks], qf[ks], p, 0, 0, 0);
#pragma unroll
        for (int it = 0; it < 4; ++it) *(LAS v4u*)(vw + (it >> 1) * 1024 + (it & 1) * 512) = vs[kb % 2][it];
#pragma unroll
        for (int v = 0; v < 16; ++v) { p[v] = __builtin_amdgcn_exp2f(p[v]); lsum += p[v]; }
        v4u pw0, pw1;
        pw0.x = pk2(p[0], p[1]); pw0.y = pk2(p[2], p[3]); pw0.z = pk2(p[4], p[5]); pw0.w = pk2(p[6], p[7]);
        pw1.x = pk2(p[8], p[9]); pw1.y = pk2(p[10], p[11]); pw1.z = pk2(p[12], p[13]); pw1.w = pk2(p[14], p[15]);
        asm volatile("s_waitcnt lgkmcnt(0)" ::: "memory");
#pragma unroll
        for (int sdh = 0; sdh < 4; ++sdh) {
            const int dh = sdh >> 1, ss = sdh & 1;
            const s16x4 lo = vtr(vb + dh * 2048 + ss * 1024), hi = vtr(vb + dh * 2048 + ss * 1024 + 512);
            const bf16x8 vf = {lo[0], lo[1], lo[2], lo[3], hi[0], hi[1], hi[2], hi[3]};
            const bf16x8 pa = __builtin_bit_cast(bf16x8, ss == 0 ? pw0 : pw1);
            if (dh == 0) o0 = __builtin_amdgcn_mfma_f32_32x32x16_bf16(pa, vf, o0, 0, 0, 0);
            else o1 = __builtin_amdgcn_mfma_f32_32x32x16_bf16(pa, vf, o1, 0, 0, 0);
        }
        asm volatile("s_waitcnt lgkmcnt(0)" ::: "memory");
    }
#undef AT_LOADK
#undef AT_LOADV
    lsum += __shfl_xor(lsum, 32);
    if (lane < nq) { LAS float* lp = Lacc + tl0 + tls * lane; *lp = first ? lsum : *lp + lsum; }
#pragma unroll
    for (int v = 0; v < 16; ++v) {
        const int iq = (v & 3) + 8 * (v >> 2) + 4 * hh;
        if (v < 8 || nq == 32) { LAS float* op = Oacc + (tl0 + tls * iq) * 64 + r;
            if (first) { op[0] = o0[v]; op[32] = o1[v]; } else { const float x0 = op[0], x1 = op[32]; op[0] = x0 + o0[v]; op[32] = x1 + o1[v]; } }
    }
}
__device__ __forceinline__ void attn_phase(const Ctx& C, const Args& a) {
    const bf16* Q = (const bf16*)(a.ws + WS_PROJ + 16 * MiB);
    const bf16* K = (const bf16*)(a.ws + WS_PROJ + 32 * MiB);
    const bf16* V = (const bf16*)(a.ws + WS_PROJ + 48 * MiB);
    bf16* MIXED = (bf16*)(a.ws + WS_MIXED);
    LAS float* Oacc = (LAS float*)(C.lds + AT_O); LAS float* Lacc = (LAS float*)(C.lds + AT_L); LAS char* vst = (LAS char*)(C.lds + AT_V + C.wave * 8192);
    float mq = fabsf(a.in[7][C.lane]), mk = fabsf(a.in[8][C.lane]);
#pragma unroll
    for (int o = 1; o < 64; o <<= 1) { mq = fmaxf(mq, __shfl_xor(mq, o)); mk = fmaxf(mk, __shfl_xor(mk, o)); }
    const float bound2 = 64.f * pg8::QSCALE * mq * mk * 1.01f;
    for (int item = C.vcu; item < NB * NH * 16; item += C.G) {
        const int span = item & 15, h = (item >> 4) & 7, b = item >> 7, t0 = span * 256, w = C.wave;
        const size_t hb = (size_t)(b * NH + h) * S * 64;
        const bf16 *Qh = Q + hb, *Kh = K + hb, *Vh = V + hb;
        const float slope2 = exp2f(-(float)(h + 1)) * 1.4426950408889634f;
#pragma unroll 1
        for (int un = 0; un < 4; ++un) {
            const int d = un == 0 ? 1 : (un == 1 ? 4 : 16);
            const int tl0 = un == 0 ? 32 * w : (un == 1 ? (w >> 1) + 128 * (w & 1) : 2 * w + (un - 2));
            attn_unit(C, Qh, Kh, Vh, d, t0 + tl0, un < 2 ? 32 : 16, tl0, d, slope2 * (float)d, bound2, Oacc, Lacc, vst, un == 0);
            if (un < 2) __syncthreads();
        }
        __syncthreads();
        {
            const int q = C.tid >> 1, hf = C.tid & 1;
            const float inv = 1.f / Lacc[q];
            const LAS f32x4* op = (const LAS f32x4*)(Oacc + q * 64 + 32 * hf);
            bf16* dst = MIXED + (size_t)(b * S + t0 + q) * D + 512 + h * 64 + 32 * hf;
#pragma unroll
            for (int j = 0; j < 4; ++j) { const f32x4 x0 = op[2 * j] * inv, x1 = op[2 * j + 1] * inv; v4u o; o.x = pk2(x0[0], x0[1]); o.y = pk2(x0[2], x0[3]); o.z = pk2(x1[0], x1[1]); o.w = pk2(x1[2], x1[3]); *(v4u*)(dst + 8 * j) = o; }
        }
        __syncthreads();
    }
}

__device__ __forceinline__ void p_router(const Ctx& C, const Args& a, int layer) {
    const bf16* X = (const bf16*)(a.ws + (layer == 0 ? WS_XA : WS_XB)); const float* g = a.in[20] + (size_t)layer * D;
    const float* wr = a.in[21] + (size_t)layer * D * NE; const float* br = a.in[22] + layer * NE;
    bf16* XN = (bf16*)(a.ws + WS_XN); float* AFF = (float*)(a.ws + WS_AFF);
    LAS float* wl = (LAS float*)C.lds;
    for (int i = C.tid; i < D * 4; i += NTHR) { const int k = i >> 2, qd = i & 3; const f32x4 v = *(const f32x4*)(wr + (size_t)k * NE + 4 * qd);
        const int slot = (k & 15) * 64 + (k >> 4); *(LAS f32x4*)(wl + slot * 20 + 4 * qd) = v; }
    __syncthreads();
    const int gw = C.vcu * NWAVES + C.wave, NGW = C.G * NWAVES, lane = C.lane;
    auto LOADR = [&](v4u (&v)[2], int m) __attribute__((always_inline)) { const v4u* xr = (const v4u*)(X + (size_t)m * D) + 2 * lane; v[0] = xr[0]; v[1] = xr[1]; };
    auto PROC = [&](const v4u (&vr)[2], int m) __attribute__((always_inline)) {
        f32x4 v[4];
        v[0] = (f32x4){bflo(vr[0].x), bfhi(vr[0].x), bflo(vr[0].y), bfhi(vr[0].y)}; v[1] = (f32x4){bflo(vr[0].z), bfhi(vr[0].z), bflo(vr[0].w), bfhi(vr[0].w)};
        v[2] = (f32x4){bflo(vr[1].x), bfhi(vr[1].x), bflo(vr[1].y), bfhi(vr[1].y)}; v[3] = (f32x4){bflo(vr[1].z), bfhi(vr[1].z), bflo(vr[1].w), bfhi(vr[1].w)};
        float s = 0.f;
#pragma unroll
        for (int j = 0; j < 4; ++j) s += (v[j][0] * v[j][0] + v[j][1] * v[j][1]) + (v[j][2] * v[j][2] + v[j][3] * v[j][3]);
        const float r = rsqrtf(wave_sum(s) * (1.f / D) + EPS);
        float acc[NE];
#pragma unroll
        for (int e = 0; e < NE; ++e) acc[e] = 0.f;
#pragma unroll
        for (int j = 0; j < 4; ++j) {
            const f32x4 w = ((const f32x4*)g)[4 * lane + j];
            const f32x4 hv = v[j] * w * r;
            v2u o; o.x = pk2(hv[0], hv[1]); o.y = pk2(hv[2], hv[3]); ((v2u*)(XN + (size_t)m * D))[4 * lane + j] = o;
#pragma unroll
            for (int i = 0; i < 4; ++i) {
                const LAS float* wp = wl + ((j * 4 + i) * 64 + lane) * 20;
#pragma unroll
                for (int qd = 0; qd < 4; ++qd) { const f32x4 ww = *(const LAS f32x4*)(wp + 4 * qd); acc[4 * qd] += hv[i] * ww[0]; acc[4 * qd + 1] += hv[i] * ww[1]; acc[4 * qd + 2] += hv[i] * ww[2]; acc[4 * qd + 3] += hv[i] * ww[3]; }
                if (i & 1) asm volatile("" ::: "memory");
            }
        }
#pragma unroll
        for (int i = 0; i < 8; ++i) { const bool up = lane & 32; const float keep = up ? acc[i + 8] : acc[i], give = up ? acc[i] : acc[i + 8]; acc[i] = keep + __shfl_xor(give, 32); }
#pragma unroll
        for (int i = 0; i < 4; ++i) { const bool up = lane & 16; const float keep = up ? acc[i + 4] : acc[i], give = up ? acc[i] : acc[i + 4]; acc[i] = keep + __shfl_xor(give, 16); }
#pragma unroll
        for (int i = 0; i < 2; ++i) { const bool up = lane & 8; const float keep = up ? acc[i + 2] : acc[i], give = up ? acc[i] : acc[i + 2]; acc[i] = keep + __shfl_xor(give, 8); }
        { const bool up = lane & 4; const float keep = up ? acc[1] : acc[0], give = up ? acc[0] : acc[1]; acc[0] = keep + __shfl_xor(give, 4); }
        float lg = acc[0]; lg += __shfl_xor(lg, 2); lg += __shfl_xor(lg, 1);
        const int e = ((lane >> 5) & 1) * 8 + ((lane >> 4) & 1) * 4 + ((lane >> 3) & 1) * 2 + ((lane >> 2) & 1);
        lg += br[e];
        float mx = lg;
#pragma unroll
        for (int o = 4; o < 64; o <<= 1) mx = fmaxf(mx, __shfl_xor(mx, o));
        const float ex = __expf(lg - mx); float sum = ex;
#pragma unroll
        for (int o = 4; o < 64; o <<= 1) sum += __shfl_xor(sum, o);
        const int b = m / S, ss = m % S;
        if ((lane & 3) == 0) AFF[((size_t)b * NE + e) * S + ss] = ex / sum;
    };
    v4u va[2], vb[2];
    int m = gw;
    if (m < T) LOADR(va, m);
    for (; m < T; m += 2 * NGW) {
        if (m + NGW < T) LOADR(vb, m + NGW);
        PROC(va, m);
        if (m + 2 * NGW < T) LOADR(va, m + 2 * NGW);
        if (m + NGW < T) PROC(vb, m + NGW);
    }
    __syncthreads();
}

__device__ __forceinline__ int popc64(unsigned long long m) { return __builtin_popcountll(m); }
__device__ __forceinline__ void p_topk(const Ctx& C, const Args& a) {
    const float* AFF = (const float*)(a.ws + WS_AFF);
    int* IDX = (int*)(a.ws + WS_IDX); float* GATE = (float*)(a.ws + WS_GATE); int* SLOT = (int*)(a.ws + WS_SLOT);
    const int lane = C.lane, w = C.wave;
    for (int item = C.vcu; item < NB * NE * 4; item += C.G) {
        const int be = item >> 2, qt = item & 3, b = be / NE, e = be % NE;
        unsigned key[16][4];
#pragma unroll
        for (int j = 0; j < 16; ++j) { const v4u k = *(const v4u*)(AFF + (size_t)be * S + 256 * j + 4 * lane); key[j][0] = k.x; key[j][1] = k.y; key[j][2] = k.z; key[j][3] = k.w; }
        unsigned cur = 0u;
        LAS unsigned* curw = (LAS unsigned*)C.lds;
        if (w == 0) {
#pragma unroll 1
        for (int bit = 30; bit >= 0; --bit) {
            const unsigned cand = cur | (1u << bit);
            unsigned c4[4] = {0u, 0u, 0u, 0u};
#pragma unroll
            for (int j = 0; j < 16; ++j)
#pragma unroll
                for (int i = 0; i < 4; ++i) c4[i] += (key[j][i] >= cand) ? 1u : 0u;
            const unsigned c = (c4[0] + c4[1]) + (c4[2] + c4[3]);
            int cnt = 0;
#pragma unroll
            for (int k = 0; k < 7; ++k) cnt += popc64(__ballot((c >> k) & 1u)) << k;
            if (cnt >= CAP) cur = cand;
        }
        if (lane == 0) curw[0] = cur;
        }
        __syncthreads();
        cur = curw[0];
        __syncthreads();
        const int jj = 4 * qt + (w >> 1);
        unsigned cga = 0, pre = 0; unsigned kk[4] = {0u, 0u, 0u, 0u};
#pragma unroll
        for (int j = 0; j < 16; ++j) {
            unsigned cg = 0, ce = 0;
#pragma unroll
            for (int i = 0; i < 4; ++i) { cg += (key[j][i] > cur) ? 1u : 0u; ce += (key[j][i] == cur) ? 1u : 0u; }
            cga += cg;
            if (j < jj) pre += cg | (ce << 8);
            if (j == jj) { kk[0] = key[j][0]; kk[1] = key[j][1]; kk[2] = key[j][2]; kk[3] = key[j][3]; }
        }
        int ngt = 0, gpre = 0, epre = 0;
#pragma unroll
        for (int k = 0; k < 7; ++k) { ngt += popc64(__ballot((cga >> k) & 1u)) << k; gpre += popc64(__ballot((pre >> k) & 1u)) << k; epre += popc64(__ballot((pre >> (8 + k)) & 1u)) << k; }
        const int need = CAP - ngt;
        unsigned pk = 0;
#pragma unroll
        for (int i = 0; i < 4; ++i) pk += (kk[i] > cur ? 1u : 0u) + (kk[i] == cur ? 0x10000u : 0u);
        unsigned inc = pk;
#pragma unroll
        for (int o = 1; o < 64; o <<= 1) { const unsigned t = __shfl_up(inc, o); if (lane >= o) inc += t; }
        const unsigned exc = inc - pk;
        int gtb = gpre + (int)(exc & 0xffffu), eqb = epre + (int)(exc >> 16);
        if ((lane >> 5) == (w & 1)) {
#pragma unroll
            for (int i = 0; i < 4; ++i) {
                const bool gt = kk[i] > cur, eq = kk[i] == cur;
                const bool sel = gt || (eq && eqb < need);
                const int pos = gtb + (eqb < need ? eqb : need);
                const int tok = 256 * jj + 4 * lane + i;
                SLOT[((size_t)(b * S + tok)) * NE + e] = sel ? pos : -1;
                if (sel) { IDX[be * CAP + pos] = b * S + tok; GATE[be * CAP + pos] = __uint_as_float(kk[i]); }
                gtb += gt ? 1 : 0; eqb += eq ? 1 : 0;
            }
        }
    }
}

__device__ __forceinline__ void p_combine(const Ctx& C, const Args& a, bool with_norm) {
    const bf16* Xin = (const bf16*)(a.ws + (with_norm ? WS_XA : WS_XB)); bf16* Xb = (bf16*)(a.ws + WS_XB); float* Xout = a.out;
    const bf16* Y = (const bf16*)(a.ws + WS_PROJ); const int* SLOT = (const int*)(a.ws + WS_SLOT);
    bf16* UC = (bf16*)(a.ws + WS_H); const float* g = a.in[10];
    const int gw = C.vcu * NWAVES + C.wave, NGW = C.G * NWAVES, lane = C.lane;
    auto LOADR = [&](v4u (&v)[2], int& slot, int m) __attribute__((always_inline)) { const v4u* xr = (const v4u*)(Xin + (size_t)m * D) + 2 * lane; v[0] = xr[0]; v[1] = xr[1];
        slot = (lane < NE) ? SLOT[(size_t)m * NE + lane] : -1; };
    auto PROC = [&](const v4u (&vr)[2], int myslot, int m) __attribute__((always_inline)) {
        const int b = m / S;
        f32x4 v[4];
        v[0] = (f32x4){bflo(vr[0].x), bfhi(vr[0].x), bflo(vr[0].y), bfhi(vr[0].y)}; v[1] = (f32x4){bflo(vr[0].z), bfhi(vr[0].z), bflo(vr[0].w), bfhi(vr[0].w)};
        v[2] = (f32x4){bflo(vr[1].x), bfhi(vr[1].x), bflo(vr[1].y), bfhi(vr[1].y)}; v[3] = (f32x4){bflo(vr[1].z), bfhi(vr[1].z), bflo(vr[1].w), bfhi(vr[1].w)};
        unsigned long long mask = __ballot(myslot >= 0);
        while (mask) {
            v2u y[4][4]; int ee[4];
#pragma unroll
            for (int q = 0; q < 4; ++q) { ee[q] = mask ? (int)__builtin_ctzll(mask) : -1; if (mask) mask &= mask - 1; }
#pragma unroll
            for (int q = 0; q < 4; ++q) if (ee[q] >= 0) { const int sl = __shfl(myslot, ee[q]);
                const v2u* yr = (const v2u*)(Y + ((size_t)(b * NE + ee[q]) * CAP + sl) * D) + 4 * lane;
#pragma unroll
                for (int j = 0; j < 4; ++j) y[q][j] = yr[j]; }
#pragma unroll
            for (int q = 0; q < 4; ++q) if (ee[q] >= 0) {
#pragma unroll
                for (int j = 0; j < 4; ++j) { v[j][0] += bflo(y[q][j].x); v[j][1] += bfhi(y[q][j].x); v[j][2] += bflo(y[q][j].y); v[j][3] += bfhi(y[q][j].y); } }
        }
        if (!with_norm) { f32x4* xo = (f32x4*)(Xout + (size_t)m * D) + 4 * lane;
#pragma unroll
            for (int j = 0; j < 4; ++j) xo[j] = v[j]; }
        else { v4u o0, o1; o0.x = pk2(v[0][0], v[0][1]); o0.y = pk2(v[0][2], v[0][3]); o0.z = pk2(v[1][0], v[1][1]); o0.w = pk2(v[1][2], v[1][3]);
            o1.x = pk2(v[2][0], v[2][1]); o1.y = pk2(v[2][2], v[2][3]); o1.z = pk2(v[3][0], v[3][1]); o1.w = pk2(v[3][2], v[3][3]);
            v4u* xo = (v4u*)(Xb + (size_t)m * D) + 2 * lane; xo[0] = o0; xo[1] = o1; }
        if (with_norm) {
            float s = 0.f;
#pragma unroll
            for (int j = 0; j < 4; ++j) s += (v[j][0] * v[j][0] + v[j][1] * v[j][1]) + (v[j][2] * v[j][2] + v[j][3] * v[j][3]);
            const float r = rsqrtf(wave_sum(s) * (1.f / D) + EPS);
            unsigned w[8];
#pragma unroll
            for (int j = 0; j < 4; ++j) { const f32x4 gg = ((const f32x4*)g)[4 * lane + j]; w[2 * j] = pk2(v[j][0] * r * gg[0], v[j][1] * r * gg[1]); w[2 * j + 1] = pk2(v[j][2] * r * gg[2], v[j][3] * r * gg[3]); }
            bf16* up = UC + ((size_t)(lane * 1024 + (m >> 4)) * 512 + (m & 15) * 16);
            *(v4u*)up = (v4u){w[0], w[1], w[2], w[3]}; *(v4u*)(up + 8) = (v4u){w[4], w[5], w[6], w[7]};
        }
    };
    v4u va[2], vb[2]; int sa = -1, sb = -1;
    int m = gw;
    if (m < T) LOADR(va, sa, m);
    for (; m < T; m += 2 * NGW) {
        if (m + NGW < T) LOADR(vb, sb, m + NGW);
        PROC(va, sa, m);
        if (m + 2 * NGW < T) LOADR(va, sa, m + 2 * NGW);
        if (m + NGW < T) PROC(vb, sb, m + NGW);
    }
}

constexpr size_t WS_UC = WS_H;
constexpr size_t WS_E = WS_PROJ;
constexpr size_t WS_TM = 468 * MiB;
constexpr size_t WS_W16 = 484 * MiB;
__device__ __forceinline__ void s5_lambda(const Args& a, int pg, int p, float& lbr, float& lbi, float& fr, float& fi) {
    const float lr = a.in[11][pg * SP + p], li = a.in[12][pg * SP + p], dt = expf(a.in[13][pg]);
    const float mag = expf(lr * dt), ang = li * dt;
    lbr = mag * cosf(ang); lbi = mag * sinf(ang);
    const float den = lr * lr + li * li, nr = lbr - 1.f;
    fr = (nr * lr + lbi * li) / den; fi = (lbi * lr - nr * li) / den;
}
__device__ __forceinline__ void p_s5_pre(const Ctx& C, const Args& a, int g) {
    LAS float* lam = (LAS float*)C.lds; LAS float* bb = lam + 2 * 64 * 17 * 2; LAS float* cc = bb + 2 * 64 * 16 * 2; LAS float* Kt = cc + 2 * 16 * 64 * 2;
    bf16* TM = (bf16*)(a.ws + WS_TM) + (size_t)g * 256 * 512; bf16* W16 = (bf16*)(a.ws + WS_W16) + (size_t)g * 256 * 256;
    const int tid = C.tid;
    if (tid < 128) {
        const int dir = tid >> 6, p = tid & 63, pg = dir * SG + g;
        float lbr, lbi, fr, fi; s5_lambda(a, pg, p, lbr, lbi, fr, fi);
        float pr = 1.f, pi = 0.f;
        for (int k = 0; k <= 16; ++k) { lam[((dir * 64 + p) * 17 + k) * 2] = pr; lam[((dir * 64 + p) * 17 + k) * 2 + 1] = pi; const float nr = pr * lbr - pi * lbi, ni = pr * lbi + pi * lbr; pr = nr; pi = ni; }
        for (int c = 0; c < 16; ++c) { const float br = a.in[14][((size_t)pg * SP + p) * SC + c], bi = a.in[15][((size_t)pg * SP + p) * SC + c];
            bb[((dir * 64 + p) * 16 + c) * 2] = fr * br - fi * bi; bb[((dir * 64 + p) * 16 + c) * 2 + 1] = fr * bi + fi * br; }
    }
    for (int i = tid; i < 2048; i += NTHR) { const int dir = i >> 10, r = i & 1023;
        cc[i * 2] = a.in[16][(size_t)(dir * SG + g) * 1024 + r]; cc[i * 2 + 1] = a.in[17][(size_t)(dir * SG + g) * 1024 + r]; }
    __syncthreads();
    for (int id = tid; id < 8192; id += NTHR) {
        const int dir = id >> 12, k = (id >> 8) & 15, cp = (id >> 4) & 15, c = id & 15; float acc = 0.f;
        for (int p = 0; p < 64; ++p) {
            const float cr = cc[((dir * 16 + cp) * 64 + p) * 2], ci = cc[((dir * 16 + cp) * 64 + p) * 2 + 1];
            const float lr = lam[((dir * 64 + p) * 17 + k) * 2], li = lam[((dir * 64 + p) * 17 + k) * 2 + 1];
            const float xr = cr * lr - ci * li, xi = cr * li + ci * lr;
            acc += xr * bb[((dir * 64 + p) * 16 + c) * 2] - xi * bb[((dir * 64 + p) * 16 + c) * 2 + 1];
        }
        Kt[id] = acc;
    }
    __syncthreads();
    const float* dsk = a.in[18] + g * 16;
    for (int e8 = tid; e8 < 256 * 64; e8 += NTHR) {
        const int n = e8 >> 6, ch = e8 & 63, t = n >> 4, cp = n & 15; float v[8];
        if (ch < 32) {
            const int s_ = ch >> 1, c0 = (ch & 1) * 8;
#pragma unroll
            for (int i = 0; i < 8; ++i) { const int c = c0 + i; float x = 0.f;
                if (s_ <= t) x += Kt[((0 * 16 + (t - s_)) * 16 + cp) * 16 + c];
                if (s_ >= t) x += Kt[((1 * 16 + (s_ - t)) * 16 + cp) * 16 + c];
                if (s_ == t && c == cp) x += dsk[cp];
                v[i] = x; }
        } else {
            const int dir = (ch - 32) >> 4, p0 = ((ch - 32) & 15) * 4, e = dir ? 16 - t : t + 1;
#pragma unroll
            for (int i = 0; i < 4; ++i) { const int p = p0 + i;
                const float cr = cc[((dir * 16 + cp) * 64 + p) * 2], ci = cc[((dir * 16 + cp) * 64 + p) * 2 + 1];
                const float lr = lam[((dir * 64 + p) * 17 + e) * 2], li = lam[((dir * 64 + p) * 17 + e) * 2 + 1];
                v[2 * i] = cr * lr - ci * li; v[2 * i + 1] = -(cr * li + ci * lr); }
        }
        v4u o; o.x = pk2(v[0], v[1]); o.y = pk2(v[2], v[3]); o.z = pk2(v[4], v[5]); o.w = pk2(v[6], v[7]);
        *(v4u*)(TM + (size_t)n * 512 + 8 * ch) = o;
    }
    for (int e8 = tid; e8 < 256 * 32; e8 += NTHR) {
        const int n = e8 >> 5, ch = e8 & 31, dir = n >> 7, p = (n & 127) >> 1, part = n & 1, s_ = ch >> 1, c0 = (ch & 1) * 8, e = dir ? s_ : 15 - s_;
        const float lr = lam[((dir * 64 + p) * 17 + e) * 2], li = lam[((dir * 64 + p) * 17 + e) * 2 + 1]; float v[8];
#pragma unroll
        for (int i = 0; i < 8; ++i) { const float br = bb[((dir * 64 + p) * 16 + c0 + i) * 2], bi = bb[((dir * 64 + p) * 16 + c0 + i) * 2 + 1];
            v[i] = part ? (lr * bi + li * br) : (lr * br - li * bi); }
        v4u o; o.x = pk2(v[0], v[1]); o.y = pk2(v[2], v[3]); o.z = pk2(v[4], v[5]); o.w = pk2(v[6], v[7]);
        *(v4u*)(W16 + (size_t)n * 256 + 8 * ch) = o;
    }
    __syncthreads();
}
struct S5Order {
    int G, c;
    __device__ void init(int G_, int c_) { G = G_; c = c_; }
    __device__ bool next(int i, pg8::Unit& u) const {
        const long L = (long)i * G + c; if (L >= 256) return false;
        int V = (int)L; if (G == 256) V = (c & 7) * 32 + (c >> 3);
        u.pm = V; u.pn = 0; u.pb = V >> 2; return true;
    }
    __device__ __forceinline__ void a_ready(const pg8::Unit&) const {}
    __device__ __forceinline__ void done(const pg8::Unit&) const {}
};
struct EpiS5Scan {
    static constexpr bool PERM = true, AFTER_DRAIN = true;
    bf16* UC; const float *lam_re, *lam_im, *log_dt;
    static constexpr int PITCH = 528;
    __device__ __forceinline__ void fused(const pg8::f32x4 (&acc)[2][2][4][2], const pg8::Unit& u, int wr, int wc, int fr, int fq, LAS unsigned char* lds, int wid, int lane) const {
        const int tid = wid * 64 + lane;
#pragma unroll
        for (int ai = 0; ai < 2; ++ai)
#pragma unroll
            for (int m = 0; m < 4; ++m)
#pragma unroll
                for (int bj = 0; bj < 2; ++bj) { const pg8::f32x4 x = acc[ai][bj][m][0], y = acc[ai][bj][m][1];
                    v4u w; w.x = pk2(x[0], x[1]); w.y = pk2(x[2], x[3]); w.z = pk2(y[0], y[1]); w.w = pk2(y[2], y[3]);
                    *(LAS v4u*)(lds + (ai * 128 + wr * 64 + m * 16 + fr) * PITCH + (bj * 128 + wc * 32 + 8 * fq) * 2) = w; }
        __syncthreads();
        const int g = u.pm >> 2;
        if (tid < 128) {
            const int dir = tid >> 6, p = tid & 63, pg = dir * SG + g;
            const float lr = lam_re[pg * SP + p], li = lam_im[pg * SP + p], dt = expf(log_dt[pg]);
            const float mag = expf(lr * dt), ang = li * dt;
            float pr = mag * cosf(ang), pi = mag * sinf(ang);
#pragma unroll
            for (int i = 0; i < 4; ++i) { const float nr = pr * pr - pi * pi, ni = 2.f * pr * pi; pr = nr; pi = ni; }
            LAS unsigned char* col = lds + (dir * 128 + 2 * p) * 2;
            float hr = 0.f, hi = 0.f;
#pragma unroll 8
            for (int j = 0; j < 256; ++j) {
                LAS unsigned* cell = (LAS unsigned*)(col + (dir ? 255 - j : j) * PITCH);
                const unsigned e = *cell; *cell = pk2(hr, hi);
                const float er = bflo(e), ei = bfhi(e); const float nr = pr * hr - pi * hi + er, ni = pr * hi + pi * hr + ei; hr = nr; hi = ni;
            }
        }
        __syncthreads();
        bf16* dst = UC + (size_t)u.pm * 256 * 512 + 256;
#pragma unroll
        for (int i = 0; i < 16; ++i) { const int idx = tid + 512 * i, row = idx >> 5, ch = idx & 31;
            *(v4u*)(dst + (size_t)row * 512 + 8 * ch) = *(const LAS v4u*)(lds + row * PITCH + 16 * ch); }
        __syncthreads();
    }
};
__device__ __forceinline__ float gelu_t(float y) { const float u = 0.7978845608028654f * (y + 0.044715f * y * y * y); const float e = __builtin_amdgcn_exp2f(2.885390081777927f * u); const float th = 1.f - 2.f * __builtin_amdgcn_rcpf(e + 1.f); return 0.5f * y * (1.f + th); }
struct EpiS5Z {
    static constexpr bool PERM = true, AFTER_DRAIN = false;
    bf16* Z;
    __device__ __forceinline__ void operator()(const pg8::f32x4 (&acc)[2][2][4][2], const pg8::Unit& u, int wr, int wc, int fr, int fq) const {
        const int row0 = u.pm * 256 + wr * 64 + fr;
#pragma unroll
        for (int ai = 0; ai < 2; ++ai)
#pragma unroll
            for (int m = 0; m < 4; ++m) { const int row = row0 + ai * 128 + m * 16, g = row >> 10, J = row & 1023;
#pragma unroll
                for (int bj = 0; bj < 2; ++bj) { const int t = 8 * bj + 2 * wc + (fq >> 1), c0 = 8 * (fq & 1);
                    const pg8::f32x4 x = acc[ai][bj][m][0], y = acc[ai][bj][m][1];
                    v4u w; w.x = pk2(gelu_t(x[0]), gelu_t(x[1])); w.y = pk2(gelu_t(x[2]), gelu_t(x[3])); w.z = pk2(gelu_t(y[0]), gelu_t(y[1])); w.w = pk2(gelu_t(y[2]), gelu_t(y[3]));
                    *(v4u*)(Z + (size_t)(16 * J + t) * D + g * 16 + c0) = w; } }
    }
};
constexpr int NPHASE = 18;
__global__ void __launch_bounds__(NTHR, 2) mk_fwd(Args args) {
    extern __shared__ __attribute__((aligned(16))) unsigned char lds_raw[];
    Ctx C;
    C.lds = (LAS unsigned char*)lds_raw;
    C.tid = threadIdx.x; C.lane = C.tid & 63; C.wave = __builtin_amdgcn_readfirstlane(C.tid >> 6);
    C.G = gridDim.x; { const int bx = blockIdx.x; C.vcu = (C.G % 8 == 0) ? (bx % 8) * (C.G / 8) + bx / 8 : bx; }
    volatile LAS unsigned* MISC = (volatile LAS unsigned*)(C.lds + LDSCTL_OFF);
    for (int u = C.tid; u < (LDS_BYTES - LDSCTL_OFF) / 4; u += NTHR) ((LAS unsigned*)(C.lds + LDSCTL_OFF))[u] = 0u;
    __syncthreads();
    int lo = args.ph_lo, hi = args.ph_hi;
    unsigned char* ws = args.ws;
    asm volatile("" : "+s"(lo), "+s"(hi), "+s"(ws));
    unsigned* ctl = (unsigned*)(ws + WS_CTL);
    const bool one_launch = (lo == 0 && hi == NPHASE);
    XcdBarrier bar; bar.bar = ctl + CW_BAR; bar.x = 0; bar.st = nullptr;
    if (one_launch) bar = xcd_barrier_post(ctl + CW_BAR, MISC + 8);
    LAS unsigned char* glds = C.lds;
#ifndef MK_ONLY
#define MK_ONLY -1
#endif
#define IN(k) ((MK_ONLY < 0 || MK_ONLY == (k) || (MK_ONLY == 4 && (k) == 13) || (MK_ONLY == 5 && (k) == 14) || (MK_ONLY == 6 && (k) == 15) || (MK_ONLY == 7 && (k) == 16) || (MK_ONLY == 8 && (k) == 17)) && lo <= (k) && (k) < hi)
#ifndef MK_S5DUP
#define MK_S5DUP 0
#endif
#ifndef MK_DUP
#define MK_DUP 0
#endif
#define DUPBIT(k) ((MK_DUP >> ((k) < 13 ? (k) : (k) - 9)) & 1)
#define DUPX(k, ...) do { __VA_ARGS__ if (DUPBIT(k)) { __VA_ARGS__ } } while (0)
#define SEAM(k) do { if (IN(k) && IN((k) + 1)) xcd_barrier(bar); } while (0)

#ifdef MK_XBAR
    if (one_launch) for (int xb_ = 0; xb_ < MK_XBAR; ++xb_) xcd_barrier(bar);
#endif
    if (IN(0)) { DUPX(0, p0_prologue(C, args);); } SEAM(0);
    if (IN(1)) {
        const int G1 = (C.G == 256) ? 214 : C.G;
        if ((int)blockIdx.x < G1) {
            pg8::Gemm g{(const bf16*)(ws + WS_XN), (const bf16*)(ws + WS_WIN), D, nullptr, D, D}; pg8::DenseOrder So; So.init(T, INC, G1, (int)blockIdx.x);
            pg8::EpiProj E{(bf16*)(ws + WS_PROJ), (bf16*)(ws + WS_PROJ + 16 * MiB), args.in[7], args.in[8]};
            pg8::gemm_phase<pg8::EpiProj, pg8::DenseOrder, true, true>(glds, g, So, E);
            if (C.tid == 0) __hip_atomic_fetch_add((unsigned*)(ws + WS_CTL) + CW_P1DONE, 1u, __ATOMIC_RELAXED, __HIP_MEMORY_SCOPE_AGENT);
        } else conv_drain(C, args, true);
    } SEAM(1);
    if (IN(2)) {
 DUPX(2, {        for (int gq = C.vcu; gq < SG; gq += C.G) p_s5_pre(C, args, gq);
        conv_drain(C, args, false);
        conv_phase(C, args);
        attn_phase(C, args);
    }); } SEAM(2);
    if (IN(3)) {
 DUPX(3, {        pg8::Gemm g{(const bf16*)(ws + WS_MIXED), (const bf16*)(ws + WS_WOUT), D, nullptr, D, D}; pg8::DenseOrder So; So.init(T, D, C.G, (int)blockIdx.x);
        pg8::EpiRes E{args.in[0], (bf16*)(ws + WS_XA)};
        pg8::gemm_phase<pg8::EpiRes, pg8::DenseOrder, true, true>(glds, g, So, E);
    }); } SEAM(3);
#define MOE_PHASES(layer, pb) do { \
        if (IN(pb)) { DUPX(pb, p_router(C, args, layer);); } SEAM(pb); \
        if (IN(pb + 1)) { DUPX(pb + 1, p_topk(C, args);); } SEAM(pb + 1); \
        if (IN(pb + 2)) { DUPX(pb + 2, { \
            pg8::Gemm g{(const bf16*)(ws + WS_XN), (const bf16*)(ws + WS_WEXP + layer * WEXP_LAYER + WEXP_GU), D, (const int*)(ws + WS_IDX), D, D}; pg8::ExpertOrder So; So.init(8, C.G, (int)blockIdx.x); \
            pg8::EpiSwiGLU E{(bf16*)(ws + WS_H)}; \
            pg8::gemm_phase<pg8::EpiSwiGLU, pg8::ExpertOrder, true, true, true>(glds, g, So, E); \
        }); } SEAM(pb + 2); \
        if (IN(pb + 3)) { DUPX(pb + 3, { \
            pg8::Gemm g{(const bf16*)(ws + WS_H), (const bf16*)(ws + WS_WEXP + layer * WEXP_LAYER + WEXP_DN), EH, nullptr, EH, EH}; pg8::ExpertOrder So; So.init(4, C.G, (int)blockIdx.x); \
            pg8::EpiDown E{(bf16*)(ws + WS_PROJ), (const float*)(ws + WS_GATE)}; \
            pg8::gemm_phase<pg8::EpiDown, pg8::ExpertOrder, true, true>(glds, g, So, E); \
        }); } SEAM(pb + 3); \
        if (IN(pb + 4)) { DUPX(pb + 4, p_combine(C, args, layer == 0);); } \
    } while (0)
    MOE_PHASES(0, 4);
    SEAM(8);
    if (IN(9)) {
        int k9 = 256; asm volatile("" : "+s"(k9));
        pg8::Gemm g{(const bf16*)(ws + WS_UC), (const bf16*)(ws + WS_W16), k9, nullptr, 512, 256}; S5Order So; So.init(C.G, (int)blockIdx.x);
        EpiS5Scan E{(bf16*)(ws + WS_UC), args.in[11], args.in[12], args.in[13]};
        pg8::gemm_phase<EpiS5Scan, S5Order, false, true>(glds, g, So, E);
    }
    asm volatile("s_waitcnt vmcnt(0)" ::: "memory"); __syncthreads();
    if (IN(11)) {
        int k11 = 512; asm volatile("" : "+s"(k11));
        pg8::Gemm g{(const bf16*)(ws + WS_UC), (const bf16*)(ws + WS_TM), k11, nullptr, 512, 512}; S5Order So; So.init(C.G, (int)blockIdx.x);
        EpiS5Z E{(bf16*)(ws + WS_MIXED)};
        pg8::gemm_phase<EpiS5Z, S5Order, true, true>(glds, g, So, E);
#if MK_S5DUP == 11
        pg8::gemm_phase<EpiS5Z, S5Order, true, true>(glds, g, So, E);
#endif
    } SEAM(11);
    if (IN(12)) {
        pg8::Gemm g{(const bf16*)(ws + WS_MIXED), (const bf16*)(ws + WS_WGLU), D, nullptr, D, D}; pg8::DenseOrder So; So.init(T, 2 * D, C.G, (int)blockIdx.x);
        pg8::EpiGluRes E{(bf16*)(ws + WS_XB)};
        pg8::gemm_phase<pg8::EpiGluRes, pg8::DenseOrder, true, true>(glds, g, So, E);
    } SEAM(12);
    MOE_PHASES(1, 13);
#undef IN
#undef SEAM
}

#ifndef MK_PER_PHASE
#define MK_PER_PHASE 0
#endif
extern "C" void kernel_launch(void* const* d_in, const int* in_sizes, int n_in, void* d_out, int out_size, void* d_ws, size_t ws_size, hipStream_t stream) {
    static int grid = 0;
    if (grid == 0) {
        if (n_in != 26 || out_size != T * D || ws_size < WS_END) { fprintf(stderr, "kernel_launch: unexpected shapes (n_in %d out %d ws %zu)\n", n_in, out_size, ws_size); grid = -1; return; }
        int dev = 0, cus = 0, per_cu = 0;
        if (hipGetDevice(&dev) != hipSuccess || hipDeviceGetAttribute(&cus, hipDeviceAttributeMultiprocessorCount, dev) != hipSuccess) { grid = -1; return; }
        if (hipFuncSetAttribute((const void*)mk_fwd, hipFuncAttributeMaxDynamicSharedMemorySize, LDS_BYTES) != hipSuccess) { fprintf(stderr, "kernel_launch: hipFuncSetAttribute failed\n"); grid = -1; return; }
        if (hipOccupancyMaxActiveBlocksPerMultiprocessor(&per_cu, (const void*)mk_fwd, NTHR, LDS_BYTES) != hipSuccess || per_cu < 1) { fprintf(stderr, "kernel_launch: occupancy query says %d blocks per CU\n", per_cu); (void)hipGetLastError(); grid = -1; return; }
        grid = cus;
    }
    if (grid < 0) return;
    (void)hipMemsetAsync((char*)d_ws + WS_CTL, 0, CTL_ZERO_BYTES, stream);
    Args a{};
    for (int i = 0; i < 26; ++i) a.in[i] = (const float*)d_in[i];
    a.out = (float*)d_out; a.ws = (unsigned char*)d_ws;
#if MK_PER_PHASE
    for (int p = 0; p < NPHASE; ++p) { a.ph_lo = p; a.ph_hi = p + 1; hipLaunchKernelGGL(mk_fwd, dim3(grid), dim3(NTHR), LDS_BYTES, stream, a); }
#else
    a.ph_lo = 0; a.ph_hi = NPHASE;
    hipLaunchKernelGGL(mk_fwd, dim3(grid), dim3(NTHR), LDS_BYTES, stream, a);
#endif
}
```

```cpp
#include <hip/hip_runtime.h>
#include <cstdint>
#include <cstdio>

namespace pg8 {
#define PG8_LAS __attribute__((address_space(3)))
typedef unsigned short bf16_t;
typedef short bf16x8 __attribute__((ext_vector_type(8)));
typedef float f32x4 __attribute__((ext_vector_type(4)));
typedef unsigned u32x4 __attribute__((ext_vector_type(4)));
constexpr int BM = 256, BK = 64, HALF = 128, HTB = HALF * BK * 2  , STAGE_BYTES = 8 * HTB, NXCD = 8, WGM = 8;

__host__ __device__ __forceinline__ int lds_byte(int r, int c) { const int st = (r >> 4) * 2 + (c >> 5), rr = r & 15, cc = c & 31, ob = rr * 64 + cc * 2; return st * 1024 + (ob ^ (((ob >> 9) & 1) << 5)); }
__host__ __device__ __forceinline__ void stage_rc(int b, int& R, int& C) { const int st = b / 1024, sb = b % 1024, swz = sb ^ (((sb >> 9) & 1) << 5); R = (st >> 1) * 16 + swz / 64; C = (st & 1) * 32 + (swz % 64) / 2; }
__host__ __device__ __forceinline__ int perm32(int rho) { const int n = rho >> 4, i = rho & 15; return 8 * (i >> 2) + 4 * n + (i & 3); }

struct Unit { int pm, pn, pb; };
struct Gemm { const bf16_t* A; const bf16_t* Bt; int K; const int* gidx; int lda, ldb; };

struct DenseOrder {
    int nM, nN, nwg, G, c;
    __device__ void init(int M, int N, int G_, int c_) { nM = M / BM; nN = N / BM; nwg = nM * nN; G = G_; c = c_; }
    __device__ bool next(int i, Unit& u) const {
        const long L = (long)i * G + c; if (L >= nwg) return false;
        int wgid = (int)L; { const int q = nwg / NXCD, r = nwg % NXCD, xcd = wgid % NXCD, off = wgid / NXCD; wgid = (xcd < r ? xcd * (q + 1) : r * (q + 1) + (xcd - r) * q) + off; }
        const int nig = WGM * nN, gid = wgid / nig, fm = gid * WGM, gsz = (nM - fm) < WGM ? (nM - fm) : WGM;
        u.pm = fm + ((wgid % nig) % gsz); u.pn = (wgid % nig) / gsz; u.pb = u.pn; return true;
    }
    __device__ __forceinline__ void a_ready(const Unit&) const {}
    __device__ __forceinline__ void done(const Unit&) const {}
};
struct ExpertOrder {
    int nN, nun, G, c;
    __device__ void init(int nN_, int G_, int c_) { nN = nN_; nun = 128 * nN_; G = G_; c = c_; }
    __device__ bool next(int i, Unit& u) const {
        const long L = (long)i * G + c; if (L >= nun) return false;
        int V = (int)L;
        if (G == 256) {
            const int x = c & 7, j = c >> 3, upx = 32, rpe = (8 * nN) / upx;
            const int e_ = 8 * (i / rpe) + x, r_ = (i % rpe) * upx + j;
            V = e_ * 8 * nN + r_;
        }
        const int per = 8 * nN, e = V / per, r = V % per, pml = r / nN, pn = r % nN;
        u.pm = ((pml >> 1) * 16 + e) * 2 + (pml & 1); u.pn = pn; u.pb = e * nN + pn; return true;
    }
    __device__ __forceinline__ void a_ready(const Unit&) const {}
    __device__ __forceinline__ void done(const Unit&) const {}
};

typedef float f32x2 __attribute__((ext_vector_type(2)));
typedef __bf16 bf16x2_t __attribute__((ext_vector_type(2)));
__device__ __forceinline__ unsigned pk2(float lo, float hi) { f32x2 v = {lo, hi}; bf16x2_t b = __builtin_convertvector(v, bf16x2_t); return __builtin_bit_cast(unsigned, b); }
__device__ __forceinline__ float sigm(float x) { return __builtin_amdgcn_rcpf(1.f + __builtin_amdgcn_exp2f(-1.4426950408889634f * x)); }

constexpr float QSCALE = 0.125f * 1.4426950408889634f;
struct EpiProj {
    static constexpr bool PERM = true, AFTER_DRAIN = false;
    bf16_t *GLU, *Q; const float *qg, *kg;
    __device__ __forceinline__ void operator()(const f32x4 (&acc)[2][2][4][2], const Unit& u, int wr, int wc, int fr, int fq) const {
        const int row0 = u.pm * BM + wr * 64 + fr;
        if (u.pn < 4) {
            const int col0 = 128 * u.pn + 32 * wc + 8 * fq;
#pragma unroll
            for (int ai = 0; ai < 2; ++ai)
#pragma unroll
                for (int m = 0; m < 4; ++m) {
                    const f32x4 v0 = acc[ai][0][m][0], v1 = acc[ai][0][m][1], g0 = acc[ai][1][m][0], g1 = acc[ai][1][m][1];
                    u32x4 w; w.x = pk2(v0[0] * sigm(g0[0]), v0[1] * sigm(g0[1])); w.y = pk2(v0[2] * sigm(g0[2]), v0[3] * sigm(g0[3]));
                    w.z = pk2(v1[0] * sigm(g1[0]), v1[1] * sigm(g1[1])); w.w = pk2(v1[2] * sigm(g1[2]), v1[3] * sigm(g1[3]));
                    *(u32x4*)(GLU + (size_t)(row0 + ai * HALF + m * 16) * 512 + col0) = w;
                    asm volatile("" ::: "memory");
                }
        } else {
            const int t = (u.pn - 4) >> 1;
            const int hd = 4 * ((u.pn - 4) & 1) + wc;
            bf16_t* dst = Q + (size_t)t * (size_t)(8u << 20);
            const float* gp = (const float*)((uintptr_t)qg + (((uintptr_t)kg - (uintptr_t)qg) & (uintptr_t)(t == 0 ? 0 : ~(uintptr_t)0)));
#pragma unroll
            for (int ai = 0; ai < 2; ++ai)
#pragma unroll
                for (int m = 0; m < 4; ++m) {
                    float ss = 0.f;
#pragma unroll
                    for (int bj = 0; bj < 2; ++bj)
#pragma unroll
                        for (int n = 0; n < 2; ++n) { const f32x4 x = acc[ai][bj][m][n]; ss += (x[0] * x[0] + x[1] * x[1]) + (x[2] * x[2] + x[3] * x[3]); }
                    ss += __shfl_xor(ss, 16); ss += __shfl_xor(ss, 32);
                    float rs = 1.f;
                    if (t < 2) rs = rsqrtf(ss * (1.f / 64.f) + 1e-6f) * (t == 0 ? QSCALE : 1.f);
#pragma unroll
                    for (int bj = 0; bj < 2; ++bj) {
                        f32x4 g0 = {1.f, 1.f, 1.f, 1.f}, g1 = g0;
                        if (t < 2) { g0 = *(const f32x4*)(gp + 32 * bj + 8 * fq); g1 = *(const f32x4*)(gp + 32 * bj + 8 * fq + 4); }
                        const f32x4 a = acc[ai][bj][m][0] * g0 * rs, b = acc[ai][bj][m][1] * g1 * rs;
                        u32x4 w; w.x = pk2(a[0], a[1]); w.y = pk2(a[2], a[3]); w.z = pk2(b[0], b[1]); w.w = pk2(b[2], b[3]);
                        const int row = row0 + ai * HALF + m * 16;
                        *(u32x4*)(dst + ((size_t)((row >> 12) * 8 + hd) * 4096 + (row & 4095)) * 64 + 32 * bj + 8 * fq) = w;
                    }
                    asm volatile("" ::: "memory");
                }
        }
    }
};
struct EpiRes {
    static constexpr bool PERM = true, AFTER_DRAIN = false;
    const float* xin; bf16_t* X;
    __device__ __forceinline__ void operator()(const f32x4 (&acc)[2][2][4][2], const Unit& u, int wr, int wc, int fr, int fq) const {
        const int row0 = u.pm * BM + wr * 64 + fr, col0 = u.pn * BM + wc * 32 + 8 * fq;
#pragma unroll
        for (int ai = 0; ai < 2; ++ai)
#pragma unroll
            for (int m = 0; m < 4; ++m) { const size_t off = (size_t)(row0 + ai * HALF + m * 16) * 1024 + col0;
#pragma unroll
                for (int bj = 0; bj < 2; ++bj) { const f32x4 a = *(const f32x4*)(xin + off + bj * HALF) + acc[ai][bj][m][0], b = *(const f32x4*)(xin + off + bj * HALF + 4) + acc[ai][bj][m][1];
                    u32x4 w; w.x = pk2(a[0], a[1]); w.y = pk2(a[2], a[3]); w.z = pk2(b[0], b[1]); w.w = pk2(b[2], b[3]);
                    *(u32x4*)(X + off + bj * HALF) = w; } }
    }
};
struct EpiSwiGLU {
    static constexpr bool PERM = true, AFTER_DRAIN = false;
    bf16_t* H; const float* rsrow;
    __device__ __forceinline__ void operator()(const f32x4 (&acc)[2][2][4][2], const Unit& u, int wr, int wc, int fr, int fq) const {
        const int row0 = u.pm * BM + wr * 64 + fr, col0 = 128 * u.pn + 32 * wc + 8 * fq;
#pragma unroll
        for (int ai = 0; ai < 2; ++ai)
#pragma unroll
            for (int m = 0; m < 4; ++m) {
                const float rs = rsrow[row0 + ai * HALF + m * 16];
                const f32x4 g0 = acc[ai][0][m][0] * rs, g1 = acc[ai][0][m][1] * rs, u0 = acc[ai][1][m][0] * rs, u1 = acc[ai][1][m][1] * rs;
                u32x4 w; w.x = pk2(g0[0] * sigm(g0[0]) * u0[0], g0[1] * sigm(g0[1]) * u0[1]); w.y = pk2(g0[2] * sigm(g0[2]) * u0[2], g0[3] * sigm(g0[3]) * u0[3]);
                w.z = pk2(g1[0] * sigm(g1[0]) * u1[0], g1[1] * sigm(g1[1]) * u1[1]); w.w = pk2(g1[2] * sigm(g1[2]) * u1[2], g1[3] * sigm(g1[3]) * u1[3]);
                *(u32x4*)(H + (size_t)(row0 + ai * HALF + m * 16) * 1024 + col0) = w;
            }
    }
};
struct EpiDown {
    static constexpr bool PERM = true, AFTER_DRAIN = false;
    bf16_t* Y; const float* gate;
    __device__ __forceinline__ void operator()(const f32x4 (&acc)[2][2][4][2], const Unit& u, int wr, int wc, int fr, int fq) const {
        const int row0 = u.pm * BM + wr * 64 + fr, col0 = u.pn * BM + wc * 32 + 8 * fq;
#pragma unroll
        for (int ai = 0; ai < 2; ++ai)
#pragma unroll
            for (int m = 0; m < 4; ++m) { const int row = row0 + ai * HALF + m * 16; const float gs = gate[row];
#pragma unroll
                for (int bj = 0; bj < 2; ++bj) { const f32x4 a = acc[ai][bj][m][0] * gs, b = acc[ai][bj][m][1] * gs;
                    u32x4 w; w.x = pk2(a[0], a[1]); w.y = pk2(a[2], a[3]); w.z = pk2(b[0], b[1]); w.w = pk2(b[2], b[3]);
                    *(u32x4*)(Y + (size_t)row * 1024 + col0 + bj * HALF) = w; } }
    }
};
struct EpiGluRes {
    static constexpr bool PERM = true, AFTER_DRAIN = false;
    bf16_t* X;
    __device__ __forceinline__ void operator()(const f32x4 (&acc)[2][2][4][2], const Unit& u, int wr, int wc, int fr, int fq) const {
        const int row0 = u.pm * BM + wr * 64 + fr, col0 = 128 * u.pn + 32 * wc + 8 * fq;
#pragma unroll
        for (int ai = 0; ai < 2; ++ai)
#pragma unroll
            for (int m = 0; m < 4; ++m) { bf16_t* p = X + (size_t)(row0 + ai * HALF + m * 16) * 1024 + col0;
                const u32x4 o = *(const u32x4*)p; const f32x4 v0 = acc[ai][0][m][0], v1 = acc[ai][0][m][1], g0 = acc[ai][1][m][0], g1 = acc[ai][1][m][1];
                u32x4 w;
                w.x = pk2(__uint_as_float(o.x << 16) + v0[0] * sigm(g0[0]), __uint_as_float(o.x & 0xffff0000u) + v0[1] * sigm(g0[1]));
                w.y = pk2(__uint_as_float(o.y << 16) + v0[2] * sigm(g0[2]), __uint_as_float(o.y & 0xffff0000u) + v0[3] * sigm(g0[3]));
                w.z = pk2(__uint_as_float(o.z << 16) + v1[0] * sigm(g1[0]), __uint_as_float(o.z & 0xffff0000u) + v1[1] * sigm(g1[1]));
                w.w = pk2(__uint_as_float(o.w << 16) + v1[2] * sigm(g1[2]), __uint_as_float(o.w & 0xffff0000u) + v1[3] * sigm(g1[3]));
                *(u32x4*)p = w; }
    }
};

template <class Epi, class Sched, bool ALIGN_EPI = false, bool SP2 = false, bool GATHER = false>
__device__ __forceinline__ void gemm_phase(PG8_LAS unsigned char* lds, const Gemm g, const Sched& S, const Epi& E) {
    const int tid = threadIdx.x, wid = __builtin_amdgcn_readfirstlane(tid >> 6), lane = tid & 63, wr = wid >> 2, wc = wid & 3, fr = lane & 15, fq = lane >> 4;
    const int K = g.K, nt = K / BK;
    unsigned voffA[2], voffB[2];
#pragma unroll
    for (int i = 0; i < 2; ++i) { int R, C; stage_rc(tid * 16 + i * 8192, R, C); const int Rb = Epi::PERM ? ((R & ~31) + perm32(R & 31)) : R;
        voffA[i] = (unsigned)(R * g.lda + C) * 2u; voffB[i] = (unsigned)(Rb * g.ldb + C) * 2u; }
    const size_t kstep = (size_t)(BK * 2);
    const size_t hstepA = (size_t)HALF * g.lda * 2, hstepB = (size_t)HALF * g.ldb * 2;
    const size_t tstepA = 2 * hstepA, tstepB = 2 * hstepB;
    const unsigned ldsw = (unsigned)wid * 1024u;
    const int aoff = lds_byte(wr * 64 + fr, fq * 8), boff = lds_byte(wc * 32 + fr, fq * 8);
#define PG8_SA(b, h) (((b) * 2 + (h)) * HTB)
#define PG8_SB(b, h) ((4 + (b) * 2 + (h)) * HTB)
#define PG8_STAGE(bufoff, gbase, voff) do { _Pragma("unroll") for (int _i = 0; _i < 2; ++_i) \
        __builtin_amdgcn_global_load_lds((const unsigned*)((const char*)(gbase) + (voff)[_i]), (PG8_LAS unsigned*)(lds + (bufoff) + ldsw + _i * 8192), 16, 0, 0); } while (0)
#define PG8_STAGE_A(bufoff, gptr, h, nsel) do { if constexpr (GATHER) { const unsigned _o[2] = {(nsel) ? nOA[h][0] : oA[h][0], (nsel) ? nOA[h][1] : oA[h][1]}; PG8_STAGE(bufoff, gptr, _o); } \
        else { PG8_STAGE(bufoff, (gptr) + ((h) ? hstepA : 0), voffA); } } while (0)
#define PG8_GOFF(dst, u) do { if constexpr (GATHER) { _Pragma("unroll") for (int _h = 0; _h < 2; ++_h) _Pragma("unroll") for (int _i = 0; _i < 2; ++_i) { \
        (dst)[_h][_i] = (unsigned)g.gidx[(u).pm * BM + _h * HALF + gR[_i]] * (unsigned)(g.lda * 2) + gC[_i]; asm volatile("" : "+v"((dst)[_h][_i])); } } } while (0)
#define PG8_LDA(dst, b, h) do { _Pragma("unroll") for (int m = 0; m < 4; ++m) _Pragma("unroll") for (int k = 0; k < 2; ++k) dst[m][k] = *(const PG8_LAS bf16x8*)(lds + PG8_SA(b, h) + aoff + m * 2048 + k * 1024); } while (0)
#define PG8_LDB(dst, b, h) do { _Pragma("unroll") for (int n = 0; n < 2; ++n) _Pragma("unroll") for (int k = 0; k < 2; ++k) dst[n][k] = *(const PG8_LAS bf16x8*)(lds + PG8_SB(b, h) + boff + n * 2048 + k * 1024); } while (0)
#define PG8_MMA(ai, bj, At, Bt) do { __builtin_amdgcn_s_setprio(1); _Pragma("unroll") for (int m = 0; m < 4; ++m) _Pragma("unroll") for (int n = 0; n < 2; ++n) _Pragma("unroll") for (int k = 0; k < 2; ++k) \
        acc[ai][bj][m][n] = __builtin_amdgcn_mfma_f32_16x16x32_bf16(Bt[n][k], At[m][k], acc[ai][bj][m][n], 0, 0, 0); __builtin_amdgcn_s_setprio(0); } while (0)
#define PG8_WAIT_V(n) asm volatile("s_waitcnt vmcnt(" #n ")" ::: "memory")
#define PG8_WAIT_L(n) asm volatile("s_waitcnt lgkmcnt(" #n ")" ::: "memory")
#define PG8_BAR __builtin_amdgcn_s_barrier()
#define PG8_SCHED __builtin_amdgcn_sched_barrier(0)
    Unit cur, nxt; int ui = 0;
    if (!S.next(0, cur)) return;
    unsigned oA[2][2], nOA[2][2]; int gR[2]; unsigned gC[2];
    if constexpr (GATHER) { static_assert(SP2, "GATHER is wired into the SP2 loop only");
#pragma unroll
        for (int i = 0; i < 2; ++i) { int R, Cc; stage_rc(tid * 16 + i * 8192, R, Cc); gR[i] = R; gC[i] = (unsigned)Cc * 2u; } }
    PG8_GOFF(oA, cur);
    f32x4 acc[2][2][4][2];
#pragma unroll
    for (int a = 0; a < 2; ++a)
#pragma unroll
        for (int b = 0; b < 2; ++b)
#pragma unroll
            for (int m = 0; m < 4; ++m)
#pragma unroll
                for (int n = 0; n < 2; ++n) acc[a][b][m][n] = (f32x4){0.f, 0.f, 0.f, 0.f};
    bf16x8 At[4][2], B0[2][2], B1[2][2];
    const char* cA = (const char*)g.A + (GATHER ? (size_t)0 : (size_t)cur.pm * tstepA); const char* cB = (const char*)g.Bt + (size_t)cur.pb * tstepB;
    S.a_ready(cur);
    if constexpr (SP2) {
        PG8_STAGE(PG8_SB(0, 0), cB, voffB); PG8_STAGE(PG8_SB(0, 1), cB + hstepB, voffB); PG8_STAGE_A(PG8_SA(0, 0), cA, 0, false); PG8_STAGE_A(PG8_SA(0, 1), cA, 1, false);
        if (wr == 1) PG8_BAR;
        PG8_WAIT_V(2); PG8_BAR;
        PG8_STAGE(PG8_SB(1, 0), cB + kstep, voffB); PG8_STAGE_A(PG8_SA(1, 0), cA + kstep, 0, false); PG8_STAGE(PG8_SB(1, 1), cB + hstepB + kstep, voffB);
        PG8_WAIT_V(6); PG8_BAR;
    } else {
        PG8_STAGE(PG8_SB(0, 0), cB, voffB); PG8_STAGE(PG8_SA(0, 0), cA, voffA); PG8_STAGE(PG8_SB(0, 1), cB + hstepB, voffB); PG8_STAGE(PG8_SA(0, 1), cA + hstepA, voffA);
        if (wr == 1) PG8_BAR;
        PG8_WAIT_V(4); PG8_BAR;
        PG8_STAGE(PG8_SB(1, 0), cB + kstep, voffB); PG8_STAGE(PG8_SA(1, 0), cA + kstep, voffA); PG8_STAGE(PG8_SB(1, 1), cB + hstepB + kstep, voffB);
        PG8_WAIT_V(6); PG8_BAR;
    }
    for (;;) {
        const bool has_next = S.next(ui + 1, nxt);
        const char* nA = has_next ? (const char*)g.A + (GATHER ? (size_t)0 : (size_t)nxt.pm * tstepA) : cA; const char* nB = has_next ? (const char*)g.Bt + (size_t)nxt.pb * tstepB : cB;
        if constexpr (GATHER) { if (has_next) { PG8_GOFF(nOA, nxt); } else {
#pragma unroll
            for (int _h = 0; _h < 2; ++_h) { nOA[_h][0] = oA[_h][0]; nOA[_h][1] = oA[_h][1]; } } }
        for (int t = 0; t < nt; t += 2) {
            const bool last = (t == nt - 2);
            const char* a1 = cA + (size_t)(t + 1) * kstep;
            const char* a2 = last ? nA : cA + (size_t)(t + 2) * kstep; const char* b2 = last ? nB : cB + (size_t)(t + 2) * kstep;
            const char* a3 = a2 + kstep; const char* b3 = b2 + kstep;
            if (last && has_next) S.a_ready(nxt);
            if constexpr (SP2) {
            PG8_LDB(B0, 0, 0); PG8_LDB(B1, 0, 1); PG8_SCHED; PG8_LDA(At, 0, 0); PG8_STAGE_A(PG8_SA(1, 1), a1, 1, false);
            PG8_WAIT_V(8); PG8_WAIT_L(0); PG8_BAR; PG8_MMA(0, 0, At, B0); PG8_MMA(0, 1, At, B1); PG8_BAR; PG8_SCHED;
            PG8_LDA(At, 0, 1); PG8_STAGE(PG8_SB(0, 0), b2, voffB); PG8_STAGE(PG8_SB(0, 1), b2 + hstepB, voffB); PG8_STAGE_A(PG8_SA(0, 0), a2, 0, last);
            PG8_WAIT_V(8); PG8_WAIT_L(0); PG8_BAR; PG8_MMA(1, 0, At, B0); PG8_MMA(1, 1, At, B1); PG8_BAR; PG8_SCHED;
            PG8_LDB(B0, 1, 0); PG8_LDB(B1, 1, 1); PG8_SCHED; PG8_LDA(At, 1, 0); PG8_STAGE_A(PG8_SA(0, 1), a2, 1, last);
            PG8_WAIT_V(8); PG8_WAIT_L(0); PG8_BAR; PG8_MMA(0, 0, At, B0); PG8_MMA(0, 1, At, B1); PG8_BAR; PG8_SCHED;
            PG8_LDA(At, 1, 1); PG8_STAGE(PG8_SB(1, 0), b3, voffB); PG8_STAGE(PG8_SB(1, 1), b3 + hstepB, voffB); PG8_STAGE_A(PG8_SA(1, 0), a3, 0, last);
            PG8_WAIT_V(8); PG8_WAIT_L(0); PG8_BAR; PG8_MMA(1, 0, At, B0); PG8_MMA(1, 1, At, B1); PG8_BAR; PG8_SCHED;
            } else {
            PG8_LDB(B0, 0, 0); PG8_SCHED; PG8_LDA(At, 0, 0); PG8_STAGE(PG8_SA(1, 1), a1 + hstepA, voffA);
            PG8_WAIT_L(8); PG8_BAR; PG8_WAIT_L(0); PG8_MMA(0, 0, At, B0); PG8_BAR; PG8_SCHED;
            PG8_LDB(B1, 0, 1); PG8_STAGE(PG8_SB(0, 0), b2, voffB);
            PG8_BAR; PG8_WAIT_L(0); PG8_MMA(0, 1, At, B1); PG8_BAR;
            PG8_LDA(At, 0, 1); PG8_STAGE(PG8_SA(0, 0), a2, voffA);
            PG8_BAR; PG8_WAIT_L(0); PG8_MMA(1, 0, At, B0); PG8_BAR; PG8_SCHED;
            PG8_STAGE(PG8_SB(0, 1), b2 + hstepB, voffB);
            PG8_WAIT_V(6); PG8_BAR; PG8_MMA(1, 1, At, B1); PG8_BAR;
            PG8_LDB(B0, 1, 0); PG8_SCHED; PG8_LDA(At, 1, 0); PG8_STAGE(PG8_SA(0, 1), a2 + hstepA, voffA);
            PG8_WAIT_L(8); PG8_BAR; PG8_WAIT_L(0); PG8_MMA(0, 0, At, B0); PG8_BAR; PG8_SCHED;
            PG8_LDB(B1, 1, 1); PG8_STAGE(PG8_SB(1, 0), b3, voffB);
            PG8_BAR; PG8_WAIT_L(0); PG8_MMA(0, 1, At, B1); PG8_BAR;
            PG8_LDA(At, 1, 1); PG8_STAGE(PG8_SA(1, 0), a3, voffA);
            PG8_BAR; PG8_WAIT_L(0); PG8_MMA(1, 0, At, B0); PG8_BAR; PG8_SCHED;
            PG8_STAGE(PG8_SB(1, 1), b3 + hstepB, voffB);
            PG8_WAIT_V(6); PG8_BAR; PG8_MMA(1, 1, At, B1); PG8_BAR;
            }
        }
        if constexpr (ALIGN_EPI) { if (wr == 0) PG8_BAR; }
        if constexpr (!Epi::AFTER_DRAIN) { E(acc, cur, wr, wc, fr, fq); S.done(cur); }
        if (!has_next) break;
#pragma unroll
        for (int a = 0; a < 2; ++a)
#pragma unroll
            for (int b = 0; b < 2; ++b)
#pragma unroll
                for (int m = 0; m < 4; ++m)
#pragma unroll
                    for (int n = 0; n < 2; ++n) acc[a][b][m][n] = (f32x4){0.f, 0.f, 0.f, 0.f};
        cur = nxt; cA = nA; cB = nB; ++ui;
        if constexpr (GATHER) {
#pragma unroll
            for (int _h = 0; _h < 2; ++_h) { oA[_h][0] = nOA[_h][0]; oA[_h][1] = nOA[_h][1]; } }
        if constexpr (ALIGN_EPI) { if (wr == 1) PG8_BAR; }
    }
    PG8_WAIT_V(0);
    if constexpr (!ALIGN_EPI) { if (wr == 0) PG8_BAR; }
    PG8_BAR;
    if constexpr (Epi::AFTER_DRAIN) { E.fused(acc, cur, wr, wc, fr, fq, lds, wid, lane); S.done(cur); }
#undef PG8_SA
#undef PG8_SB
#undef PG8_STAGE
#undef PG8_LDA
#undef PG8_STAGE_A
#undef PG8_GOFF
#undef PG8_LDB
#undef PG8_MMA
#undef PG8_WAIT_V
#undef PG8_WAIT_L
#undef PG8_BAR
#undef PG8_SCHED
}
}

constexpr int NB = 4, S = 4096, D = 1024, T = NB * S;
constexpr int CONV_CH = 512, CONV_W = 31, NH = 8, INC = 2560;
constexpr int SG = 64, SC = 16, SP = 64;
constexpr int NE = 16, CAP = 512, EH = 1024, MR = NB * NE * CAP;
constexpr float EPS = 1e-6f;
constexpr int NWAVES = 8, NTHR = NWAVES * 64;

constexpr size_t MiB = 1u << 20;
constexpr size_t WS_CTL = 0, CTL_ZERO_BYTES = 64 * 1024;
constexpr size_t WS_AFF = 1 * MiB, WS_IDX = 2 * MiB, WS_GATE = 2 * MiB + 512 * 1024, WS_SLOT = 3 * MiB;
constexpr size_t WS_RS = 2 * MiB + 256 * 1024, WS_RSROW = 2 * MiB + 768 * 1024;
constexpr size_t WS_WIN = 4 * MiB, WS_WOUT = 10 * MiB, WS_WGLU = 12 * MiB;
constexpr size_t WS_WEXP = 16 * MiB, WEXP_LAYER = 96 * MiB, WEXP_GU = 0, WEXP_DN = 64 * MiB;
constexpr size_t WS_XN = 208 * MiB, WS_MIXED = 240 * MiB;
constexpr size_t WS_PROJ = 272 * MiB;
constexpr size_t WS_H = 336 * MiB;
constexpr size_t WS_XA = 404 * MiB, WS_XB = 436 * MiB;
constexpr size_t WS_END = 492 * MiB;
constexpr int CW_BAR = 1024, CW_Q0 = 64;

constexpr int SCRATCH_BYTES = 143360;
constexpr int LDSCTL_OFF = SCRATCH_BYTES;
constexpr int LDS_BYTES = 147456;

#define GAS __attribute__((address_space(1)))
#define LAS __attribute__((address_space(3)))
typedef unsigned short bf16;
typedef unsigned v4u __attribute__((ext_vector_type(4)));
typedef unsigned v2u __attribute__((ext_vector_type(2)));
typedef float f32x4 __attribute__((ext_vector_type(4)));
typedef float f32x2 __attribute__((ext_vector_type(2)));
using pg8::pk2;
using pg8::sigm;
__device__ __forceinline__ float bf2f(unsigned short h) { return __uint_as_float(((unsigned)h) << 16); }
__device__ __forceinline__ float bflo(unsigned w) { return __uint_as_float(w << 16); }
__device__ __forceinline__ float bfhi(unsigned w) { return __uint_as_float(w & 0xffff0000u); }
__device__ __forceinline__ float wave_sum(float v) {
#pragma unroll
    for (int o = 1; o < 64; o <<= 1) v += __shfl_xor(v, o);
    return v;
}

#define XB_TMO      128
#define XB_XCNT(j)  (256  + 64 * (j))
#define XB_XSUB(j)  (1280 + 64 * (j))
#define XB_XGEN(j)  (2304 + 64 * (j))
#define XB_TOP      3328
#define XB_TOPGEN   3392
#define XCD_BAR_WORDS 3456
#define XB_SPIN_CAP (1u << 18)
__device__ __forceinline__ unsigned xb_ld(unsigned* p)              { return __hip_atomic_load(p, __ATOMIC_RELAXED, __HIP_MEMORY_SCOPE_AGENT); }
__device__ __forceinline__ unsigned xb_add(unsigned* p, unsigned v) { return __hip_atomic_fetch_add(p, v, __ATOMIC_RELAXED, __HIP_MEMORY_SCOPE_AGENT); }
__device__ __forceinline__ unsigned xb_xcc_id() { return (unsigned)__builtin_amdgcn_s_getreg((3 << 11) | 20) & 0xFu; }
#define XB_SPIN(cond, bar) do { unsigned _sp = 0; while (cond) { __builtin_amdgcn_s_sleep(1); \
    if ((++_sp & 255u) == 0u) { if (xb_ld(&(bar)[XB_TMO])) break; if (_sp > XB_SPIN_CAP) { atomicAdd(&(bar)[XB_TMO], 1u); break; } } } } while (0)
struct XcdBarrier { unsigned* bar; unsigned x; volatile LAS unsigned* st; };
__device__ __forceinline__ XcdBarrier xcd_barrier_post(unsigned* bar, volatile LAS unsigned* st) {
    XcdBarrier b; b.bar = bar; b.x = xb_xcc_id(); b.st = st;
    if (threadIdx.x == 0) (void)xb_add(&bar[XB_XCNT(b.x)], 1u);
    return b;
}
__device__ __forceinline__ void xcd_barrier_complete(unsigned* bar, unsigned x, unsigned& nloc, unsigned& nx) {
    const unsigned G = gridDim.x * gridDim.y * gridDim.z;
    unsigned sum, cnt, mine, sp = 0u;
    for (;;) {
        sum = 0u; cnt = 0u; mine = 0u;
#pragma unroll
        for (unsigned j = 0; j < 16; ++j) { const unsigned c = xb_ld(&bar[XB_XCNT(j)]); sum += c; cnt += (c > 0u) ? 1u : 0u; mine = (j == x) ? c : mine; }
        if (sum == G) break;
        __builtin_amdgcn_s_sleep(1);
        if ((++sp & 255u) == 0u) { if (xb_ld(&bar[XB_TMO])) break; if (sp > XB_SPIN_CAP) { atomicAdd(&bar[XB_TMO], 1u); break; } }
    }
    nloc = mine > 0u ? mine : 1u; nx = cnt > 0u ? cnt : 1u;
}
__device__ __forceinline__ void xcd_barrier(const XcdBarrier& b) {
    asm volatile("s_waitcnt vmcnt(0)" ::: "memory");
    __syncthreads();
    if (threadIdx.x == 0) {
        unsigned* bar = b.bar;
        __builtin_amdgcn_s_waitcnt(0);
        unsigned nloc = b.st[0], nx = b.st[1];
        if (nloc == 0u) { xcd_barrier_complete(bar, b.x, nloc, nx); b.st[0] = nloc; b.st[1] = nx; }
        const unsigned old = xb_add(&bar[XB_XSUB(b.x)], 1u);
        const unsigned gen = old / nloc;
        if (old + 1u == (gen + 1u) * nloc) {
            __builtin_amdgcn_fence(__ATOMIC_RELEASE, "agent");
            asm volatile("s_waitcnt vmcnt(0)" ::: "memory");
            const unsigned og = xb_add(&bar[XB_TOP], 1u);
            const unsigned tg = og / nx;
            if (og + 1u == (tg + 1u) * nx) xb_add(&bar[XB_TOPGEN], 1u);
            else XB_SPIN(xb_ld(&bar[XB_TOPGEN]) == tg, bar);
            __builtin_amdgcn_fence(__ATOMIC_ACQUIRE, "agent");
            xb_add(&bar[XB_XGEN(b.x)], 1u);
            asm volatile("s_waitcnt vmcnt(0)" ::: "memory");
        } else {
            XB_SPIN(xb_ld(&bar[XB_XGEN(b.x)]) == gen, bar);
            __builtin_amdgcn_fence(__ATOMIC_ACQUIRE, "agent");
            asm volatile("s_waitcnt vmcnt(0)" ::: "memory");
        }
    }
    __syncthreads();
}

struct Args {
    const float* in[26]; float* out; unsigned char* ws; int ph_lo, ph_hi;
};
struct Ctx { LAS unsigned char* lds; int tid, lane, wave, vcu, G; };

__device__ __forceinline__ int rowmap(int kind, int half, int n) {
    if (kind == 0) {
        if (n < 1024) { const int hf = n >> 9, r = n & 511; return 256 * (r >> 7) + 128 * hf + (r & 127); }
        const int pn = n >> 8, w = n & 255, wc = w >> 6, bj = (w >> 5) & 1, j = w & 31; return 256 * pn + 128 * bj + 32 * wc + j;
    }
    if (kind == 2) { const int hf = n >> 10, r = n & 1023; return 256 * (r >> 7) + 128 * hf + (r & 127); }
    if (kind == 3) return 256 * (n >> 7) + 128 * half + (n & 127);
    return n;
}
struct ConvDesc { const float* src; bf16* dst; const float* gsc; int N, kind, half, k0, n0; };
__device__ __forceinline__ bool conv_desc(const Args& a, int it, ConvDesc& d) {
    constexpr int I_IN = 16 * 40, I_OUT = 256, I_GLU = 16 * 32, I_EXP = 2 * 16 * 3 * 256;
    if (it >= I_IN + I_OUT + I_GLU + I_EXP) return false;
    unsigned char* ws = a.ws; int r = it, kb, nb; d.gsc = nullptr;
    if (r < I_IN) { d.src = a.in[2]; d.N = INC; d.dst = (bf16*)(ws + WS_WIN); d.kind = 0; d.half = 0; kb = r / 40; nb = r % 40; }
    else if ((r -= I_IN) < I_OUT) { d.src = a.in[9]; d.N = D; d.dst = (bf16*)(ws + WS_WOUT); d.kind = 1; d.half = 0; kb = r >> 4; nb = r & 15; }
    else if ((r -= I_OUT) < I_GLU) { d.src = a.in[19]; d.N = 2 * D; d.dst = (bf16*)(ws + WS_WGLU); d.kind = 2; d.half = 0; kb = r >> 5; nb = r & 31; }
    else { r -= I_GLU; const int mat = r >> 8, tile = r & 255, layer = mat / 48, rem = mat % 48, e = rem / 3, which = rem % 3;
        d.src = a.in[23 + which] + ((size_t)layer * NE + e) * (size_t)D * EH; d.N = EH;
        d.dst = (bf16*)(ws + WS_WEXP + layer * WEXP_LAYER + (which == 2 ? WEXP_DN + (size_t)e * 2 * MiB : WEXP_GU + (size_t)e * 4 * MiB));
        d.kind = which == 2 ? 1 : 3; d.half = which; kb = tile >> 4; nb = tile & 15; if (which != 2) d.gsc = a.in[20] + (size_t)layer * D; }
    d.k0 = 64 * kb; d.n0 = 64 * nb; return true;
}
__device__ __forceinline__ void conv_load(const ConvDesc& d, f32x4 (&v)[16], int lane) {
    const float* p = d.src + (size_t)(d.k0 + (lane >> 4)) * d.N + d.n0 + 4 * (lane & 15);
#pragma unroll
    for (int it = 0; it < 16; ++it) v[it] = *(const f32x4*)(p + (size_t)(4 * it) * d.N);
}
__device__ __forceinline__ void conv_store(const ConvDesc& d, const f32x4 (&v)[16], LAS float* scr, int lane) {
#pragma unroll
    for (int it = 0; it < 16; ++it) { const int kk = 4 * it + (lane >> 4), nn = 4 * (lane & 15); const float gs = d.gsc ? d.gsc[d.k0 + kk] : 1.f;
        scr[kk * 65 + nn] = v[it][0] * gs; scr[kk * 65 + nn + 1] = v[it][1] * gs; scr[kk * 65 + nn + 2] = v[it][2] * gs; scr[kk * 65 + nn + 3] = v[it][3] * gs; }
    asm volatile("s_waitcnt lgkmcnt(0)" ::: "memory");
    const int kc = lane & 7;
#pragma unroll
    for (int jt = 0; jt < 8; ++jt) {
        const int nl = 8 * jt + (lane >> 3);
        const LAS float* s = scr + (8 * kc) * 65 + nl;
        v4u o; o.x = pk2(s[0], s[65]); o.y = pk2(s[2 * 65], s[3 * 65]); o.z = pk2(s[4 * 65], s[5 * 65]); o.w = pk2(s[6 * 65], s[7 * 65]);
        *(v4u*)(d.dst + (size_t)rowmap(d.kind, d.half, d.n0 + nl) * 1024 + d.k0 + 8 * kc) = o;
    }
    asm volatile("s_waitcnt lgkmcnt(0)" ::: "memory");
}
__device__ __forceinline__ void rms_row_bf16(const float* __restrict__ xrow, const float* __restrict__ g, bf16* __restrict__ orow, int lane) {
    const f32x4* xr = (const f32x4*)xrow + lane;
    f32x4 v[4]; float s = 0.f;
#pragma unroll
    for (int j = 0; j < 4; ++j) { v[j] = xr[64 * j]; s += (v[j][0] * v[j][0] + v[j][1] * v[j][1]) + (v[j][2] * v[j][2] + v[j][3] * v[j][3]); }
    const float r = rsqrtf(wave_sum(s) * (1.f / D) + EPS);
#pragma unroll
    for (int j = 0; j < 4; ++j) { const f32x4 w = ((const f32x4*)g)[lane + 64 * j]; v2u o; o.x = pk2(v[j][0] * r * w[0], v[j][1] * r * w[1]); o.y = pk2(v[j][2] * r * w[2], v[j][3] * r * w[3]); ((v2u*)orow)[lane + 64 * j] = o; }
}
constexpr int CONV_NITEMS = 25984, CONV_FIRST_Q = 640, CW_P1DONE = 128;
__device__ __forceinline__ void conv_drain(const Ctx& C, const Args& a, bool until_flag) {
    LAS float* scr = (LAS float*)(C.lds + C.wave * 16640);
    unsigned* ctl = (unsigned*)(a.ws + WS_CTL);
    LAS int* qs = (LAS int*)(C.lds + 8 * 16640);
    ConvDesc dA; f32x4 vA[16];
    for (;;) {
        if (C.tid == 0) {
            int v = -1;
            if (!(until_flag && __hip_atomic_load(ctl + CW_P1DONE, __ATOMIC_RELAXED, __HIP_MEMORY_SCOPE_AGENT) != 0u))
                v = CONV_FIRST_Q + (int)__hip_atomic_fetch_add(ctl + CW_Q0, 8u, __ATOMIC_RELAXED, __HIP_MEMORY_SCOPE_AGENT);
            qs[0] = v;
        }
        __syncthreads();
        const int base = qs[0];
        __syncthreads();
        if (base < 0 || base >= CONV_NITEMS) break;
        if (conv_desc(a, base + C.wave, dA)) { conv_load(dA, vA, C.lane); conv_store(dA, vA, scr, C.lane); }
    }
}
__device__ __forceinline__ void p0_prologue(const Ctx& C, const Args& a) {
    LAS float* scr = (LAS float*)(C.lds + C.wave * 16640);
    const int gw = C.vcu * NWAVES + C.wave, NGW = C.G * NWAVES;
    unsigned char* ws = a.ws;
    {
        const float* x = a.in[0]; const float* gg = a.in[1]; bf16* XN = (bf16*)(ws + WS_XN); const int lane = C.lane;
        auto LOADR = [&](f32x4 (&v)[4], int m) __attribute__((always_inline)) { const f32x4* xr = (const f32x4*)(x + (size_t)m * D) + lane;
#pragma unroll
            for (int j = 0; j < 4; ++j) v[j] = xr[64 * j]; };
        auto PROC = [&](const f32x4 (&v)[4], int m) __attribute__((always_inline)) { float s = 0.f;
#pragma unroll
            for (int j = 0; j < 4; ++j) s += (v[j][0] * v[j][0] + v[j][1] * v[j][1]) + (v[j][2] * v[j][2] + v[j][3] * v[j][3]);
            const float r = rsqrtf(wave_sum(s) * (1.f / D) + EPS);
#pragma unroll
            for (int j = 0; j < 4; ++j) { const f32x4 w = ((const f32x4*)gg)[lane + 64 * j]; v2u o; o.x = pk2(v[j][0] * r * w[0], v[j][1] * r * w[1]); o.y = pk2(v[j][2] * r * w[2], v[j][3] * r * w[3]); ((v2u*)(XN + (size_t)m * D))[lane + 64 * j] = o; } };
        f32x4 va[4], vb[4]; int m = gw;
        if (m < T) LOADR(va, m);
        for (; m < T; m += 2 * NGW) { if (m + NGW < T) LOADR(vb, m + NGW); PROC(va, m); if (m + 2 * NGW < T) LOADR(va, m + 2 * NGW); if (m + NGW < T) PROC(vb, m + NGW); }
    }
    ConvDesc dA; f32x4 vA[16];
    for (int it = gw; it < CONV_FIRST_Q; it += NGW) if (conv_desc(a, it, dA)) { conv_load(dA, vA, C.lane); conv_store(dA, vA, scr, C.lane); }
}

__device__ __forceinline__ void conv_phase(const Ctx& C, const Args& a) {
    const bf16* GLU = (const bf16*)(a.ws + WS_PROJ);
    bf16* MIXED = (bf16*)(a.ws + WS_MIXED);
    const float* cw = a.in[3]; const float* cb = a.in[4]; const float* lg = a.in[5]; const float* lb = a.in[6];
    LAS float* tl = (LAS float*)C.lds;
    const int cp = C.tid & 255, th = C.tid >> 8, lane = C.lane, wave = C.wave;
    f32x2 w[CONV_W];
#pragma unroll
    for (int j = 0; j < CONV_W; ++j) w[j] = *(const f32x2*)(cw + j * CONV_CH + 2 * cp);
    const f32x2 bias = *(const f32x2*)(cb + 2 * cp);
    auto LOADT = [&](unsigned (&xin)[46], int tile) __attribute__((always_inline)) {
        const int b = tile / (S / 32), s0 = (tile % (S / 32)) * 32;
#pragma unroll
        for (int i = 0; i < 46; ++i) { const int ss = s0 + 16 * th - 15 + i; xin[i] = (ss >= 0 && ss < S) ? *(const unsigned*)(GLU + (size_t)(b * S + ss) * 512 + 2 * cp) : 0u; } };
    auto PROC = [&](const unsigned (&xin)[46], unsigned (&xn)[46], int tile, int nt) __attribute__((always_inline)) {
        const int b = tile / (S / 32), s0 = (tile % (S / 32)) * 32;
        f32x2 acc[16];
#pragma unroll
        for (int k = 0; k < 16; ++k) acc[k] = bias;
#pragma unroll
        for (int i = 0; i < 46; ++i) {
            unsigned xi = xin[i]; asm volatile("" : "+v"(xi));
            const f32x2 x = {bflo(xi), bfhi(xi)};
#pragma unroll
            for (int k = 0; k < 16; ++k) { const int j = i - k; if (j >= 0 && j < CONV_W) acc[k] += w[j] * x; }
        }
        if (nt < T / 32) LOADT(xn, nt);
#pragma unroll
        for (int k = 0; k < 16; ++k) *(LAS f32x2*)(tl + (16 * th + k) * 512 + 2 * cp) = acc[k];
        __syncthreads();
#pragma unroll
        for (int q = 0; q < 4; ++q) {
            const int tok = 4 * wave + q;
            const f32x4 v0 = *(const LAS f32x4*)(tl + tok * 512 + 8 * lane), v1 = *(const LAS f32x4*)(tl + tok * 512 + 8 * lane + 4);
            const float mu = wave_sum((v0[0] + v0[1]) + (v0[2] + v0[3]) + (v1[0] + v1[1]) + (v1[2] + v1[3])) * (1.f / CONV_CH);
            const f32x4 d0 = v0 - mu, d1 = v1 - mu;
            const float var = wave_sum((d0[0] * d0[0] + d0[1] * d0[1]) + (d0[2] * d0[2] + d0[3] * d0[3]) + (d1[0] * d1[0] + d1[1] * d1[1]) + (d1[2] * d1[2] + d1[3] * d1[3])) * (1.f / CONV_CH);
            const float rs = rsqrtf(var + EPS);
            const f32x4 g0 = *(const f32x4*)(lg + 8 * lane), g1 = *(const f32x4*)(lg + 8 * lane + 4), b0 = *(const f32x4*)(lb + 8 * lane), b1 = *(const f32x4*)(lb + 8 * lane + 4);
            f32x4 y0 = d0 * rs * g0 + b0, y1 = d1 * rs * g1 + b1;
#pragma unroll
            for (int e = 0; e < 4; ++e) { y0[e] = y0[e] * sigm(y0[e]); y1[e] = y1[e] * sigm(y1[e]); }
            v4u o; o.x = pk2(y0[0], y0[1]); o.y = pk2(y0[2], y0[3]); o.z = pk2(y1[0], y1[1]); o.w = pk2(y1[2], y1[3]);
            *(v4u*)(MIXED + (size_t)(b * S + s0 + tok) * D + 8 * lane) = o;
        }
        __syncthreads();
    };
    unsigned xa[46];
    int t = C.vcu;
    if (t < T / 32) LOADT(xa, t);
#pragma unroll 1
    for (; t < T / 32; t += C.G) PROC(xa, xa, t, t + C.G);
}
typedef short bf16x8 __attribute__((ext_vector_type(8)));
typedef short s16x4 __attribute__((ext_vector_type(4)));
typedef short v4i16_t __attribute__((ext_vector_type(4)));
typedef float f32x16 __attribute__((ext_vector_type(16)));
constexpr int AT_O = 0, AT_L = 65536, AT_V = 66560;
__device__ __forceinline__ s16x4 vtr(const LAS char* p) { return __builtin_bit_cast(s16x4, __builtin_amdgcn_ds_read_tr16_b64_v4i16((LAS v4i16_t*)p)); }
__device__ __forceinline__ void lds_addf(LAS float* p, float v) { (void)__hip_atomic_fetch_add(p, v, __ATOMIC_RELAXED, __HIP_MEMORY_SCOPE_WORKGROUP); }
__device__ __forceinline__ int med3i(int x, int lo, int hi) { return x < lo ? lo : (x > hi ? hi : x); }
__device__ __forceinline__ void attn_unit(const Ctx& C, const bf16* __restrict__ Qh, const bf16* __restrict__ Kh, const bf16* __restrict__ Vh,
                                          int d, int tq0, int nq, int tl0, int tls, float a2, float bound2, LAS float* Oacc, LAS float* Lacc, LAS char* vst, bool first) {
    int lane_ = C.lane; asm volatile("" : "+v"(lane_));
    const int lane = lane_, r = lane & 31, hh = lane >> 5;
    const int qi = r < nq ? r : nq - 1;
    bf16x8 qf[4]; v4u ks_[2][4], vs[2][4];
    const char* Kc = (const char*)Kh; const char* Vc = (const char*)Vh;
#define AT_LOADK(kb) do { _Pragma("unroll") for (int it = 0; it < 4; ++it) { const int key = (lane >> 3) + 8 * it; \
        const unsigned ro = (unsigned)med3i(tq0 + d * (32 * (kb) + key - 64), 0, S - 1) * 128u + 16u * (lane & 7); ks_[(kb) % 2][it] = *(const v4u*)(Kc + ro); } } while (0)
#define AT_LOADV(kb) do { _Pragma("unroll") for (int it = 0; it < 4; ++it) { const int key = (lane >> 3) + 8 * it; \
        const unsigned ro = (unsigned)med3i(tq0 + d * (32 * (kb) + key - 64), 0, S - 1) * 128u + 16u * (lane & 7); vs[(kb) % 2][it] = *(const v4u*)(Vc + ro); } } while (0)
    { const char* qp = (const char*)Qh + (unsigned)(tq0 + d * qi) * 128u + 16u * hh;
#pragma unroll
      for (int ks = 0; ks < 4; ++ks) qf[ks] = *(const bf16x8*)(qp + 32 * ks); }
    AT_LOADK(0); AT_LOADV(0);
    f32x16 o0, o1;
#pragma unroll
    for (int v = 0; v < 16; ++v) { o0[v] = 0.f; o1[v] = 0.f; }
    float lsum = 0.f;
    LAS char* kst = vst, *vt = vst + 4096;
    const LAS char* vb = vt + ((lane >> 4) & 1) * 32 + (lane & 3) * 8 + (4 * hh + ((lane & 15) >> 2)) * 64;
    LAS char* vw = vt + ((lane & 7) >> 2) * 2048 + ((lane >> 3) & 15) * 64 + (lane & 3) * 16;
    LAS char* kw = kst + (lane >> 3) * 128;
    const LAS char* kr = kst + r * 128;
    const int rsw = (r >> 1) & 7;
#pragma unroll
    for (int kb = 0; kb < 5; ++kb) {
        if (kb + 1 < 5) { AT_LOADK(kb + 1); AT_LOADV(kb + 1); }
#pragma unroll
        for (int it = 0; it < 4; ++it) { const int key = (lane >> 3) + 8 * it;
            *(LAS v4u*)(kw + it * 1024 + (((lane & 7) ^ ((key >> 1) & 7)) << 4)) = ks_[kb % 2][it]; }
        f32x16 p;
        int relb = 32 * kb - 64 - r + 4 * hh; const int kposb = tq0 + d * (32 * kb - 64 + 4 * hh);
        asm volatile("" : "+v"(relb));
#pragma unroll
        for (int v = 0; v < 16; ++v) {
            const int rw = (v & 3) + 8 * (v >> 2), rel = relb + rw, kpos = kposb + d * rw;
            bool valid = ((unsigned)kpos < (unsigned)S) && (r < nq);
            if (kb == 0) valid = valid && (rel >= -64);
            if (kb == 4) valid = valid && (rel <= 64);
            p[v] = valid ? -(a2 * fabsf((float)rel)) - bound2 : -1e30f;
        }
        asm volatile("s_waitcnt lgkmcnt(0)" ::: "memory");
        bf16x8 kf[4];
#pragma unroll
        for (int ks = 0; ks < 4; ++ks) kf[ks] = *(const LAS bf16x8*)(kr + (((2 * ks + hh) ^ rsw) << 4));
#pragma unroll
        for (int ks = 0; ks < 4; ++ks) p = __builtin_amdgcn_mfma_f32_32x32x16_bf16(kf[ks], qf[ks], p, 0, 0, 0);
#pragma unroll
        for (int it = 0; it < 4; ++it) *(LAS v4u*)(vw + (it >> 1) * 1024 + (it & 1) * 512) = vs[kb % 2][it];
#pragma unroll
        for (int v = 0; v < 16; ++v) { p[v] = __builtin_amdgcn_exp2f(p[v]); lsum += p[v]; }
        v4u pw0, pw1;
        pw0.x = pk2(p[0], p[1]); pw0.y = pk2(p[2], p[3]); pw0.z = pk2(p[4], p[5]); pw0.w = pk2(p[6], p[7]);
        pw1.x = pk2(p[8], p[9]); pw1.y = pk2(p[10], p[11]); pw1.z = pk2(p[12], p[13]); pw1.w = pk2(p[14], p[15]);
        asm volatile("s_waitcnt lgkmcnt(0)" ::: "memory");
#pragma unroll
        for (int sdh = 0; sdh < 4; ++sdh) {
            const int dh = sdh >> 1, ss = sdh & 1;
            const s16x4 lo = vtr(vb + dh * 2048 + ss * 1024), hi = vtr(vb + dh * 2048 + ss * 1024 + 512);
            const bf16x8 vf = {lo[0], lo[1], lo[2], lo[3], hi[0], hi[1], hi[2], hi[3]};
            const bf16x8 pa = __builtin_bit_cast(bf16x8, ss == 0 ? pw0 : pw1);
            if (dh == 0) o0 = __builtin_amdgcn_mfma_f32_32x32x16_bf16(pa, vf, o0, 0, 0, 0);
            else o1 = __builtin_amdgcn_mfma_f32_32x32x16_bf16(pa, vf, o1, 0, 0, 0);
        }
        asm volatile("s_waitcnt lgkmcnt(0)" ::: "memory");
    }
#undef AT_LOADK
#undef AT_LOADV
    lsum += __shfl_xor(lsum, 32);
    if (lane < nq) { LAS float* lp = Lacc + tl0 + tls * lane; *lp = first ? lsum : *lp + lsum; }
#pragma unroll
    for (int v = 0; v < 16; ++v) {
        const int iq = (v & 3) + 8 * (v >> 2) + 4 * hh;
        if (v < 8 || nq == 32) { LAS float* op = Oacc + (tl0 + tls * iq) * 64 + r;
            if (first) { op[0] = o0[v]; op[32] = o1[v]; } else { const float x0 = op[0], x1 = op[32]; op[0] = x0 + o0[v]; op[32] = x1 + o1[v]; } }
    }
}
__device__ __forceinline__ void attn_phase(const Ctx& C, const Args& a) {
    const bf16* Q = (const bf16*)(a.ws + WS_PROJ + 16 * MiB);
    const bf16* K = (const bf16*)(a.ws + WS_PROJ + 32 * MiB);
    const bf16* V = (const bf16*)(a.ws + WS_PROJ + 48 * MiB);
    bf16* MIXED = (bf16*)(a.ws + WS_MIXED);
    LAS float* Oacc = (LAS float*)(C.lds + AT_O); LAS float* Lacc = (LAS float*)(C.lds + AT_L); LAS char* vst = (LAS char*)(C.lds + AT_V + C.wave * 8192);
    float mq = fabsf(a.in[7][C.lane]), mk = fabsf(a.in[8][C.lane]);
#pragma unroll
    for (int o = 1; o < 64; o <<= 1) { mq = fmaxf(mq, __shfl_xor(mq, o)); mk = fmaxf(mk, __shfl_xor(mk, o)); }
    const float bound2 = 64.f * pg8::QSCALE * mq * mk * 1.01f;
    for (int item = C.vcu; item < NB * NH * 16; item += C.G) {
        const int span = item & 15, h = (item >> 4) & 7, b = item >> 7, t0 = span * 256, w = C.wave;
        const size_t hb = (size_t)(b * NH + h) * S * 64;
        const bf16 *Qh = Q + hb, *Kh = K + hb, *Vh = V + hb;
        const float slope2 = exp2f(-(float)(h + 1)) * 1.4426950408889634f;
#pragma unroll 1
        for (int un = 0; un < 4; ++un) {
            const int d = un == 0 ? 1 : (un == 1 ? 4 : 16);
            const int tl0 = un == 0 ? 32 * w : (un == 1 ? (w >> 1) + 128 * (w & 1) : 2 * w + (un - 2));
            attn_unit(C, Qh, Kh, Vh, d, t0 + tl0, un < 2 ? 32 : 16, tl0, d, slope2 * (float)d, bound2, Oacc, Lacc, vst, un == 0);
            if (un < 2) __syncthreads();
        }
        __syncthreads();
        {
            const int q = C.tid >> 1, hf = C.tid & 1;
            const float inv = 1.f / Lacc[q];
            const LAS f32x4* op = (const LAS f32x4*)(Oacc + q * 64 + 32 * hf);
            bf16* dst = MIXED + (size_t)(b * S + t0 + q) * D + 512 + h * 64 + 32 * hf;
#pragma unroll
            for (int j = 0; j < 4; ++j) { const f32x4 x0 = op[2 * j] * inv, x1 = op[2 * j + 1] * inv; v4u o; o.x = pk2(x0[0], x0[1]); o.y = pk2(x0[2], x0[3]); o.z = pk2(x1[0], x1[1]); o.w = pk2(x1[2], x1[3]); *(v4u*)(dst + 8 * j) = o; }
        }
        __syncthreads();
    }
}

__device__ __forceinline__ void p_router(const Ctx& C, const Args& a, int layer) {
    const bf16* X = (const bf16*)(a.ws + (layer == 0 ? WS_XA : WS_XB)); const float* g = a.in[20] + (size_t)layer * D;
    const float* wr = a.in[21] + (size_t)layer * D * NE; const float* br = a.in[22] + layer * NE;
    float* RS = (float*)(a.ws + WS_RS); float* AFF = (float*)(a.ws + WS_AFF);
    LAS float* wl = (LAS float*)C.lds;
    for (int i = C.tid; i < D * 4; i += NTHR) { const int k = i >> 2, qd = i & 3; const f32x4 v = *(const f32x4*)(wr + (size_t)k * NE + 4 * qd);
        const int slot = (k & 15) * 64 + (k >> 4); *(LAS f32x4*)(wl + slot * 20 + 4 * qd) = v; }
    __syncthreads();
    const int gw = C.vcu * NWAVES + C.wave, NGW = C.G * NWAVES, lane = C.lane;
    auto LOADR = [&](v4u (&v)[2], int m) __attribute__((always_inline)) { const v4u* xr = (const v4u*)(X + (size_t)m * D) + 2 * lane; v[0] = xr[0]; v[1] = xr[1]; };
    auto PROC = [&](const v4u (&vr)[2], int m) __attribute__((always_inline)) {
        f32x4 v[4];
        v[0] = (f32x4){bflo(vr[0].x), bfhi(vr[0].x), bflo(vr[0].y), bfhi(vr[0].y)}; v[1] = (f32x4){bflo(vr[0].z), bfhi(vr[0].z), bflo(vr[0].w), bfhi(vr[0].w)};
        v[2] = (f32x4){bflo(vr[1].x), bfhi(vr[1].x), bflo(vr[1].y), bfhi(vr[1].y)}; v[3] = (f32x4){bflo(vr[1].z), bfhi(vr[1].z), bflo(vr[1].w), bfhi(vr[1].w)};
        float s = 0.f;
#pragma unroll
        for (int j = 0; j < 4; ++j) s += (v[j][0] * v[j][0] + v[j][1] * v[j][1]) + (v[j][2] * v[j][2] + v[j][3] * v[j][3]);
        const float r = rsqrtf(wave_sum(s) * (1.f / D) + EPS);
        if (lane == 0) RS[m] = r;
        float acc[NE];
#pragma unroll
        for (int e = 0; e < NE; ++e) acc[e] = 0.f;
#pragma unroll
        for (int j = 0; j < 4; ++j) {
            const f32x4 w = ((const f32x4*)g)[4 * lane + j];
            const f32x4 hv = v[j] * w * r;
#pragma unroll
            for (int i = 0; i < 4; ++i) {
                const LAS float* wp = wl + ((j * 4 + i) * 64 + lane) * 20;
#pragma unroll
                for (int qd = 0; qd < 4; ++qd) { const f32x4 ww = *(const LAS f32x4*)(wp + 4 * qd); acc[4 * qd] += hv[i] * ww[0]; acc[4 * qd + 1] += hv[i] * ww[1]; acc[4 * qd + 2] += hv[i] * ww[2]; acc[4 * qd + 3] += hv[i] * ww[3]; }
                if (i & 1) asm volatile("" ::: "memory");
            }
        }
#pragma unroll
        for (int i = 0; i < 8; ++i) { const bool up = lane & 32; const float keep = up ? acc[i + 8] : acc[i], give = up ? acc[i] : acc[i + 8]; acc[i] = keep + __shfl_xor(give, 32); }
#pragma unroll
        for (int i = 0; i < 4; ++i) { const bool up = lane & 16; const float keep = up ? acc[i + 4] : acc[i], give = up ? acc[i] : acc[i + 4]; acc[i] = keep + __shfl_xor(give, 16); }
#pragma unroll
        for (int i = 0; i < 2; ++i) { const bool up = lane & 8; const float keep = up ? acc[i + 2] : acc[i], give = up ? acc[i] : acc[i + 2]; acc[i] = keep + __shfl_xor(give, 8); }
        { const bool up = lane & 4; const float keep = up ? acc[1] : acc[0], give = up ? acc[0] : acc[1]; acc[0] = keep + __shfl_xor(give, 4); }
        float lg = acc[0]; lg += __shfl_xor(lg, 2); lg += __shfl_xor(lg, 1);
        const int e = ((lane >> 5) & 1) * 8 + ((lane >> 4) & 1) * 4 + ((lane >> 3) & 1) * 2 + ((lane >> 2) & 1);
        lg += br[e];
        float mx = lg;
#pragma unroll
        for (int o = 4; o < 64; o <<= 1) mx = fmaxf(mx, __shfl_xor(mx, o));
        const float ex = __expf(lg - mx); float sum = ex;
#pragma unroll
        for (int o = 4; o < 64; o <<= 1) sum += __shfl_xor(sum, o);
        const int b = m / S, ss = m % S;
        if ((lane & 3) == 0) AFF[((size_t)b * NE + e) * S + ss] = ex / sum;
    };
    v4u va[2], vb[2];
    int m = gw;
    if (m < T) LOADR(va, m);
    for (; m < T; m += 2 * NGW) {
        if (m + NGW < T) LOADR(vb, m + NGW);
        PROC(va, m);
        if (m + 2 * NGW < T) LOADR(va, m + 2 * NGW);
        if (m + NGW < T) PROC(vb, m + NGW);
    }
    __syncthreads();
}

__device__ __forceinline__ int popc64(unsigned long long m) { return __builtin_popcountll(m); }
__device__ __forceinline__ void p_topk(const Ctx& C, const Args& a) {
    const float* AFF = (const float*)(a.ws + WS_AFF);
    int* IDX = (int*)(a.ws + WS_IDX); float* GATE = (float*)(a.ws + WS_GATE); int* SLOT = (int*)(a.ws + WS_SLOT);
    const float* RS = (const float*)(a.ws + WS_RS); float* RSROW = (float*)(a.ws + WS_RSROW);
    LAS int* red = (LAS int*)C.lds;
    const int lane = C.lane, w = C.wave;
    for (int be = C.vcu; be < NB * NE; be += C.G) {
        const int b = be / NE, e = be % NE;
        unsigned key[8];
        { const v4u k0 = *(const v4u*)(AFF + (size_t)be * S + 512 * w + 8 * lane), k1 = *(const v4u*)(AFF + (size_t)be * S + 512 * w + 8 * lane + 4);
          key[0] = k0.x; key[1] = k0.y; key[2] = k0.z; key[3] = k0.w; key[4] = k1.x; key[5] = k1.y; key[6] = k1.z; key[7] = k1.w; }
        unsigned cur = 0u;
#pragma unroll 1
        for (int bit = 30; bit >= 0; --bit) {
            const unsigned cand = cur | (1u << bit);
            unsigned c = 0;
#pragma unroll
            for (int i = 0; i < 8; ++i) c += (key[i] >= cand) ? 1u : 0u;
            int cnt = 0;
#pragma unroll
            for (int k = 0; k < 4; ++k) cnt += popc64(__ballot((c >> k) & 1u)) << k;
            const int par = bit & 1;
            if (lane == 0) red[par * 8 + w] = cnt;
            __syncthreads();
            int tot = 0;
#pragma unroll
            for (int ww = 0; ww < 8; ++ww) tot += red[par * 8 + ww];
            if (tot >= CAP) cur = cand;
        }
        unsigned pk = 0;
#pragma unroll
        for (int i = 0; i < 8; ++i) pk += (key[i] > cur ? 1u : 0u) + (key[i] == cur ? 0x10000u : 0u);
        unsigned inc = pk;
#pragma unroll
        for (int o = 1; o < 64; o <<= 1) { const unsigned t = __shfl_up(inc, o); if (lane >= o) inc += t; }
        if (lane == 63) { red[16 + w] = (int)(inc & 0xffffu); red[24 + w] = (int)(inc >> 16); }
        __syncthreads();
        int gpre = 0, epre = 0, ngt = 0;
#pragma unroll
        for (int ww = 0; ww < 8; ++ww) { const int tg = red[16 + ww], te = red[24 + ww]; ngt += tg; if (ww < w) { gpre += tg; epre += te; } }
        const int need = CAP - ngt;
        const unsigned exc = inc - pk;
        int gtb = gpre + (int)(exc & 0xffffu), eqb = epre + (int)(exc >> 16);
#pragma unroll
        for (int i = 0; i < 8; ++i) {
            const bool gt = key[i] > cur, eq = key[i] == cur;
            const bool sel = gt || (eq && eqb < need);
            const int pos = gtb + (eqb < need ? eqb : need);
            const int tok = 512 * w + 8 * lane + i;
            SLOT[((size_t)(b * S + tok)) * NE + e] = sel ? pos : -1;
            if (sel) { IDX[be * CAP + pos] = b * S + tok; GATE[be * CAP + pos] = __uint_as_float(key[i]); RSROW[be * CAP + pos] = RS[b * S + tok]; }
            gtb += gt ? 1 : 0; eqb += eq ? 1 : 0;
        }
        __syncthreads();
    }
}

__device__ __forceinline__ void p_combine(const Ctx& C, const Args& a, bool with_norm) {
    const bf16* Xin = (const bf16*)(a.ws + (with_norm ? WS_XA : WS_XB)); bf16* Xb = (bf16*)(a.ws + WS_XB); float* Xout = a.out;
    const bf16* Y = (const bf16*)(a.ws + WS_PROJ); const int* SLOT = (const int*)(a.ws + WS_SLOT);
    bf16* UC = (bf16*)(a.ws + WS_H); const float* g = a.in[10];
    const int gw = C.vcu * NWAVES + C.wave, NGW = C.G * NWAVES, lane = C.lane;
    auto LOADR = [&](v4u (&v)[2], int& slot, int m) __attribute__((always_inline)) { const v4u* xr = (const v4u*)(Xin + (size_t)m * D) + 2 * lane; v[0] = xr[0]; v[1] = xr[1];
        slot = (lane < NE) ? SLOT[(size_t)m * NE + lane] : -1; };
    auto PROC = [&](const v4u (&vr)[2], int myslot, int m) __attribute__((always_inline)) {
        const int b = m / S;
        f32x4 v[4];
        v[0] = (f32x4){bflo(vr[0].x), bfhi(vr[0].x), bflo(vr[0].y), bfhi(vr[0].y)}; v[1] = (f32x4){bflo(vr[0].z), bfhi(vr[0].z), bflo(vr[0].w), bfhi(vr[0].w)};
        v[2] = (f32x4){bflo(vr[1].x), bfhi(vr[1].x), bflo(vr[1].y), bfhi(vr[1].y)}; v[3] = (f32x4){bflo(vr[1].z), bfhi(vr[1].z), bflo(vr[1].w), bfhi(vr[1].w)};
        unsigned long long mask = __ballot(myslot >= 0);
        while (mask) {
            v2u y[4][4]; int ee[4];
#pragma unroll
            for (int q = 0; q < 4; ++q) { ee[q] = mask ? (int)__builtin_ctzll(mask) : -1; if (mask) mask &= mask - 1; }
#pragma unroll
            for (int q = 0; q < 4; ++q) if (ee[q] >= 0) { const int sl = __shfl(myslot, ee[q]);
                const v2u* yr = (const v2u*)(Y + ((size_t)(b * NE + ee[q]) * CAP + sl) * D) + 4 * lane;
#pragma unroll
                for (int j = 0; j < 4; ++j) y[q][j] = yr[j]; }
#pragma unroll
            for (int q = 0; q < 4; ++q) if (ee[q] >= 0) {
#pragma unroll
                for (int j = 0; j < 4; ++j) { v[j][0] += bflo(y[q][j].x); v[j][1] += bfhi(y[q][j].x); v[j][2] += bflo(y[q][j].y); v[j][3] += bfhi(y[q][j].y); } }
        }
        if (!with_norm) { f32x4* xo = (f32x4*)(Xout + (size_t)m * D) + 4 * lane;
#pragma unroll
            for (int j = 0; j < 4; ++j) xo[j] = v[j]; }
        else { v4u o0, o1; o0.x = pk2(v[0][0], v[0][1]); o0.y = pk2(v[0][2], v[0][3]); o0.z = pk2(v[1][0], v[1][1]); o0.w = pk2(v[1][2], v[1][3]);
            o1.x = pk2(v[2][0], v[2][1]); o1.y = pk2(v[2][2], v[2][3]); o1.z = pk2(v[3][0], v[3][1]); o1.w = pk2(v[3][2], v[3][3]);
            v4u* xo = (v4u*)(Xb + (size_t)m * D) + 2 * lane; xo[0] = o0; xo[1] = o1; }
        if (with_norm) {
            float s = 0.f;
#pragma unroll
            for (int j = 0; j < 4; ++j) s += (v[j][0] * v[j][0] + v[j][1] * v[j][1]) + (v[j][2] * v[j][2] + v[j][3] * v[j][3]);
            const float r = rsqrtf(wave_sum(s) * (1.f / D) + EPS);
            unsigned w[8];
#pragma unroll
            for (int j = 0; j < 4; ++j) { const f32x4 gg = ((const f32x4*)g)[4 * lane + j]; w[2 * j] = pk2(v[j][0] * r * gg[0], v[j][1] * r * gg[1]); w[2 * j + 1] = pk2(v[j][2] * r * gg[2], v[j][3] * r * gg[3]); }
            bf16* up = UC + ((size_t)(lane * 1024 + (m >> 4)) * 512 + (m & 15) * 16);
            *(v4u*)up = (v4u){w[0], w[1], w[2], w[3]}; *(v4u*)(up + 8) = (v4u){w[4], w[5], w[6], w[7]};
        }
    };
    v4u va[2], vb[2]; int sa = -1, sb = -1;
    int m = gw;
    if (m < T) LOADR(va, sa, m);
    for (; m < T; m += 2 * NGW) {
        if (m + NGW < T) LOADR(vb, sb, m + NGW);
        PROC(va, sa, m);
        if (m + 2 * NGW < T) LOADR(va, sa, m + 2 * NGW);
        if (m + NGW < T) PROC(vb, sb, m + NGW);
    }
}

constexpr size_t WS_UC = WS_H;
constexpr size_t WS_E = WS_PROJ;
constexpr size_t WS_TM = 468 * MiB;
constexpr size_t WS_W16 = 484 * MiB;
__device__ __forceinline__ void s5_lambda(const Args& a, int pg, int p, float& lbr, float& lbi, float& fr, float& fi) {
    const float lr = a.in[11][pg * SP + p], li = a.in[12][pg * SP + p], dt = expf(a.in[13][pg]);
    const float mag = expf(lr * dt), ang = li * dt;
    lbr = mag * cosf(ang); lbi = mag * sinf(ang);
    const float den = lr * lr + li * li, nr = lbr - 1.f;
    fr = (nr * lr + lbi * li) / den; fi = (lbi * lr - nr * li) / den;
}
__device__ __forceinline__ void p_s5_pre(const Ctx& C, const Args& a, int g) {
    LAS float* lam = (LAS float*)C.lds; LAS float* bb = lam + 2 * 64 * 17 * 2; LAS float* cc = bb + 2 * 64 * 16 * 2; LAS float* Kt = cc + 2 * 16 * 64 * 2;
    bf16* TM = (bf16*)(a.ws + WS_TM) + (size_t)g * 256 * 512; bf16* W16 = (bf16*)(a.ws + WS_W16) + (size_t)g * 256 * 256;
    const int tid = C.tid;
    if (tid < 128) {
        const int dir = tid >> 6, p = tid & 63, pg = dir * SG + g;
        float lbr, lbi, fr, fi; s5_lambda(a, pg, p, lbr, lbi, fr, fi);
        float pr = 1.f, pi = 0.f;
        for (int k = 0; k <= 16; ++k) { lam[((dir * 64 + p) * 17 + k) * 2] = pr; lam[((dir * 64 + p) * 17 + k) * 2 + 1] = pi; const float nr = pr * lbr - pi * lbi, ni = pr * lbi + pi * lbr; pr = nr; pi = ni; }
        for (int c = 0; c < 16; ++c) { const float br = a.in[14][((size_t)pg * SP + p) * SC + c], bi = a.in[15][((size_t)pg * SP + p) * SC + c];
            bb[((dir * 64 + p) * 16 + c) * 2] = fr * br - fi * bi; bb[((dir * 64 + p) * 16 + c) * 2 + 1] = fr * bi + fi * br; }
    }
    for (int i = tid; i < 2048; i += NTHR) { const int dir = i >> 10, r = i & 1023;
        cc[i * 2] = a.in[16][(size_t)(dir * SG + g) * 1024 + r]; cc[i * 2 + 1] = a.in[17][(size_t)(dir * SG + g) * 1024 + r]; }
    __syncthreads();
    for (int id = tid; id < 8192; id += NTHR) {
        const int dir = id >> 12, k = (id >> 8) & 15, cp = (id >> 4) & 15, c = id & 15; float acc = 0.f;
        for (int p = 0; p < 64; ++p) {
            const float cr = cc[((dir * 16 + cp) * 64 + p) * 2], ci = cc[((dir * 16 + cp) * 64 + p) * 2 + 1];
            const float lr = lam[((dir * 64 + p) * 17 + k) * 2], li = lam[((dir * 64 + p) * 17 + k) * 2 + 1];
            const float xr = cr * lr - ci * li, xi = cr * li + ci * lr;
            acc += xr * bb[((dir * 64 + p) * 16 + c) * 2] - xi * bb[((dir * 64 + p) * 16 + c) * 2 + 1];
        }
        Kt[id] = acc;
    }
    __syncthreads();
    const float* dsk = a.in[18] + g * 16;
    for (int e8 = tid; e8 < 256 * 64; e8 += NTHR) {
        const int n = e8 >> 6, ch = e8 & 63, t = n >> 4, cp = n & 15; float v[8];
        if (ch < 32) {
            const int s_ = ch >> 1, c0 = (ch & 1) * 8;
#pragma unroll
            for (int i = 0; i < 8; ++i) { const int c = c0 + i; float x = 0.f;
                if (s_ <= t) x += Kt[((0 * 16 + (t - s_)) * 16 + cp) * 16 + c];
                if (s_ >= t) x += Kt[((1 * 16 + (s_ - t)) * 16 + cp) * 16 + c];
                if (s_ == t && c == cp) x += dsk[cp];
                v[i] = x; }
        } else {
            const int dir = (ch - 32) >> 4, p0 = ((ch - 32) & 15) * 4, e = dir ? 16 - t : t + 1;
#pragma unroll
            for (int i = 0; i < 4; ++i) { const int p = p0 + i;
                const float cr = cc[((dir * 16 + cp) * 64 + p) * 2], ci = cc[((dir * 16 + cp) * 64 + p) * 2 + 1];
                const float lr = lam[((dir * 64 + p) * 17 + e) * 2], li = lam[((dir * 64 + p) * 17 + e) * 2 + 1];
                v[2 * i] = cr * lr - ci * li; v[2 * i + 1] = -(cr * li + ci * lr); }
        }
        v4u o; o.x = pk2(v[0], v[1]); o.y = pk2(v[2], v[3]); o.z = pk2(v[4], v[5]); o.w = pk2(v[6], v[7]);
        *(v4u*)(TM + (size_t)n * 512 + 8 * ch) = o;
    }
    for (int e8 = tid; e8 < 256 * 32; e8 += NTHR) {
        const int n = e8 >> 5, ch = e8 & 31, dir = n >> 7, p = (n & 127) >> 1, part = n & 1, s_ = ch >> 1, c0 = (ch & 1) * 8, e = dir ? s_ : 15 - s_;
        const float lr = lam[((dir * 64 + p) * 17 + e) * 2], li = lam[((dir * 64 + p) * 17 + e) * 2 + 1]; float v[8];
#pragma unroll
        for (int i = 0; i < 8; ++i) { const float br = bb[((dir * 64 + p) * 16 + c0 + i) * 2], bi = bb[((dir * 64 + p) * 16 + c0 + i) * 2 + 1];
            v[i] = part ? (lr * bi + li * br) : (lr * br - li * bi); }
        v4u o; o.x = pk2(v[0], v[1]); o.y = pk2(v[2], v[3]); o.z = pk2(v[4], v[5]); o.w = pk2(v[6], v[7]);
        *(v4u*)(W16 + (size_t)n * 256 + 8 * ch) = o;
    }
    __syncthreads();
}
struct S5Order {
    int G, c;
    __device__ void init(int G_, int c_) { G = G_; c = c_; }
    __device__ bool next(int i, pg8::Unit& u) const {
        const long L = (long)i * G + c; if (L >= 256) return false;
        int V = (int)L; if (G == 256) V = (c & 7) * 32 + (c >> 3);
        u.pm = V; u.pn = 0; u.pb = V >> 2; return true;
    }
    __device__ __forceinline__ void a_ready(const pg8::Unit&) const {}
    __device__ __forceinline__ void done(const pg8::Unit&) const {}
};
struct EpiS5Scan {
    static constexpr bool PERM = true, AFTER_DRAIN = true;
    bf16* UC; const float *lam_re, *lam_im, *log_dt;
    static constexpr int PITCH = 528;
    __device__ __forceinline__ void fused(const pg8::f32x4 (&acc)[2][2][4][2], const pg8::Unit& u, int wr, int wc, int fr, int fq, LAS unsigned char* lds, int wid, int lane) const {
        const int tid = wid * 64 + lane;
#pragma unroll
        for (int ai = 0; ai < 2; ++ai)
#pragma unroll
            for (int m = 0; m < 4; ++m)
#pragma unroll
                for (int bj = 0; bj < 2; ++bj) { const pg8::f32x4 x = acc[ai][bj][m][0], y = acc[ai][bj][m][1];
                    v4u w; w.x = pk2(x[0], x[1]); w.y = pk2(x[2], x[3]); w.z = pk2(y[0], y[1]); w.w = pk2(y[2], y[3]);
                    *(LAS v4u*)(lds + (ai * 128 + wr * 64 + m * 16 + fr) * PITCH + (bj * 128 + wc * 32 + 8 * fq) * 2) = w; }
        __syncthreads();
        const int g = u.pm >> 2;
        if (tid < 128) {
            const int dir = tid >> 6, p = tid & 63, pg = dir * SG + g;
            const float lr = lam_re[pg * SP + p], li = lam_im[pg * SP + p], dt = expf(log_dt[pg]);
            const float mag = expf(lr * dt), ang = li * dt;
            float pr = mag * cosf(ang), pi = mag * sinf(ang);
#pragma unroll
            for (int i = 0; i < 4; ++i) { const float nr = pr * pr - pi * pi, ni = 2.f * pr * pi; pr = nr; pi = ni; }
            LAS unsigned char* col = lds + (dir * 128 + 2 * p) * 2;
            float hr = 0.f, hi = 0.f;
#pragma unroll 8
            for (int j = 0; j < 256; ++j) {
                LAS unsigned* cell = (LAS unsigned*)(col + (dir ? 255 - j : j) * PITCH);
                const unsigned e = *cell; *cell = pk2(hr, hi);
                const float er = bflo(e), ei = bfhi(e); const float nr = pr * hr - pi * hi + er, ni = pr * hi + pi * hr + ei; hr = nr; hi = ni;
            }
        }
        __syncthreads();
        bf16* dst = UC + (size_t)u.pm * 256 * 512 + 256;
#pragma unroll
        for (int i = 0; i < 16; ++i) { const int idx = tid + 512 * i, row = idx >> 5, ch = idx & 31;
            *(v4u*)(dst + (size_t)row * 512 + 8 * ch) = *(const LAS v4u*)(lds + row * PITCH + 16 * ch); }
        __syncthreads();
    }
};
__device__ __forceinline__ float gelu_t(float y) { const float u = 0.7978845608028654f * (y + 0.044715f * y * y * y); const float e = __builtin_amdgcn_exp2f(2.885390081777927f * u); const float th = 1.f - 2.f * __builtin_amdgcn_rcpf(e + 1.f); return 0.5f * y * (1.f + th); }
struct EpiS5Z {
    static constexpr bool PERM = true, AFTER_DRAIN = false;
    bf16* Z;
    __device__ __forceinline__ void operator()(const pg8::f32x4 (&acc)[2][2][4][2], const pg8::Unit& u, int wr, int wc, int fr, int fq) const {
        const int row0 = u.pm * 256 + wr * 64 + fr;
#pragma unroll
        for (int ai = 0; ai < 2; ++ai)
#pragma unroll
            for (int m = 0; m < 4; ++m) { const int row = row0 + ai * 128 + m * 16, g = row >> 10, J = row & 1023;
#pragma unroll
                for (int bj = 0; bj < 2; ++bj) { const int t = 8 * bj + 2 * wc + (fq >> 1), c0 = 8 * (fq & 1);
                    const pg8::f32x4 x = acc[ai][bj][m][0], y = acc[ai][bj][m][1];
                    v4u w; w.x = pk2(gelu_t(x[0]), gelu_t(x[1])); w.y = pk2(gelu_t(x[2]), gelu_t(x[3])); w.z = pk2(gelu_t(y[0]), gelu_t(y[1])); w.w = pk2(gelu_t(y[2]), gelu_t(y[3]));
                    *(v4u*)(Z + (size_t)(16 * J + t) * D + g * 16 + c0) = w; } }
    }
};
constexpr int NPHASE = 18;
__global__ void __launch_bounds__(NTHR, 2) mk_fwd(Args args) {
    extern __shared__ __attribute__((aligned(16))) unsigned char lds_raw[];
    Ctx C;
    C.lds = (LAS unsigned char*)lds_raw;
    C.tid = threadIdx.x; C.lane = C.tid & 63; C.wave = __builtin_amdgcn_readfirstlane(C.tid >> 6);
    C.G = gridDim.x; { const int bx = blockIdx.x; C.vcu = (C.G % 8 == 0) ? (bx % 8) * (C.G / 8) + bx / 8 : bx; }
    volatile LAS unsigned* MISC = (volatile LAS unsigned*)(C.lds + LDSCTL_OFF);
    for (int u = C.tid; u < (LDS_BYTES - LDSCTL_OFF) / 4; u += NTHR) ((LAS unsigned*)(C.lds + LDSCTL_OFF))[u] = 0u;
    __syncthreads();
    int lo = args.ph_lo, hi = args.ph_hi;
    unsigned char* ws = args.ws;
    asm volatile("" : "+s"(lo), "+s"(hi), "+s"(ws));
    unsigned* ctl = (unsigned*)(ws + WS_CTL);
    const bool one_launch = (lo == 0 && hi == NPHASE);
    XcdBarrier bar; bar.bar = ctl + CW_BAR; bar.x = 0; bar.st = nullptr;
    if (one_launch) bar = xcd_barrier_post(ctl + CW_BAR, MISC + 8);
    LAS unsigned char* glds = C.lds;
#ifndef MK_ONLY
#define MK_ONLY -1
#endif
#define IN(k) ((MK_ONLY < 0 || MK_ONLY == (k) || (MK_ONLY == 4 && (k) == 13) || (MK_ONLY == 5 && (k) == 14) || (MK_ONLY == 6 && (k) == 15) || (MK_ONLY == 7 && (k) == 16) || (MK_ONLY == 8 && (k) == 17)) && lo <= (k) && (k) < hi)
#ifndef MK_S5DUP
#define MK_S5DUP 0
#endif
#ifndef MK_DUP
#define MK_DUP 0
#endif
#define DUPBIT(k) ((MK_DUP >> ((k) < 13 ? (k) : (k) - 9)) & 1)
#define DUPX(k, ...) do { __VA_ARGS__ if (DUPBIT(k)) { __VA_ARGS__ } } while (0)
#define SEAM(k) do { if (IN(k) && IN((k) + 1)) xcd_barrier(bar); } while (0)

#ifdef MK_XBAR
    if (one_launch) for (int xb_ = 0; xb_ < MK_XBAR; ++xb_) xcd_barrier(bar);
#endif
    if (IN(0)) { DUPX(0, p0_prologue(C, args);); } SEAM(0);
    if (IN(1)) {
        const int G1 = (C.G == 256) ? 214 : C.G;
        if ((int)blockIdx.x < G1) {
            pg8::Gemm g{(const bf16*)(ws + WS_XN), (const bf16*)(ws + WS_WIN), D, nullptr, D, D}; pg8::DenseOrder So; So.init(T, INC, G1, (int)blockIdx.x);
            pg8::EpiProj E{(bf16*)(ws + WS_PROJ), (bf16*)(ws + WS_PROJ + 16 * MiB), args.in[7], args.in[8]};
            pg8::gemm_phase<pg8::EpiProj, pg8::DenseOrder, true, true>(glds, g, So, E);
            if (C.tid == 0) __hip_atomic_fetch_add((unsigned*)(ws + WS_CTL) + CW_P1DONE, 1u, __ATOMIC_RELAXED, __HIP_MEMORY_SCOPE_AGENT);
        } else conv_drain(C, args, true);
    } SEAM(1);
    if (IN(2)) {
 DUPX(2, {        for (int gq = C.vcu; gq < SG; gq += C.G) p_s5_pre(C, args, gq);
        conv_drain(C, args, false);
        conv_phase(C, args);
        attn_phase(C, args);
    }); } SEAM(2);
    if (IN(3)) {
 DUPX(3, {        pg8::Gemm g{(const bf16*)(ws + WS_MIXED), (const bf16*)(ws + WS_WOUT), D, nullptr, D, D}; pg8::DenseOrder So; So.init(T, D, C.G, (int)blockIdx.x);
        pg8::EpiRes E{args.in[0], (bf16*)(ws + WS_XA)};
        pg8::gemm_phase<pg8::EpiRes, pg8::DenseOrder, true, true>(glds, g, So, E);
    }); } SEAM(3);
#define MOE_PHASES(layer, pb) do { \
        if (IN(pb)) { DUPX(pb, p_router(C, args, layer);); } SEAM(pb); \
        if (IN(pb + 1)) { DUPX(pb + 1, p_topk(C, args);); } SEAM(pb + 1); \
        if (IN(pb + 2)) { DUPX(pb + 2, { \
            pg8::Gemm g{(const bf16*)(ws + (layer == 0 ? WS_XA : WS_XB)), (const bf16*)(ws + WS_WEXP + layer * WEXP_LAYER + WEXP_GU), D, (const int*)(ws + WS_IDX), D, D}; pg8::ExpertOrder So; So.init(8, C.G, (int)blockIdx.x); \
            pg8::EpiSwiGLU E{(bf16*)(ws + WS_H), (const float*)(ws + WS_RSROW)}; \
            pg8::gemm_phase<pg8::EpiSwiGLU, pg8::ExpertOrder, true, true, true>(glds, g, So, E); \
        }); } SEAM(pb + 2); \
        if (IN(pb + 3)) { DUPX(pb + 3, { \
            pg8::Gemm g{(const bf16*)(ws + WS_H), (const bf16*)(ws + WS_WEXP + layer * WEXP_LAYER + WEXP_DN), EH, nullptr, EH, EH}; pg8::ExpertOrder So; So.init(4, C.G, (int)blockIdx.x); \
            pg8::EpiDown E{(bf16*)(ws + WS_PROJ), (const float*)(ws + WS_GATE)}; \
            pg8::gemm_phase<pg8::EpiDown, pg8::ExpertOrder, true, true>(glds, g, So, E); \
        }); } SEAM(pb + 3); \
        if (IN(pb + 4)) { DUPX(pb + 4, p_combine(C, args, layer == 0);); } \
    } while (0)
    MOE_PHASES(0, 4);
    SEAM(8);
    if (IN(9)) {
        int k9 = 256; asm volatile("" : "+s"(k9));
        pg8::Gemm g{(const bf16*)(ws + WS_UC), (const bf16*)(ws + WS_W16), k9, nullptr, 512, 256}; S5Order So; So.init(C.G, (int)blockIdx.x);
        EpiS5Scan E{(bf16*)(ws + WS_UC), args.in[11], args.in[12], args.in[13]};
        pg8::gemm_phase<EpiS5Scan, S5Order, false, true>(glds, g, So, E);
    }
    asm volatile("s_waitcnt vmcnt(0)" ::: "memory"); __syncthreads();
    if (IN(11)) {
        int k11 = 512; asm volatile("" : "+s"(k11));
        pg8::Gemm g{(const bf16*)(ws + WS_UC), (const bf16*)(ws + WS_TM), k11, nullptr, 512, 512}; S5Order So; So.init(C.G, (int)blockIdx.x);
        EpiS5Z E{(bf16*)(ws + WS_MIXED)};
        pg8::gemm_phase<EpiS5Z, S5Order, true, true>(glds, g, So, E);
#if MK_S5DUP == 11
        pg8::gemm_phase<EpiS5Z, S5Order, true, true>(glds, g, So, E);
#endif
    } SEAM(11);
    if (IN(12)) {
        pg8::Gemm g{(const bf16*)(ws + WS_MIXED), (const bf16*)(ws + WS_WGLU), D, nullptr, D, D}; pg8::DenseOrder So; So.init(T, 2 * D, C.G, (int)blockIdx.x);
        pg8::EpiGluRes E{(bf16*)(ws + WS_XB)};
        pg8::gemm_phase<pg8::EpiGluRes, pg8::DenseOrder, true, true>(glds, g, So, E);
    } SEAM(12);
    MOE_PHASES(1, 13);
#undef IN
#undef SEAM
}

#ifndef MK_PER_PHASE
#define MK_PER_PHASE 0
#endif
extern "C" void kernel_launch(void* const* d_in, const int* in_sizes, int n_in, void* d_out, int out_size, void* d_ws, size_t ws_size, hipStream_t stream) {
    static int grid = 0;
    if (grid == 0) {
        if (n_in != 26 || out_size != T * D || ws_size < WS_END) { fprintf(stderr, "kernel_launch: unexpected shapes (n_in %d out %d ws %zu)\n", n_in, out_size, ws_size); grid = -1; return; }
        int dev = 0, cus = 0, per_cu = 0;
        if (hipGetDevice(&dev) != hipSuccess || hipDeviceGetAttribute(&cus, hipDeviceAttributeMultiprocessorCount, dev) != hipSuccess) { grid = -1; return; }
        if (hipFuncSetAttribute((const void*)mk_fwd, hipFuncAttributeMaxDynamicSharedMemorySize, LDS_BYTES) != hipSuccess) { fprintf(stderr, "kernel_launch: hipFuncSetAttribute failed\n"); grid = -1; return; }
        if (hipOccupancyMaxActiveBlocksPerMultiprocessor(&per_cu, (const void*)mk_fwd, NTHR, LDS_BYTES) != hipSuccess || per_cu < 1) { fprintf(stderr, "kernel_launch: occupancy query says %d blocks per CU\n", per_cu); (void)hipGetLastError(); grid = -1; return; }
        grid = cus;
    }
    if (grid < 0) return;
    (void)hipMemsetAsync((char*)d_ws + WS_CTL, 0, CTL_ZERO_BYTES, stream);
    Args a{};
    for (int i = 0; i < 26; ++i) a.in[i] = (const float*)d_in[i];
    a.out = (float*)d_out; a.ws = (unsigned char*)d_ws;
#if MK_PER_PHASE
    for (int p = 0; p < NPHASE; ++p) { a.ph_lo = p; a.ph_hi = p + 1; hipLaunchKernelGGL(mk_fwd, dim3(grid), dim3(NTHR), LDS_BYTES, stream, a); }
#else
    a.ph_lo = 0; a.ph_hi = NPHASE;
    hipLaunchKernelGGL(mk_fwd, dim3(grid), dim3(NTHR), LDS_BYTES, stream, a);
#endif
}
```

```cpp
#include <hip/hip_runtime.h>
#include <cstdint>
#include <cstdio>

namespace pg8 {
#define PG8_LAS __attribute__((address_space(3)))
typedef unsigned short bf16_t;
typedef short bf16x8 __attribute__((ext_vector_type(8)));
typedef float f32x4 __attribute__((ext_vector_type(4)));
typedef unsigned u32x4 __attribute__((ext_vector_type(4)));
constexpr int BM = 256, BK = 64, HALF = 128, HTB = HALF * BK * 2  , STAGE_BYTES = 8 * HTB, NXCD = 8, WGM = 8;

__host__ __device__ __forceinline__ int lds_byte(int r, int c) { const int st = (r >> 4) * 2 + (c >> 5), rr = r & 15, cc = c & 31, ob = rr * 64 + cc * 2; return st * 1024 + (ob ^ (((ob >> 9) & 1) << 5)); }
__host__ __device__ __forceinline__ void stage_rc(int b, int& R, int& C) { const int st = b / 1024, sb = b % 1024, swz = sb ^ (((sb >> 9) & 1) << 5); R = (st >> 1) * 16 + swz / 64; C = (st & 1) * 32 + (swz % 64) / 2; }
__host__ __device__ __forceinline__ int perm32(int rho) { const int n = rho >> 4, i = rho & 15; return 8 * (i >> 2) + 4 * n + (i & 3); }

struct Unit { int pm, pn, pb; };
struct Gemm { const bf16_t* A; const bf16_t* Bt; int K; const int* gidx; int lda, ldb; };

struct DenseOrder {
    int nM, nN, nwg, G, c;
    __device__ void init(int M, int N, int G_, int c_) { nM = M / BM; nN = N / BM; nwg = nM * nN; G = G_; c = c_; }
    __device__ bool next(int i, Unit& u) const {
        const long L = (long)i * G + c; if (L >= nwg) return false;
        int wgid = (int)L; { const int q = nwg / NXCD, r = nwg % NXCD, xcd = wgid % NXCD, off = wgid / NXCD; wgid = (xcd < r ? xcd * (q + 1) : r * (q + 1) + (xcd - r) * q) + off; }
        const int nig = WGM * nN, gid = wgid / nig, fm = gid * WGM, gsz = (nM - fm) < WGM ? (nM - fm) : WGM;
        u.pm = fm + ((wgid % nig) % gsz); u.pn = (wgid % nig) / gsz; u.pb = u.pn; return true;
    }
    __device__ __forceinline__ void a_ready(const Unit&) const {}
    __device__ __forceinline__ void done(const Unit&) const {}
};
struct ExpertOrder {
    int nN, nun, G, c;
    __device__ void init(int nN_, int G_, int c_) { nN = nN_; nun = 128 * nN_; G = G_; c = c_; }
    __device__ bool next(int i, Unit& u) const {
        const long L = (long)i * G + c; if (L >= nun) return false;
        int V = (int)L;
        if (G == 256) {
            const int x = c & 7, j = c >> 3, upx = 32, rpe = (8 * nN) / upx;
            const int e_ = 8 * (i / rpe) + x, r_ = (i % rpe) * upx + j;
            V = e_ * 8 * nN + r_;
        }
        const int per = 8 * nN, e = V / per, r = V % per, pml = r / nN, pn = r % nN;
        u.pm = ((pml >> 1) * 16 + e) * 2 + (pml & 1); u.pn = pn; u.pb = e * nN + pn; return true;
    }
    __device__ __forceinline__ void a_ready(const Unit&) const {}
    __device__ __forceinline__ void done(const Unit&) const {}
};

typedef float f32x2 __attribute__((ext_vector_type(2)));
typedef __bf16 bf16x2_t __attribute__((ext_vector_type(2)));
__device__ __forceinline__ unsigned pk2(float lo, float hi) { f32x2 v = {lo, hi}; bf16x2_t b = __builtin_convertvector(v, bf16x2_t); return __builtin_bit_cast(unsigned, b); }
__device__ __forceinline__ float sigm(float x) { return __builtin_amdgcn_rcpf(1.f + __builtin_amdgcn_exp2f(-1.4426950408889634f * x)); }

constexpr float QSCALE = 0.125f * 1.4426950408889634f;
struct EpiProj {
    static constexpr bool PERM = true, AFTER_DRAIN = false;
    bf16_t *GLU, *Q; const float *qg, *kg;
    __device__ __forceinline__ void operator()(const f32x4 (&acc)[2][2][4][2], const Unit& u, int wr, int wc, int fr, int fq) const {
        const int row0 = u.pm * BM + wr * 64 + fr;
        if (u.pn < 4) {
            const int col0 = 128 * u.pn + 32 * wc + 8 * fq;
#pragma unroll
            for (int ai = 0; ai < 2; ++ai)
#pragma unroll
                for (int m = 0; m < 4; ++m) {
                    const f32x4 v0 = acc[ai][0][m][0], v1 = acc[ai][0][m][1], g0 = acc[ai][1][m][0], g1 = acc[ai][1][m][1];
                    u32x4 w; w.x = pk2(v0[0] * sigm(g0[0]), v0[1] * sigm(g0[1])); w.y = pk2(v0[2] * sigm(g0[2]), v0[3] * sigm(g0[3]));
                    w.z = pk2(v1[0] * sigm(g1[0]), v1[1] * sigm(g1[1])); w.w = pk2(v1[2] * sigm(g1[2]), v1[3] * sigm(g1[3]));
                    *(u32x4*)(GLU + (size_t)(row0 + ai * HALF + m * 16) * 512 + col0) = w;
                    asm volatile("" ::: "memory");
                }
        } else {
            const int t = (u.pn - 4) >> 1;
            const int hd = 4 * ((u.pn - 4) & 1) + wc;
            bf16_t* dst = Q + (size_t)t * (size_t)(8u << 20);
            const float* gp = (const float*)((uintptr_t)qg + (((uintptr_t)kg - (uintptr_t)qg) & (uintptr_t)(t == 0 ? 0 : ~(uintptr_t)0)));
#pragma unroll
            for (int ai = 0; ai < 2; ++ai)
#pragma unroll
                for (int m = 0; m < 4; ++m) {
                    float ss = 0.f;
#pragma unroll
                    for (int bj = 0; bj < 2; ++bj)
#pragma unroll
                        for (int n = 0; n < 2; ++n) { const f32x4 x = acc[ai][bj][m][n]; ss += (x[0] * x[0] + x[1] * x[1]) + (x[2] * x[2] + x[3] * x[3]); }
                    ss += __shfl_xor(ss, 16); ss += __shfl_xor(ss, 32);
                    float rs = 1.f;
                    if (t < 2) rs = rsqrtf(ss * (1.f / 64.f) + 1e-6f) * (t == 0 ? QSCALE : 1.f);
#pragma unroll
                    for (int bj = 0; bj < 2; ++bj) {
                        f32x4 g0 = {1.f, 1.f, 1.f, 1.f}, g1 = g0;
                        if (t < 2) { g0 = *(const f32x4*)(gp + 32 * bj + 8 * fq); g1 = *(const f32x4*)(gp + 32 * bj + 8 * fq + 4); }
                        const f32x4 a = acc[ai][bj][m][0] * g0 * rs, b = acc[ai][bj][m][1] * g1 * rs;
                        u32x4 w; w.x = pk2(a[0], a[1]); w.y = pk2(a[2], a[3]); w.z = pk2(b[0], b[1]); w.w = pk2(b[2], b[3]);
                        const int row = row0 + ai * HALF + m * 16;
                        *(u32x4*)(dst + ((size_t)((row >> 12) * 8 + hd) * 4096 + (row & 4095)) * 64 + 32 * bj + 8 * fq) = w;
                    }
                    asm volatile("" ::: "memory");
                }
        }
    }
};
struct EpiRes {
    static constexpr bool PERM = true, AFTER_DRAIN = false;
    const float* xin; bf16_t* X;
    __device__ __forceinline__ void operator()(const f32x4 (&acc)[2][2][4][2], const Unit& u, int wr, int wc, int fr, int fq) const {
        const int row0 = u.pm * BM + wr * 64 + fr, col0 = u.pn * BM + wc * 32 + 8 * fq;
#pragma unroll
        for (int ai = 0; ai < 2; ++ai)
#pragma unroll
            for (int m = 0; m < 4; ++m) { const size_t off = (size_t)(row0 + ai * HALF + m * 16) * 1024 + col0;
#pragma unroll
                for (int bj = 0; bj < 2; ++bj) { const f32x4 a = *(const f32x4*)(xin + off + bj * HALF) + acc[ai][bj][m][0], b = *(const f32x4*)(xin + off + bj * HALF + 4) + acc[ai][bj][m][1];
                    u32x4 w; w.x = pk2(a[0], a[1]); w.y = pk2(a[2], a[3]); w.z = pk2(b[0], b[1]); w.w = pk2(b[2], b[3]);
                    *(u32x4*)(X + off + bj * HALF) = w; } }
    }
};
struct EpiSwiGLU {
    static constexpr bool PERM = true, AFTER_DRAIN = false;
    bf16_t* H; const float* rsrow;
    __device__ __forceinline__ void operator()(const f32x4 (&acc)[2][2][4][2], const Unit& u, int wr, int wc, int fr, int fq) const {
        const int row0 = u.pm * BM + wr * 64 + fr, col0 = 128 * u.pn + 32 * wc + 8 * fq;
#pragma unroll
        for (int ai = 0; ai < 2; ++ai)
#pragma unroll
            for (int m = 0; m < 4; ++m) {
                const float rs = rsrow[row0 + ai * HALF + m * 16];
                const f32x4 g0 = acc[ai][0][m][0] * rs, g1 = acc[ai][0][m][1] * rs, u0 = acc[ai][1][m][0] * rs, u1 = acc[ai][1][m][1] * rs;
                u32x4 w; w.x = pk2(g0[0] * sigm(g0[0]) * u0[0], g0[1] * sigm(g0[1]) * u0[1]); w.y = pk2(g0[2] * sigm(g0[2]) * u0[2], g0[3] * sigm(g0[3]) * u0[3]);
                w.z = pk2(g1[0] * sigm(g1[0]) * u1[0], g1[1] * sigm(g1[1]) * u1[1]); w.w = pk2(g1[2] * sigm(g1[2]) * u1[2], g1[3] * sigm(g1[3]) * u1[3]);
                *(u32x4*)(H + (size_t)(row0 + ai * HALF + m * 16) * 1024 + col0) = w;
            }
    }
};
struct EpiDown {
    static constexpr bool PERM = true, AFTER_DRAIN = false;
    bf16_t* Y; const float* gate;
    __device__ __forceinline__ void operator()(const f32x4 (&acc)[2][2][4][2], const Unit& u, int wr, int wc, int fr, int fq) const {
        const int row0 = u.pm * BM + wr * 64 + fr, col0 = u.pn * BM + wc * 32 + 8 * fq;
#pragma unroll
        for (int ai = 0; ai < 2; ++ai)
#pragma unroll
            for (int m = 0; m < 4; ++m) { const int row = row0 + ai * HALF + m * 16; const float gs = gate[row];
#pragma unroll
                for (int bj = 0; bj < 2; ++bj) { const f32x4 a = acc[ai][bj][m][0] * gs, b = acc[ai][bj][m][1] * gs;
                    u32x4 w; w.x = pk2(a[0], a[1]); w.y = pk2(a[2], a[3]); w.z = pk2(b[0], b[1]); w.w = pk2(b[2], b[3]);
                    *(u32x4*)(Y + (size_t)row * 1024 + col0 + bj * HALF) = w; } }
    }
};
struct EpiGluRes {
    static constexpr bool PERM = true, AFTER_DRAIN = false;
    bf16_t* X;
    __device__ __forceinline__ void operator()(const f32x4 (&acc)[2][2][4][2], const Unit& u, int wr, int wc, int fr, int fq) const {
        const int row0 = u.pm * BM + wr * 64 + fr, col0 = 128 * u.pn + 32 * wc + 8 * fq;
#pragma unroll
        for (int ai = 0; ai < 2; ++ai)
#pragma unroll
            for (int m = 0; m < 4; ++m) { bf16_t* p = X + (size_t)(row0 + ai * HALF + m * 16) * 1024 + col0;
                const u32x4 o = *(const u32x4*)p; const f32x4 v0 = acc[ai][0][m][0], v1 = acc[ai][0][m][1], g0 = acc[ai][1][m][0], g1 = acc[ai][1][m][1];
                u32x4 w;
                w.x = pk2(__uint_as_float(o.x << 16) + v0[0] * sigm(g0[0]), __uint_as_float(o.x & 0xffff0000u) + v0[1] * sigm(g0[1]));
                w.y = pk2(__uint_as_float(o.y << 16) + v0[2] * sigm(g0[2]), __uint_as_float(o.y & 0xffff0000u) + v0[3] * sigm(g0[3]));
                w.z = pk2(__uint_as_float(o.z << 16) + v1[0] * sigm(g1[0]), __uint_as_float(o.z & 0xffff0000u) + v1[1] * sigm(g1[1]));
                w.w = pk2(__uint_as_float(o.w << 16) + v1[2] * sigm(g1[2]), __uint_as_float(o.w & 0xffff0000u) + v1[3] * sigm(g1[3]));
                *(u32x4*)p = w; }
    }
};

template <class Epi, class Sched, bool ALIGN_EPI = false, bool SP2 = false, bool GATHER = false>
__device__ __forceinline__ void gemm_phase(PG8_LAS unsigned char* lds, const Gemm g, const Sched& S, const Epi& E) {
    const int tid = threadIdx.x, wid = __builtin_amdgcn_readfirstlane(tid >> 6), lane = tid & 63, wr = wid >> 2, wc = wid & 3, fr = lane & 15, fq = lane >> 4;
    const int K = g.K, nt = K / BK;
    unsigned voffA[2], voffB[2];
#pragma unroll
    for (int i = 0; i < 2; ++i) { int R, C; stage_rc(tid * 16 + i * 8192, R, C); const int Rb = Epi::PERM ? ((R & ~31) + perm32(R & 31)) : R;
        voffA[i] = (unsigned)(R * g.lda + C) * 2u; voffB[i] = (unsigned)(Rb * g.ldb + C) * 2u; }
    const size_t kstep = (size_t)(BK * 2);
    const size_t hstepA = (size_t)HALF * g.lda * 2, hstepB = (size_t)HALF * g.ldb * 2;
    const size_t tstepA = 2 * hstepA, tstepB = 2 * hstepB;
    const unsigned ldsw = (unsigned)wid * 1024u;
    const int aoff = lds_byte(wr * 64 + fr, fq * 8), boff = lds_byte(wc * 32 + fr, fq * 8);
#define PG8_SA(b, h) (((b) * 2 + (h)) * HTB)
#define PG8_SB(b, h) ((4 + (b) * 2 + (h)) * HTB)
#define PG8_STAGE(bufoff, gbase, voff) do { _Pragma("unroll") for (int _i = 0; _i < 2; ++_i) \
        __builtin_amdgcn_global_load_lds((const unsigned*)((const char*)(gbase) + (voff)[_i]), (PG8_LAS unsigned*)(lds + (bufoff) + ldsw + _i * 8192), 16, 0, 0); } while (0)
#define PG8_STAGE_A(bufoff, gptr, h, nsel) do { if constexpr (GATHER) { const unsigned _o[2] = {(nsel) ? nOA[h][0] : oA[h][0], (nsel) ? nOA[h][1] : oA[h][1]}; PG8_STAGE(bufoff, gptr, _o); } \
        else { PG8_STAGE(bufoff, (gptr) + ((h) ? hstepA : 0), voffA); } } while (0)
#define PG8_GOFF(dst, u) do { if constexpr (GATHER) { _Pragma("unroll") for (int _h = 0; _h < 2; ++_h) _Pragma("unroll") for (int _i = 0; _i < 2; ++_i) { \
        (dst)[_h][_i] = (unsigned)g.gidx[(u).pm * BM + _h * HALF + gR[_i]] * (unsigned)(g.lda * 2) + gC[_i]; asm volatile("" : "+v"((dst)[_h][_i])); } } } while (0)
#define PG8_LDA(dst, b, h) do { _Pragma("unroll") for (int m = 0; m < 4; ++m) _Pragma("unroll") for (int k = 0; k < 2; ++k) dst[m][k] = *(const PG8_LAS bf16x8*)(lds + PG8_SA(b, h) + aoff + m * 2048 + k * 1024); } while (0)
#define PG8_LDB(dst, b, h) do { _Pragma("unroll") for (int n = 0; n < 2; ++n) _Pragma("unroll") for (int k = 0; k < 2; ++k) dst[n][k] = *(const PG8_LAS bf16x8*)(lds + PG8_SB(b, h) + boff + n * 2048 + k * 1024); } while (0)
#define PG8_MMA(ai, bj, At, Bt) do { __builtin_amdgcn_s_setprio(1); _Pragma("unroll") for (int m = 0; m < 4; ++m) _Pragma("unroll") for (int n = 0; n < 2; ++n) _Pragma("unroll") for (int k = 0; k < 2; ++k) \
        acc[ai][bj][m][n] = __builtin_amdgcn_mfma_f32_16x16x32_bf16(Bt[n][k], At[m][k], acc[ai][bj][m][n], 0, 0, 0); __builtin_amdgcn_s_setprio(0); } while (0)
#define PG8_WAIT_V(n) asm volatile("s_waitcnt vmcnt(" #n ")" ::: "memory")
#define PG8_WAIT_L(n) asm volatile("s_waitcnt lgkmcnt(" #n ")" ::: "memory")
#define PG8_BAR __builtin_amdgcn_s_barrier()
#define PG8_SCHED __builtin_amdgcn_sched_barrier(0)
    Unit cur, nxt; int ui = 0;
    if (!S.next(0, cur)) return;
    unsigned oA[2][2], nOA[2][2]; int gR[2]; unsigned gC[2];
    if constexpr (GATHER) { static_assert(SP2, "GATHER is wired into the SP2 loop only");
#pragma unroll
        for (int i = 0; i < 2; ++i) { int R, Cc; stage_rc(tid * 16 + i * 8192, R, Cc); gR[i] = R; gC[i] = (unsigned)Cc * 2u; } }
    PG8_GOFF(oA, cur);
    f32x4 acc[2][2][4][2];
#pragma unroll
    for (int a = 0; a < 2; ++a)
#pragma unroll
        for (int b = 0; b < 2; ++b)
#pragma unroll
            for (int m = 0; m < 4; ++m)
#pragma unroll
                for (int n = 0; n < 2; ++n) acc[a][b][m][n] = (f32x4){0.f, 0.f, 0.f, 0.f};
    bf16x8 At[4][2], B0[2][2], B1[2][2];
    const char* cA = (const char*)g.A + (GATHER ? (size_t)0 : (size_t)cur.pm * tstepA); const char* cB = (const char*)g.Bt + (size_t)cur.pb * tstepB;
    S.a_ready(cur);
    if constexpr (SP2) {
        PG8_STAGE(PG8_SB(0, 0), cB, voffB); PG8_STAGE(PG8_SB(0, 1), cB + hstepB, voffB); PG8_STAGE_A(PG8_SA(0, 0), cA, 0, false); PG8_STAGE_A(PG8_SA(0, 1), cA, 1, false);
        if (wr == 1) PG8_BAR;
        PG8_WAIT_V(2); PG8_BAR;
        PG8_STAGE(PG8_SB(1, 0), cB + kstep, voffB); PG8_STAGE_A(PG8_SA(1, 0), cA + kstep, 0, false); PG8_STAGE(PG8_SB(1, 1), cB + hstepB + kstep, voffB);
        PG8_WAIT_V(6); PG8_BAR;
    } else {
        PG8_STAGE(PG8_SB(0, 0), cB, voffB); PG8_STAGE(PG8_SA(0, 0), cA, voffA); PG8_STAGE(PG8_SB(0, 1), cB + hstepB, voffB); PG8_STAGE(PG8_SA(0, 1), cA + hstepA, voffA);
        if (wr == 1) PG8_BAR;
        PG8_WAIT_V(4); PG8_BAR;
        PG8_STAGE(PG8_SB(1, 0), cB + kstep, voffB); PG8_STAGE(PG8_SA(1, 0), cA + kstep, voffA); PG8_STAGE(PG8_SB(1, 1), cB + hstepB + kstep, voffB);
        PG8_WAIT_V(6); PG8_BAR;
    }
    for (;;) {
        const bool has_next = S.next(ui + 1, nxt);
        const char* nA = has_next ? (const char*)g.A + (GATHER ? (size_t)0 : (size_t)nxt.pm * tstepA) : cA; const char* nB = has_next ? (const char*)g.Bt + (size_t)nxt.pb * tstepB : cB;
        if constexpr (GATHER) { if (has_next) { PG8_GOFF(nOA, nxt); } else {
#pragma unroll
            for (int _h = 0; _h < 2; ++_h) { nOA[_h][0] = oA[_h][0]; nOA[_h][1] = oA[_h][1]; } } }
        for (int t = 0; t < nt; t += 2) {
            const bool last = (t == nt - 2);
            const char* a1 = cA + (size_t)(t + 1) * kstep;
            const char* a2 = last ? nA : cA + (size_t)(t + 2) * kstep; const char* b2 = last ? nB : cB + (size_t)(t + 2) * kstep;
            const char* a3 = a2 + kstep; const char* b3 = b2 + kstep;
            if (last && has_next) S.a_ready(nxt);
            if constexpr (SP2) {
            PG8_LDB(B0, 0, 0); PG8_LDB(B1, 0, 1); PG8_SCHED; PG8_LDA(At, 0, 0); PG8_STAGE_A(PG8_SA(1, 1), a1, 1, false);
            PG8_WAIT_V(8); PG8_WAIT_L(0); PG8_BAR; PG8_MMA(0, 0, At, B0); PG8_MMA(0, 1, At, B1); PG8_BAR; PG8_SCHED;
            PG8_LDA(At, 0, 1); PG8_STAGE(PG8_SB(0, 0), b2, voffB); PG8_STAGE(PG8_SB(0, 1), b2 + hstepB, voffB); PG8_STAGE_A(PG8_SA(0, 0), a2, 0, last);
            PG8_WAIT_V(8); PG8_WAIT_L(0); PG8_BAR; PG8_MMA(1, 0, At, B0); PG8_MMA(1, 1, At, B1); PG8_BAR; PG8_SCHED;
            PG8_LDB(B0, 1, 0); PG8_LDB(B1, 1, 1); PG8_SCHED; PG8_LDA(At, 1, 0); PG8_STAGE_A(PG8_SA(0, 1), a2, 1, last);
            PG8_WAIT_V(8); PG8_WAIT_L(0); PG8_BAR; PG8_MMA(0, 0, At, B0); PG8_MMA(0, 1, At, B1); PG8_BAR; PG8_SCHED;
            PG8_LDA(At, 1, 1); PG8_STAGE(PG8_SB(1, 0), b3, voffB); PG8_STAGE(PG8_SB(1, 1), b3 + hstepB, voffB); PG8_STAGE_A(PG8_SA(1, 0), a3, 0, last);
            PG8_WAIT_V(8); PG8_WAIT_L(0); PG8_BAR; PG8_MMA(1, 0, At, B0); PG8_MMA(1, 1, At, B1); PG8_BAR; PG8_SCHED;
            } else {
            PG8_LDB(B0, 0, 0); PG8_SCHED; PG8_LDA(At, 0, 0); PG8_STAGE(PG8_SA(1, 1), a1 + hstepA, voffA);
            PG8_WAIT_L(8); PG8_BAR; PG8_WAIT_L(0); PG8_MMA(0, 0, At, B0); PG8_BAR; PG8_SCHED;
            PG8_LDB(B1, 0, 1); PG8_STAGE(PG8_SB(0, 0), b2, voffB);
            PG8_BAR; PG8_WAIT_L(0); PG8_MMA(0, 1, At, B1); PG8_BAR;
            PG8_LDA(At, 0, 1); PG8_STAGE(PG8_SA(0, 0), a2, voffA);
            PG8_BAR; PG8_WAIT_L(0); PG8_MMA(1, 0, At, B0); PG8_BAR; PG8_SCHED;
            PG8_STAGE(PG8_SB(0, 1), b2 + hstepB, voffB);
            PG8_WAIT_V(6); PG8_BAR; PG8_MMA(1, 1, At, B1); PG8_BAR;
            PG8_LDB(B0, 1, 0); PG8_SCHED; PG8_LDA(At, 1, 0); PG8_STAGE(PG8_SA(0, 1), a2 + hstepA, voffA);
            PG8_WAIT_L(8); PG8_BAR; PG8_WAIT_L(0); PG8_MMA(0, 0, At, B0); PG8_BAR; PG8_SCHED;
            PG8_LDB(B1, 1, 1); PG8_STAGE(PG8_SB(1, 0), b3, voffB);
            PG8_BAR; PG8_WAIT_L(0); PG8_MMA(0, 1, At, B1); PG8_BAR;
            PG8_LDA(At, 1, 1); PG8_STAGE(PG8_SA(1, 0), a3, voffA);
            PG8_BAR; PG8_WAIT_L(0); PG8_MMA(1, 0, At, B0); PG8_BAR; PG8_SCHED;
            PG8_STAGE(PG8_SB(1, 1), b3 + hstepB, voffB);
            PG8_WAIT_V(6); PG8_BAR; PG8_MMA(1, 1, At, B1); PG8_BAR;
            }
        }
        if constexpr (ALIGN_EPI) { if (wr == 0) PG8_BAR; }
        if constexpr (!Epi::AFTER_DRAIN) { E(acc, cur, wr, wc, fr, fq); S.done(cur); }
        if (!has_next) break;
#pragma unroll
        for (int a = 0; a < 2; ++a)
#pragma unroll
            for (int b = 0; b < 2; ++b)
#pragma unroll
                for (int m = 0; m < 4; ++m)
#pragma unroll
                    for (int n = 0; n < 2; ++n) acc[a][b][m][n] = (f32x4){0.f, 0.f, 0.f, 0.f};
        cur = nxt; cA = nA; cB = nB; ++ui;
        if constexpr (GATHER) {
#pragma unroll
            for (int _h = 0; _h < 2; ++_h) { oA[_h][0] = nOA[_h][0]; oA[_h][1] = nOA[_h][1]; } }
        if constexpr (ALIGN_EPI) { if (wr == 1) PG8_BAR; }
    }
    PG8_WAIT_V(0);
    if constexpr (!ALIGN_EPI) { if (wr == 0) PG8_BAR; }
    PG8_BAR;
    if constexpr (Epi::AFTER_DRAIN) { E.fused(acc, cur, wr, wc, fr, fq, lds, wid, lane); S.done(cur); }
#undef PG8_SA
#undef PG8_SB
#undef PG8_STAGE
#undef PG8_LDA
#undef PG8_STAGE_A
#undef PG8_GOFF
#undef PG8_LDB
#undef PG8_MMA
#undef PG8_WAIT_V
#undef PG8_WAIT_L
#undef PG8_BAR
#undef PG8_SCHED
}
}

constexpr int NB = 4, S = 4096, D = 1024, T = NB * S;
constexpr int CONV_CH = 512, CONV_W = 31, NH = 8, INC = 2560;
constexpr int SG = 64, SC = 16, SP = 64;
constexpr int NE = 16, CAP = 512, EH = 1024, MR = NB * NE * CAP;
constexpr float EPS = 1e-6f;
constexpr int NWAVES = 8, NTHR = NWAVES * 64;

constexpr size_t MiB = 1u << 20;
constexpr size_t WS_CTL = 0, CTL_ZERO_BYTES = 64 * 1024;
constexpr size_t WS_AFF = 1 * MiB, WS_IDX = 2 * MiB, WS_GATE = 2 * MiB + 512 * 1024, WS_SLOT = 3 * MiB;
constexpr size_t WS_RS = 2 * MiB + 256 * 1024, WS_RSROW = 2 * MiB + 768 * 1024;
constexpr size_t WS_WIN = 4 * MiB, WS_WOUT = 10 * MiB, WS_WGLU = 12 * MiB;
constexpr size_t WS_WEXP = 16 * MiB, WEXP_LAYER = 96 * MiB, WEXP_GU = 0, WEXP_DN = 64 * MiB;
constexpr size_t WS_XN = 208 * MiB, WS_MIXED = 240 * MiB;
constexpr size_t WS_PROJ = 272 * MiB;
constexpr size_t WS_H = 336 * MiB;
constexpr size_t WS_XA = 404 * MiB, WS_XB = 436 * MiB;
constexpr size_t WS_END = 492 * MiB;
constexpr int CW_BAR = 1024, CW_Q0 = 64;

constexpr int SCRATCH_BYTES = 143360;
constexpr int LDSCTL_OFF = SCRATCH_BYTES;
constexpr int LDS_BYTES = 147456;

#define GAS __attribute__((address_space(1)))
#define LAS __attribute__((address_space(3)))
typedef unsigned short bf16;
typedef unsigned v4u __attribute__((ext_vector_type(4)));
typedef unsigned v2u __attribute__((ext_vector_type(2)));
typedef float f32x4 __attribute__((ext_vector_type(4)));
typedef float f32x2 __attribute__((ext_vector_type(2)));
using pg8::pk2;
using pg8::sigm;
__device__ __forceinline__ float bf2f(unsigned short h) { return __uint_as_float(((unsigned)h) << 16); }
__device__ __forceinline__ float bflo(unsigned w) { return __uint_as_float(w << 16); }
__device__ __forceinline__ float bfhi(unsigned w) { return __uint_as_float(w & 0xffff0000u); }
__device__ __forceinline__ float wave_sum(float v) {
#pragma unroll
    for (int o = 1; o < 64; o <<= 1) v += __shfl_xor(v, o);
    return v;
}

#define XB_TMO      128
#define XB_XCNT(j)  (256  + 64 * (j))
#define XB_XSUB(j)  (1280 + 64 * (j))
#define XB_XGEN(j)  (2304 + 64 * (j))
#define XB_TOP      3328
#define XB_TOPGEN   3392
#define XCD_BAR_WORDS 3456
#define XB_SPIN_CAP (1u << 18)
__device__ __forceinline__ unsigned xb_ld(unsigned* p)              { return __hip_atomic_load(p, __ATOMIC_RELAXED, __HIP_MEMORY_SCOPE_AGENT); }
__device__ __forceinline__ unsigned xb_add(unsigned* p, unsigned v) { return __hip_atomic_fetch_add(p, v, __ATOMIC_RELAXED, __HIP_MEMORY_SCOPE_AGENT); }
__device__ __forceinline__ unsigned xb_xcc_id() { return (unsigned)__builtin_amdgcn_s_getreg((3 << 11) | 20) & 0xFu; }
#define XB_SPIN(cond, bar) do { unsigned _sp = 0; while (cond) { __builtin_amdgcn_s_sleep(1); \
    if ((++_sp & 255u) == 0u) { if (xb_ld(&(bar)[XB_TMO])) break; if (_sp > XB_SPIN_CAP) { atomicAdd(&(bar)[XB_TMO], 1u); break; } } } } while (0)
#define XB_LSUB(j)  (3456 + 64 * (j))
#define XB_LGEN(j)  (4480 + 64 * (j))
struct XcdBarrier { unsigned* bar; unsigned x; volatile LAS unsigned* st; unsigned rank; };
__device__ __forceinline__ XcdBarrier xcd_barrier_post(unsigned* bar, volatile LAS unsigned* st) {
    XcdBarrier b; b.bar = bar; b.x = xb_xcc_id(); b.st = st; b.rank = 0u;
    if (threadIdx.x == 0) b.rank = xb_add(&bar[XB_XCNT(b.x)], 1u);
    return b;
}
__device__ __forceinline__ void xcd_barrier_complete(unsigned* bar, unsigned x, unsigned& nloc, unsigned& nx) {
    const unsigned G = gridDim.x * gridDim.y * gridDim.z;
    unsigned sum, cnt, mine, sp = 0u;
    for (;;) {
        sum = 0u; cnt = 0u; mine = 0u;
#pragma unroll
        for (unsigned j = 0; j < 16; ++j) { const unsigned c = xb_ld(&bar[XB_XCNT(j)]); sum += c; cnt += (c > 0u) ? 1u : 0u; mine = (j == x) ? c : mine; }
        if (sum == G) break;
        __builtin_amdgcn_s_sleep(1);
        if ((++sp & 255u) == 0u) { if (xb_ld(&bar[XB_TMO])) break; if (sp > XB_SPIN_CAP) { atomicAdd(&bar[XB_TMO], 1u); break; } }
    }
    nloc = mine > 0u ? mine : 1u; nx = cnt > 0u ? cnt : 1u;
}
__device__ __forceinline__ void xcd_barrier(const XcdBarrier& b) {
    asm volatile("s_waitcnt vmcnt(0)" ::: "memory");
    __syncthreads();
    if (threadIdx.x == 0) {
        unsigned* bar = b.bar;
        __builtin_amdgcn_s_waitcnt(0);
        unsigned nloc = b.st[0], nx = b.st[1];
        if (nloc == 0u) { xcd_barrier_complete(bar, b.x, nloc, nx); b.st[0] = nloc; b.st[1] = nx; }
        const unsigned old = xb_add(&bar[XB_XSUB(b.x)], 1u);
        const unsigned gen = old / nloc;
        if (old + 1u == (gen + 1u) * nloc) {
            __builtin_amdgcn_fence(__ATOMIC_RELEASE, "agent");
            asm volatile("s_waitcnt vmcnt(0)" ::: "memory");
            const unsigned og = xb_add(&bar[XB_TOP], 1u);
            const unsigned tg = og / nx;
            if (og + 1u == (tg + 1u) * nx) xb_add(&bar[XB_TOPGEN], 1u);
            else XB_SPIN(xb_ld(&bar[XB_TOPGEN]) == tg, bar);
            __builtin_amdgcn_fence(__ATOMIC_ACQUIRE, "agent");
            xb_add(&bar[XB_XGEN(b.x)], 1u);
            asm volatile("s_waitcnt vmcnt(0)" ::: "memory");
        } else {
            XB_SPIN(xb_ld(&bar[XB_XGEN(b.x)]) == gen, bar);
            __builtin_amdgcn_fence(__ATOMIC_ACQUIRE, "agent");
            asm volatile("s_waitcnt vmcnt(0)" ::: "memory");
        }
    }
    __syncthreads();
}

__device__ __forceinline__ void xcd_local_barrier(const XcdBarrier& b) {
    asm volatile("s_waitcnt vmcnt(0)" ::: "memory");
    __syncthreads();
    if (threadIdx.x == 0) {
        unsigned* bar = b.bar;
        const unsigned nloc = b.st[0];
        const unsigned old = xb_add(&bar[XB_LSUB(b.x)], 1u);
        const unsigned gen = old / nloc;
        if (old + 1u == (gen + 1u) * nloc) xb_add(&bar[XB_LGEN(b.x)], 1u);
        else XB_SPIN(xb_ld(&bar[XB_LGEN(b.x)]) == gen, bar);
        __builtin_amdgcn_fence(__ATOMIC_ACQUIRE, "agent");
        asm volatile("s_waitcnt vmcnt(0)" ::: "memory");
    }
    __syncthreads();
}

struct Args {
    const float* in[26]; float* out; unsigned char* ws; int ph_lo, ph_hi;
};
struct Ctx { LAS unsigned char* lds; int tid, lane, wave, vcu, G; };

__device__ __forceinline__ int rowmap(int kind, int half, int n) {
    if (kind == 0) {
        if (n < 1024) { const int hf = n >> 9, r = n & 511; return 256 * (r >> 7) + 128 * hf + (r & 127); }
        const int pn = n >> 8, w = n & 255, wc = w >> 6, bj = (w >> 5) & 1, j = w & 31; return 256 * pn + 128 * bj + 32 * wc + j;
    }
    if (kind == 2) { const int hf = n >> 10, r = n & 1023; return 256 * (r >> 7) + 128 * hf + (r & 127); }
    if (kind == 3) return 256 * (n >> 7) + 128 * half + (n & 127);
    return n;
}
struct ConvDesc { const float* src; bf16* dst; const float* gsc; int N, kind, half, k0, n0; };
__device__ __forceinline__ bool conv_desc(const Args& a, int it, ConvDesc& d) {
    constexpr int I_IN = 16 * 40, I_OUT = 256, I_GLU = 16 * 32, I_EXP = 2 * 16 * 3 * 256;
    if (it >= I_IN + I_OUT + I_GLU + I_EXP) return false;
    unsigned char* ws = a.ws; int r = it, kb, nb; d.gsc = nullptr;
    if (r < I_IN) { d.src = a.in[2]; d.N = INC; d.dst = (bf16*)(ws + WS_WIN); d.kind = 0; d.half = 0; kb = r / 40; nb = r % 40; }
    else if ((r -= I_IN) < I_OUT) { d.src = a.in[9]; d.N = D; d.dst = (bf16*)(ws + WS_WOUT); d.kind = 1; d.half = 0; kb = r >> 4; nb = r & 15; }
    else if ((r -= I_OUT) < I_GLU) { d.src = a.in[19]; d.N = 2 * D; d.dst = (bf16*)(ws + WS_WGLU); d.kind = 2; d.half = 0; kb = r >> 5; nb = r & 31; }
    else { r -= I_GLU; const int mat = r >> 8, tile = r & 255, layer = mat / 48, rem = mat % 48, e = rem / 3, which = rem % 3;
        d.src = a.in[23 + which] + ((size_t)layer * NE + e) * (size_t)D * EH; d.N = EH;
        d.dst = (bf16*)(ws + WS_WEXP + layer * WEXP_LAYER + (which == 2 ? WEXP_DN + (size_t)e * 2 * MiB : WEXP_GU + (size_t)e * 4 * MiB));
        d.kind = which == 2 ? 1 : 3; d.half = which; kb = tile >> 4; nb = tile & 15; if (which != 2) d.gsc = a.in[20] + (size_t)layer * D; }
    d.k0 = 64 * kb; d.n0 = 64 * nb; return true;
}
__device__ __forceinline__ void conv_load(const ConvDesc& d, f32x4 (&v)[16], int lane) {
    const float* p = d.src + (size_t)(d.k0 + (lane >> 4)) * d.N + d.n0 + 4 * (lane & 15);
#pragma unroll
    for (int it = 0; it < 16; ++it) v[it] = *(const f32x4*)(p + (size_t)(4 * it) * d.N);
}
__device__ __forceinline__ void conv_store(const ConvDesc& d, const f32x4 (&v)[16], LAS float* scr, int lane) {
#pragma unroll
    for (int it = 0; it < 16; ++it) { const int kk = 4 * it + (lane >> 4), nn = 4 * (lane & 15); const float gs = d.gsc ? d.gsc[d.k0 + kk] : 1.f;
        scr[kk * 65 + nn] = v[it][0] * gs; scr[kk * 65 + nn + 1] = v[it][1] * gs; scr[kk * 65 + nn + 2] = v[it][2] * gs; scr[kk * 65 + nn + 3] = v[it][3] * gs; }
    asm volatile("s_waitcnt lgkmcnt(0)" ::: "memory");
    const int kc = lane & 7;
#pragma unroll
    for (int jt = 0; jt < 8; ++jt) {
        const int nl = 8 * jt + (lane >> 3);
        const LAS float* s = scr + (8 * kc) * 65 + nl;
        v4u o; o.x = pk2(s[0], s[65]); o.y = pk2(s[2 * 65], s[3 * 65]); o.z = pk2(s[4 * 65], s[5 * 65]); o.w = pk2(s[6 * 65], s[7 * 65]);
        *(v4u*)(d.dst + (size_t)rowmap(d.kind, d.half, d.n0 + nl) * 1024 + d.k0 + 8 * kc) = o;
    }
    asm volatile("s_waitcnt lgkmcnt(0)" ::: "memory");
}
__device__ __forceinline__ void rms_row_bf16(const float* __restrict__ xrow, const float* __restrict__ g, bf16* __restrict__ orow, int lane) {
    const f32x4* xr = (const f32x4*)xrow + lane;
    f32x4 v[4]; float s = 0.f;
#pragma unroll
    for (int j = 0; j < 4; ++j) { v[j] = xr[64 * j]; s += (v[j][0] * v[j][0] + v[j][1] * v[j][1]) + (v[j][2] * v[j][2] + v[j][3] * v[j][3]); }
    const float r = rsqrtf(wave_sum(s) * (1.f / D) + EPS);
#pragma unroll
    for (int j = 0; j < 4; ++j) { const f32x4 w = ((const f32x4*)g)[lane + 64 * j]; v2u o; o.x = pk2(v[j][0] * r * w[0], v[j][1] * r * w[1]); o.y = pk2(v[j][2] * r * w[2], v[j][3] * r * w[3]); ((v2u*)orow)[lane + 64 * j] = o; }
}
constexpr int CONV_NITEMS = 25984, CONV_FIRST_Q = 640, CW_P1DONE = 128;
__device__ __forceinline__ void conv_drain(const Ctx& C, const Args& a, bool until_flag) {
    LAS float* scr = (LAS float*)(C.lds + C.wave * 16640);
    unsigned* ctl = (unsigned*)(a.ws + WS_CTL);
    LAS int* qs = (LAS int*)(C.lds + 8 * 16640);
    ConvDesc dA; f32x4 vA[16];
    for (;;) {
        if (C.tid == 0) {
            int v = -1;
            if (!(until_flag && __hip_atomic_load(ctl + CW_P1DONE, __ATOMIC_RELAXED, __HIP_MEMORY_SCOPE_AGENT) != 0u))
                v = CONV_FIRST_Q + (int)__hip_atomic_fetch_add(ctl + CW_Q0, 8u, __ATOMIC_RELAXED, __HIP_MEMORY_SCOPE_AGENT);
            qs[0] = v;
        }
        __syncthreads();
        const int base = qs[0];
        __syncthreads();
        if (base < 0 || base >= CONV_NITEMS) break;
        if (conv_desc(a, base + C.wave, dA)) { conv_load(dA, vA, C.lane); conv_store(dA, vA, scr, C.lane); }
    }
}
__device__ __forceinline__ void p0_prologue(const Ctx& C, const Args& a) {
    LAS float* scr = (LAS float*)(C.lds + C.wave * 16640);
    const int gw = C.vcu * NWAVES + C.wave, NGW = C.G * NWAVES;
    unsigned char* ws = a.ws;
    {
        const float* x = a.in[0]; const float* gg = a.in[1]; bf16* XN = (bf16*)(ws + WS_XN); const int lane = C.lane;
        auto LOADR = [&](f32x4 (&v)[4], int m) __attribute__((always_inline)) { const f32x4* xr = (const f32x4*)(x + (size_t)m * D) + lane;
#pragma unroll
            for (int j = 0; j < 4; ++j) v[j] = xr[64 * j]; };
        auto PROC = [&](const f32x4 (&v)[4], int m) __attribute__((always_inline)) { float s = 0.f;
#pragma unroll
            for (int j = 0; j < 4; ++j) s += (v[j][0] * v[j][0] + v[j][1] * v[j][1]) + (v[j][2] * v[j][2] + v[j][3] * v[j][3]);
            const float r = rsqrtf(wave_sum(s) * (1.f / D) + EPS);
#pragma unroll
            for (int j = 0; j < 4; ++j) { const f32x4 w = ((const f32x4*)gg)[lane + 64 * j]; v2u o; o.x = pk2(v[j][0] * r * w[0], v[j][1] * r * w[1]); o.y = pk2(v[j][2] * r * w[2], v[j][3] * r * w[3]); ((v2u*)(XN + (size_t)m * D))[lane + 64 * j] = o; } };
        f32x4 va[4], vb[4]; int m = gw;
        if (m < T) LOADR(va, m);
        for (; m < T; m += 2 * NGW) { if (m + NGW < T) LOADR(vb, m + NGW); PROC(va, m); if (m + 2 * NGW < T) LOADR(va, m + 2 * NGW); if (m + NGW < T) PROC(vb, m + NGW); }
    }
    ConvDesc dA; f32x4 vA[16];
    for (int it = gw; it < CONV_FIRST_Q; it += NGW) if (conv_desc(a, it, dA)) { conv_load(dA, vA, C.lane); conv_store(dA, vA, scr, C.lane); }
}

__device__ __forceinline__ void conv_phase(const Ctx& C, const Args& a) {
    const bf16* GLU = (const bf16*)(a.ws + WS_PROJ);
    bf16* MIXED = (bf16*)(a.ws + WS_MIXED);
    const float* cw = a.in[3]; const float* cb = a.in[4]; const float* lg = a.in[5]; const float* lb = a.in[6];
    LAS float* tl = (LAS float*)C.lds;
    const int cp = C.tid & 255, th = C.tid >> 8, lane = C.lane, wave = C.wave;
    f32x2 w[CONV_W];
#pragma unroll
    for (int j = 0; j < CONV_W; ++j) w[j] = *(const f32x2*)(cw + j * CONV_CH + 2 * cp);
    const f32x2 bias = *(const f32x2*)(cb + 2 * cp);
    auto LOADT = [&](unsigned (&xin)[46], int tile) __attribute__((always_inline)) {
        const int b = tile / (S / 32), s0 = (tile % (S / 32)) * 32;
#pragma unroll
        for (int i = 0; i < 46; ++i) { const int ss = s0 + 16 * th - 15 + i; xin[i] = (ss >= 0 && ss < S) ? *(const unsigned*)(GLU + (size_t)(b * S + ss) * 512 + 2 * cp) : 0u; } };
    auto PROC = [&](const unsigned (&xin)[46], unsigned (&xn)[46], int tile, int nt) __attribute__((always_inline)) {
        const int b = tile / (S / 32), s0 = (tile % (S / 32)) * 32;
        f32x2 acc[16];
#pragma unroll
        for (int k = 0; k < 16; ++k) acc[k] = bias;
#pragma unroll
        for (int i = 0; i < 46; ++i) {
            unsigned xi = xin[i]; asm volatile("" : "+v"(xi));
            const f32x2 x = {bflo(xi), bfhi(xi)};
#pragma unroll
            for (int k = 0; k < 16; ++k) { const int j = i - k; if (j >= 0 && j < CONV_W) acc[k] += w[j] * x; }
        }
        if (nt < T / 32) LOADT(xn, nt);
#pragma unroll
        for (int k = 0; k < 16; ++k) *(LAS f32x2*)(tl + (16 * th + k) * 512 + 2 * cp) = acc[k];
        __syncthreads();
#pragma unroll
        for (int q = 0; q < 4; ++q) {
            const int tok = 4 * wave + q;
            const f32x4 v0 = *(const LAS f32x4*)(tl + tok * 512 + 8 * lane), v1 = *(const LAS f32x4*)(tl + tok * 512 + 8 * lane + 4);
            const float mu = wave_sum((v0[0] + v0[1]) + (v0[2] + v0[3]) + (v1[0] + v1[1]) + (v1[2] + v1[3])) * (1.f / CONV_CH);
            const f32x4 d0 = v0 - mu, d1 = v1 - mu;
            const float var = wave_sum((d0[0] * d0[0] + d0[1] * d0[1]) + (d0[2] * d0[2] + d0[3] * d0[3]) + (d1[0] * d1[0] + d1[1] * d1[1]) + (d1[2] * d1[2] + d1[3] * d1[3])) * (1.f / CONV_CH);
            const float rs = rsqrtf(var + EPS);
            const f32x4 g0 = *(const f32x4*)(lg + 8 * lane), g1 = *(const f32x4*)(lg + 8 * lane + 4), b0 = *(const f32x4*)(lb + 8 * lane), b1 = *(const f32x4*)(lb + 8 * lane + 4);
            f32x4 y0 = d0 * rs * g0 + b0, y1 = d1 * rs * g1 + b1;
#pragma unroll
            for (int e = 0; e < 4; ++e) { y0[e] = y0[e] * sigm(y0[e]); y1[e] = y1[e] * sigm(y1[e]); }
            v4u o; o.x = pk2(y0[0], y0[1]); o.y = pk2(y0[2], y0[3]); o.z = pk2(y1[0], y1[1]); o.w = pk2(y1[2], y1[3]);
            *(v4u*)(MIXED + (size_t)(b * S + s0 + tok) * D + 8 * lane) = o;
        }
        __syncthreads();
    };
    unsigned xa[46];
    int t = C.vcu;
    if (t < T / 32) LOADT(xa, t);
#pragma unroll 1
    for (; t < T / 32; t += C.G) PROC(xa, xa, t, t + C.G);
}
typedef short bf16x8 __attribute__((ext_vector_type(8)));
typedef short s16x4 __attribute__((ext_vector_type(4)));
typedef short v4i16_t __attribute__((ext_vector_type(4)));
typedef float f32x16 __attribute__((ext_vector_type(16)));
constexpr int AT_O = 0, AT_L = 65536, AT_V = 66560;
__device__ __forceinline__ s16x4 vtr(const LAS char* p) { return __builtin_bit_cast(s16x4, __builtin_amdgcn_ds_read_tr16_b64_v4i16((LAS v4i16_t*)p)); }
__device__ __forceinline__ void lds_addf(LAS float* p, float v) { (void)__hip_atomic_fetch_add(p, v, __ATOMIC_RELAXED, __HIP_MEMORY_SCOPE_WORKGROUP); }
__device__ __forceinline__ int med3i(int x, int lo, int hi) { return x < lo ? lo : (x > hi ? hi : x); }
__device__ __forceinline__ void attn_unit(const Ctx& C, const bf16* __restrict__ Qh, const bf16* __restrict__ Kh, const bf16* __restrict__ Vh,
                                          int d, int tq0, int nq, int tl0, int tls, float a2, float bound2, LAS float* Oacc, LAS float* Lacc, LAS char* vst, bool first) {
    int lane_ = C.lane; asm volatile("" : "+v"(lane_));
    const int lane = lane_, r = lane & 31, hh = lane >> 5;
    const int qi = r < nq ? r : nq - 1;
    bf16x8 qf[4]; v4u ks_[2][4], vs[2][4];
    const char* Kc = (const char*)Kh; const char* Vc = (const char*)Vh;
#define AT_LOADK(kb) do { _Pragma("unroll") for (int it = 0; it < 4; ++it) { const int key = (lane >> 3) + 8 * it; \
        const unsigned ro = (unsigned)med3i(tq0 + d * (32 * (kb) + key - 64), 0, S - 1) * 128u + 16u * (lane & 7); ks_[(kb) % 2][it] = *(const v4u*)(Kc + ro); } } while (0)
#define AT_LOADV(kb) do { _Pragma("unroll") for (int it = 0; it < 4; ++it) { const int key = (lane >> 3) + 8 * it; \
        const unsigned ro = (unsigned)med3i(tq0 + d * (32 * (kb) + key - 64), 0, S - 1) * 128u + 16u * (lane & 7); vs[(kb) % 2][it] = *(const v4u*)(Vc + ro); } } while (0)
    { const char* qp = (const char*)Qh + (unsigned)(tq0 + d * qi) * 128u + 16u * hh;
#pragma unroll
      for (int ks = 0; ks < 4; ++ks) qf[ks] = *(const bf16x8*)(qp + 32 * ks); }
    AT_LOADK(0); AT_LOADV(0);
    f32x16 o0, o1;
#pragma unroll
    for (int v = 0; v < 16; ++v) { o0[v] = 0.f; o1[v] = 0.f; }
    float lsum = 0.f;
    LAS char* kst = vst, *vt = vst + 4096;
    const LAS char* vb = vt + ((lane >> 4) & 1) * 32 + (lane & 3) * 8 + (4 * hh + ((lane & 15) >> 2)) * 64;
    LAS char* vw = vt + ((lane & 7) >> 2) * 2048 + ((lane >> 3) & 15) * 64 + (lane & 3) * 16;
    LAS char* kw = kst + (lane >> 3) * 128;
    const LAS char* kr = kst + r * 128;
    const int rsw = (r >> 1) & 7;
#pragma unroll
    for (int kb = 0; kb < 5; ++kb) {
        if (kb + 1 < 5) { AT_LOADK(kb + 1); AT_LOADV(kb + 1); }
#pragma unroll
        for (int it = 0; it < 4; ++it) { const int key = (lane >> 3) + 8 * it;
            *(LAS v4u*)(kw + it * 1024 + (((lane & 7) ^ ((key >> 1) & 7)) << 4)) = ks_[kb % 2][it]; }
        f32x16 p;
        int relb = 32 * kb - 64 - r + 4 * hh; const int kposb = tq0 + d * (32 * kb - 64 + 4 * hh);
        asm volatile("" : "+v"(relb));
#pragma unroll
        for (int v = 0; v < 16; ++v) {
            const int rw = (v & 3) + 8 * (v >> 2), rel = relb + rw, kpos = kposb + d * rw;
            bool valid = ((unsigned)kpos < (unsigned)S) && (r < nq);
            if (kb == 0) valid = valid && (rel >= -64);
            if (kb == 4) valid = valid && (rel <= 64);
            p[v] = valid ? -(a2 * fabsf((float)rel)) - bound2 : -1e30f;
        }
        asm volatile("s_waitcnt lgkmcnt(0)" ::: "memory");
        bf16x8 kf[4];
#pragma unroll
        for (int ks = 0; ks < 4; ++ks) kf[ks] = *(const LAS bf16x8*)(kr + (((2 * ks + hh) ^ rsw) << 4));
#pragma unroll
        for (int ks = 0; ks < 4; ++ks) p = __builtin_amdgcn_mfma_f32_32x32x16_bf16(kf[ks], qf[ks], p, 0, 0, 0);
#pragma unroll
        for (int it = 0; it < 4; ++it) *(LAS v4u*)(vw + (it >> 1) * 1024 + (it & 1) * 512) = vs[kb % 2][it];
#pragma unroll
        for (int v = 0; v < 16; ++v) { p[v] = __builtin_amdgcn_exp2f(p[v]); lsum += p[v]; }
        v4u pw0, pw1;
        pw0.x = pk2(p[0], p[1]); pw0.y = pk2(p[2], p[3]); pw0.z = pk2(p[4], p[5]); pw0.w = pk2(p[6], p[7]);
        pw1.x = pk2(p[8], p[9]); pw1.y = pk2(p[10], p[11]); pw1.z = pk2(p[12], p[13]); pw1.w = pk2(p[14], p[15]);
        asm volatile("s_waitcnt lgkmcnt(0)" ::: "memory");
#pragma unroll
        for (int sdh = 0; sdh < 4; ++sdh) {
            const int dh = sdh >> 1, ss = sdh & 1;
            const s16x4 lo = vtr(vb + dh * 2048 + ss * 1024), hi = vtr(vb + dh * 2048 + ss * 1024 + 512);
            const bf16x8 vf = {lo[0], lo[1], lo[2], lo[3], hi[0], hi[1], hi[2], hi[3]};
            const bf16x8 pa = __builtin_bit_cast(bf16x8, ss == 0 ? pw0 : pw1);
            if (dh == 0) o0 = __builtin_amdgcn_mfma_f32_32x32x16_bf16(pa, vf, o0, 0, 0, 0);
            else o1 = __builtin_amdgcn_mfma_f32_32x32x16_bf16(pa, vf, o1, 0, 0, 0);
        }
        asm volatile("s_waitcnt lgkmcnt(0)" ::: "memory");
    }
#undef AT_LOADK
#undef AT_LOADV
    lsum += __shfl_xor(lsum, 32);
    if (lane < nq) { LAS float* lp = Lacc + tl0 + tls * lane; *lp = first ? lsum : *lp + lsum; }
#pragma unroll
    for (int v = 0; v < 16; ++v) {
        const int iq = (v & 3) + 8 * (v >> 2) + 4 * hh;
        if (v < 8 || nq == 32) { LAS float* op = Oacc + (tl0 + tls * iq) * 64 + r;
            if (first) { op[0] = o0[v]; op[32] = o1[v]; } else { const float x0 = op[0], x1 = op[32]; op[0] = x0 + o0[v]; op[32] = x1 + o1[v]; } }
    }
}
__device__ __forceinline__ void attn_phase(const Ctx& C, const Args& a) {
    const bf16* Q = (const bf16*)(a.ws + WS_PROJ + 16 * MiB);
    const bf16* K = (const bf16*)(a.ws + WS_PROJ + 32 * MiB);
    const bf16* V = (const bf16*)(a.ws + WS_PROJ + 48 * MiB);
    bf16* MIXED = (bf16*)(a.ws + WS_MIXED);
    LAS float* Oacc = (LAS float*)(C.lds + AT_O); LAS float* Lacc = (LAS float*)(C.lds + AT_L); LAS char* vst = (LAS char*)(C.lds + AT_V + C.wave * 8192);
    float mq = fabsf(a.in[7][C.lane]), mk = fabsf(a.in[8][C.lane]);
#pragma unroll
    for (int o = 1; o < 64; o <<= 1) { mq = fmaxf(mq, __shfl_xor(mq, o)); mk = fmaxf(mk, __shfl_xor(mk, o)); }
    const float bound2 = 64.f * pg8::QSCALE * mq * mk * 1.01f;
    for (int item = C.vcu; item < NB * NH * 16; item += C.G) {
        const int span = item & 15, h = (item >> 4) & 7, b = item >> 7, t0 = span * 256, w = C.wave;
        const size_t hb = (size_t)(b * NH + h) * S * 64;
        const bf16 *Qh = Q + hb, *Kh = K + hb, *Vh = V + hb;
        const float slope2 = exp2f(-(float)(h + 1)) * 1.4426950408889634f;
#pragma unroll 1
        for (int un = 0; un < 4; ++un) {
            const int d = un == 0 ? 1 : (un == 1 ? 4 : 16);
            const int tl0 = un == 0 ? 32 * w : (un == 1 ? (w >> 1) + 128 * (w & 1) : 2 * w + (un - 2));
            attn_unit(C, Qh, Kh, Vh, d, t0 + tl0, un < 2 ? 32 : 16, tl0, d, slope2 * (float)d, bound2, Oacc, Lacc, vst, un == 0);
            if (un < 2) __syncthreads();
        }
        __syncthreads();
        {
            const int q = C.tid >> 1, hf = C.tid & 1;
            const float inv = 1.f / Lacc[q];
            const LAS f32x4* op = (const LAS f32x4*)(Oacc + q * 64 + 32 * hf);
            bf16* dst = MIXED + (size_t)(b * S + t0 + q) * D + 512 + h * 64 + 32 * hf;
#pragma unroll
            for (int j = 0; j < 4; ++j) { const f32x4 x0 = op[2 * j] * inv, x1 = op[2 * j + 1] * inv; v4u o; o.x = pk2(x0[0], x0[1]); o.y = pk2(x0[2], x0[3]); o.z = pk2(x1[0], x1[1]); o.w = pk2(x1[2], x1[3]); *(v4u*)(dst + 8 * j) = o; }
        }
        __syncthreads();
    }
}

typedef float f32x4m __attribute__((ext_vector_type(4)));
__device__ __forceinline__ void p_router(const Ctx& C, const Args& a, int layer) {
    const bf16* X = (const bf16*)(a.ws + (layer == 0 ? WS_XA : WS_XB)); const float* g = a.in[20] + (size_t)layer * D;
    const float* wr = a.in[21] + (size_t)layer * D * NE; const float* br = a.in[22] + layer * NE;
    float* RS = (float*)(a.ws + WS_RS); float* AFF = (float*)(a.ws + WS_AFF);
    LAS unsigned char* wl = C.lds;
    LAS float* xch = (LAS float*)(C.lds + 65536);
    const int lane = C.lane, row = lane & 15, kq = lane >> 4, wq = C.wave & 3, kh = C.wave >> 2;
    bool first = true;
    for (int tb = 4 * C.vcu; tb < T / 16; tb += 4 * C.G) {
        const int m0 = 16 * (tb + wq);
        const bf16* xp = X + (size_t)(m0 + row) * D + 8 * kq + 512 * kh;
        bf16x8 fa[8], fb[8];
        f32x4m acc = {0.f, 0.f, 0.f, 0.f}; float ss = 0.f;
#define RT_LOAD(dst, c) do { _Pragma("unroll") for (int i = 0; i < 8; ++i) dst[i] = *(const bf16x8*)(xp + 32 * (8 * (c) + i)); } while (0)
#define RT_MUL(src, c) do { _Pragma("unroll") for (int i = 0; i < 8; ++i) { const int ks = 16 * kh + 8 * (c) + i; \
            const bf16x8 bh = *(const LAS bf16x8*)(wl + (ks * 64 + lane) * 16), bl = *(const LAS bf16x8*)(wl + 32768 + (ks * 64 + lane) * 16); \
            acc = __builtin_amdgcn_mfma_f32_16x16x32_bf16(src[i], bh, acc, 0, 0, 0); acc = __builtin_amdgcn_mfma_f32_16x16x32_bf16(src[i], bl, acc, 0, 0, 0); \
            const v4u raw = __builtin_bit_cast(v4u, src[i]); \
            const float x0 = bflo(raw.x), x1 = bfhi(raw.x), x2 = bflo(raw.y), x3 = bfhi(raw.y), x4 = bflo(raw.z), x5 = bfhi(raw.z), x6 = bflo(raw.w), x7 = bfhi(raw.w); \
            ss += ((x0 * x0 + x1 * x1) + (x2 * x2 + x3 * x3)) + ((x4 * x4 + x5 * x5) + (x6 * x6 + x7 * x7)); \
            if (i & 1) asm volatile("" ::: "memory"); } } while (0)
        RT_LOAD(fa, 0); RT_LOAD(fb, 1);
        if (first) {
#pragma unroll
            for (int it = 0; it < 32 * 64 / NTHR; ++it) { const int idx = C.tid + it * NTHR;
                const int ks = idx >> 6, l = idx & 63, n = l & 15, kq2 = l >> 4; unsigned hi[4], lo[4];
#pragma unroll
                for (int jj = 0; jj < 4; ++jj) { float wv[2]; unsigned short hb[2];
#pragma unroll
                    for (int t = 0; t < 2; ++t) { const int k = 32 * ks + 8 * kq2 + 2 * jj + t; wv[t] = g[k] * wr[(size_t)k * NE + n]; }
                    const unsigned ph = pk2(wv[0], wv[1]); hb[0] = (unsigned short)(ph & 0xffffu); hb[1] = (unsigned short)(ph >> 16);
                    const unsigned pl = pk2(wv[0] - bf2f(hb[0]), wv[1] - bf2f(hb[1]));
                    hi[jj] = ph; lo[jj] = pl; }
                *(LAS v4u*)(wl + idx * 16) = (v4u){hi[0], hi[1], hi[2], hi[3]};
                *(LAS v4u*)(wl + 32768 + idx * 16) = (v4u){lo[0], lo[1], lo[2], lo[3]};
            }
            __syncthreads();
            first = false;
        }
        RT_MUL(fa, 0); RT_MUL(fb, 1);
#undef RT_LOAD
#undef RT_MUL
        if (kh) {
#pragma unroll
            for (int r = 0; r < 4; ++r) xch[(wq * 5 + r) * 64 + lane] = acc[r];
            xch[(wq * 5 + 4) * 64 + lane] = ss;
        }
        __syncthreads();
        if (!kh) {
#pragma unroll
            for (int r = 0; r < 4; ++r) acc[r] += xch[(wq * 5 + r) * 64 + lane];
            ss += xch[(wq * 5 + 4) * 64 + lane];
            ss += __shfl_xor(ss, 16); ss += __shfl_xor(ss, 32);
            const float rs = rsqrtf(ss * (1.f / D) + EPS);
            if (lane < 16) RS[m0 + lane] = rs;
            const float bias = br[row];
#pragma unroll
            for (int r = 0; r < 4; ++r) {
                const int orow = 4 * kq + r;
                const float lg = acc[r] * __shfl(rs, orow) + bias;
                float mx = lg;
#pragma unroll
                for (int o = 1; o < 16; o <<= 1) mx = fmaxf(mx, __shfl_xor(mx, o));
                const float ex = __expf(lg - mx); float sum = ex;
#pragma unroll
                for (int o = 1; o < 16; o <<= 1) sum += __shfl_xor(sum, o);
                const int m = m0 + orow, b = m / S, sidx = m % S;
                AFF[((size_t)b * NE + row) * S + sidx] = ex / sum;
            }
        }
        __syncthreads();
    }
}

__device__ __forceinline__ int popc64(unsigned long long m) { return __builtin_popcountll(m); }
__device__ __forceinline__ void p_topk(const Ctx& C, const Args& a) {
    const float* AFF = (const float*)(a.ws + WS_AFF);
    int* IDX = (int*)(a.ws + WS_IDX); float* GATE = (float*)(a.ws + WS_GATE); int* SLOT = (int*)(a.ws + WS_SLOT);
    const float* RS = (const float*)(a.ws + WS_RS); float* RSROW = (float*)(a.ws + WS_RSROW);
    LAS int* red = (LAS int*)C.lds;
    const int lane = C.lane, w = C.wave;
    const bool by_xcd = (C.G == 256);
    for (int it = C.vcu; it < (by_xcd ? C.G : NB * NE); it += C.G) {
        int be = it;
        if (by_xcd) { const int x = it >> 5, r = it & 31; if (r >= 8) break; be = (r >> 1) * NE + x + 8 * (r & 1); }
        const int b = be / NE, e = be % NE;
        unsigned key[8];
        { const v4u k0 = *(const v4u*)(AFF + (size_t)be * S + 512 * w + 8 * lane), k1 = *(const v4u*)(AFF + (size_t)be * S + 512 * w + 8 * lane + 4);
          key[0] = k0.x; key[1] = k0.y; key[2] = k0.z; key[3] = k0.w; key[4] = k1.x; key[5] = k1.y; key[6] = k1.z; key[7] = k1.w; }
        unsigned cur = 0u;
#pragma unroll 1
        for (int bit = 30; bit >= 0; --bit) {
            const unsigned cand = cur | (1u << bit);
            unsigned c = 0;
#pragma unroll
            for (int i = 0; i < 8; ++i) c += (key[i] >= cand) ? 1u : 0u;
            int cnt = 0;
#pragma unroll
            for (int k = 0; k < 4; ++k) cnt += popc64(__ballot((c >> k) & 1u)) << k;
            const int par = bit & 1;
            if (lane == 0) red[par * 8 + w] = cnt;
            __syncthreads();
            int tot = 0;
#pragma unroll
            for (int ww = 0; ww < 8; ++ww) tot += red[par * 8 + ww];
            if (tot >= CAP) cur = cand;
        }
        unsigned pk = 0;
#pragma unroll
        for (int i = 0; i < 8; ++i) pk += (key[i] > cur ? 1u : 0u) + (key[i] == cur ? 0x10000u : 0u);
        unsigned inc = pk;
#pragma unroll
        for (int o = 1; o < 64; o <<= 1) { const unsigned t = __shfl_up(inc, o); if (lane >= o) inc += t; }
        if (lane == 63) { red[16 + w] = (int)(inc & 0xffffu); red[24 + w] = (int)(inc >> 16); }
        __syncthreads();
        int gpre = 0, epre = 0, ngt = 0;
#pragma unroll
        for (int ww = 0; ww < 8; ++ww) { const int tg = red[16 + ww], te = red[24 + ww]; ngt += tg; if (ww < w) { gpre += tg; epre += te; } }
        const int need = CAP - ngt;
        const unsigned exc = inc - pk;
        int gtb = gpre + (int)(exc & 0xffffu), eqb = epre + (int)(exc >> 16);
#pragma unroll
        for (int i = 0; i < 8; ++i) {
            const bool gt = key[i] > cur, eq = key[i] == cur;
            const bool sel = gt || (eq && eqb < need);
            const int pos = gtb + (eqb < need ? eqb : need);
            const int tok = 512 * w + 8 * lane + i;
            SLOT[((size_t)(b * S + tok)) * NE + e] = sel ? pos : -1;
            if (sel) { IDX[be * CAP + pos] = b * S + tok; GATE[be * CAP + pos] = __uint_as_float(key[i]); RSROW[be * CAP + pos] = RS[b * S + tok]; }
            gtb += gt ? 1 : 0; eqb += eq ? 1 : 0;
        }
        __syncthreads();
    }
}

__device__ __forceinline__ void p_combine(const Ctx& C, const Args& a, bool with_norm) {
    const bf16* Xin = (const bf16*)(a.ws + (with_norm ? WS_XA : WS_XB)); bf16* Xb = (bf16*)(a.ws + WS_XB); float* Xout = a.out;
    const bf16* Y = (const bf16*)(a.ws + WS_PROJ); const int* SLOT = (const int*)(a.ws + WS_SLOT);
    bf16* UC = (bf16*)(a.ws + WS_H); const float* g = a.in[10];
    const int gw = C.vcu * NWAVES + C.wave, NGW = C.G * NWAVES, lane = C.lane;
    auto LOADR = [&](v4u (&v)[2], int& slot, int m) __attribute__((always_inline)) { const v4u* xr = (const v4u*)(Xin + (size_t)m * D) + 2 * lane; v[0] = xr[0]; v[1] = xr[1];
        slot = (lane < NE) ? SLOT[(size_t)m * NE + lane] : -1; };
    auto PROC = [&](const v4u (&vr)[2], int myslot, int m) __attribute__((always_inline)) {
        const int b = m / S;
        f32x4 v[4];
        v[0] = (f32x4){bflo(vr[0].x), bfhi(vr[0].x), bflo(vr[0].y), bfhi(vr[0].y)}; v[1] = (f32x4){bflo(vr[0].z), bfhi(vr[0].z), bflo(vr[0].w), bfhi(vr[0].w)};
        v[2] = (f32x4){bflo(vr[1].x), bfhi(vr[1].x), bflo(vr[1].y), bfhi(vr[1].y)}; v[3] = (f32x4){bflo(vr[1].z), bfhi(vr[1].z), bflo(vr[1].w), bfhi(vr[1].w)};
        unsigned long long mask = __ballot(myslot >= 0);
        while (mask) {
            v4u y[4][2]; int ee[4];
#pragma unroll
            for (int q = 0; q < 4; ++q) { ee[q] = mask ? (int)__builtin_ctzll(mask) : -1; if (mask) mask &= mask - 1; }
#pragma unroll
            for (int q = 0; q < 4; ++q) if (ee[q] >= 0) { const int sl = __shfl(myslot, ee[q]);
                const v4u* yr = (const v4u*)(Y + ((size_t)(b * NE + ee[q]) * CAP + sl) * D) + 2 * lane; y[q][0] = yr[0]; y[q][1] = yr[1]; }
#pragma unroll
            for (int q = 0; q < 4; ++q) if (ee[q] >= 0) {
#pragma unroll
                for (int hq = 0; hq < 2; ++hq) { const v4u t = y[q][hq];
                    v[2 * hq][0] += bflo(t.x); v[2 * hq][1] += bfhi(t.x); v[2 * hq][2] += bflo(t.y); v[2 * hq][3] += bfhi(t.y);
                    v[2 * hq + 1][0] += bflo(t.z); v[2 * hq + 1][1] += bfhi(t.z); v[2 * hq + 1][2] += bflo(t.w); v[2 * hq + 1][3] += bfhi(t.w); } }
        }
        if (!with_norm) { f32x4* xo = (f32x4*)(Xout + (size_t)m * D) + 4 * lane;
#pragma unroll
            for (int j = 0; j < 4; ++j) xo[j] = v[j]; }
        else { v4u o0, o1; o0.x = pk2(v[0][0], v[0][1]); o0.y = pk2(v[0][2], v[0][3]); o0.z = pk2(v[1][0], v[1][1]); o0.w = pk2(v[1][2], v[1][3]);
            o1.x = pk2(v[2][0], v[2][1]); o1.y = pk2(v[2][2], v[2][3]); o1.z = pk2(v[3][0], v[3][1]); o1.w = pk2(v[3][2], v[3][3]);
            v4u* xo = (v4u*)(Xb + (size_t)m * D) + 2 * lane; xo[0] = o0; xo[1] = o1; }
        if (with_norm) {
            float s = 0.f;
#pragma unroll
            for (int j = 0; j < 4; ++j) s += (v[j][0] * v[j][0] + v[j][1] * v[j][1]) + (v[j][2] * v[j][2] + v[j][3] * v[j][3]);
            const float r = rsqrtf(wave_sum(s) * (1.f / D) + EPS);
            unsigned w[8];
#pragma unroll
            for (int j = 0; j < 4; ++j) { const f32x4 gg = ((const f32x4*)g)[4 * lane + j]; w[2 * j] = pk2(v[j][0] * r * gg[0], v[j][1] * r * gg[1]); w[2 * j + 1] = pk2(v[j][2] * r * gg[2], v[j][3] * r * gg[3]); }
            bf16* up = UC + ((size_t)(lane * 1024 + (m >> 4)) * 512 + (m & 15) * 16);
            *(v4u*)up = (v4u){w[0], w[1], w[2], w[3]}; *(v4u*)(up + 8) = (v4u){w[4], w[5], w[6], w[7]};
        }
    };
    v4u va[2], vb[2]; int sa = -1, sb = -1;
    int m = gw;
    if (m < T) LOADR(va, sa, m);
    for (; m < T; m += 2 * NGW) {
        if (m + NGW < T) LOADR(vb, sb, m + NGW);
        PROC(va, sa, m);
        if (m + 2 * NGW < T) LOADR(va, sa, m + 2 * NGW);
        if (m + NGW < T) PROC(vb, sb, m + NGW);
    }
}

constexpr size_t WS_UC = WS_H;
constexpr size_t WS_E = WS_PROJ;
constexpr size_t WS_TM = 468 * MiB;
constexpr size_t WS_W16 = 484 * MiB;
__device__ __forceinline__ void s5_lambda(const Args& a, int pg, int p, float& lbr, float& lbi, float& fr, float& fi) {
    const float lr = a.in[11][pg * SP + p], li = a.in[12][pg * SP + p], dt = expf(a.in[13][pg]);
    const float mag = expf(lr * dt), ang = li * dt;
    lbr = mag * cosf(ang); lbi = mag * sinf(ang);
    const float den = lr * lr + li * li, nr = lbr - 1.f;
    fr = (nr * lr + lbi * li) / den; fi = (lbi * lr - nr * li) / den;
}
__device__ __forceinline__ void p_s5_pre(const Ctx& C, const Args& a, int g) {
    LAS float* lam = (LAS float*)C.lds; LAS float* bb = lam + 2 * 64 * 17 * 2; LAS float* cc = bb + 2 * 64 * 16 * 2; LAS float* Kt = cc + 2 * 16 * 64 * 2;
    bf16* TM = (bf16*)(a.ws + WS_TM) + (size_t)g * 256 * 512; bf16* W16 = (bf16*)(a.ws + WS_W16) + (size_t)g * 256 * 256;
    const int tid = C.tid;
    if (tid < 128) {
        const int dir = tid >> 6, p = tid & 63, pg = dir * SG + g;
        float lbr, lbi, fr, fi; s5_lambda(a, pg, p, lbr, lbi, fr, fi);
        float pr = 1.f, pi = 0.f;
        for (int k = 0; k <= 16; ++k) { lam[((dir * 64 + p) * 17 + k) * 2] = pr; lam[((dir * 64 + p) * 17 + k) * 2 + 1] = pi; const float nr = pr * lbr - pi * lbi, ni = pr * lbi + pi * lbr; pr = nr; pi = ni; }
        for (int c = 0; c < 16; ++c) { const float br = a.in[14][((size_t)pg * SP + p) * SC + c], bi = a.in[15][((size_t)pg * SP + p) * SC + c];
            bb[((dir * 64 + p) * 16 + c) * 2] = fr * br - fi * bi; bb[((dir * 64 + p) * 16 + c) * 2 + 1] = fr * bi + fi * br; }
    }
    for (int i = tid; i < 2048; i += NTHR) { const int dir = i >> 10, r = i & 1023;
        cc[i * 2] = a.in[16][(size_t)(dir * SG + g) * 1024 + r]; cc[i * 2 + 1] = a.in[17][(size_t)(dir * SG + g) * 1024 + r]; }
    __syncthreads();
    for (int id = tid; id < 8192; id += NTHR) {
        const int dir = id >> 12, k = (id >> 8) & 15, cp = (id >> 4) & 15, c = id & 15; float acc = 0.f;
        for (int p = 0; p < 64; ++p) {
            const float cr = cc[((dir * 16 + cp) * 64 + p) * 2], ci = cc[((dir * 16 + cp) * 64 + p) * 2 + 1];
            const float lr = lam[((dir * 64 + p) * 17 + k) * 2], li = lam[((dir * 64 + p) * 17 + k) * 2 + 1];
            const float xr = cr * lr - ci * li, xi = cr * li + ci * lr;
            acc += xr * bb[((dir * 64 + p) * 16 + c) * 2] - xi * bb[((dir * 64 + p) * 16 + c) * 2 + 1];
        }
        Kt[id] = acc;
    }
    __syncthreads();
    const float* dsk = a.in[18] + g * 16;
    for (int e8 = tid; e8 < 256 * 64; e8 += NTHR) {
        const int n = e8 >> 6, ch = e8 & 63, t = n >> 4, cp = n & 15; float v[8];
        if (ch < 32) {
            const int s_ = ch >> 1, c0 = (ch & 1) * 8;
#pragma unroll
            for (int i = 0; i < 8; ++i) { const int c = c0 + i; float x = 0.f;
                if (s_ <= t) x += Kt[((0 * 16 + (t - s_)) * 16 + cp) * 16 + c];
                if (s_ >= t) x += Kt[((1 * 16 + (s_ - t)) * 16 + cp) * 16 + c];
                if (s_ == t && c == cp) x += dsk[cp];
                v[i] = x; }
        } else {
            const int dir = (ch - 32) >> 4, p0 = ((ch - 32) & 15) * 4, e = dir ? 16 - t : t + 1;
#pragma unroll
            for (int i = 0; i < 4; ++i) { const int p = p0 + i;
                const float cr = cc[((dir * 16 + cp) * 64 + p) * 2], ci = cc[((dir * 16 + cp) * 64 + p) * 2 + 1];
                const float lr = lam[((dir * 64 + p) * 17 + e) * 2], li = lam[((dir * 64 + p) * 17 + e) * 2 + 1];
                v[2 * i] = cr * lr - ci * li; v[2 * i + 1] = -(cr * li + ci * lr); }
        }
        v4u o; o.x = pk2(v[0], v[1]); o.y = pk2(v[2], v[3]); o.z = pk2(v[4], v[5]); o.w = pk2(v[6], v[7]);
        *(v4u*)(TM + (size_t)n * 512 + 8 * ch) = o;
    }
    for (int e8 = tid; e8 < 256 * 32; e8 += NTHR) {
        const int n = e8 >> 5, ch = e8 & 31, dir = n >> 7, p = (n & 127) >> 1, part = n & 1, s_ = ch >> 1, c0 = (ch & 1) * 8, e = dir ? s_ : 15 - s_;
        const float lr = lam[((dir * 64 + p) * 17 + e) * 2], li = lam[((dir * 64 + p) * 17 + e) * 2 + 1]; float v[8];
#pragma unroll
        for (int i = 0; i < 8; ++i) { const float br = bb[((dir * 64 + p) * 16 + c0 + i) * 2], bi = bb[((dir * 64 + p) * 16 + c0 + i) * 2 + 1];
            v[i] = part ? (lr * bi + li * br) : (lr * br - li * bi); }
        v4u o; o.x = pk2(v[0], v[1]); o.y = pk2(v[2], v[3]); o.z = pk2(v[4], v[5]); o.w = pk2(v[6], v[7]);
        *(v4u*)(W16 + (size_t)n * 256 + 8 * ch) = o;
    }
    __syncthreads();
}
struct S5Order {
    int G, c;
    __device__ void init(int G_, int c_) { G = G_; c = c_; }
    __device__ bool next(int i, pg8::Unit& u) const {
        const long L = (long)i * G + c; if (L >= 256) return false;
        int V = (int)L; if (G == 256) V = (c & 7) * 32 + (c >> 3);
        u.pm = V; u.pn = 0; u.pb = V >> 2; return true;
    }
    __device__ __forceinline__ void a_ready(const pg8::Unit&) const {}
    __device__ __forceinline__ void done(const pg8::Unit&) const {}
};
struct EpiS5Scan {
    static constexpr bool PERM = true, AFTER_DRAIN = true;
    bf16* UC; const float *lam_re, *lam_im, *log_dt;
    static constexpr int PITCH = 528;
    __device__ __forceinline__ void fused(const pg8::f32x4 (&acc)[2][2][4][2], const pg8::Unit& u, int wr, int wc, int fr, int fq, LAS unsigned char* lds, int wid, int lane) const {
        const int tid = wid * 64 + lane;
#pragma unroll
        for (int ai = 0; ai < 2; ++ai)
#pragma unroll
            for (int m = 0; m < 4; ++m)
#pragma unroll
                for (int bj = 0; bj < 2; ++bj) { const pg8::f32x4 x = acc[ai][bj][m][0], y = acc[ai][bj][m][1];
                    v4u w; w.x = pk2(x[0], x[1]); w.y = pk2(x[2], x[3]); w.z = pk2(y[0], y[1]); w.w = pk2(y[2], y[3]);
                    *(LAS v4u*)(lds + (ai * 128 + wr * 64 + m * 16 + fr) * PITCH + (bj * 128 + wc * 32 + 8 * fq) * 2) = w; }
        __syncthreads();
        const int g = u.pm >> 2;
        if (tid < 128) {
            const int dir = tid >> 6, p = tid & 63, pg = dir * SG + g;
            const float lr = lam_re[pg * SP + p], li = lam_im[pg * SP + p], dt = expf(log_dt[pg]);
            const float mag = expf(lr * dt), ang = li * dt;
            float pr = mag * cosf(ang), pi = mag * sinf(ang);
#pragma unroll
            for (int i = 0; i < 4; ++i) { const float nr = pr * pr - pi * pi, ni = 2.f * pr * pi; pr = nr; pi = ni; }
            LAS unsigned char* col = lds + (dir * 128 + 2 * p) * 2;
            float hr = 0.f, hi = 0.f;
#pragma unroll 8
            for (int j = 0; j < 256; ++j) {
                LAS unsigned* cell = (LAS unsigned*)(col + (dir ? 255 - j : j) * PITCH);
                const unsigned e = *cell; *cell = pk2(hr, hi);
                const float er = bflo(e), ei = bfhi(e); const float nr = pr * hr - pi * hi + er, ni = pr * hi + pi * hr + ei; hr = nr; hi = ni;
            }
        }
        __syncthreads();
        bf16* dst = UC + (size_t)u.pm * 256 * 512 + 256;
#pragma unroll
        for (int i = 0; i < 16; ++i) { const int idx = tid + 512 * i, row = idx >> 5, ch = idx & 31;
            *(v4u*)(dst + (size_t)row * 512 + 8 * ch) = *(const LAS v4u*)(lds + row * PITCH + 16 * ch); }
        __syncthreads();
    }
};
__device__ __forceinline__ float gelu_t(float y) { const float u = 0.7978845608028654f * (y + 0.044715f * y * y * y); const float e = __builtin_amdgcn_exp2f(2.885390081777927f * u); const float th = 1.f - 2.f * __builtin_amdgcn_rcpf(e + 1.f); return 0.5f * y * (1.f + th); }
struct EpiS5Z {
    static constexpr bool PERM = true, AFTER_DRAIN = false;
    bf16* Z;
    __device__ __forceinline__ void operator()(const pg8::f32x4 (&acc)[2][2][4][2], const pg8::Unit& u, int wr, int wc, int fr, int fq) const {
        const int row0 = u.pm * 256 + wr * 64 + fr;
#pragma unroll
        for (int ai = 0; ai < 2; ++ai)
#pragma unroll
            for (int m = 0; m < 4; ++m) { const int row = row0 + ai * 128 + m * 16, g = row >> 10, J = row & 1023;
#pragma unroll
                for (int bj = 0; bj < 2; ++bj) { const int t = 8 * bj + 2 * wc + (fq >> 1), c0 = 8 * (fq & 1);
                    const pg8::f32x4 x = acc[ai][bj][m][0], y = acc[ai][bj][m][1];
                    v4u w; w.x = pk2(gelu_t(x[0]), gelu_t(x[1])); w.y = pk2(gelu_t(x[2]), gelu_t(x[3])); w.z = pk2(gelu_t(y[0]), gelu_t(y[1])); w.w = pk2(gelu_t(y[2]), gelu_t(y[3]));
                    *(v4u*)(Z + (size_t)(16 * J + t) * D + g * 16 + c0) = w; } }
    }
};
constexpr int NPHASE = 18;
__global__ void __launch_bounds__(NTHR, 2) mk_fwd(Args args) {
    extern __shared__ __attribute__((aligned(16))) unsigned char lds_raw[];
    Ctx C;
    C.lds = (LAS unsigned char*)lds_raw;
    C.tid = threadIdx.x; C.lane = C.tid & 63; C.wave = __builtin_amdgcn_readfirstlane(C.tid >> 6);
    C.G = gridDim.x; { const int bx = blockIdx.x; C.vcu = (C.G % 8 == 0) ? (bx % 8) * (C.G / 8) + bx / 8 : bx; }
    volatile LAS unsigned* MISC = (volatile LAS unsigned*)(C.lds + LDSCTL_OFF);
    for (int u = C.tid; u < (LDS_BYTES - LDSCTL_OFF) / 4; u += NTHR) ((LAS unsigned*)(C.lds + LDSCTL_OFF))[u] = 0u;
    __syncthreads();
    int lo = args.ph_lo, hi = args.ph_hi;
    unsigned char* ws = args.ws;
    asm volatile("" : "+s"(lo), "+s"(hi), "+s"(ws));
    unsigned* ctl = (unsigned*)(ws + WS_CTL);
    const bool one_launch = (lo == 0 && hi == NPHASE);
    XcdBarrier bar; bar.bar = ctl + CW_BAR; bar.x = 0; bar.st = nullptr;
    if (one_launch) bar = xcd_barrier_post(ctl + CW_BAR, MISC + 8);
    LAS unsigned char* glds = C.lds;
#ifndef MK_ONLY
#define MK_ONLY -1
#endif
#define IN(k) ((MK_ONLY < 0 || MK_ONLY == (k) || (MK_ONLY == 4 && (k) == 13) || (MK_ONLY == 5 && (k) == 14) || (MK_ONLY == 6 && (k) == 15) || (MK_ONLY == 7 && (k) == 16) || (MK_ONLY == 8 && (k) == 17)) && lo <= (k) && (k) < hi)
#ifndef MK_S5DUP
#define MK_S5DUP 0
#endif
#ifndef MK_DUP
#define MK_DUP 0
#endif
#define DUPBIT(k) ((MK_DUP >> ((k) < 13 ? (k) : (k) - 9)) & 1)
#define DUPX(k, ...) do { __VA_ARGS__ if (DUPBIT(k)) { __VA_ARGS__ } } while (0)
#define SEAM(k) do { if (IN(k) && IN((k) + 1)) xcd_barrier(bar); } while (0)

#ifdef MK_XBAR
    if (one_launch) for (int xb_ = 0; xb_ < MK_XBAR; ++xb_) xcd_barrier(bar);
#endif
    if (IN(0)) { DUPX(0, p0_prologue(C, args);); } SEAM(0);
    int vb = (int)blockIdx.x; bool lsync = false;
    if (one_launch) {
        if (C.tid == 0) {
            unsigned ok = (C.G == 256 && bar.x < 8u && bar.rank < 32u) ? 1u : 0u;
            for (unsigned j = 0; j < 8; ++j) ok &= (xb_ld(&bar.bar[XB_XCNT(j)]) == 32u) ? 1u : 0u;
            MISC[8 + 2] = bar.rank; MISC[8 + 3] = ok;
        }
        __syncthreads();
        const unsigned ok = (unsigned)__builtin_amdgcn_readfirstlane((int)MISC[8 + 3]), rk = (unsigned)__builtin_amdgcn_readfirstlane((int)MISC[8 + 2]);
        if (ok) { vb = (int)(rk * 8u + bar.x); lsync = true; C.vcu = (vb % 8) * (C.G / 8) + vb / 8; }
    }
#define LSEAM(k) do { if (IN(k) && IN((k) + 1)) { if (lsync) xcd_local_barrier(bar); else xcd_barrier(bar); } } while (0)
    if (IN(1)) {
        const int G1 = (C.G == 256) ? 214 : C.G;
        if (vb < G1) {
            pg8::Gemm g{(const bf16*)(ws + WS_XN), (const bf16*)(ws + WS_WIN), D, nullptr, D, D}; pg8::DenseOrder So; So.init(T, INC, G1, vb);
            pg8::EpiProj E{(bf16*)(ws + WS_PROJ), (bf16*)(ws + WS_PROJ + 16 * MiB), args.in[7], args.in[8]};
            pg8::gemm_phase<pg8::EpiProj, pg8::DenseOrder, true, true>(glds, g, So, E);
            if (C.tid == 0) __hip_atomic_fetch_add((unsigned*)(ws + WS_CTL) + CW_P1DONE, 1u, __ATOMIC_RELAXED, __HIP_MEMORY_SCOPE_AGENT);
        } else conv_drain(C, args, true);
    } SEAM(1);
    if (IN(2)) {
 DUPX(2, {        for (int gq = C.vcu; gq < SG; gq += C.G) p_s5_pre(C, args, gq);
        conv_phase(C, args);
        attn_phase(C, args);
        conv_drain(C, args, false);
    }); } SEAM(2);
    if (IN(3)) {
 DUPX(3, {        pg8::Gemm g{(const bf16*)(ws + WS_MIXED), (const bf16*)(ws + WS_WOUT), D, nullptr, D, D}; pg8::DenseOrder So; So.init(T, D, C.G, vb);
        pg8::EpiRes E{args.in[0], (bf16*)(ws + WS_XA)};
        pg8::gemm_phase<pg8::EpiRes, pg8::DenseOrder, true, true>(glds, g, So, E);
    }); } LSEAM(3);
#define MOE_PHASES(layer, pb) do { \
        if (IN(pb)) { DUPX(pb, p_router(C, args, layer);); } SEAM(pb); \
        if (IN(pb + 1)) { DUPX(pb + 1, p_topk(C, args);); } LSEAM(pb + 1); \
        if (IN(pb + 2)) { DUPX(pb + 2, { \
            pg8::Gemm g{(const bf16*)(ws + (layer == 0 ? WS_XA : WS_XB)), (const bf16*)(ws + WS_WEXP + layer * WEXP_LAYER + WEXP_GU), D, (const int*)(ws + WS_IDX), D, D}; pg8::ExpertOrder So; So.init(8, C.G, vb); \
            pg8::EpiSwiGLU E{(bf16*)(ws + WS_H), (const float*)(ws + WS_RSROW)}; \
            pg8::gemm_phase<pg8::EpiSwiGLU, pg8::ExpertOrder, true, true, true>(glds, g, So, E); \
        }); } LSEAM(pb + 2); \
        if (IN(pb + 3)) { DUPX(pb + 3, { \
            pg8::Gemm g{(const bf16*)(ws + WS_H), (const bf16*)(ws + WS_WEXP + layer * WEXP_LAYER + WEXP_DN), EH, nullptr, EH, EH}; pg8::ExpertOrder So; So.init(4, C.G, vb); \
            pg8::EpiDown E{(bf16*)(ws + WS_PROJ), (const float*)(ws + WS_GATE)}; \
            pg8::gemm_phase<pg8::EpiDown, pg8::ExpertOrder, true, true>(glds, g, So, E); \
        }); } SEAM(pb + 3); \
        if (IN(pb + 4)) { DUPX(pb + 4, p_combine(C, args, layer == 0);); } \
    } while (0)
    MOE_PHASES(0, 4);
    SEAM(8);
    if (IN(9)) {
        int k9 = 256; asm volatile("" : "+s"(k9));
        pg8::Gemm g{(const bf16*)(ws + WS_UC), (const bf16*)(ws + WS_W16), k9, nullptr, 512, 256}; S5Order So; So.init(C.G, vb);
        EpiS5Scan E{(bf16*)(ws + WS_UC), args.in[11], args.in[12], args.in[13]};
        pg8::gemm_phase<EpiS5Scan, S5Order, false, true>(glds, g, So, E);
    }
    asm volatile("s_waitcnt vmcnt(0)" ::: "memory"); __syncthreads();
    if (IN(11)) {
        int k11 = 512; asm volatile("" : "+s"(k11));
        pg8::Gemm g{(const bf16*)(ws + WS_UC), (const bf16*)(ws + WS_TM), k11, nullptr, 512, 512}; S5Order So; So.init(C.G, vb);
        EpiS5Z E{(bf16*)(ws + WS_MIXED)};
        pg8::gemm_phase<EpiS5Z, S5Order, true, true>(glds, g, So, E);
#if MK_S5DUP == 11
        pg8::gemm_phase<EpiS5Z, S5Order, true, true>(glds, g, So, E);
#endif
    } SEAM(11);
    if (IN(12)) {
        pg8::Gemm g{(const bf16*)(ws + WS_MIXED), (const bf16*)(ws + WS_WGLU), D, nullptr, D, D}; pg8::DenseOrder So; So.init(T, 2 * D, C.G, vb);
        pg8::EpiGluRes E{(bf16*)(ws + WS_XB)};
        pg8::gemm_phase<pg8::EpiGluRes, pg8::DenseOrder, true, true>(glds, g, So, E);
    } LSEAM(12);
    MOE_PHASES(1, 13);
#undef IN
#undef SEAM
#undef LSEAM
}

#ifndef MK_PER_PHASE
#define MK_PER_PHASE 0
#endif
extern "C" void kernel_launch(void* const* d_in, const int* in_sizes, int n_in, void* d_out, int out_size, void* d_ws, size_t ws_size, hipStream_t stream) {
    static int grid = 0;
    if (grid == 0) {
        if (n_in != 26 || out_size != T * D || ws_size < WS_END) { fprintf(stderr, "kernel_launch: unexpected shapes (n_in %d out %d ws %zu)\n", n_in, out_size, ws_size); grid = -1; return; }
        int dev = 0, cus = 0, per_cu = 0;
        if (hipGetDevice(&dev) != hipSuccess || hipDeviceGetAttribute(&cus, hipDeviceAttributeMultiprocessorCount, dev) != hipSuccess) { grid = -1; return; }
        if (hipFuncSetAttribute((const void*)mk_fwd, hipFuncAttributeMaxDynamicSharedMemorySize, LDS_BYTES) != hipSuccess) { fprintf(stderr, "kernel_launch: hipFuncSetAttribute failed\n"); grid = -1; return; }
        if (hipOccupancyMaxActiveBlocksPerMultiprocessor(&per_cu, (const void*)mk_fwd, NTHR, LDS_BYTES) != hipSuccess || per_cu < 1) { fprintf(stderr, "kernel_launch: occupancy query says %d blocks per CU\n", per_cu); (void)hipGetLastError(); grid = -1; return; }
        grid = cus;
    }
    if (grid < 0) return;
    (void)hipMemsetAsync((char*)d_ws + WS_CTL, 0, CTL_ZERO_BYTES, stream);
    Args a{};
    for (int i = 0; i < 26; ++i) a.in[i] = (const float*)d_in[i];
    a.out = (float*)d_out; a.ws = (unsigned char*)d_ws;
#if MK_PER_PHASE
    for (int p = 0; p < NPHASE; ++p) { a.ph_lo = p; a.ph_hi = p + 1; hipLaunchKernelGGL(mk_fwd, dim3(grid), dim3(NTHR), LDS_BYTES, stream, a); }
#else
    a.ph_lo = 0; a.ph_hi = NPHASE;
    hipLaunchKernelGGL(mk_fwd, dim3(grid), dim3(NTHR), LDS_BYTES, stream, a);
#endif
}
```

```cpp
#include <hip/hip_runtime.h>
#include <cstdint>
#include <cstdio>

namespace pg8 {
#define PG8_LAS __attribute__((address_space(3)))
typedef unsigned short bf16_t;
typedef short bf16x8 __attribute__((ext_vector_type(8)));
typedef float f32x4 __attribute__((ext_vector_type(4)));
typedef unsigned u32x4 __attribute__((ext_vector_type(4)));
constexpr int BM = 256, BK = 64, HALF = 128, HTB = HALF * BK * 2  , STAGE_BYTES = 8 * HTB, NXCD = 8, WGM = 8;

__host__ __device__ __forceinline__ int lds_byte(int r, int c) { const int st = (r >> 4) * 2 + (c >> 5), rr = r & 15, cc = c & 31, ob = rr * 64 + cc * 2; return st * 1024 + (ob ^ (((ob >> 9) & 1) << 5)); }
__host__ __device__ __forceinline__ void stage_rc(int b, int& R, int& C) { const int st = b / 1024, sb = b % 1024, swz = sb ^ (((sb >> 9) & 1) << 5); R = (st >> 1) * 16 + swz / 64; C = (st & 1) * 32 + (swz % 64) / 2; }
__host__ __device__ __forceinline__ int perm32(int rho) { const int n = rho >> 4, i = rho & 15; return 8 * (i >> 2) + 4 * n + (i & 3); }

struct Unit { int pm, pn, pb; };
struct Gemm { const bf16_t* A; const bf16_t* Bt; int K; const int* gidx; int lda, ldb; };

struct DenseOrder {
    int nM, nN, nwg, G, c;
    __device__ void init(int M, int N, int G_, int c_) { nM = M / BM; nN = N / BM; nwg = nM * nN; G = G_; c = c_; }
    __device__ bool next(int i, Unit& u) const {
        const long L = (long)i * G + c; if (L >= nwg) return false;
        int wgid = (int)L; { const int q = nwg / NXCD, r = nwg % NXCD, xcd = wgid % NXCD, off = wgid / NXCD; wgid = (xcd < r ? xcd * (q + 1) : r * (q + 1) + (xcd - r) * q) + off; }
        const int nig = WGM * nN, gid = wgid / nig, fm = gid * WGM, gsz = (nM - fm) < WGM ? (nM - fm) : WGM;
        u.pm = fm + ((wgid % nig) % gsz); u.pn = (wgid % nig) / gsz; u.pb = u.pn; return true;
    }
    __device__ __forceinline__ void a_ready(const Unit&) const {}
    __device__ __forceinline__ void done(const Unit&) const {}
};
struct ExpertOrder {
    int nN, nun, G, c;
    __device__ void init(int nN_, int G_, int c_) { nN = nN_; nun = 128 * nN_; G = G_; c = c_; }
    __device__ bool next(int i, Unit& u) const {
        const long L = (long)i * G + c; if (L >= nun) return false;
        int V = (int)L;
        if (G == 256) {
            const int x = c & 7, j = c >> 3, upx = 32, rpe = (8 * nN) / upx;
            const int e_ = 8 * (i / rpe) + x, r_ = (i % rpe) * upx + j;
            V = e_ * 8 * nN + r_;
        }
        const int per = 8 * nN, e = V / per, r = V % per, pml = r / nN, pn = r % nN;
        u.pm = ((pml >> 1) * 16 + e) * 2 + (pml & 1); u.pn = pn; u.pb = e * nN + pn; return true;
    }
    __device__ __forceinline__ void a_ready(const Unit&) const {}
    __device__ __forceinline__ void done(const Unit&) const {}
};

typedef float f32x2 __attribute__((ext_vector_type(2)));
typedef __bf16 bf16x2_t __attribute__((ext_vector_type(2)));
__device__ __forceinline__ unsigned pk2(float lo, float hi) { f32x2 v = {lo, hi}; bf16x2_t b = __builtin_convertvector(v, bf16x2_t); return __builtin_bit_cast(unsigned, b); }
__device__ __forceinline__ unsigned pk4_fp8(float a, float b, float c, float d) {
    a = __builtin_amdgcn_fmed3f(a, -448.f, 448.f); b = __builtin_amdgcn_fmed3f(b, -448.f, 448.f); c = __builtin_amdgcn_fmed3f(c, -448.f, 448.f); d = __builtin_amdgcn_fmed3f(d, -448.f, 448.f);
    int p = 0; p = __builtin_amdgcn_cvt_pk_fp8_f32(a, b, p, false); p = __builtin_amdgcn_cvt_pk_fp8_f32(c, d, p, true); return (unsigned)p;
}
typedef unsigned u32x2 __attribute__((ext_vector_type(2)));
typedef int i32x8 __attribute__((ext_vector_type(8)));
typedef int i32x4 __attribute__((ext_vector_type(4)));
constexpr float FP8_SX = 8.f, FP8_SW = 256.f, FP8_INV = 1.f / (8.f * 256.f);
__device__ __forceinline__ float sigm(float x) { return __builtin_amdgcn_rcpf(1.f + __builtin_amdgcn_exp2f(-1.4426950408889634f * x)); }

constexpr float QSCALE = 0.125f * 1.4426950408889634f;
struct EpiProj {
    static constexpr bool PERM = true, AFTER_DRAIN = false;
    bf16_t *GLU, *Q; const float *qg, *kg;
    __device__ __forceinline__ void operator()(const f32x4 (&acc)[2][2][4][2], const Unit& u, int wr, int wc, int fr, int fq) const {
        const int row0 = u.pm * BM + wr * 64 + fr;
        if (u.pn < 4) {
            const int col0 = 128 * u.pn + 32 * wc + 8 * fq;
#pragma unroll
            for (int ai = 0; ai < 2; ++ai)
#pragma unroll
                for (int m = 0; m < 4; ++m) {
                    const f32x4 v0 = acc[ai][0][m][0], v1 = acc[ai][0][m][1], g0 = acc[ai][1][m][0], g1 = acc[ai][1][m][1];
                    u32x4 w; w.x = pk2(v0[0] * sigm(g0[0]), v0[1] * sigm(g0[1])); w.y = pk2(v0[2] * sigm(g0[2]), v0[3] * sigm(g0[3]));
                    w.z = pk2(v1[0] * sigm(g1[0]), v1[1] * sigm(g1[1])); w.w = pk2(v1[2] * sigm(g1[2]), v1[3] * sigm(g1[3]));
                    *(u32x4*)(GLU + (size_t)(row0 + ai * HALF + m * 16) * 512 + col0) = w;
                    asm volatile("" ::: "memory");
                }
        } else {
            const int t = (u.pn - 4) >> 1;
            const int hd = 4 * ((u.pn - 4) & 1) + wc;
            bf16_t* dst = Q + (size_t)t * (size_t)(8u << 20);
            const float* gp = (const float*)((uintptr_t)qg + (((uintptr_t)kg - (uintptr_t)qg) & (uintptr_t)(t == 0 ? 0 : ~(uintptr_t)0)));
#pragma unroll
            for (int ai = 0; ai < 2; ++ai)
#pragma unroll
                for (int m = 0; m < 4; ++m) {
                    float ss = 0.f;
#pragma unroll
                    for (int bj = 0; bj < 2; ++bj)
#pragma unroll
                        for (int n = 0; n < 2; ++n) { const f32x4 x = acc[ai][bj][m][n]; ss += (x[0] * x[0] + x[1] * x[1]) + (x[2] * x[2] + x[3] * x[3]); }
                    ss += __shfl_xor(ss, 16); ss += __shfl_xor(ss, 32);
                    float rs = 1.f;
                    if (t < 2) rs = rsqrtf(ss * (1.f / 64.f) + 1e-6f) * (t == 0 ? QSCALE : 1.f);
#pragma unroll
                    for (int bj = 0; bj < 2; ++bj) {
                        f32x4 g0 = {1.f, 1.f, 1.f, 1.f}, g1 = g0;
                        if (t < 2) { g0 = *(const f32x4*)(gp + 32 * bj + 8 * fq); g1 = *(const f32x4*)(gp + 32 * bj + 8 * fq + 4); }
                        const f32x4 a = acc[ai][bj][m][0] * g0 * rs, b = acc[ai][bj][m][1] * g1 * rs;
                        u32x4 w; w.x = pk2(a[0], a[1]); w.y = pk2(a[2], a[3]); w.z = pk2(b[0], b[1]); w.w = pk2(b[2], b[3]);
                        const int row = row0 + ai * HALF + m * 16;
                        *(u32x4*)(dst + ((size_t)((row >> 12) * 8 + hd) * 4096 + (row & 4095)) * 64 + 32 * bj + 8 * fq) = w;
                    }
                    asm volatile("" ::: "memory");
                }
        }
    }
};
struct EpiRes {
    static constexpr bool PERM = true, AFTER_DRAIN = false;
    const float* xin; bf16_t* X; unsigned char* XQ;
    __device__ __forceinline__ void operator()(const f32x4 (&acc)[2][2][4][2], const Unit& u, int wr, int wc, int fr, int fq) const {
        const int row0 = u.pm * BM + wr * 64 + fr, col0 = u.pn * BM + wc * 32 + 8 * fq;
#pragma unroll
        for (int ai = 0; ai < 2; ++ai)
#pragma unroll
            for (int m = 0; m < 4; ++m) { const size_t off = (size_t)(row0 + ai * HALF + m * 16) * 1024 + col0;
#pragma unroll
                for (int bj = 0; bj < 2; ++bj) { const f32x4 a = *(const f32x4*)(xin + off + bj * HALF) + acc[ai][bj][m][0], b = *(const f32x4*)(xin + off + bj * HALF + 4) + acc[ai][bj][m][1];
                    u32x4 w; w.x = pk2(a[0], a[1]); w.y = pk2(a[2], a[3]); w.z = pk2(b[0], b[1]); w.w = pk2(b[2], b[3]);
                    *(u32x4*)(X + off + bj * HALF) = w;
                    u32x2 q; q.x = pk4_fp8(a[0] * FP8_SX, a[1] * FP8_SX, a[2] * FP8_SX, a[3] * FP8_SX); q.y = pk4_fp8(b[0] * FP8_SX, b[1] * FP8_SX, b[2] * FP8_SX, b[3] * FP8_SX);
                    *(u32x2*)(XQ + off + bj * HALF) = q; } }
    }
};
struct EpiSwiGLU {
    static constexpr bool PERM = true, AFTER_DRAIN = false;
    unsigned char* H; const float* rsrow;
    __device__ __forceinline__ void operator()(const f32x4 (&acc)[2][2][4][2], const Unit& u, int wr, int wc, int fr, int fq) const {
        const int row0 = u.pm * BM + wr * 64 + fr, col0 = 128 * u.pn + 32 * wc + 8 * fq;
#pragma unroll
        for (int ai = 0; ai < 2; ++ai)
#pragma unroll
            for (int m = 0; m < 4; ++m) {
                const float rs = rsrow[row0 + ai * HALF + m * 16] * FP8_INV;
                const f32x4 g0 = acc[ai][0][m][0] * rs, g1 = acc[ai][0][m][1] * rs, u0 = acc[ai][1][m][0] * (rs * FP8_SX), u1 = acc[ai][1][m][1] * (rs * FP8_SX);
                u32x2 w; w.x = pk4_fp8(g0[0] * sigm(g0[0]) * u0[0], g0[1] * sigm(g0[1]) * u0[1], g0[2] * sigm(g0[2]) * u0[2], g0[3] * sigm(g0[3]) * u0[3]);
                w.y = pk4_fp8(g1[0] * sigm(g1[0]) * u1[0], g1[1] * sigm(g1[1]) * u1[1], g1[2] * sigm(g1[2]) * u1[2], g1[3] * sigm(g1[3]) * u1[3]);
                *(u32x2*)(H + (size_t)(row0 + ai * HALF + m * 16) * 1024 + col0) = w;
            }
    }
};
struct EpiDown {
    static constexpr bool PERM = true, AFTER_DRAIN = false;
    bf16_t* Y; const float* gate;
    __device__ __forceinline__ void operator()(const f32x4 (&acc)[2][2][4][2], const Unit& u, int wr, int wc, int fr, int fq) const {
        const int row0 = u.pm * BM + wr * 64 + fr, col0 = u.pn * BM + wc * 32 + 8 * fq;
#pragma unroll
        for (int ai = 0; ai < 2; ++ai)
#pragma unroll
            for (int m = 0; m < 4; ++m) { const int row = row0 + ai * HALF + m * 16; const float gs = gate[row] * FP8_INV;
#pragma unroll
                for (int bj = 0; bj < 2; ++bj) { const f32x4 a = acc[ai][bj][m][0] * gs, b = acc[ai][bj][m][1] * gs;
                    u32x4 w; w.x = pk2(a[0], a[1]); w.y = pk2(a[2], a[3]); w.z = pk2(b[0], b[1]); w.w = pk2(b[2], b[3]);
                    *(u32x4*)(Y + (size_t)row * 1024 + col0 + bj * HALF) = w; } }
    }
};
struct EpiGluRes {
    static constexpr bool PERM = true, AFTER_DRAIN = false;
    bf16_t* X; unsigned char* XQ;
    __device__ __forceinline__ void operator()(const f32x4 (&acc)[2][2][4][2], const Unit& u, int wr, int wc, int fr, int fq) const {
        const int row0 = u.pm * BM + wr * 64 + fr, col0 = 128 * u.pn + 32 * wc + 8 * fq;
#pragma unroll
        for (int ai = 0; ai < 2; ++ai)
#pragma unroll
            for (int m = 0; m < 4; ++m) { const size_t off = (size_t)(row0 + ai * HALF + m * 16) * 1024 + col0; bf16_t* p = X + off;
                const u32x4 o = *(const u32x4*)p; const f32x4 v0 = acc[ai][0][m][0], v1 = acc[ai][0][m][1], g0 = acc[ai][1][m][0], g1 = acc[ai][1][m][1];
                const float y0 = __uint_as_float(o.x << 16) + v0[0] * sigm(g0[0]), y1 = __uint_as_float(o.x & 0xffff0000u) + v0[1] * sigm(g0[1]);
                const float y2 = __uint_as_float(o.y << 16) + v0[2] * sigm(g0[2]), y3 = __uint_as_float(o.y & 0xffff0000u) + v0[3] * sigm(g0[3]);
                const float y4 = __uint_as_float(o.z << 16) + v1[0] * sigm(g1[0]), y5 = __uint_as_float(o.z & 0xffff0000u) + v1[1] * sigm(g1[1]);
                const float y6 = __uint_as_float(o.w << 16) + v1[2] * sigm(g1[2]), y7 = __uint_as_float(o.w & 0xffff0000u) + v1[3] * sigm(g1[3]);
                u32x4 w; w.x = pk2(y0, y1); w.y = pk2(y2, y3); w.z = pk2(y4, y5); w.w = pk2(y6, y7);
                *(u32x4*)p = w;
                u32x2 q; q.x = pk4_fp8(y0 * FP8_SX, y1 * FP8_SX, y2 * FP8_SX, y3 * FP8_SX); q.y = pk4_fp8(y4 * FP8_SX, y5 * FP8_SX, y6 * FP8_SX, y7 * FP8_SX);
                *(u32x2*)(XQ + off) = q; }
    }
};
template <class Epi, class Sched, bool ALIGN_EPI = false, bool SP2 = false, bool GATHER = false, bool FP8 = false>
__device__ __forceinline__ void gemm_phase(PG8_LAS unsigned char* lds, const Gemm g, const Sched& S, const Epi& E) {
    const int tid = threadIdx.x, wid = __builtin_amdgcn_readfirstlane(tid >> 6), lane = tid & 63, wr = wid >> 2, wc = wid & 3, fr = lane & 15, fq = lane >> 4;
    const int K = g.K, nt = K / BK;
    unsigned voffA[2], voffB[2];
#pragma unroll
    for (int i = 0; i < 2; ++i) { int R, C; stage_rc(tid * 16 + i * 8192, R, C); const int Rb = Epi::PERM ? ((R & ~31) + perm32(R & 31)) : R;
        voffA[i] = (unsigned)(R * g.lda + C) * 2u; voffB[i] = (unsigned)(Rb * g.ldb + C) * 2u; }
    const size_t kstep = (size_t)(BK * 2);
    const size_t hstepA = (size_t)HALF * g.lda * 2, hstepB = (size_t)HALF * g.ldb * 2;
    const size_t tstepA = 2 * hstepA, tstepB = 2 * hstepB;
    const unsigned ldsw = (unsigned)wid * 1024u;
    const int aoff = lds_byte(wr * 64 + fr, fq * 8), boff = lds_byte(wc * 32 + fr, fq * 8);
    int aof8[2] = {0, 0}, bof8[2] = {0, 0};
    if constexpr (FP8) {
#pragma unroll
        for (int c = 0; c < 2; ++c) { const int cb = 32 * fq + 16 * (c ^ (fq & 1)); aof8[c] = lds_byte(wr * 64 + fr, cb >> 1); bof8[c] = lds_byte(wc * 32 + fr, cb >> 1); } }
#define PG8_SA(b, h) (((b) * 2 + (h)) * HTB)
#define PG8_SB(b, h) ((4 + (b) * 2 + (h)) * HTB)
#define PG8_STAGE(bufoff, gbase, voff) do { _Pragma("unroll") for (int _i = 0; _i < 2; ++_i) \
        __builtin_amdgcn_global_load_lds((const unsigned*)((const char*)(gbase) + (voff)[_i]), (PG8_LAS unsigned*)(lds + (bufoff) + ldsw + _i * 8192), 16, 0, 0); } while (0)
#define PG8_STAGE_A(bufoff, gptr, h, nsel) do { if constexpr (GATHER) { const unsigned _o[2] = {(nsel) ? nOA[h][0] : oA[h][0], (nsel) ? nOA[h][1] : oA[h][1]}; PG8_STAGE(bufoff, gptr, _o); } \
        else { PG8_STAGE(bufoff, (gptr) + ((h) ? hstepA : 0), voffA); } } while (0)
#define PG8_GOFF(dst, u) do { if constexpr (GATHER) { _Pragma("unroll") for (int _h = 0; _h < 2; ++_h) _Pragma("unroll") for (int _i = 0; _i < 2; ++_i) { \
        (dst)[_h][_i] = (unsigned)g.gidx[(u).pm * BM + _h * HALF + gR[_i]] * (unsigned)(g.lda * 2) + gC[_i]; asm volatile("" : "+v"((dst)[_h][_i])); } } } while (0)
#define PG8_LDA(dst, b, h) do { _Pragma("unroll") for (int m = 0; m < 4; ++m) _Pragma("unroll") for (int k = 0; k < 2; ++k) dst[m][k] = *(const PG8_LAS bf16x8*)(lds + PG8_SA(b, h) + (FP8 ? aof8[k] : aoff + k * 1024) + m * 2048); } while (0)
#define PG8_LDB(dst, b, h) do { _Pragma("unroll") for (int n = 0; n < 2; ++n) _Pragma("unroll") for (int k = 0; k < 2; ++k) dst[n][k] = *(const PG8_LAS bf16x8*)(lds + PG8_SB(b, h) + (FP8 ? bof8[k] : boff + k * 1024) + n * 2048); } while (0)
#define PG8_CAT8(f) __builtin_shufflevector(__builtin_bit_cast(i32x4, (f)[0]), __builtin_bit_cast(i32x4, (f)[1]), 0, 1, 2, 3, 4, 5, 6, 7)
#define PG8_MMA(ai, bj, At, Bt) do { __builtin_amdgcn_s_setprio(1); _Pragma("unroll") for (int m = 0; m < 4; ++m) _Pragma("unroll") for (int n = 0; n < 2; ++n) { \
        if constexpr (FP8) { const i32x8 b8_ = PG8_CAT8(Bt[n]), a8_ = PG8_CAT8(At[m]); asm volatile("v_mfma_f32_16x16x128_f8f6f4 %0, %1, %2, %0" : "+v"(acc[ai][bj][m][n]) : "v"(b8_), "v"(a8_)); } \
        else { _Pragma("unroll") for (int k = 0; k < 2; ++k) acc[ai][bj][m][n] = __builtin_amdgcn_mfma_f32_16x16x32_bf16(Bt[n][k], At[m][k], acc[ai][bj][m][n], 0, 0, 0); } } \
        __builtin_amdgcn_s_setprio(0); } while (0)
#define PG8_WAIT_V(n) asm volatile("s_waitcnt vmcnt(" #n ")" ::: "memory")
#define PG8_WAIT_L(n) asm volatile("s_waitcnt lgkmcnt(" #n ")" ::: "memory")
#define PG8_BAR __builtin_amdgcn_s_barrier()
#define PG8_SCHED __builtin_amdgcn_sched_barrier(0)
    Unit cur, nxt; int ui = 0;
    if (!S.next(0, cur)) return;
    unsigned oA[2][2], nOA[2][2]; int gR[2]; unsigned gC[2];
    if constexpr (GATHER) { static_assert(SP2, "GATHER is wired into the SP2 loop only");
#pragma unroll
        for (int i = 0; i < 2; ++i) { int R, Cc; stage_rc(tid * 16 + i * 8192, R, Cc); gR[i] = R; gC[i] = (unsigned)Cc * 2u; } }
    PG8_GOFF(oA, cur);
    f32x4 acc[2][2][4][2];
#pragma unroll
    for (int a = 0; a < 2; ++a)
#pragma unroll
        for (int b = 0; b < 2; ++b)
#pragma unroll
            for (int m = 0; m < 4; ++m)
#pragma unroll
                for (int n = 0; n < 2; ++n) acc[a][b][m][n] = (f32x4){0.f, 0.f, 0.f, 0.f};
    bf16x8 At[4][2], B0[2][2], B1[2][2];
    const char* cA = (const char*)g.A + (GATHER ? (size_t)0 : (size_t)cur.pm * tstepA); const char* cB = (const char*)g.Bt + (size_t)cur.pb * tstepB;
    S.a_ready(cur);
    if constexpr (SP2) {
        PG8_STAGE(PG8_SB(0, 0), cB, voffB); PG8_STAGE(PG8_SB(0, 1), cB + hstepB, voffB); PG8_STAGE_A(PG8_SA(0, 0), cA, 0, false); PG8_STAGE_A(PG8_SA(0, 1), cA, 1, false);
        if (wr == 1) PG8_BAR;
        PG8_WAIT_V(2); PG8_BAR;
        PG8_STAGE(PG8_SB(1, 0), cB + kstep, voffB); PG8_STAGE_A(PG8_SA(1, 0), cA + kstep, 0, false); PG8_STAGE(PG8_SB(1, 1), cB + hstepB + kstep, voffB);
        PG8_WAIT_V(6); PG8_BAR;
    } else {
        PG8_STAGE(PG8_SB(0, 0), cB, voffB); PG8_STAGE(PG8_SA(0, 0), cA, voffA); PG8_STAGE(PG8_SB(0, 1), cB + hstepB, voffB); PG8_STAGE(PG8_SA(0, 1), cA + hstepA, voffA);
        if (wr == 1) PG8_BAR;
        PG8_WAIT_V(4); PG8_BAR;
        PG8_STAGE(PG8_SB(1, 0), cB + kstep, voffB); PG8_STAGE(PG8_SA(1, 0), cA + kstep, voffA); PG8_STAGE(PG8_SB(1, 1), cB + hstepB + kstep, voffB);
        PG8_WAIT_V(6); PG8_BAR;
    }
    for (;;) {
        const bool has_next = S.next(ui + 1, nxt);
        const char* nA = has_next ? (const char*)g.A + (GATHER ? (size_t)0 : (size_t)nxt.pm * tstepA) : cA; const char* nB = has_next ? (const char*)g.Bt + (size_t)nxt.pb * tstepB : cB;
        if constexpr (GATHER) { if (has_next) { PG8_GOFF(nOA, nxt); } else {
#pragma unroll
            for (int _h = 0; _h < 2; ++_h) { nOA[_h][0] = oA[_h][0]; nOA[_h][1] = oA[_h][1]; } } }
        for (int t = 0; t < nt; t += 2) {
            const bool last = (t == nt - 2);
            const char* a1 = cA + (size_t)(t + 1) * kstep;
            const char* a2 = last ? nA : cA + (size_t)(t + 2) * kstep; const char* b2 = last ? nB : cB + (size_t)(t + 2) * kstep;
            const char* a3 = a2 + kstep; const char* b3 = b2 + kstep;
            if (last && has_next) S.a_ready(nxt);
            if constexpr (SP2) {
            PG8_LDB(B0, 0, 0); PG8_LDB(B1, 0, 1); PG8_SCHED; PG8_LDA(At, 0, 0); PG8_STAGE_A(PG8_SA(1, 1), a1, 1, false);
            PG8_WAIT_V(8); PG8_WAIT_L(0); PG8_BAR; PG8_MMA(0, 0, At, B0); PG8_MMA(0, 1, At, B1); PG8_BAR; PG8_SCHED;
            PG8_LDA(At, 0, 1); PG8_STAGE(PG8_SB(0, 0), b2, voffB); PG8_STAGE(PG8_SB(0, 1), b2 + hstepB, voffB); PG8_STAGE_A(PG8_SA(0, 0), a2, 0, last);
            PG8_WAIT_V(8); PG8_WAIT_L(0); PG8_BAR; PG8_MMA(1, 0, At, B0); PG8_MMA(1, 1, At, B1); PG8_BAR; PG8_SCHED;
            PG8_LDB(B0, 1, 0); PG8_LDB(B1, 1, 1); PG8_SCHED; PG8_LDA(At, 1, 0); PG8_STAGE_A(PG8_SA(0, 1), a2, 1, last);
            PG8_WAIT_V(8); PG8_WAIT_L(0); PG8_BAR; PG8_MMA(0, 0, At, B0); PG8_MMA(0, 1, At, B1); PG8_BAR; PG8_SCHED;
            PG8_LDA(At, 1, 1); PG8_STAGE(PG8_SB(1, 0), b3, voffB); PG8_STAGE(PG8_SB(1, 1), b3 + hstepB, voffB); PG8_STAGE_A(PG8_SA(1, 0), a3, 0, last);
            PG8_WAIT_V(8); PG8_WAIT_L(0); PG8_BAR; PG8_MMA(1, 0, At, B0); PG8_MMA(1, 1, At, B1); PG8_BAR; PG8_SCHED;
            } else {
            PG8_LDB(B0, 0, 0); PG8_SCHED; PG8_LDA(At, 0, 0); PG8_STAGE(PG8_SA(1, 1), a1 + hstepA, voffA);
            PG8_WAIT_L(8); PG8_BAR; PG8_WAIT_L(0); PG8_MMA(0, 0, At, B0); PG8_BAR; PG8_SCHED;
            PG8_LDB(B1, 0, 1); PG8_STAGE(PG8_SB(0, 0), b2, voffB);
            PG8_BAR; PG8_WAIT_L(0); PG8_MMA(0, 1, At, B1); PG8_BAR;
            PG8_LDA(At, 0, 1); PG8_STAGE(PG8_SA(0, 0), a2, voffA);
            PG8_BAR; PG8_WAIT_L(0); PG8_MMA(1, 0, At, B0); PG8_BAR; PG8_SCHED;
            PG8_STAGE(PG8_SB(0, 1), b2 + hstepB, voffB);
            PG8_WAIT_V(6); PG8_BAR; PG8_MMA(1, 1, At, B1); PG8_BAR;
            PG8_LDB(B0, 1, 0); PG8_SCHED; PG8_LDA(At, 1, 0); PG8_STAGE(PG8_SA(0, 1), a2 + hstepA, voffA);
            PG8_WAIT_L(8); PG8_BAR; PG8_WAIT_L(0); PG8_MMA(0, 0, At, B0); PG8_BAR; PG8_SCHED;
            PG8_LDB(B1, 1, 1); PG8_STAGE(PG8_SB(1, 0), b3, voffB);
            PG8_BAR; PG8_WAIT_L(0); PG8_MMA(0, 1, At, B1); PG8_BAR;
            PG8_LDA(At, 1, 1); PG8_STAGE(PG8_SA(1, 0), a3, voffA);
            PG8_BAR; PG8_WAIT_L(0); PG8_MMA(1, 0, At, B0); PG8_BAR; PG8_SCHED;
            PG8_STAGE(PG8_SB(1, 1), b3 + hstepB, voffB);
            PG8_WAIT_V(6); PG8_BAR; PG8_MMA(1, 1, At, B1); PG8_BAR;
            }
        }
        if constexpr (FP8) asm volatile("s_nop 15\n\ts_nop 7" ::: "memory");
        if constexpr (ALIGN_EPI) { if (wr == 0) PG8_BAR; }
        if constexpr (!Epi::AFTER_DRAIN) { E(acc, cur, wr, wc, fr, fq); S.done(cur); }
        if (!has_next) break;
#pragma unroll
        for (int a = 0; a < 2; ++a)
#pragma unroll
            for (int b = 0; b < 2; ++b)
#pragma unroll
                for (int m = 0; m < 4; ++m)
#pragma unroll
                    for (int n = 0; n < 2; ++n) acc[a][b][m][n] = (f32x4){0.f, 0.f, 0.f, 0.f};
        cur = nxt; cA = nA; cB = nB; ++ui;
        if constexpr (GATHER) {
#pragma unroll
            for (int _h = 0; _h < 2; ++_h) { oA[_h][0] = nOA[_h][0]; oA[_h][1] = nOA[_h][1]; } }
        if constexpr (ALIGN_EPI) { if (wr == 1) PG8_BAR; }
    }
    PG8_WAIT_V(0);
    if constexpr (!ALIGN_EPI) { if (wr == 0) PG8_BAR; }
    PG8_BAR;
    if constexpr (Epi::AFTER_DRAIN) { E.fused(acc, cur, wr, wc, fr, fq, lds, wid, lane); S.done(cur); }
#undef PG8_SA
#undef PG8_SB
#undef PG8_STAGE
#undef PG8_LDA
#undef PG8_STAGE_A
#undef PG8_GOFF
#undef PG8_LDB
#undef PG8_MMA
#undef PG8_CAT8
#undef PG8_WAIT_V
#undef PG8_WAIT_L
#undef PG8_BAR
#undef PG8_SCHED
}
}

constexpr int NB = 4, S = 4096, D = 1024, T = NB * S;
constexpr int CONV_CH = 512, CONV_W = 31, NH = 8, INC = 2560;
constexpr int SG = 64, SC = 16, SP = 64;
constexpr int NE = 16, CAP = 512, EH = 1024, MR = NB * NE * CAP;
constexpr float EPS = 1e-6f;
constexpr int NWAVES = 8, NTHR = NWAVES * 64;

constexpr size_t MiB = 1u << 20;
constexpr size_t WS_CTL = 0, CTL_ZERO_BYTES = 64 * 1024;
constexpr size_t WS_AFF = 1 * MiB, WS_IDX = 2 * MiB, WS_GATE = 2 * MiB + 512 * 1024, WS_SLOT = 3 * MiB;
constexpr size_t WS_RS = 2 * MiB + 256 * 1024, WS_RSROW = 2 * MiB + 768 * 1024;
constexpr size_t WS_WIN = 4 * MiB, WS_WOUT = 10 * MiB, WS_WGLU = 12 * MiB;
constexpr size_t WS_WEXP = 16 * MiB, WEXP_LAYER = 96 * MiB, WEXP_GU = 0, WEXP_DN = 64 * MiB;
constexpr size_t WS_XQ = WS_WEXP + 32 * MiB;
constexpr size_t WS_XN = 208 * MiB, WS_MIXED = 240 * MiB;
constexpr size_t WS_PROJ = 272 * MiB;
constexpr size_t WS_H = 336 * MiB;
constexpr size_t WS_XA = 404 * MiB, WS_XB = 436 * MiB;
constexpr size_t WS_END = 492 * MiB;
constexpr int CW_BAR = 1024, CW_Q0 = 64;

constexpr int SCRATCH_BYTES = 143360;
constexpr int LDSCTL_OFF = SCRATCH_BYTES;
constexpr int LDS_BYTES = 147456;

#define GAS __attribute__((address_space(1)))
#define LAS __attribute__((address_space(3)))
typedef unsigned short bf16;
typedef unsigned v4u __attribute__((ext_vector_type(4)));
typedef unsigned v2u __attribute__((ext_vector_type(2)));
typedef float f32x4 __attribute__((ext_vector_type(4)));
typedef float f32x2 __attribute__((ext_vector_type(2)));
using pg8::pk2;
using pg8::sigm;
__device__ __forceinline__ float bf2f(unsigned short h) { return __uint_as_float(((unsigned)h) << 16); }
__device__ __forceinline__ float bflo(unsigned w) { return __uint_as_float(w << 16); }
__device__ __forceinline__ float bfhi(unsigned w) { return __uint_as_float(w & 0xffff0000u); }
__device__ __forceinline__ float wave_sum(float v) {
#pragma unroll
    for (int o = 1; o < 64; o <<= 1) v += __shfl_xor(v, o);
    return v;
}

#define XB_TMO      128
#define XB_XCNT(j)  (256  + 64 * (j))
#define XB_XSUB(j)  (1280 + 64 * (j))
#define XB_XGEN(j)  (2304 + 64 * (j))
#define XB_TOP      3328
#define XB_TOPGEN   3392
#define XCD_BAR_WORDS 3456
#define XB_SPIN_CAP (1u << 18)
__device__ __forceinline__ unsigned xb_ld(unsigned* p)              { return __hip_atomic_load(p, __ATOMIC_RELAXED, __HIP_MEMORY_SCOPE_AGENT); }
__device__ __forceinline__ unsigned xb_add(unsigned* p, unsigned v) { return __hip_atomic_fetch_add(p, v, __ATOMIC_RELAXED, __HIP_MEMORY_SCOPE_AGENT); }
__device__ __forceinline__ unsigned xb_xcc_id() { return (unsigned)__builtin_amdgcn_s_getreg((3 << 11) | 20) & 0xFu; }
#define XB_SPIN(cond, bar) do { unsigned _sp = 0; while (cond) { __builtin_amdgcn_s_sleep(1); \
    if ((++_sp & 255u) == 0u) { if (xb_ld(&(bar)[XB_TMO])) break; if (_sp > XB_SPIN_CAP) { atomicAdd(&(bar)[XB_TMO], 1u); break; } } } } while (0)
#define XB_LSUB(j)  (3456 + 64 * (j))
#define XB_LGEN(j)  (4480 + 64 * (j))
struct XcdBarrier { unsigned* bar; unsigned x; volatile LAS unsigned* st; unsigned rank; };
__device__ __forceinline__ XcdBarrier xcd_barrier_post(unsigned* bar, volatile LAS unsigned* st) {
    XcdBarrier b; b.bar = bar; b.x = xb_xcc_id(); b.st = st; b.rank = 0u;
    if (threadIdx.x == 0) b.rank = xb_add(&bar[XB_XCNT(b.x)], 1u);
    return b;
}
__device__ __forceinline__ void xcd_barrier_complete(unsigned* bar, unsigned x, unsigned& nloc, unsigned& nx) {
    const unsigned G = gridDim.x * gridDim.y * gridDim.z;
    unsigned sum, cnt, mine, sp = 0u;
    for (;;) {
        sum = 0u; cnt = 0u; mine = 0u;
#pragma unroll
        for (unsigned j = 0; j < 16; ++j) { const unsigned c = xb_ld(&bar[XB_XCNT(j)]); sum += c; cnt += (c > 0u) ? 1u : 0u; mine = (j == x) ? c : mine; }
        if (sum == G) break;
        __builtin_amdgcn_s_sleep(1);
        if ((++sp & 255u) == 0u) { if (xb_ld(&bar[XB_TMO])) break; if (sp > XB_SPIN_CAP) { atomicAdd(&bar[XB_TMO], 1u); break; } }
    }
    nloc = mine > 0u ? mine : 1u; nx = cnt > 0u ? cnt : 1u;
}
__device__ __forceinline__ void xcd_barrier(const XcdBarrier& b) {
    asm volatile("s_waitcnt vmcnt(0)" ::: "memory");
    __syncthreads();
    if (threadIdx.x == 0) {
        unsigned* bar = b.bar;
        __builtin_amdgcn_s_waitcnt(0);
        unsigned nloc = b.st[0], nx = b.st[1];
        if (nloc == 0u) { xcd_barrier_complete(bar, b.x, nloc, nx); b.st[0] = nloc; b.st[1] = nx; }
        const unsigned old = xb_add(&bar[XB_XSUB(b.x)], 1u);
        const unsigned gen = old / nloc;
        if (old + 1u == (gen + 1u) * nloc) {
            __builtin_amdgcn_fence(__ATOMIC_RELEASE, "agent");
            asm volatile("s_waitcnt vmcnt(0)" ::: "memory");
            const unsigned og = xb_add(&bar[XB_TOP], 1u);
            const unsigned tg = og / nx;
            if (og + 1u == (tg + 1u) * nx) xb_add(&bar[XB_TOPGEN], 1u);
            else XB_SPIN(xb_ld(&bar[XB_TOPGEN]) == tg, bar);
            __builtin_amdgcn_fence(__ATOMIC_ACQUIRE, "agent");
            xb_add(&bar[XB_XGEN(b.x)], 1u);
            asm volatile("s_waitcnt vmcnt(0)" ::: "memory");
        } else {
            XB_SPIN(xb_ld(&bar[XB_XGEN(b.x)]) == gen, bar);
            __builtin_amdgcn_fence(__ATOMIC_ACQUIRE, "agent");
            asm volatile("s_waitcnt vmcnt(0)" ::: "memory");
        }
    }
    __syncthreads();
}

__device__ __forceinline__ void xcd_local_barrier(const XcdBarrier& b) {
    asm volatile("s_waitcnt vmcnt(0)" ::: "memory");
    __syncthreads();
    if (threadIdx.x == 0) {
        unsigned* bar = b.bar;
        const unsigned nloc = b.st[0];
        const unsigned old = xb_add(&bar[XB_LSUB(b.x)], 1u);
        const unsigned gen = old / nloc;
        if (old + 1u == (gen + 1u) * nloc) xb_add(&bar[XB_LGEN(b.x)], 1u);
        else XB_SPIN(xb_ld(&bar[XB_LGEN(b.x)]) == gen, bar);
        __builtin_amdgcn_fence(__ATOMIC_ACQUIRE, "agent");
        asm volatile("s_waitcnt vmcnt(0)" ::: "memory");
    }
    __syncthreads();
}

struct Args {
    const float* in[26]; float* out; unsigned char* ws; int ph_lo, ph_hi;
};
struct Ctx { LAS unsigned char* lds; int tid, lane, wave, vcu, G; };

__device__ __forceinline__ int rowmap(int kind, int half, int n) {
    if (kind == 0) {
        if (n < 1024) { const int hf = n >> 9, r = n & 511; return 256 * (r >> 7) + 128 * hf + (r & 127); }
        const int pn = n >> 8, w = n & 255, wc = w >> 6, bj = (w >> 5) & 1, j = w & 31; return 256 * pn + 128 * bj + 32 * wc + j;
    }
    if (kind == 2) { const int hf = n >> 10, r = n & 1023; return 256 * (r >> 7) + 128 * hf + (r & 127); }
    if (kind == 3) return 256 * (n >> 7) + 128 * half + (n & 127);
    return n;
}
struct ConvDesc { const float* src; bf16* dst; const float* gsc; int N, kind, half, k0, n0, fp8; };
__device__ __forceinline__ bool conv_desc(const Args& a, int it, ConvDesc& d) {
    constexpr int I_IN = 16 * 40, I_OUT = 256, I_GLU = 16 * 32, I_EXP = 2 * 16 * 3 * 256;
    if (it >= I_IN + I_OUT + I_GLU + I_EXP) return false;
    unsigned char* ws = a.ws; int r = it, kb, nb; d.gsc = nullptr; d.fp8 = 0;
    if (r < I_IN) { d.src = a.in[2]; d.N = INC; d.dst = (bf16*)(ws + WS_WIN); d.kind = 0; d.half = 0; kb = r / 40; nb = r % 40; }
    else if ((r -= I_IN) < I_OUT) { d.src = a.in[9]; d.N = D; d.dst = (bf16*)(ws + WS_WOUT); d.kind = 1; d.half = 0; kb = r >> 4; nb = r & 15; }
    else if ((r -= I_OUT) < I_GLU) { d.src = a.in[19]; d.N = 2 * D; d.dst = (bf16*)(ws + WS_WGLU); d.kind = 2; d.half = 0; kb = r >> 5; nb = r & 31; }
    else { r -= I_GLU; const int mat = r >> 8, tile = r & 255, layer = mat / 48, rem = mat % 48, e = rem / 3, which = rem % 3;
        d.src = a.in[23 + which] + ((size_t)layer * NE + e) * (size_t)D * EH; d.N = EH;
        d.dst = (bf16*)(ws + WS_WEXP + layer * WEXP_LAYER + (which == 2 ? WEXP_DN + (size_t)e * MiB : WEXP_GU + (size_t)e * 2 * MiB)); d.fp8 = 1;
        d.kind = which == 2 ? 1 : 3; d.half = which; kb = tile >> 4; nb = tile & 15; if (which != 2) d.gsc = a.in[20] + (size_t)layer * D; }
    d.k0 = 64 * kb; d.n0 = 64 * nb; return true;
}
__device__ __forceinline__ void conv_load(const ConvDesc& d, f32x4 (&v)[16], int lane) {
    const float* p = d.src + (size_t)(d.k0 + (lane >> 4)) * d.N + d.n0 + 4 * (lane & 15);
#pragma unroll
    for (int it = 0; it < 16; ++it) v[it] = *(const f32x4*)(p + (size_t)(4 * it) * d.N);
}
__device__ __forceinline__ void conv_store(const ConvDesc& d, const f32x4 (&v)[16], LAS float* scr, int lane) {
#pragma unroll
    for (int it = 0; it < 16; ++it) { const int kk = 4 * it + (lane >> 4), nn = 4 * (lane & 15); const float gs = (d.gsc ? d.gsc[d.k0 + kk] : 1.f) * (d.fp8 ? pg8::FP8_SW : 1.f);
        scr[kk * 65 + nn] = v[it][0] * gs; scr[kk * 65 + nn + 1] = v[it][1] * gs; scr[kk * 65 + nn + 2] = v[it][2] * gs; scr[kk * 65 + nn + 3] = v[it][3] * gs; }
    asm volatile("s_waitcnt lgkmcnt(0)" ::: "memory");
    const int kc = lane & 7;
#pragma unroll
    for (int jt = 0; jt < 8; ++jt) {
        const int nl = 8 * jt + (lane >> 3);
        const LAS float* s = scr + (8 * kc) * 65 + nl;
        if (d.fp8) { v2u o; o.x = pg8::pk4_fp8(s[0], s[65], s[2 * 65], s[3 * 65]); o.y = pg8::pk4_fp8(s[4 * 65], s[5 * 65], s[6 * 65], s[7 * 65]);
            *(v2u*)((unsigned char*)d.dst + (size_t)rowmap(d.kind, d.half, d.n0 + nl) * 1024 + d.k0 + 8 * kc) = o; }
        else { v4u o; o.x = pk2(s[0], s[65]); o.y = pk2(s[2 * 65], s[3 * 65]); o.z = pk2(s[4 * 65], s[5 * 65]); o.w = pk2(s[6 * 65], s[7 * 65]);
            *(v4u*)(d.dst + (size_t)rowmap(d.kind, d.half, d.n0 + nl) * 1024 + d.k0 + 8 * kc) = o; }
    }
    asm volatile("s_waitcnt lgkmcnt(0)" ::: "memory");
}
__device__ __forceinline__ void rms_row_bf16(const float* __restrict__ xrow, const float* __restrict__ g, bf16* __restrict__ orow, int lane) {
    const f32x4* xr = (const f32x4*)xrow + lane;
    f32x4 v[4]; float s = 0.f;
#pragma unroll
    for (int j = 0; j < 4; ++j) { v[j] = xr[64 * j]; s += (v[j][0] * v[j][0] + v[j][1] * v[j][1]) + (v[j][2] * v[j][2] + v[j][3] * v[j][3]); }
    const float r = rsqrtf(wave_sum(s) * (1.f / D) + EPS);
#pragma unroll
    for (int j = 0; j < 4; ++j) { const f32x4 w = ((const f32x4*)g)[lane + 64 * j]; v2u o; o.x = pk2(v[j][0] * r * w[0], v[j][1] * r * w[1]); o.y = pk2(v[j][2] * r * w[2], v[j][3] * r * w[3]); ((v2u*)orow)[lane + 64 * j] = o; }
}
constexpr int CONV_NITEMS = 25984, CONV_FIRST_Q = 640, CW_P1DONE = 128;
__device__ __forceinline__ void conv_drain(const Ctx& C, const Args& a, bool until_flag) {
    LAS float* scr = (LAS float*)(C.lds + C.wave * 16640);
    unsigned* ctl = (unsigned*)(a.ws + WS_CTL);
    LAS int* qs = (LAS int*)(C.lds + 8 * 16640);
    ConvDesc dA; f32x4 vA[16];
    for (;;) {
        if (C.tid == 0) {
            int v = -1;
            if (!(until_flag && __hip_atomic_load(ctl + CW_P1DONE, __ATOMIC_RELAXED, __HIP_MEMORY_SCOPE_AGENT) != 0u))
                v = CONV_FIRST_Q + (int)__hip_atomic_fetch_add(ctl + CW_Q0, 8u, __ATOMIC_RELAXED, __HIP_MEMORY_SCOPE_AGENT);
            qs[0] = v;
        }
        __syncthreads();
        const int base = qs[0];
        __syncthreads();
        if (base < 0 || base >= CONV_NITEMS) break;
        if (conv_desc(a, base + C.wave, dA)) { conv_load(dA, vA, C.lane); conv_store(dA, vA, scr, C.lane); }
    }
}
__device__ __forceinline__ void p0_prologue(const Ctx& C, const Args& a) {
    LAS float* scr = (LAS float*)(C.lds + C.wave * 16640);
    const int gw = C.vcu * NWAVES + C.wave, NGW = C.G * NWAVES;
    unsigned char* ws = a.ws;
    {
        const float* x = a.in[0]; const float* gg = a.in[1]; bf16* XN = (bf16*)(ws + WS_XN); const int lane = C.lane;
        auto LOADR = [&](f32x4 (&v)[4], int m) __attribute__((always_inline)) { const f32x4* xr = (const f32x4*)(x + (size_t)m * D) + lane;
#pragma unroll
            for (int j = 0; j < 4; ++j) v[j] = xr[64 * j]; };
        auto PROC = [&](const f32x4 (&v)[4], int m) __attribute__((always_inline)) { float s = 0.f;
#pragma unroll
            for (int j = 0; j < 4; ++j) s += (v[j][0] * v[j][0] + v[j][1] * v[j][1]) + (v[j][2] * v[j][2] + v[j][3] * v[j][3]);
            const float r = rsqrtf(wave_sum(s) * (1.f / D) + EPS);
#pragma unroll
            for (int j = 0; j < 4; ++j) { const f32x4 w = ((const f32x4*)gg)[lane + 64 * j]; v2u o; o.x = pk2(v[j][0] * r * w[0], v[j][1] * r * w[1]); o.y = pk2(v[j][2] * r * w[2], v[j][3] * r * w[3]); ((v2u*)(XN + (size_t)m * D))[lane + 64 * j] = o; } };
        f32x4 va[4], vb[4]; int m = gw;
        if (m < T) LOADR(va, m);
        for (; m < T; m += 2 * NGW) { if (m + NGW < T) LOADR(vb, m + NGW); PROC(va, m); if (m + 2 * NGW < T) LOADR(va, m + 2 * NGW); if (m + NGW < T) PROC(vb, m + NGW); }
    }
    ConvDesc dA; f32x4 vA[16];
    for (int it = gw; it < CONV_FIRST_Q; it += NGW) if (conv_desc(a, it, dA)) { conv_load(dA, vA, C.lane); conv_store(dA, vA, scr, C.lane); }
}

__device__ __forceinline__ void conv_phase(const Ctx& C, const Args& a) {
    const bf16* GLU = (const bf16*)(a.ws + WS_PROJ);
    bf16* MIXED = (bf16*)(a.ws + WS_MIXED);
    const float* cw = a.in[3]; const float* cb = a.in[4]; const float* lg = a.in[5]; const float* lb = a.in[6];
    LAS float* tl = (LAS float*)C.lds;
    const int cp = C.tid & 255, th = C.tid >> 8, lane = C.lane, wave = C.wave;
    f32x2 w[CONV_W];
#pragma unroll
    for (int j = 0; j < CONV_W; ++j) w[j] = *(const f32x2*)(cw + j * CONV_CH + 2 * cp);
    const f32x2 bias = *(const f32x2*)(cb + 2 * cp);
    auto LOADT = [&](unsigned (&xin)[46], int tile) __attribute__((always_inline)) {
        const int b = tile / (S / 32), s0 = (tile % (S / 32)) * 32;
#pragma unroll
        for (int i = 0; i < 46; ++i) { const int ss = s0 + 16 * th - 15 + i; xin[i] = (ss >= 0 && ss < S) ? *(const unsigned*)(GLU + (size_t)(b * S + ss) * 512 + 2 * cp) : 0u; } };
    auto PROC = [&](const unsigned (&xin)[46], unsigned (&xn)[46], int tile, int nt) __attribute__((always_inline)) {
        const int b = tile / (S / 32), s0 = (tile % (S / 32)) * 32;
        f32x2 acc[16];
#pragma unroll
        for (int k = 0; k < 16; ++k) acc[k] = bias;
#pragma unroll
        for (int i = 0; i < 46; ++i) {
            unsigned xi = xin[i]; asm volatile("" : "+v"(xi));
            const f32x2 x = {bflo(xi), bfhi(xi)};
#pragma unroll
            for (int k = 0; k < 16; ++k) { const int j = i - k; if (j >= 0 && j < CONV_W) acc[k] += w[j] * x; }
        }
        if (nt < T / 32) LOADT(xn, nt);
#pragma unroll
        for (int k = 0; k < 16; ++k) *(LAS f32x2*)(tl + (16 * th + k) * 512 + 2 * cp) = acc[k];
        __syncthreads();
#pragma unroll
        for (int q = 0; q < 4; ++q) {
            const int tok = 4 * wave + q;
            const f32x4 v0 = *(const LAS f32x4*)(tl + tok * 512 + 8 * lane), v1 = *(const LAS f32x4*)(tl + tok * 512 + 8 * lane + 4);
            const float mu = wave_sum((v0[0] + v0[1]) + (v0[2] + v0[3]) + (v1[0] + v1[1]) + (v1[2] + v1[3])) * (1.f / CONV_CH);
            const f32x4 d0 = v0 - mu, d1 = v1 - mu;
            const float var = wave_sum((d0[0] * d0[0] + d0[1] * d0[1]) + (d0[2] * d0[2] + d0[3] * d0[3]) + (d1[0] * d1[0] + d1[1] * d1[1]) + (d1[2] * d1[2] + d1[3] * d1[3])) * (1.f / CONV_CH);
            const float rs = rsqrtf(var + EPS);
            const f32x4 g0 = *(const f32x4*)(lg + 8 * lane), g1 = *(const f32x4*)(lg + 8 * lane + 4), b0 = *(const f32x4*)(lb + 8 * lane), b1 = *(const f32x4*)(lb + 8 * lane + 4);
            f32x4 y0 = d0 * rs * g0 + b0, y1 = d1 * rs * g1 + b1;
#pragma unroll
            for (int e = 0; e < 4; ++e) { y0[e] = y0[e] * sigm(y0[e]); y1[e] = y1[e] * sigm(y1[e]); }
            v4u o; o.x = pk2(y0[0], y0[1]); o.y = pk2(y0[2], y0[3]); o.z = pk2(y1[0], y1[1]); o.w = pk2(y1[2], y1[3]);
            *(v4u*)(MIXED + (size_t)(b * S + s0 + tok) * D + 8 * lane) = o;
        }
        __syncthreads();
    };
    unsigned xa[46];
    int t = C.vcu;
    if (t < T / 32) LOADT(xa, t);
#pragma unroll 1
    for (; t < T / 32; t += C.G) PROC(xa, xa, t, t + C.G);
}
typedef short bf16x8 __attribute__((ext_vector_type(8)));
typedef short s16x4 __attribute__((ext_vector_type(4)));
typedef short v4i16_t __attribute__((ext_vector_type(4)));
typedef float f32x16 __attribute__((ext_vector_type(16)));
constexpr int AT_O = 0, AT_L = 65536, AT_V = 66560;
__device__ __forceinline__ s16x4 vtr(const LAS char* p) { return __builtin_bit_cast(s16x4, __builtin_amdgcn_ds_read_tr16_b64_v4i16((LAS v4i16_t*)p)); }
__device__ __forceinline__ void lds_addf(LAS float* p, float v) { (void)__hip_atomic_fetch_add(p, v, __ATOMIC_RELAXED, __HIP_MEMORY_SCOPE_WORKGROUP); }
__device__ __forceinline__ int med3i(int x, int lo, int hi) { return x < lo ? lo : (x > hi ? hi : x); }
__device__ __forceinline__ void attn_unit(const Ctx& C, const bf16* __restrict__ Qh, const bf16* __restrict__ Kh, const bf16* __restrict__ Vh,
                                          int d, int tq0, int nq, int tl0, int tls, float a2, float bound2, LAS float* Oacc, LAS float* Lacc, LAS char* vst, bool first) {
    int lane_ = C.lane; asm volatile("" : "+v"(lane_));
    const int lane = lane_, r = lane & 31, hh = lane >> 5;
    const int qi = r < nq ? r : nq - 1;
    bf16x8 qf[4]; v4u ks_[2][4], vs[2][4];
    const char* Kc = (const char*)Kh; const char* Vc = (const char*)Vh;
#define AT_LOADK(kb) do { _Pragma("unroll") for (int it = 0; it < 4; ++it) { const int key = (lane >> 3) + 8 * it; \
        const unsigned ro = (unsigned)med3i(tq0 + d * (32 * (kb) + key - 64), 0, S - 1) * 128u + 16u * (lane & 7); ks_[(kb) % 2][it] = *(const v4u*)(Kc + ro); } } while (0)
#define AT_LOADV(kb) do { _Pragma("unroll") for (int it = 0; it < 4; ++it) { const int key = (lane >> 3) + 8 * it; \
        const unsigned ro = (unsigned)med3i(tq0 + d * (32 * (kb) + key - 64), 0, S - 1) * 128u + 16u * (lane & 7); vs[(kb) % 2][it] = *(const v4u*)(Vc + ro); } } while (0)
    { const char* qp = (const char*)Qh + (unsigned)(tq0 + d * qi) * 128u + 16u * hh;
#pragma unroll
      for (int ks = 0; ks < 4; ++ks) qf[ks] = *(const bf16x8*)(qp + 32 * ks); }
    AT_LOADK(0); AT_LOADV(0);
    f32x16 o0, o1;
#pragma unroll
    for (int v = 0; v < 16; ++v) { o0[v] = 0.f; o1[v] = 0.f; }
    float lsum = 0.f;
    LAS char* kst = vst, *vt = vst + 4096;
    const LAS char* vb = vt + ((lane >> 4) & 1) * 32 + (lane & 3) * 8 + (4 * hh + ((lane & 15) >> 2)) * 64;
    LAS char* vw = vt + ((lane & 7) >> 2) * 2048 + ((lane >> 3) & 15) * 64 + (lane & 3) * 16;
    LAS char* kw = kst + (lane >> 3) * 128;
    const LAS char* kr = kst + r * 128;
    const int rsw = (r >> 1) & 7;
#pragma unroll
    for (int kb = 0; kb < 5; ++kb) {
        if (kb + 1 < 5) { AT_LOADK(kb + 1); AT_LOADV(kb + 1); }
#pragma unroll
        for (int it = 0; it < 4; ++it) { const int key = (lane >> 3) + 8 * it;
            *(LAS v4u*)(kw + it * 1024 + (((lane & 7) ^ ((key >> 1) & 7)) << 4)) = ks_[kb % 2][it]; }
        f32x16 p;
        int relb = 32 * kb - 64 - r + 4 * hh; const int kposb = tq0 + d * (32 * kb - 64 + 4 * hh);
        asm volatile("" : "+v"(relb));
#pragma unroll
        for (int v = 0; v < 16; ++v) {
            const int rw = (v & 3) + 8 * (v >> 2), rel = relb + rw, kpos = kposb + d * rw;
            bool valid = ((unsigned)kpos < (unsigned)S) && (r < nq);
            if (kb == 0) valid = valid && (rel >= -64);
            if (kb == 4) valid = valid && (rel <= 64);
            p[v] = valid ? -(a2 * fabsf((float)rel)) - bound2 : -1e30f;
        }
        asm volatile("s_waitcnt lgkmcnt(0)" ::: "memory");
        bf16x8 kf[4];
#pragma unroll
        for (int ks = 0; ks < 4; ++ks) kf[ks] = *(const LAS bf16x8*)(kr + (((2 * ks + hh) ^ rsw) << 4));
#pragma unroll
        for (int ks = 0; ks < 4; ++ks) p = __builtin_amdgcn_mfma_f32_32x32x16_bf16(kf[ks], qf[ks], p, 0, 0, 0);
#pragma unroll
        for (int it = 0; it < 4; ++it) *(LAS v4u*)(vw + (it >> 1) * 1024 + (it & 1) * 512) = vs[kb % 2][it];
#pragma unroll
        for (int v = 0; v < 16; ++v) { p[v] = __builtin_amdgcn_exp2f(p[v]); lsum += p[v]; }
        v4u pw0, pw1;
        pw0.x = pk2(p[0], p[1]); pw0.y = pk2(p[2], p[3]); pw0.z = pk2(p[4], p[5]); pw0.w = pk2(p[6], p[7]);
        pw1.x = pk2(p[8], p[9]); pw1.y = pk2(p[10], p[11]); pw1.z = pk2(p[12], p[13]); pw1.w = pk2(p[14], p[15]);
        asm volatile("s_waitcnt lgkmcnt(0)" ::: "memory");
#pragma unroll
        for (int sdh = 0; sdh < 4; ++sdh) {
            const int dh = sdh >> 1, ss = sdh & 1;
            const s16x4 lo = vtr(vb + dh * 2048 + ss * 1024), hi = vtr(vb + dh * 2048 + ss * 1024 + 512);
            const bf16x8 vf = {lo[0], lo[1], lo[2], lo[3], hi[0], hi[1], hi[2], hi[3]};
            const bf16x8 pa = __builtin_bit_cast(bf16x8, ss == 0 ? pw0 : pw1);
            if (dh == 0) o0 = __builtin_amdgcn_mfma_f32_32x32x16_bf16(pa, vf, o0, 0, 0, 0);
            else o1 = __builtin_amdgcn_mfma_f32_32x32x16_bf16(pa, vf, o1, 0, 0, 0);
        }
        asm volatile("s_waitcnt lgkmcnt(0)" ::: "memory");
    }
#undef AT_LOADK
#undef AT_LOADV
    lsum += __shfl_xor(lsum, 32);
    if (lane < nq) { LAS float* lp = Lacc + tl0 + tls * lane; *lp = first ? lsum : *lp + lsum; }
#pragma unroll
    for (int v = 0; v < 16; ++v) {
        const int iq = (v & 3) + 8 * (v >> 2) + 4 * hh;
        if (v < 8 || nq == 32) { LAS float* op = Oacc + (tl0 + tls * iq) * 64 + r;
            if (first) { op[0] = o0[v]; op[32] = o1[v]; } else { const float x0 = op[0], x1 = op[32]; op[0] = x0 + o0[v]; op[32] = x1 + o1[v]; } }
    }
}
__device__ __forceinline__ void attn_phase(const Ctx& C, const Args& a) {
    const bf16* Q = (const bf16*)(a.ws + WS_PROJ + 16 * MiB);
    const bf16* K = (const bf16*)(a.ws + WS_PROJ + 32 * MiB);
    const bf16* V = (const bf16*)(a.ws + WS_PROJ + 48 * MiB);
    bf16* MIXED = (bf16*)(a.ws + WS_MIXED);
    LAS float* Oacc = (LAS float*)(C.lds + AT_O); LAS float* Lacc = (LAS float*)(C.lds + AT_L); LAS char* vst = (LAS char*)(C.lds + AT_V + C.wave * 8192);
    float mq = fabsf(a.in[7][C.lane]), mk = fabsf(a.in[8][C.lane]);
#pragma unroll
    for (int o = 1; o < 64; o <<= 1) { mq = fmaxf(mq, __shfl_xor(mq, o)); mk = fmaxf(mk, __shfl_xor(mk, o)); }
    const float bound2 = 64.f * pg8::QSCALE * mq * mk * 1.01f;
    for (int item = C.vcu; item < NB * NH * 16; item += C.G) {
        const int span = item & 15, h = (item >> 4) & 7, b = item >> 7, t0 = span * 256, w = C.wave;
        const size_t hb = (size_t)(b * NH + h) * S * 64;
        const bf16 *Qh = Q + hb, *Kh = K + hb, *Vh = V + hb;
        const float slope2 = exp2f(-(float)(h + 1)) * 1.4426950408889634f;
#pragma unroll 1
        for (int un = 0; un < 4; ++un) {
            const int d = un == 0 ? 1 : (un == 1 ? 4 : 16);
            const int tl0 = un == 0 ? 32 * w : (un == 1 ? (w >> 1) + 128 * (w & 1) : 2 * w + (un - 2));
            attn_unit(C, Qh, Kh, Vh, d, t0 + tl0, un < 2 ? 32 : 16, tl0, d, slope2 * (float)d, bound2, Oacc, Lacc, vst, un == 0);
            if (un < 2) __syncthreads();
        }
        __syncthreads();
        {
            const int q = C.tid >> 1, hf = C.tid & 1;
            const float inv = 1.f / Lacc[q];
            const LAS f32x4* op = (const LAS f32x4*)(Oacc + q * 64 + 32 * hf);
            bf16* dst = MIXED + (size_t)(b * S + t0 + q) * D + 512 + h * 64 + 32 * hf;
#pragma unroll
            for (int j = 0; j < 4; ++j) { const f32x4 x0 = op[2 * j] * inv, x1 = op[2 * j + 1] * inv; v4u o; o.x = pk2(x0[0], x0[1]); o.y = pk2(x0[2], x0[3]); o.z = pk2(x1[0], x1[1]); o.w = pk2(x1[2], x1[3]); *(v4u*)(dst + 8 * j) = o; }
        }
        __syncthreads();
    }
}

typedef float f32x4m __attribute__((ext_vector_type(4)));
__device__ __forceinline__ void p_router(const Ctx& C, const Args& a, int layer) {
    const bf16* X = (const bf16*)(a.ws + (layer == 0 ? WS_XA : WS_XB)); const float* g = a.in[20] + (size_t)layer * D;
    const float* wr = a.in[21] + (size_t)layer * D * NE; const float* br = a.in[22] + layer * NE;
    float* RS = (float*)(a.ws + WS_RS); float* AFF = (float*)(a.ws + WS_AFF);
    LAS unsigned char* wl = C.lds;
    for (int idx = C.tid; idx < 32 * 64; idx += NTHR) {
        const int ks = idx >> 6, l = idx & 63, n = l & 15, kq = l >> 4; unsigned hi[4], lo[4];
#pragma unroll
        for (int jj = 0; jj < 4; ++jj) { float wv[2]; unsigned short hb[2], lb[2];
#pragma unroll
            for (int t = 0; t < 2; ++t) { const int k = 32 * ks + 8 * kq + 2 * jj + t; wv[t] = g[k] * wr[(size_t)k * NE + n]; }
            const unsigned ph = pk2(wv[0], wv[1]); hb[0] = (unsigned short)(ph & 0xffffu); hb[1] = (unsigned short)(ph >> 16);
            const unsigned pl = pk2(wv[0] - bf2f(hb[0]), wv[1] - bf2f(hb[1])); (void)lb;
            hi[jj] = ph; lo[jj] = pl; }
        *(LAS v4u*)(wl + idx * 16) = (v4u){hi[0], hi[1], hi[2], hi[3]};
        *(LAS v4u*)(wl + 32768 + idx * 16) = (v4u){lo[0], lo[1], lo[2], lo[3]};
    }
    __syncthreads();
    const int lane = C.lane, row = lane & 15, kq = lane >> 4;
    const bool rows_by_xcd = (C.G == 256);
    for (int task = rows_by_xcd ? (C.wave < 4 ? 4 * C.vcu + C.wave : T / 16) : C.wave * C.G + C.vcu; task < T / 16; task += rows_by_xcd ? T / 16 : NWAVES * C.G) {
        const int m0 = 16 * task;
        const bf16* xp = X + (size_t)(m0 + row) * D + 8 * kq;
        bf16x8 fa[8], fb[8];
        f32x4m acc = {0.f, 0.f, 0.f, 0.f}; float ss = 0.f;
#define RT_LOAD(dst, c) do { _Pragma("unroll") for (int i = 0; i < 8; ++i) dst[i] = *(const bf16x8*)(xp + 32 * (8 * (c) + i)); } while (0)
#define RT_MUL(src, c) do { _Pragma("unroll") for (int i = 0; i < 8; ++i) { const int ks = 8 * (c) + i; \
            const bf16x8 bh = *(const LAS bf16x8*)(wl + (ks * 64 + lane) * 16), bl = *(const LAS bf16x8*)(wl + 32768 + (ks * 64 + lane) * 16); \
            acc = __builtin_amdgcn_mfma_f32_16x16x32_bf16(src[i], bh, acc, 0, 0, 0); acc = __builtin_amdgcn_mfma_f32_16x16x32_bf16(src[i], bl, acc, 0, 0, 0); \
            const v4u raw = __builtin_bit_cast(v4u, src[i]); \
            const float x0 = bflo(raw.x), x1 = bfhi(raw.x), x2 = bflo(raw.y), x3 = bfhi(raw.y), x4 = bflo(raw.z), x5 = bfhi(raw.z), x6 = bflo(raw.w), x7 = bfhi(raw.w); \
            ss += ((x0 * x0 + x1 * x1) + (x2 * x2 + x3 * x3)) + ((x4 * x4 + x5 * x5) + (x6 * x6 + x7 * x7)); \
            if (i & 1) asm volatile("" ::: "memory"); } } while (0)
        RT_LOAD(fa, 0); RT_LOAD(fb, 1); RT_MUL(fa, 0); RT_LOAD(fa, 2); RT_MUL(fb, 1); RT_LOAD(fb, 3); RT_MUL(fa, 2); RT_MUL(fb, 3);
#undef RT_LOAD
#undef RT_MUL
        ss += __shfl_xor(ss, 16); ss += __shfl_xor(ss, 32);
        const float rs = rsqrtf(ss * (1.f / D) + EPS);
        if (lane < 16) RS[m0 + lane] = rs;
        const float bias = br[row];
#pragma unroll
        for (int r = 0; r < 4; ++r) {
            const int orow = 4 * kq + r;
            const float lg = acc[r] * __shfl(rs, orow) + bias;
            float mx = lg;
#pragma unroll
            for (int o = 1; o < 16; o <<= 1) mx = fmaxf(mx, __shfl_xor(mx, o));
            const float ex = __expf(lg - mx); float sum = ex;
#pragma unroll
            for (int o = 1; o < 16; o <<= 1) sum += __shfl_xor(sum, o);
            const int m = m0 + orow, b = m / S, sidx = m % S;
            AFF[((size_t)b * NE + row) * S + sidx] = ex / sum;
        }
    }
    __syncthreads();
}

__device__ __forceinline__ int popc64(unsigned long long m) { return __builtin_popcountll(m); }
__device__ __forceinline__ void p_topk(const Ctx& C, const Args& a) {
    const float* AFF = (const float*)(a.ws + WS_AFF);
    int* IDX = (int*)(a.ws + WS_IDX); float* GATE = (float*)(a.ws + WS_GATE); int* SLOT = (int*)(a.ws + WS_SLOT);
    const float* RS = (const float*)(a.ws + WS_RS); float* RSROW = (float*)(a.ws + WS_RSROW);
    LAS int* red = (LAS int*)C.lds;
    const int lane = C.lane, w = C.wave;
    const bool by_xcd = (C.G == 256);
    for (int it = C.vcu; it < (by_xcd ? C.G : NB * NE); it += C.G) {
        int be = it;
        if (by_xcd) { const int x = it >> 5, r = it & 31; if (r >= 8) break; be = (r >> 1) * NE + x + 8 * (r & 1); }
        const int b = be / NE, e = be % NE;
        unsigned key[8];
        { const v4u k0 = *(const v4u*)(AFF + (size_t)be * S + 512 * w + 8 * lane), k1 = *(const v4u*)(AFF + (size_t)be * S + 512 * w + 8 * lane + 4);
          key[0] = k0.x; key[1] = k0.y; key[2] = k0.z; key[3] = k0.w; key[4] = k1.x; key[5] = k1.y; key[6] = k1.z; key[7] = k1.w; }
        unsigned cur = 0u;
#pragma unroll 1
        for (int bit = 30; bit >= 0; --bit) {
            const unsigned cand = cur | (1u << bit);
            unsigned c = 0;
#pragma unroll
            for (int i = 0; i < 8; ++i) c += (key[i] >= cand) ? 1u : 0u;
            int cnt = 0;
#pragma unroll
            for (int k = 0; k < 4; ++k) cnt += popc64(__ballot((c >> k) & 1u)) << k;
            const int par = bit & 1;
            if (lane == 0) red[par * 8 + w] = cnt;
            __syncthreads();
            int tot = 0;
#pragma unroll
            for (int ww = 0; ww < 8; ++ww) tot += red[par * 8 + ww];
            if (tot >= CAP) cur = cand;
        }
        unsigned pk = 0;
#pragma unroll
        for (int i = 0; i < 8; ++i) pk += (key[i] > cur ? 1u : 0u) + (key[i] == cur ? 0x10000u : 0u);
        unsigned inc = pk;
#pragma unroll
        for (int o = 1; o < 64; o <<= 1) { const unsigned t = __shfl_up(inc, o); if (lane >= o) inc += t; }
        if (lane == 63) { red[16 + w] = (int)(inc & 0xffffu); red[24 + w] = (int)(inc >> 16); }
        __syncthreads();
        int gpre = 0, epre = 0, ngt = 0;
#pragma unroll
        for (int ww = 0; ww < 8; ++ww) { const int tg = red[16 + ww], te = red[24 + ww]; ngt += tg; if (ww < w) { gpre += tg; epre += te; } }
        const int need = CAP - ngt;
        const unsigned exc = inc - pk;
        int gtb = gpre + (int)(exc & 0xffffu), eqb = epre + (int)(exc >> 16);
#pragma unroll
        for (int i = 0; i < 8; ++i) {
            const bool gt = key[i] > cur, eq = key[i] == cur;
            const bool sel = gt || (eq && eqb < need);
            const int pos = gtb + (eqb < need ? eqb : need);
            const int tok = 512 * w + 8 * lane + i;
            SLOT[((size_t)(b * S + tok)) * NE + e] = sel ? pos : -1;
            if (sel) { IDX[be * CAP + pos] = b * S + tok; GATE[be * CAP + pos] = __uint_as_float(key[i]); RSROW[be * CAP + pos] = RS[b * S + tok]; }
            gtb += gt ? 1 : 0; eqb += eq ? 1 : 0;
        }
        __syncthreads();
    }
}

__device__ __forceinline__ void p_combine(const Ctx& C, const Args& a, bool with_norm) {
    const bf16* Xin = (const bf16*)(a.ws + (with_norm ? WS_XA : WS_XB)); bf16* Xb = (bf16*)(a.ws + WS_XB); float* Xout = a.out;
    const bf16* Y = (const bf16*)(a.ws + WS_PROJ); const int* SLOT = (const int*)(a.ws + WS_SLOT);
    bf16* UC = (bf16*)(a.ws + WS_H); const float* g = a.in[10];
    const int gw = C.vcu * NWAVES + C.wave, NGW = C.G * NWAVES, lane = C.lane;
    auto LOADR = [&](v4u (&v)[2], int& slot, int m) __attribute__((always_inline)) { const v4u* xr = (const v4u*)(Xin + (size_t)m * D) + 2 * lane; v[0] = xr[0]; v[1] = xr[1];
        slot = (lane < NE) ? SLOT[(size_t)m * NE + lane] : -1; };
    auto PROC = [&](const v4u (&vr)[2], int myslot, int m) __attribute__((always_inline)) {
        const int b = m / S;
        f32x4 v[4];
        v[0] = (f32x4){bflo(vr[0].x), bfhi(vr[0].x), bflo(vr[0].y), bfhi(vr[0].y)}; v[1] = (f32x4){bflo(vr[0].z), bfhi(vr[0].z), bflo(vr[0].w), bfhi(vr[0].w)};
        v[2] = (f32x4){bflo(vr[1].x), bfhi(vr[1].x), bflo(vr[1].y), bfhi(vr[1].y)}; v[3] = (f32x4){bflo(vr[1].z), bfhi(vr[1].z), bflo(vr[1].w), bfhi(vr[1].w)};
        unsigned long long mask = __ballot(myslot >= 0);
        while (mask) {
            v4u y[4][2]; int ee[4];
#pragma unroll
            for (int q = 0; q < 4; ++q) { ee[q] = mask ? (int)__builtin_ctzll(mask) : -1; if (mask) mask &= mask - 1; }
#pragma unroll
            for (int q = 0; q < 4; ++q) if (ee[q] >= 0) { const int sl = __shfl(myslot, ee[q]);
                const v4u* yr = (const v4u*)(Y + ((size_t)(b * NE + ee[q]) * CAP + sl) * D) + 2 * lane; y[q][0] = yr[0]; y[q][1] = yr[1]; }
#pragma unroll
            for (int q = 0; q < 4; ++q) if (ee[q] >= 0) {
#pragma unroll
                for (int hq = 0; hq < 2; ++hq) { const v4u t = y[q][hq];
                    v[2 * hq][0] += bflo(t.x); v[2 * hq][1] += bfhi(t.x); v[2 * hq][2] += bflo(t.y); v[2 * hq][3] += bfhi(t.y);
                    v[2 * hq + 1][0] += bflo(t.z); v[2 * hq + 1][1] += bfhi(t.z); v[2 * hq + 1][2] += bflo(t.w); v[2 * hq + 1][3] += bfhi(t.w); } }
        }
        if (!with_norm) { f32x4* xo = (f32x4*)(Xout + (size_t)m * D) + 4 * lane;
#pragma unroll
            for (int j = 0; j < 4; ++j) xo[j] = v[j]; }
        else { v4u o0, o1; o0.x = pk2(v[0][0], v[0][1]); o0.y = pk2(v[0][2], v[0][3]); o0.z = pk2(v[1][0], v[1][1]); o0.w = pk2(v[1][2], v[1][3]);
            o1.x = pk2(v[2][0], v[2][1]); o1.y = pk2(v[2][2], v[2][3]); o1.z = pk2(v[3][0], v[3][1]); o1.w = pk2(v[3][2], v[3][3]);
            v4u* xo = (v4u*)(Xb + (size_t)m * D) + 2 * lane; xo[0] = o0; xo[1] = o1; }
        if (with_norm) {
            float s = 0.f;
#pragma unroll
            for (int j = 0; j < 4; ++j) s += (v[j][0] * v[j][0] + v[j][1] * v[j][1]) + (v[j][2] * v[j][2] + v[j][3] * v[j][3]);
            const float r = rsqrtf(wave_sum(s) * (1.f / D) + EPS);
            unsigned w[8];
#pragma unroll
            for (int j = 0; j < 4; ++j) { const f32x4 gg = ((const f32x4*)g)[4 * lane + j]; w[2 * j] = pk2(v[j][0] * r * gg[0], v[j][1] * r * gg[1]); w[2 * j + 1] = pk2(v[j][2] * r * gg[2], v[j][3] * r * gg[3]); }
            bf16* up = UC + ((size_t)(lane * 1024 + (m >> 4)) * 512 + (m & 15) * 16);
            *(v4u*)up = (v4u){w[0], w[1], w[2], w[3]}; *(v4u*)(up + 8) = (v4u){w[4], w[5], w[6], w[7]};
        }
    };
    v4u va[2], vb[2]; int sa = -1, sb = -1;
    int m = gw;
    if (m < T) LOADR(va, sa, m);
    for (; m < T; m += 2 * NGW) {
        if (m + NGW < T) LOADR(vb, sb, m + NGW);
        PROC(va, sa, m);
        if (m + 2 * NGW < T) LOADR(va, sa, m + 2 * NGW);
        if (m + NGW < T) PROC(vb, sb, m + NGW);
    }
}

constexpr size_t WS_UC = WS_H;
constexpr size_t WS_E = WS_PROJ;
constexpr size_t WS_TM = 468 * MiB;
constexpr size_t WS_W16 = 484 * MiB;
__device__ __forceinline__ void s5_lambda(const Args& a, int pg, int p, float& lbr, float& lbi, float& fr, float& fi) {
    const float lr = a.in[11][pg * SP + p], li = a.in[12][pg * SP + p], dt = expf(a.in[13][pg]);
    const float mag = expf(lr * dt), ang = li * dt;
    lbr = mag * cosf(ang); lbi = mag * sinf(ang);
    const float den = lr * lr + li * li, nr = lbr - 1.f;
    fr = (nr * lr + lbi * li) / den; fi = (lbi * lr - nr * li) / den;
}
__device__ __forceinline__ void p_s5_pre(const Ctx& C, const Args& a, int g) {
    LAS float* lam = (LAS float*)C.lds; LAS float* bb = lam + 2 * 64 * 17 * 2; LAS float* cc = bb + 2 * 64 * 16 * 2; LAS float* Kt = cc + 2 * 16 * 64 * 2;
    bf16* TM = (bf16*)(a.ws + WS_TM) + (size_t)g * 256 * 512; bf16* W16 = (bf16*)(a.ws + WS_W16) + (size_t)g * 256 * 256;
    const int tid = C.tid;
    if (tid < 128) {
        const int dir = tid >> 6, p = tid & 63, pg = dir * SG + g;
        float lbr, lbi, fr, fi; s5_lambda(a, pg, p, lbr, lbi, fr, fi);
        float pr = 1.f, pi = 0.f;
        for (int k = 0; k <= 16; ++k) { lam[((dir * 64 + p) * 17 + k) * 2] = pr; lam[((dir * 64 + p) * 17 + k) * 2 + 1] = pi; const float nr = pr * lbr - pi * lbi, ni = pr * lbi + pi * lbr; pr = nr; pi = ni; }
        for (int c = 0; c < 16; ++c) { const float br = a.in[14][((size_t)pg * SP + p) * SC + c], bi = a.in[15][((size_t)pg * SP + p) * SC + c];
            bb[((dir * 64 + p) * 16 + c) * 2] = fr * br - fi * bi; bb[((dir * 64 + p) * 16 + c) * 2 + 1] = fr * bi + fi * br; }
    }
    for (int i = tid; i < 2048; i += NTHR) { const int dir = i >> 10, r = i & 1023;
        cc[i * 2] = a.in[16][(size_t)(dir * SG + g) * 1024 + r]; cc[i * 2 + 1] = a.in[17][(size_t)(dir * SG + g) * 1024 + r]; }
    __syncthreads();
    for (int id = tid; id < 8192; id += NTHR) {
        const int dir = id >> 12, k = (id >> 8) & 15, cp = (id >> 4) & 15, c = id & 15; float acc = 0.f;
        for (int p = 0; p < 64; ++p) {
            const float cr = cc[((dir * 16 + cp) * 64 + p) * 2], ci = cc[((dir * 16 + cp) * 64 + p) * 2 + 1];
            const float lr = lam[((dir * 64 + p) * 17 + k) * 2], li = lam[((dir * 64 + p) * 17 + k) * 2 + 1];
            const float xr = cr * lr - ci * li, xi = cr * li + ci * lr;
            acc += xr * bb[((dir * 64 + p) * 16 + c) * 2] - xi * bb[((dir * 64 + p) * 16 + c) * 2 + 1];
        }
        Kt[id] = acc;
    }
    __syncthreads();
    const float* dsk = a.in[18] + g * 16;
    for (int e8 = tid; e8 < 256 * 64; e8 += NTHR) {
        const int n = e8 >> 6, ch = e8 & 63, t = n >> 4, cp = n & 15; float v[8];
        if (ch < 32) {
            const int s_ = ch >> 1, c0 = (ch & 1) * 8;
#pragma unroll
            for (int i = 0; i < 8; ++i) { const int c = c0 + i; float x = 0.f;
                if (s_ <= t) x += Kt[((0 * 16 + (t - s_)) * 16 + cp) * 16 + c];
                if (s_ >= t) x += Kt[((1 * 16 + (s_ - t)) * 16 + cp) * 16 + c];
                if (s_ == t && c == cp) x += dsk[cp];
                v[i] = x; }
        } else {
            const int dir = (ch - 32) >> 4, p0 = ((ch - 32) & 15) * 4, e = dir ? 16 - t : t + 1;
#pragma unroll
            for (int i = 0; i < 4; ++i) { const int p = p0 + i;
                const float cr = cc[((dir * 16 + cp) * 64 + p) * 2], ci = cc[((dir * 16 + cp) * 64 + p) * 2 + 1];
                const float lr = lam[((dir * 64 + p) * 17 + e) * 2], li = lam[((dir * 64 + p) * 17 + e) * 2 + 1];
                v[2 * i] = cr * lr - ci * li; v[2 * i + 1] = -(cr * li + ci * lr); }
        }
        v4u o; o.x = pk2(v[0], v[1]); o.y = pk2(v[2], v[3]); o.z = pk2(v[4], v[5]); o.w = pk2(v[6], v[7]);
        *(v4u*)(TM + (size_t)n * 512 + 8 * ch) = o;
    }
    for (int e8 = tid; e8 < 256 * 32; e8 += NTHR) {
        const int n = e8 >> 5, ch = e8 & 31, dir = n >> 7, p = (n & 127) >> 1, part = n & 1, s_ = ch >> 1, c0 = (ch & 1) * 8, e = dir ? s_ : 15 - s_;
        const float lr = lam[((dir * 64 + p) * 17 + e) * 2], li = lam[((dir * 64 + p) * 17 + e) * 2 + 1]; float v[8];
#pragma unroll
        for (int i = 0; i < 8; ++i) { const float br = bb[((dir * 64 + p) * 16 + c0 + i) * 2], bi = bb[((dir * 64 + p) * 16 + c0 + i) * 2 + 1];
            v[i] = part ? (lr * bi + li * br) : (lr * br - li * bi); }
        v4u o; o.x = pk2(v[0], v[1]); o.y = pk2(v[2], v[3]); o.z = pk2(v[4], v[5]); o.w = pk2(v[6], v[7]);
        *(v4u*)(W16 + (size_t)n * 256 + 8 * ch) = o;
    }
    __syncthreads();
}
struct S5Order {
    int G, c;
    __device__ void init(int G_, int c_) { G = G_; c = c_; }
    __device__ bool next(int i, pg8::Unit& u) const {
        const long L = (long)i * G + c; if (L >= 256) return false;
        int V = (int)L; if (G == 256) V = (c & 7) * 32 + (c >> 3);
        u.pm = V; u.pn = 0; u.pb = V >> 2; return true;
    }
    __device__ __forceinline__ void a_ready(const pg8::Unit&) const {}
    __device__ __forceinline__ void done(const pg8::Unit&) const {}
};
struct EpiS5Scan {
    static constexpr bool PERM = true, AFTER_DRAIN = true;
    bf16* UC; const float *lam_re, *lam_im, *log_dt;
    static constexpr int PITCH = 528;
    __device__ __forceinline__ void fused(const pg8::f32x4 (&acc)[2][2][4][2], const pg8::Unit& u, int wr, int wc, int fr, int fq, LAS unsigned char* lds, int wid, int lane) const {
        const int tid = wid * 64 + lane;
#pragma unroll
        for (int ai = 0; ai < 2; ++ai)
#pragma unroll
            for (int m = 0; m < 4; ++m)
#pragma unroll
                for (int bj = 0; bj < 2; ++bj) { const pg8::f32x4 x = acc[ai][bj][m][0], y = acc[ai][bj][m][1];
                    v4u w; w.x = pk2(x[0], x[1]); w.y = pk2(x[2], x[3]); w.z = pk2(y[0], y[1]); w.w = pk2(y[2], y[3]);
                    *(LAS v4u*)(lds + (ai * 128 + wr * 64 + m * 16 + fr) * PITCH + (bj * 128 + wc * 32 + 8 * fq) * 2) = w; }
        __syncthreads();
        const int g = u.pm >> 2;
        if (tid < 128) {
            const int dir = tid >> 6, p = tid & 63, pg = dir * SG + g;
            const float lr = lam_re[pg * SP + p], li = lam_im[pg * SP + p], dt = expf(log_dt[pg]);
            const float mag = expf(lr * dt), ang = li * dt;
            float pr = mag * cosf(ang), pi = mag * sinf(ang);
#pragma unroll
            for (int i = 0; i < 4; ++i) { const float nr = pr * pr - pi * pi, ni = 2.f * pr * pi; pr = nr; pi = ni; }
            LAS unsigned char* col = lds + (dir * 128 + 2 * p) * 2;
            float hr = 0.f, hi = 0.f;
#pragma unroll 8
            for (int j = 0; j < 256; ++j) {
                LAS unsigned* cell = (LAS unsigned*)(col + (dir ? 255 - j : j) * PITCH);
                const unsigned e = *cell; *cell = pk2(hr, hi);
                const float er = bflo(e), ei = bfhi(e); const float nr = pr * hr - pi * hi + er, ni = pr * hi + pi * hr + ei; hr = nr; hi = ni;
            }
        }
        __syncthreads();
        bf16* dst = UC + (size_t)u.pm * 256 * 512 + 256;
#pragma unroll
        for (int i = 0; i < 16; ++i) { const int idx = tid + 512 * i, row = idx >> 5, ch = idx & 31;
            *(v4u*)(dst + (size_t)row * 512 + 8 * ch) = *(const LAS v4u*)(lds + row * PITCH + 16 * ch); }
        __syncthreads();
    }
};
__device__ __forceinline__ float gelu_t(float y) { const float u = 0.7978845608028654f * (y + 0.044715f * y * y * y); const float e = __builtin_amdgcn_exp2f(2.885390081777927f * u); const float th = 1.f - 2.f * __builtin_amdgcn_rcpf(e + 1.f); return 0.5f * y * (1.f + th); }
struct EpiS5Z {
    static constexpr bool PERM = true, AFTER_DRAIN = false;
    bf16* Z;
    __device__ __forceinline__ void operator()(const pg8::f32x4 (&acc)[2][2][4][2], const pg8::Unit& u, int wr, int wc, int fr, int fq) const {
        const int row0 = u.pm * 256 + wr * 64 + fr;
#pragma unroll
        for (int ai = 0; ai < 2; ++ai)
#pragma unroll
            for (int m = 0; m < 4; ++m) { const int row = row0 + ai * 128 + m * 16, g = row >> 10, J = row & 1023;
#pragma unroll
                for (int bj = 0; bj < 2; ++bj) { const int t = 8 * bj + 2 * wc + (fq >> 1), c0 = 8 * (fq & 1);
                    const pg8::f32x4 x = acc[ai][bj][m][0], y = acc[ai][bj][m][1];
                    v4u w; w.x = pk2(gelu_t(x[0]), gelu_t(x[1])); w.y = pk2(gelu_t(x[2]), gelu_t(x[3])); w.z = pk2(gelu_t(y[0]), gelu_t(y[1])); w.w = pk2(gelu_t(y[2]), gelu_t(y[3]));
                    *(v4u*)(Z + (size_t)(16 * J + t) * D + g * 16 + c0) = w; } }
    }
};
constexpr int NPHASE = 18;
__global__ void __launch_bounds__(NTHR, 2) mk_fwd(Args args) {
    extern __shared__ __attribute__((aligned(16))) unsigned char lds_raw[];
    Ctx C;
    C.lds = (LAS unsigned char*)lds_raw;
    C.tid = threadIdx.x; C.lane = C.tid & 63; C.wave = __builtin_amdgcn_readfirstlane(C.tid >> 6);
    C.G = gridDim.x; { const int bx = blockIdx.x; C.vcu = (C.G % 8 == 0) ? (bx % 8) * (C.G / 8) + bx / 8 : bx; }
    volatile LAS unsigned* MISC = (volatile LAS unsigned*)(C.lds + LDSCTL_OFF);
    for (int u = C.tid; u < (LDS_BYTES - LDSCTL_OFF) / 4; u += NTHR) ((LAS unsigned*)(C.lds + LDSCTL_OFF))[u] = 0u;
    __syncthreads();
    int lo = args.ph_lo, hi = args.ph_hi;
    unsigned char* ws = args.ws;
    asm volatile("" : "+s"(lo), "+s"(hi), "+s"(ws));
    unsigned* ctl = (unsigned*)(ws + WS_CTL);
    const bool one_launch = (lo == 0 && hi == NPHASE);
    XcdBarrier bar; bar.bar = ctl + CW_BAR; bar.x = 0; bar.st = nullptr;
    if (one_launch) bar = xcd_barrier_post(ctl + CW_BAR, MISC + 8);
    LAS unsigned char* glds = C.lds;
#ifndef MK_ONLY
#define MK_ONLY -1
#endif
#define IN(k) ((MK_ONLY < 0 || MK_ONLY == (k) || (MK_ONLY == 4 && (k) == 13) || (MK_ONLY == 5 && (k) == 14) || (MK_ONLY == 6 && (k) == 15) || (MK_ONLY == 7 && (k) == 16) || (MK_ONLY == 8 && (k) == 17)) && lo <= (k) && (k) < hi)
#ifndef MK_S5DUP
#define MK_S5DUP 0
#endif
#ifndef MK_DUP
#define MK_DUP 0
#endif
#define DUPBIT(k) ((MK_DUP >> ((k) < 13 ? (k) : (k) - 9)) & 1)
#define DUPX(k, ...) do { __VA_ARGS__ if (DUPBIT(k)) { __VA_ARGS__ } } while (0)
#define SEAM(k) do { if (IN(k) && IN((k) + 1)) xcd_barrier(bar); } while (0)

#ifdef MK_XBAR
    if (one_launch) for (int xb_ = 0; xb_ < MK_XBAR; ++xb_) xcd_barrier(bar);
#endif
    if (IN(0)) { DUPX(0, p0_prologue(C, args);); } SEAM(0);
    int vb = (int)blockIdx.x; bool lsync = false;
    if (one_launch) {
        if (C.tid == 0) {
            unsigned ok = (C.G == 256 && bar.x < 8u && bar.rank < 32u) ? 1u : 0u;
            for (unsigned j = 0; j < 8; ++j) ok &= (xb_ld(&bar.bar[XB_XCNT(j)]) == 32u) ? 1u : 0u;
            MISC[8 + 2] = bar.rank; MISC[8 + 3] = ok;
        }
        __syncthreads();
        const unsigned ok = (unsigned)__builtin_amdgcn_readfirstlane((int)MISC[8 + 3]), rk = (unsigned)__builtin_amdgcn_readfirstlane((int)MISC[8 + 2]);
        if (ok) { vb = (int)(rk * 8u + bar.x); lsync = true; C.vcu = (vb % 8) * (C.G / 8) + vb / 8; }
    }
#define LSEAM(k) do { if (IN(k) && IN((k) + 1)) { if (lsync) xcd_local_barrier(bar); else xcd_barrier(bar); } } while (0)
    if (IN(1)) {
        const int G1 = (C.G == 256) ? 214 : C.G;
        if (vb < G1) {
            pg8::Gemm g{(const bf16*)(ws + WS_XN), (const bf16*)(ws + WS_WIN), D, nullptr, D, D}; pg8::DenseOrder So; So.init(T, INC, G1, vb);
            pg8::EpiProj E{(bf16*)(ws + WS_PROJ), (bf16*)(ws + WS_PROJ + 16 * MiB), args.in[7], args.in[8]};
            pg8::gemm_phase<pg8::EpiProj, pg8::DenseOrder, true, true>(glds, g, So, E);
            if (C.tid == 0) __hip_atomic_fetch_add((unsigned*)(ws + WS_CTL) + CW_P1DONE, 1u, __ATOMIC_RELAXED, __HIP_MEMORY_SCOPE_AGENT);
        } else conv_drain(C, args, true);
    } SEAM(1);
    if (IN(2)) {
 DUPX(2, {        for (int gq = C.vcu; gq < SG; gq += C.G) p_s5_pre(C, args, gq);
        conv_phase(C, args);
        attn_phase(C, args);
        conv_drain(C, args, false);
    }); } SEAM(2);
    if (IN(3)) {
 DUPX(3, {        pg8::Gemm g{(const bf16*)(ws + WS_MIXED), (const bf16*)(ws + WS_WOUT), D, nullptr, D, D}; pg8::DenseOrder So; So.init(T, D, C.G, vb);
        pg8::EpiRes E{args.in[0], (bf16*)(ws + WS_XA), ws + WS_XQ};
        pg8::gemm_phase<pg8::EpiRes, pg8::DenseOrder, true, true>(glds, g, So, E);
    }); } LSEAM(3);
#define MOE_PHASES(layer, pb) do { \
        if (IN(pb)) { DUPX(pb, p_router(C, args, layer);); } SEAM(pb); \
        if (IN(pb + 1)) { DUPX(pb + 1, p_topk(C, args);); } LSEAM(pb + 1); \
        if (IN(pb + 2)) { DUPX(pb + 2, { \
            int k8 = 512; asm volatile("" : "+s"(k8));       \
            pg8::Gemm g{(const bf16*)(ws + WS_XQ), (const bf16*)(ws + WS_WEXP + layer * WEXP_LAYER + WEXP_GU), k8, (const int*)(ws + WS_IDX), 512, 512}; pg8::ExpertOrder So; So.init(8, C.G, vb); \
            pg8::EpiSwiGLU E{ws + WS_H, (const float*)(ws + WS_RSROW)}; \
            pg8::gemm_phase<pg8::EpiSwiGLU, pg8::ExpertOrder, true, true, true, true>(glds, g, So, E); \
        }); } LSEAM(pb + 2); \
        if (IN(pb + 3)) { DUPX(pb + 3, { \
            int k8 = 512; asm volatile("" : "+s"(k8)); \
            pg8::Gemm g{(const bf16*)(ws + WS_H), (const bf16*)(ws + WS_WEXP + layer * WEXP_LAYER + WEXP_DN), k8, nullptr, 512, 512}; pg8::ExpertOrder So; So.init(4, C.G, vb); \
            pg8::EpiDown E{(bf16*)(ws + WS_PROJ), (const float*)(ws + WS_GATE)}; \
            pg8::gemm_phase<pg8::EpiDown, pg8::ExpertOrder, true, true, false, true>(glds, g, So, E); \
        }); } SEAM(pb + 3); \
        if (IN(pb + 4)) { DUPX(pb + 4, p_combine(C, args, layer == 0);); } \
    } while (0)
    MOE_PHASES(0, 4);
    SEAM(8);
    if (IN(9)) {
        int k9 = 256; asm volatile("" : "+s"(k9));
        pg8::Gemm g{(const bf16*)(ws + WS_UC), (const bf16*)(ws + WS_W16), k9, nullptr, 512, 256}; S5Order So; So.init(C.G, vb);
        EpiS5Scan E{(bf16*)(ws + WS_UC), args.in[11], args.in[12], args.in[13]};
        pg8::gemm_phase<EpiS5Scan, S5Order, false, true>(glds, g, So, E);
    }
    asm volatile("s_waitcnt vmcnt(0)" ::: "memory"); __syncthreads();
    if (IN(11)) {
        int k11 = 512; asm volatile("" : "+s"(k11));
        pg8::Gemm g{(const bf16*)(ws + WS_UC), (const bf16*)(ws + WS_TM), k11, nullptr, 512, 512}; S5Order So; So.init(C.G, vb);
        EpiS5Z E{(bf16*)(ws + WS_MIXED)};
        pg8::gemm_phase<EpiS5Z, S5Order, true, true>(glds, g, So, E);
#if MK_S5DUP == 11
        pg8::gemm_phase<EpiS5Z, S5Order, true, true>(glds, g, So, E);
#endif
    } SEAM(11);
    if (IN(12)) {
        pg8::Gemm g{(const bf16*)(ws + WS_MIXED), (const bf16*)(ws + WS_WGLU), D, nullptr, D, D}; pg8::DenseOrder So; So.init(T, 2 * D, C.G, vb);
        pg8::EpiGluRes E{(bf16*)(ws + WS_XB), ws + WS_XQ};
        pg8::gemm_phase<pg8::EpiGluRes, pg8::DenseOrder, true, true>(glds, g, So, E);
    } LSEAM(12);
    MOE_PHASES(1, 13);
#undef IN
#undef SEAM
#undef LSEAM
}

#ifndef MK_PER_PHASE
#define MK_PER_PHASE 0
#endif
extern "C" void kernel_launch(void* const* d_in, const int* in_sizes, int n_in, void* d_out, int out_size, void* d_ws, size_t ws_size, hipStream_t stream) {
    static int grid = 0;
    if (grid == 0) {
        if (n_in != 26 || out_size != T * D || ws_size < WS_END) { fprintf(stderr, "kernel_launch: unexpected shapes (n_in %d out %d ws %zu)\n", n_in, out_size, ws_size); grid = -1; return; }
        int dev = 0, cus = 0, per_cu = 0;
        if (hipGetDevice(&dev) != hipSuccess || hipDeviceGetAttribute(&cus, hipDeviceAttributeMultiprocessorCount, dev) != hipSuccess) { grid = -1; return; }
        if (hipFuncSetAttribute((const void*)mk_fwd, hipFuncAttributeMaxDynamicSharedMemorySize, LDS_BYTES) != hipSuccess) { fprintf(stderr, "kernel_launch: hipFuncSetAttribute failed\n"); grid = -1; return; }
        if (hipOccupancyMaxActiveBlocksPerMultiprocessor(&per_cu, (const void*)mk_fwd, NTHR, LDS_BYTES) != hipSuccess || per_cu < 1) { fprintf(stderr, "kernel_launch: occupancy query says %d blocks per CU\n", per_cu); (void)hipGetLastError(); grid = -1; return; }
        grid = cus;
    }
    if (grid < 0) return;
    (void)hipMemsetAsync((char*)d_ws + WS_CTL, 0, CTL_ZERO_BYTES, stream);
    Args a{};
    for (int i = 0; i < 26; ++i) a.in[i] = (const float*)d_in[i];
    a.out = (float*)d_out; a.ws = (unsigned char*)d_ws;
#if MK_PER_PHASE
    for (int p = 0; p < NPHASE; ++p) { a.ph_lo = p; a.ph_hi = p + 1; hipLaunchKernelGGL(mk_fwd, dim3(grid), dim3(NTHR), LDS_BYTES, stream, a); }
#else
    a.ph_lo = 0; a.ph_hi = NPHASE;
    hipLaunchKernelGGL(mk_fwd, dim3(grid), dim3(NTHR), LDS_BYTES, stream, a);
#endif
}
```

```cpp
#include <hip/hip_runtime.h>
#include <cstdint>
#include <cstdio>

namespace pg8 {
#define PG8_LAS __attribute__((address_space(3)))
typedef unsigned short bf16_t;
typedef short bf16x8 __attribute__((ext_vector_type(8)));
typedef float f32x4 __attribute__((ext_vector_type(4)));
typedef unsigned u32x4 __attribute__((ext_vector_type(4)));
constexpr int BM = 256, BK = 64, HALF = 128, HTB = HALF * BK * 2  , STAGE_BYTES = 8 * HTB, NXCD = 8, WGM = 8;

__host__ __device__ __forceinline__ int lds_byte(int r, int c) { const int st = (r >> 4) * 2 + (c >> 5), rr = r & 15, cc = c & 31, ob = rr * 64 + cc * 2; return st * 1024 + (ob ^ (((ob >> 9) & 1) << 5)); }
__host__ __device__ __forceinline__ void stage_rc(int b, int& R, int& C) { const int st = b / 1024, sb = b % 1024, swz = sb ^ (((sb >> 9) & 1) << 5); R = (st >> 1) * 16 + swz / 64; C = (st & 1) * 32 + (swz % 64) / 2; }
__host__ __device__ __forceinline__ int perm32(int rho) { const int n = rho >> 4, i = rho & 15; return 8 * (i >> 2) + 4 * n + (i & 3); }

struct Unit { int pm, pn, pb; };
struct Gemm { const bf16_t* A; const bf16_t* Bt; int K; const int* gidx; int lda, ldb; };

struct DenseOrder {
    int nM, nN, nwg, G, c;
    __device__ void init(int M, int N, int G_, int c_) { nM = M / BM; nN = N / BM; nwg = nM * nN; G = G_; c = c_; }
    __device__ bool next(int i, Unit& u) const {
        const long L = (long)i * G + c; if (L >= nwg) return false;
        int wgid = (int)L; { const int q = nwg / NXCD, r = nwg % NXCD, xcd = wgid % NXCD, off = wgid / NXCD; wgid = (xcd < r ? xcd * (q + 1) : r * (q + 1) + (xcd - r) * q) + off; }
        const int nig = WGM * nN, gid = wgid / nig, fm = gid * WGM, gsz = (nM - fm) < WGM ? (nM - fm) : WGM;
        u.pm = fm + ((wgid % nig) % gsz); u.pn = (wgid % nig) / gsz; u.pb = u.pn; return true;
    }
    __device__ __forceinline__ void a_ready(const Unit&) const {}
    __device__ __forceinline__ void done(const Unit&) const {}
};
struct ExpertOrder {
    int nN, nun, G, c;
    __device__ void init(int nN_, int G_, int c_) { nN = nN_; nun = 128 * nN_; G = G_; c = c_; }
    __device__ bool next(int i, Unit& u) const {
        const long L = (long)i * G + c; if (L >= nun) return false;
        int V = (int)L;
        if (G == 256) {
            const int x = c & 7, j = c >> 3, upx = 32, rpe = (8 * nN) / upx;
            const int e_ = 8 * (i / rpe) + x, r_ = (i % rpe) * upx + j;
            V = e_ * 8 * nN + r_;
        }
        const int per = 8 * nN, e = V / per, r = V % per, pml = r / nN, pn = r % nN;
        u.pm = ((pml >> 1) * 16 + e) * 2 + (pml & 1); u.pn = pn; u.pb = e * nN + pn; return true;
    }
    __device__ __forceinline__ void a_ready(const Unit&) const {}
    __device__ __forceinline__ void done(const Unit&) const {}
};

typedef float f32x2 __attribute__((ext_vector_type(2)));
typedef __bf16 bf16x2_t __attribute__((ext_vector_type(2)));
__device__ __forceinline__ unsigned pk2(float lo, float hi) { f32x2 v = {lo, hi}; bf16x2_t b = __builtin_convertvector(v, bf16x2_t); return __builtin_bit_cast(unsigned, b); }
__device__ __forceinline__ unsigned pk4_fp8(float a, float b, float c, float d) {
    a = __builtin_amdgcn_fmed3f(a, -448.f, 448.f); b = __builtin_amdgcn_fmed3f(b, -448.f, 448.f); c = __builtin_amdgcn_fmed3f(c, -448.f, 448.f); d = __builtin_amdgcn_fmed3f(d, -448.f, 448.f);
    int p = 0; p = __builtin_amdgcn_cvt_pk_fp8_f32(a, b, p, false); p = __builtin_amdgcn_cvt_pk_fp8_f32(c, d, p, true); return (unsigned)p;
}
typedef unsigned u32x2 __attribute__((ext_vector_type(2)));
typedef int i32x8 __attribute__((ext_vector_type(8)));
typedef int i32x4 __attribute__((ext_vector_type(4)));
constexpr float S5_SW16 = 4096.f, S5_SH = 64.f, S5_STU = 128.f, S5_STC = 16.f;
constexpr float FP8_SX = 8.f, FP8_SW = 256.f, FP8_INV = 1.f / (8.f * 256.f), FP8_SY = 64.f;
__device__ __forceinline__ float sigm(float x) { return __builtin_amdgcn_rcpf(1.f + __builtin_amdgcn_exp2f(-1.4426950408889634f * x)); }

constexpr float QSCALE = 0.125f * 1.4426950408889634f;
struct EpiProj {
    static constexpr bool PERM = true, AFTER_DRAIN = false;
    bf16_t *GLU, *Q; const float *qg, *kg;
    __device__ __forceinline__ void operator()(const f32x4 (&acc)[2][2][4][2], const Unit& u, int wr, int wc, int fr, int fq) const {
        const int row0 = u.pm * BM + wr * 64 + fr;
        if (u.pn < 4) {
            const int col0 = 128 * u.pn + 32 * wc + 8 * fq;
#pragma unroll
            for (int ai = 0; ai < 2; ++ai)
#pragma unroll
                for (int m = 0; m < 4; ++m) {
                    const f32x4 v0 = acc[ai][0][m][0], v1 = acc[ai][0][m][1], g0 = acc[ai][1][m][0], g1 = acc[ai][1][m][1];
                    u32x4 w; w.x = pk2(v0[0] * sigm(g0[0]), v0[1] * sigm(g0[1])); w.y = pk2(v0[2] * sigm(g0[2]), v0[3] * sigm(g0[3]));
                    w.z = pk2(v1[0] * sigm(g1[0]), v1[1] * sigm(g1[1])); w.w = pk2(v1[2] * sigm(g1[2]), v1[3] * sigm(g1[3]));
                    *(u32x4*)(GLU + (size_t)(row0 + ai * HALF + m * 16) * 512 + col0) = w;
                    asm volatile("" ::: "memory");
                }
        } else {
            const int t = (u.pn - 4) >> 1;
            const int hd = 4 * ((u.pn - 4) & 1) + wc;
            bf16_t* dst = Q + (size_t)t * (size_t)(8u << 20);
            const float* gp = (const float*)((uintptr_t)qg + (((uintptr_t)kg - (uintptr_t)qg) & (uintptr_t)(t == 0 ? 0 : ~(uintptr_t)0)));
            f32x4 gn[2][2];
#pragma unroll
            for (int bj = 0; bj < 2; ++bj) { gn[bj][0] = (f32x4){1.f, 1.f, 1.f, 1.f}; gn[bj][1] = gn[bj][0];
                if (t < 2) { gn[bj][0] = *(const f32x4*)(gp + 32 * bj + 8 * fq); gn[bj][1] = *(const f32x4*)(gp + 32 * bj + 8 * fq + 4); } }
#pragma unroll
            for (int ai = 0; ai < 2; ++ai)
#pragma unroll
                for (int m = 0; m < 4; ++m) {
                    float ss = 0.f;
#pragma unroll
                    for (int bj = 0; bj < 2; ++bj)
#pragma unroll
                        for (int n = 0; n < 2; ++n) { const f32x4 x = acc[ai][bj][m][n]; ss += (x[0] * x[0] + x[1] * x[1]) + (x[2] * x[2] + x[3] * x[3]); }
                    ss += __shfl_xor(ss, 16); ss += __shfl_xor(ss, 32);
                    float rs = 1.f;
                    if (t < 2) rs = rsqrtf(ss * (1.f / 64.f) + 1e-6f) * (t == 0 ? QSCALE : 1.f);
#pragma unroll
                    for (int bj = 0; bj < 2; ++bj) {
                        const f32x4 a = acc[ai][bj][m][0] * gn[bj][0] * rs, b = acc[ai][bj][m][1] * gn[bj][1] * rs;
                        u32x4 w; w.x = pk2(a[0], a[1]); w.y = pk2(a[2], a[3]); w.z = pk2(b[0], b[1]); w.w = pk2(b[2], b[3]);
                        const int row = row0 + ai * HALF + m * 16;
                        *(u32x4*)(dst + ((size_t)((row >> 12) * 8 + hd) * 4096 + (row & 4095)) * 64 + 32 * bj + 8 * fq) = w;
                    }
                }
        }
    }
};
__device__ __forceinline__ void fp8_pair_store(unsigned char* base, size_t off0, size_t off1, u32x2 q0, u32x2 q1, int fq) {
    const bool odd = fq & 1;
    const u32x2 send = odd ? q0 : q1, keep = odd ? q1 : q0;
    u32x2 recv; recv.x = (unsigned)__shfl_xor((int)send.x, 16); recv.y = (unsigned)__shfl_xor((int)send.y, 16);
    u32x4 w; if (odd) { w.x = recv.x; w.y = recv.y; w.z = keep.x; w.w = keep.y; } else { w.x = keep.x; w.y = keep.y; w.z = recv.x; w.w = recv.y; }
    *(u32x4*)(base + (odd ? off1 - 8 : off0)) = w;
}
struct EpiRes {
    static constexpr bool PERM = true, AFTER_DRAIN = false;
    const bf16_t* XN; const float* rms0; bf16_t* X; unsigned char* XQ;
    __device__ __forceinline__ void operator()(const f32x4 (&acc)[2][2][4][2], const Unit& u, int wr, int wc, int fr, int fq) const {
        const int row0 = u.pm * BM + wr * 64 + fr, col0 = u.pn * BM + wc * 32 + 8 * fq;
        u32x4 xv[2][4][2]; float rm[2][4];
#pragma unroll
        for (int ai = 0; ai < 2; ++ai)
#pragma unroll
            for (int m = 0; m < 4; ++m) { const int row = row0 + ai * HALF + m * 16; rm[ai][m] = rms0[row];
#pragma unroll
                for (int bj = 0; bj < 2; ++bj) xv[ai][m][bj] = *(const u32x4*)(XN + (size_t)row * 1024 + col0 + bj * HALF); }
#pragma unroll
        for (int ai = 0; ai < 2; ++ai)
#pragma unroll
            for (int m = 0; m < 4; ++m) { const size_t off = (size_t)(row0 + ai * HALF + m * 16) * 1024 + col0; const float r = rm[ai][m];
#pragma unroll
                for (int bj = 0; bj < 2; ++bj) { const u32x4 xn = xv[ai][m][bj];
                    const f32x4 xa = {__uint_as_float(xn.x << 16), __uint_as_float(xn.x & 0xffff0000u), __uint_as_float(xn.y << 16), __uint_as_float(xn.y & 0xffff0000u)};
                    const f32x4 xb = {__uint_as_float(xn.z << 16), __uint_as_float(xn.z & 0xffff0000u), __uint_as_float(xn.w << 16), __uint_as_float(xn.w & 0xffff0000u)};
                    const f32x4 a = xa * r + acc[ai][bj][m][0], b = xb * r + acc[ai][bj][m][1];
                    u32x4 w; w.x = pk2(a[0], a[1]); w.y = pk2(a[2], a[3]); w.z = pk2(b[0], b[1]); w.w = pk2(b[2], b[3]);
                    *(u32x4*)(X + off + bj * HALF) = w;
                    u32x2 q; q.x = pk4_fp8(a[0] * FP8_SX, a[1] * FP8_SX, a[2] * FP8_SX, a[3] * FP8_SX); q.y = pk4_fp8(b[0] * FP8_SX, b[1] * FP8_SX, b[2] * FP8_SX, b[3] * FP8_SX);
                    *(u32x2*)(XQ + off + bj * HALF) = q; } }
    }
};

struct EpiSwiGLU {
    static constexpr bool PERM = true, AFTER_DRAIN = false;
    unsigned char* H; const float* rsrow;
    __device__ __forceinline__ void operator()(const f32x4 (&acc)[2][2][4][2], const Unit& u, int wr, int wc, int fr, int fq) const {
        const int row0 = u.pm * BM + wr * 64 + fr, col0 = 128 * u.pn + 32 * wc + 8 * fq;
        float rsv[2][4];
#pragma unroll
        for (int ai = 0; ai < 2; ++ai)
#pragma unroll
            for (int m = 0; m < 4; ++m) rsv[ai][m] = rsrow[row0 + ai * HALF + m * 16];
#pragma unroll
        for (int ai = 0; ai < 2; ++ai) {
            u32x2 hq[4];
#pragma unroll
            for (int m = 0; m < 4; ++m) {
                const float rs = rsv[ai][m] * FP8_INV;
                const f32x4 g0 = acc[ai][0][m][0] * rs, g1 = acc[ai][0][m][1] * rs, u0 = acc[ai][1][m][0] * (rs * FP8_SX), u1 = acc[ai][1][m][1] * (rs * FP8_SX);
                hq[m].x = pk4_fp8(g0[0] * sigm(g0[0]) * u0[0], g0[1] * sigm(g0[1]) * u0[1], g0[2] * sigm(g0[2]) * u0[2], g0[3] * sigm(g0[3]) * u0[3]);
                hq[m].y = pk4_fp8(g1[0] * sigm(g1[0]) * u1[0], g1[1] * sigm(g1[1]) * u1[1], g1[2] * sigm(g1[2]) * u1[2], g1[3] * sigm(g1[3]) * u1[3]);
            }
#pragma unroll
            for (int m = 0; m < 4; m += 2) { const size_t off0 = (size_t)(row0 + ai * HALF + m * 16) * 1024 + col0; fp8_pair_store(H, off0, off0 + 16 * 1024, hq[m], hq[m + 1], fq); }
        }
    }
};

struct EpiDown {
    static constexpr bool PERM = true, AFTER_DRAIN = false;
    unsigned char* Y; const float* gate;
    __device__ __forceinline__ void operator()(const f32x4 (&acc)[2][2][4][2], const Unit& u, int wr, int wc, int fr, int fq) const {
        const int row0 = u.pm * BM + wr * 64 + fr, col0 = u.pn * BM + wc * 32 + 8 * fq;
        float gv[2][4];
#pragma unroll
        for (int ai = 0; ai < 2; ++ai)
#pragma unroll
            for (int m = 0; m < 4; ++m) gv[ai][m] = gate[row0 + ai * HALF + m * 16];
#pragma unroll
        for (int ai = 0; ai < 2; ++ai) {
            u32x2 yq[4][2];
#pragma unroll
            for (int m = 0; m < 4; ++m) { const float gs = gv[ai][m] * (FP8_INV * FP8_SY);
#pragma unroll
                for (int bj = 0; bj < 2; ++bj) { const f32x4 a = acc[ai][bj][m][0] * gs, b = acc[ai][bj][m][1] * gs;
                    yq[m][bj].x = pk4_fp8(a[0], a[1], a[2], a[3]); yq[m][bj].y = pk4_fp8(b[0], b[1], b[2], b[3]); } }
#pragma unroll
            for (int m = 0; m < 4; m += 2) { const size_t off0 = (size_t)(row0 + ai * HALF + m * 16) * 1024 + col0;
#pragma unroll
                for (int bj = 0; bj < 2; ++bj) fp8_pair_store(Y, off0 + bj * HALF, off0 + 16 * 1024 + bj * HALF, yq[m][bj], yq[m + 1][bj], fq); }
        }
    }
};

struct EpiGluRes {
    static constexpr bool PERM = true, AFTER_DRAIN = false;
    bf16_t* X; unsigned char* XQ;
    __device__ __forceinline__ void operator()(const f32x4 (&acc)[2][2][4][2], const Unit& u, int wr, int wc, int fr, int fq) const {
        const int row0 = u.pm * BM + wr * 64 + fr, col0 = 128 * u.pn + 32 * wc + 8 * fq;
        u32x2 xq[2][4];
        u32x4 ov[2][4];
#pragma unroll
        for (int ai = 0; ai < 2; ++ai)
#pragma unroll
            for (int m = 0; m < 4; ++m) ov[ai][m] = *(const u32x4*)(X + (size_t)(row0 + ai * HALF + m * 16) * 1024 + col0);
#pragma unroll
        for (int ai = 0; ai < 2; ++ai)
#pragma unroll
            for (int m = 0; m < 4; ++m) { const size_t off = (size_t)(row0 + ai * HALF + m * 16) * 1024 + col0; bf16_t* p = X + off;
                const u32x4 o = ov[ai][m]; const f32x4 v0 = acc[ai][0][m][0] * FP8_INV, v1 = acc[ai][0][m][1] * FP8_INV, g0 = acc[ai][1][m][0] * FP8_INV, g1 = acc[ai][1][m][1] * FP8_INV;
                const float y0 = __uint_as_float(o.x << 16) + v0[0] * sigm(g0[0]), y1 = __uint_as_float(o.x & 0xffff0000u) + v0[1] * sigm(g0[1]);
                const float y2 = __uint_as_float(o.y << 16) + v0[2] * sigm(g0[2]), y3 = __uint_as_float(o.y & 0xffff0000u) + v0[3] * sigm(g0[3]);
                const float y4 = __uint_as_float(o.z << 16) + v1[0] * sigm(g1[0]), y5 = __uint_as_float(o.z & 0xffff0000u) + v1[1] * sigm(g1[1]);
                const float y6 = __uint_as_float(o.w << 16) + v1[2] * sigm(g1[2]), y7 = __uint_as_float(o.w & 0xffff0000u) + v1[3] * sigm(g1[3]);
                u32x4 w; w.x = pk2(y0, y1); w.y = pk2(y2, y3); w.z = pk2(y4, y5); w.w = pk2(y6, y7);
                *(u32x4*)p = w;
                xq[ai][m].x = pk4_fp8(y0 * FP8_SX, y1 * FP8_SX, y2 * FP8_SX, y3 * FP8_SX); xq[ai][m].y = pk4_fp8(y4 * FP8_SX, y5 * FP8_SX, y6 * FP8_SX, y7 * FP8_SX); }
#pragma unroll
        for (int ai = 0; ai < 2; ++ai)
#pragma unroll
            for (int m = 0; m < 4; m += 2) { const size_t off0 = (size_t)(row0 + ai * HALF + m * 16) * 1024 + col0; fp8_pair_store(XQ, off0, off0 + 16 * 1024, xq[ai][m], xq[ai][m + 1], fq); }
    }
};
template <class Epi, class Sched, bool ALIGN_EPI = false, bool SP2 = false, bool GATHER = false, bool FP8 = false>
__device__ __forceinline__ void gemm_phase(PG8_LAS unsigned char* lds, const Gemm g, const Sched& S, const Epi& E) {
    const int tid = threadIdx.x, wid = __builtin_amdgcn_readfirstlane(tid >> 6), lane = tid & 63, wr = wid >> 2, wc = wid & 3, fr = lane & 15, fq = lane >> 4;
    const int K = g.K, nt = K / BK;
    unsigned voffA[2], voffB[2];
#pragma unroll
    for (int i = 0; i < 2; ++i) { int R, C; stage_rc(tid * 16 + i * 8192, R, C); const int Rb = Epi::PERM ? ((R & ~31) + perm32(R & 31)) : R;
        voffA[i] = (unsigned)(R * g.lda + C) * 2u; voffB[i] = (unsigned)(Rb * g.ldb + C) * 2u; }
    const size_t kstep = (size_t)(BK * 2);
    const size_t hstepA = (size_t)HALF * g.lda * 2, hstepB = (size_t)HALF * g.ldb * 2;
    const size_t tstepA = 2 * hstepA, tstepB = 2 * hstepB;
    const unsigned ldsw = (unsigned)wid * 1024u;
    const int aoff = lds_byte(wr * 64 + fr, fq * 8), boff = lds_byte(wc * 32 + fr, fq * 8);
    int aof8[2] = {0, 0}, bof8[2] = {0, 0};
    if constexpr (FP8) {
#pragma unroll
        for (int c = 0; c < 2; ++c) { const int cb = 32 * fq + 16 * (c ^ (fq & 1)); aof8[c] = lds_byte(wr * 64 + fr, cb >> 1); bof8[c] = lds_byte(wc * 32 + fr, cb >> 1); } }
#define PG8_SA(b, h) (((b) * 2 + (h)) * HTB)
#define PG8_SB(b, h) ((4 + (b) * 2 + (h)) * HTB)
#define PG8_STAGE(bufoff, gbase, voff) do { _Pragma("unroll") for (int _i = 0; _i < 2; ++_i) \
        __builtin_amdgcn_global_load_lds((const unsigned*)((const char*)(gbase) + (voff)[_i]), (PG8_LAS unsigned*)(lds + (bufoff) + ldsw + _i * 8192), 16, 0, 0); } while (0)
#define PG8_STAGE_A(bufoff, gptr, h, nsel) do { if constexpr (GATHER) { const unsigned _o[2] = {(nsel) ? nOA[h][0] : oA[h][0], (nsel) ? nOA[h][1] : oA[h][1]}; PG8_STAGE(bufoff, gptr, _o); } \
        else { PG8_STAGE(bufoff, (gptr) + ((h) ? hstepA : 0), voffA); } } while (0)
#define PG8_GOFF(dst, u) do { if constexpr (GATHER) { _Pragma("unroll") for (int _h = 0; _h < 2; ++_h) _Pragma("unroll") for (int _i = 0; _i < 2; ++_i) { \
        (dst)[_h][_i] = (unsigned)g.gidx[(u).pm * BM + _h * HALF + gR[_i]] * (unsigned)(g.lda * 2) + gC[_i]; asm volatile("" : "+v"((dst)[_h][_i])); } } } while (0)
#define PG8_LDA(dst, b, h) do { _Pragma("unroll") for (int m = 0; m < 4; ++m) _Pragma("unroll") for (int k = 0; k < 2; ++k) dst[m][k] = *(const PG8_LAS bf16x8*)(lds + PG8_SA(b, h) + (FP8 ? aof8[k] : aoff + k * 1024) + m * 2048); } while (0)
#define PG8_LDB(dst, b, h) do { _Pragma("unroll") for (int n = 0; n < 2; ++n) _Pragma("unroll") for (int k = 0; k < 2; ++k) dst[n][k] = *(const PG8_LAS bf16x8*)(lds + PG8_SB(b, h) + (FP8 ? bof8[k] : boff + k * 1024) + n * 2048); } while (0)
#define PG8_CAT8(f) __builtin_shufflevector(__builtin_bit_cast(i32x4, (f)[0]), __builtin_bit_cast(i32x4, (f)[1]), 0, 1, 2, 3, 4, 5, 6, 7)
#define PG8_MMA(ai, bj, At, Bt) do { __builtin_amdgcn_s_setprio(1); _Pragma("unroll") for (int m = 0; m < 4; ++m) _Pragma("unroll") for (int n = 0; n < 2; ++n) { \
        if constexpr (FP8) { const i32x8 b8_ = PG8_CAT8(Bt[n]), a8_ = PG8_CAT8(At[m]); asm volatile("v_mfma_f32_16x16x128_f8f6f4 %0, %1, %2, %0" : "+v"(acc[ai][bj][m][n]) : "v"(b8_), "v"(a8_)); } \
        else { _Pragma("unroll") for (int k = 0; k < 2; ++k) acc[ai][bj][m][n] = __builtin_amdgcn_mfma_f32_16x16x32_bf16(Bt[n][k], At[m][k], acc[ai][bj][m][n], 0, 0, 0); } } \
        __builtin_amdgcn_s_setprio(0); } while (0)
#define PG8_WAIT_V(n) asm volatile("s_waitcnt vmcnt(" #n ")" ::: "memory")
#define PG8_WAIT_L(n) asm volatile("s_waitcnt lgkmcnt(" #n ")" ::: "memory")
#define PG8_BAR __builtin_amdgcn_s_barrier()
#define PG8_SCHED __builtin_amdgcn_sched_barrier(0)
    Unit cur, nxt; int ui = 0;
    if (!S.next(0, cur)) return;
    unsigned oA[2][2], nOA[2][2]; int gR[2]; unsigned gC[2];
    if constexpr (GATHER) { static_assert(SP2, "GATHER is wired into the SP2 loop only");
#pragma unroll
        for (int i = 0; i < 2; ++i) { int R, Cc; stage_rc(tid * 16 + i * 8192, R, Cc); gR[i] = R; gC[i] = (unsigned)Cc * 2u; } }
    PG8_GOFF(oA, cur);
    f32x4 acc[2][2][4][2];
#pragma unroll
    for (int a = 0; a < 2; ++a)
#pragma unroll
        for (int b = 0; b < 2; ++b)
#pragma unroll
            for (int m = 0; m < 4; ++m)
#pragma unroll
                for (int n = 0; n < 2; ++n) acc[a][b][m][n] = (f32x4){0.f, 0.f, 0.f, 0.f};
    bf16x8 At[4][2], B0[2][2], B1[2][2];
    const char* cA = (const char*)g.A + (GATHER ? (size_t)0 : (size_t)cur.pm * tstepA); const char* cB = (const char*)g.Bt + (size_t)cur.pb * tstepB;
    S.a_ready(cur);
    if constexpr (SP2) {
        PG8_STAGE(PG8_SB(0, 0), cB, voffB); PG8_STAGE(PG8_SB(0, 1), cB + hstepB, voffB); PG8_STAGE_A(PG8_SA(0, 0), cA, 0, false); PG8_STAGE_A(PG8_SA(0, 1), cA, 1, false);
        if (wr == 1) PG8_BAR;
        PG8_WAIT_V(2); PG8_BAR;
        PG8_STAGE(PG8_SB(1, 0), cB + kstep, voffB); PG8_STAGE_A(PG8_SA(1, 0), cA + kstep, 0, false); PG8_STAGE(PG8_SB(1, 1), cB + hstepB + kstep, voffB);
        PG8_WAIT_V(6); PG8_BAR;
    } else {
        PG8_STAGE(PG8_SB(0, 0), cB, voffB); PG8_STAGE(PG8_SA(0, 0), cA, voffA); PG8_STAGE(PG8_SB(0, 1), cB + hstepB, voffB); PG8_STAGE(PG8_SA(0, 1), cA + hstepA, voffA);
        if (wr == 1) PG8_BAR;
        PG8_WAIT_V(4); PG8_BAR;
        PG8_STAGE(PG8_SB(1, 0), cB + kstep, voffB); PG8_STAGE(PG8_SA(1, 0), cA + kstep, voffA); PG8_STAGE(PG8_SB(1, 1), cB + hstepB + kstep, voffB);
        PG8_WAIT_V(6); PG8_BAR;
    }
    for (;;) {
        const bool has_next = S.next(ui + 1, nxt);
        const char* nA = has_next ? (const char*)g.A + (GATHER ? (size_t)0 : (size_t)nxt.pm * tstepA) : cA; const char* nB = has_next ? (const char*)g.Bt + (size_t)nxt.pb * tstepB : cB;
        if constexpr (GATHER) { if (has_next) { PG8_GOFF(nOA, nxt); } else {
#pragma unroll
            for (int _h = 0; _h < 2; ++_h) { nOA[_h][0] = oA[_h][0]; nOA[_h][1] = oA[_h][1]; } } }
        for (int t = 0; t < nt; t += 2) {
            const bool last = (t == nt - 2); const bool tail = SP2 && last && !has_next;
            const char* a1 = cA + (size_t)(t + 1) * kstep;
            const char* a2 = last ? nA : cA + (size_t)(t + 2) * kstep; const char* b2 = last ? nB : cB + (size_t)(t + 2) * kstep;
            const char* a3 = a2 + kstep; const char* b3 = b2 + kstep;
            if (last && has_next) S.a_ready(nxt);
            if constexpr (SP2) {
            PG8_LDB(B0, 0, 0); PG8_LDB(B1, 0, 1); PG8_SCHED; PG8_LDA(At, 0, 0); PG8_STAGE_A(PG8_SA(1, 1), a1, 1, false);
            PG8_WAIT_V(8); PG8_WAIT_L(0); PG8_BAR; PG8_MMA(0, 0, At, B0); PG8_MMA(0, 1, At, B1); PG8_BAR; PG8_SCHED;
            PG8_LDA(At, 0, 1); if (!tail) { PG8_STAGE(PG8_SB(0, 0), b2, voffB); PG8_STAGE(PG8_SB(0, 1), b2 + hstepB, voffB); PG8_STAGE_A(PG8_SA(0, 0), a2, 0, last); }
            if (tail) PG8_WAIT_V(2); else PG8_WAIT_V(8); PG8_WAIT_L(0); PG8_BAR; PG8_MMA(1, 0, At, B0); PG8_MMA(1, 1, At, B1); PG8_BAR; PG8_SCHED;
            PG8_LDB(B0, 1, 0); PG8_LDB(B1, 1, 1); PG8_SCHED; PG8_LDA(At, 1, 0); if (!tail) { PG8_STAGE_A(PG8_SA(0, 1), a2, 1, last); }
            if (tail) PG8_WAIT_V(0); else PG8_WAIT_V(8); PG8_WAIT_L(0); PG8_BAR; PG8_MMA(0, 0, At, B0); PG8_MMA(0, 1, At, B1); PG8_BAR; PG8_SCHED;
            PG8_LDA(At, 1, 1); if (!tail) { PG8_STAGE(PG8_SB(1, 0), b3, voffB); PG8_STAGE(PG8_SB(1, 1), b3 + hstepB, voffB); PG8_STAGE_A(PG8_SA(1, 0), a3, 0, last); }
            if (tail) PG8_WAIT_V(0); else PG8_WAIT_V(8); PG8_WAIT_L(0); PG8_BAR; PG8_MMA(1, 0, At, B0); PG8_MMA(1, 1, At, B1); PG8_BAR; PG8_SCHED;
            } else {
            PG8_LDB(B0, 0, 0); PG8_SCHED; PG8_LDA(At, 0, 0); PG8_STAGE(PG8_SA(1, 1), a1 + hstepA, voffA);
            PG8_WAIT_L(8); PG8_BAR; PG8_WAIT_L(0); PG8_MMA(0, 0, At, B0); PG8_BAR; PG8_SCHED;
            PG8_LDB(B1, 0, 1); PG8_STAGE(PG8_SB(0, 0), b2, voffB);
            PG8_BAR; PG8_WAIT_L(0); PG8_MMA(0, 1, At, B1); PG8_BAR;
            PG8_LDA(At, 0, 1); PG8_STAGE(PG8_SA(0, 0), a2, voffA);
            PG8_BAR; PG8_WAIT_L(0); PG8_MMA(1, 0, At, B0); PG8_BAR; PG8_SCHED;
            PG8_STAGE(PG8_SB(0, 1), b2 + hstepB, voffB);
            PG8_WAIT_V(6); PG8_BAR; PG8_MMA(1, 1, At, B1); PG8_BAR;
            PG8_LDB(B0, 1, 0); PG8_SCHED; PG8_LDA(At, 1, 0); PG8_STAGE(PG8_SA(0, 1), a2 + hstepA, voffA);
            PG8_WAIT_L(8); PG8_BAR; PG8_WAIT_L(0); PG8_MMA(0, 0, At, B0); PG8_BAR; PG8_SCHED;
            PG8_LDB(B1, 1, 1); PG8_STAGE(PG8_SB(1, 0), b3, voffB);
            PG8_BAR; PG8_WAIT_L(0); PG8_MMA(0, 1, At, B1); PG8_BAR;
            PG8_LDA(At, 1, 1); PG8_STAGE(PG8_SA(1, 0), a3, voffA);
            PG8_BAR; PG8_WAIT_L(0); PG8_MMA(1, 0, At, B0); PG8_BAR; PG8_SCHED;
            PG8_STAGE(PG8_SB(1, 1), b3 + hstepB, voffB);
            PG8_WAIT_V(6); PG8_BAR; PG8_MMA(1, 1, At, B1); PG8_BAR;
            }
        }
        if constexpr (FP8) asm volatile("s_nop 15\n\ts_nop 7" ::: "memory");
        if constexpr (ALIGN_EPI) { if (wr == 0) PG8_BAR; }
        if constexpr (!Epi::AFTER_DRAIN) { E(acc, cur, wr, wc, fr, fq); S.done(cur); }
        if (!has_next) break;
#pragma unroll
        for (int a = 0; a < 2; ++a)
#pragma unroll
            for (int b = 0; b < 2; ++b)
#pragma unroll
                for (int m = 0; m < 4; ++m)
#pragma unroll
                    for (int n = 0; n < 2; ++n) acc[a][b][m][n] = (f32x4){0.f, 0.f, 0.f, 0.f};
        cur = nxt; cA = nA; cB = nB; ++ui;
        if constexpr (GATHER) {
#pragma unroll
            for (int _h = 0; _h < 2; ++_h) { oA[_h][0] = nOA[_h][0]; oA[_h][1] = nOA[_h][1]; } }
        if constexpr (ALIGN_EPI) { if (wr == 1) PG8_BAR; }
    }
    PG8_WAIT_V(0);
    if constexpr (!ALIGN_EPI) { if (wr == 0) PG8_BAR; }
    PG8_BAR;
    if constexpr (Epi::AFTER_DRAIN) { E.fused(acc, cur, wr, wc, fr, fq, lds, wid, lane); S.done(cur); }
#undef PG8_SA
#undef PG8_SB
#undef PG8_STAGE
#undef PG8_LDA
#undef PG8_STAGE_A
#undef PG8_GOFF
#undef PG8_LDB
#undef PG8_MMA
#undef PG8_CAT8
#undef PG8_WAIT_V
#undef PG8_WAIT_L
#undef PG8_BAR
#undef PG8_SCHED
}
}

constexpr int NB = 4, S = 4096, D = 1024, T = NB * S;
constexpr int CONV_CH = 512, CONV_W = 31, NH = 8, INC = 2560;
constexpr int SG = 64, SC = 16, SP = 64;
constexpr int NE = 16, CAP = 512, EH = 1024, MR = NB * NE * CAP;
constexpr float EPS = 1e-6f;
constexpr int NWAVES = 8, NTHR = NWAVES * 64;

constexpr size_t MiB = 1u << 20;
constexpr size_t WS_CTL = 0, CTL_ZERO_BYTES = 64 * 1024;
constexpr size_t WS_RB = 128 * 1024;
constexpr size_t WS_RMS0 = 512 * 1024;
constexpr size_t WS_AFF = 1 * MiB, WS_IDX = 2 * MiB, WS_GATE = 2 * MiB + 512 * 1024, WS_SLOT = 3 * MiB;
constexpr size_t WS_RS = 2 * MiB + 256 * 1024, WS_RSROW = 2 * MiB + 768 * 1024;
constexpr size_t WS_WIN = 4 * MiB, WS_WOUT = 10 * MiB, WS_WGLU = 12 * MiB;
constexpr size_t WS_WEXP = 16 * MiB, WEXP_LAYER = 96 * MiB, WEXP_GU = 0, WEXP_DN = 64 * MiB;
constexpr size_t WS_XQ = WS_WEXP + 32 * MiB;
constexpr size_t WS_XN = 208 * MiB, WS_MIXED = 240 * MiB;
constexpr size_t WS_PROJ = 272 * MiB;
constexpr size_t WS_H = 336 * MiB;
constexpr size_t WS_XA = 404 * MiB, WS_XB = 436 * MiB;
constexpr size_t WS_END = 492 * MiB;
constexpr int CW_BAR = 1024, CW_Q0 = 64;

constexpr int SCRATCH_BYTES = 143360;
constexpr int LDSCTL_OFF = SCRATCH_BYTES;
constexpr int LDS_BYTES = 147456;

#define GAS __attribute__((address_space(1)))
#define LAS __attribute__((address_space(3)))
typedef unsigned short bf16;
typedef unsigned v4u __attribute__((ext_vector_type(4)));
typedef unsigned v2u __attribute__((ext_vector_type(2)));
typedef float f32x4 __attribute__((ext_vector_type(4)));
typedef float f32x2 __attribute__((ext_vector_type(2)));
using pg8::pk2;
using pg8::sigm;
__device__ __forceinline__ float bf2f(unsigned short h) { return __uint_as_float(((unsigned)h) << 16); }
__device__ __forceinline__ float bflo(unsigned w) { return __uint_as_float(w << 16); }
__device__ __forceinline__ float bfhi(unsigned w) { return __uint_as_float(w & 0xffff0000u); }
__device__ __forceinline__ float wave_sum(float v) {
#pragma unroll
    for (int o = 1; o < 64; o <<= 1) v += __shfl_xor(v, o);
    return v;
}

#define XB_TMO      128
#define XB_XCNT(j)  (256  + 64 * (j))
#define XB_XSUB(j)  (1280 + 64 * (j))
#define XB_XGEN(j)  (2304 + 64 * (j))
#define XB_TOP      3328
#define XB_TOPGEN   3392
#define XCD_BAR_WORDS 3456
#define XB_SPIN_CAP (1u << 18)
__device__ __forceinline__ unsigned xb_ld(unsigned* p)              { return __hip_atomic_load(p, __ATOMIC_RELAXED, __HIP_MEMORY_SCOPE_AGENT); }
__device__ __forceinline__ unsigned xb_add(unsigned* p, unsigned v) { return __hip_atomic_fetch_add(p, v, __ATOMIC_RELAXED, __HIP_MEMORY_SCOPE_AGENT); }
__device__ __forceinline__ unsigned xb_xcc_id() { return (unsigned)__builtin_amdgcn_s_getreg((3 << 11) | 20) & 0xFu; }
#define XB_SPIN(cond, bar) do { unsigned _sp = 0; while (cond) { __builtin_amdgcn_s_sleep(1); \
    if ((++_sp & 255u) == 0u) { if (xb_ld(&(bar)[XB_TMO])) break; if (_sp > XB_SPIN_CAP) { atomicAdd(&(bar)[XB_TMO], 1u); break; } } } } while (0)
#define XB_LSUB(j)  (3456 + 64 * (j))
#define XB_LGEN(j)  (4480 + 64 * (j))
struct XcdBarrier { unsigned* bar; unsigned x; volatile LAS unsigned* st; unsigned rank; };
__device__ __forceinline__ XcdBarrier xcd_barrier_post(unsigned* bar, volatile LAS unsigned* st) {
    XcdBarrier b; b.bar = bar; b.x = xb_xcc_id(); b.st = st; b.rank = 0u;
    if (threadIdx.x == 0) b.rank = xb_add(&bar[XB_XCNT(b.x)], 1u);
    return b;
}
__device__ __forceinline__ void xcd_barrier_complete(unsigned* bar, unsigned x, unsigned& nloc, unsigned& nx) {
    const unsigned G = gridDim.x * gridDim.y * gridDim.z;
    unsigned sum, cnt, mine, sp = 0u;
    for (;;) {
        sum = 0u; cnt = 0u; mine = 0u;
#pragma unroll
        for (unsigned j = 0; j < 16; ++j) { const unsigned c = xb_ld(&bar[XB_XCNT(j)]); sum += c; cnt += (c > 0u) ? 1u : 0u; mine = (j == x) ? c : mine; }
        if (sum == G) break;
        __builtin_amdgcn_s_sleep(1);
        if ((++sp & 255u) == 0u) { if (xb_ld(&bar[XB_TMO])) break; if (sp > XB_SPIN_CAP) { atomicAdd(&bar[XB_TMO], 1u); break; } }
    }
    nloc = mine > 0u ? mine : 1u; nx = cnt > 0u ? cnt : 1u;
}
__device__ __forceinline__ void xcd_barrier(const XcdBarrier& b) {
    asm volatile("s_waitcnt vmcnt(0)" ::: "memory");
    __syncthreads();
    if (threadIdx.x == 0) {
        unsigned* bar = b.bar;
        __builtin_amdgcn_s_waitcnt(0);
        unsigned nloc = b.st[0], nx = b.st[1];
        if (nloc == 0u) { xcd_barrier_complete(bar, b.x, nloc, nx); b.st[0] = nloc; b.st[1] = nx; }
        const unsigned old = xb_add(&bar[XB_XSUB(b.x)], 1u);
        const unsigned gen = old / nloc;
        if (old + 1u == (gen + 1u) * nloc) {
            __builtin_amdgcn_fence(__ATOMIC_RELEASE, "agent");
            asm volatile("s_waitcnt vmcnt(0)" ::: "memory");
            const unsigned og = xb_add(&bar[XB_TOP], 1u);
            const unsigned tg = og / nx;
            if (og + 1u == (tg + 1u) * nx) xb_add(&bar[XB_TOPGEN], 1u);
            else XB_SPIN(xb_ld(&bar[XB_TOPGEN]) == tg, bar);
            __builtin_amdgcn_fence(__ATOMIC_ACQUIRE, "agent");
            xb_add(&bar[XB_XGEN(b.x)], 1u);
            asm volatile("s_waitcnt vmcnt(0)" ::: "memory");
        } else {
            XB_SPIN(xb_ld(&bar[XB_XGEN(b.x)]) == gen, bar);
            __builtin_amdgcn_fence(__ATOMIC_ACQUIRE, "agent");
            asm volatile("s_waitcnt vmcnt(0)" ::: "memory");
        }
    }
    __syncthreads();
}

__device__ __forceinline__ void xcd_local_barrier(const XcdBarrier& b) {
    asm volatile("s_waitcnt vmcnt(0)" ::: "memory");
    __syncthreads();
    if (threadIdx.x == 0) {
        unsigned* bar = b.bar;
        const unsigned nloc = b.st[0];
        const unsigned old = xb_add(&bar[XB_LSUB(b.x)], 1u);
        const unsigned gen = old / nloc;
        if (old + 1u == (gen + 1u) * nloc) xb_add(&bar[XB_LGEN(b.x)], 1u);
        else XB_SPIN(xb_ld(&bar[XB_LGEN(b.x)]) == gen, bar);
        __builtin_amdgcn_fence(__ATOMIC_ACQUIRE, "agent");
        asm volatile("s_waitcnt vmcnt(0)" ::: "memory");
    }
    __syncthreads();
}

struct Args {
    const float* in[26]; float* out; unsigned char* ws; int ph_lo, ph_hi;
};
struct Ctx { LAS unsigned char* lds; int tid, lane, wave, vcu, G; };

__device__ __forceinline__ int rowmap(int kind, int half, int n) {
    if (kind == 0) {
        if (n < 1024) { const int hf = n >> 9, r = n & 511; return 256 * (r >> 7) + 128 * hf + (r & 127); }
        const int pn = n >> 8, w = n & 255, wc = w >> 6, bj = (w >> 5) & 1, j = w & 31; return 256 * pn + 128 * bj + 32 * wc + j;
    }
    if (kind == 2) { const int hf = n >> 10, r = n & 1023; return 256 * (r >> 7) + 128 * hf + (r & 127); }
    if (kind == 3) return 256 * (n >> 7) + 128 * half + (n & 127);
    return n;
}
struct ConvDesc { const float* src; bf16* dst; const float* gsc; int N, kind, half, k0, n0, fp8; };
__device__ __forceinline__ bool conv_desc(const Args& a, int it, ConvDesc& d) {
    constexpr int I_IN = 16 * 40, I_OUT = 256, I_GLU = 16 * 32, I_EXP = 2 * 16 * 3 * 256;
    if (it >= I_IN + I_OUT + I_GLU + I_EXP) return false;
    unsigned char* ws = a.ws; int r = it, kb, nb; d.gsc = nullptr; d.fp8 = 0;
    if (r < I_IN) { d.src = a.in[2]; d.N = INC; d.dst = (bf16*)(ws + WS_WIN); d.kind = 0; d.half = 0; d.gsc = a.in[1]; kb = r / 40; nb = r % 40; }
    else if ((r -= I_IN) < I_OUT) { d.src = a.in[9]; d.N = D; d.dst = (bf16*)(ws + WS_WOUT); d.kind = 1; d.half = 0; kb = r >> 4; nb = r & 15; }
    else if ((r -= I_OUT) < I_GLU) { d.src = a.in[19]; d.N = 2 * D; d.dst = (bf16*)(ws + WS_WGLU); d.kind = 2; d.half = 0; d.fp8 = 1; kb = r >> 5; nb = r & 31; }
    else { r -= I_GLU; const int mat = r >> 8, tile = r & 255, layer = mat / 48, rem = mat % 48, e = rem / 3, which = rem % 3;
        d.src = a.in[23 + which] + ((size_t)layer * NE + e) * (size_t)D * EH; d.N = EH;
        d.dst = (bf16*)(ws + WS_WEXP + layer * WEXP_LAYER + (which == 2 ? WEXP_DN + (size_t)e * MiB : WEXP_GU + (size_t)e * 2 * MiB)); d.fp8 = 1;
        d.kind = which == 2 ? 1 : 3; d.half = which; kb = tile >> 4; nb = tile & 15; if (which != 2) d.gsc = a.in[20] + (size_t)layer * D; }
    d.k0 = 64 * kb; d.n0 = 64 * nb; return true;
}
__device__ __forceinline__ void conv_load(const ConvDesc& d, f32x4 (&v)[16], int lane) {
    const float* p = d.src + (size_t)(d.k0 + (lane >> 4)) * d.N + d.n0 + 4 * (lane & 15);
#pragma unroll
    for (int it = 0; it < 16; ++it) v[it] = *(const f32x4*)(p + (size_t)(4 * it) * d.N);
}
__device__ __forceinline__ void conv_store(const ConvDesc& d, const f32x4 (&v)[16], LAS float* scr, int lane) {
#pragma unroll
    for (int it = 0; it < 16; ++it) { const int kk = 4 * it + (lane >> 4), nn = 4 * (lane & 15); const float gs = (d.gsc ? d.gsc[d.k0 + kk] : 1.f) * (d.fp8 ? pg8::FP8_SW : 1.f);
        scr[kk * 65 + nn] = v[it][0] * gs; scr[kk * 65 + nn + 1] = v[it][1] * gs; scr[kk * 65 + nn + 2] = v[it][2] * gs; scr[kk * 65 + nn + 3] = v[it][3] * gs; }
    asm volatile("s_waitcnt lgkmcnt(0)" ::: "memory");
    const int kc = lane & 7;
#pragma unroll
    for (int jt = 0; jt < 8; ++jt) {
        const int nl = 8 * jt + (lane >> 3);
        const LAS float* s = scr + (8 * kc) * 65 + nl;
        if (d.fp8) { v2u o; o.x = pg8::pk4_fp8(s[0], s[65], s[2 * 65], s[3 * 65]); o.y = pg8::pk4_fp8(s[4 * 65], s[5 * 65], s[6 * 65], s[7 * 65]);
            *(v2u*)((unsigned char*)d.dst + (size_t)rowmap(d.kind, d.half, d.n0 + nl) * 1024 + d.k0 + 8 * kc) = o; }
        else { v4u o; o.x = pk2(s[0], s[65]); o.y = pk2(s[2 * 65], s[3 * 65]); o.z = pk2(s[4 * 65], s[5 * 65]); o.w = pk2(s[6 * 65], s[7 * 65]);
            *(v4u*)(d.dst + (size_t)rowmap(d.kind, d.half, d.n0 + nl) * 1024 + d.k0 + 8 * kc) = o; }
    }
    asm volatile("s_waitcnt lgkmcnt(0)" ::: "memory");
}
__device__ __forceinline__ void rms_row_bf16(const float* __restrict__ xrow, const float* __restrict__ g, bf16* __restrict__ orow, int lane) {
    const f32x4* xr = (const f32x4*)xrow + lane;
    f32x4 v[4]; float s = 0.f;
#pragma unroll
    for (int j = 0; j < 4; ++j) { v[j] = xr[64 * j]; s += (v[j][0] * v[j][0] + v[j][1] * v[j][1]) + (v[j][2] * v[j][2] + v[j][3] * v[j][3]); }
    const float r = rsqrtf(wave_sum(s) * (1.f / D) + EPS);
#pragma unroll
    for (int j = 0; j < 4; ++j) { const f32x4 w = ((const f32x4*)g)[lane + 64 * j]; v2u o; o.x = pk2(v[j][0] * r * w[0], v[j][1] * r * w[1]); o.y = pk2(v[j][2] * r * w[2], v[j][3] * r * w[3]); ((v2u*)orow)[lane + 64 * j] = o; }
}
constexpr int CONV_NITEMS = 25984, CONV_FIRST_Q = 640, CW_P1DONE = 128;
__device__ __forceinline__ void conv_drain(const Ctx& C, const Args& a, bool until_flag) {
    LAS float* scr = (LAS float*)(C.lds + C.wave * 16640);
    unsigned* ctl = (unsigned*)(a.ws + WS_CTL);
    LAS int* qs = (LAS int*)(C.lds + 8 * 16640);
    ConvDesc dA; f32x4 vA[16];
    for (;;) {
        if (C.tid == 0) {
            int v = -1;
            if (!(until_flag && __hip_atomic_load(ctl + CW_P1DONE, __ATOMIC_RELAXED, __HIP_MEMORY_SCOPE_AGENT) != 0u))
                v = CONV_FIRST_Q + (int)__hip_atomic_fetch_add(ctl + CW_Q0, 8u, __ATOMIC_RELAXED, __HIP_MEMORY_SCOPE_AGENT);
            qs[0] = v;
        }
        __syncthreads();
        const int base = qs[0];
        __syncthreads();
        if (base < 0 || base >= CONV_NITEMS) break;
        if (conv_desc(a, base + C.wave, dA)) { conv_load(dA, vA, C.lane); conv_store(dA, vA, scr, C.lane); }
    }
}
__device__ __forceinline__ void p0_prologue(const Ctx& C, const Args& a) {
    LAS float* scr = (LAS float*)(C.lds + C.wave * 16640);
    const int gw = C.vcu * NWAVES + C.wave, NGW = C.G * NWAVES;
    unsigned char* ws = a.ws;
    {
        const float* x = a.in[0]; bf16* XN = (bf16*)(ws + WS_XN); float* RMS0 = (float*)(ws + WS_RMS0); const int lane = C.lane;
        auto LOADR = [&](f32x4 (&v)[4], int m) __attribute__((always_inline)) { const f32x4* xr = (const f32x4*)(x + (size_t)m * D) + lane;
#pragma unroll
            for (int j = 0; j < 4; ++j) v[j] = xr[64 * j]; };
        auto PROC = [&](const f32x4 (&v)[4], int m) __attribute__((always_inline)) { float s = 0.f;
#pragma unroll
            for (int j = 0; j < 4; ++j) s += (v[j][0] * v[j][0] + v[j][1] * v[j][1]) + (v[j][2] * v[j][2] + v[j][3] * v[j][3]);
            const float ms = wave_sum(s) * (1.f / D) + EPS, r = rsqrtf(ms);
            if (lane == 0) RMS0[m] = ms * r;
#pragma unroll
            for (int j = 0; j < 4; ++j) { v2u o; o.x = pk2(v[j][0] * r, v[j][1] * r); o.y = pk2(v[j][2] * r, v[j][3] * r); ((v2u*)(XN + (size_t)m * D))[lane + 64 * j] = o; } };
        f32x4 va[4], vb[4]; int m = gw;
        if (m < T) LOADR(va, m);
        for (; m < T; m += 2 * NGW) { if (m + NGW < T) LOADR(vb, m + NGW); PROC(va, m); if (m + 2 * NGW < T) LOADR(va, m + 2 * NGW); if (m + NGW < T) PROC(vb, m + NGW); }
    }
    ConvDesc dA; f32x4 vA[16];
    for (int it = C.wave * C.G + C.vcu; it < CONV_FIRST_Q; it += NGW) if (conv_desc(a, it, dA)) { conv_load(dA, vA, C.lane); conv_store(dA, vA, scr, C.lane); }
}

__device__ __forceinline__ void conv_phase(const Ctx& C, const Args& a) {
    const bf16* GLU = (const bf16*)(a.ws + WS_PROJ);
    bf16* MIXED = (bf16*)(a.ws + WS_MIXED);
    const float* cw = a.in[3]; const float* cb = a.in[4]; const float* lg = a.in[5]; const float* lb = a.in[6];
    LAS float* tl = (LAS float*)C.lds;
    const int cp = C.tid & 255, th = C.tid >> 8, lane = C.lane, wave = C.wave;
    f32x2 w[CONV_W];
#pragma unroll
    for (int j = 0; j < CONV_W; ++j) w[j] = *(const f32x2*)(cw + j * CONV_CH + 2 * cp);
    const f32x2 bias = *(const f32x2*)(cb + 2 * cp);
    auto LOADT = [&](unsigned (&xin)[46], int tile) __attribute__((always_inline)) {
        const int b = tile / (S / 32), s0 = (tile % (S / 32)) * 32;
#pragma unroll
        for (int i = 0; i < 46; ++i) { const int ss = s0 + 16 * th - 15 + i; xin[i] = (ss >= 0 && ss < S) ? *(const unsigned*)(GLU + (size_t)(b * S + ss) * 512 + 2 * cp) : 0u; } };
    auto PROC = [&](const unsigned (&xin)[46], unsigned (&xn)[46], int tile, int nt) __attribute__((always_inline)) {
        const int b = tile / (S / 32), s0 = (tile % (S / 32)) * 32;
        f32x2 acc[16];
#pragma unroll
        for (int k = 0; k < 16; ++k) acc[k] = bias;
#pragma unroll
        for (int i = 0; i < 46; ++i) {
            unsigned xi = xin[i]; asm volatile("" : "+v"(xi));
            const f32x2 x = {bflo(xi), bfhi(xi)};
#pragma unroll
            for (int k = 0; k < 16; ++k) { const int j = i - k; if (j >= 0 && j < CONV_W) acc[k] += w[j] * x; }
        }
        if (nt < T / 32) LOADT(xn, nt);
#pragma unroll
        for (int k = 0; k < 16; ++k) *(LAS f32x2*)(tl + (16 * th + k) * 512 + 2 * cp) = acc[k];
        __syncthreads();
#pragma unroll
        for (int q = 0; q < 4; ++q) {
            const int tok = 4 * wave + q;
            const f32x4 v0 = *(const LAS f32x4*)(tl + tok * 512 + 8 * lane), v1 = *(const LAS f32x4*)(tl + tok * 512 + 8 * lane + 4);
            const float mu = wave_sum((v0[0] + v0[1]) + (v0[2] + v0[3]) + (v1[0] + v1[1]) + (v1[2] + v1[3])) * (1.f / CONV_CH);
            const f32x4 d0 = v0 - mu, d1 = v1 - mu;
            const float var = wave_sum((d0[0] * d0[0] + d0[1] * d0[1]) + (d0[2] * d0[2] + d0[3] * d0[3]) + (d1[0] * d1[0] + d1[1] * d1[1]) + (d1[2] * d1[2] + d1[3] * d1[3])) * (1.f / CONV_CH);
            const float rs = rsqrtf(var + EPS);
            const f32x4 g0 = *(const f32x4*)(lg + 8 * lane), g1 = *(const f32x4*)(lg + 8 * lane + 4), b0 = *(const f32x4*)(lb + 8 * lane), b1 = *(const f32x4*)(lb + 8 * lane + 4);
            f32x4 y0 = d0 * rs * g0 + b0, y1 = d1 * rs * g1 + b1;
#pragma unroll
            for (int e = 0; e < 4; ++e) { y0[e] = y0[e] * sigm(y0[e]); y1[e] = y1[e] * sigm(y1[e]); }
            v4u o; o.x = pk2(y0[0], y0[1]); o.y = pk2(y0[2], y0[3]); o.z = pk2(y1[0], y1[1]); o.w = pk2(y1[2], y1[3]);
            *(v4u*)(MIXED + (size_t)(b * S + s0 + tok) * D + 8 * lane) = o;
        }
        __syncthreads();
    };
    unsigned xa[46];
    int t = C.vcu;
    if (t < T / 32) LOADT(xa, t);
#pragma unroll 1
    for (; t < T / 32; t += C.G) PROC(xa, xa, t, t + C.G);
}
typedef short bf16x8 __attribute__((ext_vector_type(8)));
typedef short s16x4 __attribute__((ext_vector_type(4)));
typedef short v4i16_t __attribute__((ext_vector_type(4)));
typedef float f32x16 __attribute__((ext_vector_type(16)));
constexpr int AT_O = 0, AT_L = 65536, AT_V = 66560;
__device__ __forceinline__ s16x4 vtr(const LAS char* p) { return __builtin_bit_cast(s16x4, __builtin_amdgcn_ds_read_tr16_b64_v4i16((LAS v4i16_t*)p)); }
__device__ __forceinline__ void lds_addf(LAS float* p, float v) { (void)__hip_atomic_fetch_add(p, v, __ATOMIC_RELAXED, __HIP_MEMORY_SCOPE_WORKGROUP); }
__device__ __forceinline__ int med3i(int x, int lo, int hi) { return x < lo ? lo : (x > hi ? hi : x); }
__device__ __forceinline__ void attn_unit(const Ctx& C, const bf16* __restrict__ Qh, const bf16* __restrict__ Kh, const bf16* __restrict__ Vh,
                                          int d, int tq0, int nq, int tl0, int tls, float a2, float bound2, LAS float* Oacc, LAS float* Lacc, LAS char* vst, bool first) {
    int lane_ = C.lane; asm volatile("" : "+v"(lane_));
    const int lane = lane_, r = lane & 31, hh = lane >> 5;
    const int qi = r < nq ? r : nq - 1;
    const bool inr = (tq0 - 64 * d >= 0) && (tq0 + 95 * d < S);
    bf16x8 qf[4]; v4u ks_[2][4], vs[2][4];
    const char* Kc = (const char*)Kh; const char* Vc = (const char*)Vh;
#define AT_LOADK(kb) do { _Pragma("unroll") for (int it = 0; it < 4; ++it) { const int key = (lane >> 3) + 8 * it; \
        const unsigned ro = (unsigned)med3i(tq0 + d * (32 * (kb) + key - 64), 0, S - 1) * 128u + 16u * (lane & 7); ks_[(kb) % 2][it] = *(const v4u*)(Kc + ro); } } while (0)
#define AT_LOADV(kb) do { _Pragma("unroll") for (int it = 0; it < 4; ++it) { const int key = (lane >> 3) + 8 * it; \
        const unsigned ro = (unsigned)med3i(tq0 + d * (32 * (kb) + key - 64), 0, S - 1) * 128u + 16u * (lane & 7); vs[(kb) % 2][it] = *(const v4u*)(Vc + ro); } } while (0)
    { const char* qp = (const char*)Qh + (unsigned)(tq0 + d * qi) * 128u + 16u * hh;
#pragma unroll
      for (int ks = 0; ks < 4; ++ks) qf[ks] = *(const bf16x8*)(qp + 32 * ks); }
    AT_LOADK(0); AT_LOADV(0);
    f32x16 o0, o1;
#pragma unroll
    for (int v = 0; v < 16; ++v) { o0[v] = 0.f; o1[v] = 0.f; }
    float lsum = 0.f;
    LAS char* kst = vst, *vt = vst + 4096;
    const LAS char* vb = vt + ((lane >> 4) & 1) * 32 + (lane & 3) * 8 + (4 * hh + ((lane & 15) >> 2)) * 64;
    LAS char* vw = vt + ((lane & 7) >> 2) * 2048 + ((lane >> 3) & 15) * 64 + (lane & 3) * 16;
    LAS char* kw = kst + (lane >> 3) * 128;
    const LAS char* kr = kst + r * 128;
    const int rsw = (r >> 1) & 7;
#pragma unroll
    for (int kb = 0; kb < 5; ++kb) {
        if (kb + 1 < 5) { AT_LOADK(kb + 1); AT_LOADV(kb + 1); }
#pragma unroll
        for (int it = 0; it < 4; ++it) { const int key = (lane >> 3) + 8 * it;
            *(LAS v4u*)(kw + it * 1024 + (((lane & 7) ^ ((key >> 1) & 7)) << 4)) = ks_[kb % 2][it]; }
        f32x16 p;
        int relb = 32 * kb - 64 - r + 4 * hh; const int kposb = tq0 + d * (32 * kb - 64 + 4 * hh);
        asm volatile("" : "+v"(relb));
        if (inr) {
            const float rf = (float)relb;
#pragma unroll
            for (int v = 0; v < 16; ++v) { const float t = rf + (float)((v & 3) + 8 * (v >> 2)); float pv = __builtin_fmaf(fabsf(t), -a2, -bound2);
                if (kb == 0) pv = (t >= -64.f) ? pv : -1e30f;
                if (kb == 4) pv = (t <= 64.f) ? pv : -1e30f;
                p[v] = pv; }
        } else {
#pragma unroll
        for (int v = 0; v < 16; ++v) {
            const int rw = (v & 3) + 8 * (v >> 2), rel = relb + rw, kpos = kposb + d * rw;
            bool valid = ((unsigned)kpos < (unsigned)S) && (r < nq);
            if (kb == 0) valid = valid && (rel >= -64);
            if (kb == 4) valid = valid && (rel <= 64);
            p[v] = valid ? -(a2 * fabsf((float)rel)) - bound2 : -1e30f;
        }
        }
        bf16x8 kf[4];
#pragma unroll
        for (int ks = 0; ks < 4; ++ks) kf[ks] = *(const LAS bf16x8*)(kr + (((2 * ks + hh) ^ rsw) << 4));
#pragma unroll
        for (int ks = 0; ks < 4; ++ks) p = __builtin_amdgcn_mfma_f32_32x32x16_bf16(kf[ks], qf[ks], p, 0, 0, 0);
#pragma unroll
        for (int it = 0; it < 4; ++it) *(LAS v4u*)(vw + (it >> 1) * 1024 + (it & 1) * 512) = vs[kb % 2][it];
#pragma unroll
        for (int v = 0; v < 16; ++v) { p[v] = __builtin_amdgcn_exp2f(p[v]); lsum += p[v]; }
        v4u pw0, pw1;
        pw0.x = pk2(p[0], p[1]); pw0.y = pk2(p[2], p[3]); pw0.z = pk2(p[4], p[5]); pw0.w = pk2(p[6], p[7]);
        pw1.x = pk2(p[8], p[9]); pw1.y = pk2(p[10], p[11]); pw1.z = pk2(p[12], p[13]); pw1.w = pk2(p[14], p[15]);
#pragma unroll
        for (int sdh = 0; sdh < 4; ++sdh) {
            const int dh = sdh >> 1, ss = sdh & 1;
            const s16x4 lo = vtr(vb + dh * 2048 + ss * 1024), hi = vtr(vb + dh * 2048 + ss * 1024 + 512);
            const bf16x8 vf = {lo[0], lo[1], lo[2], lo[3], hi[0], hi[1], hi[2], hi[3]};
            const bf16x8 pa = __builtin_bit_cast(bf16x8, ss == 0 ? pw0 : pw1);
            if (dh == 0) o0 = __builtin_amdgcn_mfma_f32_32x32x16_bf16(pa, vf, o0, 0, 0, 0);
            else o1 = __builtin_amdgcn_mfma_f32_32x32x16_bf16(pa, vf, o1, 0, 0, 0);
        }
    }
#undef AT_LOADK
#undef AT_LOADV
    lsum += __shfl_xor(lsum, 32);
    if (lane < nq) { LAS float* lp = Lacc + tl0 + tls * lane; *lp = first ? lsum : *lp + lsum; }
#pragma unroll
    for (int v = 0; v < 16; ++v) {
        const int iq = (v & 3) + 8 * (v >> 2) + 4 * hh;
        if (v < 8 || nq == 32) { LAS float* op = Oacc + (tl0 + tls * iq) * 64 + r;
            if (first) { op[0] = o0[v]; op[32] = o1[v]; } else { const float x0 = op[0], x1 = op[32]; op[0] = x0 + o0[v]; op[32] = x1 + o1[v]; } }
    }
}
__device__ __forceinline__ void attn_phase(const Ctx& C, const Args& a) {
    const bf16* Q = (const bf16*)(a.ws + WS_PROJ + 16 * MiB);
    const bf16* K = (const bf16*)(a.ws + WS_PROJ + 32 * MiB);
    const bf16* V = (const bf16*)(a.ws + WS_PROJ + 48 * MiB);
    bf16* MIXED = (bf16*)(a.ws + WS_MIXED);
    LAS float* Oacc = (LAS float*)(C.lds + AT_O); LAS float* Lacc = (LAS float*)(C.lds + AT_L); LAS char* vst = (LAS char*)(C.lds + AT_V + C.wave * 8192);
    float mq = fabsf(a.in[7][C.lane]), mk = fabsf(a.in[8][C.lane]);
#pragma unroll
    for (int o = 1; o < 64; o <<= 1) { mq = fmaxf(mq, __shfl_xor(mq, o)); mk = fmaxf(mk, __shfl_xor(mk, o)); }
    const float bound2 = 64.f * pg8::QSCALE * mq * mk * 1.01f;
    for (int item = C.vcu; item < NB * NH * 16; item += C.G) {
        const int span = item & 15, h = (item >> 4) & 7, b = item >> 7, t0 = span * 256, w = C.wave;
        const size_t hb = (size_t)(b * NH + h) * S * 64;
        const bf16 *Qh = Q + hb, *Kh = K + hb, *Vh = V + hb;
        const float slope2 = exp2f(-(float)(h + 1)) * 1.4426950408889634f;
#pragma unroll 1
        for (int un = 0; un < 4; ++un) {
            const int d = un == 0 ? 1 : (un == 1 ? 4 : 16);
            const int tl0 = un == 0 ? 32 * w : (un == 1 ? (w >> 1) + 128 * (w & 1) : 2 * w + (un - 2));
            attn_unit(C, Qh, Kh, Vh, d, t0 + tl0, un < 2 ? 32 : 16, tl0, d, slope2 * (float)d, bound2, Oacc, Lacc, vst, un == 0);
            if (un < 2) __syncthreads();
        }
        __syncthreads();
        {
            const int q = C.tid >> 1, hf = C.tid & 1;
            const float inv = 1.f / Lacc[q];
            const LAS f32x4* op = (const LAS f32x4*)(Oacc + q * 64 + 32 * hf);
            bf16* dst = MIXED + (size_t)(b * S + t0 + q) * D + 512 + h * 64 + 32 * hf;
#pragma unroll
            for (int j = 0; j < 4; ++j) { const f32x4 x0 = op[2 * j] * inv, x1 = op[2 * j + 1] * inv; v4u o; o.x = pk2(x0[0], x0[1]); o.y = pk2(x0[2], x0[3]); o.z = pk2(x1[0], x1[1]); o.w = pk2(x1[2], x1[3]); *(v4u*)(dst + 8 * j) = o; }
        }
        __syncthreads();
    }
}

typedef float f32x4m __attribute__((ext_vector_type(4)));
__device__ __forceinline__ void router_frags(const Ctx& C, const Args& a) {
    for (int e = C.tid * C.G + C.vcu; e < 2 * 2048; e += C.G * NTHR) {
        const int layer = e >> 11, idx = e & 2047, ks = idx >> 6, l = idx & 63, n = l & 15, kq = l >> 4; unsigned hi[4], lo[4];
        const float* g = a.in[20] + (size_t)layer * D; const float* wr = a.in[21] + (size_t)layer * D * NE;
#pragma unroll
        for (int jj = 0; jj < 4; ++jj) { float wv[2]; unsigned short hb[2];
#pragma unroll
            for (int t = 0; t < 2; ++t) { const int k = 32 * ks + 8 * kq + 2 * jj + t; wv[t] = g[k] * wr[(size_t)k * NE + n]; }
            const unsigned ph = pk2(wv[0], wv[1]); hb[0] = (unsigned short)(ph & 0xffffu); hb[1] = (unsigned short)(ph >> 16);
            const unsigned pl = pk2(wv[0] - bf2f(hb[0]), wv[1] - bf2f(hb[1]));
            hi[jj] = ph; lo[jj] = pl; }
        v4u* rb = (v4u*)(a.ws + WS_RB + (size_t)layer * 65536);
        rb[idx] = (v4u){hi[0], hi[1], hi[2], hi[3]}; rb[2048 + idx] = (v4u){lo[0], lo[1], lo[2], lo[3]};
    }
}
__device__ __forceinline__ void p_router(const Ctx& C, const Args& a, int layer) {
    const bf16* X = (const bf16*)(a.ws + (layer == 0 ? WS_XA : WS_XB));
    const float* br = a.in[22] + layer * NE;
    float* RS = (float*)(a.ws + WS_RS); float* AFF = (float*)(a.ws + WS_AFF);
    LAS unsigned char* wl = C.lds;
    const int lane = C.lane, row = lane & 15, kq = lane >> 4;
    const bool rows_by_xcd = (C.G == 256);
    int task = rows_by_xcd ? (C.wave < 4 ? 4 * C.vcu + C.wave : T / 16) : C.wave * C.G + C.vcu; const int tstep = rows_by_xcd ? T / 16 : NWAVES * C.G;
    bf16x8 f[32]; float bias = 0.f;
#define RT_LOADALL(t) do { const bf16* xp_ = X + (size_t)(16 * (t) + row) * D + 8 * kq; _Pragma("unroll") for (int i = 0; i < 32; ++i) f[i] = *(const bf16x8*)(xp_ + 32 * i); } while (0)
    if (task < T / 16) { RT_LOADALL(task); bias = br[row]; }
    {
        const v4u* rb = (const v4u*)(a.ws + WS_RB + (size_t)layer * 65536);
        v4u fh[4], fl[4];
#pragma unroll
        for (int it = 0; it < 4; ++it) { fh[it] = rb[C.tid + NTHR * it]; fl[it] = rb[2048 + C.tid + NTHR * it]; }
#pragma unroll
        for (int it = 0; it < 4; ++it) { *(LAS v4u*)(wl + (C.tid + NTHR * it) * 16) = fh[it]; *(LAS v4u*)(wl + 32768 + (C.tid + NTHR * it) * 16) = fl[it]; }
    }
    __syncthreads();
    while (task < T / 16) {
        const int m0 = 16 * task;
        f32x4m acc = {0.f, 0.f, 0.f, 0.f}; float ss = 0.f;
#pragma unroll
        for (int ks = 0; ks < 32; ++ks) {
            const bf16x8 bh = *(const LAS bf16x8*)(wl + (ks * 64 + lane) * 16), bl = *(const LAS bf16x8*)(wl + 32768 + (ks * 64 + lane) * 16);
            v4u raw = __builtin_bit_cast(v4u, f[ks]); asm volatile("" : "+v"(raw));
            const bf16x8 fk = __builtin_bit_cast(bf16x8, raw);
            acc = __builtin_amdgcn_mfma_f32_16x16x32_bf16(fk, bh, acc, 0, 0, 0); acc = __builtin_amdgcn_mfma_f32_16x16x32_bf16(fk, bl, acc, 0, 0, 0);
            const float x0 = bflo(raw.x), x1 = bfhi(raw.x), x2 = bflo(raw.y), x3 = bfhi(raw.y), x4 = bflo(raw.z), x5 = bfhi(raw.z), x6 = bflo(raw.w), x7 = bfhi(raw.w);
            ss += ((x0 * x0 + x1 * x1) + (x2 * x2 + x3 * x3)) + ((x4 * x4 + x5 * x5) + (x6 * x6 + x7 * x7));
        }
        ss += __shfl_xor(ss, 16); ss += __shfl_xor(ss, 32);
        const float rs = rsqrtf(ss * (1.f / D) + EPS);
        if (lane < 16) RS[m0 + lane] = rs;
#pragma unroll
        for (int r = 0; r < 4; ++r) {
            const int orow = 4 * kq + r;
            const float lg = acc[r] * __shfl(rs, orow) + bias;
            float mx = lg;
#pragma unroll
            for (int o = 1; o < 16; o <<= 1) mx = fmaxf(mx, __shfl_xor(mx, o));
            const float ex = __expf(lg - mx); float sum = ex;
#pragma unroll
            for (int o = 1; o < 16; o <<= 1) sum += __shfl_xor(sum, o);
            const int m = m0 + orow, b = m / S, sidx = m % S;
            AFF[((size_t)b * NE + row) * S + sidx] = ex / sum;
        }
        task += tstep;
        if (task < T / 16) RT_LOADALL(task);
    }
#undef RT_LOADALL
    __syncthreads();
}

__device__ __forceinline__ int popc64(unsigned long long m) { return __builtin_popcountll(m); }
__device__ __forceinline__ void p_topk(const Ctx& C, const Args& a, int layer) {
    const float* AFF = (const float*)(a.ws + WS_AFF);
    int* IDX = (int*)(a.ws + WS_IDX); float* GATE = (float*)(a.ws + WS_GATE); int* SLOT = (int*)(a.ws + WS_SLOT);
    const float* RS = (const float*)(a.ws + WS_RS); float* RSROW = (float*)(a.ws + WS_RSROW);
    LAS unsigned* hist = (LAS unsigned*)C.lds;
    LAS int* red = (LAS int*)(C.lds + 8192);
    const int lane = C.lane, w = C.wave;
    const bool by_xcd = (C.G == 256);
    for (int it = C.vcu; it < (by_xcd ? C.G : NB * NE); it += C.G) {
        int be = it;
        if (by_xcd) { const int x = it >> 5, r = it & 31;
            if (r >= 8) {
                const v4u* wsrc = (const v4u*)(a.ws + WS_WEXP + (size_t)layer * WEXP_LAYER + WEXP_GU + (size_t)x * 2 * MiB) + (size_t)(r - 8) * 5632 + C.tid;
                v4u accp = {0u, 0u, 0u, 0u};
#pragma unroll
                for (int j = 0; j < 11; ++j) { const size_t o = (size_t)j * NTHR; if ((size_t)(r - 8) * 5632 + C.tid + o < 131072) { const v4u t = wsrc[o]; accp.x ^= t.x; accp.y ^= t.y; accp.z ^= t.z; accp.w ^= t.w; } }
                asm volatile("" :: "v"(accp));
                break; }
            be = (r >> 1) * NE + x + 8 * (r & 1); }
        const int b = be / NE, e = be % NE;
        unsigned key[8]; float rsv[8];
        { const v4u k0 = *(const v4u*)(AFF + (size_t)be * S + 512 * w + 8 * lane), k1 = *(const v4u*)(AFF + (size_t)be * S + 512 * w + 8 * lane + 4);
          const f32x4 r0 = *(const f32x4*)(RS + (size_t)b * S + 512 * w + 8 * lane), r1 = *(const f32x4*)(RS + (size_t)b * S + 512 * w + 8 * lane + 4);
          key[0] = k0.x; key[1] = k0.y; key[2] = k0.z; key[3] = k0.w; key[4] = k1.x; key[5] = k1.y; key[6] = k1.z; key[7] = k1.w;
          rsv[0] = r0[0]; rsv[1] = r0[1]; rsv[2] = r0[2]; rsv[3] = r0[3]; rsv[4] = r1[0]; rsv[5] = r1[1]; rsv[6] = r1[2]; rsv[7] = r1[3]; }
        unsigned cur = 0u; int need = CAP;
#pragma unroll
        for (int lvl = 0; lvl < 3; ++lvl) {
            const int bits = lvl < 2 ? 11 : 9, shift = lvl == 0 ? 20 : (lvl == 1 ? 9 : 0), nb = 1 << bits, per = nb / NTHR;
#pragma unroll
            for (int j = 0; j < per; ++j) hist[per * C.tid + j] = 0u;
            __syncthreads();
#pragma unroll
            for (int i = 0; i < 8; ++i) if ((key[i] >> (shift + bits)) == cur) (void)__hip_atomic_fetch_add(hist + ((key[i] >> shift) & (unsigned)(nb - 1)), 1u, __ATOMIC_RELAXED, __HIP_MEMORY_SCOPE_WORKGROUP);
            __syncthreads();
            int c[4] = {0, 0, 0, 0}, tsum = 0;
#pragma unroll
            for (int j = 0; j < per; ++j) { c[j] = (int)hist[per * C.tid + j]; tsum += c[j]; }
            int inc = tsum;
#pragma unroll
            for (int o = 1; o < 64; o <<= 1) { const int t = __shfl_up(inc, o); if (lane >= o) inc += t; }
            if (lane == 63) red[w] = inc;
            __syncthreads();
            int wpre = 0, total = 0;
#pragma unroll
            for (int ww = 0; ww < 8; ++ww) { const int t = red[ww]; total += t; if (ww < w) wpre += t; }
            const int above = total - (wpre + inc);
            if (above < need && above + tsum >= need) {
                int accn = above, binf = 0, left = need;
#pragma unroll
                for (int j = 3; j >= 0; --j) if (j < per) { if (accn < need && accn + c[j] >= need) { binf = per * C.tid + j; left = need - accn; } accn += c[j]; }
                red[8] = binf; red[9] = left;
            }
            __syncthreads();
            cur = (cur << bits) | (unsigned)red[8]; need = red[9];
        }
        unsigned pk = 0;
#pragma unroll
        for (int i = 0; i < 8; ++i) pk += (key[i] > cur ? 1u : 0u) + (key[i] == cur ? 0x10000u : 0u);
        unsigned inc = pk;
#pragma unroll
        for (int o = 1; o < 64; o <<= 1) { const unsigned t = __shfl_up(inc, o); if (lane >= o) inc += t; }
        if (lane == 63) { red[16 + w] = (int)(inc & 0xffffu); red[24 + w] = (int)(inc >> 16); }
        __syncthreads();
        int gpre = 0, epre = 0;
#pragma unroll
        for (int ww = 0; ww < 8; ++ww) { const int tg = red[16 + ww], te = red[24 + ww]; if (ww < w) { gpre += tg; epre += te; } }
        const unsigned exc = inc - pk;
        int gtb = gpre + (int)(exc & 0xffffu), eqb = epre + (int)(exc >> 16);
#pragma unroll
        for (int i = 0; i < 8; ++i) {
            const bool gt = key[i] > cur, eq = key[i] == cur;
            const bool sel = gt || (eq && eqb < need);
            const int pos = gtb + (eqb < need ? eqb : need);
            const int tok = 512 * w + 8 * lane + i;
            SLOT[((size_t)(b * S + tok)) * NE + e] = sel ? pos : -1;
            if (sel) { IDX[be * CAP + pos] = b * S + tok; GATE[be * CAP + pos] = __uint_as_float(key[i]); RSROW[be * CAP + pos] = rsv[i]; }
            gtb += gt ? 1 : 0; eqb += eq ? 1 : 0;
        }
        __syncthreads();
    }
}

__device__ __forceinline__ void p_combine(const Ctx& C, const Args& a, bool with_norm) {
    const bf16* Xin = (const bf16*)(a.ws + (with_norm ? WS_XA : WS_XB)); bf16* Xb = (bf16*)(a.ws + WS_XB); float* Xout = a.out;
    const unsigned char* Y = a.ws + WS_PROJ; const int* SLOT = (const int*)(a.ws + WS_SLOT);
    unsigned char* UC = a.ws + WS_H; const float* g = a.in[10];
    const int gw = C.vcu * NWAVES + C.wave, NGW = C.G * NWAVES, lane = C.lane;
    auto LOADR = [&](v4u (&v)[2], int& slot, int m) __attribute__((always_inline)) { const v4u* xr = (const v4u*)(Xin + (size_t)m * D) + 2 * lane; v[0] = xr[0]; v[1] = xr[1];
        slot = (lane < NE) ? SLOT[(size_t)m * NE + lane] : -1; };
    auto PROC = [&](const v4u (&vr)[2], int myslot, int m) __attribute__((always_inline)) {
        const int b = m / S;
        f32x4 v[4];
        v[0] = (f32x4){bflo(vr[0].x), bfhi(vr[0].x), bflo(vr[0].y), bfhi(vr[0].y)}; v[1] = (f32x4){bflo(vr[0].z), bfhi(vr[0].z), bflo(vr[0].w), bfhi(vr[0].w)};
        v[2] = (f32x4){bflo(vr[1].x), bfhi(vr[1].x), bflo(vr[1].y), bfhi(vr[1].y)}; v[3] = (f32x4){bflo(vr[1].z), bfhi(vr[1].z), bflo(vr[1].w), bfhi(vr[1].w)};
        unsigned long long mask = __ballot(myslot >= 0);
        f32x4 ys[4] = {{0.f, 0.f, 0.f, 0.f}, {0.f, 0.f, 0.f, 0.f}, {0.f, 0.f, 0.f, 0.f}, {0.f, 0.f, 0.f, 0.f}};
        while (mask) {
            v4u y[4]; int ee[4];
#pragma unroll
            for (int q = 0; q < 4; ++q) { ee[q] = mask ? (int)__builtin_ctzll(mask) : -1; if (mask) mask &= mask - 1; }
#pragma unroll
            for (int q = 0; q < 4; ++q) if (ee[q] >= 0) { const int sl = __shfl(myslot, ee[q]);
                y[q] = *((const v4u*)(Y + ((size_t)(b * NE + ee[q]) * CAP + sl) * D) + lane); }
#pragma unroll
            for (int q = 0; q < 4; ++q) if (ee[q] >= 0) {
#pragma unroll
                for (int j = 0; j < 4; ++j) { const int w = (int)y[q][j]; const f32x2 lo = __builtin_amdgcn_cvt_pk_f32_fp8(w, false), hi = __builtin_amdgcn_cvt_pk_f32_fp8(w, true);
                    ys[j][0] += lo[0]; ys[j][1] += lo[1]; ys[j][2] += hi[0]; ys[j][3] += hi[1]; } }
        }
#pragma unroll
        for (int j = 0; j < 4; ++j) v[j] += ys[j] * (1.f / pg8::FP8_SY);
        if (!with_norm) { f32x4* xo = (f32x4*)(Xout + (size_t)m * D) + 4 * lane;
#pragma unroll
            for (int j = 0; j < 4; ++j) xo[j] = v[j]; }
        else { v4u o0, o1; o0.x = pk2(v[0][0], v[0][1]); o0.y = pk2(v[0][2], v[0][3]); o0.z = pk2(v[1][0], v[1][1]); o0.w = pk2(v[1][2], v[1][3]);
            o1.x = pk2(v[2][0], v[2][1]); o1.y = pk2(v[2][2], v[2][3]); o1.z = pk2(v[3][0], v[3][1]); o1.w = pk2(v[3][2], v[3][3]);
            v4u* xo = (v4u*)(Xb + (size_t)m * D) + 2 * lane; xo[0] = o0; xo[1] = o1; }
        if (with_norm) {
            float s = 0.f;
#pragma unroll
            for (int j = 0; j < 4; ++j) s += (v[j][0] * v[j][0] + v[j][1] * v[j][1]) + (v[j][2] * v[j][2] + v[j][3] * v[j][3]);
            const float r = rsqrtf(wave_sum(s) * (1.f / D) + EPS);
            unsigned w[4]; const float r8 = r * pg8::FP8_SX;
#pragma unroll
            for (int j = 0; j < 4; ++j) { const f32x4 gg = ((const f32x4*)g)[4 * lane + j]; w[j] = pg8::pk4_fp8(v[j][0] * r8 * gg[0], v[j][1] * r8 * gg[1], v[j][2] * r8 * gg[2], v[j][3] * r8 * gg[3]); }
            unsigned char* up = UC + ((size_t)(lane * 1024 + (m >> 4)) * 512 + (m & 15) * 16);
            *(v4u*)up = (v4u){w[0], w[1], w[2], w[3]};
        }
    };
    v4u va[2], vb[2]; int sa = -1, sb = -1;
    int m = gw;
    if (m < T) LOADR(va, sa, m);
    for (; m < T; m += 2 * NGW) {
        if (m + NGW < T) LOADR(vb, sb, m + NGW);
        PROC(va, sa, m);
        if (m + 2 * NGW < T) LOADR(va, sa, m + 2 * NGW);
        if (m + NGW < T) PROC(vb, sb, m + NGW);
    }
}

constexpr size_t WS_UC = WS_H;
constexpr size_t WS_E = WS_PROJ;
constexpr size_t WS_TM = 468 * MiB;
constexpr size_t WS_W16 = 484 * MiB;
__device__ __forceinline__ void s5_lambda(const Args& a, int pg, int p, float& lbr, float& lbi, float& fr, float& fi) {
    const float lr = a.in[11][pg * SP + p], li = a.in[12][pg * SP + p], dt = expf(a.in[13][pg]);
    const float mag = expf(lr * dt), ang = li * dt;
    lbr = mag * cosf(ang); lbi = mag * sinf(ang);
    const float den = lr * lr + li * li, nr = lbr - 1.f;
    fr = (nr * lr + lbi * li) / den; fi = (lbi * lr - nr * li) / den;
}
__device__ __forceinline__ void p_s5_pre(const Ctx& C, const Args& a, int g) {
    LAS float* lam = (LAS float*)C.lds; LAS float* bb = lam + 2 * 64 * 17 * 2; LAS float* cc = bb + 2 * 64 * 16 * 2; LAS float* Kt = cc + 2 * 16 * 64 * 2;
    unsigned char* TM = a.ws + WS_TM + (size_t)g * 256 * 512; unsigned char* W16 = a.ws + WS_W16 + (size_t)g * 256 * 256;
    const int tid = C.tid;
    LAS float* ff = Kt + 8192;
    float rawb[4][2], rawc[4][2];
#pragma unroll
    for (int j = 0; j < 4; ++j) { const int i = tid + NTHR * j, dir = i >> 10, r = i & 1023;
        rawb[j][0] = a.in[14][((size_t)(dir * SG + g) * SP + (r >> 4)) * SC + (r & 15)]; rawb[j][1] = a.in[15][((size_t)(dir * SG + g) * SP + (r >> 4)) * SC + (r & 15)];
        rawc[j][0] = a.in[16][(size_t)(dir * SG + g) * 1024 + r]; rawc[j][1] = a.in[17][(size_t)(dir * SG + g) * 1024 + r]; }
    if (tid < 128) {
        const int dir = tid >> 6, p = tid & 63, pg = dir * SG + g;
        float lbr, lbi, fr, fi; s5_lambda(a, pg, p, lbr, lbi, fr, fi);
        ff[(dir * 64 + p) * 2] = fr; ff[(dir * 64 + p) * 2 + 1] = fi;
        if (tid < 16) ff[256 + tid] = a.in[18][g * 16 + tid];
        float pr = 1.f, pi = 0.f;
        for (int k = 0; k <= 16; ++k) { lam[((dir * 64 + p) * 17 + k) * 2] = pr; lam[((dir * 64 + p) * 17 + k) * 2 + 1] = pi; const float nr = pr * lbr - pi * lbi, ni = pr * lbi + pi * lbr; pr = nr; pi = ni; }
    }
    __syncthreads();
#pragma unroll
    for (int j = 0; j < 4; ++j) { const int i = tid + NTHR * j, dir = i >> 10, r = i & 1023, p = r >> 4;
        const float fr = ff[(dir * 64 + p) * 2], fi = ff[(dir * 64 + p) * 2 + 1];
        bb[i * 2] = fr * rawb[j][0] - fi * rawb[j][1]; bb[i * 2 + 1] = fr * rawb[j][1] + fi * rawb[j][0];
        cc[i * 2] = rawc[j][0]; cc[i * 2 + 1] = rawc[j][1]; }
    __syncthreads();
    {
        const int lane = C.lane, w = C.wave, dir = w >> 2, r16 = lane & 15, kq = lane >> 4;
        bf16x8 fbr[2], fbi[2];
#pragma unroll
        for (int s_ = 0; s_ < 2; ++s_) { unsigned short br_[8], bi_[8];
#pragma unroll
            for (int i = 0; i < 8; ++i) { const int p = 32 * s_ + 8 * kq + i; const f32x2 b = *(const LAS f32x2*)(bb + ((dir * 64 + p) * 16 + r16) * 2);
                br_[i] = (unsigned short)(pk2(b[0], 0.f) & 0xffffu); bi_[i] = (unsigned short)(pk2(b[1], 0.f) & 0xffffu); }
            fbr[s_] = (bf16x8){(short)br_[0], (short)br_[1], (short)br_[2], (short)br_[3], (short)br_[4], (short)br_[5], (short)br_[6], (short)br_[7]};
            fbi[s_] = (bf16x8){(short)bi_[0], (short)bi_[1], (short)bi_[2], (short)bi_[3], (short)bi_[4], (short)bi_[5], (short)bi_[6], (short)bi_[7]}; }
#pragma unroll 1
        for (int kk = 0; kk < 4; ++kk) { const int k = 4 * (w & 3) + kk;
            f32x4m acc = {0.f, 0.f, 0.f, 0.f};
#pragma unroll
            for (int s_ = 0; s_ < 2; ++s_) { unsigned short xr_[8], xi_[8];
#pragma unroll
                for (int i = 0; i < 8; ++i) { const int p = 32 * s_ + 8 * kq + i;
                    const f32x2 cv = *(const LAS f32x2*)(cc + ((dir * 16 + r16) * 64 + p) * 2), lv = *(const LAS f32x2*)(lam + ((dir * 64 + p) * 17 + k) * 2);
                    const float xr = cv[0] * lv[0] - cv[1] * lv[1], xi = cv[0] * lv[1] + cv[1] * lv[0];
                    xr_[i] = (unsigned short)(pk2(xr, 0.f) & 0xffffu); xi_[i] = (unsigned short)(pk2(-xi, 0.f) & 0xffffu); }
                const bf16x8 fxr = {(short)xr_[0], (short)xr_[1], (short)xr_[2], (short)xr_[3], (short)xr_[4], (short)xr_[5], (short)xr_[6], (short)xr_[7]};
                const bf16x8 fxi = {(short)xi_[0], (short)xi_[1], (short)xi_[2], (short)xi_[3], (short)xi_[4], (short)xi_[5], (short)xi_[6], (short)xi_[7]};
                acc = __builtin_amdgcn_mfma_f32_16x16x32_bf16(fxr, fbr[s_], acc, 0, 0, 0);
                acc = __builtin_amdgcn_mfma_f32_16x16x32_bf16(fxi, fbi[s_], acc, 0, 0, 0); }
#pragma unroll
            for (int r = 0; r < 4; ++r) Kt[((dir * 16 + k) * 16 + 4 * kq + r) * 16 + r16] = acc[r];
        }
    }
    __syncthreads();
    const LAS float* dsk = ff + 256;
    for (int it = tid; it < 256 * 16; it += NTHR) {
        const int n = it >> 4, s_ = it & 15, t = n >> 4, cp = n & 15;
        const int k0 = t - s_ > 0 ? t - s_ : 0, k1 = s_ - t > 0 ? s_ - t : 0;
        const float m0 = s_ <= t ? pg8::S5_STU : 0.f, m1 = s_ >= t ? pg8::S5_STU : 0.f;
        const LAS f32x4* r0 = (const LAS f32x4*)(Kt + ((0 * 16 + k0) * 16 + cp) * 16); const LAS f32x4* r1 = (const LAS f32x4*)(Kt + ((1 * 16 + k1) * 16 + cp) * 16);
        float v[16];
#pragma unroll
        for (int q = 0; q < 4; ++q) { const f32x4 a0 = r0[q], a1 = r1[q];
#pragma unroll
            for (int i = 0; i < 4; ++i) v[4 * q + i] = a0[i] * m0 + a1[i] * m1; }
        const float dd = (s_ == t) ? dsk[cp] * pg8::S5_STU : 0.f;
#pragma unroll
        for (int c = 0; c < 16; ++c) v[c] += (c == cp) ? dd : 0.f;
        v4u o; o.x = pg8::pk4_fp8(v[0], v[1], v[2], v[3]); o.y = pg8::pk4_fp8(v[4], v[5], v[6], v[7]); o.z = pg8::pk4_fp8(v[8], v[9], v[10], v[11]); o.w = pg8::pk4_fp8(v[12], v[13], v[14], v[15]);
        *(v4u*)(TM + (size_t)n * 512 + 16 * s_) = o;
    }
    for (int it = tid; it < 256 * 16; it += NTHR) {
        const int n = it >> 4, chc = it & 15, t = n >> 4, cp = n & 15, dir = chc >> 3, p0 = (chc & 7) * 8, e = dir ? 16 - t : t + 1;
        float v[16];
#pragma unroll
        for (int i = 0; i < 8; ++i) { const int p = p0 + i;
            const f32x2 cv = *(const LAS f32x2*)(cc + ((dir * 16 + cp) * 64 + p) * 2), lv = *(const LAS f32x2*)(lam + ((dir * 64 + p) * 17 + e) * 2);
            v[2 * i] = (cv[0] * lv[0] - cv[1] * lv[1]) * pg8::S5_STC; v[2 * i + 1] = -(cv[0] * lv[1] + cv[1] * lv[0]) * pg8::S5_STC; }
        v4u o; o.x = pg8::pk4_fp8(v[0], v[1], v[2], v[3]); o.y = pg8::pk4_fp8(v[4], v[5], v[6], v[7]); o.z = pg8::pk4_fp8(v[8], v[9], v[10], v[11]); o.w = pg8::pk4_fp8(v[12], v[13], v[14], v[15]);
        *(v4u*)(TM + (size_t)n * 512 + 256 + 16 * chc) = o;
    }
    for (int e16 = tid; e16 < 256 * 16; e16 += NTHR) {
        const int n = e16 >> 4, ch = e16 & 15, dir = n >> 7, p = (n & 127) >> 1, part = n & 1, s_ = ch, e = dir ? s_ : 15 - s_;
        const float lr = lam[((dir * 64 + p) * 17 + e) * 2], li = lam[((dir * 64 + p) * 17 + e) * 2 + 1]; float v[16];
#pragma unroll
        for (int i = 0; i < 16; ++i) { const float br = bb[((dir * 64 + p) * 16 + i) * 2], bi = bb[((dir * 64 + p) * 16 + i) * 2 + 1];
            v[i] = (part ? (lr * bi + li * br) : (lr * br - li * bi)) * pg8::S5_SW16; }
        v4u o; o.x = pg8::pk4_fp8(v[0], v[1], v[2], v[3]); o.y = pg8::pk4_fp8(v[4], v[5], v[6], v[7]); o.z = pg8::pk4_fp8(v[8], v[9], v[10], v[11]); o.w = pg8::pk4_fp8(v[12], v[13], v[14], v[15]);
        *(v4u*)(W16 + (size_t)n * 256 + 16 * ch) = o;
    }
    __syncthreads();
}
struct S5Order {
    int G, c;
    __device__ void init(int G_, int c_) { G = G_; c = c_; }
    __device__ bool next(int i, pg8::Unit& u) const {
        const long L = (long)i * G + c; if (L >= 256) return false;
        int V = (int)L; if (G == 256) V = (c & 7) * 32 + (c >> 3);
        u.pm = V; u.pn = 0; u.pb = V >> 2; return true;
    }
    __device__ __forceinline__ void a_ready(const pg8::Unit&) const {}
    __device__ __forceinline__ void done(const pg8::Unit&) const {}
};
struct EpiS5Scan {
    static constexpr bool PERM = true, AFTER_DRAIN = true;
    unsigned char* UC; const float *lam_re, *lam_im, *log_dt;
    static constexpr int PITCH = 528;
    __device__ __forceinline__ void fused(const pg8::f32x4 (&acc)[2][2][4][2], const pg8::Unit& u, int wr, int wc, int fr, int fq, LAS unsigned char* lds, int wid, int lane) const {
        const int tid = wid * 64 + lane;
#pragma unroll
        for (int ai = 0; ai < 2; ++ai)
#pragma unroll
            for (int m = 0; m < 4; ++m)
#pragma unroll
                for (int bj = 0; bj < 2; ++bj) { constexpr float si = 1.f / (pg8::FP8_SX * pg8::S5_SW16); const pg8::f32x4 x = acc[ai][bj][m][0] * si, y = acc[ai][bj][m][1] * si;
                    v4u w; w.x = pk2(x[0], x[1]); w.y = pk2(x[2], x[3]); w.z = pk2(y[0], y[1]); w.w = pk2(y[2], y[3]);
                    *(LAS v4u*)(lds + (ai * 128 + wr * 64 + m * 16 + fr) * PITCH + (bj * 128 + wc * 32 + 8 * fq) * 2) = w; }
        __syncthreads();
        const int g = u.pm >> 2;
        {
            const int seg = tid >> 7, dir = (tid >> 6) & 1, p = tid & 63, pg = dir * SG + g;
            const float lr = lam_re[pg * SP + p], li = lam_im[pg * SP + p], dt = expf(log_dt[pg]);
            const float mag = expf(lr * dt), ang = li * dt;
            float pr = mag * cosf(ang), pi = mag * sinf(ang);
#pragma unroll
            for (int i = 0; i < 4; ++i) { const float nr = pr * pr - pi * pi, ni = 2.f * pr * pi; pr = nr; pi = ni; }
            float qr = pr, qi = pi;
#pragma unroll
            for (int i = 0; i < 6; ++i) { const float nr = qr * qr - qi * qi, ni = 2.f * qr * qi; qr = nr; qi = ni; }
            LAS unsigned char* col = lds + (dir * 128 + 2 * p) * 2;
            LAS float* xch = (LAS float*)(lds + 256 * PITCH);
            float hr = 0.f, hi = 0.f;
#pragma unroll 8
            for (int j = 0; j < 64; ++j) { const int q = 64 * seg + j;
                LAS unsigned* cell = (LAS unsigned*)(col + (dir ? 255 - q : q) * PITCH);
                const unsigned e = *cell; *cell = pk2(hr, hi);
                const float er = bflo(e), ei = bfhi(e); const float nr = pr * hr - pi * hi + er, ni = pr * hi + pi * hr + ei; hr = nr; hi = ni;
            }
            xch[(seg * 128 + (tid & 127)) * 2] = hr; xch[(seg * 128 + (tid & 127)) * 2 + 1] = hi;
            __syncthreads();
            float cr = 0.f, ci = 0.f;
#pragma unroll
            for (int k = 0; k < 3; ++k) if (k < seg) { const float er = xch[(k * 128 + (tid & 127)) * 2], ei = xch[(k * 128 + (tid & 127)) * 2 + 1];
                const float nr = qr * cr - qi * ci + er, ni = qr * ci + qi * cr + ei; cr = nr; ci = ni; }
            if (seg > 0) {
#pragma unroll 8
                for (int j = 0; j < 64; ++j) { const int q = 64 * seg + j;
                    LAS unsigned* cell = (LAS unsigned*)(col + (dir ? 255 - q : q) * PITCH);
                    const unsigned e = *cell; *cell = pk2(bflo(e) + cr, bfhi(e) + ci);
                    const float nr = pr * cr - pi * ci, ni = pr * ci + pi * cr; cr = nr; ci = ni;
                }
            }
        }
        __syncthreads();
        unsigned char* dst = UC + (size_t)u.pm * 256 * 512 + 256;
#pragma unroll
        for (int i = 0; i < 8; ++i) { const int idx = tid + 512 * i, row = idx >> 4, ch = idx & 15;
            const v4u s0 = *(const LAS v4u*)(lds + row * PITCH + 32 * ch), s1 = *(const LAS v4u*)(lds + row * PITCH + 32 * ch + 16);
            constexpr float sh = pg8::S5_SH; v4u o;
            o.x = pg8::pk4_fp8(bflo(s0.x) * sh, bfhi(s0.x) * sh, bflo(s0.y) * sh, bfhi(s0.y) * sh); o.y = pg8::pk4_fp8(bflo(s0.z) * sh, bfhi(s0.z) * sh, bflo(s0.w) * sh, bfhi(s0.w) * sh);
            o.z = pg8::pk4_fp8(bflo(s1.x) * sh, bfhi(s1.x) * sh, bflo(s1.y) * sh, bfhi(s1.y) * sh); o.w = pg8::pk4_fp8(bflo(s1.z) * sh, bfhi(s1.z) * sh, bflo(s1.w) * sh, bfhi(s1.w) * sh);
            *(v4u*)(dst + (size_t)row * 512 + 16 * ch) = o; }
        __syncthreads();
    }
};
__device__ __forceinline__ float gelu_t(float y) { const float q = y * __builtin_fmaf(0.10294324f, y * y, 2.3022082f); return y * __builtin_amdgcn_rcpf(1.f + __builtin_amdgcn_exp2f(-q)); }
struct EpiS5Z {
    static constexpr bool PERM = true, AFTER_DRAIN = false;
    unsigned char* Z;
    __device__ __forceinline__ void operator()(const pg8::f32x4 (&acc)[2][2][4][2], const pg8::Unit& u, int wr, int wc, int fr, int fq) const {
        const int row0 = u.pm * 256 + wr * 64 + fr;
        constexpr float sx = pg8::FP8_SX;
#pragma unroll
        for (int ai = 0; ai < 2; ++ai)
#pragma unroll
            for (int bj = 0; bj < 2; ++bj) { const int t = 8 * bj + 2 * wc + (fq >> 1), c0 = 8 * (fq & 1);
                v2u zq[4];
#pragma unroll
                for (int m = 0; m < 4; ++m) { constexpr float sz = 1.f / (pg8::FP8_SX * pg8::S5_STU); const pg8::f32x4 x = acc[ai][bj][m][0] * sz, y = acc[ai][bj][m][1] * sz;
                    zq[m].x = pg8::pk4_fp8(gelu_t(x[0]) * sx, gelu_t(x[1]) * sx, gelu_t(x[2]) * sx, gelu_t(x[3]) * sx); zq[m].y = pg8::pk4_fp8(gelu_t(y[0]) * sx, gelu_t(y[1]) * sx, gelu_t(y[2]) * sx, gelu_t(y[3]) * sx); }
#pragma unroll
                for (int m = 0; m < 4; m += 2) { const int row = row0 + ai * 128 + m * 16, g = row >> 10, J = row & 1023;
                    const size_t off0 = (size_t)(16 * J + t) * D + g * 16 + c0;
                    pg8::fp8_pair_store(Z, off0, off0 + (size_t)256 * D, zq[m], zq[m + 1], fq); } }
    }
};
constexpr int NPHASE = 18;
__global__ void __launch_bounds__(NTHR, 2) mk_fwd(Args args) {
    extern __shared__ __attribute__((aligned(16))) unsigned char lds_raw[];
    Ctx C;
    C.lds = (LAS unsigned char*)lds_raw;
    C.tid = threadIdx.x; C.lane = C.tid & 63; C.wave = __builtin_amdgcn_readfirstlane(C.tid >> 6);
    C.G = gridDim.x; { const int bx = blockIdx.x; C.vcu = (C.G % 8 == 0) ? (bx % 8) * (C.G / 8) + bx / 8 : bx; }
    volatile LAS unsigned* MISC = (volatile LAS unsigned*)(C.lds + LDSCTL_OFF);
    for (int u = C.tid; u < (LDS_BYTES - LDSCTL_OFF) / 4; u += NTHR) ((LAS unsigned*)(C.lds + LDSCTL_OFF))[u] = 0u;
    __syncthreads();
    int lo = args.ph_lo, hi = args.ph_hi;
    __attribute__((address_space(1))) unsigned char* wsg = (__attribute__((address_space(1))) unsigned char*)args.ws;
    asm volatile("" : "+s"(lo), "+s"(hi), "+s"(wsg));
    unsigned char* ws = (unsigned char*)wsg;
    unsigned* ctl = (unsigned*)(ws + WS_CTL);
    const bool one_launch = (lo == 0 && hi == NPHASE);
    XcdBarrier bar; bar.bar = ctl + CW_BAR; bar.x = 0; bar.st = nullptr;
    if (one_launch) bar = xcd_barrier_post(ctl + CW_BAR, MISC + 8);
    LAS unsigned char* glds = C.lds;
#ifndef MK_ONLY
#define MK_ONLY -1
#endif
#define IN(k) ((MK_ONLY < 0 || MK_ONLY == (k) || (MK_ONLY == 4 && (k) == 13) || (MK_ONLY == 5 && (k) == 14) || (MK_ONLY == 6 && (k) == 15) || (MK_ONLY == 7 && (k) == 16) || (MK_ONLY == 8 && (k) == 17)) && lo <= (k) && (k) < hi)
#ifndef MK_S5DUP
#define MK_S5DUP 0
#endif
#ifndef MK_DUP
#define MK_DUP 0
#endif
#define DUPBIT(k) ((MK_DUP >> ((k) < 13 ? (k) : (k) - 9)) & 1)
#define DUPX(k, ...) do { __VA_ARGS__ if (DUPBIT(k)) { __VA_ARGS__ } } while (0)
#define SEAM(k) do { if (IN(k) && IN((k) + 1)) xcd_barrier(bar); } while (0)

#ifdef MK_XBAR
    if (one_launch) for (int xb_ = 0; xb_ < MK_XBAR; ++xb_) xcd_barrier(bar);
#endif
    if (IN(0)) { DUPX(0, p0_prologue(C, args);); router_frags(C, args); } SEAM(0);
    int vb = (int)blockIdx.x; bool lsync = false;
    if (one_launch) {
        if (C.tid == 0) {
            unsigned ok = (C.G == 256 && bar.x < 8u && bar.rank < 32u) ? 1u : 0u;
            for (unsigned j = 0; j < 8; ++j) ok &= (xb_ld(&bar.bar[XB_XCNT(j)]) == 32u) ? 1u : 0u;
            MISC[8 + 2] = bar.rank; MISC[8 + 3] = ok;
        }
        __syncthreads();
        const unsigned ok = (unsigned)__builtin_amdgcn_readfirstlane((int)MISC[8 + 3]), rk = (unsigned)__builtin_amdgcn_readfirstlane((int)MISC[8 + 2]);
        if (ok) { vb = (int)(rk * 8u + bar.x); lsync = true; C.vcu = (vb % 8) * (C.G / 8) + vb / 8; }
    }
#define LSEAM(k) do { if (IN(k) && IN((k) + 1)) { if (lsync) xcd_local_barrier(bar); else xcd_barrier(bar); } } while (0)
    if (IN(1)) {
        const int G1 = (C.G == 256) ? 214 : C.G;
        if (vb < G1) {
            pg8::Gemm g{(const bf16*)(ws + WS_XN), (const bf16*)(ws + WS_WIN), D, nullptr, D, D}; pg8::DenseOrder So; So.init(T, INC, G1, vb);
            pg8::EpiProj E{(bf16*)(ws + WS_PROJ), (bf16*)(ws + WS_PROJ + 16 * MiB), args.in[7], args.in[8]};
            pg8::gemm_phase<pg8::EpiProj, pg8::DenseOrder, true, true>(glds, g, So, E);
            if (C.tid == 0) __hip_atomic_fetch_add((unsigned*)(ws + WS_CTL) + CW_P1DONE, 1u, __ATOMIC_RELAXED, __HIP_MEMORY_SCOPE_AGENT);
        } else conv_drain(C, args, true);
    } SEAM(1);
    if (IN(2)) {
 DUPX(2, {        for (int gq = C.vcu; gq < SG; gq += C.G) p_s5_pre(C, args, gq);
        conv_phase(C, args);
        attn_phase(C, args);
        conv_drain(C, args, false);
    }); } SEAM(2);
    if (IN(3)) {
 DUPX(3, {        pg8::Gemm g{(const bf16*)(ws + WS_MIXED), (const bf16*)(ws + WS_WOUT), D, nullptr, D, D}; pg8::DenseOrder So; So.init(T, D, C.G, vb);
        pg8::EpiRes E{(const bf16*)(ws + WS_XN), (const float*)(ws + WS_RMS0), (bf16*)(ws + WS_XA), ws + WS_XQ};
        pg8::gemm_phase<pg8::EpiRes, pg8::DenseOrder, true, true>(glds, g, So, E);
    }); } LSEAM(3);
#define MOE_PHASES(layer, pb) do { \
        if (IN(pb)) { DUPX(pb, p_router(C, args, layer);); } SEAM(pb); \
        if (IN(pb + 1)) { DUPX(pb + 1, p_topk(C, args, layer);); } LSEAM(pb + 1); \
        if (IN(pb + 2)) { DUPX(pb + 2, { \
            int k8 = 512; asm volatile("" : "+s"(k8));       \
            pg8::Gemm g{(const bf16*)(ws + WS_XQ), (const bf16*)(ws + WS_WEXP + layer * WEXP_LAYER + WEXP_GU), k8, (const int*)(ws + WS_IDX), 512, 512}; pg8::ExpertOrder So; So.init(8, C.G, vb); \
            pg8::EpiSwiGLU E{ws + WS_H, (const float*)(ws + WS_RSROW)}; \
            pg8::gemm_phase<pg8::EpiSwiGLU, pg8::ExpertOrder, true, true, true, true>(glds, g, So, E); \
        }); } LSEAM(pb + 2); \
        if (IN(pb + 3)) { DUPX(pb + 3, { \
            int k8 = 512; asm volatile("" : "+s"(k8)); \
            pg8::Gemm g{(const bf16*)(ws + WS_H), (const bf16*)(ws + WS_WEXP + layer * WEXP_LAYER + WEXP_DN), k8, nullptr, 512, 512}; pg8::ExpertOrder So; So.init(4, C.G, vb); \
            pg8::EpiDown E{ws + WS_PROJ, (const float*)(ws + WS_GATE)}; \
            pg8::gemm_phase<pg8::EpiDown, pg8::ExpertOrder, true, true, false, true>(glds, g, So, E); \
        }); } SEAM(pb + 3); \
        if (IN(pb + 4)) { DUPX(pb + 4, p_combine(C, args, layer == 0);); } \
    } while (0)
    MOE_PHASES(0, 4);
    SEAM(8);
    if (IN(9)) {
        int k9 = 128; asm volatile("" : "+s"(k9));
        pg8::Gemm g{(const bf16*)(ws + WS_UC), (const bf16*)(ws + WS_W16), k9, nullptr, 256, 128}; S5Order So; So.init(C.G, vb);
        EpiS5Scan E{ws + WS_UC, args.in[11], args.in[12], args.in[13]};
        pg8::gemm_phase<EpiS5Scan, S5Order, false, true, false, true>(glds, g, So, E);
    }
    asm volatile("s_waitcnt vmcnt(0)" ::: "memory"); __syncthreads();
    if (IN(11)) {
        int k11 = 256; asm volatile("" : "+s"(k11));
        pg8::Gemm g{(const bf16*)(ws + WS_UC), (const bf16*)(ws + WS_TM), k11, nullptr, 256, 256}; S5Order So; So.init(C.G, vb);
        EpiS5Z E{ws + WS_MIXED};
        pg8::gemm_phase<EpiS5Z, S5Order, true, true, false, true>(glds, g, So, E);
#if MK_S5DUP == 11
        pg8::gemm_phase<EpiS5Z, S5Order, true, true, false, true>(glds, g, So, E);
#endif
    } SEAM(11);
    if (IN(12)) {
        int k8 = 512; asm volatile("" : "+s"(k8));
        pg8::Gemm g{(const bf16*)(ws + WS_MIXED), (const bf16*)(ws + WS_WGLU), k8, nullptr, 512, 512}; pg8::DenseOrder So; So.init(T, 2 * D, C.G, vb);
        pg8::EpiGluRes E{(bf16*)(ws + WS_XB), ws + WS_XQ};
        pg8::gemm_phase<pg8::EpiGluRes, pg8::DenseOrder, true, true, false, true>(glds, g, So, E);
    } LSEAM(12);
    MOE_PHASES(1, 13);
#undef IN
#undef SEAM
#undef LSEAM
}

#ifndef MK_PER_PHASE
#define MK_PER_PHASE 0
#endif
extern "C" void kernel_launch(void* const* d_in, const int* in_sizes, int n_in, void* d_out, int out_size, void* d_ws, size_t ws_size, hipStream_t stream) {
    static int grid = 0;
    if (grid == 0) {
        if (n_in != 26 || out_size != T * D || ws_size < WS_END) { fprintf(stderr, "kernel_launch: unexpected shapes (n_in %d out %d ws %zu)\n", n_in, out_size, ws_size); grid = -1; return; }
        int dev = 0, cus = 0, per_cu = 0;
        if (hipGetDevice(&dev) != hipSuccess || hipDeviceGetAttribute(&cus, hipDeviceAttributeMultiprocessorCount, dev) != hipSuccess) { grid = -1; return; }
        if (hipFuncSetAttribute((const void*)mk_fwd, hipFuncAttributeMaxDynamicSharedMemorySize, LDS_BYTES) != hipSuccess) { fprintf(stderr, "kernel_launch: hipFuncSetAttribute failed\n"); grid = -1; return; }
        if (hipOccupancyMaxActiveBlocksPerMultiprocessor(&per_cu, (const void*)mk_fwd, NTHR, LDS_BYTES) != hipSuccess || per_cu < 1) { fprintf(stderr, "kernel_launch: occupancy query says %d blocks per CU\n", per_cu); (void)hipGetLastError(); grid = -1; return; }
        grid = cus;
    }
    if (grid < 0) return;
    (void)hipMemsetAsync((char*)d_ws + WS_CTL, 0, CTL_ZERO_BYTES, stream);
    Args a{};
    for (int i = 0; i < 26; ++i) a.in[i] = (const float*)d_in[i];
    a.out = (float*)d_out; a.ws = (unsigned char*)d_ws;
#if MK_PER_PHASE
    for (int p = 0; p < NPHASE; ++p) { a.ph_lo = p; a.ph_hi = p + 1; hipLaunchKernelGGL(mk_fwd, dim3(grid), dim3(NTHR), LDS_BYTES, stream, a); }
#else
    a.ph_lo = 0; a.ph_hi = NPHASE;
    hipLaunchKernelGGL(mk_fwd, dim3(grid), dim3(NTHR), LDS_BYTES, stream, a);
#endif
}
```
